# Optimizing an MI355X kernel written in HIP

```python
import math
import jax, jax.numpy as jnp
from jax import lax
import numpy as np


D_MODEL = 1024
BATCH = 4
SEQ = 4096
DEPTH = 1

CHUNK = 64
QUERY_BLOCK = 2 * CHUNK
SB_HEADS = 8
SB_HEAD_DIM = 64
SB_WIDTH = SB_HEADS * SB_HEAD_DIM
CONV_GROUPS = 8
CONV_WIDTH = D_MODEL // 2
CONV_K = 3
N_BRANCHES = 2
IN_WIDTH = 3 * SB_WIDTH + 3 * CONV_WIDTH + N_BRANCHES * D_MODEL
PEER_HEADS = 8
PEER_QUERY_DIM = 256
PEER_HALF = PEER_QUERY_DIM // 2
N_KEYS = 128
N_EXPERTS = N_KEYS * N_KEYS
PEER_TOPK = 16
PEER_TOKEN_BLOCK = 128
RMS_EPS = 1e-6

kernel_name = 'hybrid_stickbreak_shortconv_peer'


def rms_norm(x, gain):
    x32 = x.astype(jnp.float32)
    y = x32 * lax.rsqrt(jnp.mean(x32 * x32, axis=-1, keepdims=True) + RMS_EPS)
    return (y * gain.astype(jnp.float32)).astype(x.dtype)


def stick_breaking_attention(q, k, v):
    b, h, t, dh = q.shape
    n_blk = t // QUERY_BLOCK
    scale = dh ** -0.5
    k32 = k.astype(jnp.float32)
    v32 = v.astype(jnp.float32)
    q_blocks = q.reshape(b, h, n_blk, QUERY_BLOCK, dh).transpose(2, 0, 1, 3, 4)
    key_pos = jnp.arange(t)

    def one_block(args):
        q_blk, blk = args
        z = jnp.einsum('bhqd,bhkd->bhqk', q_blk.astype(jnp.float32), k32) * scale
        q_pos = blk * QUERY_BLOCK + jnp.arange(QUERY_BLOCK)
        mask = key_pos[None, :] < q_pos[:, None]
        log_1m_beta = jnp.where(mask, jax.nn.log_sigmoid(-z), 0.0)
        stick = lax.cumsum(log_1m_beta, axis=3, reverse=True) - log_1m_beta
        att = jnp.where(mask, jnp.exp(jax.nn.log_sigmoid(z) + stick), 0.0)
        return jnp.einsum('bhqk,bhkd->bhqd', att, v32)

    out = lax.map(one_block, (q_blocks, jnp.arange(n_blk)))
    return out.transpose(1, 2, 0, 3, 4).reshape(b, h, t, dh).astype(q.dtype)


def short_conv_mixer(b_gate, c_gate, u, conv_w, conv_b):
    z = c_gate * u
    y = lax.conv_general_dilated(
        z, conv_w.astype(z.dtype), window_strides=(1,), padding=[(CONV_K - 1, 0)],
        dimension_numbers=('NWC', 'WIO', 'NWC'), feature_group_count=CONV_WIDTH)
    return b_gate * (y + conv_b.astype(z.dtype))


def peer_ffn(x, w_q, sub_keys, expert_u, expert_v):
    b, t, d = x.shape
    n_blk = (b * t) // PEER_TOKEN_BLOCK
    x_blocks = x.reshape(n_blk, PEER_TOKEN_BLOCK, d)
    keys32 = sub_keys.astype(jnp.float32)

    def one_block(x_blk):
        n = x_blk.shape[0]
        q = (x_blk @ w_q).reshape(n, PEER_HEADS, 2, PEER_HALF).astype(jnp.float32)
        s = jnp.einsum('nhpc,hpkc->nhpk', q, keys32)
        top_s, top_i = lax.top_k(s, PEER_TOPK)
        cand_s = top_s[:, :, 0, :, None] + top_s[:, :, 1, None, :]
        cand_i = top_i[:, :, 0, :, None] * N_KEYS + top_i[:, :, 1, None, :]
        cand_s = cand_s.reshape(n, PEER_HEADS, PEER_TOPK * PEER_TOPK)
        cand_i = cand_i.reshape(n, PEER_HEADS, PEER_TOPK * PEER_TOPK)
        best_s, best_c = lax.top_k(cand_s, PEER_TOPK)
        expert_idx = jnp.take_along_axis(cand_i, best_c, axis=-1)
        gate = jax.nn.softmax(best_s, axis=-1)
        u_sel = expert_u[expert_idx]
        v_sel = expert_v[expert_idx]
        act = jax.nn.gelu(jnp.einsum('nhkd,nd->nhk', u_sel, x_blk).astype(jnp.float32), approximate=False)
        w = (gate * act).astype(v_sel.dtype)
        return jnp.einsum('nhk,nhkd->nd', w, v_sel)

    return lax.map(one_block, x_blocks).reshape(b, t, d).astype(x.dtype)


def hybrid_layer(x, norm_mix, w_in, conv_w, conv_b, w_branch_a, w_branch_b, w_out,
                 norm_ffn, w_q, sub_keys, expert_u, expert_v):
    b, t, _ = x.shape
    h = rms_norm(x, norm_mix)
    proj = h @ w_in
    o1 = SB_WIDTH
    o2 = 2 * SB_WIDTH
    o3 = 3 * SB_WIDTH
    o4 = o3 + CONV_WIDTH
    o5 = o4 + CONV_WIDTH
    o6 = o5 + CONV_WIDTH
    q, k, v, cb, cc, cu, gate_logits = jnp.split(proj, [o1, o2, o3, o4, o5, o6], axis=-1)

    def heads(a):
        return a.reshape(b, t, SB_HEADS, SB_HEAD_DIM).transpose(0, 2, 1, 3)

    att = stick_breaking_attention(heads(q), heads(k), heads(v))
    y_a = att.transpose(0, 2, 1, 3).reshape(b, t, SB_WIDTH) @ w_branch_a
    y_b = short_conv_mixer(cb, cc, cu, conv_w, conv_b) @ w_branch_b

    g = jax.nn.sigmoid(gate_logits.astype(jnp.float32)).reshape(b, t, N_BRANCHES, D_MODEL)
    merged = (g[:, :, 0, :] * y_a.astype(jnp.float32) + g[:, :, 1, :] * y_b.astype(jnp.float32)).astype(x.dtype)
    x = x + merged @ w_out
    x = x + peer_ffn(rms_norm(x, norm_ffn), w_q, sub_keys, expert_u, expert_v)
    return x


def setup_inputs(seed: int = 0) -> dict:
    key = jax.random.key(seed)
    ks = jax.random.split(key, 16)
    f32 = jnp.float32
    nrm = lambda k, shape, s: jax.random.normal(k, shape, f32) * s
    return {
        'x': nrm(ks[0], (BATCH, SEQ, D_MODEL), 1.0),
        'norm_mix': 1.0 + nrm(ks[1], (DEPTH, D_MODEL), 0.02),
        'w_in': nrm(ks[2], (DEPTH, D_MODEL, IN_WIDTH), D_MODEL ** -0.5),
        'conv_w': nrm(ks[3], (DEPTH, CONV_K, 1, CONV_WIDTH), CONV_K ** -0.5),
        'conv_b': nrm(ks[4], (DEPTH, CONV_WIDTH), 0.01),
        'w_branch_a': nrm(ks[5], (DEPTH, SB_WIDTH, D_MODEL), SB_WIDTH ** -0.5),
        'w_branch_b': nrm(ks[6], (DEPTH, CONV_WIDTH, D_MODEL), CONV_WIDTH ** -0.5),
        'w_out': nrm(ks[7], (DEPTH, D_MODEL, D_MODEL), D_MODEL ** -0.5),
        'norm_ffn': 1.0 + nrm(ks[8], (DEPTH, D_MODEL), 0.02),
        'w_q': nrm(ks[9], (DEPTH, D_MODEL, PEER_HEADS * PEER_QUERY_DIM), D_MODEL ** -0.5),
        'sub_keys': nrm(ks[10], (DEPTH, PEER_HEADS, 2, N_KEYS, PEER_HALF), PEER_HALF ** -0.5),
        'expert_u': nrm(ks[11], (DEPTH, N_EXPERTS, D_MODEL), D_MODEL ** -0.5),
        'expert_v': nrm(ks[12], (DEPTH, N_EXPERTS, D_MODEL), PEER_HEADS ** -0.5),
        'final_norm': 1.0 + nrm(ks[13], (D_MODEL,), 0.02),
    }


def reference(x, norm_mix, w_in, conv_w, conv_b, w_branch_a, w_branch_b, w_out,
              norm_ffn, w_q, sub_keys, expert_u, expert_v, final_norm):
    for layer in range(DEPTH):
        x = hybrid_layer(x, norm_mix[layer], w_in[layer], conv_w[layer], conv_b[layer],
                         w_branch_a[layer], w_branch_b[layer], w_out[layer],
                         norm_ffn[layer], w_q[layer], sub_keys[layer],
                         expert_u[layer], expert_v[layer])
    return rms_norm(x, final_norm)
```

```cpp
#include <hip/hip_runtime.h>
#include <cstdio>
#include <cstdint>
#include <cmath>
namespace pg8 {
#define PG8_LAS __attribute__((address_space(3)))
typedef unsigned short bf16_t;
typedef short bf16x8 __attribute__((ext_vector_type(8)));
typedef float f32x4 __attribute__((ext_vector_type(4)));
typedef unsigned u32x4 __attribute__((ext_vector_type(4)));
constexpr int BM = 256, BK = 64, HALF = 128, HTB = HALF * BK * 2  , STAGE_BYTES = 8 * HTB, NXCD = 8, WGM = 8;

__host__ __device__ __forceinline__ int lds_byte(int r, int c) { const int st = (r >> 4) * 2 + (c >> 5), rr = r & 15, cc = c & 31, ob = rr * 64 + cc * 2; return st * 1024 + (ob ^ (((ob >> 9) & 1) << 5)); }
__host__ __device__ __forceinline__ void stage_rc(int b, int& R, int& C) { const int st = b / 1024, sb = b % 1024, swz = sb ^ (((sb >> 9) & 1) << 5); R = (st >> 1) * 16 + swz / 64; C = (st & 1) * 32 + (swz % 64) / 2; }
__host__ __device__ __forceinline__ int perm32(int rho) { const int n = rho >> 4, i = rho & 15; return 8 * (i >> 2) + 4 * n + (i & 3); }

struct Unit { int pm, pn; };
struct Gemm { const bf16_t* A; const bf16_t* Bt; int M, N, K; };

struct StaticOrder {
    int nM, nN, nwg, G, c;
    __host__ __device__ void init(int M, int N, int G_, int c_) { nM = M / BM; nN = N / BM; nwg = nM * nN; G = G_; c = c_; }
    __host__ __device__ bool next(int i, Unit& u) const {
        const long L = (long)i * G + c; if (L >= nwg) return false;
        int wgid = (int)L; { const int q = nwg / NXCD, r = nwg % NXCD, xcd = wgid % NXCD, off = wgid / NXCD; wgid = (xcd < r ? xcd * (q + 1) : r * (q + 1) + (xcd - r) * q) + off; }
        const int nig = WGM * nN, gid = wgid / nig, fm = gid * WGM, gsz = (nM - fm) < WGM ? (nM - fm) : WGM;
        u.pm = fm + ((wgid % nig) % gsz); u.pn = (wgid % nig) / gsz; return true;
    }
    __device__ __forceinline__ void a_ready(const Unit&) const {}
    __device__ __forceinline__ void done(const Unit&) const {}
};

__device__ __forceinline__ unsigned cvt_pk_bf16(float lo, float hi) { unsigned r; asm volatile("v_cvt_pk_bf16_f32 %0, %1, %2" : "=v"(r) : "v"(lo), "v"(hi)); return r; }
constexpr int MTOK = 16384;
__device__ __forceinline__ unsigned f2bf_rne(float f) { unsigned u = __builtin_bit_cast(unsigned, f); return (u + 0x7fffu + ((u >> 16) & 1u)) >> 16; }
__device__ __forceinline__ float bf_lo(unsigned w) { return __builtin_bit_cast(float, w << 16); }
__device__ __forceinline__ float bf_hi(unsigned w) { return __builtin_bit_cast(float, w & 0xffff0000u); }
__device__ __forceinline__ float sigmoid_fast(float x) { return __builtin_amdgcn_rcpf(1.0f + __builtin_amdgcn_exp2f(-1.4426950408889634f * x)); }

struct EpiProj {
    static constexpr bool PERM = true, AFTER_DRAIN = false;
    bf16_t* six;
    bf16_t* vt;
    bf16_t* gate;
    const float* rstd;
    __device__ __forceinline__ void operator()(const f32x4 (&acc)[2][2][4][2], const Unit& u, int wr, int wc, int fr, int fq) const {
        const int row0 = u.pm * BM + wr * 64 + fr; const int colt = u.pn * BM;
        if (colt < 3072) {
            const int t = colt >> 9, cc = colt & 511;
            if (t == 2) {
#pragma unroll
                for (int ai = 0; ai < 2; ++ai)
#pragma unroll
                    for (int m = 0; m < 4; ++m) { const int r = row0 + ai * HALF + m * 16; const float rs = rstd[r]; const int b = r >> 12, tt = r & 4095;
#pragma unroll
                        for (int bj = 0; bj < 2; ++bj) { const int c0 = cc + bj * HALF + wc * 32 + 8 * fq; const int hh = c0 >> 6, d0 = c0 & 63;
                            bf16_t* p = vt + ((size_t)((b * 8 + hh) * 64 + d0)) * 4096 + tt;
#pragma unroll
                            for (int n = 0; n < 2; ++n)
#pragma unroll
                                for (int i = 0; i < 4; ++i) p[(size_t)(4 * n + i) * 4096] = (bf16_t)f2bf_rne(acc[ai][bj][m][n][i] * rs); } }
            } else {
                const int bufidx = (t == 0) ? 0 : (t == 1) ? 2 : (t == 3) ? 1 : t;
                bf16_t* base = six + (size_t)bufidx * MTOK * 512; const float sc = (t == 0) ? 0.125f : 1.0f;
                const int col0 = cc + wc * 32 + 8 * fq;
#pragma unroll
                for (int ai = 0; ai < 2; ++ai)
#pragma unroll
                    for (int m = 0; m < 4; ++m) { const int r = row0 + ai * HALF + m * 16; const float rs = rstd[r] * sc; bf16_t* rowp = base + (size_t)r * 512 + col0;
#pragma unroll
                        for (int bj = 0; bj < 2; ++bj) { const f32x4 v0 = acc[ai][bj][m][0] * rs, v1 = acc[ai][bj][m][1] * rs;
                            u32x4 w; w.x = cvt_pk_bf16(v0[0], v0[1]); w.y = cvt_pk_bf16(v0[2], v0[3]); w.z = cvt_pk_bf16(v1[0], v1[1]); w.w = cvt_pk_bf16(v1[2], v1[3]);
                            *(u32x4*)(rowp + bj * HALF) = w; } }
            }
        } else {
            const int gi = (colt - 3072) >> 10, cc = (colt - 3072) & 1023;
            bf16_t* base = gate + (size_t)gi * MTOK * 1024; const int col0 = cc + wc * 32 + 8 * fq;
#pragma unroll
            for (int ai = 0; ai < 2; ++ai)
#pragma unroll
                for (int m = 0; m < 4; ++m) { const int r = row0 + ai * HALF + m * 16; const float rs = rstd[r]; bf16_t* rowp = base + (size_t)r * 1024 + col0;
#pragma unroll
                    for (int bj = 0; bj < 2; ++bj) { f32x4 v0 = acc[ai][bj][m][0] * rs, v1 = acc[ai][bj][m][1] * rs;
#pragma unroll
                        for (int i = 0; i < 4; ++i) { v0[i] = sigmoid_fast(v0[i]); v1[i] = sigmoid_fast(v1[i]); }
                        u32x4 w; w.x = cvt_pk_bf16(v0[0], v0[1]); w.y = cvt_pk_bf16(v0[2], v0[3]); w.z = cvt_pk_bf16(v1[0], v1[1]); w.w = cvt_pk_bf16(v1[2], v1[3]);
                        *(u32x4*)(rowp + bj * HALF) = w; } }
        }
    }
};

struct EpiGate {
    static constexpr bool PERM = true, AFTER_DRAIN = false;
    float* P; bf16_t* merged; const bf16_t* g0; const bf16_t* g1;
    __device__ __forceinline__ void operator()(const f32x4 (&acc)[2][2][4][2], const Unit& u, int wr, int wc, int fr, int fq) const {
        const int which = (u.pm >= 64) ? 1 : 0; const int pm = u.pm - 64 * which, pn = u.pn - 4 * which;
        const int row0 = pm * BM + wr * 64 + fr, col0 = pn * BM + wc * 32 + 8 * fq; const bf16_t* g = which ? g1 : g0;
#pragma unroll
        for (int ai = 0; ai < 2; ++ai)
#pragma unroll
            for (int m = 0; m < 4; ++m) { const int r = row0 + ai * HALF + m * 16;
#pragma unroll
                for (int bj = 0; bj < 2; ++bj) { const size_t off = (size_t)r * 1024 + col0 + bj * HALF;
                    const u32x4 gv = *(const u32x4*)(g + off);
                    f32x4 a0 = acc[ai][bj][m][0], a1 = acc[ai][bj][m][1];
                    a0[0] *= bf_lo(gv.x); a0[1] *= bf_hi(gv.x); a0[2] *= bf_lo(gv.y); a0[3] *= bf_hi(gv.y);
                    a1[0] *= bf_lo(gv.z); a1[1] *= bf_hi(gv.z); a1[2] *= bf_lo(gv.w); a1[3] *= bf_hi(gv.w);
                    if (!which) { *(f32x4*)(P + off) = a0; *(f32x4*)(P + off + 4) = a1; }
                    else { const f32x4 p0 = *(const f32x4*)(P + off), p1 = *(const f32x4*)(P + off + 4); a0 += p0; a1 += p1;
                        u32x4 w; w.x = cvt_pk_bf16(a0[0], a0[1]); w.y = cvt_pk_bf16(a0[2], a0[3]); w.z = cvt_pk_bf16(a1[0], a1[1]); w.w = cvt_pk_bf16(a1[2], a1[3]);
                        *(u32x4*)(merged + off) = w; } } }
    }
};
struct PairOrder {
    StaticOrder so;
    __host__ __device__ void init(int G_, int c_) { so.init(MTOK, 1024, G_, c_); }
    __host__ __device__ bool next(int i, Unit& u) const { Unit t; if (!so.next(i >> 1, t)) return false; const int w = i & 1; u.pm = t.pm + 64 * w; u.pn = t.pn + 4 * w; return true; }
    __device__ __forceinline__ void a_ready(const Unit&) const {}
    __device__ __forceinline__ void done(const Unit&) const {}
};

struct EpiWo {
    static constexpr bool PERM = true, AFTER_DRAIN = false;
    const float* x; float* x1; bf16_t* x1b;
    __device__ __forceinline__ void operator()(const f32x4 (&acc)[2][2][4][2], const Unit& u, int wr, int wc, int fr, int fq) const {
        const int row0 = u.pm * BM + wr * 64 + fr, col0 = u.pn * BM + wc * 32 + 8 * fq;
#pragma unroll
        for (int ai = 0; ai < 2; ++ai)
#pragma unroll
            for (int m = 0; m < 4; ++m) { const int r = row0 + ai * HALF + m * 16;
#pragma unroll
                for (int bj = 0; bj < 2; ++bj) { const size_t off = (size_t)r * 1024 + col0 + bj * HALF;
                    const f32x4 a0 = acc[ai][bj][m][0] + *(const f32x4*)(x + off), a1 = acc[ai][bj][m][1] + *(const f32x4*)(x + off + 4);
                    *(f32x4*)(x1 + off) = a0; *(f32x4*)(x1 + off + 4) = a1;
                    u32x4 w; w.x = cvt_pk_bf16(a0[0], a0[1]); w.y = cvt_pk_bf16(a0[2], a0[3]); w.z = cvt_pk_bf16(a1[0], a1[1]); w.w = cvt_pk_bf16(a1[2], a1[3]);
                    *(u32x4*)(x1b + off) = w; } }
    }
};
struct EpiScores {
    static constexpr bool PERM = true, AFTER_DRAIN = false;
    float* S;
    __device__ __forceinline__ void operator()(const f32x4 (&acc)[2][2][4][2], const Unit& u, int wr, int wc, int fr, int fq) const {
        const int row0 = u.pm * BM + wr * 64 + fr, col0 = u.pn * BM + wc * 32 + 8 * fq;
#pragma unroll
        for (int ai = 0; ai < 2; ++ai)
#pragma unroll
            for (int m = 0; m < 4; ++m) { const int r = row0 + ai * HALF + m * 16;
#pragma unroll
                for (int bj = 0; bj < 2; ++bj) { const size_t off = (size_t)r * 2048 + col0 + bj * HALF;
                    *(f32x4*)(S + off) = acc[ai][bj][m][0]; *(f32x4*)(S + off + 4) = acc[ai][bj][m][1]; } }
    }
};
template <class Epi, class Sched, bool ALIGN_EPI = false, bool SP2 = false>
__device__ __forceinline__ void gemm_phase(PG8_LAS unsigned char* lds, const Gemm g, const Sched& S, const Epi& E) {
    const int tid = threadIdx.x, wid = __builtin_amdgcn_readfirstlane(tid >> 6), lane = tid & 63, wr = wid >> 2, wc = wid & 3, fr = lane & 15, fq = lane >> 4;
    const int K = g.K, nt = K / BK;
    unsigned voffA[2], voffB[2];
#pragma unroll
    for (int i = 0; i < 2; ++i) { int R, C; stage_rc(tid * 16 + i * 8192, R, C); const int Rb = Epi::PERM ? ((R & ~31) + perm32(R & 31)) : R;
        voffA[i] = (unsigned)(R * K + C) * 2u; voffB[i] = (unsigned)(Rb * K + C) * 2u; }
    const size_t kstep = (size_t)(BK * 2);
    const size_t hstep = (size_t)HALF * K * 2;
    const size_t tstep = 2 * hstep;
    const unsigned ldsw = (unsigned)wid * 1024u;
    const int aoff = lds_byte(wr * 64 + fr, fq * 8), boff = lds_byte(wc * 32 + fr, fq * 8);
#define PG8_SA(b, h) (((b) * 2 + (h)) * HTB)
#define PG8_SB(b, h) ((4 + (b) * 2 + (h)) * HTB)
#define PG8_STAGE(bufoff, gbase, voff) do { _Pragma("unroll") for (int _i = 0; _i < 2; ++_i) \
        __builtin_amdgcn_global_load_lds((const unsigned*)((const char*)(gbase) + (voff)[_i]), (PG8_LAS unsigned*)(lds + (bufoff) + ldsw + _i * 8192), 16, 0, 0); } while (0)
#define PG8_LDA(dst, b, h) do { _Pragma("unroll") for (int m = 0; m < 4; ++m) _Pragma("unroll") for (int k = 0; k < 2; ++k) dst[m][k] = *(const PG8_LAS bf16x8*)(lds + PG8_SA(b, h) + aoff + m * 2048 + k * 1024); } while (0)
#define PG8_LDB(dst, b, h) do { _Pragma("unroll") for (int n = 0; n < 2; ++n) _Pragma("unroll") for (int k = 0; k < 2; ++k) dst[n][k] = *(const PG8_LAS bf16x8*)(lds + PG8_SB(b, h) + boff + n * 2048 + k * 1024); } while (0)
#define PG8_MMA(ai, bj, At, Bt) do { __builtin_amdgcn_s_setprio(1); _Pragma("unroll") for (int m = 0; m < 4; ++m) _Pragma("unroll") for (int n = 0; n < 2; ++n) _Pragma("unroll") for (int k = 0; k < 2; ++k) \
        acc[ai][bj][m][n] = __builtin_amdgcn_mfma_f32_16x16x32_bf16(Bt[n][k], At[m][k], acc[ai][bj][m][n], 0, 0, 0); __builtin_amdgcn_s_setprio(0); } while (0)
#define PG8_WAIT_V(n) asm volatile("s_waitcnt vmcnt(" #n ")" ::: "memory")
#define PG8_WAIT_L(n) asm volatile("s_waitcnt lgkmcnt(" #n ")" ::: "memory")
#define PG8_BAR __builtin_amdgcn_s_barrier()
#define PG8_SCHED __builtin_amdgcn_sched_barrier(0)
    Unit cur, nxt; int ui = 0;
    if (!S.next(0, cur)) return;
    f32x4 acc[2][2][4][2];
#pragma unroll
    for (int a = 0; a < 2; ++a)
#pragma unroll
        for (int b = 0; b < 2; ++b)
#pragma unroll
            for (int m = 0; m < 4; ++m)
#pragma unroll
                for (int n = 0; n < 2; ++n) acc[a][b][m][n] = (f32x4){0.f, 0.f, 0.f, 0.f};
    bf16x8 At[4][2], B0[2][2], B1[2][2];
    const char* cA = (const char*)g.A + (size_t)cur.pm * tstep; const char* cB = (const char*)g.Bt + (size_t)cur.pn * tstep;
    S.a_ready(cur);
    if constexpr (SP2) {
        PG8_STAGE(PG8_SB(0, 0), cB, voffB); PG8_STAGE(PG8_SB(0, 1), cB + hstep, voffB); PG8_STAGE(PG8_SA(0, 0), cA, voffA); PG8_STAGE(PG8_SA(0, 1), cA + hstep, voffA);
        if (wr == 1) PG8_BAR;
        PG8_WAIT_V(2); PG8_BAR;
        PG8_STAGE(PG8_SB(1, 0), cB + kstep, voffB); PG8_STAGE(PG8_SA(1, 0), cA + kstep, voffA); PG8_STAGE(PG8_SB(1, 1), cB + hstep + kstep, voffB);
        PG8_WAIT_V(6); PG8_BAR;
    } else {
        PG8_STAGE(PG8_SB(0, 0), cB, voffB); PG8_STAGE(PG8_SA(0, 0), cA, voffA); PG8_STAGE(PG8_SB(0, 1), cB + hstep, voffB); PG8_STAGE(PG8_SA(0, 1), cA + hstep, voffA);
        if (wr == 1) PG8_BAR;
        PG8_WAIT_V(4); PG8_BAR;
        PG8_STAGE(PG8_SB(1, 0), cB + kstep, voffB); PG8_STAGE(PG8_SA(1, 0), cA + kstep, voffA); PG8_STAGE(PG8_SB(1, 1), cB + hstep + kstep, voffB);
        PG8_WAIT_V(6); PG8_BAR;
    }
    for (;;) {
        const bool has_next = S.next(ui + 1, nxt);
        const char* nA = has_next ? (const char*)g.A + (size_t)nxt.pm * tstep : cA; const char* nB = has_next ? (const char*)g.Bt + (size_t)nxt.pn * tstep : cB;
        for (int t = 0; t < nt; t += 2) {
            const bool last = (t == nt - 2);
            const char* a1 = cA + (size_t)(t + 1) * kstep;
            const char* a2 = last ? nA : cA + (size_t)(t + 2) * kstep; const char* b2 = last ? nB : cB + (size_t)(t + 2) * kstep;
            const char* a3 = a2 + kstep; const char* b3 = b2 + kstep;
            if (last && has_next) S.a_ready(nxt);
            if constexpr (SP2) {
            PG8_LDB(B0, 0, 0); PG8_LDB(B1, 0, 1); PG8_SCHED; PG8_LDA(At, 0, 0); PG8_STAGE(PG8_SA(1, 1), a1 + hstep, voffA);
            PG8_WAIT_V(8); PG8_WAIT_L(0); PG8_BAR; PG8_MMA(0, 0, At, B0); PG8_MMA(0, 1, At, B1); PG8_BAR; PG8_SCHED;
            PG8_LDA(At, 0, 1); PG8_STAGE(PG8_SB(0, 0), b2, voffB); PG8_STAGE(PG8_SB(0, 1), b2 + hstep, voffB); PG8_STAGE(PG8_SA(0, 0), a2, voffA);
            PG8_WAIT_V(8); PG8_WAIT_L(0); PG8_BAR; PG8_MMA(1, 0, At, B0); PG8_MMA(1, 1, At, B1); PG8_BAR; PG8_SCHED;
            PG8_LDB(B0, 1, 0); PG8_LDB(B1, 1, 1); PG8_SCHED; PG8_LDA(At, 1, 0); PG8_STAGE(PG8_SA(0, 1), a2 + hstep, voffA);
            PG8_WAIT_V(8); PG8_WAIT_L(0); PG8_BAR; PG8_MMA(0, 0, At, B0); PG8_MMA(0, 1, At, B1); PG8_BAR; PG8_SCHED;
            PG8_LDA(At, 1, 1); PG8_STAGE(PG8_SB(1, 0), b3, voffB); PG8_STAGE(PG8_SB(1, 1), b3 + hstep, voffB); PG8_STAGE(PG8_SA(1, 0), a3, voffA);
            PG8_WAIT_V(8); PG8_WAIT_L(0); PG8_BAR; PG8_MMA(1, 0, At, B0); PG8_MMA(1, 1, At, B1); PG8_BAR; PG8_SCHED;
            } else {
            PG8_LDB(B0, 0, 0); PG8_SCHED; PG8_LDA(At, 0, 0); PG8_STAGE(PG8_SA(1, 1), a1 + hstep, voffA);
            PG8_WAIT_L(8); PG8_BAR; PG8_WAIT_L(0); PG8_MMA(0, 0, At, B0); PG8_BAR; PG8_SCHED;
            PG8_LDB(B1, 0, 1); PG8_STAGE(PG8_SB(0, 0), b2, voffB);
            PG8_BAR; PG8_WAIT_L(0); PG8_MMA(0, 1, At, B1); PG8_BAR;
            PG8_LDA(At, 0, 1); PG8_STAGE(PG8_SA(0, 0), a2, voffA);
            PG8_BAR; PG8_WAIT_L(0); PG8_MMA(1, 0, At, B0); PG8_BAR; PG8_SCHED;
            PG8_STAGE(PG8_SB(0, 1), b2 + hstep, voffB);
            PG8_WAIT_V(6); PG8_BAR; PG8_MMA(1, 1, At, B1); PG8_BAR;
            PG8_LDB(B0, 1, 0); PG8_SCHED; PG8_LDA(At, 1, 0); PG8_STAGE(PG8_SA(0, 1), a2 + hstep, voffA);
            PG8_WAIT_L(8); PG8_BAR; PG8_WAIT_L(0); PG8_MMA(0, 0, At, B0); PG8_BAR; PG8_SCHED;
            PG8_LDB(B1, 1, 1); PG8_STAGE(PG8_SB(1, 0), b3, voffB);
            PG8_BAR; PG8_WAIT_L(0); PG8_MMA(0, 1, At, B1); PG8_BAR;
            PG8_LDA(At, 1, 1); PG8_STAGE(PG8_SA(1, 0), a3, voffA);
            PG8_BAR; PG8_WAIT_L(0); PG8_MMA(1, 0, At, B0); PG8_BAR; PG8_SCHED;
            PG8_STAGE(PG8_SB(1, 1), b3 + hstep, voffB);
            PG8_WAIT_V(6); PG8_BAR; PG8_MMA(1, 1, At, B1); PG8_BAR;
            }
        }
        if constexpr (ALIGN_EPI) { if (wr == 0) PG8_BAR; }
        if constexpr (!Epi::AFTER_DRAIN) { E(acc, cur, wr, wc, fr, fq); S.done(cur); }
        if (!has_next) break;
#pragma unroll
        for (int a = 0; a < 2; ++a)
#pragma unroll
            for (int b = 0; b < 2; ++b)
#pragma unroll
                for (int m = 0; m < 4; ++m)
#pragma unroll
                    for (int n = 0; n < 2; ++n) acc[a][b][m][n] = (f32x4){0.f, 0.f, 0.f, 0.f};
        cur = nxt; cA = nA; cB = nB; ++ui;
        if constexpr (ALIGN_EPI) { if (wr == 1) PG8_BAR; }
    }
    PG8_WAIT_V(0);
    if constexpr (!ALIGN_EPI) { if (wr == 0) PG8_BAR; }
    PG8_BAR;
    if constexpr (Epi::AFTER_DRAIN) { E.fused(acc, cur, wr, wc, fr, fq, lds, wid, lane); S.done(cur); }
#undef PG8_SA
#undef PG8_SB
#undef PG8_STAGE
#undef PG8_LDA
#undef PG8_LDB
#undef PG8_MMA
#undef PG8_WAIT_V
#undef PG8_WAIT_L
#undef PG8_BAR
#undef PG8_SCHED
}
}

constexpr int NWAVES = 8;
constexpr int BATCH = 4, T = 4096, D = 1024, NH = 8, HD = 64, NIN = 5120;
constexpr int M = BATCH * T;
constexpr int NEXP = 16384;
constexpr float RMS_EPS = 1e-6f;
#ifndef MK_N_LAUNCHES
#define MK_N_LAUNCHES 7
#endif
constexpr int N_PHASES = 7;
constexpr int N_LAUNCHES = MK_N_LAUNCHES;

constexpr size_t MiB = 1u << 20;
constexpr size_t WS_CTL = 0, CTL_ZERO_BYTES = 64 * 1024;
constexpr size_t WS_RSTD1 = 512 * 1024;
constexpr size_t WS_WEFF = 1 * MiB;
constexpr size_t WS_WAB = 5 * MiB;
constexpr size_t WS_WO = 7 * MiB;
constexpr size_t WS_WIN = 9 * MiB;
constexpr size_t WS_XB = 19 * MiB;
constexpr size_t WS_SIX = 51 * MiB;
constexpr size_t WS_VT = WS_SIX + 3 * 16 * MiB;
constexpr size_t WS_GATE = 147 * MiB;
constexpr size_t WS_MERGED = 211 * MiB;
constexpr size_t WS_X1B = 32 * MiB;
constexpr size_t WS_TU = 64 * MiB, WS_TV = 96 * MiB;
constexpr size_t WS_SCORES = 128 * MiB;
constexpr size_t WS_END = 256 * MiB;
constexpr int CW_BAR = 4096;

constexpr int RING_OFF = 0, RING_BYTES = 131072;
constexpr int LDSCTL_OFF = RING_BYTES, MISC_OFF = LDSCTL_OFF + 320;
constexpr int LDS_BYTES = 147456;

#define GAS __attribute__((address_space(1)))
#define LAS __attribute__((address_space(3)))
typedef unsigned short bf16;
typedef unsigned v4u __attribute__((ext_vector_type(4)));
typedef unsigned v2u __attribute__((ext_vector_type(2)));
typedef float f32x4 __attribute__((ext_vector_type(4)));
typedef float f32x2 __attribute__((ext_vector_type(2)));
typedef float f32x16 __attribute__((ext_vector_type(16)));
typedef short bf16x8 __attribute__((ext_vector_type(8)));
typedef _Float16 f16x8 __attribute__((ext_vector_type(8)));
typedef _Float16 f16x2 __attribute__((ext_vector_type(2)));
typedef __bf16 bf16x2_t __attribute__((ext_vector_type(2)));
typedef GAS unsigned gu32;
#define RLX_AGENT __ATOMIC_RELAXED, __HIP_MEMORY_SCOPE_AGENT
#define LDS_WAIT() asm volatile("s_waitcnt lgkmcnt(0)" ::: "memory")
#define VM_WAIT() asm volatile("s_waitcnt vmcnt(0)" ::: "memory")
__device__ __forceinline__ unsigned f2bf(float f) { unsigned u = __builtin_bit_cast(unsigned, f); return (u + 0x7fffu + ((u >> 16) & 1u)) >> 16; }
__device__ __forceinline__ unsigned pk2(float lo, float hi) { return f2bf(lo) | (f2bf(hi) << 16); }
__device__ __forceinline__ unsigned cvtpk(float lo, float hi) { f32x2 v = {lo, hi}; bf16x2_t b = __builtin_convertvector(v, bf16x2_t); return __builtin_bit_cast(unsigned, b); }
__device__ __forceinline__ float bflo(unsigned w) { return __builtin_bit_cast(float, w << 16); }
__device__ __forceinline__ float bfhi(unsigned w) { return __builtin_bit_cast(float, w & 0xffff0000u); }
__device__ __forceinline__ float wave_sum(float v) {
#pragma unroll
    for (int o = 1; o < 64; o <<= 1) v += __shfl_xor(v, o);
    return v;
}
#define XB_TMO      128
#define XB_XCNT(j)  (256  + 64 * (j))
#define XB_XSUB(j)  (1280 + 64 * (j))
#define XB_XGEN(j)  (2304 + 64 * (j))
#define XB_TOP      3328
#define XB_TOPGEN   3392
#define XCD_BAR_WORDS 3456
#define XB_SPIN_CAP (1u << 18)

__device__ __forceinline__ unsigned xb_ld(unsigned* p)              { return __hip_atomic_load(p, __ATOMIC_RELAXED, __HIP_MEMORY_SCOPE_AGENT); }
__device__ __forceinline__ unsigned xb_add(unsigned* p, unsigned v) { return __hip_atomic_fetch_add(p, v, __ATOMIC_RELAXED, __HIP_MEMORY_SCOPE_AGENT); }
__device__ __forceinline__ unsigned xb_xcc_id() { return (unsigned)__builtin_amdgcn_s_getreg((3 << 11) | 20) & 0xFu; }
#define XB_SPIN(cond, bar) do { unsigned _sp = 0; while (cond) { __builtin_amdgcn_s_sleep(1); \
    if ((++_sp & 255u) == 0u) { if (xb_ld(&(bar)[XB_TMO])) break; if (_sp > XB_SPIN_CAP) { atomicAdd(&(bar)[XB_TMO], 1u); break; } } } } while (0)

struct XcdBarrier {
    unsigned* bar; unsigned x;
    volatile LAS unsigned* st;
};

__device__ __forceinline__ XcdBarrier xcd_barrier_post(unsigned* bar, volatile LAS unsigned* st) {
    XcdBarrier b; b.bar = bar; b.x = xb_xcc_id(); b.st = st;
    if (threadIdx.x == 0) (void)xb_add(&bar[XB_XCNT(b.x)], 1u);
    return b;
}
__device__ __forceinline__ void xcd_barrier_complete(unsigned* bar, unsigned x, unsigned& nloc, unsigned& nx) {
    const unsigned G = gridDim.x * gridDim.y * gridDim.z;
    unsigned sum, cnt, mine, sp = 0u;
    for (;;) {
        sum = 0u; cnt = 0u; mine = 0u;
#pragma unroll
        for (unsigned j = 0; j < 16; ++j) { const unsigned c = xb_ld(&bar[XB_XCNT(j)]); sum += c; cnt += (c > 0u) ? 1u : 0u; mine = (j == x) ? c : mine; }
        if (sum == G) break;
        __builtin_amdgcn_s_sleep(1);
        if ((++sp & 255u) == 0u) { if (xb_ld(&bar[XB_TMO])) break; if (sp > XB_SPIN_CAP) { atomicAdd(&bar[XB_TMO], 1u); break; } }
    }
    nloc = mine > 0u ? mine : 1u; nx = cnt > 0u ? cnt : 1u;
}

__device__ __forceinline__ void xcd_barrier(const XcdBarrier& b) {
    asm volatile("s_waitcnt vmcnt(0)" ::: "memory");
    __syncthreads();
    if (threadIdx.x == 0) {
        unsigned* bar = b.bar;
        __builtin_amdgcn_s_waitcnt(0);
        unsigned nloc = b.st[0], nx = b.st[1];
        if (nloc == 0u) { xcd_barrier_complete(bar, b.x, nloc, nx); b.st[0] = nloc; b.st[1] = nx; }
        const unsigned old = xb_add(&bar[XB_XSUB(b.x)], 1u);
        const unsigned gen = old / nloc;
        if (old + 1u == (gen + 1u) * nloc) {
            __builtin_amdgcn_fence(__ATOMIC_RELEASE, "agent");
            asm volatile("s_waitcnt vmcnt(0)" ::: "memory");
            const unsigned og = xb_add(&bar[XB_TOP], 1u);
            const unsigned tg = og / nx;
            if (og + 1u == (tg + 1u) * nx) xb_add(&bar[XB_TOPGEN], 1u);
            else XB_SPIN(xb_ld(&bar[XB_TOPGEN]) == tg, bar);
            __builtin_amdgcn_fence(__ATOMIC_ACQUIRE, "agent");
            xb_add(&bar[XB_XGEN(b.x)], 1u);
            asm volatile("s_waitcnt vmcnt(0)" ::: "memory");
        } else {
            XB_SPIN(xb_ld(&bar[XB_XGEN(b.x)]) == gen, bar);
            __builtin_amdgcn_fence(__ATOMIC_ACQUIRE, "agent");
            asm volatile("s_waitcnt vmcnt(0)" ::: "memory");
        }
    }
    __syncthreads();
}

__device__ __forceinline__ void p0_transpose_item(const float* W, int K, int N, bf16* WT, int row_off, const float* kscale, LAS float* scr, int item, int lane) {
    const int nblk = N / 32, kb = item / nblk, nb = item % nblk, k0 = 64 * kb, n0 = 32 * nb;
#pragma unroll 8
    for (int i = 0; i < 32; ++i) { const int kk = 2 * i + (lane >> 5); scr[kk * 33 + (lane & 31)] = W[(size_t)(k0 + kk) * N + n0 + (lane & 31)]; }
    LDS_WAIT(); asm volatile("" ::: "memory");
    const int c = lane & 7;
    float ks[8];
#pragma unroll
    for (int i = 0; i < 8; ++i) ks[i] = kscale ? kscale[k0 + 8 * c + i] : 1.0f;
#pragma unroll
    for (int j = 0; j < 4; ++j) { const int n = (lane >> 3) + 8 * j; const LAS float* s = scr + (8 * c) * 33 + n;
        v4u o; o.x = pk2(s[0 * 33] * ks[0], s[1 * 33] * ks[1]); o.y = pk2(s[2 * 33] * ks[2], s[3 * 33] * ks[3]); o.z = pk2(s[4 * 33] * ks[4], s[5 * 33] * ks[5]); o.w = pk2(s[6 * 33] * ks[6], s[7 * 33] * ks[7]);
        *(GAS v4u*)(WT + (size_t)(row_off + n0 + n) * K + k0 + 8 * c) = o; }
    LDS_WAIT(); asm volatile("" ::: "memory");
}

__device__ __forceinline__ void conv_phase(bf16* CB, const bf16* CC, const bf16* CU, const float* cw, const float* cbias, int gtid, int nthreads) {
    for (int task = gtid; task < M * 64; task += nthreads) {
        const int tok = task >> 6, c8 = (task & 63) * 8, tt = tok & (T - 1);
        const size_t off = (size_t)tok * 512 + c8;
        float z[3][8];
#pragma unroll
        for (int k = 0; k < 3; ++k) {
            const int dt = 2 - k;
            if (tt >= dt) { const v4u a = *(const GAS v4u*)(CC + off - (size_t)dt * 512), b = *(const GAS v4u*)(CU + off - (size_t)dt * 512);
                z[k][0] = bflo(a.x) * bflo(b.x); z[k][1] = bfhi(a.x) * bfhi(b.x); z[k][2] = bflo(a.y) * bflo(b.y); z[k][3] = bfhi(a.y) * bfhi(b.y);
                z[k][4] = bflo(a.z) * bflo(b.z); z[k][5] = bfhi(a.z) * bfhi(b.z); z[k][6] = bflo(a.w) * bflo(b.w); z[k][7] = bfhi(a.w) * bfhi(b.w); }
            else {
#pragma unroll
                for (int i = 0; i < 8; ++i) z[k][i] = 0.f; }
        }
        float y[8];
#pragma unroll
        for (int i = 0; i < 8; ++i) y[i] = cbias[c8 + i];
#pragma unroll
        for (int k = 0; k < 3; ++k)
#pragma unroll
            for (int i = 0; i < 8; ++i) y[i] += cw[k * 512 + c8 + i] * z[k][i];
        const v4u g = *(const GAS v4u*)(CB + off);
        v4u o; o.x = pk2(bflo(g.x) * y[0], bfhi(g.x) * y[1]); o.y = pk2(bflo(g.y) * y[2], bfhi(g.y) * y[3]); o.z = pk2(bflo(g.z) * y[4], bfhi(g.z) * y[5]); o.w = pk2(bflo(g.w) * y[6], bfhi(g.w) * y[7]);
        *(GAS v4u*)(CB + off) = o;
    }
}

__device__ __forceinline__ int crow(int r, int hf) { return (r & 3) + 8 * (r >> 2) + 4 * hf; }
#define MFMA_BF16(a, b, c) __builtin_amdgcn_mfma_f32_32x32x16_bf16((a), (b), (c), 0, 0, 0)
#define MFMA_F16(a, b, c) __builtin_amdgcn_mfma_f32_32x32x16_f16((a), (b), (c), 0, 0, 0)
__device__ __forceinline__ void attn_item(const bf16* Qb, const bf16* Kb, const bf16* VT, bf16* Ob, int b, int h, int qblk, int lane) {
    const int t32 = lane & 31, hf = lane >> 5, q0 = qblk * 32, tq = q0 + t32;
    const size_t rowbase = (size_t)b * T;
    const float LOG2E = 1.4426950408889634f, LN2 = 0.6931471805599453f;
    bf16x8 qf[4];
    { const bf16* qp = Qb + (rowbase + q0 + t32) * 512 + h * 64 + 8 * hf;
#pragma unroll
      for (int st = 0; st < 4; ++st) qf[st] = *(const GAS bf16x8*)(qp + 16 * st); }
    f16x8 tri[2];
#pragma unroll
    for (int st = 0; st < 2; ++st)
#pragma unroll
        for (int e = 0; e < 8; ++e) { const int j = 16 * st + 8 * (e >> 2) + 4 * hf + (e & 3); tri[st][e] = (j >= t32) ? (_Float16)1.0f : (_Float16)0.0f; }
    f32x16 o0, o1;
#pragma unroll
    for (int r = 0; r < 16; ++r) { o0[r] = 0.f; o1[r] = 0.f; }
    float R = 0.f;
    const bf16* kbase = Kb + rowbase * 512 + h * 64 + 8 * hf;
    const bf16* vtb = VT + ((size_t)(b * 8 + h) * 64 + t32) * T + 4 * hf;
    for (int jt = q0 >> 6; jt >= 0; --jt) {
        const int k0 = jt * 64;
        f32x16 s0, s1;
#pragma unroll
        for (int r = 0; r < 16; ++r) { s0[r] = 0.f; s1[r] = 0.f; }
#pragma unroll
        for (int st = 0; st < 4; ++st) {
            const bf16x8 a0 = *(const GAS bf16x8*)(kbase + (size_t)(k0 + t32) * 512 + 16 * st);
            const bf16x8 a1 = *(const GAS bf16x8*)(kbase + (size_t)(k0 + 32 + t32) * 512 + 16 * st);
            s0 = MFMA_BF16(a0, qf[st], s0); s1 = MFMA_BF16(a1, qf[st], s1);
        }
        f32x16 L0, L1; float tot0 = 0.f, tot1 = 0.f;
#pragma unroll
        for (int r = 0; r < 16; ++r) {
            const int key = k0 + crow(r, hf);
            { const float z = s0[r]; const float e = __builtin_amdgcn_exp2f(-__builtin_fabsf(z) * LOG2E); const float lp = __builtin_amdgcn_logf(1.0f + e) * LN2;
              const float L = (key < tq) ? -(__builtin_fmaxf(z, 0.f) + lp) : 0.f; L0[r] = L; tot0 += L; }
            { const float z = s1[r]; const float e = __builtin_amdgcn_exp2f(-__builtin_fabsf(z) * LOG2E); const float lp = __builtin_amdgcn_logf(1.0f + e) * LN2;
              const float L = (key + 32 < tq) ? -(__builtin_fmaxf(z, 0.f) + lp) : 0.f; L1[r] = L; tot1 += L; }
        }
        tot0 += __shfl_xor(tot0, 32); tot1 += __shfl_xor(tot1, 32);
        f16x8 lf00, lf01, lf10, lf11;
#pragma unroll
        for (int e = 0; e < 8; ++e) { lf00[e] = (_Float16)L0[e]; lf01[e] = (_Float16)L0[8 + e]; lf10[e] = (_Float16)L1[e]; lf11[e] = (_Float16)L1[8 + e]; }
        f32x16 y0, y1;
#pragma unroll
        for (int r = 0; r < 16; ++r) { y0[r] = 0.f; y1[r] = 0.f; }
        y0 = MFMA_F16(tri[0], lf00, y0); y0 = MFMA_F16(tri[1], lf01, y0);
        y1 = MFMA_F16(tri[0], lf10, y1); y1 = MFMA_F16(tri[1], lf11, y1);
        const float base0 = R + tot1, base1 = R;
        float a0v[16], a1v[16];
#pragma unroll
        for (int r = 0; r < 16; ++r) {
            const int key = k0 + crow(r, hf);
            a0v[r] = (key < tq) ? __builtin_amdgcn_exp2f((s0[r] + y0[r] + base0) * LOG2E) : 0.f;
            a1v[r] = (key + 32 < tq) ? __builtin_amdgcn_exp2f((s1[r] + y1[r] + base1) * LOG2E) : 0.f;
        }
        bf16x8 pf[2][2];
#pragma unroll
        for (int st = 0; st < 2; ++st) {
            v4u w0, w1;
            w0.x = cvtpk(a0v[8 * st + 0], a0v[8 * st + 1]); w0.y = cvtpk(a0v[8 * st + 2], a0v[8 * st + 3]); w0.z = cvtpk(a0v[8 * st + 4], a0v[8 * st + 5]); w0.w = cvtpk(a0v[8 * st + 6], a0v[8 * st + 7]);
            w1.x = cvtpk(a1v[8 * st + 0], a1v[8 * st + 1]); w1.y = cvtpk(a1v[8 * st + 2], a1v[8 * st + 3]); w1.z = cvtpk(a1v[8 * st + 4], a1v[8 * st + 5]); w1.w = cvtpk(a1v[8 * st + 6], a1v[8 * st + 7]);
            pf[0][st] = __builtin_bit_cast(bf16x8, w0); pf[1][st] = __builtin_bit_cast(bf16x8, w1);
        }
#pragma unroll
        for (int kb = 0; kb < 2; ++kb)
#pragma unroll
            for (int st = 0; st < 2; ++st) {
                const int kk = k0 + 32 * kb + 16 * st;
                { const v2u lo = *(const GAS v2u*)(vtb + kk), hi = *(const GAS v2u*)(vtb + kk + 8); v4u w; w.x = lo.x; w.y = lo.y; w.z = hi.x; w.w = hi.y;
                  o0 = MFMA_BF16(__builtin_bit_cast(bf16x8, w), pf[kb][st], o0); }
                { const v2u lo = *(const GAS v2u*)(vtb + (size_t)32 * T + kk), hi = *(const GAS v2u*)(vtb + (size_t)32 * T + kk + 8); v4u w; w.x = lo.x; w.y = lo.y; w.z = hi.x; w.w = hi.y;
                  o1 = MFMA_BF16(__builtin_bit_cast(bf16x8, w), pf[kb][st], o1); }
            }
        R += tot0 + tot1;
        if (__all(R < -104.0f)) break;
    }
    bf16* op = Ob + (rowbase + q0 + t32) * 512 + h * 64 + 4 * hf;
#pragma unroll
    for (int q4 = 0; q4 < 4; ++q4) {
        v2u w; w.x = cvtpk(o0[4 * q4], o0[4 * q4 + 1]); w.y = cvtpk(o0[4 * q4 + 2], o0[4 * q4 + 3]); *(GAS v2u*)(op + 8 * q4) = w;
        v2u w2; w2.x = cvtpk(o1[4 * q4], o1[4 * q4 + 1]); w2.y = cvtpk(o1[4 * q4 + 2], o1[4 * q4 + 3]); *(GAS v2u*)(op + 32 + 8 * q4) = w2;
    }
}

template <int NV> __device__ __forceinline__ void select16(const float (&v)[NV], bool (&sel)[NV], int (&pos)[NV]) {
    float mx = v[0], mn = v[0];
#pragma unroll
    for (int i = 1; i < NV; ++i) { mx = __builtin_fmaxf(mx, v[i]); mn = __builtin_fminf(mn, v[i]); }
#pragma unroll
    for (int o = 1; o < 64; o <<= 1) { mx = __builtin_fmaxf(mx, __shfl_xor(mx, o)); mn = __builtin_fminf(mn, __shfl_xor(mn, o)); }
    float lo = mn, hi = mx, Tv;
    { int c = 0;
#pragma unroll
      for (int i = 0; i < NV; ++i) c += __popcll(__ballot(v[i] >= mx));
      if (c >= 16) { Tv = mx; }
      else {
        Tv = lo;
        for (int it = 0; it < 300; ++it) {
            const float mid = 0.5f * lo + 0.5f * hi;
            if (!(mid > lo && mid < hi)) { Tv = lo; break; }
            int cc = 0;
#pragma unroll
            for (int i = 0; i < NV; ++i) cc += __popcll(__ballot(v[i] >= mid));
            if (cc == 16) { Tv = mid; break; }
            if (cc > 16) lo = mid; else hi = mid;
            Tv = lo;
        }
      }
    }
    int cgt = 0;
#pragma unroll
    for (int i = 0; i < NV; ++i) cgt += __popcll(__ballot(v[i] > Tv));
    const int need = 16 - cgt;
    int eqbelow = 0;
#pragma unroll
    for (int i = 0; i < NV; ++i) { const unsigned long long m = __ballot(v[i] == Tv); eqbelow += __builtin_amdgcn_mbcnt_hi((unsigned)(m >> 32), __builtin_amdgcn_mbcnt_lo((unsigned)m, 0u)); }
    int eqown = 0;
#pragma unroll
    for (int i = 0; i < NV; ++i) { const bool eq = (v[i] == Tv); sel[i] = (v[i] > Tv) || (eq && (eqbelow + eqown) < need); eqown += eq ? 1 : 0; }
    int selbelow = 0;
#pragma unroll
    for (int i = 0; i < NV; ++i) { const unsigned long long m = __ballot(sel[i]); selbelow += __builtin_amdgcn_mbcnt_hi((unsigned)(m >> 32), __builtin_amdgcn_mbcnt_lo((unsigned)m, 0u)); }
    int own = 0;
#pragma unroll
    for (int i = 0; i < NV; ++i) { pos[i] = selbelow + own; own += sel[i] ? 1 : 0; }
}

__device__ __forceinline__ float gelu_exact(float a) { return 0.5f * a * (1.0f + erff(a * 0.7071067811865476f)); }

__device__ __forceinline__ void peer_token(int tok, const float* scores, float* xio  , const bf16* TU, const bf16* TV, const float* fgain, LAS unsigned char* scr, int lane) {
    LAS float* tv = (LAS float*)scr; LAS int* ti = (LAS int*)(scr + 1024); LAS float* es = (LAS float*)(scr + 2048); LAS int* ee = (LAS int*)(scr + 2560); LAS float* ww = (LAS float*)(scr + 3072);
    float xr[16];
    { const GAS f32x4* xp = (const GAS f32x4*)(xio + (size_t)tok * D);
#pragma unroll
      for (int j = 0; j < 2; ++j) { const f32x4 a = xp[2 * lane + 128 * j], b = xp[2 * lane + 128 * j + 1];
        xr[8 * j + 0] = a.x; xr[8 * j + 1] = a.y; xr[8 * j + 2] = a.z; xr[8 * j + 3] = a.w; xr[8 * j + 4] = b.x; xr[8 * j + 5] = b.y; xr[8 * j + 6] = b.z; xr[8 * j + 7] = b.w; } }
    float ss = 0.f;
#pragma unroll
    for (int i = 0; i < 16; ++i) ss += xr[i] * xr[i];
    const float rstd2 = 1.0f / sqrtf(wave_sum(ss) * (1.0f / D) + RMS_EPS);
    const float* srow = scores + (size_t)tok * 2048;
#pragma unroll 1
    for (int g = 0; g < 16; ++g) {
        const f32x2 sv = *(const GAS f32x2*)(srow + g * 128 + 2 * lane);
        float v[2] = {sv.x, sv.y}; bool sel[2]; int pos[2];
        select16<2>(v, sel, pos);
#pragma unroll
        for (int i = 0; i < 2; ++i) if (sel[i] && pos[i] < 16) { tv[g * 16 + pos[i]] = v[i]; ti[g * 16 + pos[i]] = 2 * lane + i; }
    }
    LDS_WAIT();
#pragma unroll 1
    for (int h = 0; h < 8; ++h) {
        const int i = lane >> 2, jb = (lane & 3) * 4;
        const float a = tv[(2 * h) * 16 + i];
        float c[4]; bool sel[4]; int pos[4];
#pragma unroll
        for (int jj = 0; jj < 4; ++jj) c[jj] = a + tv[(2 * h + 1) * 16 + jb + jj];
        select16<4>(c, sel, pos);
        const int ia = ti[(2 * h) * 16 + i];
#pragma unroll
        for (int jj = 0; jj < 4; ++jj) if (sel[jj] && pos[jj] < 16) { es[h * 16 + pos[jj]] = c[jj]; ee[h * 16 + pos[jj]] = ia * 128 + ti[(2 * h + 1) * 16 + jb + jj]; }
    }
    LDS_WAIT();
#pragma unroll
    for (int half = 0; half < 2; ++half) {
        const int n = lane + 64 * half; const float s = es[n] * rstd2;
        float m = s;
#pragma unroll
        for (int o = 1; o < 16; o <<= 1) m = __builtin_fmaxf(m, __shfl_xor(m, o));
        const float p = __builtin_amdgcn_exp2f((s - m) * 1.4426950408889634f);
        float sum = p;
#pragma unroll
        for (int o = 1; o < 16; o <<= 1) sum += __shfl_xor(sum, o);
        ww[n] = p / sum;
    }
    LDS_WAIT();
    const int hf = lane >> 5, b4 = (lane >> 4) & 1, b3 = (lane >> 3) & 1;
#pragma unroll 1
    for (int nb = 0; nb < 16; ++nb) {
        float p[8];
#pragma unroll
        for (int k = 0; k < 8; ++k) {
            const int e = __builtin_amdgcn_readfirstlane(ee[nb * 8 + k]);
            const GAS v4u* up = (const GAS v4u*)(TU + (size_t)e * D) + lane;
            const v4u u0 = up[0], u1 = up[64];
            float s = 0.f;
            s += xr[0] * bflo(u0.x); s += xr[1] * bfhi(u0.x); s += xr[2] * bflo(u0.y); s += xr[3] * bfhi(u0.y); s += xr[4] * bflo(u0.z); s += xr[5] * bfhi(u0.z); s += xr[6] * bflo(u0.w); s += xr[7] * bfhi(u0.w);
            s += xr[8] * bflo(u1.x); s += xr[9] * bfhi(u1.x); s += xr[10] * bflo(u1.y); s += xr[11] * bfhi(u1.y); s += xr[12] * bflo(u1.z); s += xr[13] * bfhi(u1.z); s += xr[14] * bflo(u1.w); s += xr[15] * bfhi(u1.w);
            p[k] = s;
        }
        float r4[4], q2[2];
#pragma unroll
        for (int k = 0; k < 4; ++k) { const float send = hf ? p[k] : p[k + 4], keep = hf ? p[k + 4] : p[k]; r4[k] = keep + __shfl_xor(send, 32); }
#pragma unroll
        for (int k = 0; k < 2; ++k) { const float send = b4 ? r4[k] : r4[k + 2], keep = b4 ? r4[k + 2] : r4[k]; q2[k] = keep + __shfl_xor(send, 16); }
        float s1; { const float send = b3 ? q2[0] : q2[1], keep = b3 ? q2[1] : q2[0]; s1 = keep + __shfl_xor(send, 8); }
        s1 += __shfl_xor(s1, 4); s1 += __shfl_xor(s1, 2); s1 += __shfl_xor(s1, 1);
        const int n = nb * 8 + 4 * hf + 2 * b4 + b3;
        const float act = gelu_exact(s1 * rstd2);
        const float w = ww[n] * act;
        LDS_WAIT();
        if ((lane & 7) == 0) ww[n] = w;
    }
    LDS_WAIT();
    float acc[16];
#pragma unroll
    for (int i = 0; i < 16; ++i) acc[i] = 0.f;
#pragma unroll 4
    for (int n = 0; n < 128; ++n) {
        const int e = __builtin_amdgcn_readfirstlane(ee[n]);
        const float w = __builtin_bit_cast(float, __builtin_amdgcn_readfirstlane(__builtin_bit_cast(int, ww[n])));
        const GAS v4u* vp = (const GAS v4u*)(TV + (size_t)e * D) + lane;
        const v4u u0 = vp[0], u1 = vp[64];
        acc[0] += w * bflo(u0.x); acc[1] += w * bfhi(u0.x); acc[2] += w * bflo(u0.y); acc[3] += w * bfhi(u0.y); acc[4] += w * bflo(u0.z); acc[5] += w * bfhi(u0.z); acc[6] += w * bflo(u0.w); acc[7] += w * bfhi(u0.w);
        acc[8] += w * bflo(u1.x); acc[9] += w * bfhi(u1.x); acc[10] += w * bflo(u1.y); acc[11] += w * bfhi(u1.y); acc[12] += w * bflo(u1.z); acc[13] += w * bfhi(u1.z); acc[14] += w * bflo(u1.w); acc[15] += w * bfhi(u1.w);
    }
    float s2 = 0.f;
#pragma unroll
    for (int i = 0; i < 16; ++i) { acc[i] += xr[i]; s2 += acc[i] * acc[i]; }
    const float rstd3 = 1.0f / sqrtf(wave_sum(s2) * (1.0f / D) + RMS_EPS);
    { GAS f32x4* op = (GAS f32x4*)(xio + (size_t)tok * D); const GAS f32x4* gp = (const GAS f32x4*)fgain;
#pragma unroll
      for (int j = 0; j < 2; ++j) { const f32x4 g0 = gp[2 * lane + 128 * j], g1 = gp[2 * lane + 128 * j + 1];
        f32x4 a, b; a.x = acc[8 * j + 0] * rstd3 * g0.x; a.y = acc[8 * j + 1] * rstd3 * g0.y; a.z = acc[8 * j + 2] * rstd3 * g0.z; a.w = acc[8 * j + 3] * rstd3 * g0.w;
        b.x = acc[8 * j + 4] * rstd3 * g1.x; b.y = acc[8 * j + 5] * rstd3 * g1.y; b.z = acc[8 * j + 6] * rstd3 * g1.z; b.w = acc[8 * j + 7] * rstd3 * g1.w;
        op[2 * lane + 128 * j] = a; op[2 * lane + 128 * j + 1] = b; } }
    LDS_WAIT();
}

struct Args { const float* in[14]; float* out; unsigned char* ws; int ph_lo, ph_hi, li, pad; };
__global__ void __launch_bounds__(NWAVES * 64, 2) hybrid_fwd(Args args) {
    extern __shared__ __attribute__((aligned(16))) unsigned char lds[];
    LAS unsigned char* ldsb = (LAS unsigned char*)lds;
    volatile LAS unsigned* MISC = (volatile LAS unsigned*)(ldsb + MISC_OFF);
    const int tid = threadIdx.x, lane = tid & 63, wave = __builtin_amdgcn_readfirstlane(tid >> 6);
    const int G = gridDim.x; const int bx = blockIdx.x; const int vcu = (G % 8 == 0) ? (bx % 8) * (G / 8) + bx / 8 : bx;
    const int gw = vcu * NWAVES + wave, NGW = G * NWAVES;
    unsigned char* ws = args.ws;
    gu32* ctl = (gu32*)(ws + WS_CTL);
    const float* x = args.in[0]; const float* norm_mix = args.in[1]; const float* w_in = args.in[2]; const float* conv_w = args.in[3]; const float* conv_b = args.in[4];
    const float* w_a = args.in[5]; const float* w_b = args.in[6]; const float* w_o = args.in[7]; const float* norm_ffn = args.in[8]; const float* w_q = args.in[9];
    const float* sub_keys = args.in[10]; const float* exp_u = args.in[11]; const float* exp_v = args.in[12]; const float* final_norm = args.in[13];
    float* out = args.out;
    bf16* Weff = (bf16*)(ws + WS_WEFF); bf16* Wab = (bf16*)(ws + WS_WAB); bf16* Wo_t = (bf16*)(ws + WS_WO); bf16* Win_t = (bf16*)(ws + WS_WIN);
    bf16* XB = (bf16*)(ws + WS_XB); bf16* SIX = (bf16*)(ws + WS_SIX); bf16* VT = (bf16*)(ws + WS_VT); bf16* GATE = (bf16*)(ws + WS_GATE); bf16* MERGED = (bf16*)(ws + WS_MERGED);
    bf16* X1B = (bf16*)(ws + WS_X1B); bf16* TU = (bf16*)(ws + WS_TU); bf16* TV = (bf16*)(ws + WS_TV); float* SCORES = (float*)(ws + WS_SCORES); float* RSTD1 = (float*)(ws + WS_RSTD1);
    bf16* QB = SIX; bf16* CBB = SIX + (size_t)1 * M * 512; bf16* KB = SIX + (size_t)2 * M * 512; bf16* CCB = SIX + (size_t)4 * M * 512; bf16* CUB = SIX + (size_t)5 * M * 512;

    for (int u = tid; u < (LDS_BYTES - LDSCTL_OFF) / 4; u += NWAVES * 64) ((LAS unsigned*)(ldsb + LDSCTL_OFF))[u] = 0u;
    __syncthreads();
    XcdBarrier bar; bar.bar = (unsigned*)(ctl + CW_BAR); bar.x = 0; bar.st = nullptr;
    if (N_LAUNCHES == 1) bar = xcd_barrier_post((unsigned*)(ctl + CW_BAR), MISC + 8);
#define GRID_BAR() do { if (N_LAUNCHES == 1) xcd_barrier(bar); } while (0)
    const int lo = args.ph_lo, hi = args.ph_hi;
#define IN(k) (lo <= (k) && (k) < hi)
#define BOTH(k) (IN(k) && IN((k) + 1))

    if (IN(0)) {
        LAS float* scr = (LAS float*)(ldsb + RING_OFF + wave * 16384);
        constexpr int I_IN = (D / 64) * (NIN / 32), I_A = (512 / 64) * (D / 32), I_O = (D / 64) * (D / 32);
        constexpr int NITEMS = I_IN + 2 * I_A + I_O;
        for (int it = gw; it < NITEMS; it += NGW) {
            int r = it;
            if (r < I_IN) { p0_transpose_item(w_in, D, NIN, Win_t, 0, norm_mix, scr, r, lane); continue; } r -= I_IN;
            if (r < I_A) { p0_transpose_item(w_a, 512, D, Wab, 0, nullptr, scr, r, lane); continue; } r -= I_A;
            if (r < I_A) { p0_transpose_item(w_b, 512, D, Wab, 1024, nullptr, scr, r, lane); continue; } r -= I_A;
            p0_transpose_item(w_o, D, D, Wo_t, 0, nullptr, scr, r, lane);
        }
        for (int wt = gw; wt < 32 * 256; wt += NGW) {
            const int n0 = (wt & 31) * 64, k0 = (wt >> 5) * 4, n = n0 + lane, hp = n >> 7;
            const GAS f32x4* kr = (const GAS f32x4*)(sub_keys + (size_t)n * 128);
            float a0 = 0.f, a1 = 0.f, a2 = 0.f, a3 = 0.f;
#pragma unroll 4
            for (int c4 = 0; c4 < 32; ++c4) {
                const f32x4 kv = kr[c4];
                const f32x4 w0 = *(const GAS f32x4*)(w_q + (size_t)(k0 + 0) * 2048 + hp * 128 + 4 * c4), w1 = *(const GAS f32x4*)(w_q + (size_t)(k0 + 1) * 2048 + hp * 128 + 4 * c4);
                const f32x4 w2 = *(const GAS f32x4*)(w_q + (size_t)(k0 + 2) * 2048 + hp * 128 + 4 * c4), w3 = *(const GAS f32x4*)(w_q + (size_t)(k0 + 3) * 2048 + hp * 128 + 4 * c4);
                a0 += kv.x * w0.x + kv.y * w0.y + kv.z * w0.z + kv.w * w0.w; a1 += kv.x * w1.x + kv.y * w1.y + kv.z * w1.z + kv.w * w1.w;
                a2 += kv.x * w2.x + kv.y * w2.y + kv.z * w2.z + kv.w * w2.w; a3 += kv.x * w3.x + kv.y * w3.y + kv.z * w3.z + kv.w * w3.w;
            }
            v2u o; o.x = pk2(a0 * norm_ffn[k0], a1 * norm_ffn[k0 + 1]); o.y = pk2(a2 * norm_ffn[k0 + 2], a3 * norm_ffn[k0 + 3]);
            *(GAS v2u*)(Weff + (size_t)n * D + k0) = o;
        }
        for (int m = gw; m < M; m += NGW) {
            const GAS f32x4* xr = (const GAS f32x4*)(x + (size_t)m * D) + lane;
            f32x4 v[4]; float s = 0.f;
#pragma unroll
            for (int j = 0; j < 4; ++j) { v[j] = xr[64 * j]; s += (v[j].x * v[j].x + v[j].y * v[j].y) + (v[j].z * v[j].z + v[j].w * v[j].w); }
            const float rstd = 1.0f / sqrtf(wave_sum(s) * (1.0f / D) + RMS_EPS);
            GAS v2u* o8 = (GAS v2u*)(XB + (size_t)m * D) + lane;
#pragma unroll
            for (int j = 0; j < 4; ++j) { v2u o; o.x = pk2(v[j].x, v[j].y); o.y = pk2(v[j].z, v[j].w); o8[64 * j] = o; }
            if (lane == 0) RSTD1[m] = rstd;
        }
        if (BOTH(0)) GRID_BAR();
    }

    if (IN(1)) {
        pg8::Gemm g{XB, Win_t, M, NIN, D}; pg8::StaticOrder S; S.init(M, NIN, G, (int)blockIdx.x);
        pg8::EpiProj E{SIX, VT, GATE, RSTD1};
        pg8::gemm_phase<pg8::EpiProj, pg8::StaticOrder, true, true>(ldsb + RING_OFF, g, S, E);
        if (BOTH(1)) GRID_BAR();
    }

    if (IN(2)) {
        conv_phase(CBB, CCB, CUB, conv_w, conv_b, gw * 64 + lane, NGW * 64);
        for (int it = gw; it < BATCH * NH * (T / 32); it += NGW) {
            const int bh = it >> 7, qblk = it & 127;
            attn_item(QB, KB, VT, QB, bh >> 3, bh & 7, qblk, lane);
        }
        if (BOTH(2)) GRID_BAR();
    }

    if (IN(3)) {
        pg8::Gemm g{QB, Wab, 2 * M, 2048, 512}; pg8::PairOrder S; S.init(G, (int)blockIdx.x);
        pg8::EpiGate E{out, MERGED, GATE, GATE + (size_t)M * 1024};
        pg8::gemm_phase<pg8::EpiGate, pg8::PairOrder, true, true>(ldsb + RING_OFF, g, S, E);
        if (BOTH(3)) GRID_BAR();
    }

    if (IN(4)) {
        pg8::Gemm g{MERGED, Wo_t, M, D, D}; pg8::StaticOrder S; S.init(M, D, G, (int)blockIdx.x);
        pg8::EpiWo E{x, out, X1B};
        pg8::gemm_phase<pg8::EpiWo, pg8::StaticOrder, false, true>(ldsb + RING_OFF, g, S, E);
        const int gt = gw * 64 + lane, NT = NGW * 64;
        for (int i = gt; i < NEXP * D / 8; i += NT) {
            const int k8 = (i & 127) * 8;
            const f32x4 a = *(const GAS f32x4*)(exp_u + (size_t)i * 8), b = *(const GAS f32x4*)(exp_u + (size_t)i * 8 + 4);
            const f32x4 ga = *(const GAS f32x4*)(norm_ffn + k8), gb = *(const GAS f32x4*)(norm_ffn + k8 + 4);
            v4u o; o.x = pk2(a.x * ga.x, a.y * ga.y); o.y = pk2(a.z * ga.z, a.w * ga.w); o.z = pk2(b.x * gb.x, b.y * gb.y); o.w = pk2(b.z * gb.z, b.w * gb.w);
            *(GAS v4u*)(TU + (size_t)i * 8) = o;
            const f32x4 c = *(const GAS f32x4*)(exp_v + (size_t)i * 8), d = *(const GAS f32x4*)(exp_v + (size_t)i * 8 + 4);
            v4u p; p.x = pk2(c.x, c.y); p.y = pk2(c.z, c.w); p.z = pk2(d.x, d.y); p.w = pk2(d.z, d.w);
            *(GAS v4u*)(TV + (size_t)i * 8) = p;
        }
        if (BOTH(4)) GRID_BAR();
    }

    if (IN(5)) {
        pg8::Gemm g{X1B, Weff, M, 2048, D}; pg8::StaticOrder S; S.init(M, 2048, G, (int)blockIdx.x);
        pg8::EpiScores E{SCORES};
        pg8::gemm_phase<pg8::EpiScores, pg8::StaticOrder, true, true>(ldsb + RING_OFF, g, S, E);
        if (BOTH(5)) GRID_BAR();
    }

    if (IN(6)) {
        LAS unsigned char* scr = ldsb + RING_OFF + wave * 4096;
        for (int tok = gw; tok < M; tok += NGW) peer_token(tok, SCORES, out, TU, TV, final_norm, scr, lane);
    }
#undef IN
#undef BOTH
#undef GRID_BAR
}

extern "C" void kernel_launch(void* const* d_in, const int* in_sizes, int n_in, void* d_out, int out_size, void* d_ws, size_t ws_size, hipStream_t stream) {
    static int grid = 0;
    if (grid == 0) {
        if (n_in != 14 || in_sizes[0] != M * D || out_size != M * D || ws_size < WS_END) { fprintf(stderr, "kernel_launch: built for 14 inputs, x/out of %d floats, >= %zu bytes of workspace; got n_in %d, in0 %d, out %d, ws %zu; nothing launched\n", M * D, (size_t)WS_END, n_in, n_in > 0 ? in_sizes[0] : -1, out_size, ws_size); grid = -1; return; }
        int dev = 0, cus = 0, per_cu = 0;
        if (hipGetDevice(&dev) != hipSuccess || hipDeviceGetAttribute(&cus, hipDeviceAttributeMultiprocessorCount, dev) != hipSuccess) { fprintf(stderr, "kernel_launch: device query failed\n"); grid = -1; return; }
        if (hipFuncSetAttribute((const void*)hybrid_fwd, hipFuncAttributeMaxDynamicSharedMemorySize, LDS_BYTES) != hipSuccess) { fprintf(stderr, "kernel_launch: hipFuncSetAttribute failed\n"); grid = -1; return; }
        if (hipOccupancyMaxActiveBlocksPerMultiprocessor(&per_cu, (const void*)hybrid_fwd, NWAVES * 64, LDS_BYTES) != hipSuccess || per_cu < 1) { fprintf(stderr, "kernel_launch: occupancy query reports %d workgroups per CU\n", per_cu); per_cu = 1; }
        (void)hipGetLastError();
        grid = cus;
    }
    if (grid < 0) return;
    if (hipMemsetAsync((char*)d_ws + WS_CTL, 0, CTL_ZERO_BYTES, stream) != hipSuccess) { fprintf(stderr, "kernel_launch: hipMemsetAsync failed\n"); return; }
    Args a{};
    for (int i = 0; i < 14; ++i) a.in[i] = (const float*)d_in[i];
    a.out = (float*)d_out; a.ws = (unsigned char*)d_ws;
    for (int li = 0; li < N_LAUNCHES; ++li) {
        a.ph_lo = (N_LAUNCHES == 1) ? 0 : li; a.ph_hi = (N_LAUNCHES == 1) ? N_PHASES : li + 1; a.li = li;
        hipLaunchKernelGGL(hybrid_fwd, dim3(grid), dim3(NWAVES * 64), LDS_BYTES, stream, a);
        const hipError_t le = hipPeekAtLastError();
        if (le != hipSuccess) { fprintf(stderr, "kernel_launch: launch %d failed: %s\n", li, hipGetErrorName(le)); break; }
    }
}
```

```cpp
#include <hip/hip_runtime.h>
#include <cstdio>
#include <cstdint>
#include <cmath>
namespace pg8 {
#define PG8_LAS __attribute__((address_space(3)))
typedef unsigned short bf16_t;
typedef short bf16x8 __attribute__((ext_vector_type(8)));
typedef float f32x4 __attribute__((ext_vector_type(4)));
typedef unsigned u32x4 __attribute__((ext_vector_type(4)));
constexpr int BM = 256, BK = 64, HALF = 128, HTB = HALF * BK * 2  , STAGE_BYTES = 8 * HTB, NXCD = 8, WGM = 8;

__host__ __device__ __forceinline__ int lds_byte(int r, int c) { const int st = (r >> 4) * 2 + (c >> 5), rr = r & 15, cc = c & 31, ob = rr * 64 + cc * 2; return st * 1024 + (ob ^ (((ob >> 9) & 1) << 5)); }
__host__ __device__ __forceinline__ void stage_rc(int b, int& R, int& C) { const int st = b / 1024, sb = b % 1024, swz = sb ^ (((sb >> 9) & 1) << 5); R = (st >> 1) * 16 + swz / 64; C = (st & 1) * 32 + (swz % 64) / 2; }
__host__ __device__ __forceinline__ int perm32(int rho) { const int n = rho >> 4, i = rho & 15; return 8 * (i >> 2) + 4 * n + (i & 3); }

struct Unit { int pm, pn; };
struct Gemm { const bf16_t* A; const bf16_t* Bt; int M, N, K; };

struct StaticOrder {
    int nM, nN, nwg, G, c;
    __host__ __device__ void init(int M, int N, int G_, int c_) { nM = M / BM; nN = N / BM; nwg = nM * nN; G = G_; c = c_; }
    __host__ __device__ bool next(int i, Unit& u) const {
        const long L = (long)i * G + c; if (L >= nwg) return false;
        int wgid = (int)L; { const int q = nwg / NXCD, r = nwg % NXCD, xcd = wgid % NXCD, off = wgid / NXCD; wgid = (xcd < r ? xcd * (q + 1) : r * (q + 1) + (xcd - r) * q) + off; }
        const int nig = WGM * nN, gid = wgid / nig, fm = gid * WGM, gsz = (nM - fm) < WGM ? (nM - fm) : WGM;
        u.pm = fm + ((wgid % nig) % gsz); u.pn = (wgid % nig) / gsz; return true;
    }
    __device__ __forceinline__ void a_ready(const Unit&) const {}
    __device__ __forceinline__ void done(const Unit&) const {}
};

__device__ __forceinline__ unsigned cvt_pk_bf16(float lo, float hi) { unsigned r; asm volatile("v_cvt_pk_bf16_f32 %0, %1, %2" : "=v"(r) : "v"(lo), "v"(hi)); return r; }
constexpr int MTOK = 16384;
__device__ __forceinline__ unsigned f2bf_rne(float f) { unsigned u = __builtin_bit_cast(unsigned, f); return (u + 0x7fffu + ((u >> 16) & 1u)) >> 16; }
__device__ __forceinline__ float bf_lo(unsigned w) { return __builtin_bit_cast(float, w << 16); }
__device__ __forceinline__ float bf_hi(unsigned w) { return __builtin_bit_cast(float, w & 0xffff0000u); }
__device__ __forceinline__ float sigmoid_fast(float x) { return __builtin_amdgcn_rcpf(1.0f + __builtin_amdgcn_exp2f(-1.4426950408889634f * x)); }

struct EpiProj {
    static constexpr bool PERM = true, AFTER_DRAIN = false;
    bf16_t* six;
    bf16_t* vt;
    bf16_t* gate;
    const float* rstd;
    __device__ __forceinline__ void operator()(const f32x4 (&acc)[2][2][4][2], const Unit& u, int wr, int wc, int fr, int fq) const {
        const int row0 = u.pm * BM + wr * 64 + fr; const int colt = u.pn * BM;
        if (colt < 3072) {
            const int t = colt >> 9, cc = colt & 511;
            if (t == 2) {
#pragma unroll
                for (int ai = 0; ai < 2; ++ai)
#pragma unroll
                    for (int m = 0; m < 4; ++m) { const int r = row0 + ai * HALF + m * 16; const float rs = rstd[r]; const int b = r >> 12, tt = r & 4095;
#pragma unroll
                        for (int bj = 0; bj < 2; ++bj) { const int c0 = cc + bj * HALF + wc * 32 + 8 * fq; const int hh = c0 >> 6, d0 = c0 & 63;
                            bf16_t* p = vt + ((size_t)((b * 8 + hh) * 64 + d0)) * 4096 + tt;
#pragma unroll
                            for (int n = 0; n < 2; ++n)
#pragma unroll
                                for (int i = 0; i < 4; ++i) p[(size_t)(4 * n + i) * 4096] = (bf16_t)f2bf_rne(acc[ai][bj][m][n][i] * rs); } }
            } else {
                const int bufidx = (t == 0) ? 0 : (t == 1) ? 2 : (t == 3) ? 1 : t;
                bf16_t* base = six + (size_t)bufidx * MTOK * 512; const float sc = (t == 0) ? 0.125f : 1.0f;
                const int col0 = cc + wc * 32 + 8 * fq;
#pragma unroll
                for (int ai = 0; ai < 2; ++ai)
#pragma unroll
                    for (int m = 0; m < 4; ++m) { const int r = row0 + ai * HALF + m * 16; const float rs = rstd[r] * sc; bf16_t* rowp = base + (size_t)r * 512 + col0;
#pragma unroll
                        for (int bj = 0; bj < 2; ++bj) { const f32x4 v0 = acc[ai][bj][m][0] * rs, v1 = acc[ai][bj][m][1] * rs;
                            u32x4 w; w.x = cvt_pk_bf16(v0[0], v0[1]); w.y = cvt_pk_bf16(v0[2], v0[3]); w.z = cvt_pk_bf16(v1[0], v1[1]); w.w = cvt_pk_bf16(v1[2], v1[3]);
                            *(u32x4*)(rowp + bj * HALF) = w; } }
            }
        } else {
            const int gi = (colt - 3072) >> 10, cc = (colt - 3072) & 1023;
            bf16_t* base = gate + (size_t)gi * MTOK * 1024; const int col0 = cc + wc * 32 + 8 * fq;
#pragma unroll
            for (int ai = 0; ai < 2; ++ai)
#pragma unroll
                for (int m = 0; m < 4; ++m) { const int r = row0 + ai * HALF + m * 16; const float rs = rstd[r]; bf16_t* rowp = base + (size_t)r * 1024 + col0;
#pragma unroll
                    for (int bj = 0; bj < 2; ++bj) { f32x4 v0 = acc[ai][bj][m][0] * rs, v1 = acc[ai][bj][m][1] * rs;
#pragma unroll
                        for (int i = 0; i < 4; ++i) { v0[i] = sigmoid_fast(v0[i]); v1[i] = sigmoid_fast(v1[i]); }
                        u32x4 w; w.x = cvt_pk_bf16(v0[0], v0[1]); w.y = cvt_pk_bf16(v0[2], v0[3]); w.z = cvt_pk_bf16(v1[0], v1[1]); w.w = cvt_pk_bf16(v1[2], v1[3]);
                        *(u32x4*)(rowp + bj * HALF) = w; } }
        }
    }
};

struct EpiGate {
    static constexpr bool PERM = true, AFTER_DRAIN = false;
    float* P; bf16_t* merged; const bf16_t* g0; const bf16_t* g1;
    __device__ __forceinline__ void operator()(const f32x4 (&acc)[2][2][4][2], const Unit& u, int wr, int wc, int fr, int fq) const {
        const int which = (u.pm >= 64) ? 1 : 0; const int pm = u.pm - 64 * which, pn = u.pn - 4 * which;
        const int row0 = pm * BM + wr * 64 + fr, col0 = pn * BM + wc * 32 + 8 * fq; const bf16_t* g = which ? g1 : g0;
#pragma unroll
        for (int ai = 0; ai < 2; ++ai)
#pragma unroll
            for (int m = 0; m < 4; ++m) { const int r = row0 + ai * HALF + m * 16;
#pragma unroll
                for (int bj = 0; bj < 2; ++bj) { const size_t off = (size_t)r * 1024 + col0 + bj * HALF;
                    const u32x4 gv = *(const u32x4*)(g + off);
                    f32x4 a0 = acc[ai][bj][m][0], a1 = acc[ai][bj][m][1];
                    a0[0] *= bf_lo(gv.x); a0[1] *= bf_hi(gv.x); a0[2] *= bf_lo(gv.y); a0[3] *= bf_hi(gv.y);
                    a1[0] *= bf_lo(gv.z); a1[1] *= bf_hi(gv.z); a1[2] *= bf_lo(gv.w); a1[3] *= bf_hi(gv.w);
                    if (!which) { *(f32x4*)(P + off) = a0; *(f32x4*)(P + off + 4) = a1; }
                    else { const f32x4 p0 = *(const f32x4*)(P + off), p1 = *(const f32x4*)(P + off + 4); a0 += p0; a1 += p1;
                        u32x4 w; w.x = cvt_pk_bf16(a0[0], a0[1]); w.y = cvt_pk_bf16(a0[2], a0[3]); w.z = cvt_pk_bf16(a1[0], a1[1]); w.w = cvt_pk_bf16(a1[2], a1[3]);
                        *(u32x4*)(merged + off) = w; } } }
    }
};
struct PairOrder {
    StaticOrder so;
    __host__ __device__ void init(int G_, int c_) { so.init(MTOK, 1024, G_, c_); }
    __host__ __device__ bool next(int i, Unit& u) const { Unit t; if (!so.next(i >> 1, t)) return false; const int w = i & 1; u.pm = t.pm + 64 * w; u.pn = t.pn + 4 * w; return true; }
    __device__ __forceinline__ void a_ready(const Unit&) const {}
    __device__ __forceinline__ void done(const Unit&) const {}
};

struct EpiWo {
    static constexpr bool PERM = true, AFTER_DRAIN = false;
    const float* x; float* x1; bf16_t* x1b;
    __device__ __forceinline__ void operator()(const f32x4 (&acc)[2][2][4][2], const Unit& u, int wr, int wc, int fr, int fq) const {
        const int row0 = u.pm * BM + wr * 64 + fr, col0 = u.pn * BM + wc * 32 + 8 * fq;
#pragma unroll
        for (int ai = 0; ai < 2; ++ai)
#pragma unroll
            for (int m = 0; m < 4; ++m) { const int r = row0 + ai * HALF + m * 16;
#pragma unroll
                for (int bj = 0; bj < 2; ++bj) { const size_t off = (size_t)r * 1024 + col0 + bj * HALF;
                    const f32x4 a0 = acc[ai][bj][m][0] + *(const f32x4*)(x + off), a1 = acc[ai][bj][m][1] + *(const f32x4*)(x + off + 4);
                    *(f32x4*)(x1 + off) = a0; *(f32x4*)(x1 + off + 4) = a1;
                    u32x4 w; w.x = cvt_pk_bf16(a0[0], a0[1]); w.y = cvt_pk_bf16(a0[2], a0[3]); w.z = cvt_pk_bf16(a1[0], a1[1]); w.w = cvt_pk_bf16(a1[2], a1[3]);
                    *(u32x4*)(x1b + off) = w; } }
    }
};
struct EpiScores {
    static constexpr bool PERM = true, AFTER_DRAIN = false;
    float* S;
    __device__ __forceinline__ void operator()(const f32x4 (&acc)[2][2][4][2], const Unit& u, int wr, int wc, int fr, int fq) const {
        const int row0 = u.pm * BM + wr * 64 + fr, col0 = u.pn * BM + wc * 32 + 8 * fq;
#pragma unroll
        for (int ai = 0; ai < 2; ++ai)
#pragma unroll
            for (int m = 0; m < 4; ++m) { const int r = row0 + ai * HALF + m * 16;
#pragma unroll
                for (int bj = 0; bj < 2; ++bj) { const size_t off = (size_t)r * 2048 + col0 + bj * HALF;
                    *(f32x4*)(S + off) = acc[ai][bj][m][0]; *(f32x4*)(S + off + 4) = acc[ai][bj][m][1]; } }
    }
};
template <class Epi, class Sched, bool ALIGN_EPI = false, bool SP2 = false>
__device__ __forceinline__ void gemm_phase(PG8_LAS unsigned char* lds, const Gemm g, const Sched& S, const Epi& E) {
    const int tid = threadIdx.x, wid = __builtin_amdgcn_readfirstlane(tid >> 6), lane = tid & 63, wr = wid >> 2, wc = wid & 3, fr = lane & 15, fq = lane >> 4;
    const int K = g.K, nt = K / BK;
    unsigned voffA[2], voffB[2];
#pragma unroll
    for (int i = 0; i < 2; ++i) { int R, C; stage_rc(tid * 16 + i * 8192, R, C); const int Rb = Epi::PERM ? ((R & ~31) + perm32(R & 31)) : R;
        voffA[i] = (unsigned)(R * K + C) * 2u; voffB[i] = (unsigned)(Rb * K + C) * 2u; }
    const size_t kstep = (size_t)(BK * 2);
    const size_t hstep = (size_t)HALF * K * 2;
    const size_t tstep = 2 * hstep;
    const unsigned ldsw = (unsigned)wid * 1024u;
    const int aoff = lds_byte(wr * 64 + fr, fq * 8), boff = lds_byte(wc * 32 + fr, fq * 8);
#define PG8_SA(b, h) (((b) * 2 + (h)) * HTB)
#define PG8_SB(b, h) ((4 + (b) * 2 + (h)) * HTB)
#define PG8_STAGE(bufoff, gbase, voff) do { _Pragma("unroll") for (int _i = 0; _i < 2; ++_i) \
        __builtin_amdgcn_global_load_lds((const unsigned*)((const char*)(gbase) + (voff)[_i]), (PG8_LAS unsigned*)(lds + (bufoff) + ldsw + _i * 8192), 16, 0, 0); } while (0)
#define PG8_LDA(dst, b, h) do { _Pragma("unroll") for (int m = 0; m < 4; ++m) _Pragma("unroll") for (int k = 0; k < 2; ++k) dst[m][k] = *(const PG8_LAS bf16x8*)(lds + PG8_SA(b, h) + aoff + m * 2048 + k * 1024); } while (0)
#define PG8_LDB(dst, b, h) do { _Pragma("unroll") for (int n = 0; n < 2; ++n) _Pragma("unroll") for (int k = 0; k < 2; ++k) dst[n][k] = *(const PG8_LAS bf16x8*)(lds + PG8_SB(b, h) + boff + n * 2048 + k * 1024); } while (0)
#define PG8_MMA(ai, bj, At, Bt) do { __builtin_amdgcn_s_setprio(1); _Pragma("unroll") for (int m = 0; m < 4; ++m) _Pragma("unroll") for (int n = 0; n < 2; ++n) _Pragma("unroll") for (int k = 0; k < 2; ++k) \
        acc[ai][bj][m][n] = __builtin_amdgcn_mfma_f32_16x16x32_bf16(Bt[n][k], At[m][k], acc[ai][bj][m][n], 0, 0, 0); __builtin_amdgcn_s_setprio(0); } while (0)
#define PG8_WAIT_V(n) asm volatile("s_waitcnt vmcnt(" #n ")" ::: "memory")
#define PG8_WAIT_L(n) asm volatile("s_waitcnt lgkmcnt(" #n ")" ::: "memory")
#define PG8_BAR __builtin_amdgcn_s_barrier()
#define PG8_SCHED __builtin_amdgcn_sched_barrier(0)
    Unit cur, nxt; int ui = 0;
    if (!S.next(0, cur)) return;
    f32x4 acc[2][2][4][2];
#pragma unroll
    for (int a = 0; a < 2; ++a)
#pragma unroll
        for (int b = 0; b < 2; ++b)
#pragma unroll
            for (int m = 0; m < 4; ++m)
#pragma unroll
                for (int n = 0; n < 2; ++n) acc[a][b][m][n] = (f32x4){0.f, 0.f, 0.f, 0.f};
    bf16x8 At[4][2], B0[2][2], B1[2][2];
    const char* cA = (const char*)g.A + (size_t)cur.pm * tstep; const char* cB = (const char*)g.Bt + (size_t)cur.pn * tstep;
    S.a_ready(cur);
    if constexpr (SP2) {
        PG8_STAGE(PG8_SB(0, 0), cB, voffB); PG8_STAGE(PG8_SB(0, 1), cB + hstep, voffB); PG8_STAGE(PG8_SA(0, 0), cA, voffA); PG8_STAGE(PG8_SA(0, 1), cA + hstep, voffA);
        if (wr == 1) PG8_BAR;
        PG8_WAIT_V(2); PG8_BAR;
        PG8_STAGE(PG8_SB(1, 0), cB + kstep, voffB); PG8_STAGE(PG8_SA(1, 0), cA + kstep, voffA); PG8_STAGE(PG8_SB(1, 1), cB + hstep + kstep, voffB);
        PG8_WAIT_V(6); PG8_BAR;
    } else {
        PG8_STAGE(PG8_SB(0, 0), cB, voffB); PG8_STAGE(PG8_SA(0, 0), cA, voffA); PG8_STAGE(PG8_SB(0, 1), cB + hstep, voffB); PG8_STAGE(PG8_SA(0, 1), cA + hstep, voffA);
        if (wr == 1) PG8_BAR;
        PG8_WAIT_V(4); PG8_BAR;
        PG8_STAGE(PG8_SB(1, 0), cB + kstep, voffB); PG8_STAGE(PG8_SA(1, 0), cA + kstep, voffA); PG8_STAGE(PG8_SB(1, 1), cB + hstep + kstep, voffB);
        PG8_WAIT_V(6); PG8_BAR;
    }
    for (;;) {
        const bool has_next = S.next(ui + 1, nxt);
        const char* nA = has_next ? (const char*)g.A + (size_t)nxt.pm * tstep : cA; const char* nB = has_next ? (const char*)g.Bt + (size_t)nxt.pn * tstep : cB;
        for (int t = 0; t < nt; t += 2) {
            const bool last = (t == nt - 2);
            const char* a1 = cA + (size_t)(t + 1) * kstep;
            const char* a2 = last ? nA : cA + (size_t)(t + 2) * kstep; const char* b2 = last ? nB : cB + (size_t)(t + 2) * kstep;
            const char* a3 = a2 + kstep; const char* b3 = b2 + kstep;
            if (last && has_next) S.a_ready(nxt);
            if constexpr (SP2) {
            PG8_LDB(B0, 0, 0); PG8_LDB(B1, 0, 1); PG8_SCHED; PG8_LDA(At, 0, 0); PG8_STAGE(PG8_SA(1, 1), a1 + hstep, voffA);
            PG8_WAIT_V(8); PG8_WAIT_L(0); PG8_BAR; PG8_MMA(0, 0, At, B0); PG8_MMA(0, 1, At, B1); PG8_BAR; PG8_SCHED;
            PG8_LDA(At, 0, 1); PG8_STAGE(PG8_SB(0, 0), b2, voffB); PG8_STAGE(PG8_SB(0, 1), b2 + hstep, voffB); PG8_STAGE(PG8_SA(0, 0), a2, voffA);
            PG8_WAIT_V(8); PG8_WAIT_L(0); PG8_BAR; PG8_MMA(1, 0, At, B0); PG8_MMA(1, 1, At, B1); PG8_BAR; PG8_SCHED;
            PG8_LDB(B0, 1, 0); PG8_LDB(B1, 1, 1); PG8_SCHED; PG8_LDA(At, 1, 0); PG8_STAGE(PG8_SA(0, 1), a2 + hstep, voffA);
            PG8_WAIT_V(8); PG8_WAIT_L(0); PG8_BAR; PG8_MMA(0, 0, At, B0); PG8_MMA(0, 1, At, B1); PG8_BAR; PG8_SCHED;
            PG8_LDA(At, 1, 1); PG8_STAGE(PG8_SB(1, 0), b3, voffB); PG8_STAGE(PG8_SB(1, 1), b3 + hstep, voffB); PG8_STAGE(PG8_SA(1, 0), a3, voffA);
            PG8_WAIT_V(8); PG8_WAIT_L(0); PG8_BAR; PG8_MMA(1, 0, At, B0); PG8_MMA(1, 1, At, B1); PG8_BAR; PG8_SCHED;
            } else {
            PG8_LDB(B0, 0, 0); PG8_SCHED; PG8_LDA(At, 0, 0); PG8_STAGE(PG8_SA(1, 1), a1 + hstep, voffA);
            PG8_WAIT_L(8); PG8_BAR; PG8_WAIT_L(0); PG8_MMA(0, 0, At, B0); PG8_BAR; PG8_SCHED;
            PG8_LDB(B1, 0, 1); PG8_STAGE(PG8_SB(0, 0), b2, voffB);
            PG8_BAR; PG8_WAIT_L(0); PG8_MMA(0, 1, At, B1); PG8_BAR;
            PG8_LDA(At, 0, 1); PG8_STAGE(PG8_SA(0, 0), a2, voffA);
            PG8_BAR; PG8_WAIT_L(0); PG8_MMA(1, 0, At, B0); PG8_BAR; PG8_SCHED;
            PG8_STAGE(PG8_SB(0, 1), b2 + hstep, voffB);
            PG8_WAIT_V(6); PG8_BAR; PG8_MMA(1, 1, At, B1); PG8_BAR;
            PG8_LDB(B0, 1, 0); PG8_SCHED; PG8_LDA(At, 1, 0); PG8_STAGE(PG8_SA(0, 1), a2 + hstep, voffA);
            PG8_WAIT_L(8); PG8_BAR; PG8_WAIT_L(0); PG8_MMA(0, 0, At, B0); PG8_BAR; PG8_SCHED;
            PG8_LDB(B1, 1, 1); PG8_STAGE(PG8_SB(1, 0), b3, voffB);
            PG8_BAR; PG8_WAIT_L(0); PG8_MMA(0, 1, At, B1); PG8_BAR;
            PG8_LDA(At, 1, 1); PG8_STAGE(PG8_SA(1, 0), a3, voffA);
            PG8_BAR; PG8_WAIT_L(0); PG8_MMA(1, 0, At, B0); PG8_BAR; PG8_SCHED;
            PG8_STAGE(PG8_SB(1, 1), b3 + hstep, voffB);
            PG8_WAIT_V(6); PG8_BAR; PG8_MMA(1, 1, At, B1); PG8_BAR;
            }
        }
        if constexpr (ALIGN_EPI) { if (wr == 0) PG8_BAR; }
        if constexpr (!Epi::AFTER_DRAIN) { E(acc, cur, wr, wc, fr, fq); S.done(cur); }
        if (!has_next) break;
#pragma unroll
        for (int a = 0; a < 2; ++a)
#pragma unroll
            for (int b = 0; b < 2; ++b)
#pragma unroll
                for (int m = 0; m < 4; ++m)
#pragma unroll
                    for (int n = 0; n < 2; ++n) acc[a][b][m][n] = (f32x4){0.f, 0.f, 0.f, 0.f};
        cur = nxt; cA = nA; cB = nB; ++ui;
        if constexpr (ALIGN_EPI) { if (wr == 1) PG8_BAR; }
    }
    PG8_WAIT_V(0);
    if constexpr (!ALIGN_EPI) { if (wr == 0) PG8_BAR; }
    PG8_BAR;
    if constexpr (Epi::AFTER_DRAIN) { E.fused(acc, cur, wr, wc, fr, fq, lds, wid, lane); S.done(cur); }
#undef PG8_SA
#undef PG8_SB
#undef PG8_STAGE
#undef PG8_LDA
#undef PG8_LDB
#undef PG8_MMA
#undef PG8_WAIT_V
#undef PG8_WAIT_L
#undef PG8_BAR
#undef PG8_SCHED
}
}

constexpr int NWAVES = 8;
constexpr int BATCH = 4, T = 4096, D = 1024, NH = 8, HD = 64, NIN = 5120;
constexpr int M = BATCH * T;
constexpr int NEXP = 16384;
constexpr float RMS_EPS = 1e-6f;
#ifndef MK_N_LAUNCHES
#define MK_N_LAUNCHES 1
#endif
constexpr int N_PHASES = 7;
constexpr int N_LAUNCHES = MK_N_LAUNCHES;

constexpr size_t MiB = 1u << 20;
constexpr size_t WS_CTL = 0, CTL_ZERO_BYTES = 64 * 1024;
constexpr size_t WS_RSTD1 = 512 * 1024;
constexpr size_t WS_WEFF = 1 * MiB;
constexpr size_t WS_WAB = 5 * MiB;
constexpr size_t WS_WO = 7 * MiB;
constexpr size_t WS_WIN = 9 * MiB;
constexpr size_t WS_XB = 19 * MiB;
constexpr size_t WS_SIX = 51 * MiB;
constexpr size_t WS_VT = WS_SIX + 3 * 16 * MiB;
constexpr size_t WS_GATE = 147 * MiB;
constexpr size_t WS_MERGED = 211 * MiB;
constexpr size_t WS_X1B = 32 * MiB;
constexpr size_t WS_TU = 64 * MiB, WS_TV = 96 * MiB;
constexpr size_t WS_SCORES = 128 * MiB;
constexpr size_t WS_END = 256 * MiB;
constexpr int CW_BAR = 4096;

constexpr int RING_OFF = 0, RING_BYTES = 131072;
constexpr int LDSCTL_OFF = RING_BYTES, MISC_OFF = LDSCTL_OFF + 320;
constexpr int LDS_BYTES = 147456;

#define GAS __attribute__((address_space(1)))
#define LAS __attribute__((address_space(3)))
typedef unsigned short bf16;
typedef unsigned v4u __attribute__((ext_vector_type(4)));
typedef unsigned v2u __attribute__((ext_vector_type(2)));
typedef float f32x4 __attribute__((ext_vector_type(4)));
typedef float f32x2 __attribute__((ext_vector_type(2)));
typedef float f32x16 __attribute__((ext_vector_type(16)));
typedef short bf16x8 __attribute__((ext_vector_type(8)));
typedef _Float16 f16x8 __attribute__((ext_vector_type(8)));
typedef _Float16 f16x2 __attribute__((ext_vector_type(2)));
typedef __bf16 bf16x2_t __attribute__((ext_vector_type(2)));
typedef GAS unsigned gu32;
#define RLX_AGENT __ATOMIC_RELAXED, __HIP_MEMORY_SCOPE_AGENT
#define LDS_WAIT() asm volatile("s_waitcnt lgkmcnt(0)" ::: "memory")
#define VM_WAIT() asm volatile("s_waitcnt vmcnt(0)" ::: "memory")
__device__ __forceinline__ unsigned f2bf(float f) { unsigned u = __builtin_bit_cast(unsigned, f); return (u + 0x7fffu + ((u >> 16) & 1u)) >> 16; }
__device__ __forceinline__ unsigned pk2(float lo, float hi) { return f2bf(lo) | (f2bf(hi) << 16); }
__device__ __forceinline__ unsigned cvtpk(float lo, float hi) { f32x2 v = {lo, hi}; bf16x2_t b = __builtin_convertvector(v, bf16x2_t); return __builtin_bit_cast(unsigned, b); }
__device__ __forceinline__ float bflo(unsigned w) { return __builtin_bit_cast(float, w << 16); }
__device__ __forceinline__ float bfhi(unsigned w) { return __builtin_bit_cast(float, w & 0xffff0000u); }
__device__ __forceinline__ float wave_sum(float v) {
#pragma unroll
    for (int o = 1; o < 64; o <<= 1) v += __shfl_xor(v, o);
    return v;
}
#define XB_TMO      128
#define XB_XCNT(j)  (256  + 64 * (j))
#define XB_XSUB(j)  (1280 + 64 * (j))
#define XB_XGEN(j)  (2304 + 64 * (j))
#define XB_TOP      3328
#define XB_TOPGEN   3392
#define XCD_BAR_WORDS 3456
#define XB_SPIN_CAP (1u << 18)

__device__ __forceinline__ unsigned xb_ld(unsigned* p)              { return __hip_atomic_load(p, __ATOMIC_RELAXED, __HIP_MEMORY_SCOPE_AGENT); }
__device__ __forceinline__ unsigned xb_add(unsigned* p, unsigned v) { return __hip_atomic_fetch_add(p, v, __ATOMIC_RELAXED, __HIP_MEMORY_SCOPE_AGENT); }
__device__ __forceinline__ unsigned xb_xcc_id() { return (unsigned)__builtin_amdgcn_s_getreg((3 << 11) | 20) & 0xFu; }
#define XB_SPIN(cond, bar) do { unsigned _sp = 0; while (cond) { __builtin_amdgcn_s_sleep(1); \
    if ((++_sp & 255u) == 0u) { if (xb_ld(&(bar)[XB_TMO])) break; if (_sp > XB_SPIN_CAP) { atomicAdd(&(bar)[XB_TMO], 1u); break; } } } } while (0)

struct XcdBarrier {
    unsigned* bar; unsigned x;
    volatile LAS unsigned* st;
};

__device__ __forceinline__ XcdBarrier xcd_barrier_post(unsigned* bar, volatile LAS unsigned* st) {
    XcdBarrier b; b.bar = bar; b.x = xb_xcc_id(); b.st = st;
    if (threadIdx.x == 0) (void)xb_add(&bar[XB_XCNT(b.x)], 1u);
    return b;
}
__device__ __forceinline__ void xcd_barrier_complete(unsigned* bar, unsigned x, unsigned& nloc, unsigned& nx) {
    const unsigned G = gridDim.x * gridDim.y * gridDim.z;
    unsigned sum, cnt, mine, sp = 0u;
    for (;;) {
        sum = 0u; cnt = 0u; mine = 0u;
#pragma unroll
        for (unsigned j = 0; j < 16; ++j) { const unsigned c = xb_ld(&bar[XB_XCNT(j)]); sum += c; cnt += (c > 0u) ? 1u : 0u; mine = (j == x) ? c : mine; }
        if (sum == G) break;
        __builtin_amdgcn_s_sleep(1);
        if ((++sp & 255u) == 0u) { if (xb_ld(&bar[XB_TMO])) break; if (sp > XB_SPIN_CAP) { atomicAdd(&bar[XB_TMO], 1u); break; } }
    }
    nloc = mine > 0u ? mine : 1u; nx = cnt > 0u ? cnt : 1u;
}

__device__ __forceinline__ void xcd_barrier(const XcdBarrier& b) {
    asm volatile("s_waitcnt vmcnt(0)" ::: "memory");
    __syncthreads();
    if (threadIdx.x == 0) {
        unsigned* bar = b.bar;
        __builtin_amdgcn_s_waitcnt(0);
        unsigned nloc = b.st[0], nx = b.st[1];
        if (nloc == 0u) { xcd_barrier_complete(bar, b.x, nloc, nx); b.st[0] = nloc; b.st[1] = nx; }
        const unsigned old = xb_add(&bar[XB_XSUB(b.x)], 1u);
        const unsigned gen = old / nloc;
        if (old + 1u == (gen + 1u) * nloc) {
            __builtin_amdgcn_fence(__ATOMIC_RELEASE, "agent");
            asm volatile("s_waitcnt vmcnt(0)" ::: "memory");
            const unsigned og = xb_add(&bar[XB_TOP], 1u);
            const unsigned tg = og / nx;
            if (og + 1u == (tg + 1u) * nx) xb_add(&bar[XB_TOPGEN], 1u);
            else XB_SPIN(xb_ld(&bar[XB_TOPGEN]) == tg, bar);
            __builtin_amdgcn_fence(__ATOMIC_ACQUIRE, "agent");
            xb_add(&bar[XB_XGEN(b.x)], 1u);
            asm volatile("s_waitcnt vmcnt(0)" ::: "memory");
        } else {
            XB_SPIN(xb_ld(&bar[XB_XGEN(b.x)]) == gen, bar);
            __builtin_amdgcn_fence(__ATOMIC_ACQUIRE, "agent");
            asm volatile("s_waitcnt vmcnt(0)" ::: "memory");
        }
    }
    __syncthreads();
}

__device__ __forceinline__ void p0_transpose_item(const float* W, int K, int N, bf16* WT, int row_off, const float* kscale, LAS float* scr, int item, int lane) {
    const int nblk = N / 32, kb = item / nblk, nb = item % nblk, k0 = 64 * kb, n0 = 32 * nb;
#pragma unroll 8
    for (int i = 0; i < 32; ++i) { const int kk = 2 * i + (lane >> 5); scr[kk * 33 + (lane & 31)] = W[(size_t)(k0 + kk) * N + n0 + (lane & 31)]; }
    LDS_WAIT(); asm volatile("" ::: "memory");
    const int c = lane & 7;
    float ks[8];
#pragma unroll
    for (int i = 0; i < 8; ++i) ks[i] = kscale ? kscale[k0 + 8 * c + i] : 1.0f;
#pragma unroll
    for (int j = 0; j < 4; ++j) { const int n = (lane >> 3) + 8 * j; const LAS float* s = scr + (8 * c) * 33 + n;
        v4u o; o.x = pk2(s[0 * 33] * ks[0], s[1 * 33] * ks[1]); o.y = pk2(s[2 * 33] * ks[2], s[3 * 33] * ks[3]); o.z = pk2(s[4 * 33] * ks[4], s[5 * 33] * ks[5]); o.w = pk2(s[6 * 33] * ks[6], s[7 * 33] * ks[7]);
        *(GAS v4u*)(WT + (size_t)(row_off + n0 + n) * K + k0 + 8 * c) = o; }
    LDS_WAIT(); asm volatile("" ::: "memory");
}

__device__ __forceinline__ void conv_phase(bf16* CB, const bf16* CC, const bf16* CU, const float* cw, const float* cbias, int gtid, int nthreads) {
    for (int task = gtid; task < M * 64; task += nthreads) {
        const int tok = task >> 6, c8 = (task & 63) * 8, tt = tok & (T - 1);
        const size_t off = (size_t)tok * 512 + c8;
        float z[3][8];
#pragma unroll
        for (int k = 0; k < 3; ++k) {
            const int dt = 2 - k;
            if (tt >= dt) { const v4u a = *(const GAS v4u*)(CC + off - (size_t)dt * 512), b = *(const GAS v4u*)(CU + off - (size_t)dt * 512);
                z[k][0] = bflo(a.x) * bflo(b.x); z[k][1] = bfhi(a.x) * bfhi(b.x); z[k][2] = bflo(a.y) * bflo(b.y); z[k][3] = bfhi(a.y) * bfhi(b.y);
                z[k][4] = bflo(a.z) * bflo(b.z); z[k][5] = bfhi(a.z) * bfhi(b.z); z[k][6] = bflo(a.w) * bflo(b.w); z[k][7] = bfhi(a.w) * bfhi(b.w); }
            else {
#pragma unroll
                for (int i = 0; i < 8; ++i) z[k][i] = 0.f; }
        }
        float y[8];
#pragma unroll
        for (int i = 0; i < 8; ++i) y[i] = cbias[c8 + i];
#pragma unroll
        for (int k = 0; k < 3; ++k)
#pragma unroll
            for (int i = 0; i < 8; ++i) y[i] += cw[k * 512 + c8 + i] * z[k][i];
        const v4u g = *(const GAS v4u*)(CB + off);
        v4u o; o.x = pk2(bflo(g.x) * y[0], bfhi(g.x) * y[1]); o.y = pk2(bflo(g.y) * y[2], bfhi(g.y) * y[3]); o.z = pk2(bflo(g.z) * y[4], bfhi(g.z) * y[5]); o.w = pk2(bflo(g.w) * y[6], bfhi(g.w) * y[7]);
        *(GAS v4u*)(CB + off) = o;
    }
}

__device__ __forceinline__ int crow(int r, int hf) { return (r & 3) + 8 * (r >> 2) + 4 * hf; }
#define MFMA_BF16(a, b, c) __builtin_amdgcn_mfma_f32_32x32x16_bf16((a), (b), (c), 0, 0, 0)
#define MFMA_F16(a, b, c) __builtin_amdgcn_mfma_f32_32x32x16_f16((a), (b), (c), 0, 0, 0)
__device__ __forceinline__ void attn_item(const bf16* Qb, const bf16* Kb, const bf16* VT, bf16* Ob, int b, int h, int qblk, int lane) {
    const int t32 = lane & 31, hf = lane >> 5, q0 = qblk * 32, tq = q0 + t32;
    const size_t rowbase = (size_t)b * T;
    const float LOG2E = 1.4426950408889634f, LN2 = 0.6931471805599453f;
    bf16x8 qf[4];
    { const bf16* qp = Qb + (rowbase + q0 + t32) * 512 + h * 64 + 8 * hf;
#pragma unroll
      for (int st = 0; st < 4; ++st) qf[st] = *(const GAS bf16x8*)(qp + 16 * st); }
    f16x8 tri[2];
#pragma unroll
    for (int st = 0; st < 2; ++st)
#pragma unroll
        for (int e = 0; e < 8; ++e) { const int j = 16 * st + 8 * (e >> 2) + 4 * hf + (e & 3); tri[st][e] = (j >= t32) ? (_Float16)1.0f : (_Float16)0.0f; }
    f32x16 o0, o1;
#pragma unroll
    for (int r = 0; r < 16; ++r) { o0[r] = 0.f; o1[r] = 0.f; }
    float R = 0.f;
    const bf16* kbase = Kb + rowbase * 512 + h * 64 + 8 * hf;
    const bf16* vtb = VT + ((size_t)(b * 8 + h) * 64 + t32) * T + 4 * hf;
    for (int jt = q0 >> 6; jt >= 0; --jt) {
        const int k0 = jt * 64;
        f32x16 s0, s1;
#pragma unroll
        for (int r = 0; r < 16; ++r) { s0[r] = 0.f; s1[r] = 0.f; }
#pragma unroll
        for (int st = 0; st < 4; ++st) {
            const bf16x8 a0 = *(const GAS bf16x8*)(kbase + (size_t)(k0 + t32) * 512 + 16 * st);
            const bf16x8 a1 = *(const GAS bf16x8*)(kbase + (size_t)(k0 + 32 + t32) * 512 + 16 * st);
            s0 = MFMA_BF16(a0, qf[st], s0); s1 = MFMA_BF16(a1, qf[st], s1);
        }
        f32x16 L0, L1; float tot0 = 0.f, tot1 = 0.f;
#pragma unroll
        for (int r = 0; r < 16; ++r) {
            const int key = k0 + crow(r, hf);
            { const float z = s0[r]; const float e = __builtin_amdgcn_exp2f(-__builtin_fabsf(z) * LOG2E); const float lp = __builtin_amdgcn_logf(1.0f + e) * LN2;
              const float L = (key < tq) ? -(__builtin_fmaxf(z, 0.f) + lp) : 0.f; L0[r] = L; tot0 += L; }
            { const float z = s1[r]; const float e = __builtin_amdgcn_exp2f(-__builtin_fabsf(z) * LOG2E); const float lp = __builtin_amdgcn_logf(1.0f + e) * LN2;
              const float L = (key + 32 < tq) ? -(__builtin_fmaxf(z, 0.f) + lp) : 0.f; L1[r] = L; tot1 += L; }
        }
        tot0 += __shfl_xor(tot0, 32); tot1 += __shfl_xor(tot1, 32);
        f16x8 lf00, lf01, lf10, lf11;
#pragma unroll
        for (int e = 0; e < 8; ++e) { lf00[e] = (_Float16)L0[e]; lf01[e] = (_Float16)L0[8 + e]; lf10[e] = (_Float16)L1[e]; lf11[e] = (_Float16)L1[8 + e]; }
        f32x16 y0, y1;
#pragma unroll
        for (int r = 0; r < 16; ++r) { y0[r] = 0.f; y1[r] = 0.f; }
        y0 = MFMA_F16(tri[0], lf00, y0); y0 = MFMA_F16(tri[1], lf01, y0);
        y1 = MFMA_F16(tri[0], lf10, y1); y1 = MFMA_F16(tri[1], lf11, y1);
        const float base0 = R + tot1, base1 = R;
        float a0v[16], a1v[16];
#pragma unroll
        for (int r = 0; r < 16; ++r) {
            const int key = k0 + crow(r, hf);
            a0v[r] = (key < tq) ? __builtin_amdgcn_exp2f((s0[r] + y0[r] + base0) * LOG2E) : 0.f;
            a1v[r] = (key + 32 < tq) ? __builtin_amdgcn_exp2f((s1[r] + y1[r] + base1) * LOG2E) : 0.f;
        }
        bf16x8 pf[2][2];
#pragma unroll
        for (int st = 0; st < 2; ++st) {
            v4u w0, w1;
            w0.x = cvtpk(a0v[8 * st + 0], a0v[8 * st + 1]); w0.y = cvtpk(a0v[8 * st + 2], a0v[8 * st + 3]); w0.z = cvtpk(a0v[8 * st + 4], a0v[8 * st + 5]); w0.w = cvtpk(a0v[8 * st + 6], a0v[8 * st + 7]);
            w1.x = cvtpk(a1v[8 * st + 0], a1v[8 * st + 1]); w1.y = cvtpk(a1v[8 * st + 2], a1v[8 * st + 3]); w1.z = cvtpk(a1v[8 * st + 4], a1v[8 * st + 5]); w1.w = cvtpk(a1v[8 * st + 6], a1v[8 * st + 7]);
            pf[0][st] = __builtin_bit_cast(bf16x8, w0); pf[1][st] = __builtin_bit_cast(bf16x8, w1);
        }
#pragma unroll
        for (int kb = 0; kb < 2; ++kb)
#pragma unroll
            for (int st = 0; st < 2; ++st) {
                const int kk = k0 + 32 * kb + 16 * st;
                { const v2u lo = *(const GAS v2u*)(vtb + kk), hi = *(const GAS v2u*)(vtb + kk + 8); v4u w; w.x = lo.x; w.y = lo.y; w.z = hi.x; w.w = hi.y;
                  o0 = MFMA_BF16(__builtin_bit_cast(bf16x8, w), pf[kb][st], o0); }
                { const v2u lo = *(const GAS v2u*)(vtb + (size_t)32 * T + kk), hi = *(const GAS v2u*)(vtb + (size_t)32 * T + kk + 8); v4u w; w.x = lo.x; w.y = lo.y; w.z = hi.x; w.w = hi.y;
                  o1 = MFMA_BF16(__builtin_bit_cast(bf16x8, w), pf[kb][st], o1); }
            }
        R += tot0 + tot1;
        if (__all(R < -104.0f)) break;
    }
    bf16* op = Ob + (rowbase + q0 + t32) * 512 + h * 64 + 4 * hf;
#pragma unroll
    for (int q4 = 0; q4 < 4; ++q4) {
        v2u w; w.x = cvtpk(o0[4 * q4], o0[4 * q4 + 1]); w.y = cvtpk(o0[4 * q4 + 2], o0[4 * q4 + 3]); *(GAS v2u*)(op + 8 * q4) = w;
        v2u w2; w2.x = cvtpk(o1[4 * q4], o1[4 * q4 + 1]); w2.y = cvtpk(o1[4 * q4 + 2], o1[4 * q4 + 3]); *(GAS v2u*)(op + 32 + 8 * q4) = w2;
    }
}

template <int NV> __device__ __forceinline__ void select16(const float (&v)[NV], bool (&sel)[NV], int (&pos)[NV]) {
    float mx = v[0], mn = v[0];
#pragma unroll
    for (int i = 1; i < NV; ++i) { mx = __builtin_fmaxf(mx, v[i]); mn = __builtin_fminf(mn, v[i]); }
#pragma unroll
    for (int o = 1; o < 64; o <<= 1) { mx = __builtin_fmaxf(mx, __shfl_xor(mx, o)); mn = __builtin_fminf(mn, __shfl_xor(mn, o)); }
    float lo = mn, hi = mx, Tv;
    { int c = 0;
#pragma unroll
      for (int i = 0; i < NV; ++i) c += __popcll(__ballot(v[i] >= mx));
      if (c >= 16) { Tv = mx; }
      else {
        Tv = lo;
        for (int it = 0; it < 300; ++it) {
            const float mid = 0.5f * lo + 0.5f * hi;
            if (!(mid > lo && mid < hi)) { Tv = lo; break; }
            int cc = 0;
#pragma unroll
            for (int i = 0; i < NV; ++i) cc += __popcll(__ballot(v[i] >= mid));
            if (cc == 16) { Tv = mid; break; }
            if (cc > 16) lo = mid; else hi = mid;
            Tv = lo;
        }
      }
    }
    int cgt = 0;
#pragma unroll
    for (int i = 0; i < NV; ++i) cgt += __popcll(__ballot(v[i] > Tv));
    const int need = 16 - cgt;
    int eqbelow = 0;
#pragma unroll
    for (int i = 0; i < NV; ++i) { const unsigned long long m = __ballot(v[i] == Tv); eqbelow += __builtin_amdgcn_mbcnt_hi((unsigned)(m >> 32), __builtin_amdgcn_mbcnt_lo((unsigned)m, 0u)); }
    int eqown = 0;
#pragma unroll
    for (int i = 0; i < NV; ++i) { const bool eq = (v[i] == Tv); sel[i] = (v[i] > Tv) || (eq && (eqbelow + eqown) < need); eqown += eq ? 1 : 0; }
    int selbelow = 0;
#pragma unroll
    for (int i = 0; i < NV; ++i) { const unsigned long long m = __ballot(sel[i]); selbelow += __builtin_amdgcn_mbcnt_hi((unsigned)(m >> 32), __builtin_amdgcn_mbcnt_lo((unsigned)m, 0u)); }
    int own = 0;
#pragma unroll
    for (int i = 0; i < NV; ++i) { pos[i] = selbelow + own; own += sel[i] ? 1 : 0; }
}

__device__ __forceinline__ float gelu_exact(float a) { return 0.5f * a * (1.0f + erff(a * 0.7071067811865476f)); }

__device__ __forceinline__ void peer_token(int tok, const float* scores, float* xio  , const bf16* TU, const bf16* TV, const float* fgain, LAS unsigned char* scr, int lane) {
    LAS float* tv = (LAS float*)scr; LAS int* ti = (LAS int*)(scr + 1024); LAS float* es = (LAS float*)(scr + 2048); LAS int* ee = (LAS int*)(scr + 2560); LAS float* ww = (LAS float*)(scr + 3072);
    float xr[16];
    { const GAS f32x4* xp = (const GAS f32x4*)(xio + (size_t)tok * D);
#pragma unroll
      for (int j = 0; j < 2; ++j) { const f32x4 a = xp[2 * lane + 128 * j], b = xp[2 * lane + 128 * j + 1];
        xr[8 * j + 0] = a.x; xr[8 * j + 1] = a.y; xr[8 * j + 2] = a.z; xr[8 * j + 3] = a.w; xr[8 * j + 4] = b.x; xr[8 * j + 5] = b.y; xr[8 * j + 6] = b.z; xr[8 * j + 7] = b.w; } }
    float ss = 0.f;
#pragma unroll
    for (int i = 0; i < 16; ++i) ss += xr[i] * xr[i];
    const float rstd2 = 1.0f / sqrtf(wave_sum(ss) * (1.0f / D) + RMS_EPS);
    const float* srow = scores + (size_t)tok * 2048;
#pragma unroll 1
    for (int g = 0; g < 16; ++g) {
        const f32x2 sv = *(const GAS f32x2*)(srow + g * 128 + 2 * lane);
        float v[2] = {sv.x, sv.y}; bool sel[2]; int pos[2];
        select16<2>(v, sel, pos);
#pragma unroll
        for (int i = 0; i < 2; ++i) if (sel[i] && pos[i] < 16) { tv[g * 16 + pos[i]] = v[i]; ti[g * 16 + pos[i]] = 2 * lane + i; }
    }
    LDS_WAIT();
#pragma unroll 1
    for (int h = 0; h < 8; ++h) {
        const int i = lane >> 2, jb = (lane & 3) * 4;
        const float a = tv[(2 * h) * 16 + i];
        float c[4]; bool sel[4]; int pos[4];
#pragma unroll
        for (int jj = 0; jj < 4; ++jj) c[jj] = a + tv[(2 * h + 1) * 16 + jb + jj];
        select16<4>(c, sel, pos);
        const int ia = ti[(2 * h) * 16 + i];
#pragma unroll
        for (int jj = 0; jj < 4; ++jj) if (sel[jj] && pos[jj] < 16) { es[h * 16 + pos[jj]] = c[jj]; ee[h * 16 + pos[jj]] = ia * 128 + ti[(2 * h + 1) * 16 + jb + jj]; }
    }
    LDS_WAIT();
#pragma unroll
    for (int half = 0; half < 2; ++half) {
        const int n = lane + 64 * half; const float s = es[n] * rstd2;
        float m = s;
#pragma unroll
        for (int o = 1; o < 16; o <<= 1) m = __builtin_fmaxf(m, __shfl_xor(m, o));
        const float p = __builtin_amdgcn_exp2f((s - m) * 1.4426950408889634f);
        float sum = p;
#pragma unroll
        for (int o = 1; o < 16; o <<= 1) sum += __shfl_xor(sum, o);
        ww[n] = p / sum;
    }
    LDS_WAIT();
    const int hf = lane >> 5, b4 = (lane >> 4) & 1, b3 = (lane >> 3) & 1;
#pragma unroll 1
    for (int nb = 0; nb < 16; ++nb) {
        float p[8];
#pragma unroll
        for (int k = 0; k < 8; ++k) {
            const int e = __builtin_amdgcn_readfirstlane(ee[nb * 8 + k]);
            const GAS v4u* up = (const GAS v4u*)(TU + (size_t)e * D) + lane;
            const v4u u0 = up[0], u1 = up[64];
            float s = 0.f;
            s += xr[0] * bflo(u0.x); s += xr[1] * bfhi(u0.x); s += xr[2] * bflo(u0.y); s += xr[3] * bfhi(u0.y); s += xr[4] * bflo(u0.z); s += xr[5] * bfhi(u0.z); s += xr[6] * bflo(u0.w); s += xr[7] * bfhi(u0.w);
            s += xr[8] * bflo(u1.x); s += xr[9] * bfhi(u1.x); s += xr[10] * bflo(u1.y); s += xr[11] * bfhi(u1.y); s += xr[12] * bflo(u1.z); s += xr[13] * bfhi(u1.z); s += xr[14] * bflo(u1.w); s += xr[15] * bfhi(u1.w);
            p[k] = s;
        }
        float r4[4], q2[2];
#pragma unroll
        for (int k = 0; k < 4; ++k) { const float send = hf ? p[k] : p[k + 4], keep = hf ? p[k + 4] : p[k]; r4[k] = keep + __shfl_xor(send, 32); }
#pragma unroll
        for (int k = 0; k < 2; ++k) { const float send = b4 ? r4[k] : r4[k + 2], keep = b4 ? r4[k + 2] : r4[k]; q2[k] = keep + __shfl_xor(send, 16); }
        float s1; { const float send = b3 ? q2[0] : q2[1], keep = b3 ? q2[1] : q2[0]; s1 = keep + __shfl_xor(send, 8); }
        s1 += __shfl_xor(s1, 4); s1 += __shfl_xor(s1, 2); s1 += __shfl_xor(s1, 1);
        const int n = nb * 8 + 4 * hf + 2 * b4 + b3;
        const float act = gelu_exact(s1 * rstd2);
        const float w = ww[n] * act;
        LDS_WAIT();
        if ((lane & 7) == 0) ww[n] = w;
    }
    LDS_WAIT();
    float acc[16];
#pragma unroll
    for (int i = 0; i < 16; ++i) acc[i] = 0.f;
#pragma unroll 4
    for (int n = 0; n < 128; ++n) {
        const int e = __builtin_amdgcn_readfirstlane(ee[n]);
        const float w = __builtin_bit_cast(float, __builtin_amdgcn_readfirstlane(__builtin_bit_cast(int, ww[n])));
        const GAS v4u* vp = (const GAS v4u*)(TV + (size_t)e * D) + lane;
        const v4u u0 = vp[0], u1 = vp[64];
        acc[0] += w * bflo(u0.x); acc[1] += w * bfhi(u0.x); acc[2] += w * bflo(u0.y); acc[3] += w * bfhi(u0.y); acc[4] += w * bflo(u0.z); acc[5] += w * bfhi(u0.z); acc[6] += w * bflo(u0.w); acc[7] += w * bfhi(u0.w);
        acc[8] += w * bflo(u1.x); acc[9] += w * bfhi(u1.x); acc[10] += w * bflo(u1.y); acc[11] += w * bfhi(u1.y); acc[12] += w * bflo(u1.z); acc[13] += w * bfhi(u1.z); acc[14] += w * bflo(u1.w); acc[15] += w * bfhi(u1.w);
    }
    float s2 = 0.f;
#pragma unroll
    for (int i = 0; i < 16; ++i) { acc[i] += xr[i]; s2 += acc[i] * acc[i]; }
    const float rstd3 = 1.0f / sqrtf(wave_sum(s2) * (1.0f / D) + RMS_EPS);
    { GAS f32x4* op = (GAS f32x4*)(xio + (size_t)tok * D); const GAS f32x4* gp = (const GAS f32x4*)fgain;
#pragma unroll
      for (int j = 0; j < 2; ++j) { const f32x4 g0 = gp[2 * lane + 128 * j], g1 = gp[2 * lane + 128 * j + 1];
        f32x4 a, b; a.x = acc[8 * j + 0] * rstd3 * g0.x; a.y = acc[8 * j + 1] * rstd3 * g0.y; a.z = acc[8 * j + 2] * rstd3 * g0.z; a.w = acc[8 * j + 3] * rstd3 * g0.w;
        b.x = acc[8 * j + 4] * rstd3 * g1.x; b.y = acc[8 * j + 5] * rstd3 * g1.y; b.z = acc[8 * j + 6] * rstd3 * g1.z; b.w = acc[8 * j + 7] * rstd3 * g1.w;
        op[2 * lane + 128 * j] = a; op[2 * lane + 128 * j + 1] = b; } }
    LDS_WAIT();
}

struct Args { const float* in[14]; float* out; unsigned char* ws; int ph_lo, ph_hi, li, pad; };
__global__ void __launch_bounds__(NWAVES * 64, 2) hybrid_fwd(Args args) {
    extern __shared__ __attribute__((aligned(16))) unsigned char lds[];
    LAS unsigned char* ldsb = (LAS unsigned char*)lds;
    volatile LAS unsigned* MISC = (volatile LAS unsigned*)(ldsb + MISC_OFF);
    const int tid = threadIdx.x, lane = tid & 63, wave = __builtin_amdgcn_readfirstlane(tid >> 6);
    const int G = gridDim.x; const int bx = blockIdx.x; const int vcu = (G % 8 == 0) ? (bx % 8) * (G / 8) + bx / 8 : bx;
    const int gw = vcu * NWAVES + wave, NGW = G * NWAVES;
    unsigned char* ws = args.ws;
    gu32* ctl = (gu32*)(ws + WS_CTL);
    const float* x = args.in[0]; const float* norm_mix = args.in[1]; const float* w_in = args.in[2]; const float* conv_w = args.in[3]; const float* conv_b = args.in[4];
    const float* w_a = args.in[5]; const float* w_b = args.in[6]; const float* w_o = args.in[7]; const float* norm_ffn = args.in[8]; const float* w_q = args.in[9];
    const float* sub_keys = args.in[10]; const float* exp_u = args.in[11]; const float* exp_v = args.in[12]; const float* final_norm = args.in[13];
    float* out = args.out;
    bf16* Weff = (bf16*)(ws + WS_WEFF); bf16* Wab = (bf16*)(ws + WS_WAB); bf16* Wo_t = (bf16*)(ws + WS_WO); bf16* Win_t = (bf16*)(ws + WS_WIN);
    bf16* XB = (bf16*)(ws + WS_XB); bf16* SIX = (bf16*)(ws + WS_SIX); bf16* VT = (bf16*)(ws + WS_VT); bf16* GATE = (bf16*)(ws + WS_GATE); bf16* MERGED = (bf16*)(ws + WS_MERGED);
    bf16* X1B = (bf16*)(ws + WS_X1B); bf16* TU = (bf16*)(ws + WS_TU); bf16* TV = (bf16*)(ws + WS_TV); float* SCORES = (float*)(ws + WS_SCORES); float* RSTD1 = (float*)(ws + WS_RSTD1);
    bf16* QB = SIX; bf16* CBB = SIX + (size_t)1 * M * 512; bf16* KB = SIX + (size_t)2 * M * 512; bf16* CCB = SIX + (size_t)4 * M * 512; bf16* CUB = SIX + (size_t)5 * M * 512;

    for (int u = tid; u < (LDS_BYTES - LDSCTL_OFF) / 4; u += NWAVES * 64) ((LAS unsigned*)(ldsb + LDSCTL_OFF))[u] = 0u;
    __syncthreads();
    XcdBarrier bar; bar.bar = (unsigned*)(ctl + CW_BAR); bar.x = 0; bar.st = nullptr;
    if (N_LAUNCHES == 1) bar = xcd_barrier_post((unsigned*)(ctl + CW_BAR), MISC + 8);
#define GRID_BAR() do { if (N_LAUNCHES == 1) xcd_barrier(bar); } while (0)
    const int lo = args.ph_lo, hi = args.ph_hi;
#define IN(k) (lo <= (k) && (k) < hi)
#define BOTH(k) (IN(k) && IN((k) + 1))

    if (IN(0)) {
        LAS float* scr = (LAS float*)(ldsb + RING_OFF + wave * 16384);
        constexpr int I_IN = (D / 64) * (NIN / 32), I_A = (512 / 64) * (D / 32), I_O = (D / 64) * (D / 32);
        constexpr int NITEMS = I_IN + 2 * I_A + I_O;
        for (int it = gw; it < NITEMS; it += NGW) {
            int r = it;
            if (r < I_IN) { p0_transpose_item(w_in, D, NIN, Win_t, 0, norm_mix, scr, r, lane); continue; } r -= I_IN;
            if (r < I_A) { p0_transpose_item(w_a, 512, D, Wab, 0, nullptr, scr, r, lane); continue; } r -= I_A;
            if (r < I_A) { p0_transpose_item(w_b, 512, D, Wab, 1024, nullptr, scr, r, lane); continue; } r -= I_A;
            p0_transpose_item(w_o, D, D, Wo_t, 0, nullptr, scr, r, lane);
        }
        for (int wt = gw; wt < 32 * 256; wt += NGW) {
            const int n0 = (wt & 31) * 64, k0 = (wt >> 5) * 4, n = n0 + lane, hp = n >> 7;
            const GAS f32x4* kr = (const GAS f32x4*)(sub_keys + (size_t)n * 128);
            float a0 = 0.f, a1 = 0.f, a2 = 0.f, a3 = 0.f;
#pragma unroll 4
            for (int c4 = 0; c4 < 32; ++c4) {
                const f32x4 kv = kr[c4];
                const f32x4 w0 = *(const GAS f32x4*)(w_q + (size_t)(k0 + 0) * 2048 + hp * 128 + 4 * c4), w1 = *(const GAS f32x4*)(w_q + (size_t)(k0 + 1) * 2048 + hp * 128 + 4 * c4);
                const f32x4 w2 = *(const GAS f32x4*)(w_q + (size_t)(k0 + 2) * 2048 + hp * 128 + 4 * c4), w3 = *(const GAS f32x4*)(w_q + (size_t)(k0 + 3) * 2048 + hp * 128 + 4 * c4);
                a0 += kv.x * w0.x + kv.y * w0.y + kv.z * w0.z + kv.w * w0.w; a1 += kv.x * w1.x + kv.y * w1.y + kv.z * w1.z + kv.w * w1.w;
                a2 += kv.x * w2.x + kv.y * w2.y + kv.z * w2.z + kv.w * w2.w; a3 += kv.x * w3.x + kv.y * w3.y + kv.z * w3.z + kv.w * w3.w;
            }
            v2u o; o.x = pk2(a0 * norm_ffn[k0], a1 * norm_ffn[k0 + 1]); o.y = pk2(a2 * norm_ffn[k0 + 2], a3 * norm_ffn[k0 + 3]);
            *(GAS v2u*)(Weff + (size_t)n * D + k0) = o;
        }
        for (int m = gw; m < M; m += NGW) {
            const GAS f32x4* xr = (const GAS f32x4*)(x + (size_t)m * D) + lane;
            f32x4 v[4]; float s = 0.f;
#pragma unroll
            for (int j = 0; j < 4; ++j) { v[j] = xr[64 * j]; s += (v[j].x * v[j].x + v[j].y * v[j].y) + (v[j].z * v[j].z + v[j].w * v[j].w); }
            const float rstd = 1.0f / sqrtf(wave_sum(s) * (1.0f / D) + RMS_EPS);
            GAS v2u* o8 = (GAS v2u*)(XB + (size_t)m * D) + lane;
#pragma unroll
            for (int j = 0; j < 4; ++j) { v2u o; o.x = pk2(v[j].x, v[j].y); o.y = pk2(v[j].z, v[j].w); o8[64 * j] = o; }
            if (lane == 0) RSTD1[m] = rstd;
        }
        if (BOTH(0)) GRID_BAR();
    }

    if (IN(1)) {
        pg8::Gemm g{XB, Win_t, M, NIN, D}; pg8::StaticOrder S; S.init(M, NIN, G, (int)blockIdx.x);
        pg8::EpiProj E{SIX, VT, GATE, RSTD1};
        pg8::gemm_phase<pg8::EpiProj, pg8::StaticOrder, true, true>(ldsb + RING_OFF, g, S, E);
        if (BOTH(1)) GRID_BAR();
    }

    if (IN(2)) {
        conv_phase(CBB, CCB, CUB, conv_w, conv_b, gw * 64 + lane, NGW * 64);
        for (int it = gw; it < BATCH * NH * (T / 32); it += NGW) {
            const int bh = it >> 7, qblk = it & 127;
            attn_item(QB, KB, VT, QB, bh >> 3, bh & 7, qblk, lane);
        }
        if (BOTH(2)) GRID_BAR();
    }

    if (IN(3)) {
        pg8::Gemm g{QB, Wab, 2 * M, 2048, 512}; pg8::PairOrder S; S.init(G, (int)blockIdx.x);
        pg8::EpiGate E{out, MERGED, GATE, GATE + (size_t)M * 1024};
        pg8::gemm_phase<pg8::EpiGate, pg8::PairOrder, true, true>(ldsb + RING_OFF, g, S, E);
        if (BOTH(3)) GRID_BAR();
    }

    if (IN(4)) {
        pg8::Gemm g{MERGED, Wo_t, M, D, D}; pg8::StaticOrder S; S.init(M, D, G, (int)blockIdx.x);
        pg8::EpiWo E{x, out, X1B};
        pg8::gemm_phase<pg8::EpiWo, pg8::StaticOrder, false, true>(ldsb + RING_OFF, g, S, E);
        const int gt = gw * 64 + lane, NT = NGW * 64;
        for (int i = gt; i < NEXP * D / 8; i += NT) {
            const int k8 = (i & 127) * 8;
            const f32x4 a = *(const GAS f32x4*)(exp_u + (size_t)i * 8), b = *(const GAS f32x4*)(exp_u + (size_t)i * 8 + 4);
            const f32x4 ga = *(const GAS f32x4*)(norm_ffn + k8), gb = *(const GAS f32x4*)(norm_ffn + k8 + 4);
            v4u o; o.x = pk2(a.x * ga.x, a.y * ga.y); o.y = pk2(a.z * ga.z, a.w * ga.w); o.z = pk2(b.x * gb.x, b.y * gb.y); o.w = pk2(b.z * gb.z, b.w * gb.w);
            *(GAS v4u*)(TU + (size_t)i * 8) = o;
            const f32x4 c = *(const GAS f32x4*)(exp_v + (size_t)i * 8), d = *(const GAS f32x4*)(exp_v + (size_t)i * 8 + 4);
            v4u p; p.x = pk2(c.x, c.y); p.y = pk2(c.z, c.w); p.z = pk2(d.x, d.y); p.w = pk2(d.z, d.w);
            *(GAS v4u*)(TV + (size_t)i * 8) = p;
        }
        if (BOTH(4)) GRID_BAR();
    }

    if (IN(5)) {
        pg8::Gemm g{X1B, Weff, M, 2048, D}; pg8::StaticOrder S; S.init(M, 2048, G, (int)blockIdx.x);
        pg8::EpiScores E{SCORES};
        pg8::gemm_phase<pg8::EpiScores, pg8::StaticOrder, true, true>(ldsb + RING_OFF, g, S, E);
        if (BOTH(5)) GRID_BAR();
    }

    if (IN(6)) {
        LAS unsigned char* scr = ldsb + RING_OFF + wave * 4096;
        for (int tok = gw; tok < M; tok += NGW) peer_token(tok, SCORES, out, TU, TV, final_norm, scr, lane);
    }
#undef IN
#undef BOTH
#undef GRID_BAR
}

extern "C" void kernel_launch(void* const* d_in, const int* in_sizes, int n_in, void* d_out, int out_size, void* d_ws, size_t ws_size, hipStream_t stream) {
    static int grid = 0;
    if (grid == 0) {
        if (n_in != 14 || in_sizes[0] != M * D || out_size != M * D || ws_size < WS_END) { fprintf(stderr, "kernel_launch: built for 14 inputs, x/out of %d floats, >= %zu bytes of workspace; got n_in %d, in0 %d, out %d, ws %zu; nothing launched\n", M * D, (size_t)WS_END, n_in, n_in > 0 ? in_sizes[0] : -1, out_size, ws_size); grid = -1; return; }
        int dev = 0, cus = 0, per_cu = 0;
        if (hipGetDevice(&dev) != hipSuccess || hipDeviceGetAttribute(&cus, hipDeviceAttributeMultiprocessorCount, dev) != hipSuccess) { fprintf(stderr, "kernel_launch: device query failed\n"); grid = -1; return; }
        if (hipFuncSetAttribute((const void*)hybrid_fwd, hipFuncAttributeMaxDynamicSharedMemorySize, LDS_BYTES) != hipSuccess) { fprintf(stderr, "kernel_launch: hipFuncSetAttribute failed\n"); grid = -1; return; }
        if (hipOccupancyMaxActiveBlocksPerMultiprocessor(&per_cu, (const void*)hybrid_fwd, NWAVES * 64, LDS_BYTES) != hipSuccess || per_cu < 1) { fprintf(stderr, "kernel_launch: occupancy query reports %d workgroups per CU\n", per_cu); per_cu = 1; }
        (void)hipGetLastError();
        grid = cus;
    }
    if (grid < 0) return;
    if (hipMemsetAsync((char*)d_ws + WS_CTL, 0, CTL_ZERO_BYTES, stream) != hipSuccess) { fprintf(stderr, "kernel_launch: hipMemsetAsync failed\n"); return; }
    Args a{};
    for (int i = 0; i < 14; ++i) a.in[i] = (const float*)d_in[i];
    a.out = (float*)d_out; a.ws = (unsigned char*)d_ws;
    for (int li = 0; li < N_LAUNCHES; ++li) {
        a.ph_lo = (N_LAUNCHES == 1) ? 0 : li; a.ph_hi = (N_LAUNCHES == 1) ? N_PHASES : li + 1; a.li = li;
        hipLaunchKernelGGL(hybrid_fwd, dim3(grid), dim3(NWAVES * 64), LDS_BYTES, stream, a);
        const hipError_t le = hipPeekAtLastError();
        if (le != hipSuccess) { fprintf(stderr, "kernel_launch: launch %d failed: %s\n", li, hipGetErrorName(le)); break; }
    }
}
```

```cpp
#define DUP_MASK 0
#include <hip/hip_runtime.h>
#include <cstdio>
#include <cstdint>
#include <cmath>
namespace pg8 {
#define PG8_LAS __attribute__((address_space(3)))
typedef unsigned short bf16_t;
typedef short bf16x8 __attribute__((ext_vector_type(8)));
typedef float f32x4 __attribute__((ext_vector_type(4)));
typedef unsigned u32x4 __attribute__((ext_vector_type(4)));
constexpr int BM = 256, BK = 64, HALF = 128, HTB = HALF * BK * 2  , STAGE_BYTES = 8 * HTB, NXCD = 8, WGM = 8;

__host__ __device__ __forceinline__ int lds_byte(int r, int c) { const int st = (r >> 4) * 2 + (c >> 5), rr = r & 15, cc = c & 31, ob = rr * 64 + cc * 2; return st * 1024 + (ob ^ (((ob >> 9) & 1) << 5)); }
__host__ __device__ __forceinline__ void stage_rc(int b, int& R, int& C) { const int st = b / 1024, sb = b % 1024, swz = sb ^ (((sb >> 9) & 1) << 5); R = (st >> 1) * 16 + swz / 64; C = (st & 1) * 32 + (swz % 64) / 2; }
__host__ __device__ __forceinline__ int perm32(int rho) { const int n = rho >> 4, i = rho & 15; return 8 * (i >> 2) + 4 * n + (i & 3); }

struct Unit { int pm, pn; };
struct Gemm { const bf16_t* A; const bf16_t* Bt; int M, N, K; };

struct StaticOrder {
    int nM, nN, nwg, G, c;
    __host__ __device__ void init(int M, int N, int G_, int c_) { nM = M / BM; nN = N / BM; nwg = nM * nN; G = G_; c = c_; }
    __host__ __device__ bool next(int i, Unit& u) const {
        const long L = (long)i * G + c; if (L >= nwg) return false;
        int wgid = (int)L; { const int q = nwg / NXCD, r = nwg % NXCD, xcd = wgid % NXCD, off = wgid / NXCD; wgid = (xcd < r ? xcd * (q + 1) : r * (q + 1) + (xcd - r) * q) + off; }
        const int nig = WGM * nN, gid = wgid / nig, fm = gid * WGM, gsz = (nM - fm) < WGM ? (nM - fm) : WGM;
        u.pm = fm + ((wgid % nig) % gsz); u.pn = (wgid % nig) / gsz; return true;
    }
    __device__ __forceinline__ void a_ready(const Unit&) const {}
    __device__ __forceinline__ void done(const Unit&) const {}
};

__device__ __forceinline__ unsigned cvt_pk_bf16(float lo, float hi) { unsigned r; asm volatile("v_cvt_pk_bf16_f32 %0, %1, %2" : "=v"(r) : "v"(lo), "v"(hi)); return r; }
constexpr int MTOK = 16384;
__device__ __forceinline__ unsigned f2bf_rne(float f) { unsigned u = __builtin_bit_cast(unsigned, f); return (u + 0x7fffu + ((u >> 16) & 1u)) >> 16; }
__device__ __forceinline__ float bf_lo(unsigned w) { return __builtin_bit_cast(float, w << 16); }
__device__ __forceinline__ float bf_hi(unsigned w) { return __builtin_bit_cast(float, w & 0xffff0000u); }
__device__ __forceinline__ float sigmoid_fast(float x) { return __builtin_amdgcn_rcpf(1.0f + __builtin_amdgcn_exp2f(-1.4426950408889634f * x)); }

struct EpiProj {
    static constexpr bool PERM = true, AFTER_DRAIN = false;
    bf16_t* six;
    bf16_t* vt;
    bf16_t* gate;
    const float* rstd; int skip;
    __device__ __forceinline__ void operator()(const f32x4 (&acc)[2][2][4][2], const Unit& u, int wr, int wc, int fr, int fq) const {
        const int row0 = u.pm * BM + wr * 64 + fr; const int colt = u.pn * BM;
        if (skip) return;
        if (colt < 3072) {
            const int t = colt >> 9, cc = colt & 511;
            if (t == 2) {
#pragma unroll
                for (int ai = 0; ai < 2; ++ai)
#pragma unroll
                    for (int m = 0; m < 4; ++m) { const int r = row0 + ai * HALF + m * 16; const float rs = rstd[r]; const int b = r >> 12, tt = r & 4095;
#pragma unroll
                        for (int bj = 0; bj < 2; ++bj) { const int c0 = cc + bj * HALF + wc * 32 + 8 * fq; const int hh = c0 >> 6, d0 = c0 & 63;
                            bf16_t* p = vt + ((size_t)((b * 8 + hh) * 64 + d0)) * 4096 + tt;
#pragma unroll
                            for (int n = 0; n < 2; ++n)
#pragma unroll
                                for (int i = 0; i < 4; ++i) p[(size_t)(4 * n + i) * 4096] = (bf16_t)f2bf_rne(acc[ai][bj][m][n][i] * rs); } }
            } else {
                const int bufidx = (t == 0) ? 0 : (t == 1) ? 2 : (t == 3) ? 1 : t;
                bf16_t* base = six + (size_t)bufidx * MTOK * 512; const float sc = (t == 0) ? 0.125f : 1.0f;
                const int col0 = cc + wc * 32 + 8 * fq;
#pragma unroll
                for (int ai = 0; ai < 2; ++ai)
#pragma unroll
                    for (int m = 0; m < 4; ++m) { const int r = row0 + ai * HALF + m * 16; const float rs = rstd[r] * sc; bf16_t* rowp = base + (size_t)r * 512 + col0;
#pragma unroll
                        for (int bj = 0; bj < 2; ++bj) { const f32x4 v0 = acc[ai][bj][m][0] * rs, v1 = acc[ai][bj][m][1] * rs;
                            u32x4 w; w.x = cvt_pk_bf16(v0[0], v0[1]); w.y = cvt_pk_bf16(v0[2], v0[3]); w.z = cvt_pk_bf16(v1[0], v1[1]); w.w = cvt_pk_bf16(v1[2], v1[3]);
                            *(u32x4*)(rowp + bj * HALF) = w; } }
            }
        } else {
            const int gi = (colt - 3072) >> 10, cc = (colt - 3072) & 1023;
            bf16_t* base = gate + (size_t)gi * MTOK * 1024; const int col0 = cc + wc * 32 + 8 * fq;
#pragma unroll
            for (int ai = 0; ai < 2; ++ai)
#pragma unroll
                for (int m = 0; m < 4; ++m) { const int r = row0 + ai * HALF + m * 16; const float rs = rstd[r]; bf16_t* rowp = base + (size_t)r * 1024 + col0;
#pragma unroll
                    for (int bj = 0; bj < 2; ++bj) { f32x4 v0 = acc[ai][bj][m][0] * rs, v1 = acc[ai][bj][m][1] * rs;
#pragma unroll
                        for (int i = 0; i < 4; ++i) { v0[i] = sigmoid_fast(v0[i]); v1[i] = sigmoid_fast(v1[i]); }
                        u32x4 w; w.x = cvt_pk_bf16(v0[0], v0[1]); w.y = cvt_pk_bf16(v0[2], v0[3]); w.z = cvt_pk_bf16(v1[0], v1[1]); w.w = cvt_pk_bf16(v1[2], v1[3]);
                        *(u32x4*)(rowp + bj * HALF) = w; } }
        }
    }
};

struct EpiGate {
    static constexpr bool PERM = true, AFTER_DRAIN = false;
    float* P; bf16_t* merged; const bf16_t* g0; const bf16_t* g1;
    __device__ __forceinline__ void operator()(const f32x4 (&acc)[2][2][4][2], const Unit& u, int wr, int wc, int fr, int fq) const {
        const int which = (u.pm >= 64) ? 1 : 0; const int pm = u.pm - 64 * which, pn = u.pn - 4 * which;
        const int row0 = pm * BM + wr * 64 + fr, col0 = pn * BM + wc * 32 + 8 * fq; const bf16_t* g = which ? g1 : g0;
#pragma unroll
        for (int ai = 0; ai < 2; ++ai)
#pragma unroll
            for (int m = 0; m < 4; ++m) { const int r = row0 + ai * HALF + m * 16;
#pragma unroll
                for (int bj = 0; bj < 2; ++bj) { const size_t off = (size_t)r * 1024 + col0 + bj * HALF;
                    const u32x4 gv = *(const u32x4*)(g + off);
                    f32x4 a0 = acc[ai][bj][m][0], a1 = acc[ai][bj][m][1];
                    a0[0] *= bf_lo(gv.x); a0[1] *= bf_hi(gv.x); a0[2] *= bf_lo(gv.y); a0[3] *= bf_hi(gv.y);
                    a1[0] *= bf_lo(gv.z); a1[1] *= bf_hi(gv.z); a1[2] *= bf_lo(gv.w); a1[3] *= bf_hi(gv.w);
                    if (!which) { u32x4 w; w.x = cvt_pk_bf16(a0[0], a0[1]); w.y = cvt_pk_bf16(a0[2], a0[3]); w.z = cvt_pk_bf16(a1[0], a1[1]); w.w = cvt_pk_bf16(a1[2], a1[3]); *(u32x4*)((bf16_t*)P + off) = w; }
                    else { const u32x4 pw = *(const u32x4*)((const bf16_t*)P + off);
                        a0[0] += bf_lo(pw.x); a0[1] += bf_hi(pw.x); a0[2] += bf_lo(pw.y); a0[3] += bf_hi(pw.y); a1[0] += bf_lo(pw.z); a1[1] += bf_hi(pw.z); a1[2] += bf_lo(pw.w); a1[3] += bf_hi(pw.w);
                        u32x4 w; w.x = cvt_pk_bf16(a0[0], a0[1]); w.y = cvt_pk_bf16(a0[2], a0[3]); w.z = cvt_pk_bf16(a1[0], a1[1]); w.w = cvt_pk_bf16(a1[2], a1[3]);
                        *(u32x4*)(merged + off) = w; } } }
    }
};
struct PairOrder {
    StaticOrder so;
    __host__ __device__ void init(int G_, int c_) { so.init(MTOK, 1024, G_, c_); }
    __host__ __device__ bool next(int i, Unit& u) const { Unit t; if (!so.next(i >> 1, t)) return false; const int w = i & 1; u.pm = t.pm + 64 * w; u.pn = t.pn + 4 * w; return true; }
    __device__ __forceinline__ void a_ready(const Unit&) const {}
    __device__ __forceinline__ void done(const Unit&) const {}
};

struct EpiWo {
    static constexpr bool PERM = true, AFTER_DRAIN = false;
    const float* x; float* x1; bf16_t* x1b;
    __device__ __forceinline__ void operator()(const f32x4 (&acc)[2][2][4][2], const Unit& u, int wr, int wc, int fr, int fq) const {
        const int row0 = u.pm * BM + wr * 64 + fr, col0 = u.pn * BM + wc * 32 + 8 * fq;
#pragma unroll
        for (int ai = 0; ai < 2; ++ai)
#pragma unroll
            for (int m = 0; m < 4; ++m) { const int r = row0 + ai * HALF + m * 16;
#pragma unroll
                for (int bj = 0; bj < 2; ++bj) { const size_t off = (size_t)r * 1024 + col0 + bj * HALF;
                    const f32x4 a0 = acc[ai][bj][m][0] + *(const f32x4*)(x + off), a1 = acc[ai][bj][m][1] + *(const f32x4*)(x + off + 4);
                    *(f32x4*)(x1 + off) = a0; *(f32x4*)(x1 + off + 4) = a1;
                    u32x4 w; w.x = cvt_pk_bf16(a0[0], a0[1]); w.y = cvt_pk_bf16(a0[2], a0[3]); w.z = cvt_pk_bf16(a1[0], a1[1]); w.w = cvt_pk_bf16(a1[2], a1[3]);
                    *(u32x4*)(x1b + off) = w; } }
    }
};
typedef _Float16 f16x2_t __attribute__((ext_vector_type(2)));
typedef float f32x2e __attribute__((ext_vector_type(2)));
__device__ __forceinline__ unsigned pk_f16(float lo, float hi) { f32x2e v = {lo, hi}; f16x2_t h = __builtin_convertvector(v, f16x2_t); return __builtin_bit_cast(unsigned, h); }
struct EpiScores {
    static constexpr bool PERM = true, AFTER_DRAIN = false;
    unsigned short* S;
    __device__ __forceinline__ void operator()(const f32x4 (&acc)[2][2][4][2], const Unit& u, int wr, int wc, int fr, int fq) const {
        const int row0 = u.pm * BM + wr * 64 + fr, col0 = u.pn * BM + wc * 32 + 8 * fq;
#pragma unroll
        for (int ai = 0; ai < 2; ++ai)
#pragma unroll
            for (int m = 0; m < 4; ++m) { const int r = row0 + ai * HALF + m * 16;
#pragma unroll
                for (int bj = 0; bj < 2; ++bj) { const size_t off = ((size_t)((col0 + bj * HALF) >> 3) * MTOK + r) * 8;
                    const f32x4 a0 = acc[ai][bj][m][0], a1 = acc[ai][bj][m][1];
                    u32x4 w; w.x = pk_f16(a0[0], a0[1]); w.y = pk_f16(a0[2], a0[3]); w.z = pk_f16(a1[0], a1[1]); w.w = pk_f16(a1[2], a1[3]);
                    *(u32x4*)(S + off) = w; } }
    }
};
template <class Epi, class Sched, bool ALIGN_EPI = false, bool SP2 = false>
__device__ __forceinline__ void gemm_phase(PG8_LAS unsigned char* lds, const Gemm g, const Sched& S, const Epi& E) {
    const int tid = threadIdx.x, wid = __builtin_amdgcn_readfirstlane(tid >> 6), lane = tid & 63, wr = wid >> 2, wc = wid & 3, fr = lane & 15, fq = lane >> 4;
    const int K = g.K, nt = K / BK;
    unsigned voffA[2], voffB[2];
#pragma unroll
    for (int i = 0; i < 2; ++i) { int R, C; stage_rc(tid * 16 + i * 8192, R, C); const int Rb = Epi::PERM ? ((R & ~31) + perm32(R & 31)) : R;
        voffA[i] = (unsigned)(R * K + C) * 2u; voffB[i] = (unsigned)(Rb * K + C) * 2u; }
    const size_t kstep = (size_t)(BK * 2);
    const size_t hstep = (size_t)HALF * K * 2;
    const size_t tstep = 2 * hstep;
    const unsigned ldsw = (unsigned)wid * 1024u;
    const int aoff = lds_byte(wr * 64 + fr, fq * 8), boff = lds_byte(wc * 32 + fr, fq * 8);
#define PG8_SA(b, h) (((b) * 2 + (h)) * HTB)
#define PG8_SB(b, h) ((4 + (b) * 2 + (h)) * HTB)
#define PG8_STAGE(bufoff, gbase, voff) do { _Pragma("unroll") for (int _i = 0; _i < 2; ++_i) \
        __builtin_amdgcn_global_load_lds((const unsigned*)((const char*)(gbase) + (voff)[_i]), (PG8_LAS unsigned*)(lds + (bufoff) + ldsw + _i * 8192), 16, 0, 0); } while (0)
#define PG8_LDA(dst, b, h) do { _Pragma("unroll") for (int m = 0; m < 4; ++m) _Pragma("unroll") for (int k = 0; k < 2; ++k) dst[m][k] = *(const PG8_LAS bf16x8*)(lds + PG8_SA(b, h) + aoff + m * 2048 + k * 1024); } while (0)
#define PG8_LDB(dst, b, h) do { _Pragma("unroll") for (int n = 0; n < 2; ++n) _Pragma("unroll") for (int k = 0; k < 2; ++k) dst[n][k] = *(const PG8_LAS bf16x8*)(lds + PG8_SB(b, h) + boff + n * 2048 + k * 1024); } while (0)
#define PG8_MMA(ai, bj, At, Bt) do { __builtin_amdgcn_s_setprio(1); _Pragma("unroll") for (int m = 0; m < 4; ++m) _Pragma("unroll") for (int n = 0; n < 2; ++n) _Pragma("unroll") for (int k = 0; k < 2; ++k) \
        acc[ai][bj][m][n] = __builtin_amdgcn_mfma_f32_16x16x32_bf16(Bt[n][k], At[m][k], acc[ai][bj][m][n], 0, 0, 0); __builtin_amdgcn_s_setprio(0); } while (0)
#define PG8_WAIT_V(n) asm volatile("s_waitcnt vmcnt(" #n ")" ::: "memory")
#define PG8_WAIT_L(n) asm volatile("s_waitcnt lgkmcnt(" #n ")" ::: "memory")
#define PG8_BAR __builtin_amdgcn_s_barrier()
#define PG8_SCHED __builtin_amdgcn_sched_barrier(0)
    Unit cur, nxt; int ui = 0;
    if (!S.next(0, cur)) return;
    f32x4 acc[2][2][4][2];
#pragma unroll
    for (int a = 0; a < 2; ++a)
#pragma unroll
        for (int b = 0; b < 2; ++b)
#pragma unroll
            for (int m = 0; m < 4; ++m)
#pragma unroll
                for (int n = 0; n < 2; ++n) acc[a][b][m][n] = (f32x4){0.f, 0.f, 0.f, 0.f};
    bf16x8 At[4][2], B0[2][2], B1[2][2];
    const char* cA = (const char*)g.A + (size_t)cur.pm * tstep; const char* cB = (const char*)g.Bt + (size_t)cur.pn * tstep;
    S.a_ready(cur);
    if constexpr (SP2) {
        PG8_STAGE(PG8_SB(0, 0), cB, voffB); PG8_STAGE(PG8_SB(0, 1), cB + hstep, voffB); PG8_STAGE(PG8_SA(0, 0), cA, voffA); PG8_STAGE(PG8_SA(0, 1), cA + hstep, voffA);
        if (wr == 1) PG8_BAR;
        PG8_WAIT_V(2); PG8_BAR;
        PG8_STAGE(PG8_SB(1, 0), cB + kstep, voffB); PG8_STAGE(PG8_SA(1, 0), cA + kstep, voffA); PG8_STAGE(PG8_SB(1, 1), cB + hstep + kstep, voffB);
        PG8_WAIT_V(6); PG8_BAR;
    } else {
        PG8_STAGE(PG8_SB(0, 0), cB, voffB); PG8_STAGE(PG8_SA(0, 0), cA, voffA); PG8_STAGE(PG8_SB(0, 1), cB + hstep, voffB); PG8_STAGE(PG8_SA(0, 1), cA + hstep, voffA);
        if (wr == 1) PG8_BAR;
        PG8_WAIT_V(4); PG8_BAR;
        PG8_STAGE(PG8_SB(1, 0), cB + kstep, voffB); PG8_STAGE(PG8_SA(1, 0), cA + kstep, voffA); PG8_STAGE(PG8_SB(1, 1), cB + hstep + kstep, voffB);
        PG8_WAIT_V(6); PG8_BAR;
    }
    for (;;) {
        const bool has_next = S.next(ui + 1, nxt);
        const char* nA = has_next ? (const char*)g.A + (size_t)nxt.pm * tstep : cA; const char* nB = has_next ? (const char*)g.Bt + (size_t)nxt.pn * tstep : cB;
        for (int t = 0; t < nt; t += 2) {
            const bool last = (t == nt - 2);
            const char* a1 = cA + (size_t)(t + 1) * kstep;
            const char* a2 = last ? nA : cA + (size_t)(t + 2) * kstep; const char* b2 = last ? nB : cB + (size_t)(t + 2) * kstep;
            const char* a3 = a2 + kstep; const char* b3 = b2 + kstep;
            if (last && has_next) S.a_ready(nxt);
            if constexpr (SP2) {
            PG8_LDB(B0, 0, 0); PG8_LDB(B1, 0, 1); PG8_SCHED; PG8_LDA(At, 0, 0); PG8_STAGE(PG8_SA(1, 1), a1 + hstep, voffA);
            PG8_WAIT_V(8); PG8_WAIT_L(0); PG8_BAR; PG8_MMA(0, 0, At, B0); PG8_MMA(0, 1, At, B1); PG8_BAR; PG8_SCHED;
            PG8_LDA(At, 0, 1); PG8_STAGE(PG8_SB(0, 0), b2, voffB); PG8_STAGE(PG8_SB(0, 1), b2 + hstep, voffB); PG8_STAGE(PG8_SA(0, 0), a2, voffA);
            PG8_WAIT_V(8); PG8_WAIT_L(0); PG8_BAR; PG8_MMA(1, 0, At, B0); PG8_MMA(1, 1, At, B1); PG8_BAR; PG8_SCHED;
            PG8_LDB(B0, 1, 0); PG8_LDB(B1, 1, 1); PG8_SCHED; PG8_LDA(At, 1, 0); PG8_STAGE(PG8_SA(0, 1), a2 + hstep, voffA);
            PG8_WAIT_V(8); PG8_WAIT_L(0); PG8_BAR; PG8_MMA(0, 0, At, B0); PG8_MMA(0, 1, At, B1); PG8_BAR; PG8_SCHED;
            PG8_LDA(At, 1, 1); PG8_STAGE(PG8_SB(1, 0), b3, voffB); PG8_STAGE(PG8_SB(1, 1), b3 + hstep, voffB); PG8_STAGE(PG8_SA(1, 0), a3, voffA);
            PG8_WAIT_V(8); PG8_WAIT_L(0); PG8_BAR; PG8_MMA(1, 0, At, B0); PG8_MMA(1, 1, At, B1); PG8_BAR; PG8_SCHED;
            } else {
            PG8_LDB(B0, 0, 0); PG8_SCHED; PG8_LDA(At, 0, 0); PG8_STAGE(PG8_SA(1, 1), a1 + hstep, voffA);
            PG8_WAIT_L(8); PG8_BAR; PG8_WAIT_L(0); PG8_MMA(0, 0, At, B0); PG8_BAR; PG8_SCHED;
            PG8_LDB(B1, 0, 1); PG8_STAGE(PG8_SB(0, 0), b2, voffB);
            PG8_BAR; PG8_WAIT_L(0); PG8_MMA(0, 1, At, B1); PG8_BAR;
            PG8_LDA(At, 0, 1); PG8_STAGE(PG8_SA(0, 0), a2, voffA);
            PG8_BAR; PG8_WAIT_L(0); PG8_MMA(1, 0, At, B0); PG8_BAR; PG8_SCHED;
            PG8_STAGE(PG8_SB(0, 1), b2 + hstep, voffB);
            PG8_WAIT_V(6); PG8_BAR; PG8_MMA(1, 1, At, B1); PG8_BAR;
            PG8_LDB(B0, 1, 0); PG8_SCHED; PG8_LDA(At, 1, 0); PG8_STAGE(PG8_SA(0, 1), a2 + hstep, voffA);
            PG8_WAIT_L(8); PG8_BAR; PG8_WAIT_L(0); PG8_MMA(0, 0, At, B0); PG8_BAR; PG8_SCHED;
            PG8_LDB(B1, 1, 1); PG8_STAGE(PG8_SB(1, 0), b3, voffB);
            PG8_BAR; PG8_WAIT_L(0); PG8_MMA(0, 1, At, B1); PG8_BAR;
            PG8_LDA(At, 1, 1); PG8_STAGE(PG8_SA(1, 0), a3, voffA);
            PG8_BAR; PG8_WAIT_L(0); PG8_MMA(1, 0, At, B0); PG8_BAR; PG8_SCHED;
            PG8_STAGE(PG8_SB(1, 1), b3 + hstep, voffB);
            PG8_WAIT_V(6); PG8_BAR; PG8_MMA(1, 1, At, B1); PG8_BAR;
            }
        }
        if constexpr (ALIGN_EPI) { if (wr == 0) PG8_BAR; }
        if constexpr (!Epi::AFTER_DRAIN) { E(acc, cur, wr, wc, fr, fq); S.done(cur); }
        if (!has_next) break;
#pragma unroll
        for (int a = 0; a < 2; ++a)
#pragma unroll
            for (int b = 0; b < 2; ++b)
#pragma unroll
                for (int m = 0; m < 4; ++m)
#pragma unroll
                    for (int n = 0; n < 2; ++n) acc[a][b][m][n] = (f32x4){0.f, 0.f, 0.f, 0.f};
        cur = nxt; cA = nA; cB = nB; ++ui;
        if constexpr (ALIGN_EPI) { if (wr == 1) PG8_BAR; }
    }
    PG8_WAIT_V(0);
    if constexpr (!ALIGN_EPI) { if (wr == 0) PG8_BAR; }
    PG8_BAR;
    if constexpr (Epi::AFTER_DRAIN) { E.fused(acc, cur, wr, wc, fr, fq, lds, wid, lane); S.done(cur); }
#undef PG8_SA
#undef PG8_SB
#undef PG8_STAGE
#undef PG8_LDA
#undef PG8_LDB
#undef PG8_MMA
#undef PG8_WAIT_V
#undef PG8_WAIT_L
#undef PG8_BAR
#undef PG8_SCHED
}
}

constexpr int NWAVES = 8;
constexpr int BATCH = 4, T = 4096, D = 1024, NH = 8, HD = 64, NIN = 5120;
constexpr int M = BATCH * T;
constexpr int NEXP = 16384;
constexpr float RMS_EPS = 1e-6f;
#ifndef MK_N_LAUNCHES
#define MK_N_LAUNCHES 1
#endif
constexpr int N_PHASES = 11;
constexpr int N_LAUNCHES = MK_N_LAUNCHES;

constexpr size_t MiB = 1u << 20;
constexpr size_t WS_CTL = 0, CTL_ZERO_BYTES = 64 * 1024;
constexpr size_t WS_RSTD1 = 512 * 1024;
constexpr size_t WS_WEFF = 1 * MiB;
constexpr size_t WS_WAB = 5 * MiB;
constexpr size_t WS_WO = 7 * MiB;
constexpr size_t WS_WIN = 9 * MiB;
constexpr size_t WS_XB = 19 * MiB;
constexpr size_t WS_SIX = 51 * MiB;
constexpr size_t WS_VT = WS_SIX + 3 * 16 * MiB;
constexpr size_t WS_GATE = 147 * MiB;
constexpr size_t WS_MERGED = 19 * MiB;
constexpr size_t WS_X1B = 51 * MiB;
constexpr size_t WS_TU = 211 * MiB, WS_TV = 227 * MiB;
constexpr size_t WS_SU = 576 * 1024, WS_SV = 640 * 1024;
constexpr size_t WS_SCORES = 83 * MiB;
constexpr size_t WS_ROUTE = 19 * MiB;
constexpr size_t WS_W = 35 * MiB;
constexpr size_t WS_SS = 43 * MiB;
constexpr size_t WS_UPART = 83 * MiB;
constexpr size_t WS_END = 256 * MiB;
constexpr int CW_BAR = 4096;

constexpr int RING_OFF = 0, RING_BYTES = 131072;
constexpr int LDSCTL_OFF = RING_BYTES;
constexpr int LDS_BYTES = 147456;
constexpr int MISC_OFF = LDS_BYTES - 128;

#define GAS __attribute__((address_space(1)))
#define LAS __attribute__((address_space(3)))
#define CAS __attribute__((address_space(4)))
typedef unsigned short bf16;
typedef unsigned v4u __attribute__((ext_vector_type(4)));
typedef unsigned v2u __attribute__((ext_vector_type(2)));
typedef float f32x4 __attribute__((ext_vector_type(4)));
typedef float f32x2 __attribute__((ext_vector_type(2)));
typedef float f32x16 __attribute__((ext_vector_type(16)));
typedef short bf16x8 __attribute__((ext_vector_type(8)));
typedef _Float16 f16x8 __attribute__((ext_vector_type(8)));
typedef _Float16 f16x2 __attribute__((ext_vector_type(2)));
typedef __bf16 bf16x2_t __attribute__((ext_vector_type(2)));
typedef GAS unsigned gu32;
#define RLX_AGENT __ATOMIC_RELAXED, __HIP_MEMORY_SCOPE_AGENT
#define LDS_WAIT() asm volatile("s_waitcnt lgkmcnt(0)" ::: "memory")
#define VM_WAIT() asm volatile("s_waitcnt vmcnt(0)" ::: "memory")
__device__ __forceinline__ unsigned f2bf(float f) { unsigned u = __builtin_bit_cast(unsigned, f); return (u + 0x7fffu + ((u >> 16) & 1u)) >> 16; }
__device__ __forceinline__ unsigned pk2(float lo, float hi) { return f2bf(lo) | (f2bf(hi) << 16); }
__device__ __forceinline__ unsigned cvtpk(float lo, float hi) { f32x2 v = {lo, hi}; bf16x2_t b = __builtin_convertvector(v, bf16x2_t); return __builtin_bit_cast(unsigned, b); }
__device__ __forceinline__ float bflo(unsigned w) { return __builtin_bit_cast(float, w << 16); }
__device__ __forceinline__ float bfhi(unsigned w) { return __builtin_bit_cast(float, w & 0xffff0000u); }
__device__ __forceinline__ float wave_sum(float v) {
#pragma unroll
    for (int o = 1; o < 64; o <<= 1) v += __shfl_xor(v, o);
    return v;
}
#define XB_TMO      128
#define XB_XCNT(j)  (256  + 64 * (j))
#define XB_XSUB(j)  (1280 + 64 * (j))
#define XB_XGEN(j)  (2304 + 64 * (j))
#define XB_TOP      3328
#define XB_TOPGEN   3392
#define XCD_BAR_WORDS 3456
#define XB_SPIN_CAP (1u << 18)

__device__ __forceinline__ unsigned xb_ld(unsigned* p)              { return __hip_atomic_load(p, __ATOMIC_RELAXED, __HIP_MEMORY_SCOPE_AGENT); }
__device__ __forceinline__ unsigned xb_add(unsigned* p, unsigned v) { return __hip_atomic_fetch_add(p, v, __ATOMIC_RELAXED, __HIP_MEMORY_SCOPE_AGENT); }
__device__ __forceinline__ unsigned xb_xcc_id() { return (unsigned)__builtin_amdgcn_s_getreg((3 << 11) | 20) & 0xFu; }
#define XB_SPIN(cond, bar) do { unsigned _sp = 0; while (cond) { __builtin_amdgcn_s_sleep(1); \
    if ((++_sp & 255u) == 0u) { if (xb_ld(&(bar)[XB_TMO])) break; if (_sp > XB_SPIN_CAP) { atomicAdd(&(bar)[XB_TMO], 1u); break; } } } } while (0)

struct XcdBarrier {
    unsigned* bar; unsigned x;
    volatile LAS unsigned* st;
};

__device__ __forceinline__ XcdBarrier xcd_barrier_post(unsigned* bar, volatile LAS unsigned* st) {
    XcdBarrier b; b.bar = bar; b.x = xb_xcc_id(); b.st = st;
    if (threadIdx.x == 0) (void)xb_add(&bar[XB_XCNT(b.x)], 1u);
    return b;
}
__device__ __forceinline__ void xcd_barrier_complete(unsigned* bar, unsigned x, unsigned& nloc, unsigned& nx) {
    const unsigned G = gridDim.x * gridDim.y * gridDim.z;
    unsigned sum, cnt, mine, sp = 0u;
    for (;;) {
        sum = 0u; cnt = 0u; mine = 0u;
#pragma unroll
        for (unsigned j = 0; j < 16; ++j) { const unsigned c = xb_ld(&bar[XB_XCNT(j)]); sum += c; cnt += (c > 0u) ? 1u : 0u; mine = (j == x) ? c : mine; }
        if (sum == G) break;
        __builtin_amdgcn_s_sleep(1);
        if ((++sp & 255u) == 0u) { if (xb_ld(&bar[XB_TMO])) break; if (sp > XB_SPIN_CAP) { atomicAdd(&bar[XB_TMO], 1u); break; } }
    }
    nloc = mine > 0u ? mine : 1u; nx = cnt > 0u ? cnt : 1u;
}

__device__ __forceinline__ void xcd_barrier(const XcdBarrier& b) {
    asm volatile("s_waitcnt vmcnt(0)" ::: "memory");
    __syncthreads();
    if (threadIdx.x == 0) {
        unsigned* bar = b.bar;
        __builtin_amdgcn_s_waitcnt(0);
        unsigned nloc = b.st[0], nx = b.st[1];
        if (nloc == 0u) { xcd_barrier_complete(bar, b.x, nloc, nx); b.st[0] = nloc; b.st[1] = nx; }
        const unsigned old = xb_add(&bar[XB_XSUB(b.x)], 1u);
        const unsigned gen = old / nloc;
        if (old + 1u == (gen + 1u) * nloc) {
            __builtin_amdgcn_fence(__ATOMIC_RELEASE, "agent");
            asm volatile("s_waitcnt vmcnt(0)" ::: "memory");
            const unsigned og = xb_add(&bar[XB_TOP], 1u);
            const unsigned tg = og / nx;
            if (og + 1u == (tg + 1u) * nx) xb_add(&bar[XB_TOPGEN], 1u);
            else XB_SPIN(xb_ld(&bar[XB_TOPGEN]) == tg, bar);
            __builtin_amdgcn_fence(__ATOMIC_ACQUIRE, "agent");
            xb_add(&bar[XB_XGEN(b.x)], 1u);
            asm volatile("s_waitcnt vmcnt(0)" ::: "memory");
        } else {
            XB_SPIN(xb_ld(&bar[XB_XGEN(b.x)]) == gen, bar);
            __builtin_amdgcn_fence(__ATOMIC_ACQUIRE, "agent");
            asm volatile("s_waitcnt vmcnt(0)" ::: "memory");
        }
    }
    __syncthreads();
}

__device__ __forceinline__ void p0_transpose_item(const float* W, int K, int N, bf16* WT, int row_off, const float* kscale, LAS float* scr, int item, int lane) {
    const int nblk = N / 32, kb = item / nblk, nb = item % nblk, k0 = 64 * kb, n0 = 32 * nb;
#pragma unroll 8
    for (int i = 0; i < 32; ++i) { const int kk = 2 * i + (lane >> 5); scr[kk * 33 + (lane & 31)] = W[(size_t)(k0 + kk) * N + n0 + (lane & 31)]; }
    LDS_WAIT(); asm volatile("" ::: "memory");
    const int c = lane & 7;
    float ks[8];
#pragma unroll
    for (int i = 0; i < 8; ++i) ks[i] = kscale ? kscale[k0 + 8 * c + i] : 1.0f;
#pragma unroll
    for (int j = 0; j < 4; ++j) { const int n = (lane >> 3) + 8 * j; const LAS float* s = scr + (8 * c) * 33 + n;
        v4u o; o.x = pk2(s[0 * 33] * ks[0], s[1 * 33] * ks[1]); o.y = pk2(s[2 * 33] * ks[2], s[3 * 33] * ks[3]); o.z = pk2(s[4 * 33] * ks[4], s[5 * 33] * ks[5]); o.w = pk2(s[6 * 33] * ks[6], s[7 * 33] * ks[7]);
        *(GAS v4u*)(WT + (size_t)(row_off + n0 + n) * K + k0 + 8 * c) = o; }
    LDS_WAIT(); asm volatile("" ::: "memory");
}

__device__ __forceinline__ void conv_phase(const bf16* CB, const bf16* CC, const bf16* CU, bf16* CO, const float* cw, const float* cbias, int gtid, int nthreads) {
    for (int task = gtid; task < M * 64; task += nthreads) {
        const int tok = task >> 6, c8 = (task & 63) * 8, tt = tok & (T - 1);
        const size_t off = (size_t)tok * 512 + c8;
        float z[3][8];
#pragma unroll
        for (int k = 0; k < 3; ++k) {
            const int dt = 2 - k;
            if (tt >= dt) { const v4u a = *(const GAS v4u*)(CC + off - (size_t)dt * 512), b = *(const GAS v4u*)(CU + off - (size_t)dt * 512);
                z[k][0] = bflo(a.x) * bflo(b.x); z[k][1] = bfhi(a.x) * bfhi(b.x); z[k][2] = bflo(a.y) * bflo(b.y); z[k][3] = bfhi(a.y) * bfhi(b.y);
                z[k][4] = bflo(a.z) * bflo(b.z); z[k][5] = bfhi(a.z) * bfhi(b.z); z[k][6] = bflo(a.w) * bflo(b.w); z[k][7] = bfhi(a.w) * bfhi(b.w); }
            else {
#pragma unroll
                for (int i = 0; i < 8; ++i) z[k][i] = 0.f; }
        }
        float y[8];
#pragma unroll
        for (int i = 0; i < 8; ++i) y[i] = cbias[c8 + i];
#pragma unroll
        for (int k = 0; k < 3; ++k)
#pragma unroll
            for (int i = 0; i < 8; ++i) y[i] += cw[k * 512 + c8 + i] * z[k][i];
        const v4u g = *(const GAS v4u*)(CB + off);
        v4u o; o.x = pk2(bflo(g.x) * y[0], bfhi(g.x) * y[1]); o.y = pk2(bflo(g.y) * y[2], bfhi(g.y) * y[3]); o.z = pk2(bflo(g.z) * y[4], bfhi(g.z) * y[5]); o.w = pk2(bflo(g.w) * y[6], bfhi(g.w) * y[7]);
        *(GAS v4u*)(CO + off) = o;
    }
}

__device__ __forceinline__ int crow(int r, int hf) { return (r & 3) + 8 * (r >> 2) + 4 * hf; }
#define MFMA_BF16(a, b, c) __builtin_amdgcn_mfma_f32_32x32x16_bf16((a), (b), (c), 0, 0, 0)
#define MFMA_F16(a, b, c) __builtin_amdgcn_mfma_f32_32x32x16_f16((a), (b), (c), 0, 0, 0)
__device__ __forceinline__ void attn_item(const bf16* Qb, const bf16* Kb, const bf16* VT, bf16* Ob, int b, int h, int qblk, int lane) {
    const int t32 = lane & 31, hf = lane >> 5, q0 = qblk * 32, tq = q0 + t32;
    const size_t rowbase = (size_t)b * T;
    const float LOG2E = 1.4426950408889634f, LN2 = 0.6931471805599453f;
    bf16x8 qf[4];
    { const bf16* qp = Qb + (rowbase + q0 + t32) * 512 + h * 64 + 8 * hf;
#pragma unroll
      for (int st = 0; st < 4; ++st) qf[st] = *(const GAS bf16x8*)(qp + 16 * st); }
    f16x8 tri[2];
#pragma unroll
    for (int st = 0; st < 2; ++st)
#pragma unroll
        for (int e = 0; e < 8; ++e) { const int j = 16 * st + 8 * (e >> 2) + 4 * hf + (e & 3); tri[st][e] = (j >= t32) ? (_Float16)1.0f : (_Float16)0.0f; }
    f32x16 o0, o1;
#pragma unroll
    for (int r = 0; r < 16; ++r) { o0[r] = 0.f; o1[r] = 0.f; }
    float R = 0.f;
    const bf16* kbase = Kb + rowbase * 512 + h * 64 + 8 * hf;
    const bf16* vtb = VT + ((size_t)(b * 8 + h) * 64 + t32) * T + 4 * hf;
    for (int jt = q0 >> 6; jt >= 0; --jt) {
        const int k0 = jt * 64;
        f32x16 s0, s1;
#pragma unroll
        for (int r = 0; r < 16; ++r) { s0[r] = 0.f; s1[r] = 0.f; }
#pragma unroll
        for (int st = 0; st < 4; ++st) {
            const bf16x8 a0 = *(const GAS bf16x8*)(kbase + (size_t)(k0 + t32) * 512 + 16 * st);
            const bf16x8 a1 = *(const GAS bf16x8*)(kbase + (size_t)(k0 + 32 + t32) * 512 + 16 * st);
            s0 = MFMA_BF16(a0, qf[st], s0); s1 = MFMA_BF16(a1, qf[st], s1);
        }
        f32x16 L0, L1; float tot0 = 0.f, tot1 = 0.f;
#pragma unroll
        for (int r = 0; r < 16; ++r) {
            const int key = k0 + crow(r, hf);
            { const float z = s0[r]; const float e = __builtin_amdgcn_exp2f(-__builtin_fabsf(z) * LOG2E); const float lp = __builtin_amdgcn_logf(1.0f + e) * LN2;
              const float L = (key < tq) ? -(__builtin_fmaxf(z, 0.f) + lp) : 0.f; L0[r] = L; tot0 += L; }
            { const float z = s1[r]; const float e = __builtin_amdgcn_exp2f(-__builtin_fabsf(z) * LOG2E); const float lp = __builtin_amdgcn_logf(1.0f + e) * LN2;
              const float L = (key + 32 < tq) ? -(__builtin_fmaxf(z, 0.f) + lp) : 0.f; L1[r] = L; tot1 += L; }
        }
        tot0 += __shfl_xor(tot0, 32); tot1 += __shfl_xor(tot1, 32);
        f16x8 lf00, lf01, lf10, lf11;
#pragma unroll
        for (int e = 0; e < 8; ++e) { lf00[e] = (_Float16)L0[e]; lf01[e] = (_Float16)L0[8 + e]; lf10[e] = (_Float16)L1[e]; lf11[e] = (_Float16)L1[8 + e]; }
        f32x16 y0, y1;
#pragma unroll
        for (int r = 0; r < 16; ++r) { y0[r] = 0.f; y1[r] = 0.f; }
        y0 = MFMA_F16(tri[0], lf00, y0); y0 = MFMA_F16(tri[1], lf01, y0);
        y1 = MFMA_F16(tri[0], lf10, y1); y1 = MFMA_F16(tri[1], lf11, y1);
        const float base0 = R + tot1, base1 = R;
        float a0v[16], a1v[16];
#pragma unroll
        for (int r = 0; r < 16; ++r) {
            const int key = k0 + crow(r, hf);
            a0v[r] = (key < tq) ? __builtin_amdgcn_exp2f((s0[r] + y0[r] + base0) * LOG2E) : 0.f;
            a1v[r] = (key + 32 < tq) ? __builtin_amdgcn_exp2f((s1[r] + y1[r] + base1) * LOG2E) : 0.f;
        }
        bf16x8 pf[2][2];
#pragma unroll
        for (int st = 0; st < 2; ++st) {
            v4u w0, w1;
            w0.x = cvtpk(a0v[8 * st + 0], a0v[8 * st + 1]); w0.y = cvtpk(a0v[8 * st + 2], a0v[8 * st + 3]); w0.z = cvtpk(a0v[8 * st + 4], a0v[8 * st + 5]); w0.w = cvtpk(a0v[8 * st + 6], a0v[8 * st + 7]);
            w1.x = cvtpk(a1v[8 * st + 0], a1v[8 * st + 1]); w1.y = cvtpk(a1v[8 * st + 2], a1v[8 * st + 3]); w1.z = cvtpk(a1v[8 * st + 4], a1v[8 * st + 5]); w1.w = cvtpk(a1v[8 * st + 6], a1v[8 * st + 7]);
            pf[0][st] = __builtin_bit_cast(bf16x8, w0); pf[1][st] = __builtin_bit_cast(bf16x8, w1);
        }
#pragma unroll
        for (int kb = 0; kb < 2; ++kb)
#pragma unroll
            for (int st = 0; st < 2; ++st) {
                const int kk = k0 + 32 * kb + 16 * st;
                { const v2u lo = *(const GAS v2u*)(vtb + kk), hi = *(const GAS v2u*)(vtb + kk + 8); v4u w; w.x = lo.x; w.y = lo.y; w.z = hi.x; w.w = hi.y;
                  o0 = MFMA_BF16(__builtin_bit_cast(bf16x8, w), pf[kb][st], o0); }
                { const v2u lo = *(const GAS v2u*)(vtb + (size_t)32 * T + kk), hi = *(const GAS v2u*)(vtb + (size_t)32 * T + kk + 8); v4u w; w.x = lo.x; w.y = lo.y; w.z = hi.x; w.w = hi.y;
                  o1 = MFMA_BF16(__builtin_bit_cast(bf16x8, w), pf[kb][st], o1); }
            }
        R += tot0 + tot1;
        if (__all(R < -104.0f)) break;
    }
    bf16* op = Ob + (rowbase + q0 + t32) * 512 + h * 64 + 4 * hf;
#pragma unroll
    for (int q4 = 0; q4 < 4; ++q4) {
        v2u w; w.x = cvtpk(o0[4 * q4], o0[4 * q4 + 1]); w.y = cvtpk(o0[4 * q4 + 2], o0[4 * q4 + 3]); *(GAS v2u*)(op + 8 * q4) = w;
        v2u w2; w2.x = cvtpk(o1[4 * q4], o1[4 * q4 + 1]); w2.y = cvtpk(o1[4 * q4 + 2], o1[4 * q4 + 3]); *(GAS v2u*)(op + 32 + 8 * q4) = w2;
    }
}

#define RT_C8(op_str, cnt, x0, x1, x2, x3, x4, x5, x6, x7, thr) asm volatile(op_str : "+v"(cnt) : "v"(x0), "v"(x1), "v"(x2), "v"(x3), "v"(x4), "v"(x5), "v"(x6), "v"(x7), "v"(thr) : "vcc")
#define RT_GE8 "v_cmp_ge_f32 vcc, %1, %9\n\tv_addc_co_u32_e32 %0, vcc, 0, %0, vcc\n\tv_cmp_ge_f32 vcc, %2, %9\n\tv_addc_co_u32_e32 %0, vcc, 0, %0, vcc\n\tv_cmp_ge_f32 vcc, %3, %9\n\tv_addc_co_u32_e32 %0, vcc, 0, %0, vcc\n\tv_cmp_ge_f32 vcc, %4, %9\n\tv_addc_co_u32_e32 %0, vcc, 0, %0, vcc\n\tv_cmp_ge_f32 vcc, %5, %9\n\tv_addc_co_u32_e32 %0, vcc, 0, %0, vcc\n\tv_cmp_ge_f32 vcc, %6, %9\n\tv_addc_co_u32_e32 %0, vcc, 0, %0, vcc\n\tv_cmp_ge_f32 vcc, %7, %9\n\tv_addc_co_u32_e32 %0, vcc, 0, %0, vcc\n\tv_cmp_ge_f32 vcc, %8, %9\n\tv_addc_co_u32_e32 %0, vcc, 0, %0, vcc"
#define RT_GT8 "v_cmp_gt_f32 vcc, %1, %9\n\tv_addc_co_u32_e32 %0, vcc, 0, %0, vcc\n\tv_cmp_gt_f32 vcc, %2, %9\n\tv_addc_co_u32_e32 %0, vcc, 0, %0, vcc\n\tv_cmp_gt_f32 vcc, %3, %9\n\tv_addc_co_u32_e32 %0, vcc, 0, %0, vcc\n\tv_cmp_gt_f32 vcc, %4, %9\n\tv_addc_co_u32_e32 %0, vcc, 0, %0, vcc\n\tv_cmp_gt_f32 vcc, %5, %9\n\tv_addc_co_u32_e32 %0, vcc, 0, %0, vcc\n\tv_cmp_gt_f32 vcc, %6, %9\n\tv_addc_co_u32_e32 %0, vcc, 0, %0, vcc\n\tv_cmp_gt_f32 vcc, %7, %9\n\tv_addc_co_u32_e32 %0, vcc, 0, %0, vcc\n\tv_cmp_gt_f32 vcc, %8, %9\n\tv_addc_co_u32_e32 %0, vcc, 0, %0, vcc"
#define RT_COUNT128(OPS, cnt, thr) do { cnt = 0; RT_C8(OPS, cnt, v[0], v[1], v[2], v[3], v[4], v[5], v[6], v[7], thr); RT_C8(OPS, cnt, v[8], v[9], v[10], v[11], v[12], v[13], v[14], v[15], thr); RT_C8(OPS, cnt, v[16], v[17], v[18], v[19], v[20], v[21], v[22], v[23], thr); RT_C8(OPS, cnt, v[24], v[25], v[26], v[27], v[28], v[29], v[30], v[31], thr); RT_C8(OPS, cnt, v[32], v[33], v[34], v[35], v[36], v[37], v[38], v[39], thr); RT_C8(OPS, cnt, v[40], v[41], v[42], v[43], v[44], v[45], v[46], v[47], thr); RT_C8(OPS, cnt, v[48], v[49], v[50], v[51], v[52], v[53], v[54], v[55], thr); RT_C8(OPS, cnt, v[56], v[57], v[58], v[59], v[60], v[61], v[62], v[63], thr); RT_C8(OPS, cnt, v[64], v[65], v[66], v[67], v[68], v[69], v[70], v[71], thr); RT_C8(OPS, cnt, v[72], v[73], v[74], v[75], v[76], v[77], v[78], v[79], thr); RT_C8(OPS, cnt, v[80], v[81], v[82], v[83], v[84], v[85], v[86], v[87], thr); RT_C8(OPS, cnt, v[88], v[89], v[90], v[91], v[92], v[93], v[94], v[95], thr); RT_C8(OPS, cnt, v[96], v[97], v[98], v[99], v[100], v[101], v[102], v[103], thr); RT_C8(OPS, cnt, v[104], v[105], v[106], v[107], v[108], v[109], v[110], v[111], thr); RT_C8(OPS, cnt, v[112], v[113], v[114], v[115], v[116], v[117], v[118], v[119], thr); RT_C8(OPS, cnt, v[120], v[121], v[122], v[123], v[124], v[125], v[126], v[127], thr); } while (0)
#define RT_S5(op_str, cnt, a0, a1, a2, a3, a4, b0, b1, b2, b3, b4, thr) do { float t_; asm volatile(op_str : "+v"(cnt), "=&v"(t_) : "v"(a0), "v"(a1), "v"(a2), "v"(a3), "v"(a4), "v"(b0), "v"(b1), "v"(b2), "v"(b3), "v"(b4), "v"(thr) : "vcc"); } while (0)
#define RT_SGE5 "v_add_f32_e32 %1, %2, %7\n\tv_cmp_ge_f32 vcc, %1, %12\n\tv_addc_co_u32_e32 %0, vcc, 0, %0, vcc\n\tv_add_f32_e32 %1, %3, %8\n\tv_cmp_ge_f32 vcc, %1, %12\n\tv_addc_co_u32_e32 %0, vcc, 0, %0, vcc\n\tv_add_f32_e32 %1, %4, %9\n\tv_cmp_ge_f32 vcc, %1, %12\n\tv_addc_co_u32_e32 %0, vcc, 0, %0, vcc\n\tv_add_f32_e32 %1, %5, %10\n\tv_cmp_ge_f32 vcc, %1, %12\n\tv_addc_co_u32_e32 %0, vcc, 0, %0, vcc\n\tv_add_f32_e32 %1, %6, %11\n\tv_cmp_ge_f32 vcc, %1, %12\n\tv_addc_co_u32_e32 %0, vcc, 0, %0, vcc"
#define RT_SGT5 "v_add_f32_e32 %1, %2, %7\n\tv_cmp_gt_f32 vcc, %1, %12\n\tv_addc_co_u32_e32 %0, vcc, 0, %0, vcc\n\tv_add_f32_e32 %1, %3, %8\n\tv_cmp_gt_f32 vcc, %1, %12\n\tv_addc_co_u32_e32 %0, vcc, 0, %0, vcc\n\tv_add_f32_e32 %1, %4, %9\n\tv_cmp_gt_f32 vcc, %1, %12\n\tv_addc_co_u32_e32 %0, vcc, 0, %0, vcc\n\tv_add_f32_e32 %1, %5, %10\n\tv_cmp_gt_f32 vcc, %1, %12\n\tv_addc_co_u32_e32 %0, vcc, 0, %0, vcc\n\tv_add_f32_e32 %1, %6, %11\n\tv_cmp_gt_f32 vcc, %1, %12\n\tv_addc_co_u32_e32 %0, vcc, 0, %0, vcc"
#define RT_COUNT50(OPS, cnt, thr) do { cnt = 0; RT_S5(OPS, cnt, a[0], a[0], a[0], a[0], a[0], b[0], b[1], b[2], b[3], b[4], thr); RT_S5(OPS, cnt, a[0], a[0], a[0], a[0], a[0], b[5], b[6], b[7], b[8], b[9], thr); RT_S5(OPS, cnt, a[0], a[0], a[0], a[0], a[0], b[10], b[11], b[12], b[13], b[14], thr); RT_S5(OPS, cnt, a[0], a[1], a[1], a[1], a[1], b[15], b[0], b[1], b[2], b[3], thr); RT_S5(OPS, cnt, a[1], a[1], a[1], a[1], a[2], b[4], b[5], b[6], b[7], b[0], thr); RT_S5(OPS, cnt, a[2], a[2], a[2], a[2], a[3], b[1], b[2], b[3], b[4], b[0], thr); RT_S5(OPS, cnt, a[3], a[3], a[3], a[4], a[4], b[1], b[2], b[3], b[0], b[1], thr); RT_S5(OPS, cnt, a[4], a[5], a[5], a[6], a[6], b[2], b[0], b[1], b[0], b[1], thr); RT_S5(OPS, cnt, a[7], a[7], a[8], a[9], a[10], b[0], b[1], b[0], b[0], b[0], thr); RT_S5(OPS, cnt, a[11], a[12], a[13], a[14], a[15], b[0], b[0], b[0], b[0], b[0], thr); } while (0)
#define RT_CSWAP(x, xi, p, q) do { float t_; asm volatile("v_cmp_gt_f32 vcc, %1, %0\n\tv_cndmask_b32_e32 %4, %0, %1, vcc\n\tv_cndmask_b32_e32 %1, %1, %0, vcc\n\tv_mov_b32_e32 %0, %4\n\tv_cndmask_b32_e32 %4, %2, %3, vcc\n\tv_cndmask_b32_e32 %3, %3, %2, vcc\n\tv_mov_b32_e32 %2, %4" : "+v"(x[p]), "+v"(x[q]), "+v"(xi[p]), "+v"(xi[q]), "=&v"(t_) : : "vcc"); } while (0)
#define RT_SORT16(x, xi) do { RT_CSWAP(x, xi, 0, 1); RT_CSWAP(x, xi, 2, 3); RT_CSWAP(x, xi, 0, 2); RT_CSWAP(x, xi, 1, 3); RT_CSWAP(x, xi, 1, 2); RT_CSWAP(x, xi, 4, 5); RT_CSWAP(x, xi, 6, 7); RT_CSWAP(x, xi, 4, 6); RT_CSWAP(x, xi, 5, 7); RT_CSWAP(x, xi, 5, 6); RT_CSWAP(x, xi, 0, 4); RT_CSWAP(x, xi, 2, 6); RT_CSWAP(x, xi, 2, 4); RT_CSWAP(x, xi, 1, 5); RT_CSWAP(x, xi, 3, 7); RT_CSWAP(x, xi, 3, 5); RT_CSWAP(x, xi, 1, 2); RT_CSWAP(x, xi, 3, 4); RT_CSWAP(x, xi, 5, 6); RT_CSWAP(x, xi, 8, 9); RT_CSWAP(x, xi, 10, 11); RT_CSWAP(x, xi, 8, 10); RT_CSWAP(x, xi, 9, 11); RT_CSWAP(x, xi, 9, 10); RT_CSWAP(x, xi, 12, 13); RT_CSWAP(x, xi, 14, 15); RT_CSWAP(x, xi, 12, 14); RT_CSWAP(x, xi, 13, 15); RT_CSWAP(x, xi, 13, 14); RT_CSWAP(x, xi, 8, 12); RT_CSWAP(x, xi, 10, 14); RT_CSWAP(x, xi, 10, 12); RT_CSWAP(x, xi, 9, 13); RT_CSWAP(x, xi, 11, 15); RT_CSWAP(x, xi, 11, 13); RT_CSWAP(x, xi, 9, 10); RT_CSWAP(x, xi, 11, 12); RT_CSWAP(x, xi, 13, 14); RT_CSWAP(x, xi, 0, 8); RT_CSWAP(x, xi, 4, 12); RT_CSWAP(x, xi, 4, 8); RT_CSWAP(x, xi, 2, 10); RT_CSWAP(x, xi, 6, 14); RT_CSWAP(x, xi, 6, 10); RT_CSWAP(x, xi, 2, 4); RT_CSWAP(x, xi, 6, 8); RT_CSWAP(x, xi, 10, 12); RT_CSWAP(x, xi, 1, 9); RT_CSWAP(x, xi, 5, 13); RT_CSWAP(x, xi, 5, 9); RT_CSWAP(x, xi, 3, 11); RT_CSWAP(x, xi, 7, 15); RT_CSWAP(x, xi, 7, 11); RT_CSWAP(x, xi, 3, 5); RT_CSWAP(x, xi, 7, 9); RT_CSWAP(x, xi, 11, 13); RT_CSWAP(x, xi, 1, 2); RT_CSWAP(x, xi, 3, 4); RT_CSWAP(x, xi, 5, 6); RT_CSWAP(x, xi, 7, 8); RT_CSWAP(x, xi, 9, 10); RT_CSWAP(x, xi, 11, 12); RT_CSWAP(x, xi, 13, 14); } while (0)
#define RT_FOR_CANDS(F) F(0, 0) F(0, 1) F(0, 2) F(0, 3) F(0, 4) F(0, 5) F(0, 6) F(0, 7) F(0, 8) F(0, 9) F(0, 10) F(0, 11) F(0, 12) F(0, 13) F(0, 14) F(0, 15) F(1, 0) F(1, 1) F(1, 2) F(1, 3) F(1, 4) F(1, 5) F(1, 6) F(1, 7) F(2, 0) F(2, 1) F(2, 2) F(2, 3) F(2, 4) F(3, 0) F(3, 1) F(3, 2) F(3, 3) F(4, 0) F(4, 1) F(4, 2) F(5, 0) F(5, 1) F(6, 0) F(6, 1) F(7, 0) F(7, 1) F(8, 0) F(9, 0) F(10, 0) F(11, 0) F(12, 0) F(13, 0) F(14, 0) F(15, 0)
#define RT_SEARCH(COUNT_MACRO, NTOT) \
    for (int it_ = 0; it_ < 400 && __any(!done); ++it_) { \
        const float w_ = hi - lo; float t_ = ((float)(clo - 16) + 0.5f) * __builtin_amdgcn_rcpf((float)(clo - chi)); t_ = __builtin_fminf(__builtin_fmaxf(t_, 0.125f), 0.875f); \
        float x_ = lo + w_ * t_; if (!(x_ > lo && x_ < hi)) x_ = 0.5f * lo + 0.5f * hi; const bool stuck_ = !(x_ > lo && x_ < hi); \
        int c_; COUNT_MACRO(c_, x_); \
        if (!done) { if (stuck_) { Tv = lo; done = true; } else if (c_ == 16) { Tv = x_; done = true; } else if (c_ > 16) { lo = x_; clo = c_; } else { hi = x_; chi = c_; } } } \
    if (!done) Tv = lo;
#define RT_CNT128_GE(c, x) RT_COUNT128(RT_GE8, c, x)
#define RT_CNT50_GE(c, x) RT_COUNT50(RT_SGE5, c, x)
__device__ __forceinline__ void lane_top16_of_128(const float (&v)[128], LAS unsigned char* sb) {
    float mx = v[0], mn = v[0];
#pragma unroll
    for (int i = 1; i < 128; ++i) { mx = __builtin_fmaxf(mx, v[i]); mn = __builtin_fminf(mn, v[i]); }
    float lo = mn, hi = mx, Tv = mn; int clo = 128, chi; bool done;
    RT_CNT128_GE(chi, mx); done = (chi >= 16); if (done) Tv = mx;
    RT_SEARCH(RT_CNT128_GE, 128)
    int cgt; RT_COUNT128(RT_GT8, cgt, Tv);
    const int need = 16 - cgt; int cnt = 0, idx = 0;
#pragma unroll
    for (int i = 0; i < 128; ++i) {
        asm volatile("" : "+v"(Tv), "+v"(cnt), "+v"(idx));
        LAS unsigned char* q = sb + cnt * 512; *(LAS float*)q = v[i]; *(LAS int*)(q + 4) = idx;
        cnt += (v[i] > Tv) ? 1 : 0; idx += 1;
    }
    if (__any(need > 0)) {
        idx = 0;
#pragma unroll
        for (int i = 0; i < 128; ++i) { asm volatile("" : "+v"(Tv), "+v"(cnt), "+v"(idx));
            if (v[i] == Tv && cnt < 16) { LAS unsigned char* q = sb + cnt * 512; *(LAS float*)q = v[i]; *(LAS int*)(q + 4) = idx; cnt += 1; } idx += 1; }
    }
}
__device__ __forceinline__ int opaque_zero() { int z = 0; asm volatile("" : "+v"(z)); return z; }
__device__ __forceinline__ void route_task_search(const float* SCT, v2u* ROUTE, int tok0, int h, LAS unsigned char* scr, int lane) {
    const int tok = tok0 + lane;
    LAS unsigned char* sb = scr + lane * 8;
#pragma unroll 1
    for (int p = 0; p < 2; ++p) {
        const int g = 2 * h + p; float v[128];
        const unsigned voff = (unsigned)tok * 16u;
#pragma unroll
        for (int k = 0; k < 32; ++k) { const char* bk = (const char*)SCT + ((size_t)(g * 32 + k) * M) * 16; const f32x4 q = *(const GAS f32x4*)(bk + voff); v[4 * k] = q.x; v[4 * k + 1] = q.y; v[4 * k + 2] = q.z; v[4 * k + 3] = q.w; }
        lane_top16_of_128(v, sb + p * 8704);
    }
    LDS_WAIT();
    float a[16], b[16]; int ai[16], bi[16];
#pragma unroll
    for (int i = 0; i < 16; ++i) { const v2u ea = *(LAS v2u*)(sb + i * 512), eb = *(LAS v2u*)(sb + 8704 + i * 512);
        a[i] = __builtin_bit_cast(float, ea.x); ai[i] = (int)ea.y; b[i] = __builtin_bit_cast(float, eb.x); bi[i] = (int)eb.y; }
    LDS_WAIT();
    RT_SORT16(a, ai); RT_SORT16(b, bi);
    float lo = a[15] + b[15], hi = a[0] + b[0], Tv = lo; int clo = 50, chi; bool done;
    RT_CNT50_GE(chi, hi); done = (chi >= 16); if (done) Tv = hi;
    RT_SEARCH(RT_CNT50_GE, 50)
    int cgt; RT_COUNT50(RT_SGT5, cgt, Tv);
    const int need = 16 - cgt; int cnt = 0;
#define RT_EXT(i, j) { asm volatile("" : "+v"(Tv), "+v"(cnt)); const float s_ = a[i] + b[j]; LAS unsigned char* q_ = sb + cnt * 512; *(LAS float*)q_ = s_; *(LAS int*)(q_ + 4) = ai[i] * 128 + bi[j]; cnt += (s_ > Tv) ? 1 : 0; }
    RT_FOR_CANDS(RT_EXT)
#undef RT_EXT
    if (__any(need > 0)) {
#define RT_EXT2(i, j) { asm volatile("" : "+v"(Tv), "+v"(cnt)); const float s_ = a[i] + b[j]; if (s_ == Tv && cnt < 16) { LAS unsigned char* q_ = sb + cnt * 512; *(LAS float*)q_ = s_; *(LAS int*)(q_ + 4) = ai[i] * 128 + bi[j]; cnt += 1; } }
        RT_FOR_CANDS(RT_EXT2)
#undef RT_EXT2
    }
    LDS_WAIT();
    GAS v4u* rp = (GAS v4u*)((GAS v2u*)ROUTE + (size_t)tok * 128 + h * 16);
#pragma unroll
    for (int i = 0; i < 8; ++i) { const v2u e0 = *(LAS v2u*)(sb + (2 * i) * 512), e1 = *(LAS v2u*)(sb + (2 * i + 1) * 512); v4u o; o.x = e0.y; o.y = e0.x; o.z = e1.y; o.w = e1.x; rp[i] = o; }
    LDS_WAIT();
}

#define RT2_CE(a, b) { const int t0_ = (a), t1_ = (b); (a) = t0_ > t1_ ? t0_ : t1_; (b) = t0_ > t1_ ? t1_ : t0_; }
#define RT2_MX(a, b) ((a) > (b) ? (a) : (b))
#define RT2_SORT16(k, B) do { RT2_CE(k[(B) + 0], k[(B) + 13]); RT2_CE(k[(B) + 1], k[(B) + 12]); RT2_CE(k[(B) + 2], k[(B) + 15]); RT2_CE(k[(B) + 3], k[(B) + 14]); RT2_CE(k[(B) + 4], k[(B) + 8]); RT2_CE(k[(B) + 5], k[(B) + 6]); RT2_CE(k[(B) + 7], k[(B) + 11]); RT2_CE(k[(B) + 9], k[(B) + 10]); RT2_CE(k[(B) + 0], k[(B) + 5]); RT2_CE(k[(B) + 1], k[(B) + 7]); RT2_CE(k[(B) + 2], k[(B) + 9]); RT2_CE(k[(B) + 3], k[(B) + 4]); RT2_CE(k[(B) + 6], k[(B) + 13]); RT2_CE(k[(B) + 8], k[(B) + 14]); RT2_CE(k[(B) + 10], k[(B) + 15]); RT2_CE(k[(B) + 11], k[(B) + 12]); RT2_CE(k[(B) + 0], k[(B) + 1]); RT2_CE(k[(B) + 2], k[(B) + 3]); RT2_CE(k[(B) + 4], k[(B) + 5]); RT2_CE(k[(B) + 6], k[(B) + 8]); RT2_CE(k[(B) + 7], k[(B) + 9]); RT2_CE(k[(B) + 10], k[(B) + 11]); RT2_CE(k[(B) + 12], k[(B) + 13]); RT2_CE(k[(B) + 14], k[(B) + 15]); RT2_CE(k[(B) + 0], k[(B) + 2]); RT2_CE(k[(B) + 1], k[(B) + 3]); RT2_CE(k[(B) + 4], k[(B) + 10]); RT2_CE(k[(B) + 5], k[(B) + 11]); RT2_CE(k[(B) + 6], k[(B) + 7]); RT2_CE(k[(B) + 8], k[(B) + 9]); RT2_CE(k[(B) + 12], k[(B) + 14]); RT2_CE(k[(B) + 13], k[(B) + 15]); RT2_CE(k[(B) + 1], k[(B) + 2]); RT2_CE(k[(B) + 3], k[(B) + 12]); RT2_CE(k[(B) + 4], k[(B) + 6]); RT2_CE(k[(B) + 5], k[(B) + 7]); RT2_CE(k[(B) + 8], k[(B) + 10]); RT2_CE(k[(B) + 9], k[(B) + 11]); RT2_CE(k[(B) + 13], k[(B) + 14]); RT2_CE(k[(B) + 1], k[(B) + 4]); RT2_CE(k[(B) + 2], k[(B) + 6]); RT2_CE(k[(B) + 5], k[(B) + 8]); RT2_CE(k[(B) + 7], k[(B) + 10]); RT2_CE(k[(B) + 9], k[(B) + 13]); RT2_CE(k[(B) + 11], k[(B) + 14]); RT2_CE(k[(B) + 2], k[(B) + 4]); RT2_CE(k[(B) + 3], k[(B) + 6]); RT2_CE(k[(B) + 9], k[(B) + 12]); RT2_CE(k[(B) + 11], k[(B) + 13]); RT2_CE(k[(B) + 3], k[(B) + 5]); RT2_CE(k[(B) + 6], k[(B) + 8]); RT2_CE(k[(B) + 7], k[(B) + 9]); RT2_CE(k[(B) + 10], k[(B) + 12]); RT2_CE(k[(B) + 3], k[(B) + 4]); RT2_CE(k[(B) + 5], k[(B) + 6]); RT2_CE(k[(B) + 7], k[(B) + 8]); RT2_CE(k[(B) + 9], k[(B) + 10]); RT2_CE(k[(B) + 11], k[(B) + 12]); RT2_CE(k[(B) + 6], k[(B) + 7]); RT2_CE(k[(B) + 8], k[(B) + 9]); } while (0)
#define RT2_BIT16(k, B) do { RT2_CE(k[(B) + 0], k[(B) + 8]); RT2_CE(k[(B) + 1], k[(B) + 9]); RT2_CE(k[(B) + 2], k[(B) + 10]); RT2_CE(k[(B) + 3], k[(B) + 11]); RT2_CE(k[(B) + 4], k[(B) + 12]); RT2_CE(k[(B) + 5], k[(B) + 13]); RT2_CE(k[(B) + 6], k[(B) + 14]); RT2_CE(k[(B) + 7], k[(B) + 15]); RT2_CE(k[(B) + 0], k[(B) + 4]); RT2_CE(k[(B) + 1], k[(B) + 5]); RT2_CE(k[(B) + 2], k[(B) + 6]); RT2_CE(k[(B) + 3], k[(B) + 7]); RT2_CE(k[(B) + 8], k[(B) + 12]); RT2_CE(k[(B) + 9], k[(B) + 13]); RT2_CE(k[(B) + 10], k[(B) + 14]); RT2_CE(k[(B) + 11], k[(B) + 15]); RT2_CE(k[(B) + 0], k[(B) + 2]); RT2_CE(k[(B) + 1], k[(B) + 3]); RT2_CE(k[(B) + 4], k[(B) + 6]); RT2_CE(k[(B) + 5], k[(B) + 7]); RT2_CE(k[(B) + 8], k[(B) + 10]); RT2_CE(k[(B) + 9], k[(B) + 11]); RT2_CE(k[(B) + 12], k[(B) + 14]); RT2_CE(k[(B) + 13], k[(B) + 15]); RT2_CE(k[(B) + 0], k[(B) + 1]); RT2_CE(k[(B) + 2], k[(B) + 3]); RT2_CE(k[(B) + 4], k[(B) + 5]); RT2_CE(k[(B) + 6], k[(B) + 7]); RT2_CE(k[(B) + 8], k[(B) + 9]); RT2_CE(k[(B) + 10], k[(B) + 11]); RT2_CE(k[(B) + 12], k[(B) + 13]); RT2_CE(k[(B) + 14], k[(B) + 15]); } while (0)
#define RT2_HCLEAN(k, A, B) do { k[(A) + 0] = RT2_MX(k[(A) + 0], k[(B) + 15]); k[(A) + 1] = RT2_MX(k[(A) + 1], k[(B) + 14]); k[(A) + 2] = RT2_MX(k[(A) + 2], k[(B) + 13]); k[(A) + 3] = RT2_MX(k[(A) + 3], k[(B) + 12]); k[(A) + 4] = RT2_MX(k[(A) + 4], k[(B) + 11]); k[(A) + 5] = RT2_MX(k[(A) + 5], k[(B) + 10]); k[(A) + 6] = RT2_MX(k[(A) + 6], k[(B) + 9]); k[(A) + 7] = RT2_MX(k[(A) + 7], k[(B) + 8]); k[(A) + 8] = RT2_MX(k[(A) + 8], k[(B) + 7]); k[(A) + 9] = RT2_MX(k[(A) + 9], k[(B) + 6]); k[(A) + 10] = RT2_MX(k[(A) + 10], k[(B) + 5]); k[(A) + 11] = RT2_MX(k[(A) + 11], k[(B) + 4]); k[(A) + 12] = RT2_MX(k[(A) + 12], k[(B) + 3]); k[(A) + 13] = RT2_MX(k[(A) + 13], k[(B) + 2]); k[(A) + 14] = RT2_MX(k[(A) + 14], k[(B) + 1]); k[(A) + 15] = RT2_MX(k[(A) + 15], k[(B) + 0]); } while (0)
#define RT2_TOP16_OF_128(k) do { RT2_SORT16(k, 0); RT2_SORT16(k, 16); RT2_SORT16(k, 32); RT2_SORT16(k, 48); RT2_SORT16(k, 64); RT2_SORT16(k, 80); RT2_SORT16(k, 96); RT2_SORT16(k, 112); RT2_HCLEAN(k, 0, 16); RT2_BIT16(k, 0); RT2_HCLEAN(k, 32, 48); RT2_BIT16(k, 32); RT2_HCLEAN(k, 64, 80); RT2_BIT16(k, 64); RT2_HCLEAN(k, 96, 112); RT2_BIT16(k, 96); RT2_HCLEAN(k, 0, 32); RT2_BIT16(k, 0); RT2_HCLEAN(k, 64, 96); RT2_BIT16(k, 64); RT2_HCLEAN(k, 0, 64); RT2_BIT16(k, 0); } while (0)
#define RT2_BUILD_CANDS(c) do { c[0] = RT2_CK(0, 0); c[1] = RT2_CK(0, 1); c[2] = RT2_CK(0, 2); c[3] = RT2_CK(0, 3); c[4] = RT2_CK(0, 4); c[5] = RT2_CK(0, 5); c[6] = RT2_CK(0, 6); c[7] = RT2_CK(0, 7); c[8] = RT2_CK(0, 8); c[9] = RT2_CK(0, 9); c[10] = RT2_CK(0, 10); c[11] = RT2_CK(0, 11); c[12] = RT2_CK(0, 12); c[13] = RT2_CK(0, 13); c[14] = RT2_CK(0, 14); c[15] = RT2_CK(0, 15); c[16] = RT2_CK(1, 0); c[17] = RT2_CK(1, 1); c[18] = RT2_CK(1, 2); c[19] = RT2_CK(1, 3); c[20] = RT2_CK(1, 4); c[21] = RT2_CK(1, 5); c[22] = RT2_CK(1, 6); c[23] = RT2_CK(1, 7); c[24] = RT2_CK(15, 0); c[25] = RT2_CK(14, 0); c[26] = RT2_CK(13, 0); c[27] = RT2_CK(12, 0); c[28] = RT2_CK(11, 0); c[29] = RT2_CK(10, 0); c[30] = RT2_CK(9, 0); c[31] = RT2_CK(8, 0); c[32] = RT2_CK(2, 0); c[33] = RT2_CK(2, 1); c[34] = RT2_CK(2, 2); c[35] = RT2_CK(2, 3); c[36] = RT2_CK(2, 4); c[37] = RT2_CK(3, 0); c[38] = RT2_CK(3, 1); c[39] = RT2_CK(3, 2); c[40] = RT2_CK(3, 3); c[41] = RT2_CK(4, 0); c[42] = RT2_CK(4, 1); c[43] = RT2_CK(4, 2); c[44] = RT2_CK(5, 0); c[45] = RT2_CK(5, 1); c[46] = RT2_CK(6, 0); c[47] = RT2_CK(6, 1); } while (0)
__device__ __forceinline__ int rt2_tr(int u) { return u ^ (int)((unsigned)(u >> 31) >> 1); }
__device__ __forceinline__ int rt2_key(float x, int code, int mask) { return (rt2_tr(__builtin_bit_cast(int, x)) & ~mask) | code; }
__device__ __forceinline__ int rt2_key16(unsigned hbits_hi, int code) { return (rt2_tr((int)hbits_hi) & (int)0xffff0000) | code; }
__device__ __forceinline__ float rt2_val16(int k) { const unsigned u = (unsigned)rt2_tr(k) >> 16; return (float)__builtin_bit_cast(_Float16, (unsigned short)u); }
__device__ __forceinline__ void route_task(const unsigned short* SCT, v2u* ROUTE, int tok0, int h, LAS unsigned char* scr, int lane) {
    const int tok = tok0 + lane;
    LAS unsigned char* sb = scr + lane * 4;
#pragma unroll 1
    for (int p = 0; p < 2; ++p) {
        const int g = 2 * h + p; int k[128];
        const unsigned voff = (unsigned)tok * 16u;
#pragma unroll
        for (int q8 = 0; q8 < 16; ++q8) { const char* bq = (const char*)SCT + ((size_t)(g * 16 + q8) * M) * 16; const v4u q = *(const GAS v4u*)(bq + voff);
            k[8 * q8 + 0] = rt2_key16(q.x << 16, 127 - 8 * q8); k[8 * q8 + 1] = rt2_key16(q.x, 126 - 8 * q8); k[8 * q8 + 2] = rt2_key16(q.y << 16, 125 - 8 * q8); k[8 * q8 + 3] = rt2_key16(q.y, 124 - 8 * q8);
            k[8 * q8 + 4] = rt2_key16(q.z << 16, 123 - 8 * q8); k[8 * q8 + 5] = rt2_key16(q.z, 122 - 8 * q8); k[8 * q8 + 6] = rt2_key16(q.w << 16, 121 - 8 * q8); k[8 * q8 + 7] = rt2_key16(q.w, 120 - 8 * q8); }
        RT2_TOP16_OF_128(k);
#pragma unroll
        for (int i = 0; i < 16; ++i) *(LAS int*)(sb + (p * 16 + i) * 256) = k[i];
    }
    LDS_WAIT();
    float af[16], bf[16];
#pragma unroll
    for (int i = 0; i < 16; ++i) { af[i] = rt2_val16(*(const LAS int*)(sb + i * 256)); bf[i] = rt2_val16(*(const LAS int*)(sb + (16 + i) * 256)); }
    int c[48];
#define RT2_CK(i, j) rt2_key(af[i] + bf[j], 255 - (16 * (i) + (j)), 255)
    RT2_BUILD_CANDS(c);
    const int r7a = RT2_CK(7, 0), r7b = RT2_CK(7, 1);
#undef RT2_CK
    RT2_BIT16(c, 16);
    RT2_SORT16(c, 32);
    RT2_HCLEAN(c, 0, 16); RT2_BIT16(c, 0);
    c[46] = RT2_MX(c[46], r7b); c[47] = RT2_MX(c[47], r7a); RT2_BIT16(c, 32);
    RT2_HCLEAN(c, 0, 32);
    GAS v4u* rp = (GAS v4u*)((GAS v2u*)ROUTE + (size_t)tok * 128 + h * 16);
#pragma unroll
    for (int i = 0; i < 8; ++i) { v4u o;
        { const int ij = (~c[2 * i]) & 255; const int ka = *(const LAS int*)(sb + ((ij >> 4) << 8)), kb = *(const LAS int*)(sb + 4096 + ((ij & 15) << 8));
          o.x = (unsigned)(((~ka) & 127) * 128 + ((~kb) & 127)); o.y = __builtin_bit_cast(unsigned, rt2_val16(ka) + rt2_val16(kb)); }
        { const int ij = (~c[2 * i + 1]) & 255; const int ka = *(const LAS int*)(sb + ((ij >> 4) << 8)), kb = *(const LAS int*)(sb + 4096 + ((ij & 15) << 8));
          o.z = (unsigned)(((~ka) & 127) * 128 + ((~kb) & 127)); o.w = __builtin_bit_cast(unsigned, rt2_val16(ka) + rt2_val16(kb)); }
        rp[i] = o; }
    LDS_WAIT();
}

#define DPPF(v, ctrl) __builtin_bit_cast(float, __builtin_amdgcn_update_dpp(0, __builtin_bit_cast(int, (v)), (ctrl), 0xf, 0xf, true))
__device__ __forceinline__ float wave_max_f(float m) {
#pragma unroll
    for (int o = 1; o < 64; o <<= 1) m = __builtin_fmaxf(m, __shfl_xor(m, o));
    return m;
}
template <int NV> __device__ __forceinline__ void select16(const float (&v)[NV], bool (&sel)[NV], int (&pos)[NV]) {
    float mx = v[0], mn = v[0];
#pragma unroll
    for (int i = 1; i < NV; ++i) { mx = __builtin_fmaxf(mx, v[i]); mn = __builtin_fminf(mn, v[i]); }
    mx = wave_max_f(mx); mn = -wave_max_f(-mn);
    float lo = mn, hi = mx, Tv;
    { int c = 0;
#pragma unroll
      for (int i = 0; i < NV; ++i) c += __popcll(__ballot(v[i] >= mx));
      if (c >= 16) { Tv = mx; }
      else {
        Tv = lo;
        for (int it = 0; it < 300; ++it) {
            const float mid = 0.5f * lo + 0.5f * hi;
            if (!(mid > lo && mid < hi)) { Tv = lo; break; }
            int cc = 0;
#pragma unroll
            for (int i = 0; i < NV; ++i) cc += __popcll(__ballot(v[i] >= mid));
            if (cc == 16) { Tv = mid; break; }
            if (cc > 16) lo = mid; else hi = mid;
            Tv = lo;
        }
      }
    }
    int cgt = 0;
#pragma unroll
    for (int i = 0; i < NV; ++i) cgt += __popcll(__ballot(v[i] > Tv));
    const int need = 16 - cgt;
    int eqbelow = 0;
#pragma unroll
    for (int i = 0; i < NV; ++i) { const unsigned long long m = __ballot(v[i] == Tv); eqbelow += __builtin_amdgcn_mbcnt_hi((unsigned)(m >> 32), __builtin_amdgcn_mbcnt_lo((unsigned)m, 0u)); }
    int eqown = 0;
#pragma unroll
    for (int i = 0; i < NV; ++i) { const bool eq = (v[i] == Tv); sel[i] = (v[i] > Tv) || (eq && (eqbelow + eqown) < need); eqown += eq ? 1 : 0; }
    int selbelow = 0;
#pragma unroll
    for (int i = 0; i < NV; ++i) { const unsigned long long m = __ballot(sel[i]); selbelow += __builtin_amdgcn_mbcnt_hi((unsigned)(m >> 32), __builtin_amdgcn_mbcnt_lo((unsigned)m, 0u)); }
    int own = 0;
#pragma unroll
    for (int i = 0; i < NV; ++i) { pos[i] = selbelow + own; own += sel[i] ? 1 : 0; }
}

__device__ __forceinline__ float gelu_exact(float a) { return 0.5f * a * (1.0f + erff(a * 0.7071067811865476f)); }

__device__ __forceinline__ void fp8_row_dot(const v4u q, const float (&xr)[16], float& s) {
    const f32x2 a0 = __builtin_amdgcn_cvt_pk_f32_fp8((int)q.x, false), a1 = __builtin_amdgcn_cvt_pk_f32_fp8((int)q.x, true), a2 = __builtin_amdgcn_cvt_pk_f32_fp8((int)q.y, false), a3 = __builtin_amdgcn_cvt_pk_f32_fp8((int)q.y, true);
    const f32x2 b0 = __builtin_amdgcn_cvt_pk_f32_fp8((int)q.z, false), b1 = __builtin_amdgcn_cvt_pk_f32_fp8((int)q.z, true), b2 = __builtin_amdgcn_cvt_pk_f32_fp8((int)q.w, false), b3 = __builtin_amdgcn_cvt_pk_f32_fp8((int)q.w, true);
    f32x2 t = a0 * (f32x2){xr[0], xr[1]};
    t = __builtin_elementwise_fma(a1, (f32x2){xr[2], xr[3]}, t); t = __builtin_elementwise_fma(a2, (f32x2){xr[4], xr[5]}, t); t = __builtin_elementwise_fma(a3, (f32x2){xr[6], xr[7]}, t);
    t = __builtin_elementwise_fma(b0, (f32x2){xr[8], xr[9]}, t); t = __builtin_elementwise_fma(b1, (f32x2){xr[10], xr[11]}, t); t = __builtin_elementwise_fma(b2, (f32x2){xr[12], xr[13]}, t); t = __builtin_elementwise_fma(b3, (f32x2){xr[14], xr[15]}, t);
    s = t.x + t.y;
}
__device__ __forceinline__ void fp8_row_axpy2(const v4u q, const float w, f32x2 (&acc)[8]) {
    const f32x2 a0 = __builtin_amdgcn_cvt_pk_f32_fp8((int)q.x, false), a1 = __builtin_amdgcn_cvt_pk_f32_fp8((int)q.x, true), a2 = __builtin_amdgcn_cvt_pk_f32_fp8((int)q.y, false), a3 = __builtin_amdgcn_cvt_pk_f32_fp8((int)q.y, true);
    const f32x2 b0 = __builtin_amdgcn_cvt_pk_f32_fp8((int)q.z, false), b1 = __builtin_amdgcn_cvt_pk_f32_fp8((int)q.z, true), b2 = __builtin_amdgcn_cvt_pk_f32_fp8((int)q.w, false), b3 = __builtin_amdgcn_cvt_pk_f32_fp8((int)q.w, true);
    const f32x2 ww = {w, w};
    acc[0] = __builtin_elementwise_fma(a0, ww, acc[0]); acc[1] = __builtin_elementwise_fma(a1, ww, acc[1]); acc[2] = __builtin_elementwise_fma(a2, ww, acc[2]); acc[3] = __builtin_elementwise_fma(a3, ww, acc[3]);
    acc[4] = __builtin_elementwise_fma(b0, ww, acc[4]); acc[5] = __builtin_elementwise_fma(b1, ww, acc[5]); acc[6] = __builtin_elementwise_fma(b2, ww, acc[6]); acc[7] = __builtin_elementwise_fma(b3, ww, acc[7]);
}
__device__ __forceinline__ void fp8_row_axpy(const v4u q, const float w, float (&acc)[16]) {
    const f32x2 a0 = __builtin_amdgcn_cvt_pk_f32_fp8((int)q.x, false), a1 = __builtin_amdgcn_cvt_pk_f32_fp8((int)q.x, true), a2 = __builtin_amdgcn_cvt_pk_f32_fp8((int)q.y, false), a3 = __builtin_amdgcn_cvt_pk_f32_fp8((int)q.y, true);
    const f32x2 b0 = __builtin_amdgcn_cvt_pk_f32_fp8((int)q.z, false), b1 = __builtin_amdgcn_cvt_pk_f32_fp8((int)q.z, true), b2 = __builtin_amdgcn_cvt_pk_f32_fp8((int)q.w, false), b3 = __builtin_amdgcn_cvt_pk_f32_fp8((int)q.w, true);
    acc[0] += w * a0.x; acc[1] += w * a0.y; acc[2] += w * a1.x; acc[3] += w * a1.y; acc[4] += w * a2.x; acc[5] += w * a2.y; acc[6] += w * a3.x; acc[7] += w * a3.y;
    acc[8] += w * b0.x; acc[9] += w * b0.y; acc[10] += w * b1.x; acc[11] += w * b1.y; acc[12] += w * b2.x; acc[13] += w * b2.y; acc[14] += w * b3.x; acc[15] += w * b3.y;
}
__device__ __forceinline__ void fp8_convert_row(const float* src, const float* gain, unsigned char* dst, float* inv_scale, int lane, int sliced, int e) {
    const GAS f32x4* sp = (const GAS f32x4*)src; float v[16];
#pragma unroll
    for (int j = 0; j < 2; ++j) { f32x4 a = sp[2 * lane + 128 * j], b = sp[2 * lane + 128 * j + 1];
        if (gain) { const GAS f32x4* gp = (const GAS f32x4*)gain; const f32x4 ga = gp[2 * lane + 128 * j], gb = gp[2 * lane + 128 * j + 1]; a = a * ga; b = b * gb; }
        v[8 * j + 0] = a.x; v[8 * j + 1] = a.y; v[8 * j + 2] = a.z; v[8 * j + 3] = a.w; v[8 * j + 4] = b.x; v[8 * j + 5] = b.y; v[8 * j + 6] = b.z; v[8 * j + 7] = b.w; }
    float am = 0.f;
#pragma unroll
    for (int i = 0; i < 16; ++i) am = __builtin_fmaxf(am, __builtin_fabsf(v[i]));
    am = wave_max_f(am);
    const float sc = (am > 0.f) ? 384.0f / am : 1.0f, inv = (am > 0.f) ? am * (1.0f / 384.0f) : 1.0f;
    v4u q;
    { int w = __builtin_amdgcn_cvt_pk_fp8_f32(v[0] * sc, v[1] * sc, 0, false); w = __builtin_amdgcn_cvt_pk_fp8_f32(v[2] * sc, v[3] * sc, w, true); q.x = (unsigned)w; }
    { int w = __builtin_amdgcn_cvt_pk_fp8_f32(v[4] * sc, v[5] * sc, 0, false); w = __builtin_amdgcn_cvt_pk_fp8_f32(v[6] * sc, v[7] * sc, w, true); q.y = (unsigned)w; }
    { int w = __builtin_amdgcn_cvt_pk_fp8_f32(v[8] * sc, v[9] * sc, 0, false); w = __builtin_amdgcn_cvt_pk_fp8_f32(v[10] * sc, v[11] * sc, w, true); q.z = (unsigned)w; }
    { int w = __builtin_amdgcn_cvt_pk_fp8_f32(v[12] * sc, v[13] * sc, 0, false); w = __builtin_amdgcn_cvt_pk_fp8_f32(v[14] * sc, v[15] * sc, w, true); q.w = (unsigned)w; }
    if (!sliced) ((GAS v4u*)dst)[lane] = q;
    else { v2u q0, q1; q0.x = q.x; q0.y = q.y; q1.x = q.z; q1.y = q.w; const int s0 = lane >> 4, o8 = 8 * (lane & 15);
        *(GAS v2u*)(dst + ((size_t)s0 * NEXP + e) * 128 + o8) = q0; *(GAS v2u*)(dst + ((size_t)(s0 + 4) * NEXP + e) * 128 + o8) = q1; }
    if (lane == 0) *inv_scale = inv;
}

#define PIN_ACC2(b) asm volatile("" : "+v"(b), "+v"(acc2[0]), "+v"(acc2[1]), "+v"(acc2[2]), "+v"(acc2[3]), "+v"(acc2[4]), "+v"(acc2[5]), "+v"(acc2[6]), "+v"(acc2[7]))
#define PIN_ACC(b) asm volatile("" : "+v"(b), "+v"(acc[0]), "+v"(acc[1]), "+v"(acc[2]), "+v"(acc[3]), "+v"(acc[4]), "+v"(acc[5]), "+v"(acc[6]), "+v"(acc[7]), "+v"(acc[8]), "+v"(acc[9]), "+v"(acc[10]), "+v"(acc[11]), "+v"(acc[12]), "+v"(acc[13]), "+v"(acc[14]), "+v"(acc[15]))
#define PC_META_U(tk) do { const char* rb_ = (const char*)route + (size_t)(tk) * 1024; m_e0 = *(const GAS int*)(rb_ + l8); m_e1 = *(const GAS int*)(rb_ + 512 + l8); } while (0)
#define PC_ISSUE_U(buf, xs, par, tk) do { LAS int* lid_ = (LAS int*)(scr + (par) * 512); lid_[lane] = m_e0; lid_[lane + 64] = m_e1; LDS_WAIT(); \
        { const GAS f32x4* xq_ = (const GAS f32x4*)(x1 + (size_t)(tk) * D + 128 * s + 16 * c); const f32x4 x0_ = xq_[0], x1_ = xq_[1], x2_ = xq_[2], x3_ = xq_[3]; \
          xs[0] = x0_.x; xs[1] = x0_.y; xs[2] = x0_.z; xs[3] = x0_.w; xs[4] = x1_.x; xs[5] = x1_.y; xs[6] = x1_.z; xs[7] = x1_.w; xs[8] = x2_.x; xs[9] = x2_.y; xs[10] = x2_.z; xs[11] = x2_.w; xs[12] = x3_.x; xs[13] = x3_.y; xs[14] = x3_.z; xs[15] = x3_.w; } \
        _Pragma("unroll") for (int k = 0; k < 16; ++k) { const int e_ = lid_[8 * k + r]; buf[k] = *(const GAS v4u*)(tbs + (unsigned)(e_ * 128)); } } while (0)
#define PC_COMPUTE_U(buf, xs, tk) do { float p_[16]; \
        _Pragma("unroll") for (int k = 0; k < 16; ++k) { if (k) asm volatile("" : "+v"(buf[k]), "+v"(p_[k ? k - 1 : 0])); else asm volatile("" : "+v"(buf[k])); fp8_row_dot(buf[k], xs, p_[k]); } \
        float q8_[8], q4_[4], q2_[2]; \
        _Pragma("unroll") for (int k = 0; k < 8; ++k) { const float send = c2 ? p_[k] : p_[k + 8], keep = c2 ? p_[k + 8] : p_[k]; q8_[k] = keep + __shfl_xor(send, 4); } \
        _Pragma("unroll") for (int k = 0; k < 4; ++k) { const float send = c1 ? q8_[k] : q8_[k + 4], keep = c1 ? q8_[k + 4] : q8_[k]; q4_[k] = keep + __shfl_xor(send, 2); } \
        _Pragma("unroll") for (int k = 0; k < 2; ++k) { const float send = c0 ? q4_[k] : q4_[k + 2], keep = c0 ? q4_[k + 2] : q4_[k]; q2_[k] = keep + __shfl_xor(send, 1); } \
        GAS float* up_ = (GAS float*)(Upart + ((size_t)s * M + (tk)) * 128 + 64 * c2 + 32 * c1 + 16 * c0 + r); up_[0] = q2_[0]; up_[8] = q2_[1]; } while (0)
__device__ __forceinline__ void peer_u_phase(int s, int tok0, int tstride, int nitems, const v2u* route, const float* x1, const unsigned char* TU8s, float* Upart, LAS unsigned char* scr, int lane) {
    const int r = lane >> 3, c = lane & 7, c2 = (lane >> 2) & 1, c1 = (lane >> 1) & 1, c0 = lane & 1; const unsigned l8 = (unsigned)lane * 8u;
    const char* tbs = (const char*)TU8s + (size_t)s * NEXP * 128 + 16 * c;
    int m_e0, m_e1;
    v4u bufA[16], bufB[16]; float xsA[16], xsB[16];
    PC_META_U(tok0); PC_ISSUE_U(bufA, xsA, 0, tok0); if (nitems > 1) PC_META_U(tok0 + tstride);
#pragma unroll 1
    for (int i = 0; i < nitems; i += 2) {
        const int tk = tok0 + i * tstride;
        if (i + 1 < nitems) PC_ISSUE_U(bufB, xsB, 1, tk + tstride);
        if (i + 2 < nitems) PC_META_U(tk + 2 * tstride);
        PC_COMPUTE_U(bufA, xsA, tk);
        if (i + 1 < nitems) {
            if (i + 2 < nitems) PC_ISSUE_U(bufA, xsA, 0, tk + 2 * tstride);
            if (i + 3 < nitems) PC_META_U(tk + 3 * tstride);
            PC_COMPUTE_U(bufB, xsB, tk + tstride);
        }
    }
    LDS_WAIT();
}
#define PD_META_U(tk) do { const char* rb_ = (const char*)route + (size_t)(tk) * 1024; m_e0 = *(const GAS int*)(rb_ + l8); m_e1 = *(const GAS int*)(rb_ + 512 + l8); \
        m_x = *(const GAS f32x2*)(x1 + (size_t)(tk) * D + 128 * s + 2 * lane); } while (0)
#define PD_ISSUE_U(buf, xq, xinv, par) do { LAS int* lid_ = (LAS int*)(scr + (par) * 1024); LAS unsigned short* lx_ = (LAS unsigned short*)(scr + (par) * 1024 + 512); lid_[lane] = m_e0; lid_[lane + 64] = m_e1; LDS_WAIT(); \
        _Pragma("unroll") for (int k = 0; k < 16; ++k) { const int e_ = lid_[8 * k + r]; buf[k] = *(const GAS v4u*)(tb0 + (unsigned)(e_ * 128 + c16)); } \
        { float am_ = __builtin_fmaxf(__builtin_fabsf(m_x.x), __builtin_fabsf(m_x.y)); \
          _Pragma("unroll") for (int o_ = 1; o_ < 64; o_ <<= 1) am_ = __builtin_fmaxf(am_, __shfl_xor(am_, o_)); \
          const float sc_ = (am_ > 0.f) ? 127.0f / am_ : 0.f; xinv = am_ * (1.0f / 127.0f); \
          const int q0_ = (int)__builtin_rintf(m_x.x * sc_), q1_ = (int)__builtin_rintf(m_x.y * sc_); lx_[lane] = (unsigned short)(((unsigned)q0_ & 255u) | (((unsigned)q1_ & 255u) << 8)); } \
        LDS_WAIT(); xq = *(const LAS v4u*)((LAS unsigned char*)lx_ + 16 * c); } while (0)
#define PD_COMPUTE_U(buf, xq, xinv, tk) do { int p_[16]; \
        _Pragma("unroll") for (int k = 0; k < 16; ++k) { int a_ = __builtin_amdgcn_sdot4((int)buf[k].x, (int)xq.x, 0, false); a_ = __builtin_amdgcn_sdot4((int)buf[k].y, (int)xq.y, a_, false); \
            a_ = __builtin_amdgcn_sdot4((int)buf[k].z, (int)xq.z, a_, false); a_ = __builtin_amdgcn_sdot4((int)buf[k].w, (int)xq.w, a_, false); p_[k] = a_; } \
        int q8_[8], q4_[4], q2_[2]; \
        _Pragma("unroll") for (int k = 0; k < 8; ++k) { const int send = c2 ? p_[k] : p_[k + 8], keep = c2 ? p_[k + 8] : p_[k]; q8_[k] = keep + __shfl_xor(send, 4); } \
        _Pragma("unroll") for (int k = 0; k < 4; ++k) { const int send = c1 ? q8_[k] : q8_[k + 4], keep = c1 ? q8_[k + 4] : q8_[k]; q4_[k] = keep + __shfl_xor(send, 2); } \
        _Pragma("unroll") for (int k = 0; k < 2; ++k) { const int send = c0 ? q4_[k] : q4_[k + 2], keep = c0 ? q4_[k + 2] : q4_[k]; q2_[k] = keep + __shfl_xor(send, 1); } \
        GAS float* up_ = (GAS float*)(Upart + ((size_t)s * M + (tk)) * 128 + 64 * c2 + 32 * c1 + 16 * c0 + r); up_[0] = (float)q2_[0] * xinv; up_[8] = (float)q2_[1] * xinv; } while (0)
__device__ __forceinline__ void peer_u_phase_dot4(int s, int tok0, int tstride, int nitems, const v2u* route, const float* x1, const unsigned char* TU8s, float* Upart, LAS unsigned char* scr, int lane) {
    const int r = lane >> 3, c = lane & 7, c2 = (lane >> 2) & 1, c1 = (lane >> 1) & 1, c0 = lane & 1; const unsigned l8 = (unsigned)lane * 8u;
    const char* tb0 = (const char*)TU8s + (size_t)s * NEXP * 128; const int c16 = 16 * c;
    int m_e0, m_e1; f32x2 m_x;
    v4u bufA[16], bufB[16], xqA, xqB; float xiA, xiB;
    PD_META_U(tok0); PD_ISSUE_U(bufA, xqA, xiA, 0); if (nitems > 1) PD_META_U(tok0 + tstride);
#pragma unroll 1
    for (int it = 0; it < nitems; it += 2) {
        const int tk = tok0 + it * tstride;
        if (it + 1 < nitems) PD_ISSUE_U(bufB, xqB, xiB, 1);
        if (it + 2 < nitems) PD_META_U(tk + 2 * tstride);
        PD_COMPUTE_U(bufA, xqA, xiA, tk);
        if (it + 1 < nitems) {
            if (it + 2 < nitems) PD_ISSUE_U(bufA, xqA, xiA, 0);
            if (it + 3 < nitems) PD_META_U(tk + 3 * tstride);
            PD_COMPUTE_U(bufB, xqB, xiB, tk + tstride);
        }
    }
    LDS_WAIT();
}
__device__ __forceinline__ void peer_w_token(int tok, const v2u* route, const float* x1, const float* Upart, const float* SU, const float* SV, float* W, int lane) {
    const GAS f32x4* xp = (const GAS f32x4*)(x1 + (size_t)tok * D) + lane; float ssq = 0.f;
#pragma unroll
    for (int j = 0; j < 4; ++j) { const f32x4 q = xp[64 * j]; ssq += (q.x * q.x + q.y * q.y) + (q.z * q.z + q.w * q.w); }
    const float rstd2 = 1.0f / sqrtf(wave_sum(ssq) * (1.0f / D) + RMS_EPS);
    const char* rb_ = (const char*)route + (size_t)tok * 1024; const unsigned l8_ = (unsigned)lane * 8u;
    const v2u r_lo = *(const GAS v2u*)(rb_ + l8_), r_hi = *(const GAS v2u*)(rb_ + 512 + l8_);
    float g_lo, g_hi;
#pragma unroll
    for (int half = 0; half < 2; ++half) {
        const float sc_ = __builtin_bit_cast(float, half ? r_hi.y : r_lo.y) * rstd2; float m_ = sc_;
#pragma unroll
        for (int o = 1; o < 16; o <<= 1) m_ = __builtin_fmaxf(m_, __shfl_xor(m_, o));
        const float p_ = __builtin_amdgcn_exp2f((sc_ - m_) * 1.4426950408889634f); float sum_ = p_;
#pragma unroll
        for (int o = 1; o < 16; o <<= 1) sum_ += __shfl_xor(sum_, o);
        if (half) g_hi = p_ / sum_; else g_lo = p_ / sum_;
    }
    asm volatile("" : "+v"(g_lo), "+v"(g_hi));
#pragma unroll
    for (int half = 0; half < 2; ++half) {
        const int e = (int)(half ? r_hi.x : r_lo.x); const int n = lane + 64 * half;
        float dot = 0.f;
#pragma unroll
        for (int s8 = 0; s8 < 8; ++s8) dot += Upart[((size_t)s8 * M + tok) * 128 + n];
        const float act = gelu_exact(dot * SU[e] * rstd2);
        W[(size_t)tok * 128 + n] = (half ? g_hi : g_lo) * act * SV[e];
    }
}
#define PC_META_V(tk) do { const char* rb_ = (const char*)route + (size_t)(tk) * 1024; m_e0 = *(const GAS int*)(rb_ + l8); m_e1 = *(const GAS int*)(rb_ + 512 + l8); \
        const GAS float* wp_ = (const GAS float*)(W + (size_t)(tk) * 128); m_w0 = wp_[lane]; m_w1 = wp_[lane + 64]; m_xv = *(const GAS f32x2*)(xio + (size_t)(tk) * D + col0); } while (0)
#define PC_ISSUE_V(buf, wk, xv, par) do { LAS int* lid_ = (LAS int*)(scr + (par) * 1024); LAS float* lw_ = (LAS float*)(scr + (par) * 1024 + 512); lid_[lane] = m_e0; lid_[lane + 64] = m_e1; lw_[lane] = m_w0; lw_[lane + 64] = m_w1; LDS_WAIT(); xv = m_xv; \
        _Pragma("unroll") for (int k = 0; k < 16; ++k) { const int e_ = lid_[8 * k + r]; wk[k] = lw_[8 * k + r]; buf[k] = *(const GAS v4u*)(tb0 + (unsigned)(e_ * 128 + c16)); } } while (0)
#define PC_COMPUTE_V(buf, wk, xv, tk) do { f32x2 acc2[8]; _Pragma("unroll") for (int i_ = 0; i_ < 8; ++i_) acc2[i_] = (f32x2){0.f, 0.f}; \
        _Pragma("unroll") for (int k = 0; k < 16; ++k) { PIN_ACC2(buf[k]); fp8_row_axpy2(buf[k], wk[k], acc2); } \
        float acc[16]; _Pragma("unroll") for (int i_ = 0; i_ < 8; ++i_) { acc[2 * i_] = acc2[i_].x; acc[2 * i_ + 1] = acc2[i_].y; } \
        float r8_[8], r4_[4], r2_[2]; \
        _Pragma("unroll") for (int i_ = 0; i_ < 8; ++i_) { const float send = b5 ? acc[i_] : acc[i_ + 8], keep = b5 ? acc[i_ + 8] : acc[i_]; r8_[i_] = keep + __shfl_xor(send, 32); } \
        _Pragma("unroll") for (int i_ = 0; i_ < 4; ++i_) { const float send = b4 ? r8_[i_] : r8_[i_ + 4], keep = b4 ? r8_[i_ + 4] : r8_[i_]; r4_[i_] = keep + __shfl_xor(send, 16); } \
        _Pragma("unroll") for (int i_ = 0; i_ < 2; ++i_) { const float send = b3 ? r4_[i_] : r4_[i_ + 2], keep = b3 ? r4_[i_ + 2] : r4_[i_]; r2_[i_] = keep + __shfl_xor(send, 8); } \
        f32x2 o_ = xv; o_.x += r2_[0]; o_.y += r2_[1]; *(GAS f32x2*)(xio + (size_t)(tk) * D + col0) = o_; } while (0)
__device__ __forceinline__ void peer_v_phase(int s, int tok0, int tstride, int nitems, const v2u* route, const float* W, const unsigned char* TV8s, float* xio, float* SS, LAS unsigned char* scr, int lane) {
    const int r = lane >> 3, c = lane & 7, b5 = lane >> 5, b4 = (lane >> 4) & 1, b3 = (lane >> 3) & 1; const unsigned l8 = (unsigned)lane * 8u;
    const int col0 = 128 * s + 16 * c + 8 * b5 + 4 * b4 + 2 * b3;
    const char* tb0 = (const char*)TV8s + (size_t)s * NEXP * 128; const int c16 = 16 * c;
    int m_e0, m_e1; float m_w0, m_w1; f32x2 m_xv;
    v4u bufA[16], bufB[16]; float wA[16], wB[16]; f32x2 xvA, xvB;
    PC_META_V(tok0); PC_ISSUE_V(bufA, wA, xvA, 0); if (nitems > 1) PC_META_V(tok0 + tstride);
#pragma unroll 1
    for (int i = 0; i < nitems; i += 2) {
        const int tk = tok0 + i * tstride;
        if (i + 1 < nitems) PC_ISSUE_V(bufB, wB, xvB, 1);
        if (i + 2 < nitems) PC_META_V(tk + 2 * tstride);
        PC_COMPUTE_V(bufA, wA, xvA, tk);
        if (i + 1 < nitems) {
            if (i + 2 < nitems) PC_ISSUE_V(bufA, wA, xvA, 0);
            if (i + 3 < nitems) PC_META_V(tk + 3 * tstride);
            PC_COMPUTE_V(bufB, wB, xvB, tk + tstride);
        }
    }
    LDS_WAIT();
}


__device__ __forceinline__ void peer_u_debug(int tok, const v2u* route, const float* x1, const unsigned char* TU8s, const float* SU, const float* SV, float* W, int lane) {
    float xr[16], ssq = 0.f;
    { const GAS f32x4* xp = (const GAS f32x4*)(x1 + (size_t)tok * D + 16 * lane);
#pragma unroll
      for (int j = 0; j < 4; ++j) { const f32x4 a = xp[j]; xr[4 * j] = a.x; xr[4 * j + 1] = a.y; xr[4 * j + 2] = a.z; xr[4 * j + 3] = a.w; } }
#pragma unroll
    for (int i = 0; i < 16; ++i) ssq += xr[i] * xr[i];
    const float rstd2 = 1.0f / sqrtf(wave_sum(ssq) * (1.0f / D) + RMS_EPS);
    const char* rb_ = (const char*)route + (size_t)tok * 1024; const int s = lane >> 3, c = lane & 7;
#pragma unroll 1
    for (int h = 0; h < 8; ++h) {
        float sc[16]; int id[16]; float m = -3e38f;
#pragma unroll
        for (int i = 0; i < 16; ++i) { const v2u r = *(const GAS v2u*)(rb_ + (h * 16 + i) * 8 + opaque_zero()); id[i] = (int)r.x; sc[i] = __builtin_bit_cast(float, r.y) * rstd2; m = __builtin_fmaxf(m, sc[i]); }
        float sum = 0.f;
#pragma unroll
        for (int i = 0; i < 16; ++i) { sc[i] = __builtin_amdgcn_exp2f((sc[i] - m) * 1.4426950408889634f); sum += sc[i]; }
#pragma unroll
        for (int i = 0; i < 16; ++i) { const int e = id[i];
            const v4u q = *(const GAS v4u*)(TU8s + ((size_t)s * NEXP + e) * 128 + 16 * c);
            float d; fp8_row_dot(q, xr, d); d = wave_sum(d);
            const float act = gelu_exact(d * SU[e] * rstd2);
            if (lane == 0) W[(size_t)tok * 128 + h * 16 + i] = (sc[i] / sum) * act * SV[e]; }
    }
}
__device__ __forceinline__ void peer_v_debug(int tok, const v2u* route, const float* W, const unsigned char* TV8s, float* xio, float* SS, int lane) {
    const char* rb_ = (const char*)route + (size_t)tok * 1024;
    float acc[16];
#pragma unroll
    for (int i = 0; i < 16; ++i) acc[i] = 0.f;
    const int s = lane >> 3, c = lane & 7;
#pragma unroll 1
    for (int n = 0; n < 128; ++n) {
        const int e = *(const GAS int*)(rb_ + n * 8 + opaque_zero()); const float w = W[(size_t)tok * 128 + n + opaque_zero()];
        const v4u q = *(const GAS v4u*)(TV8s + ((size_t)s * NEXP + e) * 128 + 16 * c);
        fp8_row_axpy(q, w, acc);
    }
    float ssq = 0.f;
    GAS float* xp = (GAS float*)(xio + (size_t)tok * D + 16 * lane);
#pragma unroll
    for (int i = 0; i < 16; ++i) { const float o = xp[i] + acc[i]; xp[i] = o; ssq += o * o; }
    ssq = wave_sum(ssq);
    if (lane < 8) SS[(size_t)lane * M + tok] = (lane == 0) ? ssq : 0.f;
}
#ifndef DUP_MASK
#define DUP_MASK 0
#endif
#define NREP(k) (1 + ((DUP_MASK >> (k)) & 1))
struct Args { const float* in[14]; float* out; unsigned char* ws; int ph_lo, ph_hi, li, pad; };
__global__ void __launch_bounds__(NWAVES * 64, 2) hybrid_fwd(Args args) {
    extern __shared__ __attribute__((aligned(16))) unsigned char lds[];
    LAS unsigned char* ldsb = (LAS unsigned char*)lds;
    volatile LAS unsigned* MISC = (volatile LAS unsigned*)(ldsb + MISC_OFF);
    const int tid = threadIdx.x, lane = tid & 63, wave = __builtin_amdgcn_readfirstlane(tid >> 6);
    const int G = gridDim.x; const int bx = blockIdx.x; const int vcu = (G % 8 == 0) ? (bx % 8) * (G / 8) + bx / 8 : bx;
    const int gw = vcu * NWAVES + wave, NGW = G * NWAVES;
    unsigned char* ws = args.ws;
    gu32* ctl = (gu32*)(ws + WS_CTL);
    const float* x = args.in[0]; float* out = args.out;
#define norm_mix (args.in[1])
#define w_in (args.in[2])
#define conv_w (args.in[3])
#define conv_b (args.in[4])
#define w_a (args.in[5])
#define w_b (args.in[6])
#define w_o (args.in[7])
#define norm_ffn (args.in[8])
#define w_q (args.in[9])
#define sub_keys (args.in[10])
#define exp_u (args.in[11])
#define exp_v (args.in[12])
#define final_norm (args.in[13])
#define Weff ((bf16*)((bf16*)(ws + WS_WEFF)))
#define Wab ((bf16*)((bf16*)(ws + WS_WAB)))
#define Wo_t ((bf16*)((bf16*)(ws + WS_WO)))
#define Win_t ((bf16*)((bf16*)(ws + WS_WIN)))
#define XB ((bf16*)((bf16*)(ws + WS_XB)))
#define SIX ((bf16*)((bf16*)(ws + WS_SIX)))
#define VT ((bf16*)((bf16*)(ws + WS_VT)))
#define GATE ((bf16*)((bf16*)(ws + WS_GATE)))
#define MERGED ((bf16*)((bf16*)(ws + WS_MERGED)))
#define X1B ((bf16*)((bf16*)(ws + WS_X1B)))
#define TU8 ((unsigned char*)(ws + WS_TU))
#define TV8 ((unsigned char*)(ws + WS_TV))
#define SU ((float*)((float*)(ws + WS_SU)))
#define SV ((float*)((float*)(ws + WS_SV)))
#define SCORES ((float*)((float*)(ws + WS_SCORES)))
#define ROUTE ((v2u*)((v2u*)(ws + WS_ROUTE)))
#define WBUF ((float*)((float*)(ws + WS_W)))
#define SSB ((float*)((float*)(ws + WS_SS)))
#define UPART ((float*)((float*)(ws + WS_UPART)))
#define RSTD1 ((float*)((float*)(ws + WS_RSTD1)))
#define QB ((bf16*)(SIX))
#define CBB ((bf16*)(SIX + (size_t)1 * M * 512))
#define KB ((bf16*)(SIX + (size_t)2 * M * 512))
#define CCB ((bf16*)(SIX + (size_t)4 * M * 512))
#define CUB ((bf16*)(SIX + (size_t)5 * M * 512))
    for (int u = tid; u < (LDS_BYTES - LDSCTL_OFF) / 4; u += NWAVES * 64) ((LAS unsigned*)(ldsb + LDSCTL_OFF))[u] = 0u;
    __syncthreads();
    XcdBarrier bar; bar.bar = (unsigned*)(ctl + CW_BAR); bar.x = 0; bar.st = nullptr;
    if (N_LAUNCHES == 1) bar = xcd_barrier_post((unsigned*)(ctl + CW_BAR), MISC + 8);
#define GRID_BAR() do { if (N_LAUNCHES == 1) xcd_barrier(bar); } while (0)
    const int lo = args.ph_lo, hi = args.ph_hi;
#define IN(k) (lo <= (k) && (k) < hi)
#define BOTH(k) (IN(k) && IN((k) + 1))

    if (IN(0)) { for (int rep = 0; rep < NREP(0); ++rep) {
        LAS float* scr = (LAS float*)(ldsb + RING_OFF + wave * 16384);
        constexpr int I_IN = (D / 64) * (NIN / 32), I_A = (512 / 64) * (D / 32), I_O = (D / 64) * (D / 32);
        constexpr int NITEMS = I_IN + 2 * I_A + I_O;
        constexpr int ABW = 3; const int aw = vcu * ABW + wave, NAW = G * ABW, cw = vcu * (NWAVES - ABW) + (wave - ABW), NCW = G * (NWAVES - ABW);
        if (wave < ABW) {
        for (int it = aw; it < NITEMS; it += NAW) {
            int r = it;
            if (r < I_IN) { p0_transpose_item(w_in, D, NIN, Win_t, 0, norm_mix, scr, r, lane); continue; } r -= I_IN;
            if (r < I_A) { p0_transpose_item(w_a, 512, D, Wab, 0, nullptr, scr, r, lane); continue; } r -= I_A;
            if (r < I_A) { p0_transpose_item(w_b, 512, D, Wab, 1024, nullptr, scr, r, lane); continue; } r -= I_A;
            p0_transpose_item(w_o, D, D, Wo_t, 0, nullptr, scr, r, lane);
        }
        for (int wt = aw; wt < 64 * 32; wt += NAW) {
            const int nt = wt & 63, kt = wt >> 6, hp = nt >> 2, h = lane >> 5, l32 = lane & 31;
            const GAS f32x4* ap = (const GAS f32x4*)(w_q + (size_t)(kt * 32 + l32) * 2048 + hp * 128 + 64 * h);
            const GAS f32x4* bp = (const GAS f32x4*)(sub_keys + (size_t)(nt * 32 + l32) * 128 + 64 * h);
            f32x4 av[16], bv[16];
#pragma unroll
            for (int i = 0; i < 16; ++i) { av[i] = ap[i]; bv[i] = bp[i]; }
            f32x16 acc;
#pragma unroll
            for (int i = 0; i < 16; ++i) acc[i] = 0.f;
#pragma unroll
            for (int i = 0; i < 16; ++i) {
                acc = __builtin_amdgcn_mfma_f32_32x32x2f32(av[i].x, bv[i].x, acc, 0, 0, 0); acc = __builtin_amdgcn_mfma_f32_32x32x2f32(av[i].y, bv[i].y, acc, 0, 0, 0);
                acc = __builtin_amdgcn_mfma_f32_32x32x2f32(av[i].z, bv[i].z, acc, 0, 0, 0); acc = __builtin_amdgcn_mfma_f32_32x32x2f32(av[i].w, bv[i].w, acc, 0, 0, 0); }
            const int n = nt * 32 + l32;
#pragma unroll
            for (int rq = 0; rq < 4; ++rq) { const int kb = kt * 32 + 8 * rq + 4 * h; const f32x4 g = *(const GAS f32x4*)(norm_ffn + kb);
                v2u o; o.x = pk2(acc[4 * rq] * g.x, acc[4 * rq + 1] * g.y); o.y = pk2(acc[4 * rq + 2] * g.z, acc[4 * rq + 3] * g.w);
                *(GAS v2u*)(Weff + (size_t)n * D + kb) = o; }
        }
        } else {
        for (int m0 = cw; m0 < M; m0 += 4 * NCW) {
            f32x4 v[4][4]; float s[4];
#pragma unroll
            for (int q = 0; q < 4; ++q) { const int m = m0 + q * NCW; const GAS f32x4* xr = (const GAS f32x4*)(x + (size_t)(m < M ? m : m0) * D) + lane;
#pragma unroll
                for (int j = 0; j < 4; ++j) v[q][j] = xr[64 * j]; }
#pragma unroll
            for (int q = 0; q < 4; ++q) { s[q] = 0.f;
#pragma unroll
                for (int j = 0; j < 4; ++j) s[q] += (v[q][j].x * v[q][j].x + v[q][j].y * v[q][j].y) + (v[q][j].z * v[q][j].z + v[q][j].w * v[q][j].w); }
#pragma unroll
            for (int o = 1; o < 64; o <<= 1) {
#pragma unroll
                for (int q = 0; q < 4; ++q) s[q] += __shfl_xor(s[q], o); }
#pragma unroll
            for (int q = 0; q < 4; ++q) { const int m = m0 + q * NCW; if (m < M) {
                const float rstd = 1.0f / sqrtf(s[q] * (1.0f / D) + RMS_EPS);
                GAS v2u* o8 = (GAS v2u*)(XB + (size_t)m * D) + lane;
#pragma unroll
                for (int j = 0; j < 4; ++j) { v2u o; o.x = pk2(v[q][j].x, v[q][j].y); o.y = pk2(v[q][j].z, v[q][j].w); o8[64 * j] = o; }
                if (lane == 0) RSTD1[m] = rstd; } }
        }
        for (int e0 = cw; e0 < NEXP; e0 += 2 * NCW) {
            float v[4][16]; float am[4]; int ee[4];
#pragma unroll
            for (int q = 0; q < 4; ++q) { const int e = e0 + (q >> 1) * NCW; ee[q] = e < NEXP ? e : e0; const float* src = ((q & 1) ? exp_v : exp_u) + (size_t)ee[q] * D; const GAS f32x4* sp = (const GAS f32x4*)src;
#pragma unroll
                for (int j = 0; j < 2; ++j) { const f32x4 a = sp[2 * lane + 128 * j], b = sp[2 * lane + 128 * j + 1];
                    v[q][8 * j + 0] = a.x; v[q][8 * j + 1] = a.y; v[q][8 * j + 2] = a.z; v[q][8 * j + 3] = a.w; v[q][8 * j + 4] = b.x; v[q][8 * j + 5] = b.y; v[q][8 * j + 6] = b.z; v[q][8 * j + 7] = b.w; } }
            { const GAS f32x4* gp = (const GAS f32x4*)norm_ffn;
#pragma unroll
              for (int j = 0; j < 2; ++j) { const f32x4 ga = gp[2 * lane + 128 * j], gb = gp[2 * lane + 128 * j + 1];
#pragma unroll
                for (int q = 0; q < 4; q += 2) { v[q][8 * j + 0] *= ga.x; v[q][8 * j + 1] *= ga.y; v[q][8 * j + 2] *= ga.z; v[q][8 * j + 3] *= ga.w; v[q][8 * j + 4] *= gb.x; v[q][8 * j + 5] *= gb.y; v[q][8 * j + 6] *= gb.z; v[q][8 * j + 7] *= gb.w; } } }
#pragma unroll
            for (int q = 0; q < 4; ++q) { am[q] = 0.f;
#pragma unroll
                for (int i = 0; i < 16; ++i) am[q] = __builtin_fmaxf(am[q], __builtin_fabsf(v[q][i])); }
#pragma unroll
            for (int o = 1; o < 64; o <<= 1) {
#pragma unroll
                for (int q = 0; q < 4; ++q) am[q] = __builtin_fmaxf(am[q], __shfl_xor(am[q], o)); }
#pragma unroll
            for (int q = 0; q < 4; ++q) { const int e = e0 + (q >> 1) * NCW; if (e < NEXP) {
                const float top = (q & 1) ? 384.0f : 127.0f;
                const float sc = (am[q] > 0.f) ? top / am[q] : 1.0f, inv = (am[q] > 0.f) ? am[q] * (1.0f / top) : 1.0f;
                v2u q0, q1;
                if (q & 1) {
                { int w = __builtin_amdgcn_cvt_pk_fp8_f32(v[q][0] * sc, v[q][1] * sc, 0, false); w = __builtin_amdgcn_cvt_pk_fp8_f32(v[q][2] * sc, v[q][3] * sc, w, true); q0.x = (unsigned)w; }
                { int w = __builtin_amdgcn_cvt_pk_fp8_f32(v[q][4] * sc, v[q][5] * sc, 0, false); w = __builtin_amdgcn_cvt_pk_fp8_f32(v[q][6] * sc, v[q][7] * sc, w, true); q0.y = (unsigned)w; }
                { int w = __builtin_amdgcn_cvt_pk_fp8_f32(v[q][8] * sc, v[q][9] * sc, 0, false); w = __builtin_amdgcn_cvt_pk_fp8_f32(v[q][10] * sc, v[q][11] * sc, w, true); q1.x = (unsigned)w; }
                { int w = __builtin_amdgcn_cvt_pk_fp8_f32(v[q][12] * sc, v[q][13] * sc, 0, false); w = __builtin_amdgcn_cvt_pk_fp8_f32(v[q][14] * sc, v[q][15] * sc, w, true); q1.y = (unsigned)w; }
                } else {
                    unsigned w4[4];
#pragma unroll
                    for (int j = 0; j < 4; ++j) { const int i0 = (int)__builtin_rintf(v[q][4 * j] * sc), i1 = (int)__builtin_rintf(v[q][4 * j + 1] * sc), i2 = (int)__builtin_rintf(v[q][4 * j + 2] * sc), i3 = (int)__builtin_rintf(v[q][4 * j + 3] * sc);
                        w4[j] = ((unsigned)i0 & 255u) | (((unsigned)i1 & 255u) << 8) | (((unsigned)i2 & 255u) << 16) | ((unsigned)i3 << 24); }
                    q0.x = w4[0]; q0.y = w4[1]; q1.x = w4[2]; q1.y = w4[3];
                }
                unsigned char* dst = (q & 1) ? TV8 : TU8; const int s0 = lane >> 4, o8 = 8 * (lane & 15);
                *(GAS v2u*)(dst + ((size_t)s0 * NEXP + e) * 128 + o8) = q0; *(GAS v2u*)(dst + ((size_t)(s0 + 4) * NEXP + e) * 128 + o8) = q1;
                if (lane == 0) ((q & 1) ? SV : SU)[e] = inv; } }
        }
                }
}
        if (BOTH(0)) GRID_BAR();
    }

    if (IN(1)) { for (int rep = 0; rep < NREP(1); ++rep) { if (rep) GRID_BAR();
        pg8::Gemm g{XB, Win_t, M, NIN, D}; pg8::StaticOrder S; S.init(M, NIN, G, (int)blockIdx.x);
        pg8::EpiProj E{SIX, VT, GATE, RSTD1, (DUP_MASK & 64) ? rep : 0};
        pg8::gemm_phase<pg8::EpiProj, pg8::StaticOrder, true, true>(ldsb + RING_OFF, g, S, E); }
        if (DUP_MASK & 128) { const unsigned long long t0 = __builtin_amdgcn_s_memrealtime(); while (__builtin_amdgcn_s_memrealtime() - t0 < 15000ull) __builtin_amdgcn_s_sleep(8); }
        if (BOTH(1)) GRID_BAR();
    }

    if (IN(2)) {
        for (int rep = 0; rep < NREP(2); ++rep) {
        const bool dummy = (rep + 1 < NREP(2));
        conv_phase(CBB, CCB, CUB, dummy ? XB : CBB, conv_w, conv_b, gw * 64 + lane, NGW * 64);
        for (int it = gw; it < BATCH * NH * (T / 32); it += NGW) {
            const int bh = it >> 7, qblk = it & 127;
            attn_item(QB, KB, VT, dummy ? MERGED : QB, bh >> 3, bh & 7, qblk, lane);
        }
        }
        if (BOTH(2)) GRID_BAR();
    }

    if (IN(3)) { for (int rep = 0; rep < NREP(3); ++rep) { if (rep) GRID_BAR();
        pg8::Gemm g{QB, Wab, 2 * M, 2048, 512}; pg8::PairOrder S; S.init(G, (int)blockIdx.x);
        pg8::EpiGate E{out, MERGED, GATE, GATE + (size_t)M * 1024};
        pg8::gemm_phase<pg8::EpiGate, pg8::PairOrder, true, true>(ldsb + RING_OFF, g, S, E); }
        if (BOTH(3)) GRID_BAR();
    }

    if (IN(4)) { for (int rep = 0; rep < NREP(4); ++rep) { if (rep) GRID_BAR();
        pg8::Gemm g{MERGED, Wo_t, M, D, D}; pg8::StaticOrder S; S.init(M, D, G, (int)blockIdx.x);
        pg8::EpiWo E{x, out, X1B};
        pg8::gemm_phase<pg8::EpiWo, pg8::StaticOrder, false, true>(ldsb + RING_OFF, g, S, E);
        }
        if (BOTH(4)) GRID_BAR();
    }

    if (IN(5)) { for (int rep = 0; rep < NREP(5); ++rep) { if (rep) GRID_BAR();
        pg8::Gemm g{X1B, Weff, M, 2048, D}; pg8::StaticOrder S; S.init(M, 2048, G, (int)blockIdx.x);
        pg8::EpiScores E{(unsigned short*)SCORES};
        pg8::gemm_phase<pg8::EpiScores, pg8::StaticOrder, true, true>(ldsb + RING_OFF, g, S, E);
        asm volatile("s_waitcnt vmcnt(0)" ::: "memory"); __syncthreads();
        int nu = 0; { pg8::Unit u; while (S.next(nu, u)) ++nu; }
        LAS unsigned char* scr = ldsb + RING_OFF + wave * 8192;
        for (int t = wave; t < nu * 4; t += NWAVES) { pg8::Unit u; S.next(t >> 2, u); route_task((const unsigned short*)SCORES, ROUTE, u.pm * 256 + (t & 3) * 64, u.pn, scr, lane); } }
        if (BOTH(5)) GRID_BAR();
    }
    const bool sliced_ok = (G % 8 == 0) && (M % ((G / 8) * NWAVES) == 0);

    if (IN(7)) {
        LAS unsigned char* scr = ldsb + RING_OFF + wave * 2048;
#ifdef DEBUG_U
        if (1) {} else
#endif
        if (sliced_ok) { const int nj = G >> 3; peer_u_phase_dot4(bx & 7, (bx >> 3) * NWAVES + wave, nj * NWAVES, M / (nj * NWAVES), ROUTE, out, TU8, UPART, scr, lane); }
        else for (int s8 = 0; s8 < 8; ++s8) { const int nt = (M - 1 - gw) / NGW + 1; if (gw < M) peer_u_phase_dot4(s8, gw, NGW, nt, ROUTE, out, TU8, UPART, scr, lane); }
        if (BOTH(7)) GRID_BAR();
    }

    if (IN(8)) {
#ifdef DEBUG_U
        for (int tok = gw; tok < M; tok += NGW) peer_u_debug(tok, ROUTE, out, TU8, SU, SV, WBUF, lane);
#else
        for (int tok = gw; tok < M; tok += NGW) peer_w_token(tok, ROUTE, out, UPART, SU, SV, WBUF, lane);
#endif
        if (BOTH(8)) GRID_BAR();
    }

    if (IN(9)) {
        LAS unsigned char* scr = ldsb + RING_OFF + wave * 2048;
#ifdef DEBUG_V
        for (int tok = gw; tok < M; tok += NGW) peer_v_debug(tok, ROUTE, WBUF, TV8, out, SSB, lane);
        if (0)
#endif
        if (sliced_ok) { const int nj = G >> 3; peer_v_phase(bx & 7, (bx >> 3) * NWAVES + wave, nj * NWAVES, M / (nj * NWAVES), ROUTE, WBUF, TV8, out, SSB, scr, lane); }
        else for (int s8 = 0; s8 < 8; ++s8) { const int nt = (M - 1 - gw) / NGW + 1; if (gw < M) peer_v_phase(s8, gw, NGW, nt, ROUTE, WBUF, TV8, out, SSB, scr, lane); }
        if (BOTH(9)) GRID_BAR();
    }

    if (IN(10)) {
        for (int tok = gw; tok < M; tok += NGW) {
            GAS f32x4* op = (GAS f32x4*)(out + (size_t)tok * D) + lane; const GAS f32x4* gp = (const GAS f32x4*)final_norm + lane;
            f32x4 v[4]; float s2 = 0.f;
#pragma unroll
            for (int j = 0; j < 4; ++j) { v[j] = op[64 * j]; s2 += (v[j].x * v[j].x + v[j].y * v[j].y) + (v[j].z * v[j].z + v[j].w * v[j].w); }
            const float rstd3 = 1.0f / sqrtf(wave_sum(s2) * (1.0f / D) + RMS_EPS);
#pragma unroll
            for (int j = 0; j < 4; ++j) { const f32x4 g = gp[64 * j]; f32x4 o; o.x = v[j].x * rstd3 * g.x; o.y = v[j].y * rstd3 * g.y; o.z = v[j].z * rstd3 * g.z; o.w = v[j].w * rstd3 * g.w; op[64 * j] = o; }
        }
    }
#undef IN
#undef BOTH
#undef GRID_BAR
#undef norm_mix
#undef w_in
#undef conv_w
#undef conv_b
#undef w_a
#undef w_b
#undef w_o
#undef norm_ffn
#undef w_q
#undef sub_keys
#undef exp_u
#undef exp_v
#undef final_norm
#undef Weff
#undef Wab
#undef Wo_t
#undef Win_t
#undef XB
#undef SIX
#undef VT
#undef GATE
#undef MERGED
#undef X1B
#undef TU8
#undef TV8
#undef SU
#undef SV
#undef SCORES
#undef ROUTE
#undef WBUF
#undef SSB
#undef UPART
#undef RSTD1
#undef QB
#undef CBB
#undef KB
#undef CCB
#undef CUB
}

extern "C" void kernel_launch(void* const* d_in, const int* in_sizes, int n_in, void* d_out, int out_size, void* d_ws, size_t ws_size, hipStream_t stream) {
    static int grid = 0;
    if (grid == 0) {
        if (n_in != 14 || in_sizes[0] != M * D || out_size != M * D || ws_size < WS_END) { fprintf(stderr, "kernel_launch: built for 14 inputs, x/out of %d floats, >= %zu bytes of workspace; got n_in %d, in0 %d, out %d, ws %zu; nothing launched\n", M * D, (size_t)WS_END, n_in, n_in > 0 ? in_sizes[0] : -1, out_size, ws_size); grid = -1; return; }
        int dev = 0, cus = 0, per_cu = 0;
        if (hipGetDevice(&dev) != hipSuccess || hipDeviceGetAttribute(&cus, hipDeviceAttributeMultiprocessorCount, dev) != hipSuccess) { fprintf(stderr, "kernel_launch: device query failed\n"); grid = -1; return; }
        if (hipFuncSetAttribute((const void*)hybrid_fwd, hipFuncAttributeMaxDynamicSharedMemorySize, LDS_BYTES) != hipSuccess) { fprintf(stderr, "kernel_launch: hipFuncSetAttribute failed\n"); grid = -1; return; }
        if (hipOccupancyMaxActiveBlocksPerMultiprocessor(&per_cu, (const void*)hybrid_fwd, NWAVES * 64, LDS_BYTES) != hipSuccess || per_cu < 1) { fprintf(stderr, "kernel_launch: occupancy query reports %d workgroups per CU\n", per_cu); per_cu = 1; }
        (void)hipGetLastError();
        grid = cus;
    }
    if (grid < 0) return;
    if (hipMemsetAsync((char*)d_ws + WS_CTL, 0, CTL_ZERO_BYTES, stream) != hipSuccess) { fprintf(stderr, "kernel_launch: hipMemsetAsync failed\n"); return; }
    Args a{};
    for (int i = 0; i < 14; ++i) a.in[i] = (const float*)d_in[i];
    a.out = (float*)d_out; a.ws = (unsigned char*)d_ws;
#ifdef PROBE_SEQ
    const int seq[] = PROBE_SEQ; const int nseq = (int)(sizeof(seq) / sizeof(int));
#else
    const int seq[] = {0, 1, 2, 3, 4, 5, 6, 7, 8, 9, 10}; const int nseq = (N_LAUNCHES == 1) ? 1 : 11;
#endif
    for (int li = 0; li < nseq; ++li) {
        a.ph_lo = (N_LAUNCHES == 1) ? 0 : seq[li]; a.ph_hi = (N_LAUNCHES == 1) ? N_PHASES : seq[li] + 1; a.li = li;
        hipLaunchKernelGGL(hybrid_fwd, dim3(grid), dim3(NWAVES * 64), LDS_BYTES, stream, a);
        const hipError_t le = hipPeekAtLastError();
        if (le != hipSuccess) { fprintf(stderr, "kernel_launch: launch %d failed: %s\n", li, hipGetErrorName(le)); break; }
    }
}
```

```cpp
#define DUP_MASK 0
#include <hip/hip_runtime.h>
#include <cstdio>
#include <cstdint>
#include <cmath>
namespace pg8 {
#define PG8_LAS __attribute__((address_space(3)))
typedef unsigned short bf16_t;
typedef short bf16x8 __attribute__((ext_vector_type(8)));
typedef float f32x4 __attribute__((ext_vector_type(4)));
typedef unsigned u32x4 __attribute__((ext_vector_type(4)));
constexpr int BM = 256, BK = 64, HALF = 128, HTB = HALF * BK * 2  , STAGE_BYTES = 8 * HTB, NXCD = 8, WGM = 8;

__host__ __device__ __forceinline__ int lds_byte(int r, int c) { const int st = (r >> 4) * 2 + (c >> 5), rr = r & 15, cc = c & 31, ob = rr * 64 + cc * 2; return st * 1024 + (ob ^ (((ob >> 9) & 1) << 5)); }
__host__ __device__ __forceinline__ void stage_rc(int b, int& R, int& C) { const int st = b / 1024, sb = b % 1024, swz = sb ^ (((sb >> 9) & 1) << 5); R = (st >> 1) * 16 + swz / 64; C = (st & 1) * 32 + (swz % 64) / 2; }
__host__ __device__ __forceinline__ int perm32(int rho) { const int n = rho >> 4, i = rho & 15; return 8 * (i >> 2) + 4 * n + (i & 3); }

struct Unit { int pm, pn; };
struct Gemm { const bf16_t* A; const bf16_t* Bt; int M, N, K; };

struct StaticOrder {
    int nM, nN, nwg, G, c;
    __host__ __device__ void init(int M, int N, int G_, int c_) { nM = M / BM; nN = N / BM; nwg = nM * nN; G = G_; c = c_; }
    __host__ __device__ bool next(int i, Unit& u) const {
        const long L = (long)i * G + c; if (L >= nwg) return false;
        int wgid = (int)L; { const int q = nwg / NXCD, r = nwg % NXCD, xcd = wgid % NXCD, off = wgid / NXCD; wgid = (xcd < r ? xcd * (q + 1) : r * (q + 1) + (xcd - r) * q) + off; }
        const int nig = WGM * nN, gid = wgid / nig, fm = gid * WGM, gsz = (nM - fm) < WGM ? (nM - fm) : WGM;
        u.pm = fm + ((wgid % nig) % gsz); u.pn = (wgid % nig) / gsz; return true;
    }
    __device__ __forceinline__ void a_ready(const Unit&) const {}
    __device__ __forceinline__ void done(const Unit&) const {}
};

__device__ __forceinline__ unsigned cvt_pk_bf16(float lo, float hi) { unsigned r; asm volatile("v_cvt_pk_bf16_f32 %0, %1, %2" : "=v"(r) : "v"(lo), "v"(hi)); return r; }
constexpr int MTOK = 16384;
__device__ __forceinline__ unsigned f2bf_rne(float f) { unsigned u = __builtin_bit_cast(unsigned, f); return (u + 0x7fffu + ((u >> 16) & 1u)) >> 16; }
__device__ __forceinline__ float bf_lo(unsigned w) { return __builtin_bit_cast(float, w << 16); }
__device__ __forceinline__ float bf_hi(unsigned w) { return __builtin_bit_cast(float, w & 0xffff0000u); }
__device__ __forceinline__ float sigmoid_fast(float x) { return __builtin_amdgcn_rcpf(1.0f + __builtin_amdgcn_exp2f(-1.4426950408889634f * x)); }

struct EpiProj {
    static constexpr bool PERM = true, AFTER_DRAIN = false;
    bf16_t* six;
    bf16_t* vt;
    bf16_t* gate;
    const float* rstd; int skip;
    __device__ __forceinline__ void operator()(const f32x4 (&acc)[2][2][4][2], const Unit& u, int wr, int wc, int fr, int fq) const {
        const int row0 = u.pm * BM + wr * 64 + fr; const int colt = u.pn * BM;
        if (skip) return;
        if (colt < 3072) {
            const int t = colt >> 9, cc = colt & 511;
            if (t == 2) {
#pragma unroll
                for (int ai = 0; ai < 2; ++ai)
#pragma unroll
                    for (int m = 0; m < 4; ++m) { const int r = row0 + ai * HALF + m * 16; const float rs = rstd[r]; const int b = r >> 12, tt = r & 4095;
#pragma unroll
                        for (int bj = 0; bj < 2; ++bj) { const int c0 = cc + bj * HALF + wc * 32 + 8 * fq; const int hh = c0 >> 6, d0 = c0 & 63;
                            bf16_t* p = vt + ((size_t)((b * 8 + hh) * 64 + d0)) * 4096 + tt;
#pragma unroll
                            for (int n = 0; n < 2; ++n)
#pragma unroll
                                for (int i = 0; i < 4; ++i) p[(size_t)(4 * n + i) * 4096] = (bf16_t)f2bf_rne(acc[ai][bj][m][n][i] * rs); } }
            } else {
                const int bufidx = (t == 0) ? 0 : (t == 1) ? 2 : (t == 3) ? 1 : t;
                bf16_t* base = six + (size_t)bufidx * MTOK * 512; const float sc = (t == 0) ? 0.125f : 1.0f;
                const int col0 = cc + wc * 32 + 8 * fq;
#pragma unroll
                for (int ai = 0; ai < 2; ++ai)
#pragma unroll
                    for (int m = 0; m < 4; ++m) { const int r = row0 + ai * HALF + m * 16; const float rs = rstd[r] * sc; bf16_t* rowp = base + (size_t)r * 512 + col0;
#pragma unroll
                        for (int bj = 0; bj < 2; ++bj) { const f32x4 v0 = acc[ai][bj][m][0] * rs, v1 = acc[ai][bj][m][1] * rs;
                            u32x4 w; w.x = cvt_pk_bf16(v0[0], v0[1]); w.y = cvt_pk_bf16(v0[2], v0[3]); w.z = cvt_pk_bf16(v1[0], v1[1]); w.w = cvt_pk_bf16(v1[2], v1[3]);
                            *(u32x4*)(rowp + bj * HALF) = w; } }
            }
        } else {
            const int gi = (colt - 3072) >> 10, cc = (colt - 3072) & 1023;
            bf16_t* base = gate + (size_t)gi * MTOK * 1024; const int col0 = cc + wc * 32 + 8 * fq;
#pragma unroll
            for (int ai = 0; ai < 2; ++ai)
#pragma unroll
                for (int m = 0; m < 4; ++m) { const int r = row0 + ai * HALF + m * 16; const float rs = rstd[r]; bf16_t* rowp = base + (size_t)r * 1024 + col0;
#pragma unroll
                    for (int bj = 0; bj < 2; ++bj) { f32x4 v0 = acc[ai][bj][m][0] * rs, v1 = acc[ai][bj][m][1] * rs;
#pragma unroll
                        for (int i = 0; i < 4; ++i) { v0[i] = sigmoid_fast(v0[i]); v1[i] = sigmoid_fast(v1[i]); }
                        u32x4 w; w.x = cvt_pk_bf16(v0[0], v0[1]); w.y = cvt_pk_bf16(v0[2], v0[3]); w.z = cvt_pk_bf16(v1[0], v1[1]); w.w = cvt_pk_bf16(v1[2], v1[3]);
                        *(u32x4*)(rowp + bj * HALF) = w; } }
        }
    }
};

struct EpiGate {
    static constexpr bool PERM = true, AFTER_DRAIN = false;
    float* P; bf16_t* merged; const bf16_t* g0; const bf16_t* g1;
    __device__ __forceinline__ void operator()(const f32x4 (&acc)[2][2][4][2], const Unit& u, int wr, int wc, int fr, int fq) const {
        const int which = (u.pm >= 64) ? 1 : 0; const int pm = u.pm - 64 * which, pn = u.pn - 4 * which;
        const int row0 = pm * BM + wr * 64 + fr, col0 = pn * BM + wc * 32 + 8 * fq; const bf16_t* g = which ? g1 : g0;
#pragma unroll
        for (int ai = 0; ai < 2; ++ai)
#pragma unroll
            for (int m = 0; m < 4; ++m) { const int r = row0 + ai * HALF + m * 16;
#pragma unroll
                for (int bj = 0; bj < 2; ++bj) { const size_t off = (size_t)r * 1024 + col0 + bj * HALF;
                    const u32x4 gv = *(const u32x4*)(g + off);
                    f32x4 a0 = acc[ai][bj][m][0], a1 = acc[ai][bj][m][1];
                    a0[0] *= bf_lo(gv.x); a0[1] *= bf_hi(gv.x); a0[2] *= bf_lo(gv.y); a0[3] *= bf_hi(gv.y);
                    a1[0] *= bf_lo(gv.z); a1[1] *= bf_hi(gv.z); a1[2] *= bf_lo(gv.w); a1[3] *= bf_hi(gv.w);
                    if (!which) { u32x4 w; w.x = cvt_pk_bf16(a0[0], a0[1]); w.y = cvt_pk_bf16(a0[2], a0[3]); w.z = cvt_pk_bf16(a1[0], a1[1]); w.w = cvt_pk_bf16(a1[2], a1[3]); *(u32x4*)((bf16_t*)P + off) = w; }
                    else { const u32x4 pw = *(const u32x4*)((const bf16_t*)P + off);
                        a0[0] += bf_lo(pw.x); a0[1] += bf_hi(pw.x); a0[2] += bf_lo(pw.y); a0[3] += bf_hi(pw.y); a1[0] += bf_lo(pw.z); a1[1] += bf_hi(pw.z); a1[2] += bf_lo(pw.w); a1[3] += bf_hi(pw.w);
                        u32x4 w; w.x = cvt_pk_bf16(a0[0], a0[1]); w.y = cvt_pk_bf16(a0[2], a0[3]); w.z = cvt_pk_bf16(a1[0], a1[1]); w.w = cvt_pk_bf16(a1[2], a1[3]);
                        *(u32x4*)(merged + off) = w; } } }
    }
};
struct PairOrder {
    StaticOrder so;
    __host__ __device__ void init(int G_, int c_) { so.init(MTOK, 1024, G_, c_); }
    __host__ __device__ bool next(int i, Unit& u) const { Unit t; if (!so.next(i >> 1, t)) return false; const int w = i & 1; u.pm = t.pm + 64 * w; u.pn = t.pn + 4 * w; return true; }
    __device__ __forceinline__ void a_ready(const Unit&) const {}
    __device__ __forceinline__ void done(const Unit&) const {}
};

struct EpiWo {
    static constexpr bool PERM = true, AFTER_DRAIN = false;
    const float* x; float* x1; bf16_t* x1b;
    __device__ __forceinline__ void operator()(const f32x4 (&acc)[2][2][4][2], const Unit& u, int wr, int wc, int fr, int fq) const {
        const int row0 = u.pm * BM + wr * 64 + fr, col0 = u.pn * BM + wc * 32 + 8 * fq;
#pragma unroll
        for (int ai = 0; ai < 2; ++ai)
#pragma unroll
            for (int m = 0; m < 4; ++m) { const int r = row0 + ai * HALF + m * 16;
#pragma unroll
                for (int bj = 0; bj < 2; ++bj) { const size_t off = (size_t)r * 1024 + col0 + bj * HALF;
                    const f32x4 a0 = acc[ai][bj][m][0] + *(const f32x4*)(x + off), a1 = acc[ai][bj][m][1] + *(const f32x4*)(x + off + 4);
                    *(f32x4*)(x1 + off) = a0; *(f32x4*)(x1 + off + 4) = a1;
                    u32x4 w; w.x = cvt_pk_bf16(a0[0], a0[1]); w.y = cvt_pk_bf16(a0[2], a0[3]); w.z = cvt_pk_bf16(a1[0], a1[1]); w.w = cvt_pk_bf16(a1[2], a1[3]);
                    *(u32x4*)(x1b + off) = w; } }
    }
};
typedef _Float16 f16x2_t __attribute__((ext_vector_type(2)));
typedef float f32x2e __attribute__((ext_vector_type(2)));
__device__ __forceinline__ unsigned pk_f16(float lo, float hi) { f32x2e v = {lo, hi}; f16x2_t h = __builtin_convertvector(v, f16x2_t); return __builtin_bit_cast(unsigned, h); }
struct EpiScores {
    static constexpr bool PERM = true, AFTER_DRAIN = false;
    unsigned short* S;
    __device__ __forceinline__ void operator()(const f32x4 (&acc)[2][2][4][2], const Unit& u, int wr, int wc, int fr, int fq) const {
        const int row0 = u.pm * BM + wr * 64 + fr, col0 = u.pn * BM + wc * 32 + 8 * fq;
#pragma unroll
        for (int ai = 0; ai < 2; ++ai)
#pragma unroll
            for (int m = 0; m < 4; ++m) { const int r = row0 + ai * HALF + m * 16;
#pragma unroll
                for (int bj = 0; bj < 2; ++bj) { const size_t off = ((size_t)((col0 + bj * HALF) >> 3) * MTOK + r) * 8;
                    const f32x4 a0 = acc[ai][bj][m][0], a1 = acc[ai][bj][m][1];
                    u32x4 w; w.x = pk_f16(a0[0], a0[1]); w.y = pk_f16(a0[2], a0[3]); w.z = pk_f16(a1[0], a1[1]); w.w = pk_f16(a1[2], a1[3]);
                    *(u32x4*)(S + off) = w; } }
    }
};
template <class Epi, class Sched, bool ALIGN_EPI = false, bool SP2 = false>
__device__ __forceinline__ void gemm_phase(PG8_LAS unsigned char* lds, const Gemm g, const Sched& S, const Epi& E) {
    const int tid = threadIdx.x, wid = __builtin_amdgcn_readfirstlane(tid >> 6), lane = tid & 63, wr = wid >> 2, wc = wid & 3, fr = lane & 15, fq = lane >> 4;
    const int K = g.K, nt = K / BK;
    unsigned voffA[2], voffB[2];
#pragma unroll
    for (int i = 0; i < 2; ++i) { int R, C; stage_rc(tid * 16 + i * 8192, R, C); const int Rb = Epi::PERM ? ((R & ~31) + perm32(R & 31)) : R;
        voffA[i] = (unsigned)(R * K + C) * 2u; voffB[i] = (unsigned)(Rb * K + C) * 2u; }
    const size_t kstep = (size_t)(BK * 2);
    const size_t hstep = (size_t)HALF * K * 2;
    const size_t tstep = 2 * hstep;
    const unsigned ldsw = (unsigned)wid * 1024u;
    const int aoff = lds_byte(wr * 64 + fr, fq * 8), boff = lds_byte(wc * 32 + fr, fq * 8);
#define PG8_SA(b, h) (((b) * 2 + (h)) * HTB)
#define PG8_SB(b, h) ((4 + (b) * 2 + (h)) * HTB)
#define PG8_STAGE(bufoff, gbase, voff) do { _Pragma("unroll") for (int _i = 0; _i < 2; ++_i) \
        __builtin_amdgcn_global_load_lds((const unsigned*)((const char*)(gbase) + (voff)[_i]), (PG8_LAS unsigned*)(lds + (bufoff) + ldsw + _i * 8192), 16, 0, 0); } while (0)
#define PG8_LDA(dst, b, h) do { _Pragma("unroll") for (int m = 0; m < 4; ++m) _Pragma("unroll") for (int k = 0; k < 2; ++k) dst[m][k] = *(const PG8_LAS bf16x8*)(lds + PG8_SA(b, h) + aoff + m * 2048 + k * 1024); } while (0)
#define PG8_LDB(dst, b, h) do { _Pragma("unroll") for (int n = 0; n < 2; ++n) _Pragma("unroll") for (int k = 0; k < 2; ++k) dst[n][k] = *(const PG8_LAS bf16x8*)(lds + PG8_SB(b, h) + boff + n * 2048 + k * 1024); } while (0)
#define PG8_MMA(ai, bj, At, Bt) do { __builtin_amdgcn_s_setprio(1); _Pragma("unroll") for (int m = 0; m < 4; ++m) _Pragma("unroll") for (int n = 0; n < 2; ++n) _Pragma("unroll") for (int k = 0; k < 2; ++k) \
        acc[ai][bj][m][n] = __builtin_amdgcn_mfma_f32_16x16x32_bf16(Bt[n][k], At[m][k], acc[ai][bj][m][n], 0, 0, 0); __builtin_amdgcn_s_setprio(0); } while (0)
#define PG8_WAIT_V(n) asm volatile("s_waitcnt vmcnt(" #n ")" ::: "memory")
#define PG8_WAIT_L(n) asm volatile("s_waitcnt lgkmcnt(" #n ")" ::: "memory")
#define PG8_BAR __builtin_amdgcn_s_barrier()
#define PG8_SCHED __builtin_amdgcn_sched_barrier(0)
    Unit cur, nxt; int ui = 0;
    if (!S.next(0, cur)) return;
    f32x4 acc[2][2][4][2];
#pragma unroll
    for (int a = 0; a < 2; ++a)
#pragma unroll
        for (int b = 0; b < 2; ++b)
#pragma unroll
            for (int m = 0; m < 4; ++m)
#pragma unroll
                for (int n = 0; n < 2; ++n) acc[a][b][m][n] = (f32x4){0.f, 0.f, 0.f, 0.f};
    bf16x8 At[4][2], B0[2][2], B1[2][2];
    const char* cA = (const char*)g.A + (size_t)cur.pm * tstep; const char* cB = (const char*)g.Bt + (size_t)cur.pn * tstep;
    S.a_ready(cur);
    if constexpr (SP2) {
        PG8_STAGE(PG8_SB(0, 0), cB, voffB); PG8_STAGE(PG8_SB(0, 1), cB + hstep, voffB); PG8_STAGE(PG8_SA(0, 0), cA, voffA); PG8_STAGE(PG8_SA(0, 1), cA + hstep, voffA);
        if (wr == 1) PG8_BAR;
        PG8_WAIT_V(2); PG8_BAR;
        PG8_STAGE(PG8_SB(1, 0), cB + kstep, voffB); PG8_STAGE(PG8_SA(1, 0), cA + kstep, voffA); PG8_STAGE(PG8_SB(1, 1), cB + hstep + kstep, voffB);
        PG8_WAIT_V(6); PG8_BAR;
    } else {
        PG8_STAGE(PG8_SB(0, 0), cB, voffB); PG8_STAGE(PG8_SA(0, 0), cA, voffA); PG8_STAGE(PG8_SB(0, 1), cB + hstep, voffB); PG8_STAGE(PG8_SA(0, 1), cA + hstep, voffA);
        if (wr == 1) PG8_BAR;
        PG8_WAIT_V(4); PG8_BAR;
        PG8_STAGE(PG8_SB(1, 0), cB + kstep, voffB); PG8_STAGE(PG8_SA(1, 0), cA + kstep, voffA); PG8_STAGE(PG8_SB(1, 1), cB + hstep + kstep, voffB);
        PG8_WAIT_V(6); PG8_BAR;
    }
    for (;;) {
        const bool has_next = S.next(ui + 1, nxt);
        const char* nA = has_next ? (const char*)g.A + (size_t)nxt.pm * tstep : cA; const char* nB = has_next ? (const char*)g.Bt + (size_t)nxt.pn * tstep : cB;
        for (int t = 0; t < nt; t += 2) {
            const bool last = (t == nt - 2);
            const char* a1 = cA + (size_t)(t + 1) * kstep;
            const char* a2 = last ? nA : cA + (size_t)(t + 2) * kstep; const char* b2 = last ? nB : cB + (size_t)(t + 2) * kstep;
            const char* a3 = a2 + kstep; const char* b3 = b2 + kstep;
            if (last && has_next) S.a_ready(nxt);
            if constexpr (SP2) {
            PG8_LDB(B0, 0, 0); PG8_LDB(B1, 0, 1); PG8_SCHED; PG8_LDA(At, 0, 0); PG8_STAGE(PG8_SA(1, 1), a1 + hstep, voffA);
            PG8_WAIT_V(8); PG8_WAIT_L(0); PG8_BAR; PG8_MMA(0, 0, At, B0); PG8_MMA(0, 1, At, B1); PG8_BAR; PG8_SCHED;
            PG8_LDA(At, 0, 1); PG8_STAGE(PG8_SB(0, 0), b2, voffB); PG8_STAGE(PG8_SB(0, 1), b2 + hstep, voffB); PG8_STAGE(PG8_SA(0, 0), a2, voffA);
            PG8_WAIT_V(8); PG8_WAIT_L(0); PG8_BAR; PG8_MMA(1, 0, At, B0); PG8_MMA(1, 1, At, B1); PG8_BAR; PG8_SCHED;
            PG8_LDB(B0, 1, 0); PG8_LDB(B1, 1, 1); PG8_SCHED; PG8_LDA(At, 1, 0); PG8_STAGE(PG8_SA(0, 1), a2 + hstep, voffA);
            PG8_WAIT_V(8); PG8_WAIT_L(0); PG8_BAR; PG8_MMA(0, 0, At, B0); PG8_MMA(0, 1, At, B1); PG8_BAR; PG8_SCHED;
            PG8_LDA(At, 1, 1); PG8_STAGE(PG8_SB(1, 0), b3, voffB); PG8_STAGE(PG8_SB(1, 1), b3 + hstep, voffB); PG8_STAGE(PG8_SA(1, 0), a3, voffA);
            PG8_WAIT_V(8); PG8_WAIT_L(0); PG8_BAR; PG8_MMA(1, 0, At, B0); PG8_MMA(1, 1, At, B1); PG8_BAR; PG8_SCHED;
            } else {
            PG8_LDB(B0, 0, 0); PG8_SCHED; PG8_LDA(At, 0, 0); PG8_STAGE(PG8_SA(1, 1), a1 + hstep, voffA);
            PG8_WAIT_L(8); PG8_BAR; PG8_WAIT_L(0); PG8_MMA(0, 0, At, B0); PG8_BAR; PG8_SCHED;
            PG8_LDB(B1, 0, 1); PG8_STAGE(PG8_SB(0, 0), b2, voffB);
            PG8_BAR; PG8_WAIT_L(0); PG8_MMA(0, 1, At, B1); PG8_BAR;
            PG8_LDA(At, 0, 1); PG8_STAGE(PG8_SA(0, 0), a2, voffA);
            PG8_BAR; PG8_WAIT_L(0); PG8_MMA(1, 0, At, B0); PG8_BAR; PG8_SCHED;
            PG8_STAGE(PG8_SB(0, 1), b2 + hstep, voffB);
            PG8_WAIT_V(6); PG8_BAR; PG8_MMA(1, 1, At, B1); PG8_BAR;
            PG8_LDB(B0, 1, 0); PG8_SCHED; PG8_LDA(At, 1, 0); PG8_STAGE(PG8_SA(0, 1), a2 + hstep, voffA);
            PG8_WAIT_L(8); PG8_BAR; PG8_WAIT_L(0); PG8_MMA(0, 0, At, B0); PG8_BAR; PG8_SCHED;
            PG8_LDB(B1, 1, 1); PG8_STAGE(PG8_SB(1, 0), b3, voffB);
            PG8_BAR; PG8_WAIT_L(0); PG8_MMA(0, 1, At, B1); PG8_BAR;
            PG8_LDA(At, 1, 1); PG8_STAGE(PG8_SA(1, 0), a3, voffA);
            PG8_BAR; PG8_WAIT_L(0); PG8_MMA(1, 0, At, B0); PG8_BAR; PG8_SCHED;
            PG8_STAGE(PG8_SB(1, 1), b3 + hstep, voffB);
            PG8_WAIT_V(6); PG8_BAR; PG8_MMA(1, 1, At, B1); PG8_BAR;
            }
        }
        if constexpr (ALIGN_EPI) { if (wr == 0) PG8_BAR; }
        if constexpr (!Epi::AFTER_DRAIN) { E(acc, cur, wr, wc, fr, fq); S.done(cur); }
        if (!has_next) break;
#pragma unroll
        for (int a = 0; a < 2; ++a)
#pragma unroll
            for (int b = 0; b < 2; ++b)
#pragma unroll
                for (int m = 0; m < 4; ++m)
#pragma unroll
                    for (int n = 0; n < 2; ++n) acc[a][b][m][n] = (f32x4){0.f, 0.f, 0.f, 0.f};
        cur = nxt; cA = nA; cB = nB; ++ui;
        if constexpr (ALIGN_EPI) { if (wr == 1) PG8_BAR; }
    }
    PG8_WAIT_V(0);
    if constexpr (!ALIGN_EPI) { if (wr == 0) PG8_BAR; }
    PG8_BAR;
    if constexpr (Epi::AFTER_DRAIN) { E.fused(acc, cur, wr, wc, fr, fq, lds, wid, lane); S.done(cur); }
#undef PG8_SA
#undef PG8_SB
#undef PG8_STAGE
#undef PG8_LDA
#undef PG8_LDB
#undef PG8_MMA
#undef PG8_WAIT_V
#undef PG8_WAIT_L
#undef PG8_BAR
#undef PG8_SCHED
}
}

constexpr int NWAVES = 8;
constexpr int BATCH = 4, T = 4096, D = 1024, NH = 8, HD = 64, NIN = 5120;
constexpr int M = BATCH * T;
constexpr int NEXP = 16384;
constexpr float RMS_EPS = 1e-6f;
#ifndef MK_N_LAUNCHES
#define MK_N_LAUNCHES 1
#endif
constexpr int N_PHASES = 11;
constexpr int N_LAUNCHES = MK_N_LAUNCHES;

constexpr size_t MiB = 1u << 20;
constexpr size_t WS_CTL = 0, CTL_ZERO_BYTES = 64 * 1024;
constexpr size_t WS_RSTD1 = 512 * 1024;
constexpr size_t WS_WEFF = 1 * MiB;
constexpr size_t WS_WAB = 5 * MiB;
constexpr size_t WS_WO = 7 * MiB;
constexpr size_t WS_WIN = 9 * MiB;
constexpr size_t WS_XB = 19 * MiB;
constexpr size_t WS_SIX = 51 * MiB;
constexpr size_t WS_VT = WS_SIX + 3 * 16 * MiB;
constexpr size_t WS_GATE = 147 * MiB;
constexpr size_t WS_MERGED = 19 * MiB;
constexpr size_t WS_X1B = 51 * MiB;
constexpr size_t WS_TU = 211 * MiB, WS_TV = 227 * MiB;
constexpr size_t WS_SU = 576 * 1024, WS_SV = 640 * 1024;
constexpr size_t WS_SCORES = 83 * MiB;
constexpr size_t WS_ROUTE = 19 * MiB;
constexpr size_t WS_W = 35 * MiB;
constexpr size_t WS_SS = 43 * MiB;
constexpr size_t WS_UPART = 83 * MiB;
constexpr size_t WS_END = 256 * MiB;
constexpr int CW_BAR = 4096;

constexpr int RING_OFF = 0, RING_BYTES = 131072;
constexpr int LDSCTL_OFF = RING_BYTES;
constexpr int LDS_BYTES = 147456;
constexpr int MISC_OFF = LDS_BYTES - 128;

#define GAS __attribute__((address_space(1)))
#define LAS __attribute__((address_space(3)))
#define CAS __attribute__((address_space(4)))
typedef unsigned short bf16;
typedef unsigned v4u __attribute__((ext_vector_type(4)));
typedef unsigned v2u __attribute__((ext_vector_type(2)));
typedef float f32x4 __attribute__((ext_vector_type(4)));
typedef float f32x2 __attribute__((ext_vector_type(2)));
typedef float f32x16 __attribute__((ext_vector_type(16)));
typedef short bf16x8 __attribute__((ext_vector_type(8)));
typedef _Float16 f16x8 __attribute__((ext_vector_type(8)));
typedef _Float16 f16x2 __attribute__((ext_vector_type(2)));
typedef __bf16 bf16x2_t __attribute__((ext_vector_type(2)));
typedef GAS unsigned gu32;
#define RLX_AGENT __ATOMIC_RELAXED, __HIP_MEMORY_SCOPE_AGENT
#define LDS_WAIT() asm volatile("s_waitcnt lgkmcnt(0)" ::: "memory")
#define VM_WAIT() asm volatile("s_waitcnt vmcnt(0)" ::: "memory")
__device__ __forceinline__ unsigned f2bf(float f) { unsigned u = __builtin_bit_cast(unsigned, f); return (u + 0x7fffu + ((u >> 16) & 1u)) >> 16; }
__device__ __forceinline__ unsigned pk2(float lo, float hi) { return f2bf(lo) | (f2bf(hi) << 16); }
__device__ __forceinline__ unsigned cvtpk(float lo, float hi) { f32x2 v = {lo, hi}; bf16x2_t b = __builtin_convertvector(v, bf16x2_t); return __builtin_bit_cast(unsigned, b); }
__device__ __forceinline__ float bflo(unsigned w) { return __builtin_bit_cast(float, w << 16); }
__device__ __forceinline__ float bfhi(unsigned w) { return __builtin_bit_cast(float, w & 0xffff0000u); }
__device__ __forceinline__ float wave_sum(float v) {
#pragma unroll
    for (int o = 1; o < 64; o <<= 1) v += __shfl_xor(v, o);
    return v;
}
#define XB_TMO      128
#define XB_XCNT(j)  (256  + 64 * (j))
#define XB_XSUB(j)  (1280 + 64 * (j))
#define XB_XGEN(j)  (2304 + 64 * (j))
#define XB_TOP      3328
#define XB_TOPGEN   3392
#define XCD_BAR_WORDS 3456
#define XB_SPIN_CAP (1u << 18)

__device__ __forceinline__ unsigned xb_ld(unsigned* p)              { return __hip_atomic_load(p, __ATOMIC_RELAXED, __HIP_MEMORY_SCOPE_AGENT); }
__device__ __forceinline__ unsigned xb_add(unsigned* p, unsigned v) { return __hip_atomic_fetch_add(p, v, __ATOMIC_RELAXED, __HIP_MEMORY_SCOPE_AGENT); }
__device__ __forceinline__ unsigned xb_xcc_id() { return (unsigned)__builtin_amdgcn_s_getreg((3 << 11) | 20) & 0xFu; }
#define XB_SPIN(cond, bar) do { unsigned _sp = 0; while (cond) { __builtin_amdgcn_s_sleep(1); \
    if ((++_sp & 255u) == 0u) { if (xb_ld(&(bar)[XB_TMO])) break; if (_sp > XB_SPIN_CAP) { atomicAdd(&(bar)[XB_TMO], 1u); break; } } } } while (0)

struct XcdBarrier {
    unsigned* bar; unsigned x;
    volatile LAS unsigned* st;
};

__device__ __forceinline__ XcdBarrier xcd_barrier_post(unsigned* bar, volatile LAS unsigned* st) {
    XcdBarrier b; b.bar = bar; b.x = xb_xcc_id(); b.st = st;
    if (threadIdx.x == 0) (void)xb_add(&bar[XB_XCNT(b.x)], 1u);
    return b;
}
__device__ __forceinline__ void xcd_barrier_complete(unsigned* bar, unsigned x, unsigned& nloc, unsigned& nx) {
    const unsigned G = gridDim.x * gridDim.y * gridDim.z;
    unsigned sum, cnt, mine, sp = 0u;
    for (;;) {
        sum = 0u; cnt = 0u; mine = 0u;
#pragma unroll
        for (unsigned j = 0; j < 16; ++j) { const unsigned c = xb_ld(&bar[XB_XCNT(j)]); sum += c; cnt += (c > 0u) ? 1u : 0u; mine = (j == x) ? c : mine; }
        if (sum == G) break;
        __builtin_amdgcn_s_sleep(1);
        if ((++sp & 255u) == 0u) { if (xb_ld(&bar[XB_TMO])) break; if (sp > XB_SPIN_CAP) { atomicAdd(&bar[XB_TMO], 1u); break; } }
    }
    nloc = mine > 0u ? mine : 1u; nx = cnt > 0u ? cnt : 1u;
}

__device__ __forceinline__ void xcd_barrier(const XcdBarrier& b) {
    asm volatile("s_waitcnt vmcnt(0)" ::: "memory");
    __syncthreads();
    if (threadIdx.x == 0) {
        unsigned* bar = b.bar;
        __builtin_amdgcn_s_waitcnt(0);
        unsigned nloc = b.st[0], nx = b.st[1];
        if (nloc == 0u) { xcd_barrier_complete(bar, b.x, nloc, nx); b.st[0] = nloc; b.st[1] = nx; }
        const unsigned old = xb_add(&bar[XB_XSUB(b.x)], 1u);
        const unsigned gen = old / nloc;
        if (old + 1u == (gen + 1u) * nloc) {
            __builtin_amdgcn_fence(__ATOMIC_RELEASE, "agent");
            asm volatile("s_waitcnt vmcnt(0)" ::: "memory");
            const unsigned og = xb_add(&bar[XB_TOP], 1u);
            const unsigned tg = og / nx;
            if (og + 1u == (tg + 1u) * nx) xb_add(&bar[XB_TOPGEN], 1u);
            else XB_SPIN(xb_ld(&bar[XB_TOPGEN]) == tg, bar);
            __builtin_amdgcn_fence(__ATOMIC_ACQUIRE, "agent");
            xb_add(&bar[XB_XGEN(b.x)], 1u);
            asm volatile("s_waitcnt vmcnt(0)" ::: "memory");
        } else {
            XB_SPIN(xb_ld(&bar[XB_XGEN(b.x)]) == gen, bar);
            __builtin_amdgcn_fence(__ATOMIC_ACQUIRE, "agent");
            asm volatile("s_waitcnt vmcnt(0)" ::: "memory");
        }
    }
    __syncthreads();
}

__device__ __forceinline__ void p0_transpose_item(const float* W, int K, int N, bf16* WT, int row_off, const float* kscale, LAS float* scr, int item, int lane) {
    const int nblk = N / 32, kb = item / nblk, nb = item % nblk, k0 = 64 * kb, n0 = 32 * nb;
#pragma unroll 8
    for (int i = 0; i < 32; ++i) { const int kk = 2 * i + (lane >> 5); scr[kk * 33 + (lane & 31)] = W[(size_t)(k0 + kk) * N + n0 + (lane & 31)]; }
    LDS_WAIT(); asm volatile("" ::: "memory");
    const int c = lane & 7;
    float ks[8];
#pragma unroll
    for (int i = 0; i < 8; ++i) ks[i] = kscale ? kscale[k0 + 8 * c + i] : 1.0f;
#pragma unroll
    for (int j = 0; j < 4; ++j) { const int n = (lane >> 3) + 8 * j; const LAS float* s = scr + (8 * c) * 33 + n;
        v4u o; o.x = pk2(s[0 * 33] * ks[0], s[1 * 33] * ks[1]); o.y = pk2(s[2 * 33] * ks[2], s[3 * 33] * ks[3]); o.z = pk2(s[4 * 33] * ks[4], s[5 * 33] * ks[5]); o.w = pk2(s[6 * 33] * ks[6], s[7 * 33] * ks[7]);
        *(GAS v4u*)(WT + (size_t)(row_off + n0 + n) * K + k0 + 8 * c) = o; }
    LDS_WAIT(); asm volatile("" ::: "memory");
}

__device__ __forceinline__ void conv_phase(const bf16* CB, const bf16* CC, const bf16* CU, bf16* CO, const float* cw, const float* cbias, int gtid, int nthreads) {
    for (int task = gtid; task < M * 64; task += nthreads) {
        const int tok = task >> 6, c8 = (task & 63) * 8, tt = tok & (T - 1);
        const size_t off = (size_t)tok * 512 + c8;
        float z[3][8];
#pragma unroll
        for (int k = 0; k < 3; ++k) {
            const int dt = 2 - k;
            if (tt >= dt) { const v4u a = *(const GAS v4u*)(CC + off - (size_t)dt * 512), b = *(const GAS v4u*)(CU + off - (size_t)dt * 512);
                z[k][0] = bflo(a.x) * bflo(b.x); z[k][1] = bfhi(a.x) * bfhi(b.x); z[k][2] = bflo(a.y) * bflo(b.y); z[k][3] = bfhi(a.y) * bfhi(b.y);
                z[k][4] = bflo(a.z) * bflo(b.z); z[k][5] = bfhi(a.z) * bfhi(b.z); z[k][6] = bflo(a.w) * bflo(b.w); z[k][7] = bfhi(a.w) * bfhi(b.w); }
            else {
#pragma unroll
                for (int i = 0; i < 8; ++i) z[k][i] = 0.f; }
        }
        float y[8];
#pragma unroll
        for (int i = 0; i < 8; ++i) y[i] = cbias[c8 + i];
#pragma unroll
        for (int k = 0; k < 3; ++k)
#pragma unroll
            for (int i = 0; i < 8; ++i) y[i] += cw[k * 512 + c8 + i] * z[k][i];
        const v4u g = *(const GAS v4u*)(CB + off);
        v4u o; o.x = pk2(bflo(g.x) * y[0], bfhi(g.x) * y[1]); o.y = pk2(bflo(g.y) * y[2], bfhi(g.y) * y[3]); o.z = pk2(bflo(g.z) * y[4], bfhi(g.z) * y[5]); o.w = pk2(bflo(g.w) * y[6], bfhi(g.w) * y[7]);
        *(GAS v4u*)(CO + off) = o;
    }
}

__device__ __forceinline__ int crow(int r, int hf) { return (r & 3) + 8 * (r >> 2) + 4 * hf; }
#define MFMA_BF16(a, b, c) __builtin_amdgcn_mfma_f32_32x32x16_bf16((a), (b), (c), 0, 0, 0)
#define MFMA_F16(a, b, c) __builtin_amdgcn_mfma_f32_32x32x16_f16((a), (b), (c), 0, 0, 0)
__device__ __forceinline__ void attn_item(const bf16* Qb, const bf16* Kb, const bf16* VT, bf16* Ob, int b, int h, int qblk, int lane) {
    const int t32 = lane & 31, hf = lane >> 5, q0 = qblk * 32, tq = q0 + t32;
    const size_t rowbase = (size_t)b * T;
    const float LOG2E = 1.4426950408889634f, LN2 = 0.6931471805599453f;
    bf16x8 qf[4];
    { const bf16* qp = Qb + (rowbase + q0 + t32) * 512 + h * 64 + 8 * hf;
#pragma unroll
      for (int st = 0; st < 4; ++st) qf[st] = *(const GAS bf16x8*)(qp + 16 * st); }
    f16x8 tri[2];
#pragma unroll
    for (int st = 0; st < 2; ++st)
#pragma unroll
        for (int e = 0; e < 8; ++e) { const int j = 16 * st + 8 * (e >> 2) + 4 * hf + (e & 3); tri[st][e] = (j >= t32) ? (_Float16)1.0f : (_Float16)0.0f; }
    f32x16 o0, o1;
#pragma unroll
    for (int r = 0; r < 16; ++r) { o0[r] = 0.f; o1[r] = 0.f; }
    float R = 0.f;
    const bf16* kbase = Kb + rowbase * 512 + h * 64 + 8 * hf;
    const bf16* vtb = VT + ((size_t)(b * 8 + h) * 64 + t32) * T + 4 * hf;
    for (int jt = q0 >> 6; jt >= 0; --jt) {
        const int k0 = jt * 64;
        f32x16 s0, s1;
#pragma unroll
        for (int r = 0; r < 16; ++r) { s0[r] = 0.f; s1[r] = 0.f; }
#pragma unroll
        for (int st = 0; st < 4; ++st) {
            const bf16x8 a0 = *(const GAS bf16x8*)(kbase + (size_t)(k0 + t32) * 512 + 16 * st);
            const bf16x8 a1 = *(const GAS bf16x8*)(kbase + (size_t)(k0 + 32 + t32) * 512 + 16 * st);
            s0 = MFMA_BF16(a0, qf[st], s0); s1 = MFMA_BF16(a1, qf[st], s1);
        }
        f32x16 L0, L1; float tot0 = 0.f, tot1 = 0.f;
#pragma unroll
        for (int r = 0; r < 16; ++r) {
            const int key = k0 + crow(r, hf);
            { const float z = s0[r]; const float e = __builtin_amdgcn_exp2f(-__builtin_fabsf(z) * LOG2E); const float lp = __builtin_amdgcn_logf(1.0f + e) * LN2;
              const float L = (key < tq) ? -(__builtin_fmaxf(z, 0.f) + lp) : 0.f; L0[r] = L; tot0 += L; }
            { const float z = s1[r]; const float e = __builtin_amdgcn_exp2f(-__builtin_fabsf(z) * LOG2E); const float lp = __builtin_amdgcn_logf(1.0f + e) * LN2;
              const float L = (key + 32 < tq) ? -(__builtin_fmaxf(z, 0.f) + lp) : 0.f; L1[r] = L; tot1 += L; }
        }
        tot0 += __shfl_xor(tot0, 32); tot1 += __shfl_xor(tot1, 32);
        f16x8 lf00, lf01, lf10, lf11;
#pragma unroll
        for (int e = 0; e < 8; ++e) { lf00[e] = (_Float16)L0[e]; lf01[e] = (_Float16)L0[8 + e]; lf10[e] = (_Float16)L1[e]; lf11[e] = (_Float16)L1[8 + e]; }
        f32x16 y0, y1;
#pragma unroll
        for (int r = 0; r < 16; ++r) { y0[r] = 0.f; y1[r] = 0.f; }
        y0 = MFMA_F16(tri[0], lf00, y0); y0 = MFMA_F16(tri[1], lf01, y0);
        y1 = MFMA_F16(tri[0], lf10, y1); y1 = MFMA_F16(tri[1], lf11, y1);
        const float base0 = R + tot1, base1 = R;
        float a0v[16], a1v[16];
#pragma unroll
        for (int r = 0; r < 16; ++r) {
            const int key = k0 + crow(r, hf);
            a0v[r] = (key < tq) ? __builtin_amdgcn_exp2f((s0[r] + y0[r] + base0) * LOG2E) : 0.f;
            a1v[r] = (key + 32 < tq) ? __builtin_amdgcn_exp2f((s1[r] + y1[r] + base1) * LOG2E) : 0.f;
        }
        bf16x8 pf[2][2];
#pragma unroll
        for (int st = 0; st < 2; ++st) {
            v4u w0, w1;
            w0.x = cvtpk(a0v[8 * st + 0], a0v[8 * st + 1]); w0.y = cvtpk(a0v[8 * st + 2], a0v[8 * st + 3]); w0.z = cvtpk(a0v[8 * st + 4], a0v[8 * st + 5]); w0.w = cvtpk(a0v[8 * st + 6], a0v[8 * st + 7]);
            w1.x = cvtpk(a1v[8 * st + 0], a1v[8 * st + 1]); w1.y = cvtpk(a1v[8 * st + 2], a1v[8 * st + 3]); w1.z = cvtpk(a1v[8 * st + 4], a1v[8 * st + 5]); w1.w = cvtpk(a1v[8 * st + 6], a1v[8 * st + 7]);
            pf[0][st] = __builtin_bit_cast(bf16x8, w0); pf[1][st] = __builtin_bit_cast(bf16x8, w1);
        }
#pragma unroll
        for (int kb = 0; kb < 2; ++kb)
#pragma unroll
            for (int st = 0; st < 2; ++st) {
                const int kk = k0 + 32 * kb + 16 * st;
                { const v2u lo = *(const GAS v2u*)(vtb + kk), hi = *(const GAS v2u*)(vtb + kk + 8); v4u w; w.x = lo.x; w.y = lo.y; w.z = hi.x; w.w = hi.y;
                  o0 = MFMA_BF16(__builtin_bit_cast(bf16x8, w), pf[kb][st], o0); }
                { const v2u lo = *(const GAS v2u*)(vtb + (size_t)32 * T + kk), hi = *(const GAS v2u*)(vtb + (size_t)32 * T + kk + 8); v4u w; w.x = lo.x; w.y = lo.y; w.z = hi.x; w.w = hi.y;
                  o1 = MFMA_BF16(__builtin_bit_cast(bf16x8, w), pf[kb][st], o1); }
            }
        R += tot0 + tot1;
        if (__all(R < -104.0f)) break;
    }
    bf16* op = Ob + (rowbase + q0 + t32) * 512 + h * 64 + 4 * hf;
#pragma unroll
    for (int q4 = 0; q4 < 4; ++q4) {
        v2u w; w.x = cvtpk(o0[4 * q4], o0[4 * q4 + 1]); w.y = cvtpk(o0[4 * q4 + 2], o0[4 * q4 + 3]); *(GAS v2u*)(op + 8 * q4) = w;
        v2u w2; w2.x = cvtpk(o1[4 * q4], o1[4 * q4 + 1]); w2.y = cvtpk(o1[4 * q4 + 2], o1[4 * q4 + 3]); *(GAS v2u*)(op + 32 + 8 * q4) = w2;
    }
}

#define RT_C8(op_str, cnt, x0, x1, x2, x3, x4, x5, x6, x7, thr) asm volatile(op_str : "+v"(cnt) : "v"(x0), "v"(x1), "v"(x2), "v"(x3), "v"(x4), "v"(x5), "v"(x6), "v"(x7), "v"(thr) : "vcc")
#define RT_GE8 "v_cmp_ge_f32 vcc, %1, %9\n\tv_addc_co_u32_e32 %0, vcc, 0, %0, vcc\n\tv_cmp_ge_f32 vcc, %2, %9\n\tv_addc_co_u32_e32 %0, vcc, 0, %0, vcc\n\tv_cmp_ge_f32 vcc, %3, %9\n\tv_addc_co_u32_e32 %0, vcc, 0, %0, vcc\n\tv_cmp_ge_f32 vcc, %4, %9\n\tv_addc_co_u32_e32 %0, vcc, 0, %0, vcc\n\tv_cmp_ge_f32 vcc, %5, %9\n\tv_addc_co_u32_e32 %0, vcc, 0, %0, vcc\n\tv_cmp_ge_f32 vcc, %6, %9\n\tv_addc_co_u32_e32 %0, vcc, 0, %0, vcc\n\tv_cmp_ge_f32 vcc, %7, %9\n\tv_addc_co_u32_e32 %0, vcc, 0, %0, vcc\n\tv_cmp_ge_f32 vcc, %8, %9\n\tv_addc_co_u32_e32 %0, vcc, 0, %0, vcc"
#define RT_GT8 "v_cmp_gt_f32 vcc, %1, %9\n\tv_addc_co_u32_e32 %0, vcc, 0, %0, vcc\n\tv_cmp_gt_f32 vcc, %2, %9\n\tv_addc_co_u32_e32 %0, vcc, 0, %0, vcc\n\tv_cmp_gt_f32 vcc, %3, %9\n\tv_addc_co_u32_e32 %0, vcc, 0, %0, vcc\n\tv_cmp_gt_f32 vcc, %4, %9\n\tv_addc_co_u32_e32 %0, vcc, 0, %0, vcc\n\tv_cmp_gt_f32 vcc, %5, %9\n\tv_addc_co_u32_e32 %0, vcc, 0, %0, vcc\n\tv_cmp_gt_f32 vcc, %6, %9\n\tv_addc_co_u32_e32 %0, vcc, 0, %0, vcc\n\tv_cmp_gt_f32 vcc, %7, %9\n\tv_addc_co_u32_e32 %0, vcc, 0, %0, vcc\n\tv_cmp_gt_f32 vcc, %8, %9\n\tv_addc_co_u32_e32 %0, vcc, 0, %0, vcc"
#define RT_COUNT128(OPS, cnt, thr) do { cnt = 0; RT_C8(OPS, cnt, v[0], v[1], v[2], v[3], v[4], v[5], v[6], v[7], thr); RT_C8(OPS, cnt, v[8], v[9], v[10], v[11], v[12], v[13], v[14], v[15], thr); RT_C8(OPS, cnt, v[16], v[17], v[18], v[19], v[20], v[21], v[22], v[23], thr); RT_C8(OPS, cnt, v[24], v[25], v[26], v[27], v[28], v[29], v[30], v[31], thr); RT_C8(OPS, cnt, v[32], v[33], v[34], v[35], v[36], v[37], v[38], v[39], thr); RT_C8(OPS, cnt, v[40], v[41], v[42], v[43], v[44], v[45], v[46], v[47], thr); RT_C8(OPS, cnt, v[48], v[49], v[50], v[51], v[52], v[53], v[54], v[55], thr); RT_C8(OPS, cnt, v[56], v[57], v[58], v[59], v[60], v[61], v[62], v[63], thr); RT_C8(OPS, cnt, v[64], v[65], v[66], v[67], v[68], v[69], v[70], v[71], thr); RT_C8(OPS, cnt, v[72], v[73], v[74], v[75], v[76], v[77], v[78], v[79], thr); RT_C8(OPS, cnt, v[80], v[81], v[82], v[83], v[84], v[85], v[86], v[87], thr); RT_C8(OPS, cnt, v[88], v[89], v[90], v[91], v[92], v[93], v[94], v[95], thr); RT_C8(OPS, cnt, v[96], v[97], v[98], v[99], v[100], v[101], v[102], v[103], thr); RT_C8(OPS, cnt, v[104], v[105], v[106], v[107], v[108], v[109], v[110], v[111], thr); RT_C8(OPS, cnt, v[112], v[113], v[114], v[115], v[116], v[117], v[118], v[119], thr); RT_C8(OPS, cnt, v[120], v[121], v[122], v[123], v[124], v[125], v[126], v[127], thr); } while (0)
#define RT_S5(op_str, cnt, a0, a1, a2, a3, a4, b0, b1, b2, b3, b4, thr) do { float t_; asm volatile(op_str : "+v"(cnt), "=&v"(t_) : "v"(a0), "v"(a1), "v"(a2), "v"(a3), "v"(a4), "v"(b0), "v"(b1), "v"(b2), "v"(b3), "v"(b4), "v"(thr) : "vcc"); } while (0)
#define RT_SGE5 "v_add_f32_e32 %1, %2, %7\n\tv_cmp_ge_f32 vcc, %1, %12\n\tv_addc_co_u32_e32 %0, vcc, 0, %0, vcc\n\tv_add_f32_e32 %1, %3, %8\n\tv_cmp_ge_f32 vcc, %1, %12\n\tv_addc_co_u32_e32 %0, vcc, 0, %0, vcc\n\tv_add_f32_e32 %1, %4, %9\n\tv_cmp_ge_f32 vcc, %1, %12\n\tv_addc_co_u32_e32 %0, vcc, 0, %0, vcc\n\tv_add_f32_e32 %1, %5, %10\n\tv_cmp_ge_f32 vcc, %1, %12\n\tv_addc_co_u32_e32 %0, vcc, 0, %0, vcc\n\tv_add_f32_e32 %1, %6, %11\n\tv_cmp_ge_f32 vcc, %1, %12\n\tv_addc_co_u32_e32 %0, vcc, 0, %0, vcc"
#define RT_SGT5 "v_add_f32_e32 %1, %2, %7\n\tv_cmp_gt_f32 vcc, %1, %12\n\tv_addc_co_u32_e32 %0, vcc, 0, %0, vcc\n\tv_add_f32_e32 %1, %3, %8\n\tv_cmp_gt_f32 vcc, %1, %12\n\tv_addc_co_u32_e32 %0, vcc, 0, %0, vcc\n\tv_add_f32_e32 %1, %4, %9\n\tv_cmp_gt_f32 vcc, %1, %12\n\tv_addc_co_u32_e32 %0, vcc, 0, %0, vcc\n\tv_add_f32_e32 %1, %5, %10\n\tv_cmp_gt_f32 vcc, %1, %12\n\tv_addc_co_u32_e32 %0, vcc, 0, %0, vcc\n\tv_add_f32_e32 %1, %6, %11\n\tv_cmp_gt_f32 vcc, %1, %12\n\tv_addc_co_u32_e32 %0, vcc, 0, %0, vcc"
#define RT_COUNT50(OPS, cnt, thr) do { cnt = 0; RT_S5(OPS, cnt, a[0], a[0], a[0], a[0], a[0], b[0], b[1], b[2], b[3], b[4], thr); RT_S5(OPS, cnt, a[0], a[0], a[0], a[0], a[0], b[5], b[6], b[7], b[8], b[9], thr); RT_S5(OPS, cnt, a[0], a[0], a[0], a[0], a[0], b[10], b[11], b[12], b[13], b[14], thr); RT_S5(OPS, cnt, a[0], a[1], a[1], a[1], a[1], b[15], b[0], b[1], b[2], b[3], thr); RT_S5(OPS, cnt, a[1], a[1], a[1], a[1], a[2], b[4], b[5], b[6], b[7], b[0], thr); RT_S5(OPS, cnt, a[2], a[2], a[2], a[2], a[3], b[1], b[2], b[3], b[4], b[0], thr); RT_S5(OPS, cnt, a[3], a[3], a[3], a[4], a[4], b[1], b[2], b[3], b[0], b[1], thr); RT_S5(OPS, cnt, a[4], a[5], a[5], a[6], a[6], b[2], b[0], b[1], b[0], b[1], thr); RT_S5(OPS, cnt, a[7], a[7], a[8], a[9], a[10], b[0], b[1], b[0], b[0], b[0], thr); RT_S5(OPS, cnt, a[11], a[12], a[13], a[14], a[15], b[0], b[0], b[0], b[0], b[0], thr); } while (0)
#define RT_CSWAP(x, xi, p, q) do { float t_; asm volatile("v_cmp_gt_f32 vcc, %1, %0\n\tv_cndmask_b32_e32 %4, %0, %1, vcc\n\tv_cndmask_b32_e32 %1, %1, %0, vcc\n\tv_mov_b32_e32 %0, %4\n\tv_cndmask_b32_e32 %4, %2, %3, vcc\n\tv_cndmask_b32_e32 %3, %3, %2, vcc\n\tv_mov_b32_e32 %2, %4" : "+v"(x[p]), "+v"(x[q]), "+v"(xi[p]), "+v"(xi[q]), "=&v"(t_) : : "vcc"); } while (0)
#define RT_SORT16(x, xi) do { RT_CSWAP(x, xi, 0, 1); RT_CSWAP(x, xi, 2, 3); RT_CSWAP(x, xi, 0, 2); RT_CSWAP(x, xi, 1, 3); RT_CSWAP(x, xi, 1, 2); RT_CSWAP(x, xi, 4, 5); RT_CSWAP(x, xi, 6, 7); RT_CSWAP(x, xi, 4, 6); RT_CSWAP(x, xi, 5, 7); RT_CSWAP(x, xi, 5, 6); RT_CSWAP(x, xi, 0, 4); RT_CSWAP(x, xi, 2, 6); RT_CSWAP(x, xi, 2, 4); RT_CSWAP(x, xi, 1, 5); RT_CSWAP(x, xi, 3, 7); RT_CSWAP(x, xi, 3, 5); RT_CSWAP(x, xi, 1, 2); RT_CSWAP(x, xi, 3, 4); RT_CSWAP(x, xi, 5, 6); RT_CSWAP(x, xi, 8, 9); RT_CSWAP(x, xi, 10, 11); RT_CSWAP(x, xi, 8, 10); RT_CSWAP(x, xi, 9, 11); RT_CSWAP(x, xi, 9, 10); RT_CSWAP(x, xi, 12, 13); RT_CSWAP(x, xi, 14, 15); RT_CSWAP(x, xi, 12, 14); RT_CSWAP(x, xi, 13, 15); RT_CSWAP(x, xi, 13, 14); RT_CSWAP(x, xi, 8, 12); RT_CSWAP(x, xi, 10, 14); RT_CSWAP(x, xi, 10, 12); RT_CSWAP(x, xi, 9, 13); RT_CSWAP(x, xi, 11, 15); RT_CSWAP(x, xi, 11, 13); RT_CSWAP(x, xi, 9, 10); RT_CSWAP(x, xi, 11, 12); RT_CSWAP(x, xi, 13, 14); RT_CSWAP(x, xi, 0, 8); RT_CSWAP(x, xi, 4, 12); RT_CSWAP(x, xi, 4, 8); RT_CSWAP(x, xi, 2, 10); RT_CSWAP(x, xi, 6, 14); RT_CSWAP(x, xi, 6, 10); RT_CSWAP(x, xi, 2, 4); RT_CSWAP(x, xi, 6, 8); RT_CSWAP(x, xi, 10, 12); RT_CSWAP(x, xi, 1, 9); RT_CSWAP(x, xi, 5, 13); RT_CSWAP(x, xi, 5, 9); RT_CSWAP(x, xi, 3, 11); RT_CSWAP(x, xi, 7, 15); RT_CSWAP(x, xi, 7, 11); RT_CSWAP(x, xi, 3, 5); RT_CSWAP(x, xi, 7, 9); RT_CSWAP(x, xi, 11, 13); RT_CSWAP(x, xi, 1, 2); RT_CSWAP(x, xi, 3, 4); RT_CSWAP(x, xi, 5, 6); RT_CSWAP(x, xi, 7, 8); RT_CSWAP(x, xi, 9, 10); RT_CSWAP(x, xi, 11, 12); RT_CSWAP(x, xi, 13, 14); } while (0)
#define RT_FOR_CANDS(F) F(0, 0) F(0, 1) F(0, 2) F(0, 3) F(0, 4) F(0, 5) F(0, 6) F(0, 7) F(0, 8) F(0, 9) F(0, 10) F(0, 11) F(0, 12) F(0, 13) F(0, 14) F(0, 15) F(1, 0) F(1, 1) F(1, 2) F(1, 3) F(1, 4) F(1, 5) F(1, 6) F(1, 7) F(2, 0) F(2, 1) F(2, 2) F(2, 3) F(2, 4) F(3, 0) F(3, 1) F(3, 2) F(3, 3) F(4, 0) F(4, 1) F(4, 2) F(5, 0) F(5, 1) F(6, 0) F(6, 1) F(7, 0) F(7, 1) F(8, 0) F(9, 0) F(10, 0) F(11, 0) F(12, 0) F(13, 0) F(14, 0) F(15, 0)
#define RT_SEARCH(COUNT_MACRO, NTOT) \
    for (int it_ = 0; it_ < 400 && __any(!done); ++it_) { \
        const float w_ = hi - lo; float t_ = ((float)(clo - 16) + 0.5f) * __builtin_amdgcn_rcpf((float)(clo - chi)); t_ = __builtin_fminf(__builtin_fmaxf(t_, 0.125f), 0.875f); \
        float x_ = lo + w_ * t_; if (!(x_ > lo && x_ < hi)) x_ = 0.5f * lo + 0.5f * hi; const bool stuck_ = !(x_ > lo && x_ < hi); \
        int c_; COUNT_MACRO(c_, x_); \
        if (!done) { if (stuck_) { Tv = lo; done = true; } else if (c_ == 16) { Tv = x_; done = true; } else if (c_ > 16) { lo = x_; clo = c_; } else { hi = x_; chi = c_; } } } \
    if (!done) Tv = lo;
#define RT_CNT128_GE(c, x) RT_COUNT128(RT_GE8, c, x)
#define RT_CNT50_GE(c, x) RT_COUNT50(RT_SGE5, c, x)
__device__ __forceinline__ void lane_top16_of_128(const float (&v)[128], LAS unsigned char* sb) {
    float mx = v[0], mn = v[0];
#pragma unroll
    for (int i = 1; i < 128; ++i) { mx = __builtin_fmaxf(mx, v[i]); mn = __builtin_fminf(mn, v[i]); }
    float lo = mn, hi = mx, Tv = mn; int clo = 128, chi; bool done;
    RT_CNT128_GE(chi, mx); done = (chi >= 16); if (done) Tv = mx;
    RT_SEARCH(RT_CNT128_GE, 128)
    int cgt; RT_COUNT128(RT_GT8, cgt, Tv);
    const int need = 16 - cgt; int cnt = 0, idx = 0;
#pragma unroll
    for (int i = 0; i < 128; ++i) {
        asm volatile("" : "+v"(Tv), "+v"(cnt), "+v"(idx));
        LAS unsigned char* q = sb + cnt * 512; *(LAS float*)q = v[i]; *(LAS int*)(q + 4) = idx;
        cnt += (v[i] > Tv) ? 1 : 0; idx += 1;
    }
    if (__any(need > 0)) {
        idx = 0;
#pragma unroll
        for (int i = 0; i < 128; ++i) { asm volatile("" : "+v"(Tv), "+v"(cnt), "+v"(idx));
            if (v[i] == Tv && cnt < 16) { LAS unsigned char* q = sb + cnt * 512; *(LAS float*)q = v[i]; *(LAS int*)(q + 4) = idx; cnt += 1; } idx += 1; }
    }
}
__device__ __forceinline__ int opaque_zero() { int z = 0; asm volatile("" : "+v"(z)); return z; }
__device__ __forceinline__ void route_task_search(const float* SCT, v2u* ROUTE, int tok0, int h, LAS unsigned char* scr, int lane) {
    const int tok = tok0 + lane;
    LAS unsigned char* sb = scr + lane * 8;
#pragma unroll 1
    for (int p = 0; p < 2; ++p) {
        const int g = 2 * h + p; float v[128];
        const unsigned voff = (unsigned)tok * 16u;
#pragma unroll
        for (int k = 0; k < 32; ++k) { const char* bk = (const char*)SCT + ((size_t)(g * 32 + k) * M) * 16; const f32x4 q = *(const GAS f32x4*)(bk + voff); v[4 * k] = q.x; v[4 * k + 1] = q.y; v[4 * k + 2] = q.z; v[4 * k + 3] = q.w; }
        lane_top16_of_128(v, sb + p * 8704);
    }
    LDS_WAIT();
    float a[16], b[16]; int ai[16], bi[16];
#pragma unroll
    for (int i = 0; i < 16; ++i) { const v2u ea = *(LAS v2u*)(sb + i * 512), eb = *(LAS v2u*)(sb + 8704 + i * 512);
        a[i] = __builtin_bit_cast(float, ea.x); ai[i] = (int)ea.y; b[i] = __builtin_bit_cast(float, eb.x); bi[i] = (int)eb.y; }
    LDS_WAIT();
    RT_SORT16(a, ai); RT_SORT16(b, bi);
    float lo = a[15] + b[15], hi = a[0] + b[0], Tv = lo; int clo = 50, chi; bool done;
    RT_CNT50_GE(chi, hi); done = (chi >= 16); if (done) Tv = hi;
    RT_SEARCH(RT_CNT50_GE, 50)
    int cgt; RT_COUNT50(RT_SGT5, cgt, Tv);
    const int need = 16 - cgt; int cnt = 0;
#define RT_EXT(i, j) { asm volatile("" : "+v"(Tv), "+v"(cnt)); const float s_ = a[i] + b[j]; LAS unsigned char* q_ = sb + cnt * 512; *(LAS float*)q_ = s_; *(LAS int*)(q_ + 4) = ai[i] * 128 + bi[j]; cnt += (s_ > Tv) ? 1 : 0; }
    RT_FOR_CANDS(RT_EXT)
#undef RT_EXT
    if (__any(need > 0)) {
#define RT_EXT2(i, j) { asm volatile("" : "+v"(Tv), "+v"(cnt)); const float s_ = a[i] + b[j]; if (s_ == Tv && cnt < 16) { LAS unsigned char* q_ = sb + cnt * 512; *(LAS float*)q_ = s_; *(LAS int*)(q_ + 4) = ai[i] * 128 + bi[j]; cnt += 1; } }
        RT_FOR_CANDS(RT_EXT2)
#undef RT_EXT2
    }
    LDS_WAIT();
    GAS v4u* rp = (GAS v4u*)((GAS v2u*)ROUTE + (size_t)tok * 128 + h * 16);
#pragma unroll
    for (int i = 0; i < 8; ++i) { const v2u e0 = *(LAS v2u*)(sb + (2 * i) * 512), e1 = *(LAS v2u*)(sb + (2 * i + 1) * 512); v4u o; o.x = e0.y; o.y = e0.x; o.z = e1.y; o.w = e1.x; rp[i] = o; }
    LDS_WAIT();
}

#define RT2_CE(a, b) { const int t0_ = (a), t1_ = (b); (a) = t0_ > t1_ ? t0_ : t1_; (b) = t0_ > t1_ ? t1_ : t0_; }
#define RT2_MX(a, b) ((a) > (b) ? (a) : (b))
#define RT2_SORT16(k, B) do { RT2_CE(k[(B) + 0], k[(B) + 13]); RT2_CE(k[(B) + 1], k[(B) + 12]); RT2_CE(k[(B) + 2], k[(B) + 15]); RT2_CE(k[(B) + 3], k[(B) + 14]); RT2_CE(k[(B) + 4], k[(B) + 8]); RT2_CE(k[(B) + 5], k[(B) + 6]); RT2_CE(k[(B) + 7], k[(B) + 11]); RT2_CE(k[(B) + 9], k[(B) + 10]); RT2_CE(k[(B) + 0], k[(B) + 5]); RT2_CE(k[(B) + 1], k[(B) + 7]); RT2_CE(k[(B) + 2], k[(B) + 9]); RT2_CE(k[(B) + 3], k[(B) + 4]); RT2_CE(k[(B) + 6], k[(B) + 13]); RT2_CE(k[(B) + 8], k[(B) + 14]); RT2_CE(k[(B) + 10], k[(B) + 15]); RT2_CE(k[(B) + 11], k[(B) + 12]); RT2_CE(k[(B) + 0], k[(B) + 1]); RT2_CE(k[(B) + 2], k[(B) + 3]); RT2_CE(k[(B) + 4], k[(B) + 5]); RT2_CE(k[(B) + 6], k[(B) + 8]); RT2_CE(k[(B) + 7], k[(B) + 9]); RT2_CE(k[(B) + 10], k[(B) + 11]); RT2_CE(k[(B) + 12], k[(B) + 13]); RT2_CE(k[(B) + 14], k[(B) + 15]); RT2_CE(k[(B) + 0], k[(B) + 2]); RT2_CE(k[(B) + 1], k[(B) + 3]); RT2_CE(k[(B) + 4], k[(B) + 10]); RT2_CE(k[(B) + 5], k[(B) + 11]); RT2_CE(k[(B) + 6], k[(B) + 7]); RT2_CE(k[(B) + 8], k[(B) + 9]); RT2_CE(k[(B) + 12], k[(B) + 14]); RT2_CE(k[(B) + 13], k[(B) + 15]); RT2_CE(k[(B) + 1], k[(B) + 2]); RT2_CE(k[(B) + 3], k[(B) + 12]); RT2_CE(k[(B) + 4], k[(B) + 6]); RT2_CE(k[(B) + 5], k[(B) + 7]); RT2_CE(k[(B) + 8], k[(B) + 10]); RT2_CE(k[(B) + 9], k[(B) + 11]); RT2_CE(k[(B) + 13], k[(B) + 14]); RT2_CE(k[(B) + 1], k[(B) + 4]); RT2_CE(k[(B) + 2], k[(B) + 6]); RT2_CE(k[(B) + 5], k[(B) + 8]); RT2_CE(k[(B) + 7], k[(B) + 10]); RT2_CE(k[(B) + 9], k[(B) + 13]); RT2_CE(k[(B) + 11], k[(B) + 14]); RT2_CE(k[(B) + 2], k[(B) + 4]); RT2_CE(k[(B) + 3], k[(B) + 6]); RT2_CE(k[(B) + 9], k[(B) + 12]); RT2_CE(k[(B) + 11], k[(B) + 13]); RT2_CE(k[(B) + 3], k[(B) + 5]); RT2_CE(k[(B) + 6], k[(B) + 8]); RT2_CE(k[(B) + 7], k[(B) + 9]); RT2_CE(k[(B) + 10], k[(B) + 12]); RT2_CE(k[(B) + 3], k[(B) + 4]); RT2_CE(k[(B) + 5], k[(B) + 6]); RT2_CE(k[(B) + 7], k[(B) + 8]); RT2_CE(k[(B) + 9], k[(B) + 10]); RT2_CE(k[(B) + 11], k[(B) + 12]); RT2_CE(k[(B) + 6], k[(B) + 7]); RT2_CE(k[(B) + 8], k[(B) + 9]); } while (0)
#define RT2_BIT16(k, B) do { RT2_CE(k[(B) + 0], k[(B) + 8]); RT2_CE(k[(B) + 1], k[(B) + 9]); RT2_CE(k[(B) + 2], k[(B) + 10]); RT2_CE(k[(B) + 3], k[(B) + 11]); RT2_CE(k[(B) + 4], k[(B) + 12]); RT2_CE(k[(B) + 5], k[(B) + 13]); RT2_CE(k[(B) + 6], k[(B) + 14]); RT2_CE(k[(B) + 7], k[(B) + 15]); RT2_CE(k[(B) + 0], k[(B) + 4]); RT2_CE(k[(B) + 1], k[(B) + 5]); RT2_CE(k[(B) + 2], k[(B) + 6]); RT2_CE(k[(B) + 3], k[(B) + 7]); RT2_CE(k[(B) + 8], k[(B) + 12]); RT2_CE(k[(B) + 9], k[(B) + 13]); RT2_CE(k[(B) + 10], k[(B) + 14]); RT2_CE(k[(B) + 11], k[(B) + 15]); RT2_CE(k[(B) + 0], k[(B) + 2]); RT2_CE(k[(B) + 1], k[(B) + 3]); RT2_CE(k[(B) + 4], k[(B) + 6]); RT2_CE(k[(B) + 5], k[(B) + 7]); RT2_CE(k[(B) + 8], k[(B) + 10]); RT2_CE(k[(B) + 9], k[(B) + 11]); RT2_CE(k[(B) + 12], k[(B) + 14]); RT2_CE(k[(B) + 13], k[(B) + 15]); RT2_CE(k[(B) + 0], k[(B) + 1]); RT2_CE(k[(B) + 2], k[(B) + 3]); RT2_CE(k[(B) + 4], k[(B) + 5]); RT2_CE(k[(B) + 6], k[(B) + 7]); RT2_CE(k[(B) + 8], k[(B) + 9]); RT2_CE(k[(B) + 10], k[(B) + 11]); RT2_CE(k[(B) + 12], k[(B) + 13]); RT2_CE(k[(B) + 14], k[(B) + 15]); } while (0)
#define RT2_HCLEAN(k, A, B) do { k[(A) + 0] = RT2_MX(k[(A) + 0], k[(B) + 15]); k[(A) + 1] = RT2_MX(k[(A) + 1], k[(B) + 14]); k[(A) + 2] = RT2_MX(k[(A) + 2], k[(B) + 13]); k[(A) + 3] = RT2_MX(k[(A) + 3], k[(B) + 12]); k[(A) + 4] = RT2_MX(k[(A) + 4], k[(B) + 11]); k[(A) + 5] = RT2_MX(k[(A) + 5], k[(B) + 10]); k[(A) + 6] = RT2_MX(k[(A) + 6], k[(B) + 9]); k[(A) + 7] = RT2_MX(k[(A) + 7], k[(B) + 8]); k[(A) + 8] = RT2_MX(k[(A) + 8], k[(B) + 7]); k[(A) + 9] = RT2_MX(k[(A) + 9], k[(B) + 6]); k[(A) + 10] = RT2_MX(k[(A) + 10], k[(B) + 5]); k[(A) + 11] = RT2_MX(k[(A) + 11], k[(B) + 4]); k[(A) + 12] = RT2_MX(k[(A) + 12], k[(B) + 3]); k[(A) + 13] = RT2_MX(k[(A) + 13], k[(B) + 2]); k[(A) + 14] = RT2_MX(k[(A) + 14], k[(B) + 1]); k[(A) + 15] = RT2_MX(k[(A) + 15], k[(B) + 0]); } while (0)
#define RT2_TOP16_OF_128(k) do { RT2_SORT16(k, 0); RT2_SORT16(k, 16); RT2_SORT16(k, 32); RT2_SORT16(k, 48); RT2_SORT16(k, 64); RT2_SORT16(k, 80); RT2_SORT16(k, 96); RT2_SORT16(k, 112); RT2_HCLEAN(k, 0, 16); RT2_BIT16(k, 0); RT2_HCLEAN(k, 32, 48); RT2_BIT16(k, 32); RT2_HCLEAN(k, 64, 80); RT2_BIT16(k, 64); RT2_HCLEAN(k, 96, 112); RT2_BIT16(k, 96); RT2_HCLEAN(k, 0, 32); RT2_BIT16(k, 0); RT2_HCLEAN(k, 64, 96); RT2_BIT16(k, 64); RT2_HCLEAN(k, 0, 64); RT2_BIT16(k, 0); } while (0)
#define RT2_BUILD_CANDS(c) do { c[0] = RT2_CK(0, 0); c[1] = RT2_CK(0, 1); c[2] = RT2_CK(0, 2); c[3] = RT2_CK(0, 3); c[4] = RT2_CK(0, 4); c[5] = RT2_CK(0, 5); c[6] = RT2_CK(0, 6); c[7] = RT2_CK(0, 7); c[8] = RT2_CK(0, 8); c[9] = RT2_CK(0, 9); c[10] = RT2_CK(0, 10); c[11] = RT2_CK(0, 11); c[12] = RT2_CK(0, 12); c[13] = RT2_CK(0, 13); c[14] = RT2_CK(0, 14); c[15] = RT2_CK(0, 15); c[16] = RT2_CK(1, 0); c[17] = RT2_CK(1, 1); c[18] = RT2_CK(1, 2); c[19] = RT2_CK(1, 3); c[20] = RT2_CK(1, 4); c[21] = RT2_CK(1, 5); c[22] = RT2_CK(1, 6); c[23] = RT2_CK(1, 7); c[24] = RT2_CK(15, 0); c[25] = RT2_CK(14, 0); c[26] = RT2_CK(13, 0); c[27] = RT2_CK(12, 0); c[28] = RT2_CK(11, 0); c[29] = RT2_CK(10, 0); c[30] = RT2_CK(9, 0); c[31] = RT2_CK(8, 0); c[32] = RT2_CK(2, 0); c[33] = RT2_CK(2, 1); c[34] = RT2_CK(2, 2); c[35] = RT2_CK(2, 3); c[36] = RT2_CK(2, 4); c[37] = RT2_CK(3, 0); c[38] = RT2_CK(3, 1); c[39] = RT2_CK(3, 2); c[40] = RT2_CK(3, 3); c[41] = RT2_CK(4, 0); c[42] = RT2_CK(4, 1); c[43] = RT2_CK(4, 2); c[44] = RT2_CK(5, 0); c[45] = RT2_CK(5, 1); c[46] = RT2_CK(6, 0); c[47] = RT2_CK(6, 1); } while (0)
__device__ __forceinline__ int rt2_tr(int u) { return u ^ (int)((unsigned)(u >> 31) >> 1); }
__device__ __forceinline__ int rt2_key(float x, int code, int mask) { return (rt2_tr(__builtin_bit_cast(int, x)) & ~mask) | code; }
__device__ __forceinline__ int rt2_key16(unsigned hbits_hi, int code) { return (rt2_tr((int)hbits_hi) & (int)0xffff0000) | code; }
__device__ __forceinline__ float rt2_val16(int k) { const unsigned u = (unsigned)rt2_tr(k) >> 16; return (float)__builtin_bit_cast(_Float16, (unsigned short)u); }
__device__ __forceinline__ void route_task(const unsigned short* SCT, v2u* ROUTE, int tok0, int h, LAS unsigned char* scr, int lane) {
    const int tok = tok0 + lane;
    LAS unsigned char* sb = scr + lane * 4;
#pragma unroll 1
    for (int p = 0; p < 2; ++p) {
        const int g = 2 * h + p; int k[128];
        const unsigned voff = (unsigned)tok * 16u;
#pragma unroll
        for (int q8 = 0; q8 < 16; ++q8) { const char* bq = (const char*)SCT + ((size_t)(g * 16 + q8) * M) * 16; const v4u q = *(const GAS v4u*)(bq + voff);
            k[8 * q8 + 0] = rt2_key16(q.x << 16, 127 - 8 * q8); k[8 * q8 + 1] = rt2_key16(q.x, 126 - 8 * q8); k[8 * q8 + 2] = rt2_key16(q.y << 16, 125 - 8 * q8); k[8 * q8 + 3] = rt2_key16(q.y, 124 - 8 * q8);
            k[8 * q8 + 4] = rt2_key16(q.z << 16, 123 - 8 * q8); k[8 * q8 + 5] = rt2_key16(q.z, 122 - 8 * q8); k[8 * q8 + 6] = rt2_key16(q.w << 16, 121 - 8 * q8); k[8 * q8 + 7] = rt2_key16(q.w, 120 - 8 * q8); }
        RT2_TOP16_OF_128(k);
#pragma unroll
        for (int i = 0; i < 16; ++i) *(LAS int*)(sb + (p * 16 + i) * 256) = k[i];
    }
    LDS_WAIT();
    float af[16], bf[16];
#pragma unroll
    for (int i = 0; i < 16; ++i) { af[i] = rt2_val16(*(const LAS int*)(sb + i * 256)); bf[i] = rt2_val16(*(const LAS int*)(sb + (16 + i) * 256)); }
    int c[48];
#define RT2_CK(i, j) rt2_key(af[i] + bf[j], 255 - (16 * (i) + (j)), 255)
    RT2_BUILD_CANDS(c);
    const int r7a = RT2_CK(7, 0), r7b = RT2_CK(7, 1);
#undef RT2_CK
    RT2_BIT16(c, 16);
    RT2_SORT16(c, 32);
    RT2_HCLEAN(c, 0, 16); RT2_BIT16(c, 0);
    c[46] = RT2_MX(c[46], r7b); c[47] = RT2_MX(c[47], r7a); RT2_BIT16(c, 32);
    RT2_HCLEAN(c, 0, 32);
    GAS v4u* rp = (GAS v4u*)((GAS v2u*)ROUTE + (size_t)tok * 128 + h * 16);
#pragma unroll
    for (int i = 0; i < 8; ++i) { v4u o;
        { const int ij = (~c[2 * i]) & 255; const int ka = *(const LAS int*)(sb + ((ij >> 4) << 8)), kb = *(const LAS int*)(sb + 4096 + ((ij & 15) << 8));
          o.x = (unsigned)(((~ka) & 127) * 128 + ((~kb) & 127)); o.y = __builtin_bit_cast(unsigned, rt2_val16(ka) + rt2_val16(kb)); }
        { const int ij = (~c[2 * i + 1]) & 255; const int ka = *(const LAS int*)(sb + ((ij >> 4) << 8)), kb = *(const LAS int*)(sb + 4096 + ((ij & 15) << 8));
          o.z = (unsigned)(((~ka) & 127) * 128 + ((~kb) & 127)); o.w = __builtin_bit_cast(unsigned, rt2_val16(ka) + rt2_val16(kb)); }
        rp[i] = o; }
    LDS_WAIT();
}

#define DPPF(v, ctrl) __builtin_bit_cast(float, __builtin_amdgcn_update_dpp(0, __builtin_bit_cast(int, (v)), (ctrl), 0xf, 0xf, true))
__device__ __forceinline__ float wave_max_f(float m) {
#pragma unroll
    for (int o = 1; o < 64; o <<= 1) m = __builtin_fmaxf(m, __shfl_xor(m, o));
    return m;
}
template <int NV> __device__ __forceinline__ void select16(const float (&v)[NV], bool (&sel)[NV], int (&pos)[NV]) {
    float mx = v[0], mn = v[0];
#pragma unroll
    for (int i = 1; i < NV; ++i) { mx = __builtin_fmaxf(mx, v[i]); mn = __builtin_fminf(mn, v[i]); }
    mx = wave_max_f(mx); mn = -wave_max_f(-mn);
    float lo = mn, hi = mx, Tv;
    { int c = 0;
#pragma unroll
      for (int i = 0; i < NV; ++i) c += __popcll(__ballot(v[i] >= mx));
      if (c >= 16) { Tv = mx; }
      else {
        Tv = lo;
        for (int it = 0; it < 300; ++it) {
            const float mid = 0.5f * lo + 0.5f * hi;
            if (!(mid > lo && mid < hi)) { Tv = lo; break; }
            int cc = 0;
#pragma unroll
            for (int i = 0; i < NV; ++i) cc += __popcll(__ballot(v[i] >= mid));
            if (cc == 16) { Tv = mid; break; }
            if (cc > 16) lo = mid; else hi = mid;
            Tv = lo;
        }
      }
    }
    int cgt = 0;
#pragma unroll
    for (int i = 0; i < NV; ++i) cgt += __popcll(__ballot(v[i] > Tv));
    const int need = 16 - cgt;
    int eqbelow = 0;
#pragma unroll
    for (int i = 0; i < NV; ++i) { const unsigned long long m = __ballot(v[i] == Tv); eqbelow += __builtin_amdgcn_mbcnt_hi((unsigned)(m >> 32), __builtin_amdgcn_mbcnt_lo((unsigned)m, 0u)); }
    int eqown = 0;
#pragma unroll
    for (int i = 0; i < NV; ++i) { const bool eq = (v[i] == Tv); sel[i] = (v[i] > Tv) || (eq && (eqbelow + eqown) < need); eqown += eq ? 1 : 0; }
    int selbelow = 0;
#pragma unroll
    for (int i = 0; i < NV; ++i) { const unsigned long long m = __ballot(sel[i]); selbelow += __builtin_amdgcn_mbcnt_hi((unsigned)(m >> 32), __builtin_amdgcn_mbcnt_lo((unsigned)m, 0u)); }
    int own = 0;
#pragma unroll
    for (int i = 0; i < NV; ++i) { pos[i] = selbelow + own; own += sel[i] ? 1 : 0; }
}

__device__ __forceinline__ float gelu_exact(float a) { return 0.5f * a * (1.0f + erff(a * 0.7071067811865476f)); }

__device__ __forceinline__ void fp8_row_dot(const v4u q, const float (&xr)[16], float& s) {
    const f32x2 a0 = __builtin_amdgcn_cvt_pk_f32_fp8((int)q.x, false), a1 = __builtin_amdgcn_cvt_pk_f32_fp8((int)q.x, true), a2 = __builtin_amdgcn_cvt_pk_f32_fp8((int)q.y, false), a3 = __builtin_amdgcn_cvt_pk_f32_fp8((int)q.y, true);
    const f32x2 b0 = __builtin_amdgcn_cvt_pk_f32_fp8((int)q.z, false), b1 = __builtin_amdgcn_cvt_pk_f32_fp8((int)q.z, true), b2 = __builtin_amdgcn_cvt_pk_f32_fp8((int)q.w, false), b3 = __builtin_amdgcn_cvt_pk_f32_fp8((int)q.w, true);
    f32x2 t = a0 * (f32x2){xr[0], xr[1]};
    t = __builtin_elementwise_fma(a1, (f32x2){xr[2], xr[3]}, t); t = __builtin_elementwise_fma(a2, (f32x2){xr[4], xr[5]}, t); t = __builtin_elementwise_fma(a3, (f32x2){xr[6], xr[7]}, t);
    t = __builtin_elementwise_fma(b0, (f32x2){xr[8], xr[9]}, t); t = __builtin_elementwise_fma(b1, (f32x2){xr[10], xr[11]}, t); t = __builtin_elementwise_fma(b2, (f32x2){xr[12], xr[13]}, t); t = __builtin_elementwise_fma(b3, (f32x2){xr[14], xr[15]}, t);
    s = t.x + t.y;
}
__device__ __forceinline__ void fp8_row_axpy2(const v4u q, const float w, f32x2 (&acc)[8]) {
    const f32x2 a0 = __builtin_amdgcn_cvt_pk_f32_fp8((int)q.x, false), a1 = __builtin_amdgcn_cvt_pk_f32_fp8((int)q.x, true), a2 = __builtin_amdgcn_cvt_pk_f32_fp8((int)q.y, false), a3 = __builtin_amdgcn_cvt_pk_f32_fp8((int)q.y, true);
    const f32x2 b0 = __builtin_amdgcn_cvt_pk_f32_fp8((int)q.z, false), b1 = __builtin_amdgcn_cvt_pk_f32_fp8((int)q.z, true), b2 = __builtin_amdgcn_cvt_pk_f32_fp8((int)q.w, false), b3 = __builtin_amdgcn_cvt_pk_f32_fp8((int)q.w, true);
    const f32x2 ww = {w, w};
    acc[0] = __builtin_elementwise_fma(a0, ww, acc[0]); acc[1] = __builtin_elementwise_fma(a1, ww, acc[1]); acc[2] = __builtin_elementwise_fma(a2, ww, acc[2]); acc[3] = __builtin_elementwise_fma(a3, ww, acc[3]);
    acc[4] = __builtin_elementwise_fma(b0, ww, acc[4]); acc[5] = __builtin_elementwise_fma(b1, ww, acc[5]); acc[6] = __builtin_elementwise_fma(b2, ww, acc[6]); acc[7] = __builtin_elementwise_fma(b3, ww, acc[7]);
}
__device__ __forceinline__ void fp8_row_axpy(const v4u q, const float w, float (&acc)[16]) {
    const f32x2 a0 = __builtin_amdgcn_cvt_pk_f32_fp8((int)q.x, false), a1 = __builtin_amdgcn_cvt_pk_f32_fp8((int)q.x, true), a2 = __builtin_amdgcn_cvt_pk_f32_fp8((int)q.y, false), a3 = __builtin_amdgcn_cvt_pk_f32_fp8((int)q.y, true);
    const f32x2 b0 = __builtin_amdgcn_cvt_pk_f32_fp8((int)q.z, false), b1 = __builtin_amdgcn_cvt_pk_f32_fp8((int)q.z, true), b2 = __builtin_amdgcn_cvt_pk_f32_fp8((int)q.w, false), b3 = __builtin_amdgcn_cvt_pk_f32_fp8((int)q.w, true);
    acc[0] += w * a0.x; acc[1] += w * a0.y; acc[2] += w * a1.x; acc[3] += w * a1.y; acc[4] += w * a2.x; acc[5] += w * a2.y; acc[6] += w * a3.x; acc[7] += w * a3.y;
    acc[8] += w * b0.x; acc[9] += w * b0.y; acc[10] += w * b1.x; acc[11] += w * b1.y; acc[12] += w * b2.x; acc[13] += w * b2.y; acc[14] += w * b3.x; acc[15] += w * b3.y;
}
__device__ __forceinline__ void fp8_convert_row(const float* src, const float* gain, unsigned char* dst, float* inv_scale, int lane, int sliced, int e) {
    const GAS f32x4* sp = (const GAS f32x4*)src; float v[16];
#pragma unroll
    for (int j = 0; j < 2; ++j) { f32x4 a = sp[2 * lane + 128 * j], b = sp[2 * lane + 128 * j + 1];
        if (gain) { const GAS f32x4* gp = (const GAS f32x4*)gain; const f32x4 ga = gp[2 * lane + 128 * j], gb = gp[2 * lane + 128 * j + 1]; a = a * ga; b = b * gb; }
        v[8 * j + 0] = a.x; v[8 * j + 1] = a.y; v[8 * j + 2] = a.z; v[8 * j + 3] = a.w; v[8 * j + 4] = b.x; v[8 * j + 5] = b.y; v[8 * j + 6] = b.z; v[8 * j + 7] = b.w; }
    float am = 0.f;
#pragma unroll
    for (int i = 0; i < 16; ++i) am = __builtin_fmaxf(am, __builtin_fabsf(v[i]));
    am = wave_max_f(am);
    const float sc = (am > 0.f) ? 384.0f / am : 1.0f, inv = (am > 0.f) ? am * (1.0f / 384.0f) : 1.0f;
    v4u q;
    { int w = __builtin_amdgcn_cvt_pk_fp8_f32(v[0] * sc, v[1] * sc, 0, false); w = __builtin_amdgcn_cvt_pk_fp8_f32(v[2] * sc, v[3] * sc, w, true); q.x = (unsigned)w; }
    { int w = __builtin_amdgcn_cvt_pk_fp8_f32(v[4] * sc, v[5] * sc, 0, false); w = __builtin_amdgcn_cvt_pk_fp8_f32(v[6] * sc, v[7] * sc, w, true); q.y = (unsigned)w; }
    { int w = __builtin_amdgcn_cvt_pk_fp8_f32(v[8] * sc, v[9] * sc, 0, false); w = __builtin_amdgcn_cvt_pk_fp8_f32(v[10] * sc, v[11] * sc, w, true); q.z = (unsigned)w; }
    { int w = __builtin_amdgcn_cvt_pk_fp8_f32(v[12] * sc, v[13] * sc, 0, false); w = __builtin_amdgcn_cvt_pk_fp8_f32(v[14] * sc, v[15] * sc, w, true); q.w = (unsigned)w; }
    if (!sliced) ((GAS v4u*)dst)[lane] = q;
    else { v2u q0, q1; q0.x = q.x; q0.y = q.y; q1.x = q.z; q1.y = q.w; const int s0 = lane >> 4, o8 = 8 * (lane & 15);
        *(GAS v2u*)(dst + ((size_t)s0 * NEXP + e) * 128 + o8) = q0; *(GAS v2u*)(dst + ((size_t)(s0 + 4) * NEXP + e) * 128 + o8) = q1; }
    if (lane == 0) *inv_scale = inv;
}

#define PIN_ACC2(b) asm volatile("" : "+v"(b), "+v"(acc2[0]), "+v"(acc2[1]), "+v"(acc2[2]), "+v"(acc2[3]), "+v"(acc2[4]), "+v"(acc2[5]), "+v"(acc2[6]), "+v"(acc2[7]))
#define PIN_ACC(b) asm volatile("" : "+v"(b), "+v"(acc[0]), "+v"(acc[1]), "+v"(acc[2]), "+v"(acc[3]), "+v"(acc[4]), "+v"(acc[5]), "+v"(acc[6]), "+v"(acc[7]), "+v"(acc[8]), "+v"(acc[9]), "+v"(acc[10]), "+v"(acc[11]), "+v"(acc[12]), "+v"(acc[13]), "+v"(acc[14]), "+v"(acc[15]))
#define PC_META_U(tk) do { const char* rb_ = (const char*)route + (size_t)(tk) * 1024; m_e0 = *(const GAS int*)(rb_ + l8); m_e1 = *(const GAS int*)(rb_ + 512 + l8); } while (0)
#define PC_ISSUE_U(buf, xs, par, tk) do { LAS int* lid_ = (LAS int*)(scr + (par) * 512); lid_[lane] = m_e0; lid_[lane + 64] = m_e1; LDS_WAIT(); \
        { const GAS f32x4* xq_ = (const GAS f32x4*)(x1 + (size_t)(tk) * D + 128 * s + 16 * c); const f32x4 x0_ = xq_[0], x1_ = xq_[1], x2_ = xq_[2], x3_ = xq_[3]; \
          xs[0] = x0_.x; xs[1] = x0_.y; xs[2] = x0_.z; xs[3] = x0_.w; xs[4] = x1_.x; xs[5] = x1_.y; xs[6] = x1_.z; xs[7] = x1_.w; xs[8] = x2_.x; xs[9] = x2_.y; xs[10] = x2_.z; xs[11] = x2_.w; xs[12] = x3_.x; xs[13] = x3_.y; xs[14] = x3_.z; xs[15] = x3_.w; } \
        _Pragma("unroll") for (int k = 0; k < 16; ++k) { const int e_ = lid_[8 * k + r]; buf[k] = *(const GAS v4u*)(tbs + (unsigned)(e_ * 128)); } } while (0)
#define PC_COMPUTE_U(buf, xs, tk) do { float p_[16]; \
        _Pragma("unroll") for (int k = 0; k < 16; ++k) { if (k) asm volatile("" : "+v"(buf[k]), "+v"(p_[k ? k - 1 : 0])); else asm volatile("" : "+v"(buf[k])); fp8_row_dot(buf[k], xs, p_[k]); } \
        float q8_[8], q4_[4], q2_[2]; \
        _Pragma("unroll") for (int k = 0; k < 8; ++k) { const float send = c2 ? p_[k] : p_[k + 8], keep = c2 ? p_[k + 8] : p_[k]; q8_[k] = keep + __shfl_xor(send, 4); } \
        _Pragma("unroll") for (int k = 0; k < 4; ++k) { const float send = c1 ? q8_[k] : q8_[k + 4], keep = c1 ? q8_[k + 4] : q8_[k]; q4_[k] = keep + __shfl_xor(send, 2); } \
        _Pragma("unroll") for (int k = 0; k < 2; ++k) { const float send = c0 ? q4_[k] : q4_[k + 2], keep = c0 ? q4_[k + 2] : q4_[k]; q2_[k] = keep + __shfl_xor(send, 1); } \
        GAS float* up_ = (GAS float*)(Upart + ((size_t)s * M + (tk)) * 128 + 64 * c2 + 32 * c1 + 16 * c0 + r); up_[0] = q2_[0]; up_[8] = q2_[1]; } while (0)
__device__ __forceinline__ void peer_u_phase(int s, int tok0, int tstride, int nitems, const v2u* route, const float* x1, const unsigned char* TU8s, float* Upart, LAS unsigned char* scr, int lane) {
    const int r = lane >> 3, c = lane & 7, c2 = (lane >> 2) & 1, c1 = (lane >> 1) & 1, c0 = lane & 1; const unsigned l8 = (unsigned)lane * 8u;
    const char* tbs = (const char*)TU8s + (size_t)s * NEXP * 128 + 16 * c;
    int m_e0, m_e1;
    v4u bufA[16], bufB[16]; float xsA[16], xsB[16];
    PC_META_U(tok0); PC_ISSUE_U(bufA, xsA, 0, tok0); if (nitems > 1) PC_META_U(tok0 + tstride);
#pragma unroll 1
    for (int i = 0; i < nitems; i += 2) {
        const int tk = tok0 + i * tstride;
        if (i + 1 < nitems) PC_ISSUE_U(bufB, xsB, 1, tk + tstride);
        if (i + 2 < nitems) PC_META_U(tk + 2 * tstride);
        PC_COMPUTE_U(bufA, xsA, tk);
        if (i + 1 < nitems) {
            if (i + 2 < nitems) PC_ISSUE_U(bufA, xsA, 0, tk + 2 * tstride);
            if (i + 3 < nitems) PC_META_U(tk + 3 * tstride);
            PC_COMPUTE_U(bufB, xsB, tk + tstride);
        }
    }
    LDS_WAIT();
}
#define PD_META_U(tk) do { const char* rb_ = (const char*)route + (size_t)(tk) * 1024; m_e0 = *(const GAS int*)(rb_ + l8); m_e1 = *(const GAS int*)(rb_ + 512 + l8); \
        m_x = *(const GAS f32x2*)(x1 + (size_t)(tk) * D + 128 * s + 2 * lane); } while (0)
#define PD_ISSUE_U(buf, xq, xinv, par) do { LAS int* lid_ = (LAS int*)(scr + (par) * 1024); LAS unsigned short* lx_ = (LAS unsigned short*)(scr + (par) * 1024 + 512); lid_[lane] = m_e0; lid_[lane + 64] = m_e1; LDS_WAIT(); \
        _Pragma("unroll") for (int k = 0; k < 16; ++k) { const int e_ = lid_[8 * k + r]; buf[k] = *(const GAS v4u*)(tbs + (unsigned)(e_ * 128)); } \
        { float am_ = __builtin_fmaxf(__builtin_fabsf(m_x.x), __builtin_fabsf(m_x.y)); \
          _Pragma("unroll") for (int o_ = 1; o_ < 64; o_ <<= 1) am_ = __builtin_fmaxf(am_, __shfl_xor(am_, o_)); \
          const float sc_ = (am_ > 0.f) ? 127.0f / am_ : 0.f; xinv = am_ * (1.0f / 127.0f); \
          const int q0_ = (int)__builtin_rintf(m_x.x * sc_), q1_ = (int)__builtin_rintf(m_x.y * sc_); lx_[lane] = (unsigned short)(((unsigned)q0_ & 255u) | (((unsigned)q1_ & 255u) << 8)); } \
        LDS_WAIT(); xq = *(const LAS v4u*)((LAS unsigned char*)lx_ + 16 * c); } while (0)
#define PD_COMPUTE_U(buf, xq, xinv, tk) do { int p_[16]; \
        _Pragma("unroll") for (int k = 0; k < 16; ++k) { int a_ = __builtin_amdgcn_sdot4((int)buf[k].x, (int)xq.x, 0, false); a_ = __builtin_amdgcn_sdot4((int)buf[k].y, (int)xq.y, a_, false); \
            a_ = __builtin_amdgcn_sdot4((int)buf[k].z, (int)xq.z, a_, false); a_ = __builtin_amdgcn_sdot4((int)buf[k].w, (int)xq.w, a_, false); p_[k] = a_; } \
        int q8_[8], q4_[4], q2_[2]; \
        _Pragma("unroll") for (int k = 0; k < 8; ++k) { const int send = c2 ? p_[k] : p_[k + 8], keep = c2 ? p_[k + 8] : p_[k]; q8_[k] = keep + __shfl_xor(send, 4); } \
        _Pragma("unroll") for (int k = 0; k < 4; ++k) { const int send = c1 ? q8_[k] : q8_[k + 4], keep = c1 ? q8_[k + 4] : q8_[k]; q4_[k] = keep + __shfl_xor(send, 2); } \
        _Pragma("unroll") for (int k = 0; k < 2; ++k) { const int send = c0 ? q4_[k] : q4_[k + 2], keep = c0 ? q4_[k + 2] : q4_[k]; q2_[k] = keep + __shfl_xor(send, 1); } \
        GAS bf16* up_ = (GAS bf16*)Upart + ((size_t)s * M + (tk)) * 128 + 64 * c2 + 32 * c1 + 16 * c0 + r; const unsigned pk_ = cvtpk((float)q2_[0] * xinv, (float)q2_[1] * xinv); up_[0] = (bf16)(pk_ & 0xffffu); up_[8] = (bf16)(pk_ >> 16); } while (0)
__device__ __forceinline__ void peer_u_phase_dot4(int s, int tok0, int tstride, int nitems, const v2u* route, const float* x1, const unsigned char* TU8s, float* Upart, LAS unsigned char* scr, int lane) {
    const int r = lane >> 3, c = lane & 7, c2 = (lane >> 2) & 1, c1 = (lane >> 1) & 1, c0 = lane & 1; const unsigned l8 = (unsigned)lane * 8u;
    const char* tbs = (const char*)TU8s + (size_t)s * NEXP * 128 + 16 * c;
    int m_e0, m_e1; f32x2 m_x;
    v4u bufA[16], bufB[16], xqA, xqB; float xiA, xiB;
    PD_META_U(tok0); PD_ISSUE_U(bufA, xqA, xiA, 0); if (nitems > 1) PD_META_U(tok0 + tstride);
#pragma unroll 1
    for (int it = 0; it < nitems; it += 2) {
        const int tk = tok0 + it * tstride;
        if (it + 1 < nitems) PD_ISSUE_U(bufB, xqB, xiB, 1);
        if (it + 2 < nitems) PD_META_U(tk + 2 * tstride);
        PD_COMPUTE_U(bufA, xqA, xiA, tk);
        if (it + 1 < nitems) {
            if (it + 2 < nitems) PD_ISSUE_U(bufA, xqA, xiA, 0);
            if (it + 3 < nitems) PD_META_U(tk + 3 * tstride);
            PD_COMPUTE_U(bufB, xqB, xiB, tk + tstride);
        }
    }
    LDS_WAIT();
}
__device__ __forceinline__ void peer_w_token(int tok, const v2u* route, const float* x1, const float* Upart, const float* SU, const float* SV, float* W, int lane) {
    const GAS f32x4* xp = (const GAS f32x4*)(x1 + (size_t)tok * D) + lane; float ssq = 0.f;
#pragma unroll
    for (int j = 0; j < 4; ++j) { const f32x4 q = xp[64 * j]; ssq += (q.x * q.x + q.y * q.y) + (q.z * q.z + q.w * q.w); }
    const float rstd2 = 1.0f / sqrtf(wave_sum(ssq) * (1.0f / D) + RMS_EPS);
    const char* rb_ = (const char*)route + (size_t)tok * 1024; const unsigned l8_ = (unsigned)lane * 8u;
    const v2u r_lo = *(const GAS v2u*)(rb_ + l8_), r_hi = *(const GAS v2u*)(rb_ + 512 + l8_);
    float g_lo, g_hi;
#pragma unroll
    for (int half = 0; half < 2; ++half) {
        const float sc_ = __builtin_bit_cast(float, half ? r_hi.y : r_lo.y) * rstd2; float m_ = sc_;
#pragma unroll
        for (int o = 1; o < 16; o <<= 1) m_ = __builtin_fmaxf(m_, __shfl_xor(m_, o));
        const float p_ = __builtin_amdgcn_exp2f((sc_ - m_) * 1.4426950408889634f); float sum_ = p_;
#pragma unroll
        for (int o = 1; o < 16; o <<= 1) sum_ += __shfl_xor(sum_, o);
        if (half) g_hi = p_ / sum_; else g_lo = p_ / sum_;
    }
    asm volatile("" : "+v"(g_lo), "+v"(g_hi));
#pragma unroll
    for (int half = 0; half < 2; ++half) {
        const int e = (int)(half ? r_hi.x : r_lo.x); const int n = lane + 64 * half;
        float dot = 0.f;
#pragma unroll
        for (int s8 = 0; s8 < 8; ++s8) dot += Upart[((size_t)s8 * M + tok) * 128 + n];
        const float act = gelu_exact(dot * SU[e] * rstd2);
        W[(size_t)tok * 128 + n] = (half ? g_hi : g_lo) * act * SV[e];
    }
}
__device__ __forceinline__ void peer_w_token2(int tokA, int tokB, const v2u* route, const bf16* x1b, const bf16* Upart, const float* SU, const float* SV, float* W, int lane) {
    v4u xv[2][2]; v2u r_lo[2], r_hi[2]; unsigned short ub[2][2][8];
#pragma unroll
    for (int t = 0; t < 2; ++t) { const int tok = t ? tokB : tokA;
        const GAS v4u* xp = (const GAS v4u*)(x1b + (size_t)tok * D) + lane; xv[t][0] = xp[0]; xv[t][1] = xp[64];
        const char* rb_ = (const char*)route + (size_t)tok * 1024; const unsigned l8_ = (unsigned)lane * 8u;
        r_lo[t] = *(const GAS v2u*)(rb_ + l8_); r_hi[t] = *(const GAS v2u*)(rb_ + 512 + l8_);
#pragma unroll
        for (int half = 0; half < 2; ++half)
#pragma unroll
            for (int s8 = 0; s8 < 8; ++s8) ub[t][half][s8] = *(const GAS bf16*)(Upart + ((size_t)s8 * M + tok) * 128 + lane + 64 * half); }
#pragma unroll
    for (int t = 0; t < 2; ++t) { const int tok = t ? tokB : tokA;
        float ssq = 0.f;
#pragma unroll
        for (int j = 0; j < 2; ++j) { const v4u q = xv[t][j];
            ssq += (bflo(q.x) * bflo(q.x) + bfhi(q.x) * bfhi(q.x)) + (bflo(q.y) * bflo(q.y) + bfhi(q.y) * bfhi(q.y)) + (bflo(q.z) * bflo(q.z) + bfhi(q.z) * bfhi(q.z)) + (bflo(q.w) * bflo(q.w) + bfhi(q.w) * bfhi(q.w)); }
        const float rstd2 = 1.0f / sqrtf(wave_sum(ssq) * (1.0f / D) + RMS_EPS);
        float g_lo, g_hi;
#pragma unroll
        for (int half = 0; half < 2; ++half) {
            const float sc_ = __builtin_bit_cast(float, half ? r_hi[t].y : r_lo[t].y) * rstd2; float m_ = sc_;
#pragma unroll
            for (int o = 1; o < 16; o <<= 1) m_ = __builtin_fmaxf(m_, __shfl_xor(m_, o));
            const float p_ = __builtin_amdgcn_exp2f((sc_ - m_) * 1.4426950408889634f); float sum_ = p_;
#pragma unroll
            for (int o = 1; o < 16; o <<= 1) sum_ += __shfl_xor(sum_, o);
            if (half) g_hi = p_ / sum_; else g_lo = p_ / sum_;
        }
        asm volatile("" : "+v"(g_lo), "+v"(g_hi));
#pragma unroll
        for (int half = 0; half < 2; ++half) {
            const int e = (int)(half ? r_hi[t].x : r_lo[t].x); const int n = lane + 64 * half;
            float dot = 0.f;
#pragma unroll
            for (int s8 = 0; s8 < 8; ++s8) dot += __builtin_bit_cast(float, (unsigned)ub[t][half][s8] << 16);
            const float act = gelu_exact(dot * SU[e] * rstd2);
            W[(size_t)tok * 128 + n] = (half ? g_hi : g_lo) * act * SV[e];
        }
    }
}
#define PC_META_V(tk) do { const char* rb_ = (const char*)route + (size_t)(tk) * 1024; m_e0 = *(const GAS int*)(rb_ + l8); m_e1 = *(const GAS int*)(rb_ + 512 + l8); \
        const GAS float* wp_ = (const GAS float*)(W + (size_t)(tk) * 128); m_w0 = wp_[lane]; m_w1 = wp_[lane + 64]; m_xv = *(const GAS f32x2*)(xio + (size_t)(tk) * D + col0); } while (0)
#define PC_ISSUE_V(buf, wk, xv, par) do { LAS int* lid_ = (LAS int*)(scr + (par) * 1024); LAS float* lw_ = (LAS float*)(scr + (par) * 1024 + 512); lid_[lane] = m_e0; lid_[lane + 64] = m_e1; lw_[lane] = m_w0; lw_[lane + 64] = m_w1; LDS_WAIT(); xv = m_xv; \
        _Pragma("unroll") for (int k = 0; k < 16; ++k) { const int e_ = lid_[8 * k + r]; wk[k] = lw_[8 * k + r]; buf[k] = *(const GAS v4u*)(tbs + (unsigned)(e_ * 128)); } } while (0)
#define PC_COMPUTE_V(buf, wk, xv, tk) do { f32x2 acc2[8]; _Pragma("unroll") for (int i_ = 0; i_ < 8; ++i_) acc2[i_] = (f32x2){0.f, 0.f}; \
        _Pragma("unroll") for (int k = 0; k < 16; ++k) { PIN_ACC2(buf[k]); fp8_row_axpy2(buf[k], wk[k], acc2); } \
        float acc[16]; _Pragma("unroll") for (int i_ = 0; i_ < 8; ++i_) { acc[2 * i_] = acc2[i_].x; acc[2 * i_ + 1] = acc2[i_].y; } \
        float r8_[8], r4_[4], r2_[2]; \
        _Pragma("unroll") for (int i_ = 0; i_ < 8; ++i_) { const float send = b5 ? acc[i_] : acc[i_ + 8], keep = b5 ? acc[i_ + 8] : acc[i_]; r8_[i_] = keep + __shfl_xor(send, 32); } \
        _Pragma("unroll") for (int i_ = 0; i_ < 4; ++i_) { const float send = b4 ? r8_[i_] : r8_[i_ + 4], keep = b4 ? r8_[i_ + 4] : r8_[i_]; r4_[i_] = keep + __shfl_xor(send, 16); } \
        _Pragma("unroll") for (int i_ = 0; i_ < 2; ++i_) { const float send = b3 ? r4_[i_] : r4_[i_ + 2], keep = b3 ? r4_[i_ + 2] : r4_[i_]; r2_[i_] = keep + __shfl_xor(send, 8); } \
        f32x2 o_ = xv; o_.x += r2_[0]; o_.y += r2_[1]; *(GAS f32x2*)(xio + (size_t)(tk) * D + col0) = o_; } while (0)
__device__ __forceinline__ void peer_v_phase(int s, int tok0, int tstride, int nitems, const v2u* route, const float* W, const unsigned char* TV8s, float* xio, float* SS, LAS unsigned char* scr, int lane) {
    const int r = lane >> 3, c = lane & 7, b5 = lane >> 5, b4 = (lane >> 4) & 1, b3 = (lane >> 3) & 1; const unsigned l8 = (unsigned)lane * 8u;
    const int col0 = 128 * s + 16 * c + 8 * b5 + 4 * b4 + 2 * b3;
    const char* tbs = (const char*)TV8s + (size_t)s * NEXP * 128 + 16 * c;
    int m_e0, m_e1; float m_w0, m_w1; f32x2 m_xv;
    v4u bufA[16], bufB[16]; float wA[16], wB[16]; f32x2 xvA, xvB;
    PC_META_V(tok0); PC_ISSUE_V(bufA, wA, xvA, 0); if (nitems > 1) PC_META_V(tok0 + tstride);
#pragma unroll 1
    for (int i = 0; i < nitems; i += 2) {
        const int tk = tok0 + i * tstride;
        if (i + 1 < nitems) PC_ISSUE_V(bufB, wB, xvB, 1);
        if (i + 2 < nitems) PC_META_V(tk + 2 * tstride);
        PC_COMPUTE_V(bufA, wA, xvA, tk);
        if (i + 1 < nitems) {
            if (i + 2 < nitems) PC_ISSUE_V(bufA, wA, xvA, 0);
            if (i + 3 < nitems) PC_META_V(tk + 3 * tstride);
            PC_COMPUTE_V(bufB, wB, xvB, tk + tstride);
        }
    }
    LDS_WAIT();
}


__device__ __forceinline__ void peer_u_debug(int tok, const v2u* route, const float* x1, const unsigned char* TU8s, const float* SU, const float* SV, float* W, int lane) {
    float xr[16], ssq = 0.f;
    { const GAS f32x4* xp = (const GAS f32x4*)(x1 + (size_t)tok * D + 16 * lane);
#pragma unroll
      for (int j = 0; j < 4; ++j) { const f32x4 a = xp[j]; xr[4 * j] = a.x; xr[4 * j + 1] = a.y; xr[4 * j + 2] = a.z; xr[4 * j + 3] = a.w; } }
#pragma unroll
    for (int i = 0; i < 16; ++i) ssq += xr[i] * xr[i];
    const float rstd2 = 1.0f / sqrtf(wave_sum(ssq) * (1.0f / D) + RMS_EPS);
    const char* rb_ = (const char*)route + (size_t)tok * 1024; const int s = lane >> 3, c = lane & 7;
#pragma unroll 1
    for (int h = 0; h < 8; ++h) {
        float sc[16]; int id[16]; float m = -3e38f;
#pragma unroll
        for (int i = 0; i < 16; ++i) { const v2u r = *(const GAS v2u*)(rb_ + (h * 16 + i) * 8 + opaque_zero()); id[i] = (int)r.x; sc[i] = __builtin_bit_cast(float, r.y) * rstd2; m = __builtin_fmaxf(m, sc[i]); }
        float sum = 0.f;
#pragma unroll
        for (int i = 0; i < 16; ++i) { sc[i] = __builtin_amdgcn_exp2f((sc[i] - m) * 1.4426950408889634f); sum += sc[i]; }
#pragma unroll
        for (int i = 0; i < 16; ++i) { const int e = id[i];
            const v4u q = *(const GAS v4u*)(TU8s + ((size_t)s * NEXP + e) * 128 + 16 * c);
            float d; fp8_row_dot(q, xr, d); d = wave_sum(d);
            const float act = gelu_exact(d * SU[e] * rstd2);
            if (lane == 0) W[(size_t)tok * 128 + h * 16 + i] = (sc[i] / sum) * act * SV[e]; }
    }
}
__device__ __forceinline__ void peer_v_debug(int tok, const v2u* route, const float* W, const unsigned char* TV8s, float* xio, float* SS, int lane) {
    const char* rb_ = (const char*)route + (size_t)tok * 1024;
    float acc[16];
#pragma unroll
    for (int i = 0; i < 16; ++i) acc[i] = 0.f;
    const int s = lane >> 3, c = lane & 7;
#pragma unroll 1
    for (int n = 0; n < 128; ++n) {
        const int e = *(const GAS int*)(rb_ + n * 8 + opaque_zero()); const float w = W[(size_t)tok * 128 + n + opaque_zero()];
        const v4u q = *(const GAS v4u*)(TV8s + ((size_t)s * NEXP + e) * 128 + 16 * c);
        fp8_row_axpy(q, w, acc);
    }
    float ssq = 0.f;
    GAS float* xp = (GAS float*)(xio + (size_t)tok * D + 16 * lane);
#pragma unroll
    for (int i = 0; i < 16; ++i) { const float o = xp[i] + acc[i]; xp[i] = o; ssq += o * o; }
    ssq = wave_sum(ssq);
    if (lane < 8) SS[(size_t)lane * M + tok] = (lane == 0) ? ssq : 0.f;
}
#ifndef DUP_MASK
#define DUP_MASK 0
#endif
#define NREP(k) (1 + ((DUP_MASK >> (k)) & 1))
struct Args { const float* in[14]; float* out; unsigned char* ws; int ph_lo, ph_hi, li, pad; };
__global__ void __launch_bounds__(NWAVES * 64, 2) hybrid_fwd(Args args) {
    extern __shared__ __attribute__((aligned(16))) unsigned char lds[];
    LAS unsigned char* ldsb = (LAS unsigned char*)lds;
    volatile LAS unsigned* MISC = (volatile LAS unsigned*)(ldsb + MISC_OFF);
    const int tid = threadIdx.x, lane = tid & 63, wave = __builtin_amdgcn_readfirstlane(tid >> 6);
    const int G = gridDim.x; const int bx = blockIdx.x; const int vcu = (G % 8 == 0) ? (bx % 8) * (G / 8) + bx / 8 : bx;
    const int gw = vcu * NWAVES + wave, NGW = G * NWAVES;
    unsigned char* ws = args.ws;
    gu32* ctl = (gu32*)(ws + WS_CTL);
    const float* x = args.in[0]; float* out = args.out;
#define norm_mix (args.in[1])
#define w_in (args.in[2])
#define conv_w (args.in[3])
#define conv_b (args.in[4])
#define w_a (args.in[5])
#define w_b (args.in[6])
#define w_o (args.in[7])
#define norm_ffn (args.in[8])
#define w_q (args.in[9])
#define sub_keys (args.in[10])
#define exp_u (args.in[11])
#define exp_v (args.in[12])
#define final_norm (args.in[13])
#define Weff ((bf16*)((bf16*)(ws + WS_WEFF)))
#define Wab ((bf16*)((bf16*)(ws + WS_WAB)))
#define Wo_t ((bf16*)((bf16*)(ws + WS_WO)))
#define Win_t ((bf16*)((bf16*)(ws + WS_WIN)))
#define XB ((bf16*)((bf16*)(ws + WS_XB)))
#define SIX ((bf16*)((bf16*)(ws + WS_SIX)))
#define VT ((bf16*)((bf16*)(ws + WS_VT)))
#define GATE ((bf16*)((bf16*)(ws + WS_GATE)))
#define MERGED ((bf16*)((bf16*)(ws + WS_MERGED)))
#define X1B ((bf16*)((bf16*)(ws + WS_X1B)))
#define TU8 ((unsigned char*)(ws + WS_TU))
#define TV8 ((unsigned char*)(ws + WS_TV))
#define SU ((float*)((float*)(ws + WS_SU)))
#define SV ((float*)((float*)(ws + WS_SV)))
#define SCORES ((float*)((float*)(ws + WS_SCORES)))
#define ROUTE ((v2u*)((v2u*)(ws + WS_ROUTE)))
#define WBUF ((float*)((float*)(ws + WS_W)))
#define SSB ((float*)((float*)(ws + WS_SS)))
#define UPART ((float*)((float*)(ws + WS_UPART)))
#define RSTD1 ((float*)((float*)(ws + WS_RSTD1)))
#define QB ((bf16*)(SIX))
#define CBB ((bf16*)(SIX + (size_t)1 * M * 512))
#define KB ((bf16*)(SIX + (size_t)2 * M * 512))
#define CCB ((bf16*)(SIX + (size_t)4 * M * 512))
#define CUB ((bf16*)(SIX + (size_t)5 * M * 512))
    for (int u = tid; u < (LDS_BYTES - LDSCTL_OFF) / 4; u += NWAVES * 64) ((LAS unsigned*)(ldsb + LDSCTL_OFF))[u] = 0u;
    __syncthreads();
    XcdBarrier bar; bar.bar = (unsigned*)(ctl + CW_BAR); bar.x = 0; bar.st = nullptr;
    if (N_LAUNCHES == 1) bar = xcd_barrier_post((unsigned*)(ctl + CW_BAR), MISC + 8);
#define GRID_BAR() do { if (N_LAUNCHES == 1) xcd_barrier(bar); } while (0)
    const int lo = args.ph_lo, hi = args.ph_hi;
#define IN(k) (lo <= (k) && (k) < hi)
#define BOTH(k) (IN(k) && IN((k) + 1))

    if (IN(0)) { for (int rep = 0; rep < NREP(0); ++rep) {
        LAS float* scr = (LAS float*)(ldsb + RING_OFF + wave * 16384);
        constexpr int I_IN = (D / 64) * (NIN / 32), I_A = (512 / 64) * (D / 32), I_O = (D / 64) * (D / 32);
        constexpr int NITEMS = I_IN + 2 * I_A + I_O;
        constexpr int ABW = 3; const int aw = vcu * ABW + wave, NAW = G * ABW, cw = vcu * (NWAVES - ABW) + (wave - ABW), NCW = G * (NWAVES - ABW);
        if (wave < ABW) {
        for (int it = aw; it < NITEMS; it += NAW) {
            int r = it;
            if (r < I_IN) { p0_transpose_item(w_in, D, NIN, Win_t, 0, norm_mix, scr, r, lane); continue; } r -= I_IN;
            if (r < I_A) { p0_transpose_item(w_a, 512, D, Wab, 0, nullptr, scr, r, lane); continue; } r -= I_A;
            if (r < I_A) { p0_transpose_item(w_b, 512, D, Wab, 1024, nullptr, scr, r, lane); continue; } r -= I_A;
            p0_transpose_item(w_o, D, D, Wo_t, 0, nullptr, scr, r, lane);
        }
        for (int wt = aw; wt < 64 * 32; wt += NAW) {
            const int nt = wt & 63, kt = wt >> 6, hp = nt >> 2, h = lane >> 5, l32 = lane & 31;
            const GAS f32x4* ap = (const GAS f32x4*)(w_q + (size_t)(kt * 32 + l32) * 2048 + hp * 128 + 64 * h);
            const GAS f32x4* bp = (const GAS f32x4*)(sub_keys + (size_t)(nt * 32 + l32) * 128 + 64 * h);
            f32x4 av[16], bv[16];
#pragma unroll
            for (int i = 0; i < 16; ++i) { av[i] = ap[i]; bv[i] = bp[i]; }
            f32x16 acc;
#pragma unroll
            for (int i = 0; i < 16; ++i) acc[i] = 0.f;
#pragma unroll
            for (int i = 0; i < 16; ++i) {
                acc = __builtin_amdgcn_mfma_f32_32x32x2f32(av[i].x, bv[i].x, acc, 0, 0, 0); acc = __builtin_amdgcn_mfma_f32_32x32x2f32(av[i].y, bv[i].y, acc, 0, 0, 0);
                acc = __builtin_amdgcn_mfma_f32_32x32x2f32(av[i].z, bv[i].z, acc, 0, 0, 0); acc = __builtin_amdgcn_mfma_f32_32x32x2f32(av[i].w, bv[i].w, acc, 0, 0, 0); }
            const int n = nt * 32 + l32;
#pragma unroll
            for (int rq = 0; rq < 4; ++rq) { const int kb = kt * 32 + 8 * rq + 4 * h; const f32x4 g = *(const GAS f32x4*)(norm_ffn + kb);
                v2u o; o.x = pk2(acc[4 * rq] * g.x, acc[4 * rq + 1] * g.y); o.y = pk2(acc[4 * rq + 2] * g.z, acc[4 * rq + 3] * g.w);
                *(GAS v2u*)(Weff + (size_t)n * D + kb) = o; }
        }
        } else {
        for (int m0 = cw; m0 < M; m0 += 4 * NCW) {
            f32x4 v[4][4]; float s[4];
#pragma unroll
            for (int q = 0; q < 4; ++q) { const int m = m0 + q * NCW; const GAS f32x4* xr = (const GAS f32x4*)(x + (size_t)(m < M ? m : m0) * D) + lane;
#pragma unroll
                for (int j = 0; j < 4; ++j) v[q][j] = xr[64 * j]; }
#pragma unroll
            for (int q = 0; q < 4; ++q) { s[q] = 0.f;
#pragma unroll
                for (int j = 0; j < 4; ++j) s[q] += (v[q][j].x * v[q][j].x + v[q][j].y * v[q][j].y) + (v[q][j].z * v[q][j].z + v[q][j].w * v[q][j].w); }
#pragma unroll
            for (int o = 1; o < 64; o <<= 1) {
#pragma unroll
                for (int q = 0; q < 4; ++q) s[q] += __shfl_xor(s[q], o); }
#pragma unroll
            for (int q = 0; q < 4; ++q) { const int m = m0 + q * NCW; if (m < M) {
                const float rstd = 1.0f / sqrtf(s[q] * (1.0f / D) + RMS_EPS);
                GAS v2u* o8 = (GAS v2u*)(XB + (size_t)m * D) + lane;
#pragma unroll
                for (int j = 0; j < 4; ++j) { v2u o; o.x = pk2(v[q][j].x, v[q][j].y); o.y = pk2(v[q][j].z, v[q][j].w); o8[64 * j] = o; }
                if (lane == 0) RSTD1[m] = rstd; } }
        }
        for (int e0 = cw; e0 < NEXP; e0 += 2 * NCW) {
            float v[4][16]; float am[4]; int ee[4];
#pragma unroll
            for (int q = 0; q < 4; ++q) { const int e = e0 + (q >> 1) * NCW; ee[q] = e < NEXP ? e : e0; const float* src = ((q & 1) ? exp_v : exp_u) + (size_t)ee[q] * D; const GAS f32x4* sp = (const GAS f32x4*)src;
#pragma unroll
                for (int j = 0; j < 2; ++j) { const f32x4 a = sp[2 * lane + 128 * j], b = sp[2 * lane + 128 * j + 1];
                    v[q][8 * j + 0] = a.x; v[q][8 * j + 1] = a.y; v[q][8 * j + 2] = a.z; v[q][8 * j + 3] = a.w; v[q][8 * j + 4] = b.x; v[q][8 * j + 5] = b.y; v[q][8 * j + 6] = b.z; v[q][8 * j + 7] = b.w; } }
            { const GAS f32x4* gp = (const GAS f32x4*)norm_ffn;
#pragma unroll
              for (int j = 0; j < 2; ++j) { const f32x4 ga = gp[2 * lane + 128 * j], gb = gp[2 * lane + 128 * j + 1];
#pragma unroll
                for (int q = 0; q < 4; q += 2) { v[q][8 * j + 0] *= ga.x; v[q][8 * j + 1] *= ga.y; v[q][8 * j + 2] *= ga.z; v[q][8 * j + 3] *= ga.w; v[q][8 * j + 4] *= gb.x; v[q][8 * j + 5] *= gb.y; v[q][8 * j + 6] *= gb.z; v[q][8 * j + 7] *= gb.w; } } }
#pragma unroll
            for (int q = 0; q < 4; ++q) { am[q] = 0.f;
#pragma unroll
                for (int i = 0; i < 16; ++i) am[q] = __builtin_fmaxf(am[q], __builtin_fabsf(v[q][i])); }
#pragma unroll
            for (int o = 1; o < 64; o <<= 1) {
#pragma unroll
                for (int q = 0; q < 4; ++q) am[q] = __builtin_fmaxf(am[q], __shfl_xor(am[q], o)); }
#pragma unroll
            for (int q = 0; q < 4; ++q) { const int e = e0 + (q >> 1) * NCW; if (e < NEXP) {
                const float top = (q & 1) ? 384.0f : 127.0f;
                const float sc = (am[q] > 0.f) ? top / am[q] : 1.0f, inv = (am[q] > 0.f) ? am[q] * (1.0f / top) : 1.0f;
                v2u q0, q1;
                if (q & 1) {
                { int w = __builtin_amdgcn_cvt_pk_fp8_f32(v[q][0] * sc, v[q][1] * sc, 0, false); w = __builtin_amdgcn_cvt_pk_fp8_f32(v[q][2] * sc, v[q][3] * sc, w, true); q0.x = (unsigned)w; }
                { int w = __builtin_amdgcn_cvt_pk_fp8_f32(v[q][4] * sc, v[q][5] * sc, 0, false); w = __builtin_amdgcn_cvt_pk_fp8_f32(v[q][6] * sc, v[q][7] * sc, w, true); q0.y = (unsigned)w; }
                { int w = __builtin_amdgcn_cvt_pk_fp8_f32(v[q][8] * sc, v[q][9] * sc, 0, false); w = __builtin_amdgcn_cvt_pk_fp8_f32(v[q][10] * sc, v[q][11] * sc, w, true); q1.x = (unsigned)w; }
                { int w = __builtin_amdgcn_cvt_pk_fp8_f32(v[q][12] * sc, v[q][13] * sc, 0, false); w = __builtin_amdgcn_cvt_pk_fp8_f32(v[q][14] * sc, v[q][15] * sc, w, true); q1.y = (unsigned)w; }
                } else {
                    unsigned w4[4];
#pragma unroll
                    for (int j = 0; j < 4; ++j) { const int i0 = (int)__builtin_rintf(v[q][4 * j] * sc), i1 = (int)__builtin_rintf(v[q][4 * j + 1] * sc), i2 = (int)__builtin_rintf(v[q][4 * j + 2] * sc), i3 = (int)__builtin_rintf(v[q][4 * j + 3] * sc);
                        w4[j] = ((unsigned)i0 & 255u) | (((unsigned)i1 & 255u) << 8) | (((unsigned)i2 & 255u) << 16) | ((unsigned)i3 << 24); }
                    q0.x = w4[0]; q0.y = w4[1]; q1.x = w4[2]; q1.y = w4[3];
                }
                unsigned char* dst = (q & 1) ? TV8 : TU8; const int s0 = lane >> 4, o8 = 8 * (lane & 15);
                *(GAS v2u*)(dst + ((size_t)s0 * NEXP + e) * 128 + o8) = q0; *(GAS v2u*)(dst + ((size_t)(s0 + 4) * NEXP + e) * 128 + o8) = q1;
                if (lane == 0) ((q & 1) ? SV : SU)[e] = inv; } }
        }
                }
}
        if (BOTH(0)) GRID_BAR();
    }

    if (IN(1)) { for (int rep = 0; rep < NREP(1); ++rep) { if (rep) GRID_BAR();
        pg8::Gemm g{XB, Win_t, M, NIN, D}; pg8::StaticOrder S; S.init(M, NIN, G, (int)blockIdx.x);
        pg8::EpiProj E{SIX, VT, GATE, RSTD1, (DUP_MASK & 64) ? rep : 0};
        pg8::gemm_phase<pg8::EpiProj, pg8::StaticOrder, true, true>(ldsb + RING_OFF, g, S, E); }
        if (DUP_MASK & 128) { const unsigned long long t0 = __builtin_amdgcn_s_memrealtime(); while (__builtin_amdgcn_s_memrealtime() - t0 < 15000ull) __builtin_amdgcn_s_sleep(8); }
        if (BOTH(1)) GRID_BAR();
    }

    if (IN(2)) {
        for (int rep = 0; rep < NREP(2); ++rep) {
        const bool dummy = (rep + 1 < NREP(2));
        conv_phase(CBB, CCB, CUB, dummy ? XB : CBB, conv_w, conv_b, gw * 64 + lane, NGW * 64);
        for (int it = gw; it < BATCH * NH * (T / 32); it += NGW) {
            const int bh = it >> 7, qblk = it & 127;
            attn_item(QB, KB, VT, dummy ? MERGED : QB, bh >> 3, bh & 7, qblk, lane);
        }
        }
        if (BOTH(2)) GRID_BAR();
    }

    if (IN(3)) { for (int rep = 0; rep < NREP(3); ++rep) { if (rep) GRID_BAR();
        pg8::Gemm g{QB, Wab, 2 * M, 2048, 512}; pg8::PairOrder S; S.init(G, (int)blockIdx.x);
        pg8::EpiGate E{out, MERGED, GATE, GATE + (size_t)M * 1024};
        pg8::gemm_phase<pg8::EpiGate, pg8::PairOrder, true, true>(ldsb + RING_OFF, g, S, E); }
        if (BOTH(3)) GRID_BAR();
    }

    if (IN(4)) { for (int rep = 0; rep < NREP(4); ++rep) { if (rep) GRID_BAR();
        pg8::Gemm g{MERGED, Wo_t, M, D, D}; pg8::StaticOrder S; S.init(M, D, G, (int)blockIdx.x);
        pg8::EpiWo E{x, out, X1B};
        pg8::gemm_phase<pg8::EpiWo, pg8::StaticOrder, false, true>(ldsb + RING_OFF, g, S, E);
        }
        if (BOTH(4)) GRID_BAR();
    }

    if (IN(5)) { for (int rep = 0; rep < NREP(5); ++rep) { if (rep) GRID_BAR();
        pg8::Gemm g{X1B, Weff, M, 2048, D}; pg8::StaticOrder S; S.init(M, 2048, G, (int)blockIdx.x);
        pg8::EpiScores E{(unsigned short*)SCORES};
        pg8::gemm_phase<pg8::EpiScores, pg8::StaticOrder, true, true>(ldsb + RING_OFF, g, S, E);
        asm volatile("s_waitcnt vmcnt(0)" ::: "memory"); __syncthreads();
        int nu = 0; { pg8::Unit u; while (S.next(nu, u)) ++nu; }
        LAS unsigned char* scr = ldsb + RING_OFF + wave * 8192;
        for (int t = wave; t < nu * 4; t += NWAVES) { pg8::Unit u; S.next(t >> 2, u); route_task((const unsigned short*)SCORES, ROUTE, u.pm * 256 + (t & 3) * 64, u.pn, scr, lane); } }
        if (BOTH(5)) GRID_BAR();
    }
    const bool sliced_ok = (G % 8 == 0) && (M % ((G / 8) * NWAVES) == 0);

    if (IN(7)) {
        LAS unsigned char* scr = ldsb + RING_OFF + wave * 2048;
#ifdef DEBUG_U
        if (1) {} else
#endif
        if (sliced_ok) { const int nj = G >> 3; peer_u_phase_dot4(bx & 7, (bx >> 3) * NWAVES + wave, nj * NWAVES, M / (nj * NWAVES), ROUTE, out, TU8, UPART, scr, lane); }
        else for (int s8 = 0; s8 < 8; ++s8) { const int nt = (M - 1 - gw) / NGW + 1; if (gw < M) peer_u_phase_dot4(s8, gw, NGW, nt, ROUTE, out, TU8, UPART, scr, lane); }
        if (BOTH(7)) GRID_BAR();
    }

    if (IN(8)) {
#ifdef DEBUG_U
        for (int tok = gw; tok < M; tok += NGW) peer_u_debug(tok, ROUTE, out, TU8, SU, SV, WBUF, lane);
#else
        for (int tok = gw; tok < M; tok += 2 * NGW) peer_w_token2(tok, (tok + NGW < M) ? tok + NGW : tok, ROUTE, X1B, (const bf16*)UPART, SU, SV, WBUF, lane);
#endif
        if (BOTH(8)) GRID_BAR();
    }

    if (IN(9)) {
        LAS unsigned char* scr = ldsb + RING_OFF + wave * 2048;
#ifdef DEBUG_V
        for (int tok = gw; tok < M; tok += NGW) peer_v_debug(tok, ROUTE, WBUF, TV8, out, SSB, lane);
        if (0)
#endif
        if (sliced_ok) { const int nj = G >> 3; peer_v_phase(bx & 7, (bx >> 3) * NWAVES + wave, nj * NWAVES, M / (nj * NWAVES), ROUTE, WBUF, TV8, out, SSB, scr, lane); }
        else for (int s8 = 0; s8 < 8; ++s8) { const int nt = (M - 1 - gw) / NGW + 1; if (gw < M) peer_v_phase(s8, gw, NGW, nt, ROUTE, WBUF, TV8, out, SSB, scr, lane); }
        if (BOTH(9)) GRID_BAR();
    }

    if (IN(10)) {
        for (int tok = gw; tok < M; tok += NGW) {
            GAS f32x4* op = (GAS f32x4*)(out + (size_t)tok * D) + lane; const GAS f32x4* gp = (const GAS f32x4*)final_norm + lane;
            f32x4 v[4]; float s2 = 0.f;
#pragma unroll
            for (int j = 0; j < 4; ++j) { v[j] = op[64 * j]; s2 += (v[j].x * v[j].x + v[j].y * v[j].y) + (v[j].z * v[j].z + v[j].w * v[j].w); }
            const float rstd3 = 1.0f / sqrtf(wave_sum(s2) * (1.0f / D) + RMS_EPS);
#pragma unroll
            for (int j = 0; j < 4; ++j) { const f32x4 g = gp[64 * j]; f32x4 o; o.x = v[j].x * rstd3 * g.x; o.y = v[j].y * rstd3 * g.y; o.z = v[j].z * rstd3 * g.z; o.w = v[j].w * rstd3 * g.w; op[64 * j] = o; }
        }
    }
#undef IN
#undef BOTH
#undef GRID_BAR
#undef norm_mix
#undef w_in
#undef conv_w
#undef conv_b
#undef w_a
#undef w_b
#undef w_o
#undef norm_ffn
#undef w_q
#undef sub_keys
#undef exp_u
#undef exp_v
#undef final_norm
#undef Weff
#undef Wab
#undef Wo_t
#undef Win_t
#undef XB
#undef SIX
#undef VT
#undef GATE
#undef MERGED
#undef X1B
#undef TU8
#undef TV8
#undef SU
#undef SV
#undef SCORES
#undef ROUTE
#undef WBUF
#undef SSB
#undef UPART
#undef RSTD1
#undef QB
#undef CBB
#undef KB
#undef CCB
#undef CUB
}

extern "C" void kernel_launch(void* const* d_in, const int* in_sizes, int n_in, void* d_out, int out_size, void* d_ws, size_t ws_size, hipStream_t stream) {
    static int grid = 0;
    if (grid == 0) {
        if (n_in != 14 || in_sizes[0] != M * D || out_size != M * D || ws_size < WS_END) { fprintf(stderr, "kernel_launch: built for 14 inputs, x/out of %d floats, >= %zu bytes of workspace; got n_in %d, in0 %d, out %d, ws %zu; nothing launched\n", M * D, (size_t)WS_END, n_in, n_in > 0 ? in_sizes[0] : -1, out_size, ws_size); grid = -1; return; }
        int dev = 0, cus = 0, per_cu = 0;
        if (hipGetDevice(&dev) != hipSuccess || hipDeviceGetAttribute(&cus, hipDeviceAttributeMultiprocessorCount, dev) != hipSuccess) { fprintf(stderr, "kernel_launch: device query failed\n"); grid = -1; return; }
        if (hipFuncSetAttribute((const void*)hybrid_fwd, hipFuncAttributeMaxDynamicSharedMemorySize, LDS_BYTES) != hipSuccess) { fprintf(stderr, "kernel_launch: hipFuncSetAttribute failed\n"); grid = -1; return; }
        if (hipOccupancyMaxActiveBlocksPerMultiprocessor(&per_cu, (const void*)hybrid_fwd, NWAVES * 64, LDS_BYTES) != hipSuccess || per_cu < 1) { fprintf(stderr, "kernel_launch: occupancy query reports %d workgroups per CU\n", per_cu); per_cu = 1; }
        (void)hipGetLastError();
        grid = cus;
    }
    if (grid < 0) return;
    if (hipMemsetAsync((char*)d_ws + WS_CTL, 0, CTL_ZERO_BYTES, stream) != hipSuccess) { fprintf(stderr, "kernel_launch: hipMemsetAsync failed\n"); return; }
    Args a{};
    for (int i = 0; i < 14; ++i) a.in[i] = (const float*)d_in[i];
    a.out = (float*)d_out; a.ws = (unsigned char*)d_ws;
#ifdef PROBE_SEQ
    const int seq[] = PROBE_SEQ; const int nseq = (int)(sizeof(seq) / sizeof(int));
#else
    const int seq[] = {0, 1, 2, 3, 4, 5, 6, 7, 8, 9, 10}; const int nseq = (N_LAUNCHES == 1) ? 1 : 11;
#endif
    for (int li = 0; li < nseq; ++li) {
        a.ph_lo = (N_LAUNCHES == 1) ? 0 : seq[li]; a.ph_hi = (N_LAUNCHES == 1) ? N_PHASES : seq[li] + 1; a.li = li;
        hipLaunchKernelGGL(hybrid_fwd, dim3(grid), dim3(NWAVES * 64), LDS_BYTES, stream, a);
        const hipError_t le = hipPeekAtLastError();
        if (le != hipSuccess) { fprintf(stderr, "kernel_launch: launch %d failed: %s\n", li, hipGetErrorName(le)); break; }
    }
}
```

```cpp
#define DUP_MASK 0
#include <hip/hip_runtime.h>
#include <cstdio>
#include <cstdint>
#include <cmath>
namespace pg8 {
#define PG8_LAS __attribute__((address_space(3)))
typedef unsigned short bf16_t;
typedef short bf16x8 __attribute__((ext_vector_type(8)));
typedef float f32x4 __attribute__((ext_vector_type(4)));
typedef unsigned u32x4 __attribute__((ext_vector_type(4)));
constexpr int BM = 256, BK = 64, HALF = 128, HTB = HALF * BK * 2  , STAGE_BYTES = 8 * HTB, NXCD = 8, WGM = 8;

__host__ __device__ __forceinline__ int lds_byte(int r, int c) { const int st = (r >> 4) * 2 + (c >> 5), rr = r & 15, cc = c & 31, ob = rr * 64 + cc * 2; return st * 1024 + (ob ^ (((ob >> 9) & 1) << 5)); }
__host__ __device__ __forceinline__ void stage_rc(int b, int& R, int& C) { const int st = b / 1024, sb = b % 1024, swz = sb ^ (((sb >> 9) & 1) << 5); R = (st >> 1) * 16 + swz / 64; C = (st & 1) * 32 + (swz % 64) / 2; }
__host__ __device__ __forceinline__ int perm32(int rho) { const int n = rho >> 4, i = rho & 15; return 8 * (i >> 2) + 4 * n + (i & 3); }

struct Unit { int pm, pn; };
struct Gemm { const bf16_t* A; const bf16_t* Bt; int M, N, K; };

struct StaticOrder {
    int nM, nN, nwg, G, c;
    __host__ __device__ void init(int M, int N, int G_, int c_) { nM = M / BM; nN = N / BM; nwg = nM * nN; G = G_; c = c_; }
    __host__ __device__ bool next(int i, Unit& u) const {
        const long L = (long)i * G + c; if (L >= nwg) return false;
        int wgid = (int)L; { const int q = nwg / NXCD, r = nwg % NXCD, xcd = wgid % NXCD, off = wgid / NXCD; wgid = (xcd < r ? xcd * (q + 1) : r * (q + 1) + (xcd - r) * q) + off; }
        const int nig = WGM * nN, gid = wgid / nig, fm = gid * WGM, gsz = (nM - fm) < WGM ? (nM - fm) : WGM;
        u.pm = fm + ((wgid % nig) % gsz); u.pn = (wgid % nig) / gsz; return true;
    }
    __device__ __forceinline__ void a_ready(const Unit&) const {}
    __device__ __forceinline__ void done(const Unit&) const {}
};

__device__ __forceinline__ unsigned cvt_pk_bf16(float lo, float hi) { unsigned r; asm volatile("v_cvt_pk_bf16_f32 %0, %1, %2" : "=v"(r) : "v"(lo), "v"(hi)); return r; }
constexpr int MTOK = 16384;
__device__ __forceinline__ unsigned f2bf_rne(float f) { unsigned u = __builtin_bit_cast(unsigned, f); return (u + 0x7fffu + ((u >> 16) & 1u)) >> 16; }
__device__ __forceinline__ float bf_lo(unsigned w) { return __builtin_bit_cast(float, w << 16); }
__device__ __forceinline__ float bf_hi(unsigned w) { return __builtin_bit_cast(float, w & 0xffff0000u); }
__device__ __forceinline__ float sigmoid_fast(float x) { return __builtin_amdgcn_rcpf(1.0f + __builtin_amdgcn_exp2f(-1.4426950408889634f * x)); }

struct EpiProj {
    static constexpr bool PERM = true, AFTER_DRAIN = false;
    bf16_t* six;
    bf16_t* vt;
    bf16_t* gate;
    const float* rstd; int skip;
    __device__ __forceinline__ void operator()(const f32x4 (&acc)[2][2][4][2], const Unit& u, int wr, int wc, int fr, int fq) const {
        const int row0 = u.pm * BM + wr * 64 + fr; const int colt = u.pn * BM;
        if (skip) return;
        if (colt < 3072) {
            const int t = colt >> 9, cc = colt & 511;
            if (t == 2) {
#pragma unroll
                for (int ai = 0; ai < 2; ++ai)
#pragma unroll
                    for (int m = 0; m < 4; ++m) { const int r = row0 + ai * HALF + m * 16; const float rs = rstd[r]; const int b = r >> 12, tt = r & 4095;
#pragma unroll
                        for (int bj = 0; bj < 2; ++bj) { const int c0 = cc + bj * HALF + wc * 32 + 8 * fq; const int hh = c0 >> 6, d0 = c0 & 63;
                            bf16_t* p = vt + ((size_t)((b * 8 + hh) * 64 + d0)) * 4096 + tt;
#pragma unroll
                            for (int n = 0; n < 2; ++n)
#pragma unroll
                                for (int i = 0; i < 4; ++i) p[(size_t)(4 * n + i) * 4096] = (bf16_t)f2bf_rne(acc[ai][bj][m][n][i] * rs); } }
            } else {
                const int bufidx = (t == 0) ? 0 : (t == 1) ? 2 : (t == 3) ? 1 : t;
                bf16_t* base = six + (size_t)bufidx * MTOK * 512; const float sc = (t == 0) ? 0.125f : 1.0f;
                const int col0 = cc + wc * 32 + 8 * fq;
#pragma unroll
                for (int ai = 0; ai < 2; ++ai)
#pragma unroll
                    for (int m = 0; m < 4; ++m) { const int r = row0 + ai * HALF + m * 16; const float rs = rstd[r] * sc; bf16_t* rowp = base + (size_t)r * 512 + col0;
#pragma unroll
                        for (int bj = 0; bj < 2; ++bj) { const f32x4 v0 = acc[ai][bj][m][0] * rs, v1 = acc[ai][bj][m][1] * rs;
                            u32x4 w; w.x = cvt_pk_bf16(v0[0], v0[1]); w.y = cvt_pk_bf16(v0[2], v0[3]); w.z = cvt_pk_bf16(v1[0], v1[1]); w.w = cvt_pk_bf16(v1[2], v1[3]);
                            *(u32x4*)(rowp + bj * HALF) = w; } }
            }
        } else {
            const int gi = (colt - 3072) >> 10, cc = (colt - 3072) & 1023;
            bf16_t* base = gate + (size_t)gi * MTOK * 1024; const int col0 = cc + wc * 32 + 8 * fq;
#pragma unroll
            for (int ai = 0; ai < 2; ++ai)
#pragma unroll
                for (int m = 0; m < 4; ++m) { const int r = row0 + ai * HALF + m * 16; const float rs = rstd[r]; bf16_t* rowp = base + (size_t)r * 1024 + col0;
#pragma unroll
                    for (int bj = 0; bj < 2; ++bj) { f32x4 v0 = acc[ai][bj][m][0] * rs, v1 = acc[ai][bj][m][1] * rs;
#pragma unroll
                        for (int i = 0; i < 4; ++i) { v0[i] = sigmoid_fast(v0[i]); v1[i] = sigmoid_fast(v1[i]); }
                        u32x4 w; w.x = cvt_pk_bf16(v0[0], v0[1]); w.y = cvt_pk_bf16(v0[2], v0[3]); w.z = cvt_pk_bf16(v1[0], v1[1]); w.w = cvt_pk_bf16(v1[2], v1[3]);
                        *(u32x4*)(rowp + bj * HALF) = w; } }
        }
    }
};

struct EpiGate {
    static constexpr bool PERM = true, AFTER_DRAIN = false;
    float* P; bf16_t* merged; const bf16_t* g0; const bf16_t* g1;
    __device__ __forceinline__ void operator()(const f32x4 (&acc)[2][2][4][2], const Unit& u, int wr, int wc, int fr, int fq) const {
        const int which = (u.pm >= 64) ? 1 : 0; const int pm = u.pm - 64 * which, pn = u.pn - 4 * which;
        const int row0 = pm * BM + wr * 64 + fr, col0 = pn * BM + wc * 32 + 8 * fq; const bf16_t* g = which ? g1 : g0;
#pragma unroll
        for (int ai = 0; ai < 2; ++ai)
#pragma unroll
            for (int m = 0; m < 4; ++m) { const int r = row0 + ai * HALF + m * 16;
#pragma unroll
                for (int bj = 0; bj < 2; ++bj) { const size_t off = (size_t)r * 1024 + col0 + bj * HALF;
                    const u32x4 gv = *(const u32x4*)(g + off);
                    f32x4 a0 = acc[ai][bj][m][0], a1 = acc[ai][bj][m][1];
                    a0[0] *= bf_lo(gv.x); a0[1] *= bf_hi(gv.x); a0[2] *= bf_lo(gv.y); a0[3] *= bf_hi(gv.y);
                    a1[0] *= bf_lo(gv.z); a1[1] *= bf_hi(gv.z); a1[2] *= bf_lo(gv.w); a1[3] *= bf_hi(gv.w);
                    if (!which) { u32x4 w; w.x = cvt_pk_bf16(a0[0], a0[1]); w.y = cvt_pk_bf16(a0[2], a0[3]); w.z = cvt_pk_bf16(a1[0], a1[1]); w.w = cvt_pk_bf16(a1[2], a1[3]); *(u32x4*)((bf16_t*)P + off) = w; }
                    else { const u32x4 pw = *(const u32x4*)((const bf16_t*)P + off);
                        a0[0] += bf_lo(pw.x); a0[1] += bf_hi(pw.x); a0[2] += bf_lo(pw.y); a0[3] += bf_hi(pw.y); a1[0] += bf_lo(pw.z); a1[1] += bf_hi(pw.z); a1[2] += bf_lo(pw.w); a1[3] += bf_hi(pw.w);
                        u32x4 w; w.x = cvt_pk_bf16(a0[0], a0[1]); w.y = cvt_pk_bf16(a0[2], a0[3]); w.z = cvt_pk_bf16(a1[0], a1[1]); w.w = cvt_pk_bf16(a1[2], a1[3]);
                        *(u32x4*)(merged + off) = w; } } }
    }
};
struct PairOrder {
    StaticOrder so;
    __host__ __device__ void init(int G_, int c_) { so.init(MTOK, 1024, G_, c_); }
    __host__ __device__ bool next(int i, Unit& u) const { Unit t; if (!so.next(i >> 1, t)) return false; const int w = i & 1; u.pm = t.pm + 64 * w; u.pn = t.pn + 4 * w; return true; }
    __device__ __forceinline__ void a_ready(const Unit&) const {}
    __device__ __forceinline__ void done(const Unit&) const {}
};

struct EpiWo {
    static constexpr bool PERM = true, AFTER_DRAIN = false;
    const float* x; bf16_t* x1b;
    __device__ __forceinline__ void operator()(const f32x4 (&acc)[2][2][4][2], const Unit& u, int wr, int wc, int fr, int fq) const {
        const int row0 = u.pm * BM + wr * 64 + fr, col0 = u.pn * BM + wc * 32 + 8 * fq;
#pragma unroll
        for (int ai = 0; ai < 2; ++ai)
#pragma unroll
            for (int m = 0; m < 4; ++m) { const int r = row0 + ai * HALF + m * 16;
#pragma unroll
                for (int bj = 0; bj < 2; ++bj) { const size_t off = (size_t)r * 1024 + col0 + bj * HALF;
                    const f32x4 a0 = acc[ai][bj][m][0] + *(const f32x4*)(x + off), a1 = acc[ai][bj][m][1] + *(const f32x4*)(x + off + 4);
                    u32x4 w; w.x = cvt_pk_bf16(a0[0], a0[1]); w.y = cvt_pk_bf16(a0[2], a0[3]); w.z = cvt_pk_bf16(a1[0], a1[1]); w.w = cvt_pk_bf16(a1[2], a1[3]);
                    *(u32x4*)(x1b + off) = w; } }
    }
};
typedef _Float16 f16x2_t __attribute__((ext_vector_type(2)));
typedef float f32x2e __attribute__((ext_vector_type(2)));
__device__ __forceinline__ unsigned pk_f16(float lo, float hi) { f32x2e v = {lo, hi}; f16x2_t h = __builtin_convertvector(v, f16x2_t); return __builtin_bit_cast(unsigned, h); }
struct EpiScores {
    static constexpr bool PERM = true, AFTER_DRAIN = false;
    unsigned short* S;
    __device__ __forceinline__ void operator()(const f32x4 (&acc)[2][2][4][2], const Unit& u, int wr, int wc, int fr, int fq) const {
        const int row0 = u.pm * BM + wr * 64 + fr, col0 = u.pn * BM + wc * 32 + 8 * fq;
#pragma unroll
        for (int ai = 0; ai < 2; ++ai)
#pragma unroll
            for (int m = 0; m < 4; ++m) { const int r = row0 + ai * HALF + m * 16;
#pragma unroll
                for (int bj = 0; bj < 2; ++bj) { const size_t off = ((size_t)((col0 + bj * HALF) >> 3) * MTOK + r) * 8;
                    const f32x4 a0 = acc[ai][bj][m][0], a1 = acc[ai][bj][m][1];
                    u32x4 w; w.x = pk_f16(a0[0], a0[1]); w.y = pk_f16(a0[2], a0[3]); w.z = pk_f16(a1[0], a1[1]); w.w = pk_f16(a1[2], a1[3]);
                    *(u32x4*)(S + off) = w; } }
    }
};
template <class Epi, class Sched, bool ALIGN_EPI = false, bool SP2 = false>
__device__ __forceinline__ void gemm_phase(PG8_LAS unsigned char* lds, const Gemm g, const Sched& S, const Epi& E) {
    const int tid = threadIdx.x, wid = __builtin_amdgcn_readfirstlane(tid >> 6), lane = tid & 63, wr = wid >> 2, wc = wid & 3, fr = lane & 15, fq = lane >> 4;
    const int K = g.K, nt = K / BK;
    unsigned voffA[2], voffB[2];
#pragma unroll
    for (int i = 0; i < 2; ++i) { int R, C; stage_rc(tid * 16 + i * 8192, R, C); const int Rb = Epi::PERM ? ((R & ~31) + perm32(R & 31)) : R;
        voffA[i] = (unsigned)(R * K + C) * 2u; voffB[i] = (unsigned)(Rb * K + C) * 2u; }
    const size_t kstep = (size_t)(BK * 2);
    const size_t hstep = (size_t)HALF * K * 2;
    const size_t tstep = 2 * hstep;
    const unsigned ldsw = (unsigned)wid * 1024u;
    const int aoff = lds_byte(wr * 64 + fr, fq * 8), boff = lds_byte(wc * 32 + fr, fq * 8);
#define PG8_SA(b, h) (((b) * 2 + (h)) * HTB)
#define PG8_SB(b, h) ((4 + (b) * 2 + (h)) * HTB)
#define PG8_STAGE(bufoff, gbase, voff) do { _Pragma("unroll") for (int _i = 0; _i < 2; ++_i) \
        __builtin_amdgcn_global_load_lds((const unsigned*)((const char*)(gbase) + (voff)[_i]), (PG8_LAS unsigned*)(lds + (bufoff) + ldsw + _i * 8192), 16, 0, 0); } while (0)
#define PG8_LDA(dst, b, h) do { _Pragma("unroll") for (int m = 0; m < 4; ++m) _Pragma("unroll") for (int k = 0; k < 2; ++k) dst[m][k] = *(const PG8_LAS bf16x8*)(lds + PG8_SA(b, h) + aoff + m * 2048 + k * 1024); } while (0)
#define PG8_LDB(dst, b, h) do { _Pragma("unroll") for (int n = 0; n < 2; ++n) _Pragma("unroll") for (int k = 0; k < 2; ++k) dst[n][k] = *(const PG8_LAS bf16x8*)(lds + PG8_SB(b, h) + boff + n * 2048 + k * 1024); } while (0)
#define PG8_MMA(ai, bj, At, Bt) do { __builtin_amdgcn_s_setprio(1); _Pragma("unroll") for (int m = 0; m < 4; ++m) _Pragma("unroll") for (int n = 0; n < 2; ++n) _Pragma("unroll") for (int k = 0; k < 2; ++k) \
        acc[ai][bj][m][n] = __builtin_amdgcn_mfma_f32_16x16x32_bf16(Bt[n][k], At[m][k], acc[ai][bj][m][n], 0, 0, 0); __builtin_amdgcn_s_setprio(0); } while (0)
#define PG8_WAIT_V(n) asm volatile("s_waitcnt vmcnt(" #n ")" ::: "memory")
#define PG8_WAIT_L(n) asm volatile("s_waitcnt lgkmcnt(" #n ")" ::: "memory")
#define PG8_BAR __builtin_amdgcn_s_barrier()
#define PG8_SCHED __builtin_amdgcn_sched_barrier(0)
    Unit cur, nxt; int ui = 0;
    if (!S.next(0, cur)) return;
    f32x4 acc[2][2][4][2];
#pragma unroll
    for (int a = 0; a < 2; ++a)
#pragma unroll
        for (int b = 0; b < 2; ++b)
#pragma unroll
            for (int m = 0; m < 4; ++m)
#pragma unroll
                for (int n = 0; n < 2; ++n) acc[a][b][m][n] = (f32x4){0.f, 0.f, 0.f, 0.f};
    bf16x8 At[4][2], B0[2][2], B1[2][2];
    const char* cA = (const char*)g.A + (size_t)cur.pm * tstep; const char* cB = (const char*)g.Bt + (size_t)cur.pn * tstep;
    S.a_ready(cur);
    if constexpr (SP2) {
        PG8_STAGE(PG8_SB(0, 0), cB, voffB); PG8_STAGE(PG8_SB(0, 1), cB + hstep, voffB); PG8_STAGE(PG8_SA(0, 0), cA, voffA); PG8_STAGE(PG8_SA(0, 1), cA + hstep, voffA);
        if (wr == 1) PG8_BAR;
        PG8_WAIT_V(2); PG8_BAR;
        PG8_STAGE(PG8_SB(1, 0), cB + kstep, voffB); PG8_STAGE(PG8_SA(1, 0), cA + kstep, voffA); PG8_STAGE(PG8_SB(1, 1), cB + hstep + kstep, voffB);
        PG8_WAIT_V(6); PG8_BAR;
    } else {
        PG8_STAGE(PG8_SB(0, 0), cB, voffB); PG8_STAGE(PG8_SA(0, 0), cA, voffA); PG8_STAGE(PG8_SB(0, 1), cB + hstep, voffB); PG8_STAGE(PG8_SA(0, 1), cA + hstep, voffA);
        if (wr == 1) PG8_BAR;
        PG8_WAIT_V(4); PG8_BAR;
        PG8_STAGE(PG8_SB(1, 0), cB + kstep, voffB); PG8_STAGE(PG8_SA(1, 0), cA + kstep, voffA); PG8_STAGE(PG8_SB(1, 1), cB + hstep + kstep, voffB);
        PG8_WAIT_V(6); PG8_BAR;
    }
    for (;;) {
        const bool has_next = S.next(ui + 1, nxt);
        const char* nA = has_next ? (const char*)g.A + (size_t)nxt.pm * tstep : cA; const char* nB = has_next ? (const char*)g.Bt + (size_t)nxt.pn * tstep : cB;
        for (int t = 0; t < nt; t += 2) {
            const bool last = (t == nt - 2);
            const char* a1 = cA + (size_t)(t + 1) * kstep;
            const char* a2 = last ? nA : cA + (size_t)(t + 2) * kstep; const char* b2 = last ? nB : cB + (size_t)(t + 2) * kstep;
            const char* a3 = a2 + kstep; const char* b3 = b2 + kstep;
            if (last && has_next) S.a_ready(nxt);
            if constexpr (SP2) {
            PG8_LDB(B0, 0, 0); PG8_LDB(B1, 0, 1); PG8_SCHED; PG8_LDA(At, 0, 0); PG8_STAGE(PG8_SA(1, 1), a1 + hstep, voffA);
            PG8_WAIT_V(8); PG8_WAIT_L(0); PG8_BAR; PG8_MMA(0, 0, At, B0); PG8_MMA(0, 1, At, B1); PG8_BAR; PG8_SCHED;
            PG8_LDA(At, 0, 1); PG8_STAGE(PG8_SB(0, 0), b2, voffB); PG8_STAGE(PG8_SB(0, 1), b2 + hstep, voffB); PG8_STAGE(PG8_SA(0, 0), a2, voffA);
            PG8_WAIT_V(8); PG8_WAIT_L(0); PG8_BAR; PG8_MMA(1, 0, At, B0); PG8_MMA(1, 1, At, B1); PG8_BAR; PG8_SCHED;
            PG8_LDB(B0, 1, 0); PG8_LDB(B1, 1, 1); PG8_SCHED; PG8_LDA(At, 1, 0); PG8_STAGE(PG8_SA(0, 1), a2 + hstep, voffA);
            PG8_WAIT_V(8); PG8_WAIT_L(0); PG8_BAR; PG8_MMA(0, 0, At, B0); PG8_MMA(0, 1, At, B1); PG8_BAR; PG8_SCHED;
            PG8_LDA(At, 1, 1); PG8_STAGE(PG8_SB(1, 0), b3, voffB); PG8_STAGE(PG8_SB(1, 1), b3 + hstep, voffB); PG8_STAGE(PG8_SA(1, 0), a3, voffA);
            PG8_WAIT_V(8); PG8_WAIT_L(0); PG8_BAR; PG8_MMA(1, 0, At, B0); PG8_MMA(1, 1, At, B1); PG8_BAR; PG8_SCHED;
            } else {
            PG8_LDB(B0, 0, 0); PG8_SCHED; PG8_LDA(At, 0, 0); PG8_STAGE(PG8_SA(1, 1), a1 + hstep, voffA);
            PG8_WAIT_L(8); PG8_BAR; PG8_WAIT_L(0); PG8_MMA(0, 0, At, B0); PG8_BAR; PG8_SCHED;
            PG8_LDB(B1, 0, 1); PG8_STAGE(PG8_SB(0, 0), b2, voffB);
            PG8_BAR; PG8_WAIT_L(0); PG8_MMA(0, 1, At, B1); PG8_BAR;
            PG8_LDA(At, 0, 1); PG8_STAGE(PG8_SA(0, 0), a2, voffA);
            PG8_BAR; PG8_WAIT_L(0); PG8_MMA(1, 0, At, B0); PG8_BAR; PG8_SCHED;
            PG8_STAGE(PG8_SB(0, 1), b2 + hstep, voffB);
            PG8_WAIT_V(6); PG8_BAR; PG8_MMA(1, 1, At, B1); PG8_BAR;
            PG8_LDB(B0, 1, 0); PG8_SCHED; PG8_LDA(At, 1, 0); PG8_STAGE(PG8_SA(0, 1), a2 + hstep, voffA);
            PG8_WAIT_L(8); PG8_BAR; PG8_WAIT_L(0); PG8_MMA(0, 0, At, B0); PG8_BAR; PG8_SCHED;
            PG8_LDB(B1, 1, 1); PG8_STAGE(PG8_SB(1, 0), b3, voffB);
            PG8_BAR; PG8_WAIT_L(0); PG8_MMA(0, 1, At, B1); PG8_BAR;
            PG8_LDA(At, 1, 1); PG8_STAGE(PG8_SA(1, 0), a3, voffA);
            PG8_BAR; PG8_WAIT_L(0); PG8_MMA(1, 0, At, B0); PG8_BAR; PG8_SCHED;
            PG8_STAGE(PG8_SB(1, 1), b3 + hstep, voffB);
            PG8_WAIT_V(6); PG8_BAR; PG8_MMA(1, 1, At, B1); PG8_BAR;
            }
        }
        if constexpr (ALIGN_EPI) { if (wr == 0) PG8_BAR; }
        if constexpr (!Epi::AFTER_DRAIN) { E(acc, cur, wr, wc, fr, fq); S.done(cur); }
        if (!has_next) break;
#pragma unroll
        for (int a = 0; a < 2; ++a)
#pragma unroll
            for (int b = 0; b < 2; ++b)
#pragma unroll
                for (int m = 0; m < 4; ++m)
#pragma unroll
                    for (int n = 0; n < 2; ++n) acc[a][b][m][n] = (f32x4){0.f, 0.f, 0.f, 0.f};
        cur = nxt; cA = nA; cB = nB; ++ui;
        if constexpr (ALIGN_EPI) { if (wr == 1) PG8_BAR; }
    }
    PG8_WAIT_V(0);
    if constexpr (!ALIGN_EPI) { if (wr == 0) PG8_BAR; }
    PG8_BAR;
    if constexpr (Epi::AFTER_DRAIN) { E.fused(acc, cur, wr, wc, fr, fq, lds, wid, lane); S.done(cur); }
#undef PG8_SA
#undef PG8_SB
#undef PG8_STAGE
#undef PG8_LDA
#undef PG8_LDB
#undef PG8_MMA
#undef PG8_WAIT_V
#undef PG8_WAIT_L
#undef PG8_BAR
#undef PG8_SCHED
}
}

constexpr int NWAVES = 8;
constexpr int BATCH = 4, T = 4096, D = 1024, NH = 8, HD = 64, NIN = 5120;
constexpr int M = BATCH * T;
constexpr int NEXP = 16384;
constexpr float RMS_EPS = 1e-6f;
#ifndef MK_N_LAUNCHES
#define MK_N_LAUNCHES 1
#endif
constexpr int N_PHASES = 11;
constexpr int N_LAUNCHES = MK_N_LAUNCHES;

constexpr size_t MiB = 1u << 20;
constexpr size_t WS_CTL = 0, CTL_ZERO_BYTES = 64 * 1024;
constexpr size_t WS_RSTD1 = 512 * 1024;
constexpr size_t WS_WEFF = 1 * MiB;
constexpr size_t WS_WAB = 5 * MiB;
constexpr size_t WS_WO = 7 * MiB;
constexpr size_t WS_WIN = 9 * MiB;
constexpr size_t WS_XB = 19 * MiB;
constexpr size_t WS_SIX = 51 * MiB;
constexpr size_t WS_VT = WS_SIX + 3 * 16 * MiB;
constexpr size_t WS_GATE = 147 * MiB;
constexpr size_t WS_MERGED = 19 * MiB;
constexpr size_t WS_X1B = 51 * MiB;
constexpr size_t WS_TU = 211 * MiB, WS_TV = 227 * MiB;
constexpr size_t WS_SU = 576 * 1024, WS_SV = 640 * 1024;
constexpr size_t WS_SCORES = 83 * MiB;
constexpr size_t WS_ROUTE = 19 * MiB;
constexpr size_t WS_W = 35 * MiB;
constexpr size_t WS_SS = 43 * MiB;
constexpr size_t WS_UPART = 83 * MiB;
constexpr size_t WS_END = 256 * MiB;
constexpr int CW_BAR = 4096;

constexpr int RING_OFF = 0, RING_BYTES = 131072;
constexpr int LDSCTL_OFF = RING_BYTES;
constexpr int LDS_BYTES = 147456;
constexpr int MISC_OFF = LDS_BYTES - 128;

#define GAS __attribute__((address_space(1)))
#define LAS __attribute__((address_space(3)))
#define CAS __attribute__((address_space(4)))
typedef unsigned short bf16;
typedef unsigned v4u __attribute__((ext_vector_type(4)));
typedef unsigned v2u __attribute__((ext_vector_type(2)));
typedef float f32x4 __attribute__((ext_vector_type(4)));
typedef float f32x2 __attribute__((ext_vector_type(2)));
typedef float f32x16 __attribute__((ext_vector_type(16)));
typedef short bf16x8 __attribute__((ext_vector_type(8)));
typedef _Float16 f16x8 __attribute__((ext_vector_type(8)));
typedef _Float16 f16x2 __attribute__((ext_vector_type(2)));
typedef __bf16 bf16x2_t __attribute__((ext_vector_type(2)));
typedef GAS unsigned gu32;
#define RLX_AGENT __ATOMIC_RELAXED, __HIP_MEMORY_SCOPE_AGENT
#define LDS_WAIT() asm volatile("s_waitcnt lgkmcnt(0)" ::: "memory")
#define VM_WAIT() asm volatile("s_waitcnt vmcnt(0)" ::: "memory")
__device__ __forceinline__ unsigned f2bf(float f) { unsigned u = __builtin_bit_cast(unsigned, f); return (u + 0x7fffu + ((u >> 16) & 1u)) >> 16; }
__device__ __forceinline__ unsigned pk2(float lo, float hi) { return f2bf(lo) | (f2bf(hi) << 16); }
__device__ __forceinline__ unsigned cvtpk(float lo, float hi) { f32x2 v = {lo, hi}; bf16x2_t b = __builtin_convertvector(v, bf16x2_t); return __builtin_bit_cast(unsigned, b); }
__device__ __forceinline__ float bflo(unsigned w) { return __builtin_bit_cast(float, w << 16); }
__device__ __forceinline__ float bfhi(unsigned w) { return __builtin_bit_cast(float, w & 0xffff0000u); }
__device__ __forceinline__ float wave_sum(float v) {
#pragma unroll
    for (int o = 1; o < 64; o <<= 1) v += __shfl_xor(v, o);
    return v;
}
#define XB_TMO      128
#define XB_XCNT(j)  (256  + 64 * (j))
#define XB_XSUB(j)  (1280 + 64 * (j))
#define XB_XGEN(j)  (2304 + 64 * (j))
#define XB_TOP      3328
#define XB_TOPGEN   3392
#define XCD_BAR_WORDS 3456
#define XB_SPIN_CAP (1u << 18)

__device__ __forceinline__ unsigned xb_ld(unsigned* p)              { return __hip_atomic_load(p, __ATOMIC_RELAXED, __HIP_MEMORY_SCOPE_AGENT); }
__device__ __forceinline__ unsigned xb_add(unsigned* p, unsigned v) { return __hip_atomic_fetch_add(p, v, __ATOMIC_RELAXED, __HIP_MEMORY_SCOPE_AGENT); }
__device__ __forceinline__ unsigned xb_xcc_id() { return (unsigned)__builtin_amdgcn_s_getreg((3 << 11) | 20) & 0xFu; }
#define XB_SPIN(cond, bar) do { unsigned _sp = 0; while (cond) { __builtin_amdgcn_s_sleep(1); \
    if ((++_sp & 255u) == 0u) { if (xb_ld(&(bar)[XB_TMO])) break; if (_sp > XB_SPIN_CAP) { atomicAdd(&(bar)[XB_TMO], 1u); break; } } } } while (0)

struct XcdBarrier {
    unsigned* bar; unsigned x;
    volatile LAS unsigned* st;
};

__device__ __forceinline__ XcdBarrier xcd_barrier_post(unsigned* bar, volatile LAS unsigned* st) {
    XcdBarrier b; b.bar = bar; b.x = xb_xcc_id(); b.st = st;
    if (threadIdx.x == 0) (void)xb_add(&bar[XB_XCNT(b.x)], 1u);
    return b;
}
__device__ __forceinline__ void xcd_barrier_complete(unsigned* bar, unsigned x, unsigned& nloc, unsigned& nx) {
    const unsigned G = gridDim.x * gridDim.y * gridDim.z;
    unsigned sum, cnt, mine, sp = 0u;
    for (;;) {
        sum = 0u; cnt = 0u; mine = 0u;
#pragma unroll
        for (unsigned j = 0; j < 16; ++j) { const unsigned c = xb_ld(&bar[XB_XCNT(j)]); sum += c; cnt += (c > 0u) ? 1u : 0u; mine = (j == x) ? c : mine; }
        if (sum == G) break;
        __builtin_amdgcn_s_sleep(1);
        if ((++sp & 255u) == 0u) { if (xb_ld(&bar[XB_TMO])) break; if (sp > XB_SPIN_CAP) { atomicAdd(&bar[XB_TMO], 1u); break; } }
    }
    nloc = mine > 0u ? mine : 1u; nx = cnt > 0u ? cnt : 1u;
}

__device__ __forceinline__ void xcd_barrier(const XcdBarrier& b) {
    asm volatile("s_waitcnt vmcnt(0)" ::: "memory");
    __syncthreads();
    if (threadIdx.x == 0) {
        unsigned* bar = b.bar;
        __builtin_amdgcn_s_waitcnt(0);
        unsigned nloc = b.st[0], nx = b.st[1];
        if (nloc == 0u) { xcd_barrier_complete(bar, b.x, nloc, nx); b.st[0] = nloc; b.st[1] = nx; }
        const unsigned old = xb_add(&bar[XB_XSUB(b.x)], 1u);
        const unsigned gen = old / nloc;
        if (old + 1u == (gen + 1u) * nloc) {
            __builtin_amdgcn_fence(__ATOMIC_RELEASE, "agent");
            asm volatile("s_waitcnt vmcnt(0)" ::: "memory");
            const unsigned og = xb_add(&bar[XB_TOP], 1u);
            const unsigned tg = og / nx;
            if (og + 1u == (tg + 1u) * nx) xb_add(&bar[XB_TOPGEN], 1u);
            else XB_SPIN(xb_ld(&bar[XB_TOPGEN]) == tg, bar);
            __builtin_amdgcn_fence(__ATOMIC_ACQUIRE, "agent");
            xb_add(&bar[XB_XGEN(b.x)], 1u);
            asm volatile("s_waitcnt vmcnt(0)" ::: "memory");
        } else {
            XB_SPIN(xb_ld(&bar[XB_XGEN(b.x)]) == gen, bar);
            __builtin_amdgcn_fence(__ATOMIC_ACQUIRE, "agent");
            asm volatile("s_waitcnt vmcnt(0)" ::: "memory");
        }
    }
    __syncthreads();
}

__device__ __forceinline__ void p0_transpose_item(const float* W, int K, int N, bf16* WT, int row_off, const float* kscale, LAS float* scr, int item, int lane) {
    const int nblk = N / 32, kb = item / nblk, nb = item % nblk, k0 = 64 * kb, n0 = 32 * nb;
#pragma unroll 8
    for (int i = 0; i < 32; ++i) { const int kk = 2 * i + (lane >> 5); scr[kk * 33 + (lane & 31)] = W[(size_t)(k0 + kk) * N + n0 + (lane & 31)]; }
    LDS_WAIT(); asm volatile("" ::: "memory");
    const int c = lane & 7;
    float ks[8];
#pragma unroll
    for (int i = 0; i < 8; ++i) ks[i] = kscale ? kscale[k0 + 8 * c + i] : 1.0f;
#pragma unroll
    for (int j = 0; j < 4; ++j) { const int n = (lane >> 3) + 8 * j; const LAS float* s = scr + (8 * c) * 33 + n;
        v4u o; o.x = pk2(s[0 * 33] * ks[0], s[1 * 33] * ks[1]); o.y = pk2(s[2 * 33] * ks[2], s[3 * 33] * ks[3]); o.z = pk2(s[4 * 33] * ks[4], s[5 * 33] * ks[5]); o.w = pk2(s[6 * 33] * ks[6], s[7 * 33] * ks[7]);
        *(GAS v4u*)(WT + (size_t)(row_off + n0 + n) * K + k0 + 8 * c) = o; }
    LDS_WAIT(); asm volatile("" ::: "memory");
}

__device__ __forceinline__ void conv_phase(const bf16* CB, const bf16* CC, const bf16* CU, bf16* CO, const float* cw, const float* cbias, int gtid, int nthreads) {
    for (int task = gtid; task < M * 64; task += nthreads) {
        const int tok = task >> 6, c8 = (task & 63) * 8, tt = tok & (T - 1);
        const size_t off = (size_t)tok * 512 + c8;
        float z[3][8];
#pragma unroll
        for (int k = 0; k < 3; ++k) {
            const int dt = 2 - k;
            if (tt >= dt) { const v4u a = *(const GAS v4u*)(CC + off - (size_t)dt * 512), b = *(const GAS v4u*)(CU + off - (size_t)dt * 512);
                z[k][0] = bflo(a.x) * bflo(b.x); z[k][1] = bfhi(a.x) * bfhi(b.x); z[k][2] = bflo(a.y) * bflo(b.y); z[k][3] = bfhi(a.y) * bfhi(b.y);
                z[k][4] = bflo(a.z) * bflo(b.z); z[k][5] = bfhi(a.z) * bfhi(b.z); z[k][6] = bflo(a.w) * bflo(b.w); z[k][7] = bfhi(a.w) * bfhi(b.w); }
            else {
#pragma unroll
                for (int i = 0; i < 8; ++i) z[k][i] = 0.f; }
        }
        float y[8];
#pragma unroll
        for (int i = 0; i < 8; ++i) y[i] = cbias[c8 + i];
#pragma unroll
        for (int k = 0; k < 3; ++k)
#pragma unroll
            for (int i = 0; i < 8; ++i) y[i] += cw[k * 512 + c8 + i] * z[k][i];
        const v4u g = *(const GAS v4u*)(CB + off);
        v4u o; o.x = pk2(bflo(g.x) * y[0], bfhi(g.x) * y[1]); o.y = pk2(bflo(g.y) * y[2], bfhi(g.y) * y[3]); o.z = pk2(bflo(g.z) * y[4], bfhi(g.z) * y[5]); o.w = pk2(bflo(g.w) * y[6], bfhi(g.w) * y[7]);
        *(GAS v4u*)(CO + off) = o;
    }
}

__device__ __forceinline__ int crow(int r, int hf) { return (r & 3) + 8 * (r >> 2) + 4 * hf; }
#define MFMA_BF16(a, b, c) __builtin_amdgcn_mfma_f32_32x32x16_bf16((a), (b), (c), 0, 0, 0)
#define MFMA_F16(a, b, c) __builtin_amdgcn_mfma_f32_32x32x16_f16((a), (b), (c), 0, 0, 0)
__device__ __forceinline__ void attn_item(const bf16* Qb, const bf16* Kb, const bf16* VT, bf16* Ob, int b, int h, int qblk, int lane) {
    const int t32 = lane & 31, hf = lane >> 5, q0 = qblk * 32, tq = q0 + t32;
    const size_t rowbase = (size_t)b * T;
    const float LOG2E = 1.4426950408889634f, LN2 = 0.6931471805599453f;
    bf16x8 qf[4];
    { const bf16* qp = Qb + (rowbase + q0 + t32) * 512 + h * 64 + 8 * hf;
#pragma unroll
      for (int st = 0; st < 4; ++st) qf[st] = *(const GAS bf16x8*)(qp + 16 * st); }
    f16x8 tri[2];
#pragma unroll
    for (int st = 0; st < 2; ++st)
#pragma unroll
        for (int e = 0; e < 8; ++e) { const int j = 16 * st + 8 * (e >> 2) + 4 * hf + (e & 3); tri[st][e] = (j >= t32) ? (_Float16)1.0f : (_Float16)0.0f; }
    f32x16 o0, o1;
#pragma unroll
    for (int r = 0; r < 16; ++r) { o0[r] = 0.f; o1[r] = 0.f; }
    float R = 0.f;
    const bf16* kbase = Kb + rowbase * 512 + h * 64 + 8 * hf;
    const bf16* vtb = VT + ((size_t)(b * 8 + h) * 64 + t32) * T + 4 * hf;
    for (int jt = q0 >> 6; jt >= 0; --jt) {
        const int k0 = jt * 64;
        f32x16 s0, s1;
#pragma unroll
        for (int r = 0; r < 16; ++r) { s0[r] = 0.f; s1[r] = 0.f; }
#pragma unroll
        for (int st = 0; st < 4; ++st) {
            const bf16x8 a0 = *(const GAS bf16x8*)(kbase + (size_t)(k0 + t32) * 512 + 16 * st);
            const bf16x8 a1 = *(const GAS bf16x8*)(kbase + (size_t)(k0 + 32 + t32) * 512 + 16 * st);
            s0 = MFMA_BF16(a0, qf[st], s0); s1 = MFMA_BF16(a1, qf[st], s1);
        }
        f32x16 L0, L1; float tot0 = 0.f, tot1 = 0.f;
#pragma unroll
        for (int r = 0; r < 16; ++r) {
            const int key = k0 + crow(r, hf);
            { const float z = s0[r]; const float e = __builtin_amdgcn_exp2f(-__builtin_fabsf(z) * LOG2E); const float lp = __builtin_amdgcn_logf(1.0f + e) * LN2;
              const float L = (key < tq) ? -(__builtin_fmaxf(z, 0.f) + lp) : 0.f; L0[r] = L; tot0 += L; }
            { const float z = s1[r]; const float e = __builtin_amdgcn_exp2f(-__builtin_fabsf(z) * LOG2E); const float lp = __builtin_amdgcn_logf(1.0f + e) * LN2;
              const float L = (key + 32 < tq) ? -(__builtin_fmaxf(z, 0.f) + lp) : 0.f; L1[r] = L; tot1 += L; }
        }
        tot0 += __shfl_xor(tot0, 32); tot1 += __shfl_xor(tot1, 32);
        f16x8 lf00, lf01, lf10, lf11;
#pragma unroll
        for (int e = 0; e < 8; ++e) { lf00[e] = (_Float16)L0[e]; lf01[e] = (_Float16)L0[8 + e]; lf10[e] = (_Float16)L1[e]; lf11[e] = (_Float16)L1[8 + e]; }
        f32x16 y0, y1;
#pragma unroll
        for (int r = 0; r < 16; ++r) { y0[r] = 0.f; y1[r] = 0.f; }
        y0 = MFMA_F16(tri[0], lf00, y0); y0 = MFMA_F16(tri[1], lf01, y0);
        y1 = MFMA_F16(tri[0], lf10, y1); y1 = MFMA_F16(tri[1], lf11, y1);
        const float base0 = R + tot1, base1 = R;
        float a0v[16], a1v[16];
#pragma unroll
        for (int r = 0; r < 16; ++r) {
            const int key = k0 + crow(r, hf);
            a0v[r] = (key < tq) ? __builtin_amdgcn_exp2f((s0[r] + y0[r] + base0) * LOG2E) : 0.f;
            a1v[r] = (key + 32 < tq) ? __builtin_amdgcn_exp2f((s1[r] + y1[r] + base1) * LOG2E) : 0.f;
        }
        bf16x8 pf[2][2];
#pragma unroll
        for (int st = 0; st < 2; ++st) {
            v4u w0, w1;
            w0.x = cvtpk(a0v[8 * st + 0], a0v[8 * st + 1]); w0.y = cvtpk(a0v[8 * st + 2], a0v[8 * st + 3]); w0.z = cvtpk(a0v[8 * st + 4], a0v[8 * st + 5]); w0.w = cvtpk(a0v[8 * st + 6], a0v[8 * st + 7]);
            w1.x = cvtpk(a1v[8 * st + 0], a1v[8 * st + 1]); w1.y = cvtpk(a1v[8 * st + 2], a1v[8 * st + 3]); w1.z = cvtpk(a1v[8 * st + 4], a1v[8 * st + 5]); w1.w = cvtpk(a1v[8 * st + 6], a1v[8 * st + 7]);
            pf[0][st] = __builtin_bit_cast(bf16x8, w0); pf[1][st] = __builtin_bit_cast(bf16x8, w1);
        }
#pragma unroll
        for (int kb = 0; kb < 2; ++kb)
#pragma unroll
            for (int st = 0; st < 2; ++st) {
                const int kk = k0 + 32 * kb + 16 * st;
                { const v2u lo = *(const GAS v2u*)(vtb + kk), hi = *(const GAS v2u*)(vtb + kk + 8); v4u w; w.x = lo.x; w.y = lo.y; w.z = hi.x; w.w = hi.y;
                  o0 = MFMA_BF16(__builtin_bit_cast(bf16x8, w), pf[kb][st], o0); }
                { const v2u lo = *(const GAS v2u*)(vtb + (size_t)32 * T + kk), hi = *(const GAS v2u*)(vtb + (size_t)32 * T + kk + 8); v4u w; w.x = lo.x; w.y = lo.y; w.z = hi.x; w.w = hi.y;
                  o1 = MFMA_BF16(__builtin_bit_cast(bf16x8, w), pf[kb][st], o1); }
            }
        R += tot0 + tot1;
        if (__all(R < -104.0f)) break;
    }
    bf16* op = Ob + (rowbase + q0 + t32) * 512 + h * 64 + 4 * hf;
#pragma unroll
    for (int q4 = 0; q4 < 4; ++q4) {
        v2u w; w.x = cvtpk(o0[4 * q4], o0[4 * q4 + 1]); w.y = cvtpk(o0[4 * q4 + 2], o0[4 * q4 + 3]); *(GAS v2u*)(op + 8 * q4) = w;
        v2u w2; w2.x = cvtpk(o1[4 * q4], o1[4 * q4 + 1]); w2.y = cvtpk(o1[4 * q4 + 2], o1[4 * q4 + 3]); *(GAS v2u*)(op + 32 + 8 * q4) = w2;
    }
}

#define RT_C8(op_str, cnt, x0, x1, x2, x3, x4, x5, x6, x7, thr) asm volatile(op_str : "+v"(cnt) : "v"(x0), "v"(x1), "v"(x2), "v"(x3), "v"(x4), "v"(x5), "v"(x6), "v"(x7), "v"(thr) : "vcc")
#define RT_GE8 "v_cmp_ge_f32 vcc, %1, %9\n\tv_addc_co_u32_e32 %0, vcc, 0, %0, vcc\n\tv_cmp_ge_f32 vcc, %2, %9\n\tv_addc_co_u32_e32 %0, vcc, 0, %0, vcc\n\tv_cmp_ge_f32 vcc, %3, %9\n\tv_addc_co_u32_e32 %0, vcc, 0, %0, vcc\n\tv_cmp_ge_f32 vcc, %4, %9\n\tv_addc_co_u32_e32 %0, vcc, 0, %0, vcc\n\tv_cmp_ge_f32 vcc, %5, %9\n\tv_addc_co_u32_e32 %0, vcc, 0, %0, vcc\n\tv_cmp_ge_f32 vcc, %6, %9\n\tv_addc_co_u32_e32 %0, vcc, 0, %0, vcc\n\tv_cmp_ge_f32 vcc, %7, %9\n\tv_addc_co_u32_e32 %0, vcc, 0, %0, vcc\n\tv_cmp_ge_f32 vcc, %8, %9\n\tv_addc_co_u32_e32 %0, vcc, 0, %0, vcc"
#define RT_GT8 "v_cmp_gt_f32 vcc, %1, %9\n\tv_addc_co_u32_e32 %0, vcc, 0, %0, vcc\n\tv_cmp_gt_f32 vcc, %2, %9\n\tv_addc_co_u32_e32 %0, vcc, 0, %0, vcc\n\tv_cmp_gt_f32 vcc, %3, %9\n\tv_addc_co_u32_e32 %0, vcc, 0, %0, vcc\n\tv_cmp_gt_f32 vcc, %4, %9\n\tv_addc_co_u32_e32 %0, vcc, 0, %0, vcc\n\tv_cmp_gt_f32 vcc, %5, %9\n\tv_addc_co_u32_e32 %0, vcc, 0, %0, vcc\n\tv_cmp_gt_f32 vcc, %6, %9\n\tv_addc_co_u32_e32 %0, vcc, 0, %0, vcc\n\tv_cmp_gt_f32 vcc, %7, %9\n\tv_addc_co_u32_e32 %0, vcc, 0, %0, vcc\n\tv_cmp_gt_f32 vcc, %8, %9\n\tv_addc_co_u32_e32 %0, vcc, 0, %0, vcc"
#define RT_COUNT128(OPS, cnt, thr) do { cnt = 0; RT_C8(OPS, cnt, v[0], v[1], v[2], v[3], v[4], v[5], v[6], v[7], thr); RT_C8(OPS, cnt, v[8], v[9], v[10], v[11], v[12], v[13], v[14], v[15], thr); RT_C8(OPS, cnt, v[16], v[17], v[18], v[19], v[20], v[21], v[22], v[23], thr); RT_C8(OPS, cnt, v[24], v[25], v[26], v[27], v[28], v[29], v[30], v[31], thr); RT_C8(OPS, cnt, v[32], v[33], v[34], v[35], v[36], v[37], v[38], v[39], thr); RT_C8(OPS, cnt, v[40], v[41], v[42], v[43], v[44], v[45], v[46], v[47], thr); RT_C8(OPS, cnt, v[48], v[49], v[50], v[51], v[52], v[53], v[54], v[55], thr); RT_C8(OPS, cnt, v[56], v[57], v[58], v[59], v[60], v[61], v[62], v[63], thr); RT_C8(OPS, cnt, v[64], v[65], v[66], v[67], v[68], v[69], v[70], v[71], thr); RT_C8(OPS, cnt, v[72], v[73], v[74], v[75], v[76], v[77], v[78], v[79], thr); RT_C8(OPS, cnt, v[80], v[81], v[82], v[83], v[84], v[85], v[86], v[87], thr); RT_C8(OPS, cnt, v[88], v[89], v[90], v[91], v[92], v[93], v[94], v[95], thr); RT_C8(OPS, cnt, v[96], v[97], v[98], v[99], v[100], v[101], v[102], v[103], thr); RT_C8(OPS, cnt, v[104], v[105], v[106], v[107], v[108], v[109], v[110], v[111], thr); RT_C8(OPS, cnt, v[112], v[113], v[114], v[115], v[116], v[117], v[118], v[119], thr); RT_C8(OPS, cnt, v[120], v[121], v[122], v[123], v[124], v[125], v[126], v[127], thr); } while (0)
#define RT_S5(op_str, cnt, a0, a1, a2, a3, a4, b0, b1, b2, b3, b4, thr) do { float t_; asm volatile(op_str : "+v"(cnt), "=&v"(t_) : "v"(a0), "v"(a1), "v"(a2), "v"(a3), "v"(a4), "v"(b0), "v"(b1), "v"(b2), "v"(b3), "v"(b4), "v"(thr) : "vcc"); } while (0)
#define RT_SGE5 "v_add_f32_e32 %1, %2, %7\n\tv_cmp_ge_f32 vcc, %1, %12\n\tv_addc_co_u32_e32 %0, vcc, 0, %0, vcc\n\tv_add_f32_e32 %1, %3, %8\n\tv_cmp_ge_f32 vcc, %1, %12\n\tv_addc_co_u32_e32 %0, vcc, 0, %0, vcc\n\tv_add_f32_e32 %1, %4, %9\n\tv_cmp_ge_f32 vcc, %1, %12\n\tv_addc_co_u32_e32 %0, vcc, 0, %0, vcc\n\tv_add_f32_e32 %1, %5, %10\n\tv_cmp_ge_f32 vcc, %1, %12\n\tv_addc_co_u32_e32 %0, vcc, 0, %0, vcc\n\tv_add_f32_e32 %1, %6, %11\n\tv_cmp_ge_f32 vcc, %1, %12\n\tv_addc_co_u32_e32 %0, vcc, 0, %0, vcc"
#define RT_SGT5 "v_add_f32_e32 %1, %2, %7\n\tv_cmp_gt_f32 vcc, %1, %12\n\tv_addc_co_u32_e32 %0, vcc, 0, %0, vcc\n\tv_add_f32_e32 %1, %3, %8\n\tv_cmp_gt_f32 vcc, %1, %12\n\tv_addc_co_u32_e32 %0, vcc, 0, %0, vcc\n\tv_add_f32_e32 %1, %4, %9\n\tv_cmp_gt_f32 vcc, %1, %12\n\tv_addc_co_u32_e32 %0, vcc, 0, %0, vcc\n\tv_add_f32_e32 %1, %5, %10\n\tv_cmp_gt_f32 vcc, %1, %12\n\tv_addc_co_u32_e32 %0, vcc, 0, %0, vcc\n\tv_add_f32_e32 %1, %6, %11\n\tv_cmp_gt_f32 vcc, %1, %12\n\tv_addc_co_u32_e32 %0, vcc, 0, %0, vcc"
#define RT_COUNT50(OPS, cnt, thr) do { cnt = 0; RT_S5(OPS, cnt, a[0], a[0], a[0], a[0], a[0], b[0], b[1], b[2], b[3], b[4], thr); RT_S5(OPS, cnt, a[0], a[0], a[0], a[0], a[0], b[5], b[6], b[7], b[8], b[9], thr); RT_S5(OPS, cnt, a[0], a[0], a[0], a[0], a[0], b[10], b[11], b[12], b[13], b[14], thr); RT_S5(OPS, cnt, a[0], a[1], a[1], a[1], a[1], b[15], b[0], b[1], b[2], b[3], thr); RT_S5(OPS, cnt, a[1], a[1], a[1], a[1], a[2], b[4], b[5], b[6], b[7], b[0], thr); RT_S5(OPS, cnt, a[2], a[2], a[2], a[2], a[3], b[1], b[2], b[3], b[4], b[0], thr); RT_S5(OPS, cnt, a[3], a[3], a[3], a[4], a[4], b[1], b[2], b[3], b[0], b[1], thr); RT_S5(OPS, cnt, a[4], a[5], a[5], a[6], a[6], b[2], b[0], b[1], b[0], b[1], thr); RT_S5(OPS, cnt, a[7], a[7], a[8], a[9], a[10], b[0], b[1], b[0], b[0], b[0], thr); RT_S5(OPS, cnt, a[11], a[12], a[13], a[14], a[15], b[0], b[0], b[0], b[0], b[0], thr); } while (0)
#define RT_CSWAP(x, xi, p, q) do { float t_; asm volatile("v_cmp_gt_f32 vcc, %1, %0\n\tv_cndmask_b32_e32 %4, %0, %1, vcc\n\tv_cndmask_b32_e32 %1, %1, %0, vcc\n\tv_mov_b32_e32 %0, %4\n\tv_cndmask_b32_e32 %4, %2, %3, vcc\n\tv_cndmask_b32_e32 %3, %3, %2, vcc\n\tv_mov_b32_e32 %2, %4" : "+v"(x[p]), "+v"(x[q]), "+v"(xi[p]), "+v"(xi[q]), "=&v"(t_) : : "vcc"); } while (0)
#define RT_SORT16(x, xi) do { RT_CSWAP(x, xi, 0, 1); RT_CSWAP(x, xi, 2, 3); RT_CSWAP(x, xi, 0, 2); RT_CSWAP(x, xi, 1, 3); RT_CSWAP(x, xi, 1, 2); RT_CSWAP(x, xi, 4, 5); RT_CSWAP(x, xi, 6, 7); RT_CSWAP(x, xi, 4, 6); RT_CSWAP(x, xi, 5, 7); RT_CSWAP(x, xi, 5, 6); RT_CSWAP(x, xi, 0, 4); RT_CSWAP(x, xi, 2, 6); RT_CSWAP(x, xi, 2, 4); RT_CSWAP(x, xi, 1, 5); RT_CSWAP(x, xi, 3, 7); RT_CSWAP(x, xi, 3, 5); RT_CSWAP(x, xi, 1, 2); RT_CSWAP(x, xi, 3, 4); RT_CSWAP(x, xi, 5, 6); RT_CSWAP(x, xi, 8, 9); RT_CSWAP(x, xi, 10, 11); RT_CSWAP(x, xi, 8, 10); RT_CSWAP(x, xi, 9, 11); RT_CSWAP(x, xi, 9, 10); RT_CSWAP(x, xi, 12, 13); RT_CSWAP(x, xi, 14, 15); RT_CSWAP(x, xi, 12, 14); RT_CSWAP(x, xi, 13, 15); RT_CSWAP(x, xi, 13, 14); RT_CSWAP(x, xi, 8, 12); RT_CSWAP(x, xi, 10, 14); RT_CSWAP(x, xi, 10, 12); RT_CSWAP(x, xi, 9, 13); RT_CSWAP(x, xi, 11, 15); RT_CSWAP(x, xi, 11, 13); RT_CSWAP(x, xi, 9, 10); RT_CSWAP(x, xi, 11, 12); RT_CSWAP(x, xi, 13, 14); RT_CSWAP(x, xi, 0, 8); RT_CSWAP(x, xi, 4, 12); RT_CSWAP(x, xi, 4, 8); RT_CSWAP(x, xi, 2, 10); RT_CSWAP(x, xi, 6, 14); RT_CSWAP(x, xi, 6, 10); RT_CSWAP(x, xi, 2, 4); RT_CSWAP(x, xi, 6, 8); RT_CSWAP(x, xi, 10, 12); RT_CSWAP(x, xi, 1, 9); RT_CSWAP(x, xi, 5, 13); RT_CSWAP(x, xi, 5, 9); RT_CSWAP(x, xi, 3, 11); RT_CSWAP(x, xi, 7, 15); RT_CSWAP(x, xi, 7, 11); RT_CSWAP(x, xi, 3, 5); RT_CSWAP(x, xi, 7, 9); RT_CSWAP(x, xi, 11, 13); RT_CSWAP(x, xi, 1, 2); RT_CSWAP(x, xi, 3, 4); RT_CSWAP(x, xi, 5, 6); RT_CSWAP(x, xi, 7, 8); RT_CSWAP(x, xi, 9, 10); RT_CSWAP(x, xi, 11, 12); RT_CSWAP(x, xi, 13, 14); } while (0)
#define RT_FOR_CANDS(F) F(0, 0) F(0, 1) F(0, 2) F(0, 3) F(0, 4) F(0, 5) F(0, 6) F(0, 7) F(0, 8) F(0, 9) F(0, 10) F(0, 11) F(0, 12) F(0, 13) F(0, 14) F(0, 15) F(1, 0) F(1, 1) F(1, 2) F(1, 3) F(1, 4) F(1, 5) F(1, 6) F(1, 7) F(2, 0) F(2, 1) F(2, 2) F(2, 3) F(2, 4) F(3, 0) F(3, 1) F(3, 2) F(3, 3) F(4, 0) F(4, 1) F(4, 2) F(5, 0) F(5, 1) F(6, 0) F(6, 1) F(7, 0) F(7, 1) F(8, 0) F(9, 0) F(10, 0) F(11, 0) F(12, 0) F(13, 0) F(14, 0) F(15, 0)
#define RT_SEARCH(COUNT_MACRO, NTOT) \
    for (int it_ = 0; it_ < 400 && __any(!done); ++it_) { \
        const float w_ = hi - lo; float t_ = ((float)(clo - 16) + 0.5f) * __builtin_amdgcn_rcpf((float)(clo - chi)); t_ = __builtin_fminf(__builtin_fmaxf(t_, 0.125f), 0.875f); \
        float x_ = lo + w_ * t_; if (!(x_ > lo && x_ < hi)) x_ = 0.5f * lo + 0.5f * hi; const bool stuck_ = !(x_ > lo && x_ < hi); \
        int c_; COUNT_MACRO(c_, x_); \
        if (!done) { if (stuck_) { Tv = lo; done = true; } else if (c_ == 16) { Tv = x_; done = true; } else if (c_ > 16) { lo = x_; clo = c_; } else { hi = x_; chi = c_; } } } \
    if (!done) Tv = lo;
#define RT_CNT128_GE(c, x) RT_COUNT128(RT_GE8, c, x)
#define RT_CNT50_GE(c, x) RT_COUNT50(RT_SGE5, c, x)
__device__ __forceinline__ void lane_top16_of_128(const float (&v)[128], LAS unsigned char* sb) {
    float mx = v[0], mn = v[0];
#pragma unroll
    for (int i = 1; i < 128; ++i) { mx = __builtin_fmaxf(mx, v[i]); mn = __builtin_fminf(mn, v[i]); }
    float lo = mn, hi = mx, Tv = mn; int clo = 128, chi; bool done;
    RT_CNT128_GE(chi, mx); done = (chi >= 16); if (done) Tv = mx;
    RT_SEARCH(RT_CNT128_GE, 128)
    int cgt; RT_COUNT128(RT_GT8, cgt, Tv);
    const int need = 16 - cgt; int cnt = 0, idx = 0;
#pragma unroll
    for (int i = 0; i < 128; ++i) {
        asm volatile("" : "+v"(Tv), "+v"(cnt), "+v"(idx));
        LAS unsigned char* q = sb + cnt * 512; *(LAS float*)q = v[i]; *(LAS int*)(q + 4) = idx;
        cnt += (v[i] > Tv) ? 1 : 0; idx += 1;
    }
    if (__any(need > 0)) {
        idx = 0;
#pragma unroll
        for (int i = 0; i < 128; ++i) { asm volatile("" : "+v"(Tv), "+v"(cnt), "+v"(idx));
            if (v[i] == Tv && cnt < 16) { LAS unsigned char* q = sb + cnt * 512; *(LAS float*)q = v[i]; *(LAS int*)(q + 4) = idx; cnt += 1; } idx += 1; }
    }
}
__device__ __forceinline__ int opaque_zero() { int z = 0; asm volatile("" : "+v"(z)); return z; }
__device__ __forceinline__ void route_task_search(const float* SCT, v2u* ROUTE, int tok0, int h, LAS unsigned char* scr, int lane) {
    const int tok = tok0 + lane;
    LAS unsigned char* sb = scr + lane * 8;
#pragma unroll 1
    for (int p = 0; p < 2; ++p) {
        const int g = 2 * h + p; float v[128];
        const unsigned voff = (unsigned)tok * 16u;
#pragma unroll
        for (int k = 0; k < 32; ++k) { const char* bk = (const char*)SCT + ((size_t)(g * 32 + k) * M) * 16; const f32x4 q = *(const GAS f32x4*)(bk + voff); v[4 * k] = q.x; v[4 * k + 1] = q.y; v[4 * k + 2] = q.z; v[4 * k + 3] = q.w; }
        lane_top16_of_128(v, sb + p * 8704);
    }
    LDS_WAIT();
    float a[16], b[16]; int ai[16], bi[16];
#pragma unroll
    for (int i = 0; i < 16; ++i) { const v2u ea = *(LAS v2u*)(sb + i * 512), eb = *(LAS v2u*)(sb + 8704 + i * 512);
        a[i] = __builtin_bit_cast(float, ea.x); ai[i] = (int)ea.y; b[i] = __builtin_bit_cast(float, eb.x); bi[i] = (int)eb.y; }
    LDS_WAIT();
    RT_SORT16(a, ai); RT_SORT16(b, bi);
    float lo = a[15] + b[15], hi = a[0] + b[0], Tv = lo; int clo = 50, chi; bool done;
    RT_CNT50_GE(chi, hi); done = (chi >= 16); if (done) Tv = hi;
    RT_SEARCH(RT_CNT50_GE, 50)
    int cgt; RT_COUNT50(RT_SGT5, cgt, Tv);
    const int need = 16 - cgt; int cnt = 0;
#define RT_EXT(i, j) { asm volatile("" : "+v"(Tv), "+v"(cnt)); const float s_ = a[i] + b[j]; LAS unsigned char* q_ = sb + cnt * 512; *(LAS float*)q_ = s_; *(LAS int*)(q_ + 4) = ai[i] * 128 + bi[j]; cnt += (s_ > Tv) ? 1 : 0; }
    RT_FOR_CANDS(RT_EXT)
#undef RT_EXT
    if (__any(need > 0)) {
#define RT_EXT2(i, j) { asm volatile("" : "+v"(Tv), "+v"(cnt)); const float s_ = a[i] + b[j]; if (s_ == Tv && cnt < 16) { LAS unsigned char* q_ = sb + cnt * 512; *(LAS float*)q_ = s_; *(LAS int*)(q_ + 4) = ai[i] * 128 + bi[j]; cnt += 1; } }
        RT_FOR_CANDS(RT_EXT2)
#undef RT_EXT2
    }
    LDS_WAIT();
    GAS v4u* rp = (GAS v4u*)((GAS v2u*)ROUTE + (size_t)tok * 128 + h * 16);
#pragma unroll
    for (int i = 0; i < 8; ++i) { const v2u e0 = *(LAS v2u*)(sb + (2 * i) * 512), e1 = *(LAS v2u*)(sb + (2 * i + 1) * 512); v4u o; o.x = e0.y; o.y = e0.x; o.z = e1.y; o.w = e1.x; rp[i] = o; }
    LDS_WAIT();
}

#define RT2_CE(a, b) { const int t0_ = (a), t1_ = (b); (a) = t0_ > t1_ ? t0_ : t1_; (b) = t0_ > t1_ ? t1_ : t0_; }
#define RT2_MX(a, b) ((a) > (b) ? (a) : (b))
#define RT2_SORT16(k, B) do { RT2_CE(k[(B) + 0], k[(B) + 13]); RT2_CE(k[(B) + 1], k[(B) + 12]); RT2_CE(k[(B) + 2], k[(B) + 15]); RT2_CE(k[(B) + 3], k[(B) + 14]); RT2_CE(k[(B) + 4], k[(B) + 8]); RT2_CE(k[(B) + 5], k[(B) + 6]); RT2_CE(k[(B) + 7], k[(B) + 11]); RT2_CE(k[(B) + 9], k[(B) + 10]); RT2_CE(k[(B) + 0], k[(B) + 5]); RT2_CE(k[(B) + 1], k[(B) + 7]); RT2_CE(k[(B) + 2], k[(B) + 9]); RT2_CE(k[(B) + 3], k[(B) + 4]); RT2_CE(k[(B) + 6], k[(B) + 13]); RT2_CE(k[(B) + 8], k[(B) + 14]); RT2_CE(k[(B) + 10], k[(B) + 15]); RT2_CE(k[(B) + 11], k[(B) + 12]); RT2_CE(k[(B) + 0], k[(B) + 1]); RT2_CE(k[(B) + 2], k[(B) + 3]); RT2_CE(k[(B) + 4], k[(B) + 5]); RT2_CE(k[(B) + 6], k[(B) + 8]); RT2_CE(k[(B) + 7], k[(B) + 9]); RT2_CE(k[(B) + 10], k[(B) + 11]); RT2_CE(k[(B) + 12], k[(B) + 13]); RT2_CE(k[(B) + 14], k[(B) + 15]); RT2_CE(k[(B) + 0], k[(B) + 2]); RT2_CE(k[(B) + 1], k[(B) + 3]); RT2_CE(k[(B) + 4], k[(B) + 10]); RT2_CE(k[(B) + 5], k[(B) + 11]); RT2_CE(k[(B) + 6], k[(B) + 7]); RT2_CE(k[(B) + 8], k[(B) + 9]); RT2_CE(k[(B) + 12], k[(B) + 14]); RT2_CE(k[(B) + 13], k[(B) + 15]); RT2_CE(k[(B) + 1], k[(B) + 2]); RT2_CE(k[(B) + 3], k[(B) + 12]); RT2_CE(k[(B) + 4], k[(B) + 6]); RT2_CE(k[(B) + 5], k[(B) + 7]); RT2_CE(k[(B) + 8], k[(B) + 10]); RT2_CE(k[(B) + 9], k[(B) + 11]); RT2_CE(k[(B) + 13], k[(B) + 14]); RT2_CE(k[(B) + 1], k[(B) + 4]); RT2_CE(k[(B) + 2], k[(B) + 6]); RT2_CE(k[(B) + 5], k[(B) + 8]); RT2_CE(k[(B) + 7], k[(B) + 10]); RT2_CE(k[(B) + 9], k[(B) + 13]); RT2_CE(k[(B) + 11], k[(B) + 14]); RT2_CE(k[(B) + 2], k[(B) + 4]); RT2_CE(k[(B) + 3], k[(B) + 6]); RT2_CE(k[(B) + 9], k[(B) + 12]); RT2_CE(k[(B) + 11], k[(B) + 13]); RT2_CE(k[(B) + 3], k[(B) + 5]); RT2_CE(k[(B) + 6], k[(B) + 8]); RT2_CE(k[(B) + 7], k[(B) + 9]); RT2_CE(k[(B) + 10], k[(B) + 12]); RT2_CE(k[(B) + 3], k[(B) + 4]); RT2_CE(k[(B) + 5], k[(B) + 6]); RT2_CE(k[(B) + 7], k[(B) + 8]); RT2_CE(k[(B) + 9], k[(B) + 10]); RT2_CE(k[(B) + 11], k[(B) + 12]); RT2_CE(k[(B) + 6], k[(B) + 7]); RT2_CE(k[(B) + 8], k[(B) + 9]); } while (0)
#define RT2_BIT16(k, B) do { RT2_CE(k[(B) + 0], k[(B) + 8]); RT2_CE(k[(B) + 1], k[(B) + 9]); RT2_CE(k[(B) + 2], k[(B) + 10]); RT2_CE(k[(B) + 3], k[(B) + 11]); RT2_CE(k[(B) + 4], k[(B) + 12]); RT2_CE(k[(B) + 5], k[(B) + 13]); RT2_CE(k[(B) + 6], k[(B) + 14]); RT2_CE(k[(B) + 7], k[(B) + 15]); RT2_CE(k[(B) + 0], k[(B) + 4]); RT2_CE(k[(B) + 1], k[(B) + 5]); RT2_CE(k[(B) + 2], k[(B) + 6]); RT2_CE(k[(B) + 3], k[(B) + 7]); RT2_CE(k[(B) + 8], k[(B) + 12]); RT2_CE(k[(B) + 9], k[(B) + 13]); RT2_CE(k[(B) + 10], k[(B) + 14]); RT2_CE(k[(B) + 11], k[(B) + 15]); RT2_CE(k[(B) + 0], k[(B) + 2]); RT2_CE(k[(B) + 1], k[(B) + 3]); RT2_CE(k[(B) + 4], k[(B) + 6]); RT2_CE(k[(B) + 5], k[(B) + 7]); RT2_CE(k[(B) + 8], k[(B) + 10]); RT2_CE(k[(B) + 9], k[(B) + 11]); RT2_CE(k[(B) + 12], k[(B) + 14]); RT2_CE(k[(B) + 13], k[(B) + 15]); RT2_CE(k[(B) + 0], k[(B) + 1]); RT2_CE(k[(B) + 2], k[(B) + 3]); RT2_CE(k[(B) + 4], k[(B) + 5]); RT2_CE(k[(B) + 6], k[(B) + 7]); RT2_CE(k[(B) + 8], k[(B) + 9]); RT2_CE(k[(B) + 10], k[(B) + 11]); RT2_CE(k[(B) + 12], k[(B) + 13]); RT2_CE(k[(B) + 14], k[(B) + 15]); } while (0)
#define RT2_HCLEAN(k, A, B) do { k[(A) + 0] = RT2_MX(k[(A) + 0], k[(B) + 15]); k[(A) + 1] = RT2_MX(k[(A) + 1], k[(B) + 14]); k[(A) + 2] = RT2_MX(k[(A) + 2], k[(B) + 13]); k[(A) + 3] = RT2_MX(k[(A) + 3], k[(B) + 12]); k[(A) + 4] = RT2_MX(k[(A) + 4], k[(B) + 11]); k[(A) + 5] = RT2_MX(k[(A) + 5], k[(B) + 10]); k[(A) + 6] = RT2_MX(k[(A) + 6], k[(B) + 9]); k[(A) + 7] = RT2_MX(k[(A) + 7], k[(B) + 8]); k[(A) + 8] = RT2_MX(k[(A) + 8], k[(B) + 7]); k[(A) + 9] = RT2_MX(k[(A) + 9], k[(B) + 6]); k[(A) + 10] = RT2_MX(k[(A) + 10], k[(B) + 5]); k[(A) + 11] = RT2_MX(k[(A) + 11], k[(B) + 4]); k[(A) + 12] = RT2_MX(k[(A) + 12], k[(B) + 3]); k[(A) + 13] = RT2_MX(k[(A) + 13], k[(B) + 2]); k[(A) + 14] = RT2_MX(k[(A) + 14], k[(B) + 1]); k[(A) + 15] = RT2_MX(k[(A) + 15], k[(B) + 0]); } while (0)
#define RT2_TOP16_OF_128(k) do { RT2_SORT16(k, 0); RT2_SORT16(k, 16); RT2_SORT16(k, 32); RT2_SORT16(k, 48); RT2_SORT16(k, 64); RT2_SORT16(k, 80); RT2_SORT16(k, 96); RT2_SORT16(k, 112); RT2_HCLEAN(k, 0, 16); RT2_BIT16(k, 0); RT2_HCLEAN(k, 32, 48); RT2_BIT16(k, 32); RT2_HCLEAN(k, 64, 80); RT2_BIT16(k, 64); RT2_HCLEAN(k, 96, 112); RT2_BIT16(k, 96); RT2_HCLEAN(k, 0, 32); RT2_BIT16(k, 0); RT2_HCLEAN(k, 64, 96); RT2_BIT16(k, 64); RT2_HCLEAN(k, 0, 64); RT2_BIT16(k, 0); } while (0)
#define RT2_BUILD_CANDS(c) do { c[0] = RT2_CK(0, 0); c[1] = RT2_CK(0, 1); c[2] = RT2_CK(0, 2); c[3] = RT2_CK(0, 3); c[4] = RT2_CK(0, 4); c[5] = RT2_CK(0, 5); c[6] = RT2_CK(0, 6); c[7] = RT2_CK(0, 7); c[8] = RT2_CK(0, 8); c[9] = RT2_CK(0, 9); c[10] = RT2_CK(0, 10); c[11] = RT2_CK(0, 11); c[12] = RT2_CK(0, 12); c[13] = RT2_CK(0, 13); c[14] = RT2_CK(0, 14); c[15] = RT2_CK(0, 15); c[16] = RT2_CK(1, 0); c[17] = RT2_CK(1, 1); c[18] = RT2_CK(1, 2); c[19] = RT2_CK(1, 3); c[20] = RT2_CK(1, 4); c[21] = RT2_CK(1, 5); c[22] = RT2_CK(1, 6); c[23] = RT2_CK(1, 7); c[24] = RT2_CK(15, 0); c[25] = RT2_CK(14, 0); c[26] = RT2_CK(13, 0); c[27] = RT2_CK(12, 0); c[28] = RT2_CK(11, 0); c[29] = RT2_CK(10, 0); c[30] = RT2_CK(9, 0); c[31] = RT2_CK(8, 0); c[32] = RT2_CK(2, 0); c[33] = RT2_CK(2, 1); c[34] = RT2_CK(2, 2); c[35] = RT2_CK(2, 3); c[36] = RT2_CK(2, 4); c[37] = RT2_CK(3, 0); c[38] = RT2_CK(3, 1); c[39] = RT2_CK(3, 2); c[40] = RT2_CK(3, 3); c[41] = RT2_CK(4, 0); c[42] = RT2_CK(4, 1); c[43] = RT2_CK(4, 2); c[44] = RT2_CK(5, 0); c[45] = RT2_CK(5, 1); c[46] = RT2_CK(6, 0); c[47] = RT2_CK(6, 1); } while (0)
__device__ __forceinline__ int rt2_tr(int u) { return u ^ (int)((unsigned)(u >> 31) >> 1); }
__device__ __forceinline__ int rt2_key(float x, int code, int mask) { return (rt2_tr(__builtin_bit_cast(int, x)) & ~mask) | code; }
__device__ __forceinline__ int rt2_key16(unsigned hbits_hi, int code) { return (rt2_tr((int)hbits_hi) & (int)0xffff0000) | code; }
__device__ __forceinline__ float rt2_val16(int k) { const unsigned u = (unsigned)rt2_tr(k) >> 16; return (float)__builtin_bit_cast(_Float16, (unsigned short)u); }
__device__ __forceinline__ void route_task(const unsigned short* SCT, v2u* ROUTE, int tok0, int h, LAS unsigned char* scr, int lane) {
    const int tok = tok0 + lane;
    LAS unsigned char* sb = scr + lane * 4;
#pragma unroll 1
    for (int p = 0; p < 2; ++p) {
        const int g = 2 * h + p; int k[128];
        const unsigned voff = (unsigned)tok * 16u;
#pragma unroll
        for (int q8 = 0; q8 < 16; ++q8) { const char* bq = (const char*)SCT + ((size_t)(g * 16 + q8) * M) * 16; const v4u q = *(const GAS v4u*)(bq + voff);
            k[8 * q8 + 0] = rt2_key16(q.x << 16, 127 - 8 * q8); k[8 * q8 + 1] = rt2_key16(q.x, 126 - 8 * q8); k[8 * q8 + 2] = rt2_key16(q.y << 16, 125 - 8 * q8); k[8 * q8 + 3] = rt2_key16(q.y, 124 - 8 * q8);
            k[8 * q8 + 4] = rt2_key16(q.z << 16, 123 - 8 * q8); k[8 * q8 + 5] = rt2_key16(q.z, 122 - 8 * q8); k[8 * q8 + 6] = rt2_key16(q.w << 16, 121 - 8 * q8); k[8 * q8 + 7] = rt2_key16(q.w, 120 - 8 * q8); }
        RT2_TOP16_OF_128(k);
#pragma unroll
        for (int i = 0; i < 16; ++i) *(LAS int*)(sb + (p * 16 + i) * 256) = k[i];
    }
    LDS_WAIT();
    float af[16], bf[16];
#pragma unroll
    for (int i = 0; i < 16; ++i) { af[i] = rt2_val16(*(const LAS int*)(sb + i * 256)); bf[i] = rt2_val16(*(const LAS int*)(sb + (16 + i) * 256)); }
    int c[48];
#define RT2_CK(i, j) rt2_key(af[i] + bf[j], 255 - (16 * (i) + (j)), 255)
    RT2_BUILD_CANDS(c);
    const int r7a = RT2_CK(7, 0), r7b = RT2_CK(7, 1);
#undef RT2_CK
    RT2_BIT16(c, 16);
    RT2_SORT16(c, 32);
    RT2_HCLEAN(c, 0, 16); RT2_BIT16(c, 0);
    c[46] = RT2_MX(c[46], r7b); c[47] = RT2_MX(c[47], r7a); RT2_BIT16(c, 32);
    RT2_HCLEAN(c, 0, 32);
    GAS v4u* rp = (GAS v4u*)((GAS v2u*)ROUTE + (size_t)tok * 128 + h * 16);
#pragma unroll
    for (int i = 0; i < 8; ++i) { v4u o;
        { const int ij = (~c[2 * i]) & 255; const int ka = *(const LAS int*)(sb + ((ij >> 4) << 8)), kb = *(const LAS int*)(sb + 4096 + ((ij & 15) << 8));
          o.x = (unsigned)(((~ka) & 127) * 128 + ((~kb) & 127)); o.y = __builtin_bit_cast(unsigned, rt2_val16(ka) + rt2_val16(kb)); }
        { const int ij = (~c[2 * i + 1]) & 255; const int ka = *(const LAS int*)(sb + ((ij >> 4) << 8)), kb = *(const LAS int*)(sb + 4096 + ((ij & 15) << 8));
          o.z = (unsigned)(((~ka) & 127) * 128 + ((~kb) & 127)); o.w = __builtin_bit_cast(unsigned, rt2_val16(ka) + rt2_val16(kb)); }
        rp[i] = o; }
    LDS_WAIT();
}

#define DPPF(v, ctrl) __builtin_bit_cast(float, __builtin_amdgcn_update_dpp(0, __builtin_bit_cast(int, (v)), (ctrl), 0xf, 0xf, true))
__device__ __forceinline__ float wave_max_f(float m) {
#pragma unroll
    for (int o = 1; o < 64; o <<= 1) m = __builtin_fmaxf(m, __shfl_xor(m, o));
    return m;
}
template <int NV> __device__ __forceinline__ void select16(const float (&v)[NV], bool (&sel)[NV], int (&pos)[NV]) {
    float mx = v[0], mn = v[0];
#pragma unroll
    for (int i = 1; i < NV; ++i) { mx = __builtin_fmaxf(mx, v[i]); mn = __builtin_fminf(mn, v[i]); }
    mx = wave_max_f(mx); mn = -wave_max_f(-mn);
    float lo = mn, hi = mx, Tv;
    { int c = 0;
#pragma unroll
      for (int i = 0; i < NV; ++i) c += __popcll(__ballot(v[i] >= mx));
      if (c >= 16) { Tv = mx; }
      else {
        Tv = lo;
        for (int it = 0; it < 300; ++it) {
            const float mid = 0.5f * lo + 0.5f * hi;
            if (!(mid > lo && mid < hi)) { Tv = lo; break; }
            int cc = 0;
#pragma unroll
            for (int i = 0; i < NV; ++i) cc += __popcll(__ballot(v[i] >= mid));
            if (cc == 16) { Tv = mid; break; }
            if (cc > 16) lo = mid; else hi = mid;
            Tv = lo;
        }
      }
    }
    int cgt = 0;
#pragma unroll
    for (int i = 0; i < NV; ++i) cgt += __popcll(__ballot(v[i] > Tv));
    const int need = 16 - cgt;
    int eqbelow = 0;
#pragma unroll
    for (int i = 0; i < NV; ++i) { const unsigned long long m = __ballot(v[i] == Tv); eqbelow += __builtin_amdgcn_mbcnt_hi((unsigned)(m >> 32), __builtin_amdgcn_mbcnt_lo((unsigned)m, 0u)); }
    int eqown = 0;
#pragma unroll
    for (int i = 0; i < NV; ++i) { const bool eq = (v[i] == Tv); sel[i] = (v[i] > Tv) || (eq && (eqbelow + eqown) < need); eqown += eq ? 1 : 0; }
    int selbelow = 0;
#pragma unroll
    for (int i = 0; i < NV; ++i) { const unsigned long long m = __ballot(sel[i]); selbelow += __builtin_amdgcn_mbcnt_hi((unsigned)(m >> 32), __builtin_amdgcn_mbcnt_lo((unsigned)m, 0u)); }
    int own = 0;
#pragma unroll
    for (int i = 0; i < NV; ++i) { pos[i] = selbelow + own; own += sel[i] ? 1 : 0; }
}

__device__ __forceinline__ float gelu_exact(float a) { return 0.5f * a * (1.0f + erff(a * 0.7071067811865476f)); }

__device__ __forceinline__ void fp8_row_dot(const v4u q, const float (&xr)[16], float& s) {
    const f32x2 a0 = __builtin_amdgcn_cvt_pk_f32_fp8((int)q.x, false), a1 = __builtin_amdgcn_cvt_pk_f32_fp8((int)q.x, true), a2 = __builtin_amdgcn_cvt_pk_f32_fp8((int)q.y, false), a3 = __builtin_amdgcn_cvt_pk_f32_fp8((int)q.y, true);
    const f32x2 b0 = __builtin_amdgcn_cvt_pk_f32_fp8((int)q.z, false), b1 = __builtin_amdgcn_cvt_pk_f32_fp8((int)q.z, true), b2 = __builtin_amdgcn_cvt_pk_f32_fp8((int)q.w, false), b3 = __builtin_amdgcn_cvt_pk_f32_fp8((int)q.w, true);
    f32x2 t = a0 * (f32x2){xr[0], xr[1]};
    t = __builtin_elementwise_fma(a1, (f32x2){xr[2], xr[3]}, t); t = __builtin_elementwise_fma(a2, (f32x2){xr[4], xr[5]}, t); t = __builtin_elementwise_fma(a3, (f32x2){xr[6], xr[7]}, t);
    t = __builtin_elementwise_fma(b0, (f32x2){xr[8], xr[9]}, t); t = __builtin_elementwise_fma(b1, (f32x2){xr[10], xr[11]}, t); t = __builtin_elementwise_fma(b2, (f32x2){xr[12], xr[13]}, t); t = __builtin_elementwise_fma(b3, (f32x2){xr[14], xr[15]}, t);
    s = t.x + t.y;
}
__device__ __forceinline__ void fp8_row_axpy2(const v4u q, const float w, f32x2 (&acc)[8]) {
    const f32x2 a0 = __builtin_amdgcn_cvt_pk_f32_fp8((int)q.x, false), a1 = __builtin_amdgcn_cvt_pk_f32_fp8((int)q.x, true), a2 = __builtin_amdgcn_cvt_pk_f32_fp8((int)q.y, false), a3 = __builtin_amdgcn_cvt_pk_f32_fp8((int)q.y, true);
    const f32x2 b0 = __builtin_amdgcn_cvt_pk_f32_fp8((int)q.z, false), b1 = __builtin_amdgcn_cvt_pk_f32_fp8((int)q.z, true), b2 = __builtin_amdgcn_cvt_pk_f32_fp8((int)q.w, false), b3 = __builtin_amdgcn_cvt_pk_f32_fp8((int)q.w, true);
    const f32x2 ww = {w, w};
    acc[0] = __builtin_elementwise_fma(a0, ww, acc[0]); acc[1] = __builtin_elementwise_fma(a1, ww, acc[1]); acc[2] = __builtin_elementwise_fma(a2, ww, acc[2]); acc[3] = __builtin_elementwise_fma(a3, ww, acc[3]);
    acc[4] = __builtin_elementwise_fma(b0, ww, acc[4]); acc[5] = __builtin_elementwise_fma(b1, ww, acc[5]); acc[6] = __builtin_elementwise_fma(b2, ww, acc[6]); acc[7] = __builtin_elementwise_fma(b3, ww, acc[7]);
}
__device__ __forceinline__ void fp8_row_axpy(const v4u q, const float w, float (&acc)[16]) {
    const f32x2 a0 = __builtin_amdgcn_cvt_pk_f32_fp8((int)q.x, false), a1 = __builtin_amdgcn_cvt_pk_f32_fp8((int)q.x, true), a2 = __builtin_amdgcn_cvt_pk_f32_fp8((int)q.y, false), a3 = __builtin_amdgcn_cvt_pk_f32_fp8((int)q.y, true);
    const f32x2 b0 = __builtin_amdgcn_cvt_pk_f32_fp8((int)q.z, false), b1 = __builtin_amdgcn_cvt_pk_f32_fp8((int)q.z, true), b2 = __builtin_amdgcn_cvt_pk_f32_fp8((int)q.w, false), b3 = __builtin_amdgcn_cvt_pk_f32_fp8((int)q.w, true);
    acc[0] += w * a0.x; acc[1] += w * a0.y; acc[2] += w * a1.x; acc[3] += w * a1.y; acc[4] += w * a2.x; acc[5] += w * a2.y; acc[6] += w * a3.x; acc[7] += w * a3.y;
    acc[8] += w * b0.x; acc[9] += w * b0.y; acc[10] += w * b1.x; acc[11] += w * b1.y; acc[12] += w * b2.x; acc[13] += w * b2.y; acc[14] += w * b3.x; acc[15] += w * b3.y;
}
__device__ __forceinline__ void fp8_convert_row(const float* src, const float* gain, unsigned char* dst, float* inv_scale, int lane, int sliced, int e) {
    const GAS f32x4* sp = (const GAS f32x4*)src; float v[16];
#pragma unroll
    for (int j = 0; j < 2; ++j) { f32x4 a = sp[2 * lane + 128 * j], b = sp[2 * lane + 128 * j + 1];
        if (gain) { const GAS f32x4* gp = (const GAS f32x4*)gain; const f32x4 ga = gp[2 * lane + 128 * j], gb = gp[2 * lane + 128 * j + 1]; a = a * ga; b = b * gb; }
        v[8 * j + 0] = a.x; v[8 * j + 1] = a.y; v[8 * j + 2] = a.z; v[8 * j + 3] = a.w; v[8 * j + 4] = b.x; v[8 * j + 5] = b.y; v[8 * j + 6] = b.z; v[8 * j + 7] = b.w; }
    float am = 0.f;
#pragma unroll
    for (int i = 0; i < 16; ++i) am = __builtin_fmaxf(am, __builtin_fabsf(v[i]));
    am = wave_max_f(am);
    const float sc = (am > 0.f) ? 384.0f / am : 1.0f, inv = (am > 0.f) ? am * (1.0f / 384.0f) : 1.0f;
    v4u q;
    { int w = __builtin_amdgcn_cvt_pk_fp8_f32(v[0] * sc, v[1] * sc, 0, false); w = __builtin_amdgcn_cvt_pk_fp8_f32(v[2] * sc, v[3] * sc, w, true); q.x = (unsigned)w; }
    { int w = __builtin_amdgcn_cvt_pk_fp8_f32(v[4] * sc, v[5] * sc, 0, false); w = __builtin_amdgcn_cvt_pk_fp8_f32(v[6] * sc, v[7] * sc, w, true); q.y = (unsigned)w; }
    { int w = __builtin_amdgcn_cvt_pk_fp8_f32(v[8] * sc, v[9] * sc, 0, false); w = __builtin_amdgcn_cvt_pk_fp8_f32(v[10] * sc, v[11] * sc, w, true); q.z = (unsigned)w; }
    { int w = __builtin_amdgcn_cvt_pk_fp8_f32(v[12] * sc, v[13] * sc, 0, false); w = __builtin_amdgcn_cvt_pk_fp8_f32(v[14] * sc, v[15] * sc, w, true); q.w = (unsigned)w; }
    if (!sliced) ((GAS v4u*)dst)[lane] = q;
    else { v2u q0, q1; q0.x = q.x; q0.y = q.y; q1.x = q.z; q1.y = q.w; const int s0 = lane >> 4, o8 = 8 * (lane & 15);
        *(GAS v2u*)(dst + ((size_t)s0 * NEXP + e) * 128 + o8) = q0; *(GAS v2u*)(dst + ((size_t)(s0 + 4) * NEXP + e) * 128 + o8) = q1; }
    if (lane == 0) *inv_scale = inv;
}

#define PIN_ACC2(b) asm volatile("" : "+v"(b), "+v"(acc2[0]), "+v"(acc2[1]), "+v"(acc2[2]), "+v"(acc2[3]), "+v"(acc2[4]), "+v"(acc2[5]), "+v"(acc2[6]), "+v"(acc2[7]))
#define PIN_ACC(b) asm volatile("" : "+v"(b), "+v"(acc[0]), "+v"(acc[1]), "+v"(acc[2]), "+v"(acc[3]), "+v"(acc[4]), "+v"(acc[5]), "+v"(acc[6]), "+v"(acc[7]), "+v"(acc[8]), "+v"(acc[9]), "+v"(acc[10]), "+v"(acc[11]), "+v"(acc[12]), "+v"(acc[13]), "+v"(acc[14]), "+v"(acc[15]))
#define PC_META_U(tk) do { const char* rb_ = (const char*)route + (size_t)(tk) * 1024; m_e0 = *(const GAS int*)(rb_ + l8); m_e1 = *(const GAS int*)(rb_ + 512 + l8); } while (0)
#define PC_ISSUE_U(buf, xs, par, tk) do { LAS int* lid_ = (LAS int*)(scr + (par) * 512); lid_[lane] = m_e0; lid_[lane + 64] = m_e1; LDS_WAIT(); \
        { const GAS f32x4* xq_ = (const GAS f32x4*)(x1 + (size_t)(tk) * D + 128 * s + 16 * c); const f32x4 x0_ = xq_[0], x1_ = xq_[1], x2_ = xq_[2], x3_ = xq_[3]; \
          xs[0] = x0_.x; xs[1] = x0_.y; xs[2] = x0_.z; xs[3] = x0_.w; xs[4] = x1_.x; xs[5] = x1_.y; xs[6] = x1_.z; xs[7] = x1_.w; xs[8] = x2_.x; xs[9] = x2_.y; xs[10] = x2_.z; xs[11] = x2_.w; xs[12] = x3_.x; xs[13] = x3_.y; xs[14] = x3_.z; xs[15] = x3_.w; } \
        _Pragma("unroll") for (int k = 0; k < 16; ++k) { const int e_ = lid_[8 * k + r]; buf[k] = *(const GAS v4u*)(tbs + (unsigned)(e_ * 128)); } } while (0)
#define PC_COMPUTE_U(buf, xs, tk) do { float p_[16]; \
        _Pragma("unroll") for (int k = 0; k < 16; ++k) { if (k) asm volatile("" : "+v"(buf[k]), "+v"(p_[k ? k - 1 : 0])); else asm volatile("" : "+v"(buf[k])); fp8_row_dot(buf[k], xs, p_[k]); } \
        float q8_[8], q4_[4], q2_[2]; \
        _Pragma("unroll") for (int k = 0; k < 8; ++k) { const float send = c2 ? p_[k] : p_[k + 8], keep = c2 ? p_[k + 8] : p_[k]; q8_[k] = keep + __shfl_xor(send, 4); } \
        _Pragma("unroll") for (int k = 0; k < 4; ++k) { const float send = c1 ? q8_[k] : q8_[k + 4], keep = c1 ? q8_[k + 4] : q8_[k]; q4_[k] = keep + __shfl_xor(send, 2); } \
        _Pragma("unroll") for (int k = 0; k < 2; ++k) { const float send = c0 ? q4_[k] : q4_[k + 2], keep = c0 ? q4_[k + 2] : q4_[k]; q2_[k] = keep + __shfl_xor(send, 1); } \
        GAS float* up_ = (GAS float*)(Upart + ((size_t)s * M + (tk)) * 128 + 64 * c2 + 32 * c1 + 16 * c0 + r); up_[0] = q2_[0]; up_[8] = q2_[1]; } while (0)
__device__ __forceinline__ void peer_u_phase(int s, int tok0, int tstride, int nitems, const v2u* route, const float* x1, const unsigned char* TU8s, float* Upart, LAS unsigned char* scr, int lane) {
    const int r = lane >> 3, c = lane & 7, c2 = (lane >> 2) & 1, c1 = (lane >> 1) & 1, c0 = lane & 1; const unsigned l8 = (unsigned)lane * 8u;
    const char* tbs = (const char*)TU8s + (size_t)s * NEXP * 128 + 16 * c;
    int m_e0, m_e1;
    v4u bufA[16], bufB[16]; float xsA[16], xsB[16];
    PC_META_U(tok0); PC_ISSUE_U(bufA, xsA, 0, tok0); if (nitems > 1) PC_META_U(tok0 + tstride);
#pragma unroll 1
    for (int i = 0; i < nitems; i += 2) {
        const int tk = tok0 + i * tstride;
        if (i + 1 < nitems) PC_ISSUE_U(bufB, xsB, 1, tk + tstride);
        if (i + 2 < nitems) PC_META_U(tk + 2 * tstride);
        PC_COMPUTE_U(bufA, xsA, tk);
        if (i + 1 < nitems) {
            if (i + 2 < nitems) PC_ISSUE_U(bufA, xsA, 0, tk + 2 * tstride);
            if (i + 3 < nitems) PC_META_U(tk + 3 * tstride);
            PC_COMPUTE_U(bufB, xsB, tk + tstride);
        }
    }
    LDS_WAIT();
}
#define PD_META_U(tk) do { const char* rb_ = (const char*)route + (size_t)(tk) * 1024; m_e0 = *(const GAS int*)(rb_ + l8); m_e1 = *(const GAS int*)(rb_ + 512 + l8); \
        { const unsigned xw_ = *(const GAS unsigned*)((const bf16*)x1 + (size_t)(tk) * D + 128 * s + 2 * lane); m_x.x = bflo(xw_); m_x.y = bfhi(xw_); } } while (0)
#define PD_ISSUE_U(buf, xq, xinv, par) do { LAS int* lid_ = (LAS int*)(scr + (par) * 1024); LAS unsigned short* lx_ = (LAS unsigned short*)(scr + (par) * 1024 + 512); lid_[lane] = m_e0; lid_[lane + 64] = m_e1; LDS_WAIT(); \
        _Pragma("unroll") for (int k = 0; k < 16; ++k) { const int e_ = lid_[8 * k + r]; buf[k] = *(const GAS v4u*)(tbs + (unsigned)(e_ * 128)); } \
        { float am_ = __builtin_fmaxf(__builtin_fabsf(m_x.x), __builtin_fabsf(m_x.y)); \
          _Pragma("unroll") for (int o_ = 1; o_ < 64; o_ <<= 1) am_ = __builtin_fmaxf(am_, __shfl_xor(am_, o_)); \
          const float sc_ = (am_ > 0.f) ? 127.0f / am_ : 0.f; xinv = am_ * (1.0f / 127.0f); \
          const int q0_ = (int)__builtin_rintf(m_x.x * sc_), q1_ = (int)__builtin_rintf(m_x.y * sc_); lx_[lane] = (unsigned short)(((unsigned)q0_ & 255u) | (((unsigned)q1_ & 255u) << 8)); } \
        LDS_WAIT(); xq = *(const LAS v4u*)((LAS unsigned char*)lx_ + 16 * c); } while (0)
#define PD_COMPUTE_U(buf, xq, xinv, tk) do { int p_[16]; \
        _Pragma("unroll") for (int k = 0; k < 16; ++k) { int a_ = __builtin_amdgcn_sdot4((int)buf[k].x, (int)xq.x, 0, false); a_ = __builtin_amdgcn_sdot4((int)buf[k].y, (int)xq.y, a_, false); \
            a_ = __builtin_amdgcn_sdot4((int)buf[k].z, (int)xq.z, a_, false); a_ = __builtin_amdgcn_sdot4((int)buf[k].w, (int)xq.w, a_, false); p_[k] = a_; } \
        int q8_[8], q4_[4], q2_[2]; \
        _Pragma("unroll") for (int k = 0; k < 8; ++k) { const int send = c2 ? p_[k] : p_[k + 8], keep = c2 ? p_[k + 8] : p_[k]; q8_[k] = keep + __shfl_xor(send, 4); } \
        _Pragma("unroll") for (int k = 0; k < 4; ++k) { const int send = c1 ? q8_[k] : q8_[k + 4], keep = c1 ? q8_[k + 4] : q8_[k]; q4_[k] = keep + __shfl_xor(send, 2); } \
        _Pragma("unroll") for (int k = 0; k < 2; ++k) { const int send = c0 ? q4_[k] : q4_[k + 2], keep = c0 ? q4_[k + 2] : q4_[k]; q2_[k] = keep + __shfl_xor(send, 1); } \
        GAS bf16* up_ = (GAS bf16*)Upart + ((size_t)s * M + (tk)) * 128 + 64 * c2 + 32 * c1 + 16 * c0 + r; const unsigned pk_ = cvtpk((float)q2_[0] * xinv, (float)q2_[1] * xinv); up_[0] = (bf16)(pk_ & 0xffffu); up_[8] = (bf16)(pk_ >> 16); } while (0)
__device__ __forceinline__ void peer_u_phase_dot4(int s, int tok0, int tstride, int nitems, const v2u* route, const float* x1, const unsigned char* TU8s, float* Upart, LAS unsigned char* scr, int lane) {
    const int r = lane >> 3, c = lane & 7, c2 = (lane >> 2) & 1, c1 = (lane >> 1) & 1, c0 = lane & 1; const unsigned l8 = (unsigned)lane * 8u;
    const char* tbs = (const char*)TU8s + (size_t)s * NEXP * 128 + 16 * c;
    int m_e0, m_e1; f32x2 m_x;
    v4u bufA[16], bufB[16], xqA, xqB; float xiA, xiB;
    PD_META_U(tok0); PD_ISSUE_U(bufA, xqA, xiA, 0); if (nitems > 1) PD_META_U(tok0 + tstride);
#pragma unroll 1
    for (int it = 0; it < nitems; it += 2) {
        const int tk = tok0 + it * tstride;
        if (it + 1 < nitems) PD_ISSUE_U(bufB, xqB, xiB, 1);
        if (it + 2 < nitems) PD_META_U(tk + 2 * tstride);
        PD_COMPUTE_U(bufA, xqA, xiA, tk);
        if (it + 1 < nitems) {
            if (it + 2 < nitems) PD_ISSUE_U(bufA, xqA, xiA, 0);
            if (it + 3 < nitems) PD_META_U(tk + 3 * tstride);
            PD_COMPUTE_U(bufB, xqB, xiB, tk + tstride);
        }
    }
    LDS_WAIT();
}
__device__ __forceinline__ void peer_w_token(int tok, const v2u* route, const float* x1, const float* Upart, const float* SU, const float* SV, float* W, int lane) {
    const GAS f32x4* xp = (const GAS f32x4*)(x1 + (size_t)tok * D) + lane; float ssq = 0.f;
#pragma unroll
    for (int j = 0; j < 4; ++j) { const f32x4 q = xp[64 * j]; ssq += (q.x * q.x + q.y * q.y) + (q.z * q.z + q.w * q.w); }
    const float rstd2 = 1.0f / sqrtf(wave_sum(ssq) * (1.0f / D) + RMS_EPS);
    const char* rb_ = (const char*)route + (size_t)tok * 1024; const unsigned l8_ = (unsigned)lane * 8u;
    const v2u r_lo = *(const GAS v2u*)(rb_ + l8_), r_hi = *(const GAS v2u*)(rb_ + 512 + l8_);
    float g_lo, g_hi;
#pragma unroll
    for (int half = 0; half < 2; ++half) {
        const float sc_ = __builtin_bit_cast(float, half ? r_hi.y : r_lo.y) * rstd2; float m_ = sc_;
#pragma unroll
        for (int o = 1; o < 16; o <<= 1) m_ = __builtin_fmaxf(m_, __shfl_xor(m_, o));
        const float p_ = __builtin_amdgcn_exp2f((sc_ - m_) * 1.4426950408889634f); float sum_ = p_;
#pragma unroll
        for (int o = 1; o < 16; o <<= 1) sum_ += __shfl_xor(sum_, o);
        if (half) g_hi = p_ / sum_; else g_lo = p_ / sum_;
    }
    asm volatile("" : "+v"(g_lo), "+v"(g_hi));
#pragma unroll
    for (int half = 0; half < 2; ++half) {
        const int e = (int)(half ? r_hi.x : r_lo.x); const int n = lane + 64 * half;
        float dot = 0.f;
#pragma unroll
        for (int s8 = 0; s8 < 8; ++s8) dot += Upart[((size_t)s8 * M + tok) * 128 + n];
        const float act = gelu_exact(dot * SU[e] * rstd2);
        W[(size_t)tok * 128 + n] = (half ? g_hi : g_lo) * act * SV[e];
    }
}
__device__ __forceinline__ void peer_w_token2(int tokA, int tokB, const v2u* route, const bf16* x1b, const bf16* Upart, const float* SU, const float* SV, float* W, int lane) {
    v4u xv[2][2]; v2u r_lo[2], r_hi[2]; unsigned short ub[2][2][8];
#pragma unroll
    for (int t = 0; t < 2; ++t) { const int tok = t ? tokB : tokA;
        const GAS v4u* xp = (const GAS v4u*)(x1b + (size_t)tok * D) + lane; xv[t][0] = xp[0]; xv[t][1] = xp[64];
        const char* rb_ = (const char*)route + (size_t)tok * 1024; const unsigned l8_ = (unsigned)lane * 8u;
        r_lo[t] = *(const GAS v2u*)(rb_ + l8_); r_hi[t] = *(const GAS v2u*)(rb_ + 512 + l8_);
#pragma unroll
        for (int half = 0; half < 2; ++half)
#pragma unroll
            for (int s8 = 0; s8 < 8; ++s8) ub[t][half][s8] = *(const GAS bf16*)(Upart + ((size_t)s8 * M + tok) * 128 + lane + 64 * half); }
#pragma unroll
    for (int t = 0; t < 2; ++t) { const int tok = t ? tokB : tokA;
        float ssq = 0.f;
#pragma unroll
        for (int j = 0; j < 2; ++j) { const v4u q = xv[t][j];
            ssq += (bflo(q.x) * bflo(q.x) + bfhi(q.x) * bfhi(q.x)) + (bflo(q.y) * bflo(q.y) + bfhi(q.y) * bfhi(q.y)) + (bflo(q.z) * bflo(q.z) + bfhi(q.z) * bfhi(q.z)) + (bflo(q.w) * bflo(q.w) + bfhi(q.w) * bfhi(q.w)); }
        const float rstd2 = 1.0f / sqrtf(wave_sum(ssq) * (1.0f / D) + RMS_EPS);
        float g_lo, g_hi;
#pragma unroll
        for (int half = 0; half < 2; ++half) {
            const float sc_ = __builtin_bit_cast(float, half ? r_hi[t].y : r_lo[t].y) * rstd2; float m_ = sc_;
#pragma unroll
            for (int o = 1; o < 16; o <<= 1) m_ = __builtin_fmaxf(m_, __shfl_xor(m_, o));
            const float p_ = __builtin_amdgcn_exp2f((sc_ - m_) * 1.4426950408889634f); float sum_ = p_;
#pragma unroll
            for (int o = 1; o < 16; o <<= 1) sum_ += __shfl_xor(sum_, o);
            if (half) g_hi = p_ / sum_; else g_lo = p_ / sum_;
        }
        asm volatile("" : "+v"(g_lo), "+v"(g_hi));
#pragma unroll
        for (int half = 0; half < 2; ++half) {
            const int e = (int)(half ? r_hi[t].x : r_lo[t].x); const int n = lane + 64 * half;
            float dot = 0.f;
#pragma unroll
            for (int s8 = 0; s8 < 8; ++s8) dot += __builtin_bit_cast(float, (unsigned)ub[t][half][s8] << 16);
            const float act = gelu_exact(dot * SU[e] * rstd2);
            W[(size_t)tok * 128 + n] = (half ? g_hi : g_lo) * act * SV[e];
        }
    }
}
#define PC_META_V(tk) do { const char* rb_ = (const char*)route + (size_t)(tk) * 1024; m_e0 = *(const GAS int*)(rb_ + l8); m_e1 = *(const GAS int*)(rb_ + 512 + l8); \
        const GAS float* wp_ = (const GAS float*)(W + (size_t)(tk) * 128); m_w0 = wp_[lane]; m_w1 = wp_[lane + 64]; m_xv = *(const GAS unsigned*)(xres + (size_t)(tk) * D + col0); } while (0)
#define PC_ISSUE_V(buf, wk, xv, par) do { LAS int* lid_ = (LAS int*)(scr + (par) * 1024); LAS float* lw_ = (LAS float*)(scr + (par) * 1024 + 512); lid_[lane] = m_e0; lid_[lane + 64] = m_e1; lw_[lane] = m_w0; lw_[lane + 64] = m_w1; LDS_WAIT(); xv = m_xv; \
        _Pragma("unroll") for (int k = 0; k < 16; ++k) { const int e_ = lid_[8 * k + r]; wk[k] = lw_[8 * k + r]; buf[k] = *(const GAS v4u*)(tbs + (unsigned)(e_ * 128)); } } while (0)
#define PC_COMPUTE_V(buf, wk, xv, tk) do { f32x2 acc2[8]; _Pragma("unroll") for (int i_ = 0; i_ < 8; ++i_) acc2[i_] = (f32x2){0.f, 0.f}; \
        _Pragma("unroll") for (int k = 0; k < 16; ++k) { PIN_ACC2(buf[k]); fp8_row_axpy2(buf[k], wk[k], acc2); } \
        float acc[16]; _Pragma("unroll") for (int i_ = 0; i_ < 8; ++i_) { acc[2 * i_] = acc2[i_].x; acc[2 * i_ + 1] = acc2[i_].y; } \
        float r8_[8], r4_[4], r2_[2]; \
        _Pragma("unroll") for (int i_ = 0; i_ < 8; ++i_) { const float send = b5 ? acc[i_] : acc[i_ + 8], keep = b5 ? acc[i_ + 8] : acc[i_]; r8_[i_] = keep + __shfl_xor(send, 32); } \
        _Pragma("unroll") for (int i_ = 0; i_ < 4; ++i_) { const float send = b4 ? r8_[i_] : r8_[i_ + 4], keep = b4 ? r8_[i_ + 4] : r8_[i_]; r4_[i_] = keep + __shfl_xor(send, 16); } \
        _Pragma("unroll") for (int i_ = 0; i_ < 2; ++i_) { const float send = b3 ? r4_[i_] : r4_[i_ + 2], keep = b3 ? r4_[i_ + 2] : r4_[i_]; r2_[i_] = keep + __shfl_xor(send, 8); } \
        f32x2 o_; o_.x = bflo(xv) + r2_[0]; o_.y = bfhi(xv) + r2_[1]; *(GAS f32x2*)(xio + (size_t)(tk) * D + col0) = o_; } while (0)
__device__ __forceinline__ void peer_v_phase(int s, int tok0, int tstride, int nitems, const v2u* route, const float* W, const unsigned char* TV8s, const bf16* xres, float* xio, float* SS, LAS unsigned char* scr, int lane) {
    const int r = lane >> 3, c = lane & 7, b5 = lane >> 5, b4 = (lane >> 4) & 1, b3 = (lane >> 3) & 1; const unsigned l8 = (unsigned)lane * 8u;
    const int col0 = 128 * s + 16 * c + 8 * b5 + 4 * b4 + 2 * b3;
    const char* tbs = (const char*)TV8s + (size_t)s * NEXP * 128 + 16 * c;
    int m_e0, m_e1; float m_w0, m_w1; unsigned m_xv;
    v4u bufA[16], bufB[16]; float wA[16], wB[16]; unsigned xvA, xvB;
    PC_META_V(tok0); PC_ISSUE_V(bufA, wA, xvA, 0); if (nitems > 1) PC_META_V(tok0 + tstride);
#pragma unroll 1
    for (int i = 0; i < nitems; i += 2) {
        const int tk = tok0 + i * tstride;
        if (i + 1 < nitems) PC_ISSUE_V(bufB, wB, xvB, 1);
        if (i + 2 < nitems) PC_META_V(tk + 2 * tstride);
        PC_COMPUTE_V(bufA, wA, xvA, tk);
        if (i + 1 < nitems) {
            if (i + 2 < nitems) PC_ISSUE_V(bufA, wA, xvA, 0);
            if (i + 3 < nitems) PC_META_V(tk + 3 * tstride);
            PC_COMPUTE_V(bufB, wB, xvB, tk + tstride);
        }
    }
    LDS_WAIT();
}


__device__ __forceinline__ void peer_u_debug(int tok, const v2u* route, const float* x1, const unsigned char* TU8s, const float* SU, const float* SV, float* W, int lane) {
    float xr[16], ssq = 0.f;
    { const GAS f32x4* xp = (const GAS f32x4*)(x1 + (size_t)tok * D + 16 * lane);
#pragma unroll
      for (int j = 0; j < 4; ++j) { const f32x4 a = xp[j]; xr[4 * j] = a.x; xr[4 * j + 1] = a.y; xr[4 * j + 2] = a.z; xr[4 * j + 3] = a.w; } }
#pragma unroll
    for (int i = 0; i < 16; ++i) ssq += xr[i] * xr[i];
    const float rstd2 = 1.0f / sqrtf(wave_sum(ssq) * (1.0f / D) + RMS_EPS);
    const char* rb_ = (const char*)route + (size_t)tok * 1024; const int s = lane >> 3, c = lane & 7;
#pragma unroll 1
    for (int h = 0; h < 8; ++h) {
        float sc[16]; int id[16]; float m = -3e38f;
#pragma unroll
        for (int i = 0; i < 16; ++i) { const v2u r = *(const GAS v2u*)(rb_ + (h * 16 + i) * 8 + opaque_zero()); id[i] = (int)r.x; sc[i] = __builtin_bit_cast(float, r.y) * rstd2; m = __builtin_fmaxf(m, sc[i]); }
        float sum = 0.f;
#pragma unroll
        for (int i = 0; i < 16; ++i) { sc[i] = __builtin_amdgcn_exp2f((sc[i] - m) * 1.4426950408889634f); sum += sc[i]; }
#pragma unroll
        for (int i = 0; i < 16; ++i) { const int e = id[i];
            const v4u q = *(const GAS v4u*)(TU8s + ((size_t)s * NEXP + e) * 128 + 16 * c);
            float d; fp8_row_dot(q, xr, d); d = wave_sum(d);
            const float act = gelu_exact(d * SU[e] * rstd2);
            if (lane == 0) W[(size_t)tok * 128 + h * 16 + i] = (sc[i] / sum) * act * SV[e]; }
    }
}
__device__ __forceinline__ void peer_v_debug(int tok, const v2u* route, const float* W, const unsigned char* TV8s, float* xio, float* SS, int lane) {
    const char* rb_ = (const char*)route + (size_t)tok * 1024;
    float acc[16];
#pragma unroll
    for (int i = 0; i < 16; ++i) acc[i] = 0.f;
    const int s = lane >> 3, c = lane & 7;
#pragma unroll 1
    for (int n = 0; n < 128; ++n) {
        const int e = *(const GAS int*)(rb_ + n * 8 + opaque_zero()); const float w = W[(size_t)tok * 128 + n + opaque_zero()];
        const v4u q = *(const GAS v4u*)(TV8s + ((size_t)s * NEXP + e) * 128 + 16 * c);
        fp8_row_axpy(q, w, acc);
    }
    float ssq = 0.f;
    GAS float* xp = (GAS float*)(xio + (size_t)tok * D + 16 * lane);
#pragma unroll
    for (int i = 0; i < 16; ++i) { const float o = xp[i] + acc[i]; xp[i] = o; ssq += o * o; }
    ssq = wave_sum(ssq);
    if (lane < 8) SS[(size_t)lane * M + tok] = (lane == 0) ? ssq : 0.f;
}
#ifndef DUP_MASK
#define DUP_MASK 0
#endif
#define NREP(k) (1 + ((DUP_MASK >> (k)) & 1))
struct Args { const float* in[14]; float* out; unsigned char* ws; int ph_lo, ph_hi, li, pad; };
__global__ void __launch_bounds__(NWAVES * 64, 2) hybrid_fwd(Args args) {
    extern __shared__ __attribute__((aligned(16))) unsigned char lds[];
    LAS unsigned char* ldsb = (LAS unsigned char*)lds;
    volatile LAS unsigned* MISC = (volatile LAS unsigned*)(ldsb + MISC_OFF);
    const int tid = threadIdx.x, lane = tid & 63, wave = __builtin_amdgcn_readfirstlane(tid >> 6);
    const int G = gridDim.x; const int bx = blockIdx.x; const int vcu = (G % 8 == 0) ? (bx % 8) * (G / 8) + bx / 8 : bx;
    const int gw = vcu * NWAVES + wave, NGW = G * NWAVES;
    unsigned char* ws = args.ws;
    gu32* ctl = (gu32*)(ws + WS_CTL);
    const float* x = args.in[0]; float* out = args.out;
#define norm_mix (args.in[1])
#define w_in (args.in[2])
#define conv_w (args.in[3])
#define conv_b (args.in[4])
#define w_a (args.in[5])
#define w_b (args.in[6])
#define w_o (args.in[7])
#define norm_ffn (args.in[8])
#define w_q (args.in[9])
#define sub_keys (args.in[10])
#define exp_u (args.in[11])
#define exp_v (args.in[12])
#define final_norm (args.in[13])
#define Weff ((bf16*)((bf16*)(ws + WS_WEFF)))
#define Wab ((bf16*)((bf16*)(ws + WS_WAB)))
#define Wo_t ((bf16*)((bf16*)(ws + WS_WO)))
#define Win_t ((bf16*)((bf16*)(ws + WS_WIN)))
#define XB ((bf16*)((bf16*)(ws + WS_XB)))
#define SIX ((bf16*)((bf16*)(ws + WS_SIX)))
#define VT ((bf16*)((bf16*)(ws + WS_VT)))
#define GATE ((bf16*)((bf16*)(ws + WS_GATE)))
#define MERGED ((bf16*)((bf16*)(ws + WS_MERGED)))
#define X1B ((bf16*)((bf16*)(ws + WS_X1B)))
#define TU8 ((unsigned char*)(ws + WS_TU))
#define TV8 ((unsigned char*)(ws + WS_TV))
#define SU ((float*)((float*)(ws + WS_SU)))
#define SV ((float*)((float*)(ws + WS_SV)))
#define SCORES ((float*)((float*)(ws + WS_SCORES)))
#define ROUTE ((v2u*)((v2u*)(ws + WS_ROUTE)))
#define WBUF ((float*)((float*)(ws + WS_W)))
#define SSB ((float*)((float*)(ws + WS_SS)))
#define UPART ((float*)((float*)(ws + WS_UPART)))
#define RSTD1 ((float*)((float*)(ws + WS_RSTD1)))
#define QB ((bf16*)(SIX))
#define CBB ((bf16*)(SIX + (size_t)1 * M * 512))
#define KB ((bf16*)(SIX + (size_t)2 * M * 512))
#define CCB ((bf16*)(SIX + (size_t)4 * M * 512))
#define CUB ((bf16*)(SIX + (size_t)5 * M * 512))
    for (int u = tid; u < (LDS_BYTES - LDSCTL_OFF) / 4; u += NWAVES * 64) ((LAS unsigned*)(ldsb + LDSCTL_OFF))[u] = 0u;
    __syncthreads();
    XcdBarrier bar; bar.bar = (unsigned*)(ctl + CW_BAR); bar.x = 0; bar.st = nullptr;
    if (N_LAUNCHES == 1) bar = xcd_barrier_post((unsigned*)(ctl + CW_BAR), MISC + 8);
#define GRID_BAR() do { if (N_LAUNCHES == 1) xcd_barrier(bar); } while (0)
    const int lo = args.ph_lo, hi = args.ph_hi;
#define IN(k) (lo <= (k) && (k) < hi)
#define BOTH(k) (IN(k) && IN((k) + 1))

    if (IN(0)) { for (int rep = 0; rep < NREP(0); ++rep) {
        LAS float* scr = (LAS float*)(ldsb + RING_OFF + wave * 16384);
        constexpr int I_IN = (D / 64) * (NIN / 32), I_A = (512 / 64) * (D / 32), I_O = (D / 64) * (D / 32);
        constexpr int NITEMS = I_IN + 2 * I_A + I_O;
        constexpr int ABW = 3; const int aw = vcu * ABW + wave, NAW = G * ABW, cw = vcu * (NWAVES - ABW) + (wave - ABW), NCW = G * (NWAVES - ABW);
        if (wave < ABW) {
        for (int it = aw; it < NITEMS; it += NAW) {
            int r = it;
            if (r < I_IN) { p0_transpose_item(w_in, D, NIN, Win_t, 0, norm_mix, scr, r, lane); continue; } r -= I_IN;
            if (r < I_A) { p0_transpose_item(w_a, 512, D, Wab, 0, nullptr, scr, r, lane); continue; } r -= I_A;
            if (r < I_A) { p0_transpose_item(w_b, 512, D, Wab, 1024, nullptr, scr, r, lane); continue; } r -= I_A;
            p0_transpose_item(w_o, D, D, Wo_t, 0, nullptr, scr, r, lane);
        }
        for (int wt = aw; wt < 64 * 32; wt += NAW) {
            const int nt = wt & 63, kt = wt >> 6, hp = nt >> 2, h = lane >> 5, l32 = lane & 31;
            const GAS f32x4* ap = (const GAS f32x4*)(w_q + (size_t)(kt * 32 + l32) * 2048 + hp * 128 + 64 * h);
            const GAS f32x4* bp = (const GAS f32x4*)(sub_keys + (size_t)(nt * 32 + l32) * 128 + 64 * h);
            f32x4 av[16], bv[16];
#pragma unroll
            for (int i = 0; i < 16; ++i) { av[i] = ap[i]; bv[i] = bp[i]; }
            f32x16 acc;
#pragma unroll
            for (int i = 0; i < 16; ++i) acc[i] = 0.f;
#pragma unroll
            for (int i = 0; i < 16; ++i) {
                acc = __builtin_amdgcn_mfma_f32_32x32x2f32(av[i].x, bv[i].x, acc, 0, 0, 0); acc = __builtin_amdgcn_mfma_f32_32x32x2f32(av[i].y, bv[i].y, acc, 0, 0, 0);
                acc = __builtin_amdgcn_mfma_f32_32x32x2f32(av[i].z, bv[i].z, acc, 0, 0, 0); acc = __builtin_amdgcn_mfma_f32_32x32x2f32(av[i].w, bv[i].w, acc, 0, 0, 0); }
            const int n = nt * 32 + l32;
#pragma unroll
            for (int rq = 0; rq < 4; ++rq) { const int kb = kt * 32 + 8 * rq + 4 * h; const f32x4 g = *(const GAS f32x4*)(norm_ffn + kb);
                v2u o; o.x = pk2(acc[4 * rq] * g.x, acc[4 * rq + 1] * g.y); o.y = pk2(acc[4 * rq + 2] * g.z, acc[4 * rq + 3] * g.w);
                *(GAS v2u*)(Weff + (size_t)n * D + kb) = o; }
        }
        } else {
        for (int m0 = cw; m0 < M; m0 += 4 * NCW) {
            f32x4 v[4][4]; float s[4];
#pragma unroll
            for (int q = 0; q < 4; ++q) { const int m = m0 + q * NCW; const GAS f32x4* xr = (const GAS f32x4*)(x + (size_t)(m < M ? m : m0) * D) + lane;
#pragma unroll
                for (int j = 0; j < 4; ++j) v[q][j] = xr[64 * j]; }
#pragma unroll
            for (int q = 0; q < 4; ++q) { s[q] = 0.f;
#pragma unroll
                for (int j = 0; j < 4; ++j) s[q] += (v[q][j].x * v[q][j].x + v[q][j].y * v[q][j].y) + (v[q][j].z * v[q][j].z + v[q][j].w * v[q][j].w); }
#pragma unroll
            for (int o = 1; o < 64; o <<= 1) {
#pragma unroll
                for (int q = 0; q < 4; ++q) s[q] += __shfl_xor(s[q], o); }
#pragma unroll
            for (int q = 0; q < 4; ++q) { const int m = m0 + q * NCW; if (m < M) {
                const float rstd = 1.0f / sqrtf(s[q] * (1.0f / D) + RMS_EPS);
                GAS v2u* o8 = (GAS v2u*)(XB + (size_t)m * D) + lane;
#pragma unroll
                for (int j = 0; j < 4; ++j) { v2u o; o.x = pk2(v[q][j].x, v[q][j].y); o.y = pk2(v[q][j].z, v[q][j].w); o8[64 * j] = o; }
                if (lane == 0) RSTD1[m] = rstd; } }
        }
        for (int e0 = cw; e0 < NEXP; e0 += 2 * NCW) {
            float v[4][16]; float am[4]; int ee[4];
#pragma unroll
            for (int q = 0; q < 4; ++q) { const int e = e0 + (q >> 1) * NCW; ee[q] = e < NEXP ? e : e0; const float* src = ((q & 1) ? exp_v : exp_u) + (size_t)ee[q] * D; const GAS f32x4* sp = (const GAS f32x4*)src;
#pragma unroll
                for (int j = 0; j < 2; ++j) { const f32x4 a = sp[2 * lane + 128 * j], b = sp[2 * lane + 128 * j + 1];
                    v[q][8 * j + 0] = a.x; v[q][8 * j + 1] = a.y; v[q][8 * j + 2] = a.z; v[q][8 * j + 3] = a.w; v[q][8 * j + 4] = b.x; v[q][8 * j + 5] = b.y; v[q][8 * j + 6] = b.z; v[q][8 * j + 7] = b.w; } }
            { const GAS f32x4* gp = (const GAS f32x4*)norm_ffn;
#pragma unroll
              for (int j = 0; j < 2; ++j) { const f32x4 ga = gp[2 * lane + 128 * j], gb = gp[2 * lane + 128 * j + 1];
#pragma unroll
                for (int q = 0; q < 4; q += 2) { v[q][8 * j + 0] *= ga.x; v[q][8 * j + 1] *= ga.y; v[q][8 * j + 2] *= ga.z; v[q][8 * j + 3] *= ga.w; v[q][8 * j + 4] *= gb.x; v[q][8 * j + 5] *= gb.y; v[q][8 * j + 6] *= gb.z; v[q][8 * j + 7] *= gb.w; } } }
#pragma unroll
            for (int q = 0; q < 4; ++q) { am[q] = 0.f;
#pragma unroll
                for (int i = 0; i < 16; ++i) am[q] = __builtin_fmaxf(am[q], __builtin_fabsf(v[q][i])); }
#pragma unroll
            for (int o = 1; o < 64; o <<= 1) {
#pragma unroll
                for (int q = 0; q < 4; ++q) am[q] = __builtin_fmaxf(am[q], __shfl_xor(am[q], o)); }
#pragma unroll
            for (int q = 0; q < 4; ++q) { const int e = e0 + (q >> 1) * NCW; if (e < NEXP) {
                const float top = (q & 1) ? 384.0f : 127.0f;
                const float sc = (am[q] > 0.f) ? top / am[q] : 1.0f, inv = (am[q] > 0.f) ? am[q] * (1.0f / top) : 1.0f;
                v2u q0, q1;
                if (q & 1) {
                { int w = __builtin_amdgcn_cvt_pk_fp8_f32(v[q][0] * sc, v[q][1] * sc, 0, false); w = __builtin_amdgcn_cvt_pk_fp8_f32(v[q][2] * sc, v[q][3] * sc, w, true); q0.x = (unsigned)w; }
                { int w = __builtin_amdgcn_cvt_pk_fp8_f32(v[q][4] * sc, v[q][5] * sc, 0, false); w = __builtin_amdgcn_cvt_pk_fp8_f32(v[q][6] * sc, v[q][7] * sc, w, true); q0.y = (unsigned)w; }
                { int w = __builtin_amdgcn_cvt_pk_fp8_f32(v[q][8] * sc, v[q][9] * sc, 0, false); w = __builtin_amdgcn_cvt_pk_fp8_f32(v[q][10] * sc, v[q][11] * sc, w, true); q1.x = (unsigned)w; }
                { int w = __builtin_amdgcn_cvt_pk_fp8_f32(v[q][12] * sc, v[q][13] * sc, 0, false); w = __builtin_amdgcn_cvt_pk_fp8_f32(v[q][14] * sc, v[q][15] * sc, w, true); q1.y = (unsigned)w; }
                } else {
                    unsigned w4[4];
#pragma unroll
                    for (int j = 0; j < 4; ++j) { const int i0 = (int)__builtin_rintf(v[q][4 * j] * sc), i1 = (int)__builtin_rintf(v[q][4 * j + 1] * sc), i2 = (int)__builtin_rintf(v[q][4 * j + 2] * sc), i3 = (int)__builtin_rintf(v[q][4 * j + 3] * sc);
                        w4[j] = ((unsigned)i0 & 255u) | (((unsigned)i1 & 255u) << 8) | (((unsigned)i2 & 255u) << 16) | ((unsigned)i3 << 24); }
                    q0.x = w4[0]; q0.y = w4[1]; q1.x = w4[2]; q1.y = w4[3];
                }
                unsigned char* dst = (q & 1) ? TV8 : TU8; const int s0 = lane >> 4, o8 = 8 * (lane & 15);
                *(GAS v2u*)(dst + ((size_t)s0 * NEXP + e) * 128 + o8) = q0; *(GAS v2u*)(dst + ((size_t)(s0 + 4) * NEXP + e) * 128 + o8) = q1;
                if (lane == 0) ((q & 1) ? SV : SU)[e] = inv; } }
        }
                }
}
        if (BOTH(0)) GRID_BAR();
    }

    if (IN(1)) { for (int rep = 0; rep < NREP(1); ++rep) { if (rep) GRID_BAR();
        pg8::Gemm g{XB, Win_t, M, NIN, D}; pg8::StaticOrder S; S.init(M, NIN, G, (int)blockIdx.x);
        pg8::EpiProj E{SIX, VT, GATE, RSTD1, (DUP_MASK & 64) ? rep : 0};
        pg8::gemm_phase<pg8::EpiProj, pg8::StaticOrder, true, true>(ldsb + RING_OFF, g, S, E); }
        if (DUP_MASK & 128) { const unsigned long long t0 = __builtin_amdgcn_s_memrealtime(); while (__builtin_amdgcn_s_memrealtime() - t0 < 15000ull) __builtin_amdgcn_s_sleep(8); }
        if (BOTH(1)) GRID_BAR();
    }

    if (IN(2)) {
        for (int rep = 0; rep < NREP(2); ++rep) {
        const bool dummy = (rep + 1 < NREP(2));
        conv_phase(CBB, CCB, CUB, dummy ? XB : CBB, conv_w, conv_b, gw * 64 + lane, NGW * 64);
        for (int it = gw; it < BATCH * NH * (T / 32); it += NGW) {
            const int bh = it >> 7, qblk = it & 127;
            attn_item(QB, KB, VT, dummy ? MERGED : QB, bh >> 3, bh & 7, qblk, lane);
        }
        }
        if (BOTH(2)) GRID_BAR();
    }

    if (IN(3)) { for (int rep = 0; rep < NREP(3); ++rep) { if (rep) GRID_BAR();
        pg8::Gemm g{QB, Wab, 2 * M, 2048, 512}; pg8::PairOrder S; S.init(G, (int)blockIdx.x);
        pg8::EpiGate E{out, MERGED, GATE, GATE + (size_t)M * 1024};
        pg8::gemm_phase<pg8::EpiGate, pg8::PairOrder, true, true>(ldsb + RING_OFF, g, S, E); }
        if (BOTH(3)) GRID_BAR();
    }

    if (IN(4)) { for (int rep = 0; rep < NREP(4); ++rep) { if (rep) GRID_BAR();
        pg8::Gemm g{MERGED, Wo_t, M, D, D}; pg8::StaticOrder S; S.init(M, D, G, (int)blockIdx.x);
        pg8::EpiWo E{x, X1B};
        pg8::gemm_phase<pg8::EpiWo, pg8::StaticOrder, false, true>(ldsb + RING_OFF, g, S, E);
        }
        if (BOTH(4)) GRID_BAR();
    }

    if (IN(5)) { for (int rep = 0; rep < NREP(5); ++rep) { if (rep) GRID_BAR();
        pg8::Gemm g{X1B, Weff, M, 2048, D}; pg8::StaticOrder S; S.init(M, 2048, G, (int)blockIdx.x);
        pg8::EpiScores E{(unsigned short*)SCORES};
        pg8::gemm_phase<pg8::EpiScores, pg8::StaticOrder, true, true>(ldsb + RING_OFF, g, S, E);
        asm volatile("s_waitcnt vmcnt(0)" ::: "memory"); __syncthreads();
        int nu = 0; { pg8::Unit u; while (S.next(nu, u)) ++nu; }
        LAS unsigned char* scr = ldsb + RING_OFF + wave * 8192;
        for (int t = wave; t < nu * 4; t += NWAVES) { pg8::Unit u; S.next(t >> 2, u); route_task((const unsigned short*)SCORES, ROUTE, u.pm * 256 + (t & 3) * 64, u.pn, scr, lane); } }
        if (BOTH(5)) GRID_BAR();
    }
    const bool sliced_ok = (G % 8 == 0) && (M % ((G / 8) * NWAVES) == 0);

    if (IN(7)) {
        LAS unsigned char* scr = ldsb + RING_OFF + wave * 2048;
#ifdef DEBUG_U
        if (1) {} else
#endif
        if (sliced_ok) { const int nj = G >> 3; peer_u_phase_dot4(bx & 7, (bx >> 3) * NWAVES + wave, nj * NWAVES, M / (nj * NWAVES), ROUTE, (const float*)X1B, TU8, UPART, scr, lane); }
        else for (int s8 = 0; s8 < 8; ++s8) { const int nt = (M - 1 - gw) / NGW + 1; if (gw < M) peer_u_phase_dot4(s8, gw, NGW, nt, ROUTE, (const float*)X1B, TU8, UPART, scr, lane); }
        if (BOTH(7)) GRID_BAR();
    }

    if (IN(8)) {
#ifdef DEBUG_U
        for (int tok = gw; tok < M; tok += NGW) peer_u_debug(tok, ROUTE, out, TU8, SU, SV, WBUF, lane);
#else
        for (int tok = gw; tok < M; tok += 2 * NGW) peer_w_token2(tok, (tok + NGW < M) ? tok + NGW : tok, ROUTE, X1B, (const bf16*)UPART, SU, SV, WBUF, lane);
#endif
        if (BOTH(8)) GRID_BAR();
    }

    if (IN(9)) {
        LAS unsigned char* scr = ldsb + RING_OFF + wave * 2048;
#ifdef DEBUG_V
        for (int tok = gw; tok < M; tok += NGW) peer_v_debug(tok, ROUTE, WBUF, TV8, out, SSB, lane);
        if (0)
#endif
        if (sliced_ok) { const int nj = G >> 3; peer_v_phase(bx & 7, (bx >> 3) * NWAVES + wave, nj * NWAVES, M / (nj * NWAVES), ROUTE, WBUF, TV8, X1B, out, SSB, scr, lane); }
        else for (int s8 = 0; s8 < 8; ++s8) { const int nt = (M - 1 - gw) / NGW + 1; if (gw < M) peer_v_phase(s8, gw, NGW, nt, ROUTE, WBUF, TV8, X1B, out, SSB, scr, lane); }
        if (BOTH(9)) GRID_BAR();
    }

    if (IN(10)) {
        for (int tok = gw; tok < M; tok += NGW) {
            GAS f32x4* op = (GAS f32x4*)(out + (size_t)tok * D) + lane; const GAS f32x4* gp = (const GAS f32x4*)final_norm + lane;
            f32x4 v[4]; float s2 = 0.f;
#pragma unroll
            for (int j = 0; j < 4; ++j) { v[j] = op[64 * j]; s2 += (v[j].x * v[j].x + v[j].y * v[j].y) + (v[j].z * v[j].z + v[j].w * v[j].w); }
            const float rstd3 = 1.0f / sqrtf(wave_sum(s2) * (1.0f / D) + RMS_EPS);
#pragma unroll
            for (int j = 0; j < 4; ++j) { const f32x4 g = gp[64 * j]; f32x4 o; o.x = v[j].x * rstd3 * g.x; o.y = v[j].y * rstd3 * g.y; o.z = v[j].z * rstd3 * g.z; o.w = v[j].w * rstd3 * g.w; op[64 * j] = o; }
        }
    }
#undef IN
#undef BOTH
#undef GRID_BAR
#undef norm_mix
#undef w_in
#undef conv_w
#undef conv_b
#undef w_a
#undef w_b
#undef w_o
#undef norm_ffn
#undef w_q
#undef sub_keys
#undef exp_u
#undef exp_v
#undef final_norm
#undef Weff
#undef Wab
#undef Wo_t
#undef Win_t
#undef XB
#undef SIX
#undef VT
#undef GATE
#undef MERGED
#undef X1B
#undef TU8
#undef TV8
#undef SU
#undef SV
#undef SCORES
#undef ROUTE
#undef WBUF
#undef SSB
#undef UPART
#undef RSTD1
#undef QB
#undef CBB
#undef KB
#undef CCB
#undef CUB
}

extern "C" void kernel_launch(void* const* d_in, const int* in_sizes, int n_in, void* d_out, int out_size, void* d_ws, size_t ws_size, hipStream_t stream) {
    static int grid = 0;
    if (grid == 0) {
        if (n_in != 14 || in_sizes[0] != M * D || out_size != M * D || ws_size < WS_END) { fprintf(stderr, "kernel_launch: built for 14 inputs, x/out of %d floats, >= %zu bytes of workspace; got n_in %d, in0 %d, out %d, ws %zu; nothing launched\n", M * D, (size_t)WS_END, n_in, n_in > 0 ? in_sizes[0] : -1, out_size, ws_size); grid = -1; return; }
        int dev = 0, cus = 0, per_cu = 0;
        if (hipGetDevice(&dev) != hipSuccess || hipDeviceGetAttribute(&cus, hipDeviceAttributeMultiprocessorCount, dev) != hipSuccess) { fprintf(stderr, "kernel_launch: device query failed\n"); grid = -1; return; }
        if (hipFuncSetAttribute((const void*)hybrid_fwd, hipFuncAttributeMaxDynamicSharedMemorySize, LDS_BYTES) != hipSuccess) { fprintf(stderr, "kernel_launch: hipFuncSetAttribute failed\n"); grid = -1; return; }
        if (hipOccupancyMaxActiveBlocksPerMultiprocessor(&per_cu, (const void*)hybrid_fwd, NWAVES * 64, LDS_BYTES) != hipSuccess || per_cu < 1) { fprintf(stderr, "kernel_launch: occupancy query reports %d workgroups per CU\n", per_cu); per_cu = 1; }
        (void)hipGetLastError();
        grid = cus;
    }
    if (grid < 0) return;
    if (hipMemsetAsync((char*)d_ws + WS_CTL, 0, CTL_ZERO_BYTES, stream) != hipSuccess) { fprintf(stderr, "kernel_launch: hipMemsetAsync failed\n"); return; }
    Args a{};
    for (int i = 0; i < 14; ++i) a.in[i] = (const float*)d_in[i];
    a.out = (float*)d_out; a.ws = (unsigned char*)d_ws;
#ifdef PROBE_SEQ
    const int seq[] = PROBE_SEQ; const int nseq = (int)(sizeof(seq) / sizeof(int));
#else
    const int seq[] = {0, 1, 2, 3, 4, 5, 6, 7, 8, 9, 10}; const int nseq = (N_LAUNCHES == 1) ? 1 : 11;
#endif
    for (int li = 0; li < nseq; ++li) {
        a.ph_lo = (N_LAUNCHES == 1) ? 0 : seq[li]; a.ph_hi = (N_LAUNCHES == 1) ? N_PHASES : seq[li] + 1; a.li = li;
        hipLaunchKernelGGL(hybrid_fwd, dim3(grid), dim3(NWAVES * 64), LDS_BYTES, stream, a);
        const hipError_t le = hipPeekAtLastError();
        if (le != hipSuccess) { fprintf(stderr, "kernel_launch: launch %d failed: %s\n", li, hipGetErrorName(le)); break; }
    }
}
```

```cpp
#define DUP_MASK 0
#include <hip/hip_runtime.h>
#include <cstdio>
#include <cstdint>
#include <cmath>
namespace pg8 {
#define PG8_LAS __attribute__((address_space(3)))
typedef unsigned short bf16_t;
typedef short bf16x8 __attribute__((ext_vector_type(8)));
typedef float f32x4 __attribute__((ext_vector_type(4)));
typedef unsigned u32x4 __attribute__((ext_vector_type(4)));
constexpr int BM = 256, BK = 64, HALF = 128, HTB = HALF * BK * 2  , STAGE_BYTES = 8 * HTB, NXCD = 8, WGM = 8;

__host__ __device__ __forceinline__ int lds_byte(int r, int c) { const int st = (r >> 4) * 2 + (c >> 5), rr = r & 15, cc = c & 31, ob = rr * 64 + cc * 2; return st * 1024 + (ob ^ (((ob >> 9) & 1) << 5)); }
__host__ __device__ __forceinline__ void stage_rc(int b, int& R, int& C) { const int st = b / 1024, sb = b % 1024, swz = sb ^ (((sb >> 9) & 1) << 5); R = (st >> 1) * 16 + swz / 64; C = (st & 1) * 32 + (swz % 64) / 2; }
__host__ __device__ __forceinline__ int perm32(int rho) { const int n = rho >> 4, i = rho & 15; return 8 * (i >> 2) + 4 * n + (i & 3); }

struct Unit { int pm, pn; };
struct Gemm { const bf16_t* A; const bf16_t* Bt; int M, N, K; };

struct StaticOrder {
    int nM, nN, nwg, G, c;
    __host__ __device__ void init(int M, int N, int G_, int c_) { nM = M / BM; nN = N / BM; nwg = nM * nN; G = G_; c = c_; }
    __host__ __device__ bool next(int i, Unit& u) const {
        const long L = (long)i * G + c; if (L >= nwg) return false;
        int wgid = (int)L; { const int q = nwg / NXCD, r = nwg % NXCD, xcd = wgid % NXCD, off = wgid / NXCD; wgid = (xcd < r ? xcd * (q + 1) : r * (q + 1) + (xcd - r) * q) + off; }
        const int nig = WGM * nN, gid = wgid / nig, fm = gid * WGM, gsz = (nM - fm) < WGM ? (nM - fm) : WGM;
        u.pm = fm + ((wgid % nig) % gsz); u.pn = (wgid % nig) / gsz; return true;
    }
    __device__ __forceinline__ void a_ready(const Unit&) const {}
    __device__ __forceinline__ void done(const Unit&) const {}
};

__device__ __forceinline__ unsigned cvt_pk_bf16(float lo, float hi) { unsigned r; asm volatile("v_cvt_pk_bf16_f32 %0, %1, %2" : "=v"(r) : "v"(lo), "v"(hi)); return r; }
constexpr int MTOK = 16384;
__device__ __forceinline__ unsigned f2bf_rne(float f) { unsigned u = __builtin_bit_cast(unsigned, f); return (u + 0x7fffu + ((u >> 16) & 1u)) >> 16; }
__device__ __forceinline__ float bf_lo(unsigned w) { return __builtin_bit_cast(float, w << 16); }
__device__ __forceinline__ float bf_hi(unsigned w) { return __builtin_bit_cast(float, w & 0xffff0000u); }
__device__ __forceinline__ float sigmoid_fast(float x) { return __builtin_amdgcn_rcpf(1.0f + __builtin_amdgcn_exp2f(-1.4426950408889634f * x)); }

struct EpiProj {
    static constexpr bool PERM = true, AFTER_DRAIN = false;
    bf16_t* six;
    bf16_t* vt;
    bf16_t* gate;
    const float* rstd; int skip;
    __device__ __forceinline__ void operator()(const f32x4 (&acc)[2][2][4][2], const Unit& u, int wr, int wc, int fr, int fq) const {
        const int row0 = u.pm * BM + wr * 64 + fr; const int colt = u.pn * BM;
        if (skip) return;
        if (colt < 3072) {
            const int t = colt >> 9, cc = colt & 511;
            if (t == 2) {
#pragma unroll
                for (int ai = 0; ai < 2; ++ai)
#pragma unroll
                    for (int m = 0; m < 4; ++m) { const int r = row0 + ai * HALF + m * 16; const float rs = rstd[r]; const int b = r >> 12, tt = r & 4095;
#pragma unroll
                        for (int bj = 0; bj < 2; ++bj) { const int c0 = cc + bj * HALF + wc * 32 + 8 * fq; const int hh = c0 >> 6, d0 = c0 & 63;
                            bf16_t* p = vt + ((size_t)((b * 8 + hh) * 64 + d0)) * 4096 + tt;
#pragma unroll
                            for (int n = 0; n < 2; ++n)
#pragma unroll
                                for (int i = 0; i < 4; ++i) p[(size_t)(4 * n + i) * 4096] = (bf16_t)f2bf_rne(acc[ai][bj][m][n][i] * rs); } }
            } else {
                const int bufidx = (t == 0) ? 0 : (t == 1) ? 2 : (t == 3) ? 1 : t;
                bf16_t* base = six + (size_t)bufidx * MTOK * 512; const float sc = (t == 0) ? 0.125f : 1.0f;
                const int col0 = cc + wc * 32 + 8 * fq;
#pragma unroll
                for (int ai = 0; ai < 2; ++ai)
#pragma unroll
                    for (int m = 0; m < 4; ++m) { const int r = row0 + ai * HALF + m * 16; const float rs = rstd[r] * sc; bf16_t* rowp = base + (size_t)r * 512 + col0;
#pragma unroll
                        for (int bj = 0; bj < 2; ++bj) { const f32x4 v0 = acc[ai][bj][m][0] * rs, v1 = acc[ai][bj][m][1] * rs;
                            u32x4 w; w.x = cvt_pk_bf16(v0[0], v0[1]); w.y = cvt_pk_bf16(v0[2], v0[3]); w.z = cvt_pk_bf16(v1[0], v1[1]); w.w = cvt_pk_bf16(v1[2], v1[3]);
                            *(u32x4*)(rowp + bj * HALF) = w; } }
            }
        } else {
            const int gi = (colt - 3072) >> 10, cc = (colt - 3072) & 1023;
            bf16_t* base = gate + (size_t)gi * MTOK * 1024; const int col0 = cc + wc * 32 + 8 * fq;
#pragma unroll
            for (int ai = 0; ai < 2; ++ai)
#pragma unroll
                for (int m = 0; m < 4; ++m) { const int r = row0 + ai * HALF + m * 16; const float rs = rstd[r]; bf16_t* rowp = base + (size_t)r * 1024 + col0;
#pragma unroll
                    for (int bj = 0; bj < 2; ++bj) { f32x4 v0 = acc[ai][bj][m][0] * rs, v1 = acc[ai][bj][m][1] * rs;
#pragma unroll
                        for (int i = 0; i < 4; ++i) { v0[i] = sigmoid_fast(v0[i]); v1[i] = sigmoid_fast(v1[i]); }
                        u32x4 w; w.x = cvt_pk_bf16(v0[0], v0[1]); w.y = cvt_pk_bf16(v0[2], v0[3]); w.z = cvt_pk_bf16(v1[0], v1[1]); w.w = cvt_pk_bf16(v1[2], v1[3]);
                        *(u32x4*)(rowp + bj * HALF) = w; } }
        }
    }
};

struct EpiGate {
    static constexpr bool PERM = true, AFTER_DRAIN = false;
    float* P; bf16_t* merged; const bf16_t* g0; const bf16_t* g1;
    __device__ __forceinline__ void operator()(const f32x4 (&acc)[2][2][4][2], const Unit& u, int wr, int wc, int fr, int fq) const {
        const int which = (u.pm >= 64) ? 1 : 0; const int pm = u.pm - 64 * which, pn = u.pn - 4 * which;
        const int row0 = pm * BM + wr * 64 + fr, col0 = pn * BM + wc * 32 + 8 * fq; const bf16_t* g = which ? g1 : g0;
#pragma unroll
        for (int ai = 0; ai < 2; ++ai)
#pragma unroll
            for (int m = 0; m < 4; ++m) { const int r = row0 + ai * HALF + m * 16;
#pragma unroll
                for (int bj = 0; bj < 2; ++bj) { const size_t off = (size_t)r * 1024 + col0 + bj * HALF;
                    const u32x4 gv = *(const u32x4*)(g + off);
                    f32x4 a0 = acc[ai][bj][m][0], a1 = acc[ai][bj][m][1];
                    a0[0] *= bf_lo(gv.x); a0[1] *= bf_hi(gv.x); a0[2] *= bf_lo(gv.y); a0[3] *= bf_hi(gv.y);
                    a1[0] *= bf_lo(gv.z); a1[1] *= bf_hi(gv.z); a1[2] *= bf_lo(gv.w); a1[3] *= bf_hi(gv.w);
                    if (!which) { u32x4 w; w.x = cvt_pk_bf16(a0[0], a0[1]); w.y = cvt_pk_bf16(a0[2], a0[3]); w.z = cvt_pk_bf16(a1[0], a1[1]); w.w = cvt_pk_bf16(a1[2], a1[3]); *(u32x4*)((bf16_t*)P + off) = w; }
                    else { const u32x4 pw = *(const u32x4*)((const bf16_t*)P + off);
                        a0[0] += bf_lo(pw.x); a0[1] += bf_hi(pw.x); a0[2] += bf_lo(pw.y); a0[3] += bf_hi(pw.y); a1[0] += bf_lo(pw.z); a1[1] += bf_hi(pw.z); a1[2] += bf_lo(pw.w); a1[3] += bf_hi(pw.w);
                        u32x4 w; w.x = cvt_pk_bf16(a0[0], a0[1]); w.y = cvt_pk_bf16(a0[2], a0[3]); w.z = cvt_pk_bf16(a1[0], a1[1]); w.w = cvt_pk_bf16(a1[2], a1[3]);
                        *(u32x4*)(merged + off) = w; } } }
    }
};
struct PairOrder {
    StaticOrder so;
    __host__ __device__ void init(int G_, int c_) { so.init(MTOK, 1024, G_, c_); }
    __host__ __device__ bool next(int i, Unit& u) const { Unit t; if (!so.next(i >> 1, t)) return false; const int w = i & 1; u.pm = t.pm + 64 * w; u.pn = t.pn + 4 * w; return true; }
    __device__ __forceinline__ void a_ready(const Unit&) const {}
    __device__ __forceinline__ void done(const Unit&) const {}
};

struct EpiWo {
    static constexpr bool PERM = true, AFTER_DRAIN = false;
    const float* x; bf16_t* x1b;
    __device__ __forceinline__ void operator()(const f32x4 (&acc)[2][2][4][2], const Unit& u, int wr, int wc, int fr, int fq) const {
        const int row0 = u.pm * BM + wr * 64 + fr, col0 = u.pn * BM + wc * 32 + 8 * fq;
#pragma unroll
        for (int ai = 0; ai < 2; ++ai)
#pragma unroll
            for (int m = 0; m < 4; ++m) { const int r = row0 + ai * HALF + m * 16;
#pragma unroll
                for (int bj = 0; bj < 2; ++bj) { const size_t off = (size_t)r * 1024 + col0 + bj * HALF;
                    const f32x4 a0 = acc[ai][bj][m][0] + *(const f32x4*)(x + off), a1 = acc[ai][bj][m][1] + *(const f32x4*)(x + off + 4);
                    u32x4 w; w.x = cvt_pk_bf16(a0[0], a0[1]); w.y = cvt_pk_bf16(a0[2], a0[3]); w.z = cvt_pk_bf16(a1[0], a1[1]); w.w = cvt_pk_bf16(a1[2], a1[3]);
                    *(u32x4*)(x1b + off) = w; } }
    }
};
typedef _Float16 f16x2_t __attribute__((ext_vector_type(2)));
typedef float f32x2e __attribute__((ext_vector_type(2)));
__device__ __forceinline__ unsigned pk_f16(float lo, float hi) { f32x2e v = {lo, hi}; f16x2_t h = __builtin_convertvector(v, f16x2_t); return __builtin_bit_cast(unsigned, h); }
struct EpiScores {
    static constexpr bool PERM = true, AFTER_DRAIN = false;
    unsigned short* S;
    __device__ __forceinline__ void operator()(const f32x4 (&acc)[2][2][4][2], const Unit& u, int wr, int wc, int fr, int fq) const {
        const int row0 = u.pm * BM + wr * 64 + fr, col0 = u.pn * BM + wc * 32 + 8 * fq;
#pragma unroll
        for (int ai = 0; ai < 2; ++ai)
#pragma unroll
            for (int m = 0; m < 4; ++m) { const int r = row0 + ai * HALF + m * 16;
#pragma unroll
                for (int bj = 0; bj < 2; ++bj) { const size_t off = ((size_t)((col0 + bj * HALF) >> 3) * MTOK + r) * 8;
                    const f32x4 a0 = acc[ai][bj][m][0], a1 = acc[ai][bj][m][1];
                    u32x4 w; w.x = pk_f16(a0[0], a0[1]); w.y = pk_f16(a0[2], a0[3]); w.z = pk_f16(a1[0], a1[1]); w.w = pk_f16(a1[2], a1[3]);
                    *(u32x4*)(S + off) = w; } }
    }
};
template <class Epi, class Sched, bool ALIGN_EPI = false, bool SP2 = false>
__device__ __forceinline__ void gemm_phase(PG8_LAS unsigned char* lds, const Gemm g, const Sched& S, const Epi& E) {
    const int tid = threadIdx.x, wid = __builtin_amdgcn_readfirstlane(tid >> 6), lane = tid & 63, wr = wid >> 2, wc = wid & 3, fr = lane & 15, fq = lane >> 4;
    const int K = g.K, nt = K / BK;
    unsigned voffA[2], voffB[2];
#pragma unroll
    for (int i = 0; i < 2; ++i) { int R, C; stage_rc(tid * 16 + i * 8192, R, C); const int Rb = Epi::PERM ? ((R & ~31) + perm32(R & 31)) : R;
        voffA[i] = (unsigned)(R * K + C) * 2u; voffB[i] = (unsigned)(Rb * K + C) * 2u; }
    const size_t kstep = (size_t)(BK * 2);
    const size_t hstep = (size_t)HALF * K * 2;
    const size_t tstep = 2 * hstep;
    const unsigned ldsw = (unsigned)wid * 1024u;
    const int aoff = lds_byte(wr * 64 + fr, fq * 8), boff = lds_byte(wc * 32 + fr, fq * 8);
#define PG8_SA(b, h) (((b) * 2 + (h)) * HTB)
#define PG8_SB(b, h) ((4 + (b) * 2 + (h)) * HTB)
#define PG8_STAGE(bufoff, gbase, voff) do { _Pragma("unroll") for (int _i = 0; _i < 2; ++_i) \
        __builtin_amdgcn_global_load_lds((const unsigned*)((const char*)(gbase) + (voff)[_i]), (PG8_LAS unsigned*)(lds + (bufoff) + ldsw + _i * 8192), 16, 0, 0); } while (0)
#define PG8_LDA(dst, b, h) do { _Pragma("unroll") for (int m = 0; m < 4; ++m) _Pragma("unroll") for (int k = 0; k < 2; ++k) dst[m][k] = *(const PG8_LAS bf16x8*)(lds + PG8_SA(b, h) + aoff + m * 2048 + k * 1024); } while (0)
#define PG8_LDB(dst, b, h) do { _Pragma("unroll") for (int n = 0; n < 2; ++n) _Pragma("unroll") for (int k = 0; k < 2; ++k) dst[n][k] = *(const PG8_LAS bf16x8*)(lds + PG8_SB(b, h) + boff + n * 2048 + k * 1024); } while (0)
#define PG8_MMA(ai, bj, At, Bt) do { __builtin_amdgcn_s_setprio(1); _Pragma("unroll") for (int m = 0; m < 4; ++m) _Pragma("unroll") for (int n = 0; n < 2; ++n) _Pragma("unroll") for (int k = 0; k < 2; ++k) \
        acc[ai][bj][m][n] = __builtin_amdgcn_mfma_f32_16x16x32_bf16(Bt[n][k], At[m][k], acc[ai][bj][m][n], 0, 0, 0); __builtin_amdgcn_s_setprio(0); } while (0)
#define PG8_WAIT_V(n) asm volatile("s_waitcnt vmcnt(" #n ")" ::: "memory")
#define PG8_WAIT_L(n) asm volatile("s_waitcnt lgkmcnt(" #n ")" ::: "memory")
#define PG8_BAR __builtin_amdgcn_s_barrier()
#define PG8_SCHED __builtin_amdgcn_sched_barrier(0)
    Unit cur, nxt; int ui = 0;
    if (!S.next(0, cur)) return;
    f32x4 acc[2][2][4][2];
#pragma unroll
    for (int a = 0; a < 2; ++a)
#pragma unroll
        for (int b = 0; b < 2; ++b)
#pragma unroll
            for (int m = 0; m < 4; ++m)
#pragma unroll
                for (int n = 0; n < 2; ++n) acc[a][b][m][n] = (f32x4){0.f, 0.f, 0.f, 0.f};
    bf16x8 At[4][2], B0[2][2], B1[2][2];
    const char* cA = (const char*)g.A + (size_t)cur.pm * tstep; const char* cB = (const char*)g.Bt + (size_t)cur.pn * tstep;
    S.a_ready(cur);
    if constexpr (SP2) {
        PG8_STAGE(PG8_SB(0, 0), cB, voffB); PG8_STAGE(PG8_SB(0, 1), cB + hstep, voffB); PG8_STAGE(PG8_SA(0, 0), cA, voffA); PG8_STAGE(PG8_SA(0, 1), cA + hstep, voffA);
        if (wr == 1) PG8_BAR;
        PG8_WAIT_V(2); PG8_BAR;
        PG8_STAGE(PG8_SB(1, 0), cB + kstep, voffB); PG8_STAGE(PG8_SA(1, 0), cA + kstep, voffA); PG8_STAGE(PG8_SB(1, 1), cB + hstep + kstep, voffB);
        PG8_WAIT_V(6); PG8_BAR;
    } else {
        PG8_STAGE(PG8_SB(0, 0), cB, voffB); PG8_STAGE(PG8_SA(0, 0), cA, voffA); PG8_STAGE(PG8_SB(0, 1), cB + hstep, voffB); PG8_STAGE(PG8_SA(0, 1), cA + hstep, voffA);
        if (wr == 1) PG8_BAR;
        PG8_WAIT_V(4); PG8_BAR;
        PG8_STAGE(PG8_SB(1, 0), cB + kstep, voffB); PG8_STAGE(PG8_SA(1, 0), cA + kstep, voffA); PG8_STAGE(PG8_SB(1, 1), cB + hstep + kstep, voffB);
        PG8_WAIT_V(6); PG8_BAR;
    }
    for (;;) {
        const bool has_next = S.next(ui + 1, nxt);
        const char* nA = has_next ? (const char*)g.A + (size_t)nxt.pm * tstep : cA; const char* nB = has_next ? (const char*)g.Bt + (size_t)nxt.pn * tstep : cB;
        for (int t = 0; t < nt; t += 2) {
            const bool last = (t == nt - 2);
            const char* a1 = cA + (size_t)(t + 1) * kstep;
            const char* a2 = last ? nA : cA + (size_t)(t + 2) * kstep; const char* b2 = last ? nB : cB + (size_t)(t + 2) * kstep;
            const char* a3 = a2 + kstep; const char* b3 = b2 + kstep;
            if (last && has_next) S.a_ready(nxt);
            if constexpr (SP2) {
            PG8_LDB(B0, 0, 0); PG8_LDB(B1, 0, 1); PG8_SCHED; PG8_LDA(At, 0, 0); PG8_STAGE(PG8_SA(1, 1), a1 + hstep, voffA);
            PG8_WAIT_V(8); PG8_WAIT_L(0); PG8_BAR; PG8_MMA(0, 0, At, B0); PG8_MMA(0, 1, At, B1); PG8_BAR; PG8_SCHED;
            PG8_LDA(At, 0, 1); PG8_STAGE(PG8_SB(0, 0), b2, voffB); PG8_STAGE(PG8_SB(0, 1), b2 + hstep, voffB); PG8_STAGE(PG8_SA(0, 0), a2, voffA);
            PG8_WAIT_V(8); PG8_WAIT_L(0); PG8_BAR; PG8_MMA(1, 0, At, B0); PG8_MMA(1, 1, At, B1); PG8_BAR; PG8_SCHED;
            PG8_LDB(B0, 1, 0); PG8_LDB(B1, 1, 1); PG8_SCHED; PG8_LDA(At, 1, 0); PG8_STAGE(PG8_SA(0, 1), a2 + hstep, voffA);
            PG8_WAIT_V(8); PG8_WAIT_L(0); PG8_BAR; PG8_MMA(0, 0, At, B0); PG8_MMA(0, 1, At, B1); PG8_BAR; PG8_SCHED;
            PG8_LDA(At, 1, 1); PG8_STAGE(PG8_SB(1, 0), b3, voffB); PG8_STAGE(PG8_SB(1, 1), b3 + hstep, voffB); PG8_STAGE(PG8_SA(1, 0), a3, voffA);
            PG8_WAIT_V(8); PG8_WAIT_L(0); PG8_BAR; PG8_MMA(1, 0, At, B0); PG8_MMA(1, 1, At, B1); PG8_BAR; PG8_SCHED;
            } else {
            PG8_LDB(B0, 0, 0); PG8_SCHED; PG8_LDA(At, 0, 0); PG8_STAGE(PG8_SA(1, 1), a1 + hstep, voffA);
            PG8_WAIT_L(8); PG8_BAR; PG8_WAIT_L(0); PG8_MMA(0, 0, At, B0); PG8_BAR; PG8_SCHED;
            PG8_LDB(B1, 0, 1); PG8_STAGE(PG8_SB(0, 0), b2, voffB);
            PG8_BAR; PG8_WAIT_L(0); PG8_MMA(0, 1, At, B1); PG8_BAR;
            PG8_LDA(At, 0, 1); PG8_STAGE(PG8_SA(0, 0), a2, voffA);
            PG8_BAR; PG8_WAIT_L(0); PG8_MMA(1, 0, At, B0); PG8_BAR; PG8_SCHED;
            PG8_STAGE(PG8_SB(0, 1), b2 + hstep, voffB);
            PG8_WAIT_V(6); PG8_BAR; PG8_MMA(1, 1, At, B1); PG8_BAR;
            PG8_LDB(B0, 1, 0); PG8_SCHED; PG8_LDA(At, 1, 0); PG8_STAGE(PG8_SA(0, 1), a2 + hstep, voffA);
            PG8_WAIT_L(8); PG8_BAR; PG8_WAIT_L(0); PG8_MMA(0, 0, At, B0); PG8_BAR; PG8_SCHED;
            PG8_LDB(B1, 1, 1); PG8_STAGE(PG8_SB(1, 0), b3, voffB);
            PG8_BAR; PG8_WAIT_L(0); PG8_MMA(0, 1, At, B1); PG8_BAR;
            PG8_LDA(At, 1, 1); PG8_STAGE(PG8_SA(1, 0), a3, voffA);
            PG8_BAR; PG8_WAIT_L(0); PG8_MMA(1, 0, At, B0); PG8_BAR; PG8_SCHED;
            PG8_STAGE(PG8_SB(1, 1), b3 + hstep, voffB);
            PG8_WAIT_V(6); PG8_BAR; PG8_MMA(1, 1, At, B1); PG8_BAR;
            }
        }
        if constexpr (ALIGN_EPI) { if (wr == 0) PG8_BAR; }
        if constexpr (!Epi::AFTER_DRAIN) { E(acc, cur, wr, wc, fr, fq); S.done(cur); }
        if (!has_next) break;
#pragma unroll
        for (int a = 0; a < 2; ++a)
#pragma unroll
            for (int b = 0; b < 2; ++b)
#pragma unroll
                for (int m = 0; m < 4; ++m)
#pragma unroll
                    for (int n = 0; n < 2; ++n) acc[a][b][m][n] = (f32x4){0.f, 0.f, 0.f, 0.f};
        cur = nxt; cA = nA; cB = nB; ++ui;
        if constexpr (ALIGN_EPI) { if (wr == 1) PG8_BAR; }
    }
    PG8_WAIT_V(0);
    if constexpr (!ALIGN_EPI) { if (wr == 0) PG8_BAR; }
    PG8_BAR;
    if constexpr (Epi::AFTER_DRAIN) { E.fused(acc, cur, wr, wc, fr, fq, lds, wid, lane); S.done(cur); }
#undef PG8_SA
#undef PG8_SB
#undef PG8_STAGE
#undef PG8_LDA
#undef PG8_LDB
#undef PG8_MMA
#undef PG8_WAIT_V
#undef PG8_WAIT_L
#undef PG8_BAR
#undef PG8_SCHED
}
}

constexpr int NWAVES = 8;
constexpr int BATCH = 4, T = 4096, D = 1024, NH = 8, HD = 64, NIN = 5120;
constexpr int M = BATCH * T;
constexpr int NEXP = 16384;
constexpr float RMS_EPS = 1e-6f;
#ifndef MK_N_LAUNCHES
#define MK_N_LAUNCHES 1
#endif
constexpr int N_PHASES = 11;
constexpr int N_LAUNCHES = MK_N_LAUNCHES;

constexpr size_t MiB = 1u << 20;
constexpr size_t WS_CTL = 0, CTL_ZERO_BYTES = 64 * 1024;
constexpr size_t WS_RSTD1 = 512 * 1024;
constexpr size_t WS_WEFF = 1 * MiB;
constexpr size_t WS_WAB = 5 * MiB;
constexpr size_t WS_WO = 7 * MiB;
constexpr size_t WS_WIN = 9 * MiB;
constexpr size_t WS_XB = 19 * MiB;
constexpr size_t WS_SIX = 51 * MiB;
constexpr size_t WS_VT = WS_SIX + 3 * 16 * MiB;
constexpr size_t WS_GATE = 147 * MiB;
constexpr size_t WS_MERGED = 19 * MiB;
constexpr size_t WS_X1B = 51 * MiB;
constexpr size_t WS_TU = 211 * MiB, WS_TV = 227 * MiB;
constexpr size_t WS_SU = 576 * 1024, WS_SV = 640 * 1024;
constexpr size_t WS_SCORES = 83 * MiB;
constexpr size_t WS_ROUTE = 19 * MiB;
constexpr size_t WS_W = 35 * MiB;
constexpr size_t WS_SS = 43 * MiB;
constexpr size_t WS_UPART = 83 * MiB;
constexpr size_t WS_END = 256 * MiB;
constexpr int CW_BAR = 4096;

constexpr int RING_OFF = 0, RING_BYTES = 131072;
constexpr int LDSCTL_OFF = RING_BYTES;
constexpr int LDS_BYTES = 147456;
constexpr int MISC_OFF = LDS_BYTES - 128;

#define GAS __attribute__((address_space(1)))
#define LAS __attribute__((address_space(3)))
#define CAS __attribute__((address_space(4)))
typedef unsigned short bf16;
typedef unsigned v4u __attribute__((ext_vector_type(4)));
typedef unsigned v2u __attribute__((ext_vector_type(2)));
typedef float f32x4 __attribute__((ext_vector_type(4)));
typedef float f32x2 __attribute__((ext_vector_type(2)));
typedef float f32x16 __attribute__((ext_vector_type(16)));
typedef short bf16x8 __attribute__((ext_vector_type(8)));
typedef _Float16 f16x8 __attribute__((ext_vector_type(8)));
typedef _Float16 f16x2 __attribute__((ext_vector_type(2)));
typedef __bf16 bf16x2_t __attribute__((ext_vector_type(2)));
typedef GAS unsigned gu32;
#define RLX_AGENT __ATOMIC_RELAXED, __HIP_MEMORY_SCOPE_AGENT
#define LDS_WAIT() asm volatile("s_waitcnt lgkmcnt(0)" ::: "memory")
#define VM_WAIT() asm volatile("s_waitcnt vmcnt(0)" ::: "memory")
__device__ __forceinline__ unsigned f2bf(float f) { unsigned u = __builtin_bit_cast(unsigned, f); return (u + 0x7fffu + ((u >> 16) & 1u)) >> 16; }
__device__ __forceinline__ unsigned pk2(float lo, float hi) { return f2bf(lo) | (f2bf(hi) << 16); }
__device__ __forceinline__ unsigned cvtpk(float lo, float hi) { f32x2 v = {lo, hi}; bf16x2_t b = __builtin_convertvector(v, bf16x2_t); return __builtin_bit_cast(unsigned, b); }
__device__ __forceinline__ float bflo(unsigned w) { return __builtin_bit_cast(float, w << 16); }
__device__ __forceinline__ float bfhi(unsigned w) { return __builtin_bit_cast(float, w & 0xffff0000u); }
__device__ __forceinline__ float wave_sum(float v) {
#pragma unroll
    for (int o = 1; o < 64; o <<= 1) v += __shfl_xor(v, o);
    return v;
}
#define XB_TMO      128
#define XB_XCNT(j)  (256  + 64 * (j))
#define XB_XSUB(j)  (1280 + 64 * (j))
#define XB_XGEN(j)  (2304 + 64 * (j))
#define XB_TOP      3328
#define XB_TOPGEN   3392
#define XCD_BAR_WORDS 3456
#define XB_SPIN_CAP (1u << 18)

__device__ __forceinline__ unsigned xb_ld(unsigned* p)              { return __hip_atomic_load(p, __ATOMIC_RELAXED, __HIP_MEMORY_SCOPE_AGENT); }
__device__ __forceinline__ unsigned xb_add(unsigned* p, unsigned v) { return __hip_atomic_fetch_add(p, v, __ATOMIC_RELAXED, __HIP_MEMORY_SCOPE_AGENT); }
__device__ __forceinline__ unsigned xb_xcc_id() { return (unsigned)__builtin_amdgcn_s_getreg((3 << 11) | 20) & 0xFu; }
#define XB_SPIN(cond, bar) do { unsigned _sp = 0; while (cond) { __builtin_amdgcn_s_sleep(1); \
    if ((++_sp & 255u) == 0u) { if (xb_ld(&(bar)[XB_TMO])) break; if (_sp > XB_SPIN_CAP) { atomicAdd(&(bar)[XB_TMO], 1u); break; } } } } while (0)

struct XcdBarrier {
    unsigned* bar; unsigned x;
    volatile LAS unsigned* st;
};

__device__ __forceinline__ XcdBarrier xcd_barrier_post(unsigned* bar, volatile LAS unsigned* st) {
    XcdBarrier b; b.bar = bar; b.x = xb_xcc_id(); b.st = st;
    if (threadIdx.x == 0) (void)xb_add(&bar[XB_XCNT(b.x)], 1u);
    return b;
}
__device__ __forceinline__ void xcd_barrier_complete(unsigned* bar, unsigned x, unsigned& nloc, unsigned& nx) {
    const unsigned G = gridDim.x * gridDim.y * gridDim.z;
    unsigned sum, cnt, mine, sp = 0u;
    for (;;) {
        sum = 0u; cnt = 0u; mine = 0u;
#pragma unroll
        for (unsigned j = 0; j < 16; ++j) { const unsigned c = xb_ld(&bar[XB_XCNT(j)]); sum += c; cnt += (c > 0u) ? 1u : 0u; mine = (j == x) ? c : mine; }
        if (sum == G) break;
        __builtin_amdgcn_s_sleep(1);
        if ((++sp & 255u) == 0u) { if (xb_ld(&bar[XB_TMO])) break; if (sp > XB_SPIN_CAP) { atomicAdd(&bar[XB_TMO], 1u); break; } }
    }
    nloc = mine > 0u ? mine : 1u; nx = cnt > 0u ? cnt : 1u;
}

__device__ __forceinline__ void xcd_barrier(const XcdBarrier& b) {
    asm volatile("s_waitcnt vmcnt(0)" ::: "memory");
    __syncthreads();
    if (threadIdx.x == 0) {
        unsigned* bar = b.bar;
        __builtin_amdgcn_s_waitcnt(0);
        unsigned nloc = b.st[0], nx = b.st[1];
        if (nloc == 0u) { xcd_barrier_complete(bar, b.x, nloc, nx); b.st[0] = nloc; b.st[1] = nx; }
        const unsigned old = xb_add(&bar[XB_XSUB(b.x)], 1u);
        const unsigned gen = old / nloc;
        if (old + 1u == (gen + 1u) * nloc) {
            __builtin_amdgcn_fence(__ATOMIC_RELEASE, "agent");
            asm volatile("s_waitcnt vmcnt(0)" ::: "memory");
            const unsigned og = xb_add(&bar[XB_TOP], 1u);
            const unsigned tg = og / nx;
            if (og + 1u == (tg + 1u) * nx) xb_add(&bar[XB_TOPGEN], 1u);
            else XB_SPIN(xb_ld(&bar[XB_TOPGEN]) == tg, bar);
            __builtin_amdgcn_fence(__ATOMIC_ACQUIRE, "agent");
            xb_add(&bar[XB_XGEN(b.x)], 1u);
            asm volatile("s_waitcnt vmcnt(0)" ::: "memory");
        } else {
            XB_SPIN(xb_ld(&bar[XB_XGEN(b.x)]) == gen, bar);
            __builtin_amdgcn_fence(__ATOMIC_ACQUIRE, "agent");
            asm volatile("s_waitcnt vmcnt(0)" ::: "memory");
        }
    }
    __syncthreads();
}

__device__ __forceinline__ void p0_transpose_item(const float* W, int K, int N, bf16* WT, int row_off, const float* kscale, LAS float* scr, int item, int lane) {
    const int nblk = N / 32, kb = item / nblk, nb = item % nblk, k0 = 64 * kb, n0 = 32 * nb;
#pragma unroll 8
    for (int i = 0; i < 32; ++i) { const int kk = 2 * i + (lane >> 5); scr[kk * 33 + (lane & 31)] = W[(size_t)(k0 + kk) * N + n0 + (lane & 31)]; }
    LDS_WAIT(); asm volatile("" ::: "memory");
    const int c = lane & 7;
    float ks[8];
#pragma unroll
    for (int i = 0; i < 8; ++i) ks[i] = kscale ? kscale[k0 + 8 * c + i] : 1.0f;
#pragma unroll
    for (int j = 0; j < 4; ++j) { const int n = (lane >> 3) + 8 * j; const LAS float* s = scr + (8 * c) * 33 + n;
        v4u o; o.x = pk2(s[0 * 33] * ks[0], s[1 * 33] * ks[1]); o.y = pk2(s[2 * 33] * ks[2], s[3 * 33] * ks[3]); o.z = pk2(s[4 * 33] * ks[4], s[5 * 33] * ks[5]); o.w = pk2(s[6 * 33] * ks[6], s[7 * 33] * ks[7]);
        *(GAS v4u*)(WT + (size_t)(row_off + n0 + n) * K + k0 + 8 * c) = o; }
    LDS_WAIT(); asm volatile("" ::: "memory");
}

__device__ __forceinline__ void conv_phase(const bf16* CB, const bf16* CC, const bf16* CU, bf16* CO, const float* cw, const float* cbias, int gtid, int nthreads) {
    for (int task = gtid; task < M * 64; task += nthreads) {
        const int tok = task >> 6, c8 = (task & 63) * 8, tt = tok & (T - 1);
        const size_t off = (size_t)tok * 512 + c8;
        float z[3][8];
#pragma unroll
        for (int k = 0; k < 3; ++k) {
            const int dt = 2 - k;
            if (tt >= dt) { const v4u a = *(const GAS v4u*)(CC + off - (size_t)dt * 512), b = *(const GAS v4u*)(CU + off - (size_t)dt * 512);
                z[k][0] = bflo(a.x) * bflo(b.x); z[k][1] = bfhi(a.x) * bfhi(b.x); z[k][2] = bflo(a.y) * bflo(b.y); z[k][3] = bfhi(a.y) * bfhi(b.y);
                z[k][4] = bflo(a.z) * bflo(b.z); z[k][5] = bfhi(a.z) * bfhi(b.z); z[k][6] = bflo(a.w) * bflo(b.w); z[k][7] = bfhi(a.w) * bfhi(b.w); }
            else {
#pragma unroll
                for (int i = 0; i < 8; ++i) z[k][i] = 0.f; }
        }
        float y[8];
#pragma unroll
        for (int i = 0; i < 8; ++i) y[i] = cbias[c8 + i];
#pragma unroll
        for (int k = 0; k < 3; ++k)
#pragma unroll
            for (int i = 0; i < 8; ++i) y[i] += cw[k * 512 + c8 + i] * z[k][i];
        const v4u g = *(const GAS v4u*)(CB + off);
        v4u o; o.x = pk2(bflo(g.x) * y[0], bfhi(g.x) * y[1]); o.y = pk2(bflo(g.y) * y[2], bfhi(g.y) * y[3]); o.z = pk2(bflo(g.z) * y[4], bfhi(g.z) * y[5]); o.w = pk2(bflo(g.w) * y[6], bfhi(g.w) * y[7]);
        *(GAS v4u*)(CO + off) = o;
    }
}

__device__ __forceinline__ int crow(int r, int hf) { return (r & 3) + 8 * (r >> 2) + 4 * hf; }
#define MFMA_BF16(a, b, c) __builtin_amdgcn_mfma_f32_32x32x16_bf16((a), (b), (c), 0, 0, 0)
#define MFMA_F16(a, b, c) __builtin_amdgcn_mfma_f32_32x32x16_f16((a), (b), (c), 0, 0, 0)
__device__ __forceinline__ void attn_item(const bf16* Qb, const bf16* Kb, const bf16* VT, bf16* Ob, int b, int h, int qblk, int lane) {
    const int t32 = lane & 31, hf = lane >> 5, q0 = qblk * 32, tq = q0 + t32;
    const size_t rowbase = (size_t)b * T;
    const float LOG2E = 1.4426950408889634f, LN2 = 0.6931471805599453f;
    bf16x8 qf[4];
    { const bf16* qp = Qb + (rowbase + q0 + t32) * 512 + h * 64 + 8 * hf;
#pragma unroll
      for (int st = 0; st < 4; ++st) qf[st] = *(const GAS bf16x8*)(qp + 16 * st); }
    f16x8 tri[2];
#pragma unroll
    for (int st = 0; st < 2; ++st)
#pragma unroll
        for (int e = 0; e < 8; ++e) { const int j = 16 * st + 8 * (e >> 2) + 4 * hf + (e & 3); tri[st][e] = (j >= t32) ? (_Float16)1.0f : (_Float16)0.0f; }
    f32x16 o0, o1;
#pragma unroll
    for (int r = 0; r < 16; ++r) { o0[r] = 0.f; o1[r] = 0.f; }
    float R = 0.f;
    const bf16* kbase = Kb + rowbase * 512 + h * 64 + 8 * hf;
    const bf16* vtb = VT + ((size_t)(b * 8 + h) * 64 + t32) * T + 4 * hf;
    for (int jt = q0 >> 6; jt >= 0; --jt) {
        const int k0 = jt * 64;
        f32x16 s0, s1;
#pragma unroll
        for (int r = 0; r < 16; ++r) { s0[r] = 0.f; s1[r] = 0.f; }
#pragma unroll
        for (int st = 0; st < 4; ++st) {
            const bf16x8 a0 = *(const GAS bf16x8*)(kbase + (size_t)(k0 + t32) * 512 + 16 * st);
            const bf16x8 a1 = *(const GAS bf16x8*)(kbase + (size_t)(k0 + 32 + t32) * 512 + 16 * st);
            s0 = MFMA_BF16(a0, qf[st], s0); s1 = MFMA_BF16(a1, qf[st], s1);
        }
        f32x16 L0, L1; float tot0 = 0.f, tot1 = 0.f;
#pragma unroll
        for (int r = 0; r < 16; ++r) {
            const int key = k0 + crow(r, hf);
            { const float z = s0[r]; const float e = __builtin_amdgcn_exp2f(-__builtin_fabsf(z) * LOG2E); const float lp = __builtin_amdgcn_logf(1.0f + e) * LN2;
              const float L = (key < tq) ? -(__builtin_fmaxf(z, 0.f) + lp) : 0.f; L0[r] = L; tot0 += L; }
            { const float z = s1[r]; const float e = __builtin_amdgcn_exp2f(-__builtin_fabsf(z) * LOG2E); const float lp = __builtin_amdgcn_logf(1.0f + e) * LN2;
              const float L = (key + 32 < tq) ? -(__builtin_fmaxf(z, 0.f) + lp) : 0.f; L1[r] = L; tot1 += L; }
        }
        tot0 += __shfl_xor(tot0, 32); tot1 += __shfl_xor(tot1, 32);
        f16x8 lf00, lf01, lf10, lf11;
#pragma unroll
        for (int e = 0; e < 8; ++e) { lf00[e] = (_Float16)L0[e]; lf01[e] = (_Float16)L0[8 + e]; lf10[e] = (_Float16)L1[e]; lf11[e] = (_Float16)L1[8 + e]; }
        f32x16 y0, y1;
#pragma unroll
        for (int r = 0; r < 16; ++r) { y0[r] = 0.f; y1[r] = 0.f; }
        y0 = MFMA_F16(tri[0], lf00, y0); y0 = MFMA_F16(tri[1], lf01, y0);
        y1 = MFMA_F16(tri[0], lf10, y1); y1 = MFMA_F16(tri[1], lf11, y1);
        const float base0 = R + tot1, base1 = R;
        float a0v[16], a1v[16];
#pragma unroll
        for (int r = 0; r < 16; ++r) {
            const int key = k0 + crow(r, hf);
            a0v[r] = (key < tq) ? __builtin_amdgcn_exp2f((s0[r] + y0[r] + base0) * LOG2E) : 0.f;
            a1v[r] = (key + 32 < tq) ? __builtin_amdgcn_exp2f((s1[r] + y1[r] + base1) * LOG2E) : 0.f;
        }
        bf16x8 pf[2][2];
#pragma unroll
        for (int st = 0; st < 2; ++st) {
            v4u w0, w1;
            w0.x = cvtpk(a0v[8 * st + 0], a0v[8 * st + 1]); w0.y = cvtpk(a0v[8 * st + 2], a0v[8 * st + 3]); w0.z = cvtpk(a0v[8 * st + 4], a0v[8 * st + 5]); w0.w = cvtpk(a0v[8 * st + 6], a0v[8 * st + 7]);
            w1.x = cvtpk(a1v[8 * st + 0], a1v[8 * st + 1]); w1.y = cvtpk(a1v[8 * st + 2], a1v[8 * st + 3]); w1.z = cvtpk(a1v[8 * st + 4], a1v[8 * st + 5]); w1.w = cvtpk(a1v[8 * st + 6], a1v[8 * st + 7]);
            pf[0][st] = __builtin_bit_cast(bf16x8, w0); pf[1][st] = __builtin_bit_cast(bf16x8, w1);
        }
#pragma unroll
        for (int kb = 0; kb < 2; ++kb)
#pragma unroll
            for (int st = 0; st < 2; ++st) {
                const int kk = k0 + 32 * kb + 16 * st;
                { const v2u lo = *(const GAS v2u*)(vtb + kk), hi = *(const GAS v2u*)(vtb + kk + 8); v4u w; w.x = lo.x; w.y = lo.y; w.z = hi.x; w.w = hi.y;
                  o0 = MFMA_BF16(__builtin_bit_cast(bf16x8, w), pf[kb][st], o0); }
                { const v2u lo = *(const GAS v2u*)(vtb + (size_t)32 * T + kk), hi = *(const GAS v2u*)(vtb + (size_t)32 * T + kk + 8); v4u w; w.x = lo.x; w.y = lo.y; w.z = hi.x; w.w = hi.y;
                  o1 = MFMA_BF16(__builtin_bit_cast(bf16x8, w), pf[kb][st], o1); }
            }
        R += tot0 + tot1;
        if (__all(R < -104.0f)) break;
    }
    bf16* op = Ob + (rowbase + q0 + t32) * 512 + h * 64 + 4 * hf;
#pragma unroll
    for (int q4 = 0; q4 < 4; ++q4) {
        v2u w; w.x = cvtpk(o0[4 * q4], o0[4 * q4 + 1]); w.y = cvtpk(o0[4 * q4 + 2], o0[4 * q4 + 3]); *(GAS v2u*)(op + 8 * q4) = w;
        v2u w2; w2.x = cvtpk(o1[4 * q4], o1[4 * q4 + 1]); w2.y = cvtpk(o1[4 * q4 + 2], o1[4 * q4 + 3]); *(GAS v2u*)(op + 32 + 8 * q4) = w2;
    }
}

#define RT_C8(op_str, cnt, x0, x1, x2, x3, x4, x5, x6, x7, thr) asm volatile(op_str : "+v"(cnt) : "v"(x0), "v"(x1), "v"(x2), "v"(x3), "v"(x4), "v"(x5), "v"(x6), "v"(x7), "v"(thr) : "vcc")
#define RT_GE8 "v_cmp_ge_f32 vcc, %1, %9\n\tv_addc_co_u32_e32 %0, vcc, 0, %0, vcc\n\tv_cmp_ge_f32 vcc, %2, %9\n\tv_addc_co_u32_e32 %0, vcc, 0, %0, vcc\n\tv_cmp_ge_f32 vcc, %3, %9\n\tv_addc_co_u32_e32 %0, vcc, 0, %0, vcc\n\tv_cmp_ge_f32 vcc, %4, %9\n\tv_addc_co_u32_e32 %0, vcc, 0, %0, vcc\n\tv_cmp_ge_f32 vcc, %5, %9\n\tv_addc_co_u32_e32 %0, vcc, 0, %0, vcc\n\tv_cmp_ge_f32 vcc, %6, %9\n\tv_addc_co_u32_e32 %0, vcc, 0, %0, vcc\n\tv_cmp_ge_f32 vcc, %7, %9\n\tv_addc_co_u32_e32 %0, vcc, 0, %0, vcc\n\tv_cmp_ge_f32 vcc, %8, %9\n\tv_addc_co_u32_e32 %0, vcc, 0, %0, vcc"
#define RT_GT8 "v_cmp_gt_f32 vcc, %1, %9\n\tv_addc_co_u32_e32 %0, vcc, 0, %0, vcc\n\tv_cmp_gt_f32 vcc, %2, %9\n\tv_addc_co_u32_e32 %0, vcc, 0, %0, vcc\n\tv_cmp_gt_f32 vcc, %3, %9\n\tv_addc_co_u32_e32 %0, vcc, 0, %0, vcc\n\tv_cmp_gt_f32 vcc, %4, %9\n\tv_addc_co_u32_e32 %0, vcc, 0, %0, vcc\n\tv_cmp_gt_f32 vcc, %5, %9\n\tv_addc_co_u32_e32 %0, vcc, 0, %0, vcc\n\tv_cmp_gt_f32 vcc, %6, %9\n\tv_addc_co_u32_e32 %0, vcc, 0, %0, vcc\n\tv_cmp_gt_f32 vcc, %7, %9\n\tv_addc_co_u32_e32 %0, vcc, 0, %0, vcc\n\tv_cmp_gt_f32 vcc, %8, %9\n\tv_addc_co_u32_e32 %0, vcc, 0, %0, vcc"
#define RT_COUNT128(OPS, cnt, thr) do { cnt = 0; RT_C8(OPS, cnt, v[0], v[1], v[2], v[3], v[4], v[5], v[6], v[7], thr); RT_C8(OPS, cnt, v[8], v[9], v[10], v[11], v[12], v[13], v[14], v[15], thr); RT_C8(OPS, cnt, v[16], v[17], v[18], v[19], v[20], v[21], v[22], v[23], thr); RT_C8(OPS, cnt, v[24], v[25], v[26], v[27], v[28], v[29], v[30], v[31], thr); RT_C8(OPS, cnt, v[32], v[33], v[34], v[35], v[36], v[37], v[38], v[39], thr); RT_C8(OPS, cnt, v[40], v[41], v[42], v[43], v[44], v[45], v[46], v[47], thr); RT_C8(OPS, cnt, v[48], v[49], v[50], v[51], v[52], v[53], v[54], v[55], thr); RT_C8(OPS, cnt, v[56], v[57], v[58], v[59], v[60], v[61], v[62], v[63], thr); RT_C8(OPS, cnt, v[64], v[65], v[66], v[67], v[68], v[69], v[70], v[71], thr); RT_C8(OPS, cnt, v[72], v[73], v[74], v[75], v[76], v[77], v[78], v[79], thr); RT_C8(OPS, cnt, v[80], v[81], v[82], v[83], v[84], v[85], v[86], v[87], thr); RT_C8(OPS, cnt, v[88], v[89], v[90], v[91], v[92], v[93], v[94], v[95], thr); RT_C8(OPS, cnt, v[96], v[97], v[98], v[99], v[100], v[101], v[102], v[103], thr); RT_C8(OPS, cnt, v[104], v[105], v[106], v[107], v[108], v[109], v[110], v[111], thr); RT_C8(OPS, cnt, v[112], v[113], v[114], v[115], v[116], v[117], v[118], v[119], thr); RT_C8(OPS, cnt, v[120], v[121], v[122], v[123], v[124], v[125], v[126], v[127], thr); } while (0)
#define RT_S5(op_str, cnt, a0, a1, a2, a3, a4, b0, b1, b2, b3, b4, thr) do { float t_; asm volatile(op_str : "+v"(cnt), "=&v"(t_) : "v"(a0), "v"(a1), "v"(a2), "v"(a3), "v"(a4), "v"(b0), "v"(b1), "v"(b2), "v"(b3), "v"(b4), "v"(thr) : "vcc"); } while (0)
#define RT_SGE5 "v_add_f32_e32 %1, %2, %7\n\tv_cmp_ge_f32 vcc, %1, %12\n\tv_addc_co_u32_e32 %0, vcc, 0, %0, vcc\n\tv_add_f32_e32 %1, %3, %8\n\tv_cmp_ge_f32 vcc, %1, %12\n\tv_addc_co_u32_e32 %0, vcc, 0, %0, vcc\n\tv_add_f32_e32 %1, %4, %9\n\tv_cmp_ge_f32 vcc, %1, %12\n\tv_addc_co_u32_e32 %0, vcc, 0, %0, vcc\n\tv_add_f32_e32 %1, %5, %10\n\tv_cmp_ge_f32 vcc, %1, %12\n\tv_addc_co_u32_e32 %0, vcc, 0, %0, vcc\n\tv_add_f32_e32 %1, %6, %11\n\tv_cmp_ge_f32 vcc, %1, %12\n\tv_addc_co_u32_e32 %0, vcc, 0, %0, vcc"
#define RT_SGT5 "v_add_f32_e32 %1, %2, %7\n\tv_cmp_gt_f32 vcc, %1, %12\n\tv_addc_co_u32_e32 %0, vcc, 0, %0, vcc\n\tv_add_f32_e32 %1, %3, %8\n\tv_cmp_gt_f32 vcc, %1, %12\n\tv_addc_co_u32_e32 %0, vcc, 0, %0, vcc\n\tv_add_f32_e32 %1, %4, %9\n\tv_cmp_gt_f32 vcc, %1, %12\n\tv_addc_co_u32_e32 %0, vcc, 0, %0, vcc\n\tv_add_f32_e32 %1, %5, %10\n\tv_cmp_gt_f32 vcc, %1, %12\n\tv_addc_co_u32_e32 %0, vcc, 0, %0, vcc\n\tv_add_f32_e32 %1, %6, %11\n\tv_cmp_gt_f32 vcc, %1, %12\n\tv_addc_co_u32_e32 %0, vcc, 0, %0, vcc"
#define RT_COUNT50(OPS, cnt, thr) do { cnt = 0; RT_S5(OPS, cnt, a[0], a[0], a[0], a[0], a[0], b[0], b[1], b[2], b[3], b[4], thr); RT_S5(OPS, cnt, a[0], a[0], a[0], a[0], a[0], b[5], b[6], b[7], b[8], b[9], thr); RT_S5(OPS, cnt, a[0], a[0], a[0], a[0], a[0], b[10], b[11], b[12], b[13], b[14], thr); RT_S5(OPS, cnt, a[0], a[1], a[1], a[1], a[1], b[15], b[0], b[1], b[2], b[3], thr); RT_S5(OPS, cnt, a[1], a[1], a[1], a[1], a[2], b[4], b[5], b[6], b[7], b[0], thr); RT_S5(OPS, cnt, a[2], a[2], a[2], a[2], a[3], b[1], b[2], b[3], b[4], b[0], thr); RT_S5(OPS, cnt, a[3], a[3], a[3], a[4], a[4], b[1], b[2], b[3], b[0], b[1], thr); RT_S5(OPS, cnt, a[4], a[5], a[5], a[6], a[6], b[2], b[0], b[1], b[0], b[1], thr); RT_S5(OPS, cnt, a[7], a[7], a[8], a[9], a[10], b[0], b[1], b[0], b[0], b[0], thr); RT_S5(OPS, cnt, a[11], a[12], a[13], a[14], a[15], b[0], b[0], b[0], b[0], b[0], thr); } while (0)
#define RT_CSWAP(x, xi, p, q) do { float t_; asm volatile("v_cmp_gt_f32 vcc, %1, %0\n\tv_cndmask_b32_e32 %4, %0, %1, vcc\n\tv_cndmask_b32_e32 %1, %1, %0, vcc\n\tv_mov_b32_e32 %0, %4\n\tv_cndmask_b32_e32 %4, %2, %3, vcc\n\tv_cndmask_b32_e32 %3, %3, %2, vcc\n\tv_mov_b32_e32 %2, %4" : "+v"(x[p]), "+v"(x[q]), "+v"(xi[p]), "+v"(xi[q]), "=&v"(t_) : : "vcc"); } while (0)
#define RT_SORT16(x, xi) do { RT_CSWAP(x, xi, 0, 1); RT_CSWAP(x, xi, 2, 3); RT_CSWAP(x, xi, 0, 2); RT_CSWAP(x, xi, 1, 3); RT_CSWAP(x, xi, 1, 2); RT_CSWAP(x, xi, 4, 5); RT_CSWAP(x, xi, 6, 7); RT_CSWAP(x, xi, 4, 6); RT_CSWAP(x, xi, 5, 7); RT_CSWAP(x, xi, 5, 6); RT_CSWAP(x, xi, 0, 4); RT_CSWAP(x, xi, 2, 6); RT_CSWAP(x, xi, 2, 4); RT_CSWAP(x, xi, 1, 5); RT_CSWAP(x, xi, 3, 7); RT_CSWAP(x, xi, 3, 5); RT_CSWAP(x, xi, 1, 2); RT_CSWAP(x, xi, 3, 4); RT_CSWAP(x, xi, 5, 6); RT_CSWAP(x, xi, 8, 9); RT_CSWAP(x, xi, 10, 11); RT_CSWAP(x, xi, 8, 10); RT_CSWAP(x, xi, 9, 11); RT_CSWAP(x, xi, 9, 10); RT_CSWAP(x, xi, 12, 13); RT_CSWAP(x, xi, 14, 15); RT_CSWAP(x, xi, 12, 14); RT_CSWAP(x, xi, 13, 15); RT_CSWAP(x, xi, 13, 14); RT_CSWAP(x, xi, 8, 12); RT_CSWAP(x, xi, 10, 14); RT_CSWAP(x, xi, 10, 12); RT_CSWAP(x, xi, 9, 13); RT_CSWAP(x, xi, 11, 15); RT_CSWAP(x, xi, 11, 13); RT_CSWAP(x, xi, 9, 10); RT_CSWAP(x, xi, 11, 12); RT_CSWAP(x, xi, 13, 14); RT_CSWAP(x, xi, 0, 8); RT_CSWAP(x, xi, 4, 12); RT_CSWAP(x, xi, 4, 8); RT_CSWAP(x, xi, 2, 10); RT_CSWAP(x, xi, 6, 14); RT_CSWAP(x, xi, 6, 10); RT_CSWAP(x, xi, 2, 4); RT_CSWAP(x, xi, 6, 8); RT_CSWAP(x, xi, 10, 12); RT_CSWAP(x, xi, 1, 9); RT_CSWAP(x, xi, 5, 13); RT_CSWAP(x, xi, 5, 9); RT_CSWAP(x, xi, 3, 11); RT_CSWAP(x, xi, 7, 15); RT_CSWAP(x, xi, 7, 11); RT_CSWAP(x, xi, 3, 5); RT_CSWAP(x, xi, 7, 9); RT_CSWAP(x, xi, 11, 13); RT_CSWAP(x, xi, 1, 2); RT_CSWAP(x, xi, 3, 4); RT_CSWAP(x, xi, 5, 6); RT_CSWAP(x, xi, 7, 8); RT_CSWAP(x, xi, 9, 10); RT_CSWAP(x, xi, 11, 12); RT_CSWAP(x, xi, 13, 14); } while (0)
#define RT_FOR_CANDS(F) F(0, 0) F(0, 1) F(0, 2) F(0, 3) F(0, 4) F(0, 5) F(0, 6) F(0, 7) F(0, 8) F(0, 9) F(0, 10) F(0, 11) F(0, 12) F(0, 13) F(0, 14) F(0, 15) F(1, 0) F(1, 1) F(1, 2) F(1, 3) F(1, 4) F(1, 5) F(1, 6) F(1, 7) F(2, 0) F(2, 1) F(2, 2) F(2, 3) F(2, 4) F(3, 0) F(3, 1) F(3, 2) F(3, 3) F(4, 0) F(4, 1) F(4, 2) F(5, 0) F(5, 1) F(6, 0) F(6, 1) F(7, 0) F(7, 1) F(8, 0) F(9, 0) F(10, 0) F(11, 0) F(12, 0) F(13, 0) F(14, 0) F(15, 0)
#define RT_SEARCH(COUNT_MACRO, NTOT) \
    for (int it_ = 0; it_ < 400 && __any(!done); ++it_) { \
        const float w_ = hi - lo; float t_ = ((float)(clo - 16) + 0.5f) * __builtin_amdgcn_rcpf((float)(clo - chi)); t_ = __builtin_fminf(__builtin_fmaxf(t_, 0.125f), 0.875f); \
        float x_ = lo + w_ * t_; if (!(x_ > lo && x_ < hi)) x_ = 0.5f * lo + 0.5f * hi; const bool stuck_ = !(x_ > lo && x_ < hi); \
        int c_; COUNT_MACRO(c_, x_); \
        if (!done) { if (stuck_) { Tv = lo; done = true; } else if (c_ == 16) { Tv = x_; done = true; } else if (c_ > 16) { lo = x_; clo = c_; } else { hi = x_; chi = c_; } } } \
    if (!done) Tv = lo;
#define RT_CNT128_GE(c, x) RT_COUNT128(RT_GE8, c, x)
#define RT_CNT50_GE(c, x) RT_COUNT50(RT_SGE5, c, x)
__device__ __forceinline__ void lane_top16_of_128(const float (&v)[128], LAS unsigned char* sb) {
    float mx = v[0], mn = v[0];
#pragma unroll
    for (int i = 1; i < 128; ++i) { mx = __builtin_fmaxf(mx, v[i]); mn = __builtin_fminf(mn, v[i]); }
    float lo = mn, hi = mx, Tv = mn; int clo = 128, chi; bool done;
    RT_CNT128_GE(chi, mx); done = (chi >= 16); if (done) Tv = mx;
    RT_SEARCH(RT_CNT128_GE, 128)
    int cgt; RT_COUNT128(RT_GT8, cgt, Tv);
    const int need = 16 - cgt; int cnt = 0, idx = 0;
#pragma unroll
    for (int i = 0; i < 128; ++i) {
        asm volatile("" : "+v"(Tv), "+v"(cnt), "+v"(idx));
        LAS unsigned char* q = sb + cnt * 512; *(LAS float*)q = v[i]; *(LAS int*)(q + 4) = idx;
        cnt += (v[i] > Tv) ? 1 : 0; idx += 1;
    }
    if (__any(need > 0)) {
        idx = 0;
#pragma unroll
        for (int i = 0; i < 128; ++i) { asm volatile("" : "+v"(Tv), "+v"(cnt), "+v"(idx));
            if (v[i] == Tv && cnt < 16) { LAS unsigned char* q = sb + cnt * 512; *(LAS float*)q = v[i]; *(LAS int*)(q + 4) = idx; cnt += 1; } idx += 1; }
    }
}
__device__ __forceinline__ int opaque_zero() { int z = 0; asm volatile("" : "+v"(z)); return z; }
__device__ __forceinline__ void route_task_search(const float* SCT, v2u* ROUTE, int tok0, int h, LAS unsigned char* scr, int lane) {
    const int tok = tok0 + lane;
    LAS unsigned char* sb = scr + lane * 8;
#pragma unroll 1
    for (int p = 0; p < 2; ++p) {
        const int g = 2 * h + p; float v[128];
        const unsigned voff = (unsigned)tok * 16u;
#pragma unroll
        for (int k = 0; k < 32; ++k) { const char* bk = (const char*)SCT + ((size_t)(g * 32 + k) * M) * 16; const f32x4 q = *(const GAS f32x4*)(bk + voff); v[4 * k] = q.x; v[4 * k + 1] = q.y; v[4 * k + 2] = q.z; v[4 * k + 3] = q.w; }
        lane_top16_of_128(v, sb + p * 8704);
    }
    LDS_WAIT();
    float a[16], b[16]; int ai[16], bi[16];
#pragma unroll
    for (int i = 0; i < 16; ++i) { const v2u ea = *(LAS v2u*)(sb + i * 512), eb = *(LAS v2u*)(sb + 8704 + i * 512);
        a[i] = __builtin_bit_cast(float, ea.x); ai[i] = (int)ea.y; b[i] = __builtin_bit_cast(float, eb.x); bi[i] = (int)eb.y; }
    LDS_WAIT();
    RT_SORT16(a, ai); RT_SORT16(b, bi);
    float lo = a[15] + b[15], hi = a[0] + b[0], Tv = lo; int clo = 50, chi; bool done;
    RT_CNT50_GE(chi, hi); done = (chi >= 16); if (done) Tv = hi;
    RT_SEARCH(RT_CNT50_GE, 50)
    int cgt; RT_COUNT50(RT_SGT5, cgt, Tv);
    const int need = 16 - cgt; int cnt = 0;
#define RT_EXT(i, j) { asm volatile("" : "+v"(Tv), "+v"(cnt)); const float s_ = a[i] + b[j]; LAS unsigned char* q_ = sb + cnt * 512; *(LAS float*)q_ = s_; *(LAS int*)(q_ + 4) = ai[i] * 128 + bi[j]; cnt += (s_ > Tv) ? 1 : 0; }
    RT_FOR_CANDS(RT_EXT)
#undef RT_EXT
    if (__any(need > 0)) {
#define RT_EXT2(i, j) { asm volatile("" : "+v"(Tv), "+v"(cnt)); const float s_ = a[i] + b[j]; if (s_ == Tv && cnt < 16) { LAS unsigned char* q_ = sb + cnt * 512; *(LAS float*)q_ = s_; *(LAS int*)(q_ + 4) = ai[i] * 128 + bi[j]; cnt += 1; } }
        RT_FOR_CANDS(RT_EXT2)
#undef RT_EXT2
    }
    LDS_WAIT();
    GAS v4u* rp = (GAS v4u*)((GAS v2u*)ROUTE + (size_t)tok * 128 + h * 16);
#pragma unroll
    for (int i = 0; i < 8; ++i) { const v2u e0 = *(LAS v2u*)(sb + (2 * i) * 512), e1 = *(LAS v2u*)(sb + (2 * i + 1) * 512); v4u o; o.x = e0.y; o.y = e0.x; o.z = e1.y; o.w = e1.x; rp[i] = o; }
    LDS_WAIT();
}

#define RT2_CE(a, b) { const int t0_ = (a), t1_ = (b); (a) = t0_ > t1_ ? t0_ : t1_; (b) = t0_ > t1_ ? t1_ : t0_; }
#define RT2_MX(a, b) ((a) > (b) ? (a) : (b))
#define RT2_SORT16(k, B) do { RT2_CE(k[(B) + 0], k[(B) + 13]); RT2_CE(k[(B) + 1], k[(B) + 12]); RT2_CE(k[(B) + 2], k[(B) + 15]); RT2_CE(k[(B) + 3], k[(B) + 14]); RT2_CE(k[(B) + 4], k[(B) + 8]); RT2_CE(k[(B) + 5], k[(B) + 6]); RT2_CE(k[(B) + 7], k[(B) + 11]); RT2_CE(k[(B) + 9], k[(B) + 10]); RT2_CE(k[(B) + 0], k[(B) + 5]); RT2_CE(k[(B) + 1], k[(B) + 7]); RT2_CE(k[(B) + 2], k[(B) + 9]); RT2_CE(k[(B) + 3], k[(B) + 4]); RT2_CE(k[(B) + 6], k[(B) + 13]); RT2_CE(k[(B) + 8], k[(B) + 14]); RT2_CE(k[(B) + 10], k[(B) + 15]); RT2_CE(k[(B) + 11], k[(B) + 12]); RT2_CE(k[(B) + 0], k[(B) + 1]); RT2_CE(k[(B) + 2], k[(B) + 3]); RT2_CE(k[(B) + 4], k[(B) + 5]); RT2_CE(k[(B) + 6], k[(B) + 8]); RT2_CE(k[(B) + 7], k[(B) + 9]); RT2_CE(k[(B) + 10], k[(B) + 11]); RT2_CE(k[(B) + 12], k[(B) + 13]); RT2_CE(k[(B) + 14], k[(B) + 15]); RT2_CE(k[(B) + 0], k[(B) + 2]); RT2_CE(k[(B) + 1], k[(B) + 3]); RT2_CE(k[(B) + 4], k[(B) + 10]); RT2_CE(k[(B) + 5], k[(B) + 11]); RT2_CE(k[(B) + 6], k[(B) + 7]); RT2_CE(k[(B) + 8], k[(B) + 9]); RT2_CE(k[(B) + 12], k[(B) + 14]); RT2_CE(k[(B) + 13], k[(B) + 15]); RT2_CE(k[(B) + 1], k[(B) + 2]); RT2_CE(k[(B) + 3], k[(B) + 12]); RT2_CE(k[(B) + 4], k[(B) + 6]); RT2_CE(k[(B) + 5], k[(B) + 7]); RT2_CE(k[(B) + 8], k[(B) + 10]); RT2_CE(k[(B) + 9], k[(B) + 11]); RT2_CE(k[(B) + 13], k[(B) + 14]); RT2_CE(k[(B) + 1], k[(B) + 4]); RT2_CE(k[(B) + 2], k[(B) + 6]); RT2_CE(k[(B) + 5], k[(B) + 8]); RT2_CE(k[(B) + 7], k[(B) + 10]); RT2_CE(k[(B) + 9], k[(B) + 13]); RT2_CE(k[(B) + 11], k[(B) + 14]); RT2_CE(k[(B) + 2], k[(B) + 4]); RT2_CE(k[(B) + 3], k[(B) + 6]); RT2_CE(k[(B) + 9], k[(B) + 12]); RT2_CE(k[(B) + 11], k[(B) + 13]); RT2_CE(k[(B) + 3], k[(B) + 5]); RT2_CE(k[(B) + 6], k[(B) + 8]); RT2_CE(k[(B) + 7], k[(B) + 9]); RT2_CE(k[(B) + 10], k[(B) + 12]); RT2_CE(k[(B) + 3], k[(B) + 4]); RT2_CE(k[(B) + 5], k[(B) + 6]); RT2_CE(k[(B) + 7], k[(B) + 8]); RT2_CE(k[(B) + 9], k[(B) + 10]); RT2_CE(k[(B) + 11], k[(B) + 12]); RT2_CE(k[(B) + 6], k[(B) + 7]); RT2_CE(k[(B) + 8], k[(B) + 9]); } while (0)
#define RT2_BIT16(k, B) do { RT2_CE(k[(B) + 0], k[(B) + 8]); RT2_CE(k[(B) + 1], k[(B) + 9]); RT2_CE(k[(B) + 2], k[(B) + 10]); RT2_CE(k[(B) + 3], k[(B) + 11]); RT2_CE(k[(B) + 4], k[(B) + 12]); RT2_CE(k[(B) + 5], k[(B) + 13]); RT2_CE(k[(B) + 6], k[(B) + 14]); RT2_CE(k[(B) + 7], k[(B) + 15]); RT2_CE(k[(B) + 0], k[(B) + 4]); RT2_CE(k[(B) + 1], k[(B) + 5]); RT2_CE(k[(B) + 2], k[(B) + 6]); RT2_CE(k[(B) + 3], k[(B) + 7]); RT2_CE(k[(B) + 8], k[(B) + 12]); RT2_CE(k[(B) + 9], k[(B) + 13]); RT2_CE(k[(B) + 10], k[(B) + 14]); RT2_CE(k[(B) + 11], k[(B) + 15]); RT2_CE(k[(B) + 0], k[(B) + 2]); RT2_CE(k[(B) + 1], k[(B) + 3]); RT2_CE(k[(B) + 4], k[(B) + 6]); RT2_CE(k[(B) + 5], k[(B) + 7]); RT2_CE(k[(B) + 8], k[(B) + 10]); RT2_CE(k[(B) + 9], k[(B) + 11]); RT2_CE(k[(B) + 12], k[(B) + 14]); RT2_CE(k[(B) + 13], k[(B) + 15]); RT2_CE(k[(B) + 0], k[(B) + 1]); RT2_CE(k[(B) + 2], k[(B) + 3]); RT2_CE(k[(B) + 4], k[(B) + 5]); RT2_CE(k[(B) + 6], k[(B) + 7]); RT2_CE(k[(B) + 8], k[(B) + 9]); RT2_CE(k[(B) + 10], k[(B) + 11]); RT2_CE(k[(B) + 12], k[(B) + 13]); RT2_CE(k[(B) + 14], k[(B) + 15]); } while (0)
#define RT2_HCLEAN(k, A, B) do { k[(A) + 0] = RT2_MX(k[(A) + 0], k[(B) + 15]); k[(A) + 1] = RT2_MX(k[(A) + 1], k[(B) + 14]); k[(A) + 2] = RT2_MX(k[(A) + 2], k[(B) + 13]); k[(A) + 3] = RT2_MX(k[(A) + 3], k[(B) + 12]); k[(A) + 4] = RT2_MX(k[(A) + 4], k[(B) + 11]); k[(A) + 5] = RT2_MX(k[(A) + 5], k[(B) + 10]); k[(A) + 6] = RT2_MX(k[(A) + 6], k[(B) + 9]); k[(A) + 7] = RT2_MX(k[(A) + 7], k[(B) + 8]); k[(A) + 8] = RT2_MX(k[(A) + 8], k[(B) + 7]); k[(A) + 9] = RT2_MX(k[(A) + 9], k[(B) + 6]); k[(A) + 10] = RT2_MX(k[(A) + 10], k[(B) + 5]); k[(A) + 11] = RT2_MX(k[(A) + 11], k[(B) + 4]); k[(A) + 12] = RT2_MX(k[(A) + 12], k[(B) + 3]); k[(A) + 13] = RT2_MX(k[(A) + 13], k[(B) + 2]); k[(A) + 14] = RT2_MX(k[(A) + 14], k[(B) + 1]); k[(A) + 15] = RT2_MX(k[(A) + 15], k[(B) + 0]); } while (0)
#define RT2_TOP16_OF_128(k) do { RT2_SORT16(k, 0); RT2_SORT16(k, 16); RT2_SORT16(k, 32); RT2_SORT16(k, 48); RT2_SORT16(k, 64); RT2_SORT16(k, 80); RT2_SORT16(k, 96); RT2_SORT16(k, 112); RT2_HCLEAN(k, 0, 16); RT2_BIT16(k, 0); RT2_HCLEAN(k, 32, 48); RT2_BIT16(k, 32); RT2_HCLEAN(k, 64, 80); RT2_BIT16(k, 64); RT2_HCLEAN(k, 96, 112); RT2_BIT16(k, 96); RT2_HCLEAN(k, 0, 32); RT2_BIT16(k, 0); RT2_HCLEAN(k, 64, 96); RT2_BIT16(k, 64); RT2_HCLEAN(k, 0, 64); RT2_BIT16(k, 0); } while (0)
#define RT2_BUILD_CANDS(c) do { c[0] = RT2_CK(0, 0); c[1] = RT2_CK(0, 1); c[2] = RT2_CK(0, 2); c[3] = RT2_CK(0, 3); c[4] = RT2_CK(0, 4); c[5] = RT2_CK(0, 5); c[6] = RT2_CK(0, 6); c[7] = RT2_CK(0, 7); c[8] = RT2_CK(0, 8); c[9] = RT2_CK(0, 9); c[10] = RT2_CK(0, 10); c[11] = RT2_CK(0, 11); c[12] = RT2_CK(0, 12); c[13] = RT2_CK(0, 13); c[14] = RT2_CK(0, 14); c[15] = RT2_CK(0, 15); c[16] = RT2_CK(1, 0); c[17] = RT2_CK(1, 1); c[18] = RT2_CK(1, 2); c[19] = RT2_CK(1, 3); c[20] = RT2_CK(1, 4); c[21] = RT2_CK(1, 5); c[22] = RT2_CK(1, 6); c[23] = RT2_CK(1, 7); c[24] = RT2_CK(15, 0); c[25] = RT2_CK(14, 0); c[26] = RT2_CK(13, 0); c[27] = RT2_CK(12, 0); c[28] = RT2_CK(11, 0); c[29] = RT2_CK(10, 0); c[30] = RT2_CK(9, 0); c[31] = RT2_CK(8, 0); c[32] = RT2_CK(2, 0); c[33] = RT2_CK(2, 1); c[34] = RT2_CK(2, 2); c[35] = RT2_CK(2, 3); c[36] = RT2_CK(2, 4); c[37] = RT2_CK(3, 0); c[38] = RT2_CK(3, 1); c[39] = RT2_CK(3, 2); c[40] = RT2_CK(3, 3); c[41] = RT2_CK(4, 0); c[42] = RT2_CK(4, 1); c[43] = RT2_CK(4, 2); c[44] = RT2_CK(5, 0); c[45] = RT2_CK(5, 1); c[46] = RT2_CK(6, 0); c[47] = RT2_CK(6, 1); } while (0)
__device__ __forceinline__ int rt2_tr(int u) { return u ^ (int)((unsigned)(u >> 31) >> 1); }
__device__ __forceinline__ int rt2_key(float x, int code, int mask) { return (rt2_tr(__builtin_bit_cast(int, x)) & ~mask) | code; }
__device__ __forceinline__ int rt2_key16(unsigned hbits_hi, int code) { return (rt2_tr((int)hbits_hi) & (int)0xffff0000) | code; }
__device__ __forceinline__ float rt2_val16(int k) { const unsigned u = (unsigned)rt2_tr(k) >> 16; return (float)__builtin_bit_cast(_Float16, (unsigned short)u); }
__device__ __forceinline__ void route_task(const unsigned short* SCT, v2u* ROUTE, int tok0, int h, LAS unsigned char* scr, int lane) {
    const int tok = tok0 + lane;
    LAS unsigned char* sb = scr + lane * 4;
#pragma unroll 1
    for (int p = 0; p < 2; ++p) {
        const int g = 2 * h + p; int k[128];
        const unsigned voff = (unsigned)tok * 16u;
#pragma unroll
        for (int q8 = 0; q8 < 16; ++q8) { const char* bq = (const char*)SCT + ((size_t)(g * 16 + q8) * M) * 16; const v4u q = *(const GAS v4u*)(bq + voff);
            k[8 * q8 + 0] = rt2_key16(q.x << 16, 127 - 8 * q8); k[8 * q8 + 1] = rt2_key16(q.x, 126 - 8 * q8); k[8 * q8 + 2] = rt2_key16(q.y << 16, 125 - 8 * q8); k[8 * q8 + 3] = rt2_key16(q.y, 124 - 8 * q8);
            k[8 * q8 + 4] = rt2_key16(q.z << 16, 123 - 8 * q8); k[8 * q8 + 5] = rt2_key16(q.z, 122 - 8 * q8); k[8 * q8 + 6] = rt2_key16(q.w << 16, 121 - 8 * q8); k[8 * q8 + 7] = rt2_key16(q.w, 120 - 8 * q8); }
        RT2_TOP16_OF_128(k);
#pragma unroll
        for (int i = 0; i < 16; ++i) *(LAS int*)(sb + (p * 16 + i) * 256) = k[i];
    }
    LDS_WAIT();
    float af[16], bf[16];
#pragma unroll
    for (int i = 0; i < 16; ++i) { af[i] = rt2_val16(*(const LAS int*)(sb + i * 256)); bf[i] = rt2_val16(*(const LAS int*)(sb + (16 + i) * 256)); }
    int c[48];
#define RT2_CK(i, j) rt2_key(af[i] + bf[j], 255 - (16 * (i) + (j)), 255)
    RT2_BUILD_CANDS(c);
    const int r7a = RT2_CK(7, 0), r7b = RT2_CK(7, 1);
#undef RT2_CK
    RT2_BIT16(c, 16);
    RT2_SORT16(c, 32);
    RT2_HCLEAN(c, 0, 16); RT2_BIT16(c, 0);
    c[46] = RT2_MX(c[46], r7b); c[47] = RT2_MX(c[47], r7a); RT2_BIT16(c, 32);
    RT2_HCLEAN(c, 0, 32);
    GAS v4u* rp = (GAS v4u*)((GAS v2u*)ROUTE + (size_t)tok * 128 + h * 16);
#pragma unroll
    for (int i = 0; i < 8; ++i) { v4u o;
        { const int ij = (~c[2 * i]) & 255; const int ka = *(const LAS int*)(sb + ((ij >> 4) << 8)), kb = *(const LAS int*)(sb + 4096 + ((ij & 15) << 8));
          o.x = (unsigned)(((~ka) & 127) * 128 + ((~kb) & 127)); o.y = __builtin_bit_cast(unsigned, rt2_val16(ka) + rt2_val16(kb)); }
        { const int ij = (~c[2 * i + 1]) & 255; const int ka = *(const LAS int*)(sb + ((ij >> 4) << 8)), kb = *(const LAS int*)(sb + 4096 + ((ij & 15) << 8));
          o.z = (unsigned)(((~ka) & 127) * 128 + ((~kb) & 127)); o.w = __builtin_bit_cast(unsigned, rt2_val16(ka) + rt2_val16(kb)); }
        rp[i] = o; }
    LDS_WAIT();
}

#define DPPF(v, ctrl) __builtin_bit_cast(float, __builtin_amdgcn_update_dpp(0, __builtin_bit_cast(int, (v)), (ctrl), 0xf, 0xf, true))
__device__ __forceinline__ float wave_max_f(float m) {
#pragma unroll
    for (int o = 1; o < 64; o <<= 1) m = __builtin_fmaxf(m, __shfl_xor(m, o));
    return m;
}
template <int NV> __device__ __forceinline__ void select16(const float (&v)[NV], bool (&sel)[NV], int (&pos)[NV]) {
    float mx = v[0], mn = v[0];
#pragma unroll
    for (int i = 1; i < NV; ++i) { mx = __builtin_fmaxf(mx, v[i]); mn = __builtin_fminf(mn, v[i]); }
    mx = wave_max_f(mx); mn = -wave_max_f(-mn);
    float lo = mn, hi = mx, Tv;
    { int c = 0;
#pragma unroll
      for (int i = 0; i < NV; ++i) c += __popcll(__ballot(v[i] >= mx));
      if (c >= 16) { Tv = mx; }
      else {
        Tv = lo;
        for (int it = 0; it < 300; ++it) {
            const float mid = 0.5f * lo + 0.5f * hi;
            if (!(mid > lo && mid < hi)) { Tv = lo; break; }
            int cc = 0;
#pragma unroll
            for (int i = 0; i < NV; ++i) cc += __popcll(__ballot(v[i] >= mid));
            if (cc == 16) { Tv = mid; break; }
            if (cc > 16) lo = mid; else hi = mid;
            Tv = lo;
        }
      }
    }
    int cgt = 0;
#pragma unroll
    for (int i = 0; i < NV; ++i) cgt += __popcll(__ballot(v[i] > Tv));
    const int need = 16 - cgt;
    int eqbelow = 0;
#pragma unroll
    for (int i = 0; i < NV; ++i) { const unsigned long long m = __ballot(v[i] == Tv); eqbelow += __builtin_amdgcn_mbcnt_hi((unsigned)(m >> 32), __builtin_amdgcn_mbcnt_lo((unsigned)m, 0u)); }
    int eqown = 0;
#pragma unroll
    for (int i = 0; i < NV; ++i) { const bool eq = (v[i] == Tv); sel[i] = (v[i] > Tv) || (eq && (eqbelow + eqown) < need); eqown += eq ? 1 : 0; }
    int selbelow = 0;
#pragma unroll
    for (int i = 0; i < NV; ++i) { const unsigned long long m = __ballot(sel[i]); selbelow += __builtin_amdgcn_mbcnt_hi((unsigned)(m >> 32), __builtin_amdgcn_mbcnt_lo((unsigned)m, 0u)); }
    int own = 0;
#pragma unroll
    for (int i = 0; i < NV; ++i) { pos[i] = selbelow + own; own += sel[i] ? 1 : 0; }
}

__device__ __forceinline__ float gelu_exact(float a) { return 0.5f * a * (1.0f + erff(a * 0.7071067811865476f)); }

__device__ __forceinline__ void fp8_row_dot(const v4u q, const float (&xr)[16], float& s) {
    const f32x2 a0 = __builtin_amdgcn_cvt_pk_f32_fp8((int)q.x, false), a1 = __builtin_amdgcn_cvt_pk_f32_fp8((int)q.x, true), a2 = __builtin_amdgcn_cvt_pk_f32_fp8((int)q.y, false), a3 = __builtin_amdgcn_cvt_pk_f32_fp8((int)q.y, true);
    const f32x2 b0 = __builtin_amdgcn_cvt_pk_f32_fp8((int)q.z, false), b1 = __builtin_amdgcn_cvt_pk_f32_fp8((int)q.z, true), b2 = __builtin_amdgcn_cvt_pk_f32_fp8((int)q.w, false), b3 = __builtin_amdgcn_cvt_pk_f32_fp8((int)q.w, true);
    f32x2 t = a0 * (f32x2){xr[0], xr[1]};
    t = __builtin_elementwise_fma(a1, (f32x2){xr[2], xr[3]}, t); t = __builtin_elementwise_fma(a2, (f32x2){xr[4], xr[5]}, t); t = __builtin_elementwise_fma(a3, (f32x2){xr[6], xr[7]}, t);
    t = __builtin_elementwise_fma(b0, (f32x2){xr[8], xr[9]}, t); t = __builtin_elementwise_fma(b1, (f32x2){xr[10], xr[11]}, t); t = __builtin_elementwise_fma(b2, (f32x2){xr[12], xr[13]}, t); t = __builtin_elementwise_fma(b3, (f32x2){xr[14], xr[15]}, t);
    s = t.x + t.y;
}
__device__ __forceinline__ void fp8_row_axpy2(const v4u q, const float w, f32x2 (&acc)[8]) {
    const f32x2 a0 = __builtin_amdgcn_cvt_pk_f32_fp8((int)q.x, false), a1 = __builtin_amdgcn_cvt_pk_f32_fp8((int)q.x, true), a2 = __builtin_amdgcn_cvt_pk_f32_fp8((int)q.y, false), a3 = __builtin_amdgcn_cvt_pk_f32_fp8((int)q.y, true);
    const f32x2 b0 = __builtin_amdgcn_cvt_pk_f32_fp8((int)q.z, false), b1 = __builtin_amdgcn_cvt_pk_f32_fp8((int)q.z, true), b2 = __builtin_amdgcn_cvt_pk_f32_fp8((int)q.w, false), b3 = __builtin_amdgcn_cvt_pk_f32_fp8((int)q.w, true);
    const f32x2 ww = {w, w};
    acc[0] = __builtin_elementwise_fma(a0, ww, acc[0]); acc[1] = __builtin_elementwise_fma(a1, ww, acc[1]); acc[2] = __builtin_elementwise_fma(a2, ww, acc[2]); acc[3] = __builtin_elementwise_fma(a3, ww, acc[3]);
    acc[4] = __builtin_elementwise_fma(b0, ww, acc[4]); acc[5] = __builtin_elementwise_fma(b1, ww, acc[5]); acc[6] = __builtin_elementwise_fma(b2, ww, acc[6]); acc[7] = __builtin_elementwise_fma(b3, ww, acc[7]);
}
__device__ __forceinline__ void fp8_row_axpy(const v4u q, const float w, float (&acc)[16]) {
    const f32x2 a0 = __builtin_amdgcn_cvt_pk_f32_fp8((int)q.x, false), a1 = __builtin_amdgcn_cvt_pk_f32_fp8((int)q.x, true), a2 = __builtin_amdgcn_cvt_pk_f32_fp8((int)q.y, false), a3 = __builtin_amdgcn_cvt_pk_f32_fp8((int)q.y, true);
    const f32x2 b0 = __builtin_amdgcn_cvt_pk_f32_fp8((int)q.z, false), b1 = __builtin_amdgcn_cvt_pk_f32_fp8((int)q.z, true), b2 = __builtin_amdgcn_cvt_pk_f32_fp8((int)q.w, false), b3 = __builtin_amdgcn_cvt_pk_f32_fp8((int)q.w, true);
    acc[0] += w * a0.x; acc[1] += w * a0.y; acc[2] += w * a1.x; acc[3] += w * a1.y; acc[4] += w * a2.x; acc[5] += w * a2.y; acc[6] += w * a3.x; acc[7] += w * a3.y;
    acc[8] += w * b0.x; acc[9] += w * b0.y; acc[10] += w * b1.x; acc[11] += w * b1.y; acc[12] += w * b2.x; acc[13] += w * b2.y; acc[14] += w * b3.x; acc[15] += w * b3.y;
}
__device__ __forceinline__ void fp8_convert_row(const float* src, const float* gain, unsigned char* dst, float* inv_scale, int lane, int sliced, int e) {
    const GAS f32x4* sp = (const GAS f32x4*)src; float v[16];
#pragma unroll
    for (int j = 0; j < 2; ++j) { f32x4 a = sp[2 * lane + 128 * j], b = sp[2 * lane + 128 * j + 1];
        if (gain) { const GAS f32x4* gp = (const GAS f32x4*)gain; const f32x4 ga = gp[2 * lane + 128 * j], gb = gp[2 * lane + 128 * j + 1]; a = a * ga; b = b * gb; }
        v[8 * j + 0] = a.x; v[8 * j + 1] = a.y; v[8 * j + 2] = a.z; v[8 * j + 3] = a.w; v[8 * j + 4] = b.x; v[8 * j + 5] = b.y; v[8 * j + 6] = b.z; v[8 * j + 7] = b.w; }
    float am = 0.f;
#pragma unroll
    for (int i = 0; i < 16; ++i) am = __builtin_fmaxf(am, __builtin_fabsf(v[i]));
    am = wave_max_f(am);
    const float sc = (am > 0.f) ? 384.0f / am : 1.0f, inv = (am > 0.f) ? am * (1.0f / 384.0f) : 1.0f;
    v4u q;
    { int w = __builtin_amdgcn_cvt_pk_fp8_f32(v[0] * sc, v[1] * sc, 0, false); w = __builtin_amdgcn_cvt_pk_fp8_f32(v[2] * sc, v[3] * sc, w, true); q.x = (unsigned)w; }
    { int w = __builtin_amdgcn_cvt_pk_fp8_f32(v[4] * sc, v[5] * sc, 0, false); w = __builtin_amdgcn_cvt_pk_fp8_f32(v[6] * sc, v[7] * sc, w, true); q.y = (unsigned)w; }
    { int w = __builtin_amdgcn_cvt_pk_fp8_f32(v[8] * sc, v[9] * sc, 0, false); w = __builtin_amdgcn_cvt_pk_fp8_f32(v[10] * sc, v[11] * sc, w, true); q.z = (unsigned)w; }
    { int w = __builtin_amdgcn_cvt_pk_fp8_f32(v[12] * sc, v[13] * sc, 0, false); w = __builtin_amdgcn_cvt_pk_fp8_f32(v[14] * sc, v[15] * sc, w, true); q.w = (unsigned)w; }
    if (!sliced) ((GAS v4u*)dst)[lane] = q;
    else { v2u q0, q1; q0.x = q.x; q0.y = q.y; q1.x = q.z; q1.y = q.w; const int s0 = lane >> 4, o8 = 8 * (lane & 15);
        *(GAS v2u*)(dst + ((size_t)s0 * NEXP + e) * 128 + o8) = q0; *(GAS v2u*)(dst + ((size_t)(s0 + 4) * NEXP + e) * 128 + o8) = q1; }
    if (lane == 0) *inv_scale = inv;
}

#define PIN_ACC2(b) asm volatile("" : "+v"(b), "+v"(acc2[0]), "+v"(acc2[1]), "+v"(acc2[2]), "+v"(acc2[3]), "+v"(acc2[4]), "+v"(acc2[5]), "+v"(acc2[6]), "+v"(acc2[7]))
#define PIN_ACC(b) asm volatile("" : "+v"(b), "+v"(acc[0]), "+v"(acc[1]), "+v"(acc[2]), "+v"(acc[3]), "+v"(acc[4]), "+v"(acc[5]), "+v"(acc[6]), "+v"(acc[7]), "+v"(acc[8]), "+v"(acc[9]), "+v"(acc[10]), "+v"(acc[11]), "+v"(acc[12]), "+v"(acc[13]), "+v"(acc[14]), "+v"(acc[15]))
#define PC_META_U(tk) do { const char* rb_ = (const char*)route + (size_t)(tk) * 1024; m_e0 = *(const GAS int*)(rb_ + l8); m_e1 = *(const GAS int*)(rb_ + 512 + l8); } while (0)
#define PC_ISSUE_U(buf, xs, par, tk) do { LAS int* lid_ = (LAS int*)(scr + (par) * 512); lid_[lane] = m_e0; lid_[lane + 64] = m_e1; LDS_WAIT(); \
        { const GAS f32x4* xq_ = (const GAS f32x4*)(x1 + (size_t)(tk) * D + 128 * s + 16 * c); const f32x4 x0_ = xq_[0], x1_ = xq_[1], x2_ = xq_[2], x3_ = xq_[3]; \
          xs[0] = x0_.x; xs[1] = x0_.y; xs[2] = x0_.z; xs[3] = x0_.w; xs[4] = x1_.x; xs[5] = x1_.y; xs[6] = x1_.z; xs[7] = x1_.w; xs[8] = x2_.x; xs[9] = x2_.y; xs[10] = x2_.z; xs[11] = x2_.w; xs[12] = x3_.x; xs[13] = x3_.y; xs[14] = x3_.z; xs[15] = x3_.w; } \
        _Pragma("unroll") for (int k = 0; k < 16; ++k) { const int e_ = lid_[8 * k + r]; buf[k] = *(const GAS v4u*)(tbs + (unsigned)(e_ * 128)); } } while (0)
#define PC_COMPUTE_U(buf, xs, tk) do { float p_[16]; \
        _Pragma("unroll") for (int k = 0; k < 16; ++k) { if (k) asm volatile("" : "+v"(buf[k]), "+v"(p_[k ? k - 1 : 0])); else asm volatile("" : "+v"(buf[k])); fp8_row_dot(buf[k], xs, p_[k]); } \
        float q8_[8], q4_[4], q2_[2]; \
        _Pragma("unroll") for (int k = 0; k < 8; ++k) { const float send = c2 ? p_[k] : p_[k + 8], keep = c2 ? p_[k + 8] : p_[k]; q8_[k] = keep + __shfl_xor(send, 4); } \
        _Pragma("unroll") for (int k = 0; k < 4; ++k) { const float send = c1 ? q8_[k] : q8_[k + 4], keep = c1 ? q8_[k + 4] : q8_[k]; q4_[k] = keep + __shfl_xor(send, 2); } \
        _Pragma("unroll") for (int k = 0; k < 2; ++k) { const float send = c0 ? q4_[k] : q4_[k + 2], keep = c0 ? q4_[k + 2] : q4_[k]; q2_[k] = keep + __shfl_xor(send, 1); } \
        GAS float* up_ = (GAS float*)(Upart + ((size_t)s * M + (tk)) * 128 + 64 * c2 + 32 * c1 + 16 * c0 + r); up_[0] = q2_[0]; up_[8] = q2_[1]; } while (0)
__device__ __forceinline__ void peer_u_phase(int s, int tok0, int tstride, int nitems, const v2u* route, const float* x1, const unsigned char* TU8s, float* Upart, LAS unsigned char* scr, int lane) {
    const int r = lane >> 3, c = lane & 7, c2 = (lane >> 2) & 1, c1 = (lane >> 1) & 1, c0 = lane & 1; const unsigned l8 = (unsigned)lane * 8u;
    const char* tbs = (const char*)TU8s + (size_t)s * NEXP * 128 + 16 * c;
    int m_e0, m_e1;
    v4u bufA[16], bufB[16]; float xsA[16], xsB[16];
    PC_META_U(tok0); PC_ISSUE_U(bufA, xsA, 0, tok0); if (nitems > 1) PC_META_U(tok0 + tstride);
#pragma unroll 1
    for (int i = 0; i < nitems; i += 2) {
        const int tk = tok0 + i * tstride;
        if (i + 1 < nitems) PC_ISSUE_U(bufB, xsB, 1, tk + tstride);
        if (i + 2 < nitems) PC_META_U(tk + 2 * tstride);
        PC_COMPUTE_U(bufA, xsA, tk);
        if (i + 1 < nitems) {
            if (i + 2 < nitems) PC_ISSUE_U(bufA, xsA, 0, tk + 2 * tstride);
            if (i + 3 < nitems) PC_META_U(tk + 3 * tstride);
            PC_COMPUTE_U(bufB, xsB, tk + tstride);
        }
    }
    LDS_WAIT();
}
#define PD_META_U(tk) do { const char* rb_ = (const char*)route + (size_t)(tk) * 1024; m_e0 = *(const GAS int*)(rb_ + l8); m_e1 = *(const GAS int*)(rb_ + 512 + l8); \
        { const unsigned xw_ = *(const GAS unsigned*)((const bf16*)x1 + (size_t)(tk) * D + 128 * s + 2 * lane); m_x.x = bflo(xw_); m_x.y = bfhi(xw_); } } while (0)
#define PD_ISSUE_U(buf, xq, xinv, par) do { LAS int* lid_ = (LAS int*)(scr + (par) * 1024); LAS unsigned short* lx_ = (LAS unsigned short*)(scr + (par) * 1024 + 512); lid_[lane] = m_e0; lid_[lane + 64] = m_e1; LDS_WAIT(); \
        _Pragma("unroll") for (int k = 0; k < 16; ++k) { const int e_ = lid_[8 * k + r]; buf[k] = *(const GAS v4u*)(tbs + (unsigned)(e_ * 128)); } \
        { float am_ = __builtin_fmaxf(__builtin_fabsf(m_x.x), __builtin_fabsf(m_x.y)); \
          _Pragma("unroll") for (int o_ = 1; o_ < 64; o_ <<= 1) am_ = __builtin_fmaxf(am_, __shfl_xor(am_, o_)); \
          const float sc_ = (am_ > 0.f) ? 127.0f / am_ : 0.f; xinv = am_ * (1.0f / 127.0f); \
          const int q0_ = (int)__builtin_rintf(m_x.x * sc_), q1_ = (int)__builtin_rintf(m_x.y * sc_); lx_[lane] = (unsigned short)(((unsigned)q0_ & 255u) | (((unsigned)q1_ & 255u) << 8)); } \
        LDS_WAIT(); xq = *(const LAS v4u*)((LAS unsigned char*)lx_ + 16 * c); } while (0)
#define PD_COMPUTE_U(buf, xq, xinv, tk) do { int p_[16]; \
        _Pragma("unroll") for (int k = 0; k < 16; ++k) { int a_ = __builtin_amdgcn_sdot4((int)buf[k].x, (int)xq.x, 0, false); a_ = __builtin_amdgcn_sdot4((int)buf[k].y, (int)xq.y, a_, false); \
            a_ = __builtin_amdgcn_sdot4((int)buf[k].z, (int)xq.z, a_, false); a_ = __builtin_amdgcn_sdot4((int)buf[k].w, (int)xq.w, a_, false); p_[k] = a_; } \
          \
        LAS int* red_ = (LAS int*)(scr + 2048); \
        _Pragma("unroll") for (int k = 0; k < 16; ++k) red_[64 * k + lane] = p_[k]; \
        LDS_WAIT(); \
        const v4u ra_ = *(const LAS v4u*)(red_ + 8 * lane + rsw), rb_ = *(const LAS v4u*)(red_ + 8 * lane + (4 - rsw)), rc_ = *(const LAS v4u*)(red_ + 512 + 8 * lane + rsw), rd_ = *(const LAS v4u*)(red_ + 512 + 8 * lane + (4 - rsw)); \
        const int s0_ = (int)(ra_.x + ra_.y + ra_.z + ra_.w + rb_.x + rb_.y + rb_.z + rb_.w), s1_ = (int)(rc_.x + rc_.y + rc_.z + rc_.w + rd_.x + rd_.y + rd_.z + rd_.w); \
        GAS bf16* up_ = (GAS bf16*)Upart + ((size_t)s * M + (tk)) * 128 + lane; const unsigned pk_ = cvtpk((float)s0_ * xinv, (float)s1_ * xinv); up_[0] = (bf16)(pk_ & 0xffffu); up_[64] = (bf16)(pk_ >> 16); } while (0)
__device__ __forceinline__ void peer_u_phase_dot4(int s, int tok0, int tstride, int nitems, const v2u* route, const float* x1, const unsigned char* TU8s, float* Upart, LAS unsigned char* scr, int lane) {
    const int r = lane >> 3, c = lane & 7, rsw = 4 * ((lane >> 3) & 1); const unsigned l8 = (unsigned)lane * 8u;
    const char* tbs = (const char*)TU8s + (size_t)s * NEXP * 128 + 16 * c;
    int m_e0, m_e1; f32x2 m_x;
    v4u bufA[16], bufB[16], xqA, xqB; float xiA, xiB;
    PD_META_U(tok0); PD_ISSUE_U(bufA, xqA, xiA, 0); if (nitems > 1) PD_META_U(tok0 + tstride);
#pragma unroll 1
    for (int it = 0; it < nitems; it += 2) {
        const int tk = tok0 + it * tstride;
        if (it + 1 < nitems) PD_ISSUE_U(bufB, xqB, xiB, 1);
        if (it + 2 < nitems) PD_META_U(tk + 2 * tstride);
        PD_COMPUTE_U(bufA, xqA, xiA, tk);
        if (it + 1 < nitems) {
            if (it + 2 < nitems) PD_ISSUE_U(bufA, xqA, xiA, 0);
            if (it + 3 < nitems) PD_META_U(tk + 3 * tstride);
            PD_COMPUTE_U(bufB, xqB, xiB, tk + tstride);
        }
    }
    LDS_WAIT();
}
__device__ __forceinline__ void peer_w_token(int tok, const v2u* route, const float* x1, const float* Upart, const float* SU, const float* SV, float* W, int lane) {
    const GAS f32x4* xp = (const GAS f32x4*)(x1 + (size_t)tok * D) + lane; float ssq = 0.f;
#pragma unroll
    for (int j = 0; j < 4; ++j) { const f32x4 q = xp[64 * j]; ssq += (q.x * q.x + q.y * q.y) + (q.z * q.z + q.w * q.w); }
    const float rstd2 = 1.0f / sqrtf(wave_sum(ssq) * (1.0f / D) + RMS_EPS);
    const char* rb_ = (const char*)route + (size_t)tok * 1024; const unsigned l8_ = (unsigned)lane * 8u;
    const v2u r_lo = *(const GAS v2u*)(rb_ + l8_), r_hi = *(const GAS v2u*)(rb_ + 512 + l8_);
    float g_lo, g_hi;
#pragma unroll
    for (int half = 0; half < 2; ++half) {
        const float sc_ = __builtin_bit_cast(float, half ? r_hi.y : r_lo.y) * rstd2; float m_ = sc_;
#pragma unroll
        for (int o = 1; o < 16; o <<= 1) m_ = __builtin_fmaxf(m_, __shfl_xor(m_, o));
        const float p_ = __builtin_amdgcn_exp2f((sc_ - m_) * 1.4426950408889634f); float sum_ = p_;
#pragma unroll
        for (int o = 1; o < 16; o <<= 1) sum_ += __shfl_xor(sum_, o);
        if (half) g_hi = p_ / sum_; else g_lo = p_ / sum_;
    }
    asm volatile("" : "+v"(g_lo), "+v"(g_hi));
#pragma unroll
    for (int half = 0; half < 2; ++half) {
        const int e = (int)(half ? r_hi.x : r_lo.x); const int n = lane + 64 * half;
        float dot = 0.f;
#pragma unroll
        for (int s8 = 0; s8 < 8; ++s8) dot += Upart[((size_t)s8 * M + tok) * 128 + n];
        const float act = gelu_exact(dot * SU[e] * rstd2);
        W[(size_t)tok * 128 + n] = (half ? g_hi : g_lo) * act * SV[e];
    }
}
__device__ __forceinline__ void peer_w_token2(int tokA, int tokB, const v2u* route, const bf16* x1b, const bf16* Upart, const float* SU, const float* SV, float* W, int lane) {
    v4u xv[2][2]; v2u r_lo[2], r_hi[2]; unsigned short ub[2][2][8];
#pragma unroll
    for (int t = 0; t < 2; ++t) { const int tok = t ? tokB : tokA;
        const GAS v4u* xp = (const GAS v4u*)(x1b + (size_t)tok * D) + lane; xv[t][0] = xp[0]; xv[t][1] = xp[64];
        const char* rb_ = (const char*)route + (size_t)tok * 1024; const unsigned l8_ = (unsigned)lane * 8u;
        r_lo[t] = *(const GAS v2u*)(rb_ + l8_); r_hi[t] = *(const GAS v2u*)(rb_ + 512 + l8_);
#pragma unroll
        for (int half = 0; half < 2; ++half)
#pragma unroll
            for (int s8 = 0; s8 < 8; ++s8) ub[t][half][s8] = *(const GAS bf16*)(Upart + ((size_t)s8 * M + tok) * 128 + lane + 64 * half); }
#pragma unroll
    for (int t = 0; t < 2; ++t) { const int tok = t ? tokB : tokA;
        float ssq = 0.f;
#pragma unroll
        for (int j = 0; j < 2; ++j) { const v4u q = xv[t][j];
            ssq += (bflo(q.x) * bflo(q.x) + bfhi(q.x) * bfhi(q.x)) + (bflo(q.y) * bflo(q.y) + bfhi(q.y) * bfhi(q.y)) + (bflo(q.z) * bflo(q.z) + bfhi(q.z) * bfhi(q.z)) + (bflo(q.w) * bflo(q.w) + bfhi(q.w) * bfhi(q.w)); }
        const float rstd2 = 1.0f / sqrtf(wave_sum(ssq) * (1.0f / D) + RMS_EPS);
        float g_lo, g_hi;
#pragma unroll
        for (int half = 0; half < 2; ++half) {
            const float sc_ = __builtin_bit_cast(float, half ? r_hi[t].y : r_lo[t].y) * rstd2; float m_ = sc_;
#pragma unroll
            for (int o = 1; o < 16; o <<= 1) m_ = __builtin_fmaxf(m_, __shfl_xor(m_, o));
            const float p_ = __builtin_amdgcn_exp2f((sc_ - m_) * 1.4426950408889634f); float sum_ = p_;
#pragma unroll
            for (int o = 1; o < 16; o <<= 1) sum_ += __shfl_xor(sum_, o);
            if (half) g_hi = p_ / sum_; else g_lo = p_ / sum_;
        }
        asm volatile("" : "+v"(g_lo), "+v"(g_hi));
#pragma unroll
        for (int half = 0; half < 2; ++half) {
            const int e = (int)(half ? r_hi[t].x : r_lo[t].x); const int n = lane + 64 * half;
            float dot = 0.f;
#pragma unroll
            for (int s8 = 0; s8 < 8; ++s8) dot += __builtin_bit_cast(float, (unsigned)ub[t][half][s8] << 16);
            const float act = gelu_exact(dot * SU[e] * rstd2);
            W[(size_t)tok * 128 + n] = (half ? g_hi : g_lo) * act * SV[e];
        }
    }
}
#define PC_META_V(tk) do { const char* rb_ = (const char*)route + (size_t)(tk) * 1024; m_e0 = *(const GAS int*)(rb_ + l8); m_e1 = *(const GAS int*)(rb_ + 512 + l8); \
        const GAS float* wp_ = (const GAS float*)(W + (size_t)(tk) * 128); m_w0 = wp_[lane]; m_w1 = wp_[lane + 64]; m_xv = *(const GAS unsigned*)(xres + (size_t)(tk) * D + col0); } while (0)
#define PC_ISSUE_V(buf, wk, xv, par) do { LAS int* lid_ = (LAS int*)(scr + (par) * 1024); LAS float* lw_ = (LAS float*)(scr + (par) * 1024 + 512); lid_[lane] = m_e0; lid_[lane + 64] = m_e1; lw_[lane] = m_w0; lw_[lane + 64] = m_w1; LDS_WAIT(); xv = m_xv; \
        _Pragma("unroll") for (int k = 0; k < 16; ++k) { const int e_ = lid_[8 * k + r]; wk[k] = lw_[8 * k + r]; buf[k] = *(const GAS v4u*)(tbs + (unsigned)(e_ * 128)); } } while (0)
#define PC_COMPUTE_V(buf, wk, xv, tk) do { f32x2 acc2[8]; _Pragma("unroll") for (int i_ = 0; i_ < 8; ++i_) acc2[i_] = (f32x2){0.f, 0.f}; \
        _Pragma("unroll") for (int k = 0; k < 16; ++k) { PIN_ACC2(buf[k]); fp8_row_axpy2(buf[k], wk[k], acc2); } \
          \
        LAS float* red_ = (LAS float*)(scr + 2048); LAS f32x4* wp_ = (LAS f32x4*)(red_ + 128 * r + 16 * c); \
        _Pragma("unroll") for (int j_ = 0; j_ < 4; ++j_) { f32x4 t_; t_.x = acc2[2 * j_].x; t_.y = acc2[2 * j_].y; t_.z = acc2[2 * j_ + 1].x; t_.w = acc2[2 * j_ + 1].y; wp_[j_] = t_; } \
        LDS_WAIT(); \
        f32x2 o_; o_.x = bflo(xv); o_.y = bfhi(xv); \
        _Pragma("unroll") for (int rr_ = 0; rr_ < 8; ++rr_) { const f32x2 t_ = *(const LAS f32x2*)(red_ + 128 * rr_ + 2 * lane); o_.x += t_.x; o_.y += t_.y; } \
        *(GAS f32x2*)(xio + (size_t)(tk) * D + col0) = o_; } while (0)
__device__ __forceinline__ void peer_v_phase(int s, int tok0, int tstride, int nitems, const v2u* route, const float* W, const unsigned char* TV8s, const bf16* xres, float* xio, float* SS, LAS unsigned char* scr, int lane) {
    const int r = lane >> 3, c = lane & 7; const unsigned l8 = (unsigned)lane * 8u;
    const int col0 = 128 * s + 2 * lane;
    const char* tbs = (const char*)TV8s + (size_t)s * NEXP * 128 + 16 * c;
    int m_e0, m_e1; float m_w0, m_w1; unsigned m_xv;
    v4u bufA[16], bufB[16]; float wA[16], wB[16]; unsigned xvA, xvB;
    PC_META_V(tok0); PC_ISSUE_V(bufA, wA, xvA, 0); if (nitems > 1) PC_META_V(tok0 + tstride);
#pragma unroll 1
    for (int i = 0; i < nitems; i += 2) {
        const int tk = tok0 + i * tstride;
        if (i + 1 < nitems) PC_ISSUE_V(bufB, wB, xvB, 1);
        if (i + 2 < nitems) PC_META_V(tk + 2 * tstride);
        PC_COMPUTE_V(bufA, wA, xvA, tk);
        if (i + 1 < nitems) {
            if (i + 2 < nitems) PC_ISSUE_V(bufA, wA, xvA, 0);
            if (i + 3 < nitems) PC_META_V(tk + 3 * tstride);
            PC_COMPUTE_V(bufB, wB, xvB, tk + tstride);
        }
    }
    LDS_WAIT();
}


__device__ __forceinline__ void peer_u_debug(int tok, const v2u* route, const float* x1, const unsigned char* TU8s, const float* SU, const float* SV, float* W, int lane) {
    float xr[16], ssq = 0.f;
    { const GAS f32x4* xp = (const GAS f32x4*)(x1 + (size_t)tok * D + 16 * lane);
#pragma unroll
      for (int j = 0; j < 4; ++j) { const f32x4 a = xp[j]; xr[4 * j] = a.x; xr[4 * j + 1] = a.y; xr[4 * j + 2] = a.z; xr[4 * j + 3] = a.w; } }
#pragma unroll
    for (int i = 0; i < 16; ++i) ssq += xr[i] * xr[i];
    const float rstd2 = 1.0f / sqrtf(wave_sum(ssq) * (1.0f / D) + RMS_EPS);
    const char* rb_ = (const char*)route + (size_t)tok * 1024; const int s = lane >> 3, c = lane & 7;
#pragma unroll 1
    for (int h = 0; h < 8; ++h) {
        float sc[16]; int id[16]; float m = -3e38f;
#pragma unroll
        for (int i = 0; i < 16; ++i) { const v2u r = *(const GAS v2u*)(rb_ + (h * 16 + i) * 8 + opaque_zero()); id[i] = (int)r.x; sc[i] = __builtin_bit_cast(float, r.y) * rstd2; m = __builtin_fmaxf(m, sc[i]); }
        float sum = 0.f;
#pragma unroll
        for (int i = 0; i < 16; ++i) { sc[i] = __builtin_amdgcn_exp2f((sc[i] - m) * 1.4426950408889634f); sum += sc[i]; }
#pragma unroll
        for (int i = 0; i < 16; ++i) { const int e = id[i];
            const v4u q = *(const GAS v4u*)(TU8s + ((size_t)s * NEXP + e) * 128 + 16 * c);
            float d; fp8_row_dot(q, xr, d); d = wave_sum(d);
            const float act = gelu_exact(d * SU[e] * rstd2);
            if (lane == 0) W[(size_t)tok * 128 + h * 16 + i] = (sc[i] / sum) * act * SV[e]; }
    }
}
__device__ __forceinline__ void peer_v_debug(int tok, const v2u* route, const float* W, const unsigned char* TV8s, float* xio, float* SS, int lane) {
    const char* rb_ = (const char*)route + (size_t)tok * 1024;
    float acc[16];
#pragma unroll
    for (int i = 0; i < 16; ++i) acc[i] = 0.f;
    const int s = lane >> 3, c = lane & 7;
#pragma unroll 1
    for (int n = 0; n < 128; ++n) {
        const int e = *(const GAS int*)(rb_ + n * 8 + opaque_zero()); const float w = W[(size_t)tok * 128 + n + opaque_zero()];
        const v4u q = *(const GAS v4u*)(TV8s + ((size_t)s * NEXP + e) * 128 + 16 * c);
        fp8_row_axpy(q, w, acc);
    }
    float ssq = 0.f;
    GAS float* xp = (GAS float*)(xio + (size_t)tok * D + 16 * lane);
#pragma unroll
    for (int i = 0; i < 16; ++i) { const float o = xp[i] + acc[i]; xp[i] = o; ssq += o * o; }
    ssq = wave_sum(ssq);
    if (lane < 8) SS[(size_t)lane * M + tok] = (lane == 0) ? ssq : 0.f;
}
#ifndef DUP_MASK
#define DUP_MASK 0
#endif
#define NREP(k) (1 + ((DUP_MASK >> (k)) & 1))
struct Args { const float* in[14]; float* out; unsigned char* ws; int ph_lo, ph_hi, li, pad; };
__global__ void __launch_bounds__(NWAVES * 64, 2) hybrid_fwd(Args args) {
    extern __shared__ __attribute__((aligned(16))) unsigned char lds[];
    LAS unsigned char* ldsb = (LAS unsigned char*)lds;
    volatile LAS unsigned* MISC = (volatile LAS unsigned*)(ldsb + MISC_OFF);
    const int tid = threadIdx.x, lane = tid & 63, wave = __builtin_amdgcn_readfirstlane(tid >> 6);
    const int G = gridDim.x; const int bx = blockIdx.x; const int vcu = (G % 8 == 0) ? (bx % 8) * (G / 8) + bx / 8 : bx;
    const int gw = vcu * NWAVES + wave, NGW = G * NWAVES;
    unsigned char* ws = args.ws;
    gu32* ctl = (gu32*)(ws + WS_CTL);
    const float* x = args.in[0]; float* out = args.out;
#define norm_mix (args.in[1])
#define w_in (args.in[2])
#define conv_w (args.in[3])
#define conv_b (args.in[4])
#define w_a (args.in[5])
#define w_b (args.in[6])
#define w_o (args.in[7])
#define norm_ffn (args.in[8])
#define w_q (args.in[9])
#define sub_keys (args.in[10])
#define exp_u (args.in[11])
#define exp_v (args.in[12])
#define final_norm (args.in[13])
#define Weff ((bf16*)((bf16*)(ws + WS_WEFF)))
#define Wab ((bf16*)((bf16*)(ws + WS_WAB)))
#define Wo_t ((bf16*)((bf16*)(ws + WS_WO)))
#define Win_t ((bf16*)((bf16*)(ws + WS_WIN)))
#define XB ((bf16*)((bf16*)(ws + WS_XB)))
#define SIX ((bf16*)((bf16*)(ws + WS_SIX)))
#define VT ((bf16*)((bf16*)(ws + WS_VT)))
#define GATE ((bf16*)((bf16*)(ws + WS_GATE)))
#define MERGED ((bf16*)((bf16*)(ws + WS_MERGED)))
#define X1B ((bf16*)((bf16*)(ws + WS_X1B)))
#define TU8 ((unsigned char*)(ws + WS_TU))
#define TV8 ((unsigned char*)(ws + WS_TV))
#define SU ((float*)((float*)(ws + WS_SU)))
#define SV ((float*)((float*)(ws + WS_SV)))
#define SCORES ((float*)((float*)(ws + WS_SCORES)))
#define ROUTE ((v2u*)((v2u*)(ws + WS_ROUTE)))
#define WBUF ((float*)((float*)(ws + WS_W)))
#define SSB ((float*)((float*)(ws + WS_SS)))
#define UPART ((float*)((float*)(ws + WS_UPART)))
#define RSTD1 ((float*)((float*)(ws + WS_RSTD1)))
#define QB ((bf16*)(SIX))
#define CBB ((bf16*)(SIX + (size_t)1 * M * 512))
#define KB ((bf16*)(SIX + (size_t)2 * M * 512))
#define CCB ((bf16*)(SIX + (size_t)4 * M * 512))
#define CUB ((bf16*)(SIX + (size_t)5 * M * 512))
    for (int u = tid; u < (LDS_BYTES - LDSCTL_OFF) / 4; u += NWAVES * 64) ((LAS unsigned*)(ldsb + LDSCTL_OFF))[u] = 0u;
    __syncthreads();
    XcdBarrier bar; bar.bar = (unsigned*)(ctl + CW_BAR); bar.x = 0; bar.st = nullptr;
    if (N_LAUNCHES == 1) bar = xcd_barrier_post((unsigned*)(ctl + CW_BAR), MISC + 8);
#define GRID_BAR() do { if (N_LAUNCHES == 1) xcd_barrier(bar); } while (0)
    const int lo = args.ph_lo, hi = args.ph_hi;
#define IN(k) (lo <= (k) && (k) < hi)
#define BOTH(k) (IN(k) && IN((k) + 1))

    if (IN(0)) { for (int rep = 0; rep < NREP(0); ++rep) {
        LAS float* scr = (LAS float*)(ldsb + RING_OFF + wave * 16384);
        constexpr int I_IN = (D / 64) * (NIN / 32), I_A = (512 / 64) * (D / 32), I_O = (D / 64) * (D / 32);
        constexpr int NITEMS = I_IN + 2 * I_A + I_O;
        constexpr int ABW = 3; const int aw = vcu * ABW + wave, NAW = G * ABW, cw = vcu * (NWAVES - ABW) + (wave - ABW), NCW = G * (NWAVES - ABW);
        if (wave < ABW) {
        for (int it = aw; it < NITEMS; it += NAW) {
            int r = it;
            if (r < I_IN) { p0_transpose_item(w_in, D, NIN, Win_t, 0, norm_mix, scr, r, lane); continue; } r -= I_IN;
            if (r < I_A) { p0_transpose_item(w_a, 512, D, Wab, 0, nullptr, scr, r, lane); continue; } r -= I_A;
            if (r < I_A) { p0_transpose_item(w_b, 512, D, Wab, 1024, nullptr, scr, r, lane); continue; } r -= I_A;
            p0_transpose_item(w_o, D, D, Wo_t, 0, nullptr, scr, r, lane);
        }
        for (int wt = aw; wt < 64 * 32; wt += NAW) {
            const int nt = wt & 63, kt = wt >> 6, hp = nt >> 2, h = lane >> 5, l32 = lane & 31;
            const GAS f32x4* ap = (const GAS f32x4*)(w_q + (size_t)(kt * 32 + l32) * 2048 + hp * 128 + 64 * h);
            const GAS f32x4* bp = (const GAS f32x4*)(sub_keys + (size_t)(nt * 32 + l32) * 128 + 64 * h);
            f32x4 av[16], bv[16];
#pragma unroll
            for (int i = 0; i < 16; ++i) { av[i] = ap[i]; bv[i] = bp[i]; }
            f32x16 acc;
#pragma unroll
            for (int i = 0; i < 16; ++i) acc[i] = 0.f;
#pragma unroll
            for (int i = 0; i < 16; ++i) {
                acc = __builtin_amdgcn_mfma_f32_32x32x2f32(av[i].x, bv[i].x, acc, 0, 0, 0); acc = __builtin_amdgcn_mfma_f32_32x32x2f32(av[i].y, bv[i].y, acc, 0, 0, 0);
                acc = __builtin_amdgcn_mfma_f32_32x32x2f32(av[i].z, bv[i].z, acc, 0, 0, 0); acc = __builtin_amdgcn_mfma_f32_32x32x2f32(av[i].w, bv[i].w, acc, 0, 0, 0); }
            const int n = nt * 32 + l32;
#pragma unroll
            for (int rq = 0; rq < 4; ++rq) { const int kb = kt * 32 + 8 * rq + 4 * h; const f32x4 g = *(const GAS f32x4*)(norm_ffn + kb);
                v2u o; o.x = pk2(acc[4 * rq] * g.x, acc[4 * rq + 1] * g.y); o.y = pk2(acc[4 * rq + 2] * g.z, acc[4 * rq + 3] * g.w);
                *(GAS v2u*)(Weff + (size_t)n * D + kb) = o; }
        }
        } else {
        for (int m0 = cw; m0 < M; m0 += 4 * NCW) {
            f32x4 v[4][4]; float s[4];
#pragma unroll
            for (int q = 0; q < 4; ++q) { const int m = m0 + q * NCW; const GAS f32x4* xr = (const GAS f32x4*)(x + (size_t)(m < M ? m : m0) * D) + lane;
#pragma unroll
                for (int j = 0; j < 4; ++j) v[q][j] = xr[64 * j]; }
#pragma unroll
            for (int q = 0; q < 4; ++q) { s[q] = 0.f;
#pragma unroll
                for (int j = 0; j < 4; ++j) s[q] += (v[q][j].x * v[q][j].x + v[q][j].y * v[q][j].y) + (v[q][j].z * v[q][j].z + v[q][j].w * v[q][j].w); }
#pragma unroll
            for (int o = 1; o < 64; o <<= 1) {
#pragma unroll
                for (int q = 0; q < 4; ++q) s[q] += __shfl_xor(s[q], o); }
#pragma unroll
            for (int q = 0; q < 4; ++q) { const int m = m0 + q * NCW; if (m < M) {
                const float rstd = 1.0f / sqrtf(s[q] * (1.0f / D) + RMS_EPS);
                GAS v2u* o8 = (GAS v2u*)(XB + (size_t)m * D) + lane;
#pragma unroll
                for (int j = 0; j < 4; ++j) { v2u o; o.x = pk2(v[q][j].x, v[q][j].y); o.y = pk2(v[q][j].z, v[q][j].w); o8[64 * j] = o; }
                if (lane == 0) RSTD1[m] = rstd; } }
        }
        for (int e0 = cw; e0 < NEXP; e0 += 2 * NCW) {
            float v[4][16]; float am[4]; int ee[4];
#pragma unroll
            for (int q = 0; q < 4; ++q) { const int e = e0 + (q >> 1) * NCW; ee[q] = e < NEXP ? e : e0; const float* src = ((q & 1) ? exp_v : exp_u) + (size_t)ee[q] * D; const GAS f32x4* sp = (const GAS f32x4*)src;
#pragma unroll
                for (int j = 0; j < 2; ++j) { const f32x4 a = sp[2 * lane + 128 * j], b = sp[2 * lane + 128 * j + 1];
                    v[q][8 * j + 0] = a.x; v[q][8 * j + 1] = a.y; v[q][8 * j + 2] = a.z; v[q][8 * j + 3] = a.w; v[q][8 * j + 4] = b.x; v[q][8 * j + 5] = b.y; v[q][8 * j + 6] = b.z; v[q][8 * j + 7] = b.w; } }
            { const GAS f32x4* gp = (const GAS f32x4*)norm_ffn;
#pragma unroll
              for (int j = 0; j < 2; ++j) { const f32x4 ga = gp[2 * lane + 128 * j], gb = gp[2 * lane + 128 * j + 1];
#pragma unroll
                for (int q = 0; q < 4; q += 2) { v[q][8 * j + 0] *= ga.x; v[q][8 * j + 1] *= ga.y; v[q][8 * j + 2] *= ga.z; v[q][8 * j + 3] *= ga.w; v[q][8 * j + 4] *= gb.x; v[q][8 * j + 5] *= gb.y; v[q][8 * j + 6] *= gb.z; v[q][8 * j + 7] *= gb.w; } } }
#pragma unroll
            for (int q = 0; q < 4; ++q) { am[q] = 0.f;
#pragma unroll
                for (int i = 0; i < 16; ++i) am[q] = __builtin_fmaxf(am[q], __builtin_fabsf(v[q][i])); }
#pragma unroll
            for (int o = 1; o < 64; o <<= 1) {
#pragma unroll
                for (int q = 0; q < 4; ++q) am[q] = __builtin_fmaxf(am[q], __shfl_xor(am[q], o)); }
#pragma unroll
            for (int q = 0; q < 4; ++q) { const int e = e0 + (q >> 1) * NCW; if (e < NEXP) {
                const float top = (q & 1) ? 384.0f : 127.0f;
                const float sc = (am[q] > 0.f) ? top / am[q] : 1.0f, inv = (am[q] > 0.f) ? am[q] * (1.0f / top) : 1.0f;
                v2u q0, q1;
                if (q & 1) {
                { int w = __builtin_amdgcn_cvt_pk_fp8_f32(v[q][0] * sc, v[q][1] * sc, 0, false); w = __builtin_amdgcn_cvt_pk_fp8_f32(v[q][2] * sc, v[q][3] * sc, w, true); q0.x = (unsigned)w; }
                { int w = __builtin_amdgcn_cvt_pk_fp8_f32(v[q][4] * sc, v[q][5] * sc, 0, false); w = __builtin_amdgcn_cvt_pk_fp8_f32(v[q][6] * sc, v[q][7] * sc, w, true); q0.y = (unsigned)w; }
                { int w = __builtin_amdgcn_cvt_pk_fp8_f32(v[q][8] * sc, v[q][9] * sc, 0, false); w = __builtin_amdgcn_cvt_pk_fp8_f32(v[q][10] * sc, v[q][11] * sc, w, true); q1.x = (unsigned)w; }
                { int w = __builtin_amdgcn_cvt_pk_fp8_f32(v[q][12] * sc, v[q][13] * sc, 0, false); w = __builtin_amdgcn_cvt_pk_fp8_f32(v[q][14] * sc, v[q][15] * sc, w, true); q1.y = (unsigned)w; }
                } else {
                    unsigned w4[4];
#pragma unroll
                    for (int j = 0; j < 4; ++j) { const int i0 = (int)__builtin_rintf(v[q][4 * j] * sc), i1 = (int)__builtin_rintf(v[q][4 * j + 1] * sc), i2 = (int)__builtin_rintf(v[q][4 * j + 2] * sc), i3 = (int)__builtin_rintf(v[q][4 * j + 3] * sc);
                        w4[j] = ((unsigned)i0 & 255u) | (((unsigned)i1 & 255u) << 8) | (((unsigned)i2 & 255u) << 16) | ((unsigned)i3 << 24); }
                    q0.x = w4[0]; q0.y = w4[1]; q1.x = w4[2]; q1.y = w4[3];
                }
                unsigned char* dst = (q & 1) ? TV8 : TU8; const int s0 = lane >> 4, o8 = 8 * (lane & 15);
                *(GAS v2u*)(dst + ((size_t)s0 * NEXP + e) * 128 + o8) = q0; *(GAS v2u*)(dst + ((size_t)(s0 + 4) * NEXP + e) * 128 + o8) = q1;
                if (lane == 0) ((q & 1) ? SV : SU)[e] = inv; } }
        }
                }
}
        if (BOTH(0)) GRID_BAR();
    }

    if (IN(1)) { for (int rep = 0; rep < NREP(1); ++rep) { if (rep) GRID_BAR();
        pg8::Gemm g{XB, Win_t, M, NIN, D}; pg8::StaticOrder S; S.init(M, NIN, G, (int)blockIdx.x);
        pg8::EpiProj E{SIX, VT, GATE, RSTD1, (DUP_MASK & 64) ? rep : 0};
        pg8::gemm_phase<pg8::EpiProj, pg8::StaticOrder, true, true>(ldsb + RING_OFF, g, S, E); }
        if (DUP_MASK & 128) { const unsigned long long t0 = __builtin_amdgcn_s_memrealtime(); while (__builtin_amdgcn_s_memrealtime() - t0 < 15000ull) __builtin_amdgcn_s_sleep(8); }
        if (BOTH(1)) GRID_BAR();
    }

    if (IN(2)) {
        for (int rep = 0; rep < NREP(2); ++rep) {
        const bool dummy = (rep + 1 < NREP(2));
        conv_phase(CBB, CCB, CUB, dummy ? XB : CBB, conv_w, conv_b, gw * 64 + lane, NGW * 64);
        for (int it = gw; it < BATCH * NH * (T / 32); it += NGW) {
            const int bh = it >> 7, qblk = it & 127;
            attn_item(QB, KB, VT, dummy ? MERGED : QB, bh >> 3, bh & 7, qblk, lane);
        }
        }
        if (BOTH(2)) GRID_BAR();
    }

    if (IN(3)) { for (int rep = 0; rep < NREP(3); ++rep) { if (rep) GRID_BAR();
        pg8::Gemm g{QB, Wab, 2 * M, 2048, 512}; pg8::PairOrder S; S.init(G, (int)blockIdx.x);
        pg8::EpiGate E{out, MERGED, GATE, GATE + (size_t)M * 1024};
        pg8::gemm_phase<pg8::EpiGate, pg8::PairOrder, true, true>(ldsb + RING_OFF, g, S, E); }
        if (BOTH(3)) GRID_BAR();
    }

    if (IN(4)) { for (int rep = 0; rep < NREP(4); ++rep) { if (rep) GRID_BAR();
        pg8::Gemm g{MERGED, Wo_t, M, D, D}; pg8::StaticOrder S; S.init(M, D, G, (int)blockIdx.x);
        pg8::EpiWo E{x, X1B};
        pg8::gemm_phase<pg8::EpiWo, pg8::StaticOrder, false, true>(ldsb + RING_OFF, g, S, E);
        }
        if (BOTH(4)) GRID_BAR();
    }

    if (IN(5)) { for (int rep = 0; rep < NREP(5); ++rep) { if (rep) GRID_BAR();
        pg8::Gemm g{X1B, Weff, M, 2048, D}; pg8::StaticOrder S; S.init(M, 2048, G, (int)blockIdx.x);
        pg8::EpiScores E{(unsigned short*)SCORES};
        pg8::gemm_phase<pg8::EpiScores, pg8::StaticOrder, true, true>(ldsb + RING_OFF, g, S, E);
        asm volatile("s_waitcnt vmcnt(0)" ::: "memory"); __syncthreads();
        int nu = 0; { pg8::Unit u; while (S.next(nu, u)) ++nu; }
        LAS unsigned char* scr = ldsb + RING_OFF + wave * 8192;
        for (int t = wave; t < nu * 4; t += NWAVES) { pg8::Unit u; S.next(t >> 2, u); route_task((const unsigned short*)SCORES, ROUTE, u.pm * 256 + (t & 3) * 64, u.pn, scr, lane); } }
        if (BOTH(5)) GRID_BAR();
    }
    const bool sliced_ok = (G % 8 == 0) && (M % ((G / 8) * NWAVES) == 0);

    if (IN(7)) {
        LAS unsigned char* scr = ldsb + RING_OFF + wave * 8192;
#ifdef DEBUG_U
        if (1) {} else
#endif
        if (sliced_ok) { const int nj = G >> 3; peer_u_phase_dot4(bx & 7, (bx >> 3) * NWAVES + wave, nj * NWAVES, M / (nj * NWAVES), ROUTE, (const float*)X1B, TU8, UPART, scr, lane); }
        else for (int s8 = 0; s8 < 8; ++s8) { const int nt = (M - 1 - gw) / NGW + 1; if (gw < M) peer_u_phase_dot4(s8, gw, NGW, nt, ROUTE, (const float*)X1B, TU8, UPART, scr, lane); }
        if (BOTH(7)) GRID_BAR();
    }

    if (IN(8)) {
#ifdef DEBUG_U
        for (int tok = gw; tok < M; tok += NGW) peer_u_debug(tok, ROUTE, out, TU8, SU, SV, WBUF, lane);
#else
        for (int tok = gw; tok < M; tok += 2 * NGW) peer_w_token2(tok, (tok + NGW < M) ? tok + NGW : tok, ROUTE, X1B, (const bf16*)UPART, SU, SV, WBUF, lane);
#endif
        if (BOTH(8)) GRID_BAR();
    }

    if (IN(9)) {
        LAS unsigned char* scr = ldsb + RING_OFF + wave * 8192;
#ifdef DEBUG_V
        for (int tok = gw; tok < M; tok += NGW) peer_v_debug(tok, ROUTE, WBUF, TV8, out, SSB, lane);
        if (0)
#endif
        if (sliced_ok) { const int nj = G >> 3; peer_v_phase(bx & 7, (bx >> 3) * NWAVES + wave, nj * NWAVES, M / (nj * NWAVES), ROUTE, WBUF, TV8, X1B, out, SSB, scr, lane); }
        else for (int s8 = 0; s8 < 8; ++s8) { const int nt = (M - 1 - gw) / NGW + 1; if (gw < M) peer_v_phase(s8, gw, NGW, nt, ROUTE, WBUF, TV8, X1B, out, SSB, scr, lane); }
        if (BOTH(9)) GRID_BAR();
    }

    if (IN(10)) {
        for (int tok = gw; tok < M; tok += NGW) {
            GAS f32x4* op = (GAS f32x4*)(out + (size_t)tok * D) + lane; const GAS f32x4* gp = (const GAS f32x4*)final_norm + lane;
            f32x4 v[4]; float s2 = 0.f;
#pragma unroll
            for (int j = 0; j < 4; ++j) { v[j] = op[64 * j]; s2 += (v[j].x * v[j].x + v[j].y * v[j].y) + (v[j].z * v[j].z + v[j].w * v[j].w); }
            const float rstd3 = 1.0f / sqrtf(wave_sum(s2) * (1.0f / D) + RMS_EPS);
#pragma unroll
            for (int j = 0; j < 4; ++j) { const f32x4 g = gp[64 * j]; f32x4 o; o.x = v[j].x * rstd3 * g.x; o.y = v[j].y * rstd3 * g.y; o.z = v[j].z * rstd3 * g.z; o.w = v[j].w * rstd3 * g.w; op[64 * j] = o; }
        }
    }
#undef IN
#undef BOTH
#undef GRID_BAR
#undef norm_mix
#undef w_in
#undef conv_w
#undef conv_b
#undef w_a
#undef w_b
#undef w_o
#undef norm_ffn
#undef w_q
#undef sub_keys
#undef exp_u
#undef exp_v
#undef final_norm
#undef Weff
#undef Wab
#undef Wo_t
#undef Win_t
#undef XB
#undef SIX
#undef VT
#undef GATE
#undef MERGED
#undef X1B
#undef TU8
#undef TV8
#undef SU
#undef SV
#undef SCORES
#undef ROUTE
#undef WBUF
#undef SSB
#undef UPART
#undef RSTD1
#undef QB
#undef CBB
#undef KB
#undef CCB
#undef CUB
}

extern "C" void kernel_launch(void* const* d_in, const int* in_sizes, int n_in, void* d_out, int out_size, void* d_ws, size_t ws_size, hipStream_t stream) {
    static int grid = 0;
    if (grid == 0) {
        if (n_in != 14 || in_sizes[0] != M * D || out_size != M * D || ws_size < WS_END) { fprintf(stderr, "kernel_launch: built for 14 inputs, x/out of %d floats, >= %zu bytes of workspace; got n_in %d, in0 %d, out %d, ws %zu; nothing launched\n", M * D, (size_t)WS_END, n_in, n_in > 0 ? in_sizes[0] : -1, out_size, ws_size); grid = -1; return; }
        int dev = 0, cus = 0, per_cu = 0;
        if (hipGetDevice(&dev) != hipSuccess || hipDeviceGetAttribute(&cus, hipDeviceAttributeMultiprocessorCount, dev) != hipSuccess) { fprintf(stderr, "kernel_launch: device query failed\n"); grid = -1; return; }
        if (hipFuncSetAttribute((const void*)hybrid_fwd, hipFuncAttributeMaxDynamicSharedMemorySize, LDS_BYTES) != hipSuccess) { fprintf(stderr, "kernel_launch: hipFuncSetAttribute failed\n"); grid = -1; return; }
        if (hipOccupancyMaxActiveBlocksPerMultiprocessor(&per_cu, (const void*)hybrid_fwd, NWAVES * 64, LDS_BYTES) != hipSuccess || per_cu < 1) { fprintf(stderr, "kernel_launch: occupancy query reports %d workgroups per CU\n", per_cu); per_cu = 1; }
        (void)hipGetLastError();
        grid = cus;
    }
    if (grid < 0) return;
    if (hipMemsetAsync((char*)d_ws + WS_CTL, 0, CTL_ZERO_BYTES, stream) != hipSuccess) { fprintf(stderr, "kernel_launch: hipMemsetAsync failed\n"); return; }
    Args a{};
    for (int i = 0; i < 14; ++i) a.in[i] = (const float*)d_in[i];
    a.out = (float*)d_out; a.ws = (unsigned char*)d_ws;
#ifdef PROBE_SEQ
    const int seq[] = PROBE_SEQ; const int nseq = (int)(sizeof(seq) / sizeof(int));
#else
    const int seq[] = {0, 1, 2, 3, 4, 5, 6, 7, 8, 9, 10}; const int nseq = (N_LAUNCHES == 1) ? 1 : 11;
#endif
    for (int li = 0; li < nseq; ++li) {
        a.ph_lo = (N_LAUNCHES == 1) ? 0 : seq[li]; a.ph_hi = (N_LAUNCHES == 1) ? N_PHASES : seq[li] + 1; a.li = li;
        hipLaunchKernelGGL(hybrid_fwd, dim3(grid), dim3(NWAVES * 64), LDS_BYTES, stream, a);
        const hipError_t le = hipPeekAtLastError();
        if (le != hipSuccess) { fprintf(stderr, "kernel_launch: launch %d failed: %s\n", li, hipGetErrorName(le)); break; }
    }
}
```

```cpp
#define DUP_MASK 0
#include <hip/hip_runtime.h>
#include <cstdio>
#include <cstdint>
#include <cmath>
namespace pg8 {
#define PG8_LAS __attribute__((address_space(3)))
typedef unsigned short bf16_t;
typedef short bf16x8 __attribute__((ext_vector_type(8)));
typedef float f32x4 __attribute__((ext_vector_type(4)));
typedef unsigned u32x4 __attribute__((ext_vector_type(4)));
constexpr int BM = 256, BK = 64, HALF = 128, HTB = HALF * BK * 2  , STAGE_BYTES = 8 * HTB, NXCD = 8, WGM = 8;

__host__ __device__ __forceinline__ int lds_byte(int r, int c) { const int st = (r >> 4) * 2 + (c >> 5), rr = r & 15, cc = c & 31, ob = rr * 64 + cc * 2; return st * 1024 + (ob ^ (((ob >> 9) & 1) << 5)); }
__host__ __device__ __forceinline__ void stage_rc(int b, int& R, int& C) { const int st = b / 1024, sb = b % 1024, swz = sb ^ (((sb >> 9) & 1) << 5); R = (st >> 1) * 16 + swz / 64; C = (st & 1) * 32 + (swz % 64) / 2; }
__host__ __device__ __forceinline__ int perm32(int rho) { const int n = rho >> 4, i = rho & 15; return 8 * (i >> 2) + 4 * n + (i & 3); }

struct Unit { int pm, pn; };
struct Gemm { const bf16_t* A; const bf16_t* Bt; int M, N, K; };

struct StaticOrder {
    int nM, nN, nwg, G, c;
    __host__ __device__ void init(int M, int N, int G_, int c_) { nM = M / BM; nN = N / BM; nwg = nM * nN; G = G_; c = c_; }
    __host__ __device__ bool next(int i, Unit& u) const {
        const long L = (long)i * G + c; if (L >= nwg) return false;
        int wgid = (int)L; { const int q = nwg / NXCD, r = nwg % NXCD, xcd = wgid % NXCD, off = wgid / NXCD; wgid = (xcd < r ? xcd * (q + 1) : r * (q + 1) + (xcd - r) * q) + off; }
        const int nig = WGM * nN, gid = wgid / nig, fm = gid * WGM, gsz = (nM - fm) < WGM ? (nM - fm) : WGM;
        u.pm = fm + ((wgid % nig) % gsz); u.pn = (wgid % nig) / gsz; return true;
    }
    __device__ __forceinline__ void a_ready(const Unit&) const {}
    __device__ __forceinline__ void done(const Unit&) const {}
};

__device__ __forceinline__ unsigned cvt_pk_bf16(float lo, float hi) { unsigned r; asm volatile("v_cvt_pk_bf16_f32 %0, %1, %2" : "=v"(r) : "v"(lo), "v"(hi)); return r; }
constexpr int MTOK = 16384;
__device__ __forceinline__ unsigned f2bf_rne(float f) { unsigned u = __builtin_bit_cast(unsigned, f); return (u + 0x7fffu + ((u >> 16) & 1u)) >> 16; }
__device__ __forceinline__ float bf_lo(unsigned w) { return __builtin_bit_cast(float, w << 16); }
__device__ __forceinline__ float bf_hi(unsigned w) { return __builtin_bit_cast(float, w & 0xffff0000u); }
__device__ __forceinline__ float sigmoid_fast(float x) { return __builtin_amdgcn_rcpf(1.0f + __builtin_amdgcn_exp2f(-1.4426950408889634f * x)); }

struct EpiProj {
    static constexpr bool PERM = true, AFTER_DRAIN = false;
    bf16_t* six;
    bf16_t* vt;
    bf16_t* gate;
    const float* rstd; int skip;
    __device__ __forceinline__ void operator()(const f32x4 (&acc)[2][2][4][2], const Unit& u, int wr, int wc, int fr, int fq) const {
        const int row0 = u.pm * BM + wr * 64 + fr; const int colt = u.pn * BM;
        if (skip) return;
        if (colt < 3072) {
            const int t = colt >> 9, cc = colt & 511;
            if (t == 2) {
#pragma unroll
                for (int ai = 0; ai < 2; ++ai)
#pragma unroll
                    for (int m = 0; m < 4; ++m) { const int r = row0 + ai * HALF + m * 16; const float rs = rstd[r]; const int b = r >> 12, tt = r & 4095;
#pragma unroll
                        for (int bj = 0; bj < 2; ++bj) { const int c0 = cc + bj * HALF + wc * 32 + 8 * fq; const int hh = c0 >> 6, d0 = c0 & 63;
                            bf16_t* p = vt + ((size_t)((b * 8 + hh) * 64 + d0)) * 4096 + tt;
#pragma unroll
                            for (int n = 0; n < 2; ++n)
#pragma unroll
                                for (int i = 0; i < 4; ++i) p[(size_t)(4 * n + i) * 4096] = (bf16_t)f2bf_rne(acc[ai][bj][m][n][i] * rs); } }
            } else {
                const int bufidx = (t == 0) ? 0 : (t == 1) ? 2 : (t == 3) ? 1 : t;
                bf16_t* base = six + (size_t)bufidx * MTOK * 512; const float sc = (t == 0) ? 0.125f : 1.0f;
                const int col0 = cc + wc * 32 + 8 * fq;
#pragma unroll
                for (int ai = 0; ai < 2; ++ai)
#pragma unroll
                    for (int m = 0; m < 4; ++m) { const int r = row0 + ai * HALF + m * 16; const float rs = rstd[r] * sc; bf16_t* rowp = base + (size_t)r * 512 + col0;
#pragma unroll
                        for (int bj = 0; bj < 2; ++bj) { const f32x4 v0 = acc[ai][bj][m][0] * rs, v1 = acc[ai][bj][m][1] * rs;
                            u32x4 w; w.x = cvt_pk_bf16(v0[0], v0[1]); w.y = cvt_pk_bf16(v0[2], v0[3]); w.z = cvt_pk_bf16(v1[0], v1[1]); w.w = cvt_pk_bf16(v1[2], v1[3]);
                            *(u32x4*)(rowp + bj * HALF) = w; } }
            }
        } else {
            const int gi = (colt - 3072) >> 10, cc = (colt - 3072) & 1023;
            bf16_t* base = gate + (size_t)gi * MTOK * 1024; const int col0 = cc + wc * 32 + 8 * fq;
#pragma unroll
            for (int ai = 0; ai < 2; ++ai)
#pragma unroll
                for (int m = 0; m < 4; ++m) { const int r = row0 + ai * HALF + m * 16; const float rs = rstd[r]; bf16_t* rowp = base + (size_t)r * 1024 + col0;
#pragma unroll
                    for (int bj = 0; bj < 2; ++bj) { f32x4 v0 = acc[ai][bj][m][0] * rs, v1 = acc[ai][bj][m][1] * rs;
#pragma unroll
                        for (int i = 0; i < 4; ++i) { v0[i] = sigmoid_fast(v0[i]); v1[i] = sigmoid_fast(v1[i]); }
                        u32x4 w; w.x = cvt_pk_bf16(v0[0], v0[1]); w.y = cvt_pk_bf16(v0[2], v0[3]); w.z = cvt_pk_bf16(v1[0], v1[1]); w.w = cvt_pk_bf16(v1[2], v1[3]);
                        *(u32x4*)(rowp + bj * HALF) = w; } }
        }
    }
};

struct EpiGate {
    static constexpr bool PERM = true, AFTER_DRAIN = false;
    float* P; bf16_t* merged; const bf16_t* g0; const bf16_t* g1;
    __device__ __forceinline__ void operator()(const f32x4 (&acc)[2][2][4][2], const Unit& u, int wr, int wc, int fr, int fq) const {
        const int which = (u.pm >= 64) ? 1 : 0; const int pm = u.pm - 64 * which, pn = u.pn - 4 * which;
        const int row0 = pm * BM + wr * 64 + fr, col0 = pn * BM + wc * 32 + 8 * fq; const bf16_t* g = which ? g1 : g0;
#pragma unroll
        for (int ai = 0; ai < 2; ++ai)
#pragma unroll
            for (int m = 0; m < 4; ++m) { const int r = row0 + ai * HALF + m * 16;
#pragma unroll
                for (int bj = 0; bj < 2; ++bj) { const size_t off = (size_t)r * 1024 + col0 + bj * HALF;
                    const u32x4 gv = *(const u32x4*)(g + off);
                    f32x4 a0 = acc[ai][bj][m][0], a1 = acc[ai][bj][m][1];
                    a0[0] *= bf_lo(gv.x); a0[1] *= bf_hi(gv.x); a0[2] *= bf_lo(gv.y); a0[3] *= bf_hi(gv.y);
                    a1[0] *= bf_lo(gv.z); a1[1] *= bf_hi(gv.z); a1[2] *= bf_lo(gv.w); a1[3] *= bf_hi(gv.w);
                    if (!which) { u32x4 w; w.x = cvt_pk_bf16(a0[0], a0[1]); w.y = cvt_pk_bf16(a0[2], a0[3]); w.z = cvt_pk_bf16(a1[0], a1[1]); w.w = cvt_pk_bf16(a1[2], a1[3]); *(u32x4*)((bf16_t*)P + off) = w; }
                    else { const u32x4 pw = *(const u32x4*)((const bf16_t*)P + off);
                        a0[0] += bf_lo(pw.x); a0[1] += bf_hi(pw.x); a0[2] += bf_lo(pw.y); a0[3] += bf_hi(pw.y); a1[0] += bf_lo(pw.z); a1[1] += bf_hi(pw.z); a1[2] += bf_lo(pw.w); a1[3] += bf_hi(pw.w);
                        u32x4 w; w.x = cvt_pk_bf16(a0[0], a0[1]); w.y = cvt_pk_bf16(a0[2], a0[3]); w.z = cvt_pk_bf16(a1[0], a1[1]); w.w = cvt_pk_bf16(a1[2], a1[3]);
                        *(u32x4*)(merged + off) = w; } } }
    }
};
struct PairOrder {
    StaticOrder so;
    __host__ __device__ void init(int G_, int c_) { so.init(MTOK, 1024, G_, c_); }
    __host__ __device__ bool next(int i, Unit& u) const { Unit t; if (!so.next(i >> 1, t)) return false; const int w = i & 1; u.pm = t.pm + 64 * w; u.pn = t.pn + 4 * w; return true; }
    __device__ __forceinline__ void a_ready(const Unit&) const {}
    __device__ __forceinline__ void done(const Unit&) const {}
};

struct EpiWo {
    static constexpr bool PERM = true, AFTER_DRAIN = false;
    const float* x; bf16_t* x1b;
    __device__ __forceinline__ void operator()(const f32x4 (&acc)[2][2][4][2], const Unit& u, int wr, int wc, int fr, int fq) const {
        const int row0 = u.pm * BM + wr * 64 + fr, col0 = u.pn * BM + wc * 32 + 8 * fq;
#pragma unroll
        for (int ai = 0; ai < 2; ++ai)
#pragma unroll
            for (int m = 0; m < 4; ++m) { const int r = row0 + ai * HALF + m * 16;
#pragma unroll
                for (int bj = 0; bj < 2; ++bj) { const size_t off = (size_t)r * 1024 + col0 + bj * HALF;
                    const f32x4 a0 = acc[ai][bj][m][0] + *(const f32x4*)(x + off), a1 = acc[ai][bj][m][1] + *(const f32x4*)(x + off + 4);
                    u32x4 w; w.x = cvt_pk_bf16(a0[0], a0[1]); w.y = cvt_pk_bf16(a0[2], a0[3]); w.z = cvt_pk_bf16(a1[0], a1[1]); w.w = cvt_pk_bf16(a1[2], a1[3]);
                    *(u32x4*)(x1b + off) = w; } }
    }
};
typedef _Float16 f16x2_t __attribute__((ext_vector_type(2)));
typedef float f32x2e __attribute__((ext_vector_type(2)));
__device__ __forceinline__ unsigned pk_f16(float lo, float hi) { f32x2e v = {lo, hi}; f16x2_t h = __builtin_convertvector(v, f16x2_t); return __builtin_bit_cast(unsigned, h); }
struct EpiScores {
    static constexpr bool PERM = true, AFTER_DRAIN = false;
    unsigned short* S;
    __device__ __forceinline__ void operator()(const f32x4 (&acc)[2][2][4][2], const Unit& u, int wr, int wc, int fr, int fq) const {
        const int row0 = u.pm * BM + wr * 64 + fr, col0 = u.pn * BM + wc * 32 + 8 * fq;
#pragma unroll
        for (int ai = 0; ai < 2; ++ai)
#pragma unroll
            for (int m = 0; m < 4; ++m) { const int r = row0 + ai * HALF + m * 16;
#pragma unroll
                for (int bj = 0; bj < 2; ++bj) { const size_t off = ((size_t)((col0 + bj * HALF) >> 3) * MTOK + r) * 8;
                    const f32x4 a0 = acc[ai][bj][m][0], a1 = acc[ai][bj][m][1];
                    u32x4 w; w.x = pk_f16(a0[0], a0[1]); w.y = pk_f16(a0[2], a0[3]); w.z = pk_f16(a1[0], a1[1]); w.w = pk_f16(a1[2], a1[3]);
                    *(u32x4*)(S + off) = w; } }
    }
};
template <class Epi, class Sched, bool ALIGN_EPI = false, bool SP2 = false>
__device__ __forceinline__ void gemm_phase(PG8_LAS unsigned char* lds, const Gemm g, const Sched& S, const Epi& E) {
    const int tid = threadIdx.x, wid = __builtin_amdgcn_readfirstlane(tid >> 6), lane = tid & 63, wr = wid >> 2, wc = wid & 3, fr = lane & 15, fq = lane >> 4;
    const int K = g.K, nt = K / BK;
    unsigned voffA[2], voffB[2];
#pragma unroll
    for (int i = 0; i < 2; ++i) { int R, C; stage_rc(tid * 16 + i * 8192, R, C); const int Rb = Epi::PERM ? ((R & ~31) + perm32(R & 31)) : R;
        voffA[i] = (unsigned)(R * K + C) * 2u; voffB[i] = (unsigned)(Rb * K + C) * 2u; }
    const size_t kstep = (size_t)(BK * 2);
    const size_t hstep = (size_t)HALF * K * 2;
    const size_t tstep = 2 * hstep;
    const unsigned ldsw = (unsigned)wid * 1024u;
    const int aoff = lds_byte(wr * 64 + fr, fq * 8), boff = lds_byte(wc * 32 + fr, fq * 8);
#define PG8_SA(b, h) (((b) * 2 + (h)) * HTB)
#define PG8_SB(b, h) ((4 + (b) * 2 + (h)) * HTB)
#define PG8_STAGE(bufoff, gbase, voff) do { _Pragma("unroll") for (int _i = 0; _i < 2; ++_i) \
        __builtin_amdgcn_global_load_lds((const unsigned*)((const char*)(gbase) + (voff)[_i]), (PG8_LAS unsigned*)(lds + (bufoff) + ldsw + _i * 8192), 16, 0, 0); } while (0)
#define PG8_LDA(dst, b, h) do { _Pragma("unroll") for (int m = 0; m < 4; ++m) _Pragma("unroll") for (int k = 0; k < 2; ++k) dst[m][k] = *(const PG8_LAS bf16x8*)(lds + PG8_SA(b, h) + aoff + m * 2048 + k * 1024); } while (0)
#define PG8_LDB(dst, b, h) do { _Pragma("unroll") for (int n = 0; n < 2; ++n) _Pragma("unroll") for (int k = 0; k < 2; ++k) dst[n][k] = *(const PG8_LAS bf16x8*)(lds + PG8_SB(b, h) + boff + n * 2048 + k * 1024); } while (0)
#define PG8_MMA(ai, bj, At, Bt) do { __builtin_amdgcn_s_setprio(1); _Pragma("unroll") for (int m = 0; m < 4; ++m) _Pragma("unroll") for (int n = 0; n < 2; ++n) _Pragma("unroll") for (int k = 0; k < 2; ++k) \
        acc[ai][bj][m][n] = __builtin_amdgcn_mfma_f32_16x16x32_bf16(Bt[n][k], At[m][k], acc[ai][bj][m][n], 0, 0, 0); __builtin_amdgcn_s_setprio(0); } while (0)
#define PG8_WAIT_V(n) asm volatile("s_waitcnt vmcnt(" #n ")" ::: "memory")
#define PG8_WAIT_L(n) asm volatile("s_waitcnt lgkmcnt(" #n ")" ::: "memory")
#define PG8_BAR __builtin_amdgcn_s_barrier()
#define PG8_SCHED __builtin_amdgcn_sched_barrier(0)
    Unit cur, nxt; int ui = 0;
    if (!S.next(0, cur)) return;
    f32x4 acc[2][2][4][2];
#pragma unroll
    for (int a = 0; a < 2; ++a)
#pragma unroll
        for (int b = 0; b < 2; ++b)
#pragma unroll
            for (int m = 0; m < 4; ++m)
#pragma unroll
                for (int n = 0; n < 2; ++n) acc[a][b][m][n] = (f32x4){0.f, 0.f, 0.f, 0.f};
    bf16x8 At[4][2], B0[2][2], B1[2][2];
    const char* cA = (const char*)g.A + (size_t)cur.pm * tstep; const char* cB = (const char*)g.Bt + (size_t)cur.pn * tstep;
    S.a_ready(cur);
    if constexpr (SP2) {
        PG8_STAGE(PG8_SB(0, 0), cB, voffB); PG8_STAGE(PG8_SB(0, 1), cB + hstep, voffB); PG8_STAGE(PG8_SA(0, 0), cA, voffA); PG8_STAGE(PG8_SA(0, 1), cA + hstep, voffA);
        if (wr == 1) PG8_BAR;
        PG8_WAIT_V(2); PG8_BAR;
        PG8_STAGE(PG8_SB(1, 0), cB + kstep, voffB); PG8_STAGE(PG8_SA(1, 0), cA + kstep, voffA); PG8_STAGE(PG8_SB(1, 1), cB + hstep + kstep, voffB);
        PG8_WAIT_V(6); PG8_BAR;
    } else {
        PG8_STAGE(PG8_SB(0, 0), cB, voffB); PG8_STAGE(PG8_SA(0, 0), cA, voffA); PG8_STAGE(PG8_SB(0, 1), cB + hstep, voffB); PG8_STAGE(PG8_SA(0, 1), cA + hstep, voffA);
        if (wr == 1) PG8_BAR;
        PG8_WAIT_V(4); PG8_BAR;
        PG8_STAGE(PG8_SB(1, 0), cB + kstep, voffB); PG8_STAGE(PG8_SA(1, 0), cA + kstep, voffA); PG8_STAGE(PG8_SB(1, 1), cB + hstep + kstep, voffB);
        PG8_WAIT_V(6); PG8_BAR;
    }
    for (;;) {
        const bool has_next = S.next(ui + 1, nxt);
        const char* nA = has_next ? (const char*)g.A + (size_t)nxt.pm * tstep : cA; const char* nB = has_next ? (const char*)g.Bt + (size_t)nxt.pn * tstep : cB;
        for (int t = 0; t < nt; t += 2) {
            const bool last = (t == nt - 2);
            const char* a1 = cA + (size_t)(t + 1) * kstep;
            const char* a2 = last ? nA : cA + (size_t)(t + 2) * kstep; const char* b2 = last ? nB : cB + (size_t)(t + 2) * kstep;
            const char* a3 = a2 + kstep; const char* b3 = b2 + kstep;
            if (last && has_next) S.a_ready(nxt);
            if constexpr (SP2) {
            PG8_LDB(B0, 0, 0); PG8_LDB(B1, 0, 1); PG8_SCHED; PG8_LDA(At, 0, 0); PG8_STAGE(PG8_SA(1, 1), a1 + hstep, voffA);
            PG8_WAIT_V(8); PG8_WAIT_L(0); PG8_BAR; PG8_MMA(0, 0, At, B0); PG8_MMA(0, 1, At, B1); PG8_BAR; PG8_SCHED;
            PG8_LDA(At, 0, 1); PG8_STAGE(PG8_SB(0, 0), b2, voffB); PG8_STAGE(PG8_SB(0, 1), b2 + hstep, voffB); PG8_STAGE(PG8_SA(0, 0), a2, voffA);
            PG8_WAIT_V(8); PG8_WAIT_L(0); PG8_BAR; PG8_MMA(1, 0, At, B0); PG8_MMA(1, 1, At, B1); PG8_BAR; PG8_SCHED;
            PG8_LDB(B0, 1, 0); PG8_LDB(B1, 1, 1); PG8_SCHED; PG8_LDA(At, 1, 0); PG8_STAGE(PG8_SA(0, 1), a2 + hstep, voffA);
            PG8_WAIT_V(8); PG8_WAIT_L(0); PG8_BAR; PG8_MMA(0, 0, At, B0); PG8_MMA(0, 1, At, B1); PG8_BAR; PG8_SCHED;
            PG8_LDA(At, 1, 1); PG8_STAGE(PG8_SB(1, 0), b3, voffB); PG8_STAGE(PG8_SB(1, 1), b3 + hstep, voffB); PG8_STAGE(PG8_SA(1, 0), a3, voffA);
            PG8_WAIT_V(8); PG8_WAIT_L(0); PG8_BAR; PG8_MMA(1, 0, At, B0); PG8_MMA(1, 1, At, B1); PG8_BAR; PG8_SCHED;
            } else {
            PG8_LDB(B0, 0, 0); PG8_SCHED; PG8_LDA(At, 0, 0); PG8_STAGE(PG8_SA(1, 1), a1 + hstep, voffA);
            PG8_WAIT_L(8); PG8_BAR; PG8_WAIT_L(0); PG8_MMA(0, 0, At, B0); PG8_BAR; PG8_SCHED;
            PG8_LDB(B1, 0, 1); PG8_STAGE(PG8_SB(0, 0), b2, voffB);
            PG8_BAR; PG8_WAIT_L(0); PG8_MMA(0, 1, At, B1); PG8_BAR;
            PG8_LDA(At, 0, 1); PG8_STAGE(PG8_SA(0, 0), a2, voffA);
            PG8_BAR; PG8_WAIT_L(0); PG8_MMA(1, 0, At, B0); PG8_BAR; PG8_SCHED;
            PG8_STAGE(PG8_SB(0, 1), b2 + hstep, voffB);
            PG8_WAIT_V(6); PG8_BAR; PG8_MMA(1, 1, At, B1); PG8_BAR;
            PG8_LDB(B0, 1, 0); PG8_SCHED; PG8_LDA(At, 1, 0); PG8_STAGE(PG8_SA(0, 1), a2 + hstep, voffA);
            PG8_WAIT_L(8); PG8_BAR; PG8_WAIT_L(0); PG8_MMA(0, 0, At, B0); PG8_BAR; PG8_SCHED;
            PG8_LDB(B1, 1, 1); PG8_STAGE(PG8_SB(1, 0), b3, voffB);
            PG8_BAR; PG8_WAIT_L(0); PG8_MMA(0, 1, At, B1); PG8_BAR;
            PG8_LDA(At, 1, 1); PG8_STAGE(PG8_SA(1, 0), a3, voffA);
            PG8_BAR; PG8_WAIT_L(0); PG8_MMA(1, 0, At, B0); PG8_BAR; PG8_SCHED;
            PG8_STAGE(PG8_SB(1, 1), b3 + hstep, voffB);
            PG8_WAIT_V(6); PG8_BAR; PG8_MMA(1, 1, At, B1); PG8_BAR;
            }
        }
        if constexpr (ALIGN_EPI) { if (wr == 0) PG8_BAR; }
        if constexpr (!Epi::AFTER_DRAIN) { E(acc, cur, wr, wc, fr, fq); S.done(cur); }
        if (!has_next) break;
#pragma unroll
        for (int a = 0; a < 2; ++a)
#pragma unroll
            for (int b = 0; b < 2; ++b)
#pragma unroll
                for (int m = 0; m < 4; ++m)
#pragma unroll
                    for (int n = 0; n < 2; ++n) acc[a][b][m][n] = (f32x4){0.f, 0.f, 0.f, 0.f};
        cur = nxt; cA = nA; cB = nB; ++ui;
        if constexpr (ALIGN_EPI) { if (wr == 1) PG8_BAR; }
    }
    PG8_WAIT_V(0);
    if constexpr (!ALIGN_EPI) { if (wr == 0) PG8_BAR; }
    PG8_BAR;
    if constexpr (Epi::AFTER_DRAIN) { E.fused(acc, cur, wr, wc, fr, fq, lds, wid, lane); S.done(cur); }
#undef PG8_SA
#undef PG8_SB
#undef PG8_STAGE
#undef PG8_LDA
#undef PG8_LDB
#undef PG8_MMA
#undef PG8_WAIT_V
#undef PG8_WAIT_L
#undef PG8_BAR
#undef PG8_SCHED
}
}

constexpr int NWAVES = 8;
constexpr int BATCH = 4, T = 4096, D = 1024, NH = 8, HD = 64, NIN = 5120;
constexpr int M = BATCH * T;
constexpr int NEXP = 16384;
constexpr float RMS_EPS = 1e-6f;
#ifndef MK_N_LAUNCHES
#define MK_N_LAUNCHES 1
#endif
constexpr int N_PHASES = 11;
constexpr int N_LAUNCHES = MK_N_LAUNCHES;

constexpr size_t MiB = 1u << 20;
constexpr size_t WS_CTL = 0, CTL_ZERO_BYTES = 64 * 1024;
constexpr size_t WS_RSTD1 = 512 * 1024;
constexpr size_t WS_WEFF = 1 * MiB;
constexpr size_t WS_WAB = 5 * MiB;
constexpr size_t WS_WO = 7 * MiB;
constexpr size_t WS_WIN = 9 * MiB;
constexpr size_t WS_XB = 19 * MiB;
constexpr size_t WS_SIX = 51 * MiB;
constexpr size_t WS_VT = WS_SIX + 3 * 16 * MiB;
constexpr size_t WS_GATE = 147 * MiB;
constexpr size_t WS_MERGED = 19 * MiB;
constexpr size_t WS_X1B = 51 * MiB;
constexpr size_t WS_TU = 211 * MiB, WS_TV = 227 * MiB;
constexpr size_t WS_SU = 576 * 1024, WS_SV = 640 * 1024;
constexpr size_t WS_SCORES = 83 * MiB;
constexpr size_t WS_ROUTE = 19 * MiB;
constexpr size_t WS_W = 35 * MiB;
constexpr size_t WS_SS = 43 * MiB;
constexpr size_t WS_UPART = 83 * MiB;
constexpr size_t WS_END = 256 * MiB;
constexpr int CW_BAR = 4096;

constexpr int RING_OFF = 0, RING_BYTES = 131072;
constexpr int LDSCTL_OFF = RING_BYTES;
constexpr int LDS_BYTES = 147456;
constexpr int MISC_OFF = LDS_BYTES - 128;

#define GAS __attribute__((address_space(1)))
#define LAS __attribute__((address_space(3)))
#define CAS __attribute__((address_space(4)))
typedef unsigned short bf16;
typedef unsigned v4u __attribute__((ext_vector_type(4)));
typedef unsigned v2u __attribute__((ext_vector_type(2)));
typedef float f32x4 __attribute__((ext_vector_type(4)));
typedef float f32x2 __attribute__((ext_vector_type(2)));
typedef float f32x16 __attribute__((ext_vector_type(16)));
typedef short bf16x8 __attribute__((ext_vector_type(8)));
typedef _Float16 f16x8 __attribute__((ext_vector_type(8)));
typedef _Float16 f16x2 __attribute__((ext_vector_type(2)));
typedef __bf16 bf16x2_t __attribute__((ext_vector_type(2)));
typedef GAS unsigned gu32;
#define RLX_AGENT __ATOMIC_RELAXED, __HIP_MEMORY_SCOPE_AGENT
#define LDS_WAIT() asm volatile("s_waitcnt lgkmcnt(0)" ::: "memory")
#define VM_WAIT() asm volatile("s_waitcnt vmcnt(0)" ::: "memory")
__device__ __forceinline__ unsigned f2bf(float f) { unsigned u = __builtin_bit_cast(unsigned, f); return (u + 0x7fffu + ((u >> 16) & 1u)) >> 16; }
__device__ __forceinline__ unsigned pk2(float lo, float hi) { return f2bf(lo) | (f2bf(hi) << 16); }
__device__ __forceinline__ unsigned cvtpk(float lo, float hi) { f32x2 v = {lo, hi}; bf16x2_t b = __builtin_convertvector(v, bf16x2_t); return __builtin_bit_cast(unsigned, b); }
__device__ __forceinline__ float bflo(unsigned w) { return __builtin_bit_cast(float, w << 16); }
__device__ __forceinline__ float bfhi(unsigned w) { return __builtin_bit_cast(float, w & 0xffff0000u); }
__device__ __forceinline__ float wave_sum(float v) {
#pragma unroll
    for (int o = 1; o < 64; o <<= 1) v += __shfl_xor(v, o);
    return v;
}
#define XB_TMO      128
#define XB_XCNT(j)  (256  + 64 * (j))
#define XB_XSUB(j)  (1280 + 64 * (j))
#define XB_XGEN(j)  (2304 + 64 * (j))
#define XB_TOP      3328
#define XB_TOPGEN   3392
#define XCD_BAR_WORDS 3456
#define XB_SPIN_CAP (1u << 18)

__device__ __forceinline__ unsigned xb_ld(unsigned* p)              { return __hip_atomic_load(p, __ATOMIC_RELAXED, __HIP_MEMORY_SCOPE_AGENT); }
__device__ __forceinline__ unsigned xb_add(unsigned* p, unsigned v) { return __hip_atomic_fetch_add(p, v, __ATOMIC_RELAXED, __HIP_MEMORY_SCOPE_AGENT); }
__device__ __forceinline__ unsigned xb_xcc_id() { return (unsigned)__builtin_amdgcn_s_getreg((3 << 11) | 20) & 0xFu; }
#define XB_SPIN(cond, bar) do { unsigned _sp = 0; while (cond) { __builtin_amdgcn_s_sleep(1); \
    if ((++_sp & 255u) == 0u) { if (xb_ld(&(bar)[XB_TMO])) break; if (_sp > XB_SPIN_CAP) { atomicAdd(&(bar)[XB_TMO], 1u); break; } } } } while (0)

struct XcdBarrier {
    unsigned* bar; unsigned x;
    volatile LAS unsigned* st;
};

__device__ __forceinline__ XcdBarrier xcd_barrier_post(unsigned* bar, volatile LAS unsigned* st) {
    XcdBarrier b; b.bar = bar; b.x = xb_xcc_id(); b.st = st;
    if (threadIdx.x == 0) (void)xb_add(&bar[XB_XCNT(b.x)], 1u);
    return b;
}
__device__ __forceinline__ void xcd_barrier_complete(unsigned* bar, unsigned x, unsigned& nloc, unsigned& nx) {
    const unsigned G = gridDim.x * gridDim.y * gridDim.z;
    unsigned sum, cnt, mine, sp = 0u;
    for (;;) {
        sum = 0u; cnt = 0u; mine = 0u;
#pragma unroll
        for (unsigned j = 0; j < 16; ++j) { const unsigned c = xb_ld(&bar[XB_XCNT(j)]); sum += c; cnt += (c > 0u) ? 1u : 0u; mine = (j == x) ? c : mine; }
        if (sum == G) break;
        __builtin_amdgcn_s_sleep(1);
        if ((++sp & 255u) == 0u) { if (xb_ld(&bar[XB_TMO])) break; if (sp > XB_SPIN_CAP) { atomicAdd(&bar[XB_TMO], 1u); break; } }
    }
    nloc = mine > 0u ? mine : 1u; nx = cnt > 0u ? cnt : 1u;
}

__device__ __forceinline__ void xcd_barrier(const XcdBarrier& b) {
    asm volatile("s_waitcnt vmcnt(0)" ::: "memory");
    __syncthreads();
    if (threadIdx.x == 0) {
        unsigned* bar = b.bar;
        __builtin_amdgcn_s_waitcnt(0);
        unsigned nloc = b.st[0], nx = b.st[1];
        if (nloc == 0u) { xcd_barrier_complete(bar, b.x, nloc, nx); b.st[0] = nloc; b.st[1] = nx; }
        const unsigned old = xb_add(&bar[XB_XSUB(b.x)], 1u);
        const unsigned gen = old / nloc;
        if (old + 1u == (gen + 1u) * nloc) {
            __builtin_amdgcn_fence(__ATOMIC_RELEASE, "agent");
            asm volatile("s_waitcnt vmcnt(0)" ::: "memory");
            const unsigned og = xb_add(&bar[XB_TOP], 1u);
            const unsigned tg = og / nx;
            if (og + 1u == (tg + 1u) * nx) xb_add(&bar[XB_TOPGEN], 1u);
            else XB_SPIN(xb_ld(&bar[XB_TOPGEN]) == tg, bar);
            __builtin_amdgcn_fence(__ATOMIC_ACQUIRE, "agent");
            xb_add(&bar[XB_XGEN(b.x)], 1u);
            asm volatile("s_waitcnt vmcnt(0)" ::: "memory");
        } else {
            XB_SPIN(xb_ld(&bar[XB_XGEN(b.x)]) == gen, bar);
            __builtin_amdgcn_fence(__ATOMIC_ACQUIRE, "agent");
            asm volatile("s_waitcnt vmcnt(0)" ::: "memory");
        }
    }
    __syncthreads();
}

__device__ __forceinline__ void p0_transpose_item(const float* W, int K, int N, bf16* WT, int row_off, const float* kscale, LAS float* scr, int item, int lane) {
    const int nblk = N / 32, kb = item / nblk, nb = item % nblk, k0 = 64 * kb, n0 = 32 * nb;
    f32x4 ld[8];
#pragma unroll
    for (int i = 0; i < 8; ++i) ld[i] = __builtin_nontemporal_load((const GAS f32x4*)(W + (size_t)(k0 + 8 * i + (lane >> 3)) * N + n0 + 4 * (lane & 7)));
#pragma unroll
    for (int i = 0; i < 8; ++i) { LAS float* d = scr + (8 * i + (lane >> 3)) * 33 + 4 * (lane & 7); d[0] = ld[i].x; d[1] = ld[i].y; d[2] = ld[i].z; d[3] = ld[i].w; }
    LDS_WAIT(); asm volatile("" ::: "memory");
    const int c = lane & 7;
    float ks[8];
#pragma unroll
    for (int i = 0; i < 8; ++i) ks[i] = kscale ? kscale[k0 + 8 * c + i] : 1.0f;
#pragma unroll
    for (int j = 0; j < 4; ++j) { const int n = (lane >> 3) + 8 * j; const LAS float* s = scr + (8 * c) * 33 + n;
        v4u o; o.x = pk2(s[0 * 33] * ks[0], s[1 * 33] * ks[1]); o.y = pk2(s[2 * 33] * ks[2], s[3 * 33] * ks[3]); o.z = pk2(s[4 * 33] * ks[4], s[5 * 33] * ks[5]); o.w = pk2(s[6 * 33] * ks[6], s[7 * 33] * ks[7]);
        *(GAS v4u*)(WT + (size_t)(row_off + n0 + n) * K + k0 + 8 * c) = o; }
    LDS_WAIT(); asm volatile("" ::: "memory");
}

__device__ __forceinline__ void conv_phase(const bf16* CB, const bf16* CC, const bf16* CU, bf16* CO, const float* cw, const float* cbias, int gtid, int nthreads) {
    for (int task = gtid; task < M * 64; task += nthreads) {
        const int tok = task >> 6, c8 = (task & 63) * 8, tt = tok & (T - 1);
        const size_t off = (size_t)tok * 512 + c8;
        float z[3][8];
#pragma unroll
        for (int k = 0; k < 3; ++k) {
            const int dt = 2 - k;
            if (tt >= dt) { const v4u a = *(const GAS v4u*)(CC + off - (size_t)dt * 512), b = *(const GAS v4u*)(CU + off - (size_t)dt * 512);
                z[k][0] = bflo(a.x) * bflo(b.x); z[k][1] = bfhi(a.x) * bfhi(b.x); z[k][2] = bflo(a.y) * bflo(b.y); z[k][3] = bfhi(a.y) * bfhi(b.y);
                z[k][4] = bflo(a.z) * bflo(b.z); z[k][5] = bfhi(a.z) * bfhi(b.z); z[k][6] = bflo(a.w) * bflo(b.w); z[k][7] = bfhi(a.w) * bfhi(b.w); }
            else {
#pragma unroll
                for (int i = 0; i < 8; ++i) z[k][i] = 0.f; }
        }
        float y[8];
#pragma unroll
        for (int i = 0; i < 8; ++i) y[i] = cbias[c8 + i];
#pragma unroll
        for (int k = 0; k < 3; ++k)
#pragma unroll
            for (int i = 0; i < 8; ++i) y[i] += cw[k * 512 + c8 + i] * z[k][i];
        const v4u g = *(const GAS v4u*)(CB + off);
        v4u o; o.x = pk2(bflo(g.x) * y[0], bfhi(g.x) * y[1]); o.y = pk2(bflo(g.y) * y[2], bfhi(g.y) * y[3]); o.z = pk2(bflo(g.z) * y[4], bfhi(g.z) * y[5]); o.w = pk2(bflo(g.w) * y[6], bfhi(g.w) * y[7]);
        *(GAS v4u*)(CO + off) = o;
    }
}

__device__ __forceinline__ int crow(int r, int hf) { return (r & 3) + 8 * (r >> 2) + 4 * hf; }
#define MFMA_BF16(a, b, c) __builtin_amdgcn_mfma_f32_32x32x16_bf16((a), (b), (c), 0, 0, 0)
#define MFMA_F16(a, b, c) __builtin_amdgcn_mfma_f32_32x32x16_f16((a), (b), (c), 0, 0, 0)
__device__ __forceinline__ void attn_item(const bf16* Qb, const bf16* Kb, const bf16* VT, bf16* Ob, int b, int h, int qblk, int lane) {
    const int t32 = lane & 31, hf = lane >> 5, q0 = qblk * 32, tq = q0 + t32;
    const size_t rowbase = (size_t)b * T;
    const float LOG2E = 1.4426950408889634f, LN2 = 0.6931471805599453f;
    bf16x8 qf[4];
    { const bf16* qp = Qb + (rowbase + q0 + t32) * 512 + h * 64 + 8 * hf;
#pragma unroll
      for (int st = 0; st < 4; ++st) qf[st] = *(const GAS bf16x8*)(qp + 16 * st); }
    f16x8 tri[2];
#pragma unroll
    for (int st = 0; st < 2; ++st)
#pragma unroll
        for (int e = 0; e < 8; ++e) { const int j = 16 * st + 8 * (e >> 2) + 4 * hf + (e & 3); tri[st][e] = (j >= t32) ? (_Float16)1.0f : (_Float16)0.0f; }
    f32x16 o0, o1;
#pragma unroll
    for (int r = 0; r < 16; ++r) { o0[r] = 0.f; o1[r] = 0.f; }
    float R = 0.f;
    const bf16* kbase = Kb + rowbase * 512 + h * 64 + 8 * hf;
    const bf16* vtb = VT + ((size_t)(b * 8 + h) * 64 + t32) * T + 4 * hf;
    for (int jt = q0 >> 6; jt >= 0; --jt) {
        const int k0 = jt * 64;
        f32x16 s0, s1;
#pragma unroll
        for (int r = 0; r < 16; ++r) { s0[r] = 0.f; s1[r] = 0.f; }
#pragma unroll
        for (int st = 0; st < 4; ++st) {
            const bf16x8 a0 = *(const GAS bf16x8*)(kbase + (size_t)(k0 + t32) * 512 + 16 * st);
            const bf16x8 a1 = *(const GAS bf16x8*)(kbase + (size_t)(k0 + 32 + t32) * 512 + 16 * st);
            s0 = MFMA_BF16(a0, qf[st], s0); s1 = MFMA_BF16(a1, qf[st], s1);
        }
        f32x16 L0, L1; float tot0 = 0.f, tot1 = 0.f;
#pragma unroll
        for (int r = 0; r < 16; ++r) {
            const int key = k0 + crow(r, hf);
            { const float z = s0[r]; const float e = __builtin_amdgcn_exp2f(-__builtin_fabsf(z) * LOG2E); const float lp = __builtin_amdgcn_logf(1.0f + e) * LN2;
              const float L = (key < tq) ? -(__builtin_fmaxf(z, 0.f) + lp) : 0.f; L0[r] = L; tot0 += L; }
            { const float z = s1[r]; const float e = __builtin_amdgcn_exp2f(-__builtin_fabsf(z) * LOG2E); const float lp = __builtin_amdgcn_logf(1.0f + e) * LN2;
              const float L = (key + 32 < tq) ? -(__builtin_fmaxf(z, 0.f) + lp) : 0.f; L1[r] = L; tot1 += L; }
        }
        tot0 += __shfl_xor(tot0, 32); tot1 += __shfl_xor(tot1, 32);
        f16x8 lf00, lf01, lf10, lf11;
#pragma unroll
        for (int e = 0; e < 8; ++e) { lf00[e] = (_Float16)L0[e]; lf01[e] = (_Float16)L0[8 + e]; lf10[e] = (_Float16)L1[e]; lf11[e] = (_Float16)L1[8 + e]; }
        f32x16 y0, y1;
#pragma unroll
        for (int r = 0; r < 16; ++r) { y0[r] = 0.f; y1[r] = 0.f; }
        y0 = MFMA_F16(tri[0], lf00, y0); y0 = MFMA_F16(tri[1], lf01, y0);
        y1 = MFMA_F16(tri[0], lf10, y1); y1 = MFMA_F16(tri[1], lf11, y1);
        const float base0 = R + tot1, base1 = R;
        float a0v[16], a1v[16];
#pragma unroll
        for (int r = 0; r < 16; ++r) {
            const int key = k0 + crow(r, hf);
            a0v[r] = (key < tq) ? __builtin_amdgcn_exp2f((s0[r] + y0[r] + base0) * LOG2E) : 0.f;
            a1v[r] = (key + 32 < tq) ? __builtin_amdgcn_exp2f((s1[r] + y1[r] + base1) * LOG2E) : 0.f;
        }
        bf16x8 pf[2][2];
#pragma unroll
        for (int st = 0; st < 2; ++st) {
            v4u w0, w1;
            w0.x = cvtpk(a0v[8 * st + 0], a0v[8 * st + 1]); w0.y = cvtpk(a0v[8 * st + 2], a0v[8 * st + 3]); w0.z = cvtpk(a0v[8 * st + 4], a0v[8 * st + 5]); w0.w = cvtpk(a0v[8 * st + 6], a0v[8 * st + 7]);
            w1.x = cvtpk(a1v[8 * st + 0], a1v[8 * st + 1]); w1.y = cvtpk(a1v[8 * st + 2], a1v[8 * st + 3]); w1.z = cvtpk(a1v[8 * st + 4], a1v[8 * st + 5]); w1.w = cvtpk(a1v[8 * st + 6], a1v[8 * st + 7]);
            pf[0][st] = __builtin_bit_cast(bf16x8, w0); pf[1][st] = __builtin_bit_cast(bf16x8, w1);
        }
#pragma unroll
        for (int kb = 0; kb < 2; ++kb)
#pragma unroll
            for (int st = 0; st < 2; ++st) {
                const int kk = k0 + 32 * kb + 16 * st;
                { const v2u lo = *(const GAS v2u*)(vtb + kk), hi = *(const GAS v2u*)(vtb + kk + 8); v4u w; w.x = lo.x; w.y = lo.y; w.z = hi.x; w.w = hi.y;
                  o0 = MFMA_BF16(__builtin_bit_cast(bf16x8, w), pf[kb][st], o0); }
                { const v2u lo = *(const GAS v2u*)(vtb + (size_t)32 * T + kk), hi = *(const GAS v2u*)(vtb + (size_t)32 * T + kk + 8); v4u w; w.x = lo.x; w.y = lo.y; w.z = hi.x; w.w = hi.y;
                  o1 = MFMA_BF16(__builtin_bit_cast(bf16x8, w), pf[kb][st], o1); }
            }
        R += tot0 + tot1;
        if (__all(R < -104.0f)) break;
    }
    bf16* op = Ob + (rowbase + q0 + t32) * 512 + h * 64 + 4 * hf;
#pragma unroll
    for (int q4 = 0; q4 < 4; ++q4) {
        v2u w; w.x = cvtpk(o0[4 * q4], o0[4 * q4 + 1]); w.y = cvtpk(o0[4 * q4 + 2], o0[4 * q4 + 3]); *(GAS v2u*)(op + 8 * q4) = w;
        v2u w2; w2.x = cvtpk(o1[4 * q4], o1[4 * q4 + 1]); w2.y = cvtpk(o1[4 * q4 + 2], o1[4 * q4 + 3]); *(GAS v2u*)(op + 32 + 8 * q4) = w2;
    }
}

#define RT_C8(op_str, cnt, x0, x1, x2, x3, x4, x5, x6, x7, thr) asm volatile(op_str : "+v"(cnt) : "v"(x0), "v"(x1), "v"(x2), "v"(x3), "v"(x4), "v"(x5), "v"(x6), "v"(x7), "v"(thr) : "vcc")
#define RT_GE8 "v_cmp_ge_f32 vcc, %1, %9\n\tv_addc_co_u32_e32 %0, vcc, 0, %0, vcc\n\tv_cmp_ge_f32 vcc, %2, %9\n\tv_addc_co_u32_e32 %0, vcc, 0, %0, vcc\n\tv_cmp_ge_f32 vcc, %3, %9\n\tv_addc_co_u32_e32 %0, vcc, 0, %0, vcc\n\tv_cmp_ge_f32 vcc, %4, %9\n\tv_addc_co_u32_e32 %0, vcc, 0, %0, vcc\n\tv_cmp_ge_f32 vcc, %5, %9\n\tv_addc_co_u32_e32 %0, vcc, 0, %0, vcc\n\tv_cmp_ge_f32 vcc, %6, %9\n\tv_addc_co_u32_e32 %0, vcc, 0, %0, vcc\n\tv_cmp_ge_f32 vcc, %7, %9\n\tv_addc_co_u32_e32 %0, vcc, 0, %0, vcc\n\tv_cmp_ge_f32 vcc, %8, %9\n\tv_addc_co_u32_e32 %0, vcc, 0, %0, vcc"
#define RT_GT8 "v_cmp_gt_f32 vcc, %1, %9\n\tv_addc_co_u32_e32 %0, vcc, 0, %0, vcc\n\tv_cmp_gt_f32 vcc, %2, %9\n\tv_addc_co_u32_e32 %0, vcc, 0, %0, vcc\n\tv_cmp_gt_f32 vcc, %3, %9\n\tv_addc_co_u32_e32 %0, vcc, 0, %0, vcc\n\tv_cmp_gt_f32 vcc, %4, %9\n\tv_addc_co_u32_e32 %0, vcc, 0, %0, vcc\n\tv_cmp_gt_f32 vcc, %5, %9\n\tv_addc_co_u32_e32 %0, vcc, 0, %0, vcc\n\tv_cmp_gt_f32 vcc, %6, %9\n\tv_addc_co_u32_e32 %0, vcc, 0, %0, vcc\n\tv_cmp_gt_f32 vcc, %7, %9\n\tv_addc_co_u32_e32 %0, vcc, 0, %0, vcc\n\tv_cmp_gt_f32 vcc, %8, %9\n\tv_addc_co_u32_e32 %0, vcc, 0, %0, vcc"
#define RT_COUNT128(OPS, cnt, thr) do { cnt = 0; RT_C8(OPS, cnt, v[0], v[1], v[2], v[3], v[4], v[5], v[6], v[7], thr); RT_C8(OPS, cnt, v[8], v[9], v[10], v[11], v[12], v[13], v[14], v[15], thr); RT_C8(OPS, cnt, v[16], v[17], v[18], v[19], v[20], v[21], v[22], v[23], thr); RT_C8(OPS, cnt, v[24], v[25], v[26], v[27], v[28], v[29], v[30], v[31], thr); RT_C8(OPS, cnt, v[32], v[33], v[34], v[35], v[36], v[37], v[38], v[39], thr); RT_C8(OPS, cnt, v[40], v[41], v[42], v[43], v[44], v[45], v[46], v[47], thr); RT_C8(OPS, cnt, v[48], v[49], v[50], v[51], v[52], v[53], v[54], v[55], thr); RT_C8(OPS, cnt, v[56], v[57], v[58], v[59], v[60], v[61], v[62], v[63], thr); RT_C8(OPS, cnt, v[64], v[65], v[66], v[67], v[68], v[69], v[70], v[71], thr); RT_C8(OPS, cnt, v[72], v[73], v[74], v[75], v[76], v[77], v[78], v[79], thr); RT_C8(OPS, cnt, v[80], v[81], v[82], v[83], v[84], v[85], v[86], v[87], thr); RT_C8(OPS, cnt, v[88], v[89], v[90], v[91], v[92], v[93], v[94], v[95], thr); RT_C8(OPS, cnt, v[96], v[97], v[98], v[99], v[100], v[101], v[102], v[103], thr); RT_C8(OPS, cnt, v[104], v[105], v[106], v[107], v[108], v[109], v[110], v[111], thr); RT_C8(OPS, cnt, v[112], v[113], v[114], v[115], v[116], v[117], v[118], v[119], thr); RT_C8(OPS, cnt, v[120], v[121], v[122], v[123], v[124], v[125], v[126], v[127], thr); } while (0)
#define RT_S5(op_str, cnt, a0, a1, a2, a3, a4, b0, b1, b2, b3, b4, thr) do { float t_; asm volatile(op_str : "+v"(cnt), "=&v"(t_) : "v"(a0), "v"(a1), "v"(a2), "v"(a3), "v"(a4), "v"(b0), "v"(b1), "v"(b2), "v"(b3), "v"(b4), "v"(thr) : "vcc"); } while (0)
#define RT_SGE5 "v_add_f32_e32 %1, %2, %7\n\tv_cmp_ge_f32 vcc, %1, %12\n\tv_addc_co_u32_e32 %0, vcc, 0, %0, vcc\n\tv_add_f32_e32 %1, %3, %8\n\tv_cmp_ge_f32 vcc, %1, %12\n\tv_addc_co_u32_e32 %0, vcc, 0, %0, vcc\n\tv_add_f32_e32 %1, %4, %9\n\tv_cmp_ge_f32 vcc, %1, %12\n\tv_addc_co_u32_e32 %0, vcc, 0, %0, vcc\n\tv_add_f32_e32 %1, %5, %10\n\tv_cmp_ge_f32 vcc, %1, %12\n\tv_addc_co_u32_e32 %0, vcc, 0, %0, vcc\n\tv_add_f32_e32 %1, %6, %11\n\tv_cmp_ge_f32 vcc, %1, %12\n\tv_addc_co_u32_e32 %0, vcc, 0, %0, vcc"
#define RT_SGT5 "v_add_f32_e32 %1, %2, %7\n\tv_cmp_gt_f32 vcc, %1, %12\n\tv_addc_co_u32_e32 %0, vcc, 0, %0, vcc\n\tv_add_f32_e32 %1, %3, %8\n\tv_cmp_gt_f32 vcc, %1, %12\n\tv_addc_co_u32_e32 %0, vcc, 0, %0, vcc\n\tv_add_f32_e32 %1, %4, %9\n\tv_cmp_gt_f32 vcc, %1, %12\n\tv_addc_co_u32_e32 %0, vcc, 0, %0, vcc\n\tv_add_f32_e32 %1, %5, %10\n\tv_cmp_gt_f32 vcc, %1, %12\n\tv_addc_co_u32_e32 %0, vcc, 0, %0, vcc\n\tv_add_f32_e32 %1, %6, %11\n\tv_cmp_gt_f32 vcc, %1, %12\n\tv_addc_co_u32_e32 %0, vcc, 0, %0, vcc"
#define RT_COUNT50(OPS, cnt, thr) do { cnt = 0; RT_S5(OPS, cnt, a[0], a[0], a[0], a[0], a[0], b[0], b[1], b[2], b[3], b[4], thr); RT_S5(OPS, cnt, a[0], a[0], a[0], a[0], a[0], b[5], b[6], b[7], b[8], b[9], thr); RT_S5(OPS, cnt, a[0], a[0], a[0], a[0], a[0], b[10], b[11], b[12], b[13], b[14], thr); RT_S5(OPS, cnt, a[0], a[1], a[1], a[1], a[1], b[15], b[0], b[1], b[2], b[3], thr); RT_S5(OPS, cnt, a[1], a[1], a[1], a[1], a[2], b[4], b[5], b[6], b[7], b[0], thr); RT_S5(OPS, cnt, a[2], a[2], a[2], a[2], a[3], b[1], b[2], b[3], b[4], b[0], thr); RT_S5(OPS, cnt, a[3], a[3], a[3], a[4], a[4], b[1], b[2], b[3], b[0], b[1], thr); RT_S5(OPS, cnt, a[4], a[5], a[5], a[6], a[6], b[2], b[0], b[1], b[0], b[1], thr); RT_S5(OPS, cnt, a[7], a[7], a[8], a[9], a[10], b[0], b[1], b[0], b[0], b[0], thr); RT_S5(OPS, cnt, a[11], a[12], a[13], a[14], a[15], b[0], b[0], b[0], b[0], b[0], thr); } while (0)
#define RT_CSWAP(x, xi, p, q) do { float t_; asm volatile("v_cmp_gt_f32 vcc, %1, %0\n\tv_cndmask_b32_e32 %4, %0, %1, vcc\n\tv_cndmask_b32_e32 %1, %1, %0, vcc\n\tv_mov_b32_e32 %0, %4\n\tv_cndmask_b32_e32 %4, %2, %3, vcc\n\tv_cndmask_b32_e32 %3, %3, %2, vcc\n\tv_mov_b32_e32 %2, %4" : "+v"(x[p]), "+v"(x[q]), "+v"(xi[p]), "+v"(xi[q]), "=&v"(t_) : : "vcc"); } while (0)
#define RT_SORT16(x, xi) do { RT_CSWAP(x, xi, 0, 1); RT_CSWAP(x, xi, 2, 3); RT_CSWAP(x, xi, 0, 2); RT_CSWAP(x, xi, 1, 3); RT_CSWAP(x, xi, 1, 2); RT_CSWAP(x, xi, 4, 5); RT_CSWAP(x, xi, 6, 7); RT_CSWAP(x, xi, 4, 6); RT_CSWAP(x, xi, 5, 7); RT_CSWAP(x, xi, 5, 6); RT_CSWAP(x, xi, 0, 4); RT_CSWAP(x, xi, 2, 6); RT_CSWAP(x, xi, 2, 4); RT_CSWAP(x, xi, 1, 5); RT_CSWAP(x, xi, 3, 7); RT_CSWAP(x, xi, 3, 5); RT_CSWAP(x, xi, 1, 2); RT_CSWAP(x, xi, 3, 4); RT_CSWAP(x, xi, 5, 6); RT_CSWAP(x, xi, 8, 9); RT_CSWAP(x, xi, 10, 11); RT_CSWAP(x, xi, 8, 10); RT_CSWAP(x, xi, 9, 11); RT_CSWAP(x, xi, 9, 10); RT_CSWAP(x, xi, 12, 13); RT_CSWAP(x, xi, 14, 15); RT_CSWAP(x, xi, 12, 14); RT_CSWAP(x, xi, 13, 15); RT_CSWAP(x, xi, 13, 14); RT_CSWAP(x, xi, 8, 12); RT_CSWAP(x, xi, 10, 14); RT_CSWAP(x, xi, 10, 12); RT_CSWAP(x, xi, 9, 13); RT_CSWAP(x, xi, 11, 15); RT_CSWAP(x, xi, 11, 13); RT_CSWAP(x, xi, 9, 10); RT_CSWAP(x, xi, 11, 12); RT_CSWAP(x, xi, 13, 14); RT_CSWAP(x, xi, 0, 8); RT_CSWAP(x, xi, 4, 12); RT_CSWAP(x, xi, 4, 8); RT_CSWAP(x, xi, 2, 10); RT_CSWAP(x, xi, 6, 14); RT_CSWAP(x, xi, 6, 10); RT_CSWAP(x, xi, 2, 4); RT_CSWAP(x, xi, 6, 8); RT_CSWAP(x, xi, 10, 12); RT_CSWAP(x, xi, 1, 9); RT_CSWAP(x, xi, 5, 13); RT_CSWAP(x, xi, 5, 9); RT_CSWAP(x, xi, 3, 11); RT_CSWAP(x, xi, 7, 15); RT_CSWAP(x, xi, 7, 11); RT_CSWAP(x, xi, 3, 5); RT_CSWAP(x, xi, 7, 9); RT_CSWAP(x, xi, 11, 13); RT_CSWAP(x, xi, 1, 2); RT_CSWAP(x, xi, 3, 4); RT_CSWAP(x, xi, 5, 6); RT_CSWAP(x, xi, 7, 8); RT_CSWAP(x, xi, 9, 10); RT_CSWAP(x, xi, 11, 12); RT_CSWAP(x, xi, 13, 14); } while (0)
#define RT_FOR_CANDS(F) F(0, 0) F(0, 1) F(0, 2) F(0, 3) F(0, 4) F(0, 5) F(0, 6) F(0, 7) F(0, 8) F(0, 9) F(0, 10) F(0, 11) F(0, 12) F(0, 13) F(0, 14) F(0, 15) F(1, 0) F(1, 1) F(1, 2) F(1, 3) F(1, 4) F(1, 5) F(1, 6) F(1, 7) F(2, 0) F(2, 1) F(2, 2) F(2, 3) F(2, 4) F(3, 0) F(3, 1) F(3, 2) F(3, 3) F(4, 0) F(4, 1) F(4, 2) F(5, 0) F(5, 1) F(6, 0) F(6, 1) F(7, 0) F(7, 1) F(8, 0) F(9, 0) F(10, 0) F(11, 0) F(12, 0) F(13, 0) F(14, 0) F(15, 0)
#define RT_SEARCH(COUNT_MACRO, NTOT) \
    for (int it_ = 0; it_ < 400 && __any(!done); ++it_) { \
        const float w_ = hi - lo; float t_ = ((float)(clo - 16) + 0.5f) * __builtin_amdgcn_rcpf((float)(clo - chi)); t_ = __builtin_fminf(__builtin_fmaxf(t_, 0.125f), 0.875f); \
        float x_ = lo + w_ * t_; if (!(x_ > lo && x_ < hi)) x_ = 0.5f * lo + 0.5f * hi; const bool stuck_ = !(x_ > lo && x_ < hi); \
        int c_; COUNT_MACRO(c_, x_); \
        if (!done) { if (stuck_) { Tv = lo; done = true; } else if (c_ == 16) { Tv = x_; done = true; } else if (c_ > 16) { lo = x_; clo = c_; } else { hi = x_; chi = c_; } } } \
    if (!done) Tv = lo;
#define RT_CNT128_GE(c, x) RT_COUNT128(RT_GE8, c, x)
#define RT_CNT50_GE(c, x) RT_COUNT50(RT_SGE5, c, x)
__device__ __forceinline__ void lane_top16_of_128(const float (&v)[128], LAS unsigned char* sb) {
    float mx = v[0], mn = v[0];
#pragma unroll
    for (int i = 1; i < 128; ++i) { mx = __builtin_fmaxf(mx, v[i]); mn = __builtin_fminf(mn, v[i]); }
    float lo = mn, hi = mx, Tv = mn; int clo = 128, chi; bool done;
    RT_CNT128_GE(chi, mx); done = (chi >= 16); if (done) Tv = mx;
    RT_SEARCH(RT_CNT128_GE, 128)
    int cgt; RT_COUNT128(RT_GT8, cgt, Tv);
    const int need = 16 - cgt; int cnt = 0, idx = 0;
#pragma unroll
    for (int i = 0; i < 128; ++i) {
        asm volatile("" : "+v"(Tv), "+v"(cnt), "+v"(idx));
        LAS unsigned char* q = sb + cnt * 512; *(LAS float*)q = v[i]; *(LAS int*)(q + 4) = idx;
        cnt += (v[i] > Tv) ? 1 : 0; idx += 1;
    }
    if (__any(need > 0)) {
        idx = 0;
#pragma unroll
        for (int i = 0; i < 128; ++i) { asm volatile("" : "+v"(Tv), "+v"(cnt), "+v"(idx));
            if (v[i] == Tv && cnt < 16) { LAS unsigned char* q = sb + cnt * 512; *(LAS float*)q = v[i]; *(LAS int*)(q + 4) = idx; cnt += 1; } idx += 1; }
    }
}
__device__ __forceinline__ int opaque_zero() { int z = 0; asm volatile("" : "+v"(z)); return z; }
__device__ __forceinline__ void route_task_search(const float* SCT, v2u* ROUTE, int tok0, int h, LAS unsigned char* scr, int lane) {
    const int tok = tok0 + lane;
    LAS unsigned char* sb = scr + lane * 8;
#pragma unroll 1
    for (int p = 0; p < 2; ++p) {
        const int g = 2 * h + p; float v[128];
        const unsigned voff = (unsigned)tok * 16u;
#pragma unroll
        for (int k = 0; k < 32; ++k) { const char* bk = (const char*)SCT + ((size_t)(g * 32 + k) * M) * 16; const f32x4 q = *(const GAS f32x4*)(bk + voff); v[4 * k] = q.x; v[4 * k + 1] = q.y; v[4 * k + 2] = q.z; v[4 * k + 3] = q.w; }
        lane_top16_of_128(v, sb + p * 8704);
    }
    LDS_WAIT();
    float a[16], b[16]; int ai[16], bi[16];
#pragma unroll
    for (int i = 0; i < 16; ++i) { const v2u ea = *(LAS v2u*)(sb + i * 512), eb = *(LAS v2u*)(sb + 8704 + i * 512);
        a[i] = __builtin_bit_cast(float, ea.x); ai[i] = (int)ea.y; b[i] = __builtin_bit_cast(float, eb.x); bi[i] = (int)eb.y; }
    LDS_WAIT();
    RT_SORT16(a, ai); RT_SORT16(b, bi);
    float lo = a[15] + b[15], hi = a[0] + b[0], Tv = lo; int clo = 50, chi; bool done;
    RT_CNT50_GE(chi, hi); done = (chi >= 16); if (done) Tv = hi;
    RT_SEARCH(RT_CNT50_GE, 50)
    int cgt; RT_COUNT50(RT_SGT5, cgt, Tv);
    const int need = 16 - cgt; int cnt = 0;
#define RT_EXT(i, j) { asm volatile("" : "+v"(Tv), "+v"(cnt)); const float s_ = a[i] + b[j]; LAS unsigned char* q_ = sb + cnt * 512; *(LAS float*)q_ = s_; *(LAS int*)(q_ + 4) = ai[i] * 128 + bi[j]; cnt += (s_ > Tv) ? 1 : 0; }
    RT_FOR_CANDS(RT_EXT)
#undef RT_EXT
    if (__any(need > 0)) {
#define RT_EXT2(i, j) { asm volatile("" : "+v"(Tv), "+v"(cnt)); const float s_ = a[i] + b[j]; if (s_ == Tv && cnt < 16) { LAS unsigned char* q_ = sb + cnt * 512; *(LAS float*)q_ = s_; *(LAS int*)(q_ + 4) = ai[i] * 128 + bi[j]; cnt += 1; } }
        RT_FOR_CANDS(RT_EXT2)
#undef RT_EXT2
    }
    LDS_WAIT();
    GAS v4u* rp = (GAS v4u*)((GAS v2u*)ROUTE + (size_t)tok * 128 + h * 16);
#pragma unroll
    for (int i = 0; i < 8; ++i) { const v2u e0 = *(LAS v2u*)(sb + (2 * i) * 512), e1 = *(LAS v2u*)(sb + (2 * i + 1) * 512); v4u o; o.x = e0.y; o.y = e0.x; o.z = e1.y; o.w = e1.x; rp[i] = o; }
    LDS_WAIT();
}

#define RT2_CE(a, b) { const int t0_ = (a), t1_ = (b); (a) = t0_ > t1_ ? t0_ : t1_; (b) = t0_ > t1_ ? t1_ : t0_; }
#define RT2_MX(a, b) ((a) > (b) ? (a) : (b))
#define RT2_SORT16(k, B) do { RT2_CE(k[(B) + 0], k[(B) + 13]); RT2_CE(k[(B) + 1], k[(B) + 12]); RT2_CE(k[(B) + 2], k[(B) + 15]); RT2_CE(k[(B) + 3], k[(B) + 14]); RT2_CE(k[(B) + 4], k[(B) + 8]); RT2_CE(k[(B) + 5], k[(B) + 6]); RT2_CE(k[(B) + 7], k[(B) + 11]); RT2_CE(k[(B) + 9], k[(B) + 10]); RT2_CE(k[(B) + 0], k[(B) + 5]); RT2_CE(k[(B) + 1], k[(B) + 7]); RT2_CE(k[(B) + 2], k[(B) + 9]); RT2_CE(k[(B) + 3], k[(B) + 4]); RT2_CE(k[(B) + 6], k[(B) + 13]); RT2_CE(k[(B) + 8], k[(B) + 14]); RT2_CE(k[(B) + 10], k[(B) + 15]); RT2_CE(k[(B) + 11], k[(B) + 12]); RT2_CE(k[(B) + 0], k[(B) + 1]); RT2_CE(k[(B) + 2], k[(B) + 3]); RT2_CE(k[(B) + 4], k[(B) + 5]); RT2_CE(k[(B) + 6], k[(B) + 8]); RT2_CE(k[(B) + 7], k[(B) + 9]); RT2_CE(k[(B) + 10], k[(B) + 11]); RT2_CE(k[(B) + 12], k[(B) + 13]); RT2_CE(k[(B) + 14], k[(B) + 15]); RT2_CE(k[(B) + 0], k[(B) + 2]); RT2_CE(k[(B) + 1], k[(B) + 3]); RT2_CE(k[(B) + 4], k[(B) + 10]); RT2_CE(k[(B) + 5], k[(B) + 11]); RT2_CE(k[(B) + 6], k[(B) + 7]); RT2_CE(k[(B) + 8], k[(B) + 9]); RT2_CE(k[(B) + 12], k[(B) + 14]); RT2_CE(k[(B) + 13], k[(B) + 15]); RT2_CE(k[(B) + 1], k[(B) + 2]); RT2_CE(k[(B) + 3], k[(B) + 12]); RT2_CE(k[(B) + 4], k[(B) + 6]); RT2_CE(k[(B) + 5], k[(B) + 7]); RT2_CE(k[(B) + 8], k[(B) + 10]); RT2_CE(k[(B) + 9], k[(B) + 11]); RT2_CE(k[(B) + 13], k[(B) + 14]); RT2_CE(k[(B) + 1], k[(B) + 4]); RT2_CE(k[(B) + 2], k[(B) + 6]); RT2_CE(k[(B) + 5], k[(B) + 8]); RT2_CE(k[(B) + 7], k[(B) + 10]); RT2_CE(k[(B) + 9], k[(B) + 13]); RT2_CE(k[(B) + 11], k[(B) + 14]); RT2_CE(k[(B) + 2], k[(B) + 4]); RT2_CE(k[(B) + 3], k[(B) + 6]); RT2_CE(k[(B) + 9], k[(B) + 12]); RT2_CE(k[(B) + 11], k[(B) + 13]); RT2_CE(k[(B) + 3], k[(B) + 5]); RT2_CE(k[(B) + 6], k[(B) + 8]); RT2_CE(k[(B) + 7], k[(B) + 9]); RT2_CE(k[(B) + 10], k[(B) + 12]); RT2_CE(k[(B) + 3], k[(B) + 4]); RT2_CE(k[(B) + 5], k[(B) + 6]); RT2_CE(k[(B) + 7], k[(B) + 8]); RT2_CE(k[(B) + 9], k[(B) + 10]); RT2_CE(k[(B) + 11], k[(B) + 12]); RT2_CE(k[(B) + 6], k[(B) + 7]); RT2_CE(k[(B) + 8], k[(B) + 9]); } while (0)
#define RT2_BIT16(k, B) do { RT2_CE(k[(B) + 0], k[(B) + 8]); RT2_CE(k[(B) + 1], k[(B) + 9]); RT2_CE(k[(B) + 2], k[(B) + 10]); RT2_CE(k[(B) + 3], k[(B) + 11]); RT2_CE(k[(B) + 4], k[(B) + 12]); RT2_CE(k[(B) + 5], k[(B) + 13]); RT2_CE(k[(B) + 6], k[(B) + 14]); RT2_CE(k[(B) + 7], k[(B) + 15]); RT2_CE(k[(B) + 0], k[(B) + 4]); RT2_CE(k[(B) + 1], k[(B) + 5]); RT2_CE(k[(B) + 2], k[(B) + 6]); RT2_CE(k[(B) + 3], k[(B) + 7]); RT2_CE(k[(B) + 8], k[(B) + 12]); RT2_CE(k[(B) + 9], k[(B) + 13]); RT2_CE(k[(B) + 10], k[(B) + 14]); RT2_CE(k[(B) + 11], k[(B) + 15]); RT2_CE(k[(B) + 0], k[(B) + 2]); RT2_CE(k[(B) + 1], k[(B) + 3]); RT2_CE(k[(B) + 4], k[(B) + 6]); RT2_CE(k[(B) + 5], k[(B) + 7]); RT2_CE(k[(B) + 8], k[(B) + 10]); RT2_CE(k[(B) + 9], k[(B) + 11]); RT2_CE(k[(B) + 12], k[(B) + 14]); RT2_CE(k[(B) + 13], k[(B) + 15]); RT2_CE(k[(B) + 0], k[(B) + 1]); RT2_CE(k[(B) + 2], k[(B) + 3]); RT2_CE(k[(B) + 4], k[(B) + 5]); RT2_CE(k[(B) + 6], k[(B) + 7]); RT2_CE(k[(B) + 8], k[(B) + 9]); RT2_CE(k[(B) + 10], k[(B) + 11]); RT2_CE(k[(B) + 12], k[(B) + 13]); RT2_CE(k[(B) + 14], k[(B) + 15]); } while (0)
#define RT2_HCLEAN(k, A, B) do { k[(A) + 0] = RT2_MX(k[(A) + 0], k[(B) + 15]); k[(A) + 1] = RT2_MX(k[(A) + 1], k[(B) + 14]); k[(A) + 2] = RT2_MX(k[(A) + 2], k[(B) + 13]); k[(A) + 3] = RT2_MX(k[(A) + 3], k[(B) + 12]); k[(A) + 4] = RT2_MX(k[(A) + 4], k[(B) + 11]); k[(A) + 5] = RT2_MX(k[(A) + 5], k[(B) + 10]); k[(A) + 6] = RT2_MX(k[(A) + 6], k[(B) + 9]); k[(A) + 7] = RT2_MX(k[(A) + 7], k[(B) + 8]); k[(A) + 8] = RT2_MX(k[(A) + 8], k[(B) + 7]); k[(A) + 9] = RT2_MX(k[(A) + 9], k[(B) + 6]); k[(A) + 10] = RT2_MX(k[(A) + 10], k[(B) + 5]); k[(A) + 11] = RT2_MX(k[(A) + 11], k[(B) + 4]); k[(A) + 12] = RT2_MX(k[(A) + 12], k[(B) + 3]); k[(A) + 13] = RT2_MX(k[(A) + 13], k[(B) + 2]); k[(A) + 14] = RT2_MX(k[(A) + 14], k[(B) + 1]); k[(A) + 15] = RT2_MX(k[(A) + 15], k[(B) + 0]); } while (0)
#define RT2_TOP16_OF_128(k) do { RT2_SORT16(k, 0); RT2_SORT16(k, 16); RT2_SORT16(k, 32); RT2_SORT16(k, 48); RT2_SORT16(k, 64); RT2_SORT16(k, 80); RT2_SORT16(k, 96); RT2_SORT16(k, 112); RT2_HCLEAN(k, 0, 16); RT2_BIT16(k, 0); RT2_HCLEAN(k, 32, 48); RT2_BIT16(k, 32); RT2_HCLEAN(k, 64, 80); RT2_BIT16(k, 64); RT2_HCLEAN(k, 96, 112); RT2_BIT16(k, 96); RT2_HCLEAN(k, 0, 32); RT2_BIT16(k, 0); RT2_HCLEAN(k, 64, 96); RT2_BIT16(k, 64); RT2_HCLEAN(k, 0, 64); RT2_BIT16(k, 0); } while (0)
#define RT2_BUILD_CANDS(c) do { c[0] = RT2_CK(0, 0); c[1] = RT2_CK(0, 1); c[2] = RT2_CK(0, 2); c[3] = RT2_CK(0, 3); c[4] = RT2_CK(0, 4); c[5] = RT2_CK(0, 5); c[6] = RT2_CK(0, 6); c[7] = RT2_CK(0, 7); c[8] = RT2_CK(0, 8); c[9] = RT2_CK(0, 9); c[10] = RT2_CK(0, 10); c[11] = RT2_CK(0, 11); c[12] = RT2_CK(0, 12); c[13] = RT2_CK(0, 13); c[14] = RT2_CK(0, 14); c[15] = RT2_CK(0, 15); c[16] = RT2_CK(1, 0); c[17] = RT2_CK(1, 1); c[18] = RT2_CK(1, 2); c[19] = RT2_CK(1, 3); c[20] = RT2_CK(1, 4); c[21] = RT2_CK(1, 5); c[22] = RT2_CK(1, 6); c[23] = RT2_CK(1, 7); c[24] = RT2_CK(15, 0); c[25] = RT2_CK(14, 0); c[26] = RT2_CK(13, 0); c[27] = RT2_CK(12, 0); c[28] = RT2_CK(11, 0); c[29] = RT2_CK(10, 0); c[30] = RT2_CK(9, 0); c[31] = RT2_CK(8, 0); c[32] = RT2_CK(2, 0); c[33] = RT2_CK(2, 1); c[34] = RT2_CK(2, 2); c[35] = RT2_CK(2, 3); c[36] = RT2_CK(2, 4); c[37] = RT2_CK(3, 0); c[38] = RT2_CK(3, 1); c[39] = RT2_CK(3, 2); c[40] = RT2_CK(3, 3); c[41] = RT2_CK(4, 0); c[42] = RT2_CK(4, 1); c[43] = RT2_CK(4, 2); c[44] = RT2_CK(5, 0); c[45] = RT2_CK(5, 1); c[46] = RT2_CK(6, 0); c[47] = RT2_CK(6, 1); } while (0)
__device__ __forceinline__ int rt2_tr(int u) { return u ^ (int)((unsigned)(u >> 31) >> 1); }
__device__ __forceinline__ int rt2_key(float x, int code, int mask) { return (rt2_tr(__builtin_bit_cast(int, x)) & ~mask) | code; }
__device__ __forceinline__ int rt2_key16(unsigned hbits_hi, int code) { return (rt2_tr((int)hbits_hi) & (int)0xffff0000) | code; }
__device__ __forceinline__ float rt2_val16(int k) { const unsigned u = (unsigned)rt2_tr(k) >> 16; return (float)__builtin_bit_cast(_Float16, (unsigned short)u); }
__device__ __forceinline__ void route_task(const unsigned short* SCT, v2u* ROUTE, int tok0, int h, LAS unsigned char* scr, int lane) {
    const int tok = tok0 + lane;
    LAS unsigned char* sb = scr + lane * 4;
#pragma unroll 1
    for (int p = 0; p < 2; ++p) {
        const int g = 2 * h + p; int k[128];
        const unsigned voff = (unsigned)tok * 16u;
#pragma unroll
        for (int q8 = 0; q8 < 16; ++q8) { const char* bq = (const char*)SCT + ((size_t)(g * 16 + q8) * M) * 16; const v4u q = *(const GAS v4u*)(bq + voff);
            k[8 * q8 + 0] = rt2_key16(q.x << 16, 127 - 8 * q8); k[8 * q8 + 1] = rt2_key16(q.x, 126 - 8 * q8); k[8 * q8 + 2] = rt2_key16(q.y << 16, 125 - 8 * q8); k[8 * q8 + 3] = rt2_key16(q.y, 124 - 8 * q8);
            k[8 * q8 + 4] = rt2_key16(q.z << 16, 123 - 8 * q8); k[8 * q8 + 5] = rt2_key16(q.z, 122 - 8 * q8); k[8 * q8 + 6] = rt2_key16(q.w << 16, 121 - 8 * q8); k[8 * q8 + 7] = rt2_key16(q.w, 120 - 8 * q8); }
        RT2_TOP16_OF_128(k);
#pragma unroll
        for (int i = 0; i < 16; ++i) *(LAS int*)(sb + (p * 16 + i) * 256) = k[i];
    }
    LDS_WAIT();
    float af[16], bf[16];
#pragma unroll
    for (int i = 0; i < 16; ++i) { af[i] = rt2_val16(*(const LAS int*)(sb + i * 256)); bf[i] = rt2_val16(*(const LAS int*)(sb + (16 + i) * 256)); }
    int c[48];
#define RT2_CK(i, j) rt2_key(af[i] + bf[j], 255 - (16 * (i) + (j)), 255)
    RT2_BUILD_CANDS(c);
    const int r7a = RT2_CK(7, 0), r7b = RT2_CK(7, 1);
#undef RT2_CK
    RT2_BIT16(c, 16);
    RT2_SORT16(c, 32);
    RT2_HCLEAN(c, 0, 16); RT2_BIT16(c, 0);
    c[46] = RT2_MX(c[46], r7b); c[47] = RT2_MX(c[47], r7a); RT2_BIT16(c, 32);
    RT2_HCLEAN(c, 0, 32);
    GAS v4u* rp = (GAS v4u*)((GAS v2u*)ROUTE + (size_t)tok * 128 + h * 16);
#pragma unroll
    for (int i = 0; i < 8; ++i) { v4u o;
        { const int ij = (~c[2 * i]) & 255; const int ka = *(const LAS int*)(sb + ((ij >> 4) << 8)), kb = *(const LAS int*)(sb + 4096 + ((ij & 15) << 8));
          o.x = (unsigned)(((~ka) & 127) * 128 + ((~kb) & 127)); o.y = __builtin_bit_cast(unsigned, rt2_val16(ka) + rt2_val16(kb)); }
        { const int ij = (~c[2 * i + 1]) & 255; const int ka = *(const LAS int*)(sb + ((ij >> 4) << 8)), kb = *(const LAS int*)(sb + 4096 + ((ij & 15) << 8));
          o.z = (unsigned)(((~ka) & 127) * 128 + ((~kb) & 127)); o.w = __builtin_bit_cast(unsigned, rt2_val16(ka) + rt2_val16(kb)); }
        rp[i] = o; }
    LDS_WAIT();
}

#define DPPF(v, ctrl) __builtin_bit_cast(float, __builtin_amdgcn_update_dpp(0, __builtin_bit_cast(int, (v)), (ctrl), 0xf, 0xf, true))
__device__ __forceinline__ float wave_max_f(float m) {
#pragma unroll
    for (int o = 1; o < 64; o <<= 1) m = __builtin_fmaxf(m, __shfl_xor(m, o));
    return m;
}
template <int NV> __device__ __forceinline__ void select16(const float (&v)[NV], bool (&sel)[NV], int (&pos)[NV]) {
    float mx = v[0], mn = v[0];
#pragma unroll
    for (int i = 1; i < NV; ++i) { mx = __builtin_fmaxf(mx, v[i]); mn = __builtin_fminf(mn, v[i]); }
    mx = wave_max_f(mx); mn = -wave_max_f(-mn);
    float lo = mn, hi = mx, Tv;
    { int c = 0;
#pragma unroll
      for (int i = 0; i < NV; ++i) c += __popcll(__ballot(v[i] >= mx));
      if (c >= 16) { Tv = mx; }
      else {
        Tv = lo;
        for (int it = 0; it < 300; ++it) {
            const float mid = 0.5f * lo + 0.5f * hi;
            if (!(mid > lo && mid < hi)) { Tv = lo; break; }
            int cc = 0;
#pragma unroll
            for (int i = 0; i < NV; ++i) cc += __popcll(__ballot(v[i] >= mid));
            if (cc == 16) { Tv = mid; break; }
            if (cc > 16) lo = mid; else hi = mid;
            Tv = lo;
        }
      }
    }
    int cgt = 0;
#pragma unroll
    for (int i = 0; i < NV; ++i) cgt += __popcll(__ballot(v[i] > Tv));
    const int need = 16 - cgt;
    int eqbelow = 0;
#pragma unroll
    for (int i = 0; i < NV; ++i) { const unsigned long long m = __ballot(v[i] == Tv); eqbelow += __builtin_amdgcn_mbcnt_hi((unsigned)(m >> 32), __builtin_amdgcn_mbcnt_lo((unsigned)m, 0u)); }
    int eqown = 0;
#pragma unroll
    for (int i = 0; i < NV; ++i) { const bool eq = (v[i] == Tv); sel[i] = (v[i] > Tv) || (eq && (eqbelow + eqown) < need); eqown += eq ? 1 : 0; }
    int selbelow = 0;
#pragma unroll
    for (int i = 0; i < NV; ++i) { const unsigned long long m = __ballot(sel[i]); selbelow += __builtin_amdgcn_mbcnt_hi((unsigned)(m >> 32), __builtin_amdgcn_mbcnt_lo((unsigned)m, 0u)); }
    int own = 0;
#pragma unroll
    for (int i = 0; i < NV; ++i) { pos[i] = selbelow + own; own += sel[i] ? 1 : 0; }
}

__device__ __forceinline__ float gelu_exact(float a) { return 0.5f * a * (1.0f + erff(a * 0.7071067811865476f)); }

__device__ __forceinline__ void fp8_row_dot(const v4u q, const float (&xr)[16], float& s) {
    const f32x2 a0 = __builtin_amdgcn_cvt_pk_f32_fp8((int)q.x, false), a1 = __builtin_amdgcn_cvt_pk_f32_fp8((int)q.x, true), a2 = __builtin_amdgcn_cvt_pk_f32_fp8((int)q.y, false), a3 = __builtin_amdgcn_cvt_pk_f32_fp8((int)q.y, true);
    const f32x2 b0 = __builtin_amdgcn_cvt_pk_f32_fp8((int)q.z, false), b1 = __builtin_amdgcn_cvt_pk_f32_fp8((int)q.z, true), b2 = __builtin_amdgcn_cvt_pk_f32_fp8((int)q.w, false), b3 = __builtin_amdgcn_cvt_pk_f32_fp8((int)q.w, true);
    f32x2 t = a0 * (f32x2){xr[0], xr[1]};
    t = __builtin_elementwise_fma(a1, (f32x2){xr[2], xr[3]}, t); t = __builtin_elementwise_fma(a2, (f32x2){xr[4], xr[5]}, t); t = __builtin_elementwise_fma(a3, (f32x2){xr[6], xr[7]}, t);
    t = __builtin_elementwise_fma(b0, (f32x2){xr[8], xr[9]}, t); t = __builtin_elementwise_fma(b1, (f32x2){xr[10], xr[11]}, t); t = __builtin_elementwise_fma(b2, (f32x2){xr[12], xr[13]}, t); t = __builtin_elementwise_fma(b3, (f32x2){xr[14], xr[15]}, t);
    s = t.x + t.y;
}
__device__ __forceinline__ void fp8_row_axpy2(const v4u q, const float w, f32x2 (&acc)[8]) {
    const f32x2 a0 = __builtin_amdgcn_cvt_pk_f32_fp8((int)q.x, false), a1 = __builtin_amdgcn_cvt_pk_f32_fp8((int)q.x, true), a2 = __builtin_amdgcn_cvt_pk_f32_fp8((int)q.y, false), a3 = __builtin_amdgcn_cvt_pk_f32_fp8((int)q.y, true);
    const f32x2 b0 = __builtin_amdgcn_cvt_pk_f32_fp8((int)q.z, false), b1 = __builtin_amdgcn_cvt_pk_f32_fp8((int)q.z, true), b2 = __builtin_amdgcn_cvt_pk_f32_fp8((int)q.w, false), b3 = __builtin_amdgcn_cvt_pk_f32_fp8((int)q.w, true);
    const f32x2 ww = {w, w};
    acc[0] = __builtin_elementwise_fma(a0, ww, acc[0]); acc[1] = __builtin_elementwise_fma(a1, ww, acc[1]); acc[2] = __builtin_elementwise_fma(a2, ww, acc[2]); acc[3] = __builtin_elementwise_fma(a3, ww, acc[3]);
    acc[4] = __builtin_elementwise_fma(b0, ww, acc[4]); acc[5] = __builtin_elementwise_fma(b1, ww, acc[5]); acc[6] = __builtin_elementwise_fma(b2, ww, acc[6]); acc[7] = __builtin_elementwise_fma(b3, ww, acc[7]);
}
__device__ __forceinline__ void fp8_row_axpy(const v4u q, const float w, float (&acc)[16]) {
    const f32x2 a0 = __builtin_amdgcn_cvt_pk_f32_fp8((int)q.x, false), a1 = __builtin_amdgcn_cvt_pk_f32_fp8((int)q.x, true), a2 = __builtin_amdgcn_cvt_pk_f32_fp8((int)q.y, false), a3 = __builtin_amdgcn_cvt_pk_f32_fp8((int)q.y, true);
    const f32x2 b0 = __builtin_amdgcn_cvt_pk_f32_fp8((int)q.z, false), b1 = __builtin_amdgcn_cvt_pk_f32_fp8((int)q.z, true), b2 = __builtin_amdgcn_cvt_pk_f32_fp8((int)q.w, false), b3 = __builtin_amdgcn_cvt_pk_f32_fp8((int)q.w, true);
    acc[0] += w * a0.x; acc[1] += w * a0.y; acc[2] += w * a1.x; acc[3] += w * a1.y; acc[4] += w * a2.x; acc[5] += w * a2.y; acc[6] += w * a3.x; acc[7] += w * a3.y;
    acc[8] += w * b0.x; acc[9] += w * b0.y; acc[10] += w * b1.x; acc[11] += w * b1.y; acc[12] += w * b2.x; acc[13] += w * b2.y; acc[14] += w * b3.x; acc[15] += w * b3.y;
}
__device__ __forceinline__ void fp8_convert_row(const float* src, const float* gain, unsigned char* dst, float* inv_scale, int lane, int sliced, int e) {
    const GAS f32x4* sp = (const GAS f32x4*)src; float v[16];
#pragma unroll
    for (int j = 0; j < 2; ++j) { f32x4 a = sp[2 * lane + 128 * j], b = sp[2 * lane + 128 * j + 1];
        if (gain) { const GAS f32x4* gp = (const GAS f32x4*)gain; const f32x4 ga = gp[2 * lane + 128 * j], gb = gp[2 * lane + 128 * j + 1]; a = a * ga; b = b * gb; }
        v[8 * j + 0] = a.x; v[8 * j + 1] = a.y; v[8 * j + 2] = a.z; v[8 * j + 3] = a.w; v[8 * j + 4] = b.x; v[8 * j + 5] = b.y; v[8 * j + 6] = b.z; v[8 * j + 7] = b.w; }
    float am = 0.f;
#pragma unroll
    for (int i = 0; i < 16; ++i) am = __builtin_fmaxf(am, __builtin_fabsf(v[i]));
    am = wave_max_f(am);
    const float sc = (am > 0.f) ? 384.0f / am : 1.0f, inv = (am > 0.f) ? am * (1.0f / 384.0f) : 1.0f;
    v4u q;
    { int w = __builtin_amdgcn_cvt_pk_fp8_f32(v[0] * sc, v[1] * sc, 0, false); w = __builtin_amdgcn_cvt_pk_fp8_f32(v[2] * sc, v[3] * sc, w, true); q.x = (unsigned)w; }
    { int w = __builtin_amdgcn_cvt_pk_fp8_f32(v[4] * sc, v[5] * sc, 0, false); w = __builtin_amdgcn_cvt_pk_fp8_f32(v[6] * sc, v[7] * sc, w, true); q.y = (unsigned)w; }
    { int w = __builtin_amdgcn_cvt_pk_fp8_f32(v[8] * sc, v[9] * sc, 0, false); w = __builtin_amdgcn_cvt_pk_fp8_f32(v[10] * sc, v[11] * sc, w, true); q.z = (unsigned)w; }
    { int w = __builtin_amdgcn_cvt_pk_fp8_f32(v[12] * sc, v[13] * sc, 0, false); w = __builtin_amdgcn_cvt_pk_fp8_f32(v[14] * sc, v[15] * sc, w, true); q.w = (unsigned)w; }
    if (!sliced) ((GAS v4u*)dst)[lane] = q;
    else { v2u q0, q1; q0.x = q.x; q0.y = q.y; q1.x = q.z; q1.y = q.w; const int s0 = lane >> 4, o8 = 8 * (lane & 15);
        *(GAS v2u*)(dst + ((size_t)s0 * NEXP + e) * 128 + o8) = q0; *(GAS v2u*)(dst + ((size_t)(s0 + 4) * NEXP + e) * 128 + o8) = q1; }
    if (lane == 0) *inv_scale = inv;
}

#define PIN_ACC2(b) asm volatile("" : "+v"(b), "+v"(acc2[0]), "+v"(acc2[1]), "+v"(acc2[2]), "+v"(acc2[3]), "+v"(acc2[4]), "+v"(acc2[5]), "+v"(acc2[6]), "+v"(acc2[7]))
#define PIN_ACC(b) asm volatile("" : "+v"(b), "+v"(acc[0]), "+v"(acc[1]), "+v"(acc[2]), "+v"(acc[3]), "+v"(acc[4]), "+v"(acc[5]), "+v"(acc[6]), "+v"(acc[7]), "+v"(acc[8]), "+v"(acc[9]), "+v"(acc[10]), "+v"(acc[11]), "+v"(acc[12]), "+v"(acc[13]), "+v"(acc[14]), "+v"(acc[15]))
#define PC_META_U(tk) do { const char* rb_ = (const char*)route + (size_t)(tk) * 1024; m_e0 = *(const GAS int*)(rb_ + l8); m_e1 = *(const GAS int*)(rb_ + 512 + l8); } while (0)
#define PC_ISSUE_U(buf, xs, par, tk) do { LAS int* lid_ = (LAS int*)(scr + (par) * 512); lid_[lane] = m_e0; lid_[lane + 64] = m_e1; LDS_WAIT(); \
        { const GAS f32x4* xq_ = (const GAS f32x4*)(x1 + (size_t)(tk) * D + 128 * s + 16 * c); const f32x4 x0_ = xq_[0], x1_ = xq_[1], x2_ = xq_[2], x3_ = xq_[3]; \
          xs[0] = x0_.x; xs[1] = x0_.y; xs[2] = x0_.z; xs[3] = x0_.w; xs[4] = x1_.x; xs[5] = x1_.y; xs[6] = x1_.z; xs[7] = x1_.w; xs[8] = x2_.x; xs[9] = x2_.y; xs[10] = x2_.z; xs[11] = x2_.w; xs[12] = x3_.x; xs[13] = x3_.y; xs[14] = x3_.z; xs[15] = x3_.w; } \
        _Pragma("unroll") for (int k = 0; k < 16; ++k) { const int e_ = lid_[8 * k + r]; buf[k] = *(const GAS v4u*)(tbs + (unsigned)(e_ * 128)); } } while (0)
#define PC_COMPUTE_U(buf, xs, tk) do { float p_[16]; \
        _Pragma("unroll") for (int k = 0; k < 16; ++k) { if (k) asm volatile("" : "+v"(buf[k]), "+v"(p_[k ? k - 1 : 0])); else asm volatile("" : "+v"(buf[k])); fp8_row_dot(buf[k], xs, p_[k]); } \
        float q8_[8], q4_[4], q2_[2]; \
        _Pragma("unroll") for (int k = 0; k < 8; ++k) { const float send = c2 ? p_[k] : p_[k + 8], keep = c2 ? p_[k + 8] : p_[k]; q8_[k] = keep + __shfl_xor(send, 4); } \
        _Pragma("unroll") for (int k = 0; k < 4; ++k) { const float send = c1 ? q8_[k] : q8_[k + 4], keep = c1 ? q8_[k + 4] : q8_[k]; q4_[k] = keep + __shfl_xor(send, 2); } \
        _Pragma("unroll") for (int k = 0; k < 2; ++k) { const float send = c0 ? q4_[k] : q4_[k + 2], keep = c0 ? q4_[k + 2] : q4_[k]; q2_[k] = keep + __shfl_xor(send, 1); } \
        GAS float* up_ = (GAS float*)(Upart + ((size_t)s * M + (tk)) * 128 + 64 * c2 + 32 * c1 + 16 * c0 + r); up_[0] = q2_[0]; up_[8] = q2_[1]; } while (0)
__device__ __forceinline__ void peer_u_phase(int s, int tok0, int tstride, int nitems, const v2u* route, const float* x1, const unsigned char* TU8s, float* Upart, LAS unsigned char* scr, int lane) {
    const int r = lane >> 3, c = lane & 7, c2 = (lane >> 2) & 1, c1 = (lane >> 1) & 1, c0 = lane & 1; const unsigned l8 = (unsigned)lane * 8u;
    const char* tbs = (const char*)TU8s + (size_t)s * NEXP * 128 + 16 * c;
    int m_e0, m_e1;
    v4u bufA[16], bufB[16]; float xsA[16], xsB[16];
    PC_META_U(tok0); PC_ISSUE_U(bufA, xsA, 0, tok0); if (nitems > 1) PC_META_U(tok0 + tstride);
#pragma unroll 1
    for (int i = 0; i < nitems; i += 2) {
        const int tk = tok0 + i * tstride;
        if (i + 1 < nitems) PC_ISSUE_U(bufB, xsB, 1, tk + tstride);
        if (i + 2 < nitems) PC_META_U(tk + 2 * tstride);
        PC_COMPUTE_U(bufA, xsA, tk);
        if (i + 1 < nitems) {
            if (i + 2 < nitems) PC_ISSUE_U(bufA, xsA, 0, tk + 2 * tstride);
            if (i + 3 < nitems) PC_META_U(tk + 3 * tstride);
            PC_COMPUTE_U(bufB, xsB, tk + tstride);
        }
    }
    LDS_WAIT();
}
#define PD_META_U(tk) do { const char* rb_ = (const char*)route + (size_t)(tk) * 1024; m_e0 = *(const GAS int*)(rb_ + l8); m_e1 = *(const GAS int*)(rb_ + 512 + l8); \
        { const unsigned xw_ = *(const GAS unsigned*)((const bf16*)x1 + (size_t)(tk) * D + 128 * s + 2 * lane); m_x.x = bflo(xw_); m_x.y = bfhi(xw_); } } while (0)
#define PD_ISSUE_U(buf, xq, xinv, par) do { LAS int* lid_ = (LAS int*)(scr + (par) * 1024); LAS unsigned short* lx_ = (LAS unsigned short*)(scr + (par) * 1024 + 512); lid_[lane] = m_e0; lid_[lane + 64] = m_e1; LDS_WAIT(); \
        _Pragma("unroll") for (int k = 0; k < 16; ++k) { const int e_ = lid_[8 * k + r]; buf[k] = *(const GAS v4u*)(tbs + (unsigned)(e_ * 128)); } \
        { float am_ = __builtin_fmaxf(__builtin_fabsf(m_x.x), __builtin_fabsf(m_x.y)); \
          _Pragma("unroll") for (int o_ = 1; o_ < 64; o_ <<= 1) am_ = __builtin_fmaxf(am_, __shfl_xor(am_, o_)); \
          const float sc_ = (am_ > 0.f) ? 127.0f / am_ : 0.f; xinv = am_ * (1.0f / 127.0f); \
          const int q0_ = (int)__builtin_rintf(m_x.x * sc_), q1_ = (int)__builtin_rintf(m_x.y * sc_); lx_[lane] = (unsigned short)(((unsigned)q0_ & 255u) | (((unsigned)q1_ & 255u) << 8)); } \
        LDS_WAIT(); xq = *(const LAS v4u*)((LAS unsigned char*)lx_ + 16 * c); } while (0)
#define PD_COMPUTE_U(buf, xq, xinv, tk) do { int p_[16]; \
        _Pragma("unroll") for (int k = 0; k < 16; ++k) { int a_ = __builtin_amdgcn_sdot4((int)buf[k].x, (int)xq.x, 0, false); a_ = __builtin_amdgcn_sdot4((int)buf[k].y, (int)xq.y, a_, false); \
            a_ = __builtin_amdgcn_sdot4((int)buf[k].z, (int)xq.z, a_, false); a_ = __builtin_amdgcn_sdot4((int)buf[k].w, (int)xq.w, a_, false); p_[k] = a_; } \
          \
        LAS int* red_ = (LAS int*)(scr + 2048); \
        _Pragma("unroll") for (int k = 0; k < 16; ++k) red_[64 * k + lane] = p_[k]; \
        LDS_WAIT(); \
        const v4u ra_ = *(const LAS v4u*)(red_ + 8 * lane + rsw), rb_ = *(const LAS v4u*)(red_ + 8 * lane + (4 - rsw)), rc_ = *(const LAS v4u*)(red_ + 512 + 8 * lane + rsw), rd_ = *(const LAS v4u*)(red_ + 512 + 8 * lane + (4 - rsw)); \
        const int s0_ = (int)(ra_.x + ra_.y + ra_.z + ra_.w + rb_.x + rb_.y + rb_.z + rb_.w), s1_ = (int)(rc_.x + rc_.y + rc_.z + rc_.w + rd_.x + rd_.y + rd_.z + rd_.w); \
        GAS bf16* up_ = (GAS bf16*)Upart + ((size_t)s * M + (tk)) * 128 + lane; const unsigned pk_ = cvtpk((float)s0_ * xinv, (float)s1_ * xinv); up_[0] = (bf16)(pk_ & 0xffffu); up_[64] = (bf16)(pk_ >> 16); } while (0)
__device__ __forceinline__ void peer_u_phase_dot4(int s, int tok0, int tstride, int nitems, const v2u* route, const float* x1, const unsigned char* TU8s, float* Upart, LAS unsigned char* scr, int lane) {
    const int r = lane >> 3, c = lane & 7, rsw = 4 * ((lane >> 3) & 1); const unsigned l8 = (unsigned)lane * 8u;
    const char* tbs = (const char*)TU8s + (size_t)s * NEXP * 128 + 16 * c;
    int m_e0, m_e1; f32x2 m_x;
    v4u bufA[16], bufB[16], xqA, xqB; float xiA, xiB;
    PD_META_U(tok0); PD_ISSUE_U(bufA, xqA, xiA, 0); if (nitems > 1) PD_META_U(tok0 + tstride);
#pragma unroll 1
    for (int it = 0; it < nitems; it += 2) {
        const int tk = tok0 + it * tstride;
        if (it + 1 < nitems) PD_ISSUE_U(bufB, xqB, xiB, 1);
        if (it + 2 < nitems) PD_META_U(tk + 2 * tstride);
        PD_COMPUTE_U(bufA, xqA, xiA, tk);
        if (it + 1 < nitems) {
            if (it + 2 < nitems) PD_ISSUE_U(bufA, xqA, xiA, 0);
            if (it + 3 < nitems) PD_META_U(tk + 3 * tstride);
            PD_COMPUTE_U(bufB, xqB, xiB, tk + tstride);
        }
    }
    LDS_WAIT();
}
__device__ __forceinline__ void peer_w_token(int tok, const v2u* route, const float* x1, const float* Upart, const float* SU, const float* SV, float* W, int lane) {
    const GAS f32x4* xp = (const GAS f32x4*)(x1 + (size_t)tok * D) + lane; float ssq = 0.f;
#pragma unroll
    for (int j = 0; j < 4; ++j) { const f32x4 q = xp[64 * j]; ssq += (q.x * q.x + q.y * q.y) + (q.z * q.z + q.w * q.w); }
    const float rstd2 = 1.0f / sqrtf(wave_sum(ssq) * (1.0f / D) + RMS_EPS);
    const char* rb_ = (const char*)route + (size_t)tok * 1024; const unsigned l8_ = (unsigned)lane * 8u;
    const v2u r_lo = *(const GAS v2u*)(rb_ + l8_), r_hi = *(const GAS v2u*)(rb_ + 512 + l8_);
    float g_lo, g_hi;
#pragma unroll
    for (int half = 0; half < 2; ++half) {
        const float sc_ = __builtin_bit_cast(float, half ? r_hi.y : r_lo.y) * rstd2; float m_ = sc_;
#pragma unroll
        for (int o = 1; o < 16; o <<= 1) m_ = __builtin_fmaxf(m_, __shfl_xor(m_, o));
        const float p_ = __builtin_amdgcn_exp2f((sc_ - m_) * 1.4426950408889634f); float sum_ = p_;
#pragma unroll
        for (int o = 1; o < 16; o <<= 1) sum_ += __shfl_xor(sum_, o);
        if (half) g_hi = p_ / sum_; else g_lo = p_ / sum_;
    }
    asm volatile("" : "+v"(g_lo), "+v"(g_hi));
#pragma unroll
    for (int half = 0; half < 2; ++half) {
        const int e = (int)(half ? r_hi.x : r_lo.x); const int n = lane + 64 * half;
        float dot = 0.f;
#pragma unroll
        for (int s8 = 0; s8 < 8; ++s8) dot += Upart[((size_t)s8 * M + tok) * 128 + n];
        const float act = gelu_exact(dot * SU[e] * rstd2);
        W[(size_t)tok * 128 + n] = (half ? g_hi : g_lo) * act * SV[e];
    }
}
__device__ __forceinline__ void peer_w_token2(int tokA, int tokB, const v2u* route, const bf16* x1b, const bf16* Upart, const float* SU, const float* SV, float* W, int lane) {
    v4u xv[2][2]; v2u r_lo[2], r_hi[2]; unsigned short ub[2][2][8];
#pragma unroll
    for (int t = 0; t < 2; ++t) { const int tok = t ? tokB : tokA;
        const GAS v4u* xp = (const GAS v4u*)(x1b + (size_t)tok * D) + lane; xv[t][0] = xp[0]; xv[t][1] = xp[64];
        const char* rb_ = (const char*)route + (size_t)tok * 1024; const unsigned l8_ = (unsigned)lane * 8u;
        r_lo[t] = *(const GAS v2u*)(rb_ + l8_); r_hi[t] = *(const GAS v2u*)(rb_ + 512 + l8_);
#pragma unroll
        for (int half = 0; half < 2; ++half)
#pragma unroll
            for (int s8 = 0; s8 < 8; ++s8) ub[t][half][s8] = *(const GAS bf16*)(Upart + ((size_t)s8 * M + tok) * 128 + lane + 64 * half); }
#pragma unroll
    for (int t = 0; t < 2; ++t) { const int tok = t ? tokB : tokA;
        float ssq = 0.f;
#pragma unroll
        for (int j = 0; j < 2; ++j) { const v4u q = xv[t][j];
            ssq += (bflo(q.x) * bflo(q.x) + bfhi(q.x) * bfhi(q.x)) + (bflo(q.y) * bflo(q.y) + bfhi(q.y) * bfhi(q.y)) + (bflo(q.z) * bflo(q.z) + bfhi(q.z) * bfhi(q.z)) + (bflo(q.w) * bflo(q.w) + bfhi(q.w) * bfhi(q.w)); }
        const float rstd2 = 1.0f / sqrtf(wave_sum(ssq) * (1.0f / D) + RMS_EPS);
        float g_lo, g_hi;
#pragma unroll
        for (int half = 0; half < 2; ++half) {
            const float sc_ = __builtin_bit_cast(float, half ? r_hi[t].y : r_lo[t].y) * rstd2; float m_ = sc_;
#pragma unroll
            for (int o = 1; o < 16; o <<= 1) m_ = __builtin_fmaxf(m_, __shfl_xor(m_, o));
            const float p_ = __builtin_amdgcn_exp2f((sc_ - m_) * 1.4426950408889634f); float sum_ = p_;
#pragma unroll
            for (int o = 1; o < 16; o <<= 1) sum_ += __shfl_xor(sum_, o);
            if (half) g_hi = p_ / sum_; else g_lo = p_ / sum_;
        }
        asm volatile("" : "+v"(g_lo), "+v"(g_hi));
#pragma unroll
        for (int half = 0; half < 2; ++half) {
            const int e = (int)(half ? r_hi[t].x : r_lo[t].x); const int n = lane + 64 * half;
            float dot = 0.f;
#pragma unroll
            for (int s8 = 0; s8 < 8; ++s8) dot += __builtin_bit_cast(float, (unsigned)ub[t][half][s8] << 16);
            const float act = gelu_exact(dot * SU[e] * rstd2);
            W[(size_t)tok * 128 + n] = (half ? g_hi : g_lo) * act * SV[e];
        }
    }
}
#define PC_META_V(tk) do { const char* rb_ = (const char*)route + (size_t)(tk) * 1024; m_e0 = *(const GAS int*)(rb_ + l8); m_e1 = *(const GAS int*)(rb_ + 512 + l8); \
        const GAS float* wp_ = (const GAS float*)(W + (size_t)(tk) * 128); m_w0 = wp_[lane]; m_w1 = wp_[lane + 64]; m_xv = *(const GAS unsigned*)(xres + (size_t)(tk) * D + col0); } while (0)
#define PC_ISSUE_V(buf, wk, xv, par) do { LAS int* lid_ = (LAS int*)(scr + (par) * 1024); LAS float* lw_ = (LAS float*)(scr + (par) * 1024 + 512); lid_[lane] = m_e0; lid_[lane + 64] = m_e1; lw_[lane] = m_w0; lw_[lane + 64] = m_w1; LDS_WAIT(); xv = m_xv; \
        _Pragma("unroll") for (int k = 0; k < 16; ++k) { const int e_ = lid_[8 * k + r]; wk[k] = lw_[8 * k + r]; buf[k] = *(const GAS v4u*)(tbs + (unsigned)(e_ * 128)); } } while (0)
#define PC_COMPUTE_V(buf, wk, xv, tk) do { f32x2 acc2[8]; _Pragma("unroll") for (int i_ = 0; i_ < 8; ++i_) acc2[i_] = (f32x2){0.f, 0.f}; \
        _Pragma("unroll") for (int k = 0; k < 16; ++k) { PIN_ACC2(buf[k]); fp8_row_axpy2(buf[k], wk[k], acc2); } \
          \
        LAS float* red_ = (LAS float*)(scr + 2048); LAS f32x4* wp_ = (LAS f32x4*)(red_ + 128 * r + 16 * c); \
        _Pragma("unroll") for (int j_ = 0; j_ < 4; ++j_) { f32x4 t_; t_.x = acc2[2 * j_].x; t_.y = acc2[2 * j_].y; t_.z = acc2[2 * j_ + 1].x; t_.w = acc2[2 * j_ + 1].y; wp_[j_] = t_; } \
        LDS_WAIT(); \
        f32x2 o_; o_.x = bflo(xv); o_.y = bfhi(xv); \
        _Pragma("unroll") for (int rr_ = 0; rr_ < 8; ++rr_) { const f32x2 t_ = *(const LAS f32x2*)(red_ + 128 * rr_ + 2 * lane); o_.x += t_.x; o_.y += t_.y; } \
        *(GAS f32x2*)(xio + (size_t)(tk) * D + col0) = o_; } while (0)
__device__ __forceinline__ void peer_v_phase(int s, int tok0, int tstride, int nitems, const v2u* route, const float* W, const unsigned char* TV8s, const bf16* xres, float* xio, float* SS, LAS unsigned char* scr, int lane) {
    const int r = lane >> 3, c = lane & 7; const unsigned l8 = (unsigned)lane * 8u;
    const int col0 = 128 * s + 2 * lane;
    const char* tbs = (const char*)TV8s + (size_t)s * NEXP * 128 + 16 * c;
    int m_e0, m_e1; float m_w0, m_w1; unsigned m_xv;
    v4u bufA[16], bufB[16]; float wA[16], wB[16]; unsigned xvA, xvB;
    PC_META_V(tok0); PC_ISSUE_V(bufA, wA, xvA, 0); if (nitems > 1) PC_META_V(tok0 + tstride);
#pragma unroll 1
    for (int i = 0; i < nitems; i += 2) {
        const int tk = tok0 + i * tstride;
        if (i + 1 < nitems) PC_ISSUE_V(bufB, wB, xvB, 1);
        if (i + 2 < nitems) PC_META_V(tk + 2 * tstride);
        PC_COMPUTE_V(bufA, wA, xvA, tk);
        if (i + 1 < nitems) {
            if (i + 2 < nitems) PC_ISSUE_V(bufA, wA, xvA, 0);
            if (i + 3 < nitems) PC_META_V(tk + 3 * tstride);
            PC_COMPUTE_V(bufB, wB, xvB, tk + tstride);
        }
    }
    LDS_WAIT();
}


__device__ __forceinline__ void peer_u_debug(int tok, const v2u* route, const float* x1, const unsigned char* TU8s, const float* SU, const float* SV, float* W, int lane) {
    float xr[16], ssq = 0.f;
    { const GAS f32x4* xp = (const GAS f32x4*)(x1 + (size_t)tok * D + 16 * lane);
#pragma unroll
      for (int j = 0; j < 4; ++j) { const f32x4 a = xp[j]; xr[4 * j] = a.x; xr[4 * j + 1] = a.y; xr[4 * j + 2] = a.z; xr[4 * j + 3] = a.w; } }
#pragma unroll
    for (int i = 0; i < 16; ++i) ssq += xr[i] * xr[i];
    const float rstd2 = 1.0f / sqrtf(wave_sum(ssq) * (1.0f / D) + RMS_EPS);
    const char* rb_ = (const char*)route + (size_t)tok * 1024; const int s = lane >> 3, c = lane & 7;
#pragma unroll 1
    for (int h = 0; h < 8; ++h) {
        float sc[16]; int id[16]; float m = -3e38f;
#pragma unroll
        for (int i = 0; i < 16; ++i) { const v2u r = *(const GAS v2u*)(rb_ + (h * 16 + i) * 8 + opaque_zero()); id[i] = (int)r.x; sc[i] = __builtin_bit_cast(float, r.y) * rstd2; m = __builtin_fmaxf(m, sc[i]); }
        float sum = 0.f;
#pragma unroll
        for (int i = 0; i < 16; ++i) { sc[i] = __builtin_amdgcn_exp2f((sc[i] - m) * 1.4426950408889634f); sum += sc[i]; }
#pragma unroll
        for (int i = 0; i < 16; ++i) { const int e = id[i];
            const v4u q = *(const GAS v4u*)(TU8s + ((size_t)s * NEXP + e) * 128 + 16 * c);
            float d; fp8_row_dot(q, xr, d); d = wave_sum(d);
            const float act = gelu_exact(d * SU[e] * rstd2);
            if (lane == 0) W[(size_t)tok * 128 + h * 16 + i] = (sc[i] / sum) * act * SV[e]; }
    }
}
__device__ __forceinline__ void peer_v_debug(int tok, const v2u* route, const float* W, const unsigned char* TV8s, float* xio, float* SS, int lane) {
    const char* rb_ = (const char*)route + (size_t)tok * 1024;
    float acc[16];
#pragma unroll
    for (int i = 0; i < 16; ++i) acc[i] = 0.f;
    const int s = lane >> 3, c = lane & 7;
#pragma unroll 1
    for (int n = 0; n < 128; ++n) {
        const int e = *(const GAS int*)(rb_ + n * 8 + opaque_zero()); const float w = W[(size_t)tok * 128 + n + opaque_zero()];
        const v4u q = *(const GAS v4u*)(TV8s + ((size_t)s * NEXP + e) * 128 + 16 * c);
        fp8_row_axpy(q, w, acc);
    }
    float ssq = 0.f;
    GAS float* xp = (GAS float*)(xio + (size_t)tok * D + 16 * lane);
#pragma unroll
    for (int i = 0; i < 16; ++i) { const float o = xp[i] + acc[i]; xp[i] = o; ssq += o * o; }
    ssq = wave_sum(ssq);
    if (lane < 8) SS[(size_t)lane * M + tok] = (lane == 0) ? ssq : 0.f;
}
#ifndef DUP_MASK
#define DUP_MASK 0
#endif
#define NREP(k) (1 + ((DUP_MASK >> (k)) & 1))
struct Args { const float* in[14]; float* out; unsigned char* ws; int ph_lo, ph_hi, li, pad; };
__global__ void __launch_bounds__(NWAVES * 64, 2) hybrid_fwd(Args args) {
    extern __shared__ __attribute__((aligned(16))) unsigned char lds[];
    LAS unsigned char* ldsb = (LAS unsigned char*)lds;
    volatile LAS unsigned* MISC = (volatile LAS unsigned*)(ldsb + MISC_OFF);
    const int tid = threadIdx.x, lane = tid & 63, wave = __builtin_amdgcn_readfirstlane(tid >> 6);
    const int G = gridDim.x; const int bx = blockIdx.x; const int vcu = (G % 8 == 0) ? (bx % 8) * (G / 8) + bx / 8 : bx;
    const int gw = vcu * NWAVES + wave, NGW = G * NWAVES;
    unsigned char* ws = args.ws;
    gu32* ctl = (gu32*)(ws + WS_CTL);
    const float* x = args.in[0]; float* out = args.out;
#define norm_mix (args.in[1])
#define w_in (args.in[2])
#define conv_w (args.in[3])
#define conv_b (args.in[4])
#define w_a (args.in[5])
#define w_b (args.in[6])
#define w_o (args.in[7])
#define norm_ffn (args.in[8])
#define w_q (args.in[9])
#define sub_keys (args.in[10])
#define exp_u (args.in[11])
#define exp_v (args.in[12])
#define final_norm (args.in[13])
#define Weff ((bf16*)((bf16*)(ws + WS_WEFF)))
#define Wab ((bf16*)((bf16*)(ws + WS_WAB)))
#define Wo_t ((bf16*)((bf16*)(ws + WS_WO)))
#define Win_t ((bf16*)((bf16*)(ws + WS_WIN)))
#define XB ((bf16*)((bf16*)(ws + WS_XB)))
#define SIX ((bf16*)((bf16*)(ws + WS_SIX)))
#define VT ((bf16*)((bf16*)(ws + WS_VT)))
#define GATE ((bf16*)((bf16*)(ws + WS_GATE)))
#define MERGED ((bf16*)((bf16*)(ws + WS_MERGED)))
#define X1B ((bf16*)((bf16*)(ws + WS_X1B)))
#define TU8 ((unsigned char*)(ws + WS_TU))
#define TV8 ((unsigned char*)(ws + WS_TV))
#define SU ((float*)((float*)(ws + WS_SU)))
#define SV ((float*)((float*)(ws + WS_SV)))
#define SCORES ((float*)((float*)(ws + WS_SCORES)))
#define ROUTE ((v2u*)((v2u*)(ws + WS_ROUTE)))
#define WBUF ((float*)((float*)(ws + WS_W)))
#define SSB ((float*)((float*)(ws + WS_SS)))
#define UPART ((float*)((float*)(ws + WS_UPART)))
#define RSTD1 ((float*)((float*)(ws + WS_RSTD1)))
#define QB ((bf16*)(SIX))
#define CBB ((bf16*)(SIX + (size_t)1 * M * 512))
#define KB ((bf16*)(SIX + (size_t)2 * M * 512))
#define CCB ((bf16*)(SIX + (size_t)4 * M * 512))
#define CUB ((bf16*)(SIX + (size_t)5 * M * 512))
    for (int u = tid; u < (LDS_BYTES - LDSCTL_OFF) / 4; u += NWAVES * 64) ((LAS unsigned*)(ldsb + LDSCTL_OFF))[u] = 0u;
    __syncthreads();
    XcdBarrier bar; bar.bar = (unsigned*)(ctl + CW_BAR); bar.x = 0; bar.st = nullptr;
    if (N_LAUNCHES == 1) bar = xcd_barrier_post((unsigned*)(ctl + CW_BAR), MISC + 8);
#define GRID_BAR() do { if (N_LAUNCHES == 1) xcd_barrier(bar); } while (0)
#ifdef TPROBE
    unsigned long long t_s = 0, t_e = 0;
#define TSTAMP(k) do { if ((k) == TPROBE) t_s = __builtin_amdgcn_s_memrealtime(); if ((k) == TPROBE_END) t_e = __builtin_amdgcn_s_memrealtime(); } while (0)
#ifndef TPROBE_TID
#define TPROBE_TID 0
#endif
#define TSTALL() do { if (bx == 0 && tid == TPROBE_TID) { const unsigned long long t0_ = __builtin_amdgcn_s_memrealtime(), dt_ = (t_e - t_s) * 8ull; while (__builtin_amdgcn_s_memrealtime() - t0_ < dt_) __builtin_amdgcn_s_sleep(4); } } while (0)
#else
#define TSTAMP(k) do { } while (0)
#define TSTALL() do { } while (0)
#endif
    const int lo = args.ph_lo, hi = args.ph_hi;
#define IN(k) (lo <= (k) && (k) < hi)
#define BOTH(k) (IN(k) && IN((k) + 1))

    TSTAMP(0);
    if (IN(0)) { for (int rep = 0; rep < NREP(0); ++rep) {
        LAS float* scr = (LAS float*)(ldsb + RING_OFF + wave * 17408);
        constexpr int I_IN = (D / 64) * (NIN / 32), I_A = (512 / 64) * (D / 32), I_O = (D / 64) * (D / 32);
        constexpr int NITEMS = I_IN + 2 * I_A + I_O;
        constexpr int ABW = 3; const int aw = vcu * ABW + wave, NAW = G * ABW, cw = vcu * (NWAVES - ABW) + (wave - ABW), NCW = G * (NWAVES - ABW);
        if (wave < ABW) {
        for (int it = aw; it < NITEMS; it += NAW) {
            int r = it;
            if (r < I_IN) { p0_transpose_item(w_in, D, NIN, Win_t, 0, norm_mix, scr, r, lane); continue; } r -= I_IN;
            if (r < I_A) { p0_transpose_item(w_a, 512, D, Wab, 0, nullptr, scr, r, lane); continue; } r -= I_A;
            if (r < I_A) { p0_transpose_item(w_b, 512, D, Wab, 1024, nullptr, scr, r, lane); continue; } r -= I_A;
            p0_transpose_item(w_o, D, D, Wo_t, 0, nullptr, scr, r, lane);
        }
        TSTAMP(20);
        for (int wt = aw; wt < 64 * 32; wt += NAW) {
            const int nt = wt & 63, kt = wt >> 6, hp = nt >> 2, h = lane >> 5, l32 = lane & 31;
            f32x4 av[16], bv[16];
            { f32x4 t[16];
#pragma unroll
              for (int i = 0; i < 16; ++i) t[i] = *(const GAS f32x4*)(w_q + (size_t)(kt * 32 + 2 * i + (lane >> 5)) * 2048 + hp * 128 + 4 * (lane & 31));
#pragma unroll
              for (int i = 0; i < 16; ++i) *(LAS f32x4*)(scr + (2 * i + (lane >> 5)) * 132 + 4 * (lane & 31)) = t[i];
              LDS_WAIT();
#pragma unroll
              for (int i = 0; i < 16; ++i) av[i] = *(const LAS f32x4*)(scr + l32 * 132 + 64 * h + 4 * i);
              LDS_WAIT();
#pragma unroll
              for (int i = 0; i < 16; ++i) t[i] = *(const GAS f32x4*)(sub_keys + (size_t)(nt * 32) * 128 + 4 * (i * 64 + lane));
#pragma unroll
              for (int i = 0; i < 16; ++i) *(LAS f32x4*)(scr + (2 * i + (lane >> 5)) * 132 + 4 * (lane & 31)) = t[i];
              LDS_WAIT();
#pragma unroll
              for (int i = 0; i < 16; ++i) bv[i] = *(const LAS f32x4*)(scr + l32 * 132 + 64 * h + 4 * i);
              LDS_WAIT(); }
            f32x16 acc;
#pragma unroll
            for (int i = 0; i < 16; ++i) acc[i] = 0.f;
#pragma unroll
            for (int i = 0; i < 16; ++i) {
                acc = __builtin_amdgcn_mfma_f32_32x32x2f32(av[i].x, bv[i].x, acc, 0, 0, 0); acc = __builtin_amdgcn_mfma_f32_32x32x2f32(av[i].y, bv[i].y, acc, 0, 0, 0);
                acc = __builtin_amdgcn_mfma_f32_32x32x2f32(av[i].z, bv[i].z, acc, 0, 0, 0); acc = __builtin_amdgcn_mfma_f32_32x32x2f32(av[i].w, bv[i].w, acc, 0, 0, 0); }
            const int n = nt * 32 + l32;
#pragma unroll
            for (int rq = 0; rq < 4; ++rq) { const int kb = kt * 32 + 8 * rq + 4 * h; const f32x4 g = *(const GAS f32x4*)(norm_ffn + kb);
                v2u o; o.x = pk2(acc[4 * rq] * g.x, acc[4 * rq + 1] * g.y); o.y = pk2(acc[4 * rq + 2] * g.z, acc[4 * rq + 3] * g.w);
                *(GAS v2u*)(Weff + (size_t)n * D + kb) = o; }
        }
        TSTAMP(21);
        } else {
        for (int m0 = cw; m0 < M; m0 += 4 * NCW) {
            f32x4 v[4][4]; float s[4];
#pragma unroll
            for (int q = 0; q < 4; ++q) { const int m = m0 + q * NCW; const GAS f32x4* xr = (const GAS f32x4*)(x + (size_t)(m < M ? m : m0) * D) + lane;
#pragma unroll
                for (int j = 0; j < 4; ++j) v[q][j] = __builtin_nontemporal_load(xr + 64 * j); }
#pragma unroll
            for (int q = 0; q < 4; ++q) { s[q] = 0.f;
#pragma unroll
                for (int j = 0; j < 4; ++j) s[q] += (v[q][j].x * v[q][j].x + v[q][j].y * v[q][j].y) + (v[q][j].z * v[q][j].z + v[q][j].w * v[q][j].w); }
#pragma unroll
            for (int o = 1; o < 64; o <<= 1) {
#pragma unroll
                for (int q = 0; q < 4; ++q) s[q] += __shfl_xor(s[q], o); }
#pragma unroll
            for (int q = 0; q < 4; ++q) { const int m = m0 + q * NCW; if (m < M) {
                const float rstd = 1.0f / sqrtf(s[q] * (1.0f / D) + RMS_EPS);
                GAS v2u* o8 = (GAS v2u*)(XB + (size_t)m * D) + lane;
#pragma unroll
                for (int j = 0; j < 4; ++j) { v2u o; o.x = pk2(v[q][j].x, v[q][j].y); o.y = pk2(v[q][j].z, v[q][j].w); o8[64 * j] = o; }
                if (lane == 0) RSTD1[m] = rstd; } }
        }
        TSTAMP(22);
        for (int e0 = cw; e0 < NEXP; e0 += 2 * NCW) {
            float v[4][16]; float am[4]; int ee[4];
#pragma unroll
            for (int q = 0; q < 4; ++q) { const int e = e0 + (q >> 1) * NCW; ee[q] = e < NEXP ? e : e0; const float* src = ((q & 1) ? exp_v : exp_u) + (size_t)ee[q] * D; const GAS f32x4* sp = (const GAS f32x4*)src;
#pragma unroll
                for (int j = 0; j < 2; ++j) { const f32x4 a = __builtin_nontemporal_load(sp + 2 * lane + 128 * j), b = __builtin_nontemporal_load(sp + 2 * lane + 128 * j + 1);
                    v[q][8 * j + 0] = a.x; v[q][8 * j + 1] = a.y; v[q][8 * j + 2] = a.z; v[q][8 * j + 3] = a.w; v[q][8 * j + 4] = b.x; v[q][8 * j + 5] = b.y; v[q][8 * j + 6] = b.z; v[q][8 * j + 7] = b.w; } }
            { const GAS f32x4* gp = (const GAS f32x4*)norm_ffn;
#pragma unroll
              for (int j = 0; j < 2; ++j) { const f32x4 ga = gp[2 * lane + 128 * j], gb = gp[2 * lane + 128 * j + 1];
#pragma unroll
                for (int q = 0; q < 4; q += 2) { v[q][8 * j + 0] *= ga.x; v[q][8 * j + 1] *= ga.y; v[q][8 * j + 2] *= ga.z; v[q][8 * j + 3] *= ga.w; v[q][8 * j + 4] *= gb.x; v[q][8 * j + 5] *= gb.y; v[q][8 * j + 6] *= gb.z; v[q][8 * j + 7] *= gb.w; } } }
#pragma unroll
            for (int q = 0; q < 4; ++q) { am[q] = 0.f;
#pragma unroll
                for (int i = 0; i < 16; ++i) am[q] = __builtin_fmaxf(am[q], __builtin_fabsf(v[q][i])); }
#pragma unroll
            for (int o = 1; o < 64; o <<= 1) {
#pragma unroll
                for (int q = 0; q < 4; ++q) am[q] = __builtin_fmaxf(am[q], __shfl_xor(am[q], o)); }
#pragma unroll
            for (int q = 0; q < 4; ++q) { const int e = e0 + (q >> 1) * NCW; if (e < NEXP) {
                const float top = (q & 1) ? 384.0f : 127.0f;
                const float sc = (am[q] > 0.f) ? top / am[q] : 1.0f, inv = (am[q] > 0.f) ? am[q] * (1.0f / top) : 1.0f;
                v2u q0, q1;
                if (q & 1) {
                { int w = __builtin_amdgcn_cvt_pk_fp8_f32(v[q][0] * sc, v[q][1] * sc, 0, false); w = __builtin_amdgcn_cvt_pk_fp8_f32(v[q][2] * sc, v[q][3] * sc, w, true); q0.x = (unsigned)w; }
                { int w = __builtin_amdgcn_cvt_pk_fp8_f32(v[q][4] * sc, v[q][5] * sc, 0, false); w = __builtin_amdgcn_cvt_pk_fp8_f32(v[q][6] * sc, v[q][7] * sc, w, true); q0.y = (unsigned)w; }
                { int w = __builtin_amdgcn_cvt_pk_fp8_f32(v[q][8] * sc, v[q][9] * sc, 0, false); w = __builtin_amdgcn_cvt_pk_fp8_f32(v[q][10] * sc, v[q][11] * sc, w, true); q1.x = (unsigned)w; }
                { int w = __builtin_amdgcn_cvt_pk_fp8_f32(v[q][12] * sc, v[q][13] * sc, 0, false); w = __builtin_amdgcn_cvt_pk_fp8_f32(v[q][14] * sc, v[q][15] * sc, w, true); q1.y = (unsigned)w; }
                } else {
                    unsigned w4[4];
#pragma unroll
                    for (int j = 0; j < 4; ++j) { const int i0 = (int)__builtin_rintf(v[q][4 * j] * sc), i1 = (int)__builtin_rintf(v[q][4 * j + 1] * sc), i2 = (int)__builtin_rintf(v[q][4 * j + 2] * sc), i3 = (int)__builtin_rintf(v[q][4 * j + 3] * sc);
                        w4[j] = ((unsigned)i0 & 255u) | (((unsigned)i1 & 255u) << 8) | (((unsigned)i2 & 255u) << 16) | ((unsigned)i3 << 24); }
                    q0.x = w4[0]; q0.y = w4[1]; q1.x = w4[2]; q1.y = w4[3];
                }
                unsigned char* dst = (q & 1) ? TV8 : TU8; const int s0 = lane >> 4, o8 = 8 * (lane & 15);
                *(GAS v2u*)(dst + ((size_t)s0 * NEXP + e) * 128 + o8) = q0; *(GAS v2u*)(dst + ((size_t)(s0 + 4) * NEXP + e) * 128 + o8) = q1;
                if (lane == 0) ((q & 1) ? SV : SU)[e] = inv; } }
        }
                TSTAMP(23);
        }
}
        if (BOTH(0)) GRID_BAR();
    }

    TSTAMP(1);
    if (IN(1)) { for (int rep = 0; rep < NREP(1); ++rep) { if (rep) GRID_BAR();
        pg8::Gemm g{XB, Win_t, M, NIN, D}; pg8::StaticOrder S; S.init(M, NIN, G, (int)blockIdx.x);
        pg8::EpiProj E{SIX, VT, GATE, RSTD1, (DUP_MASK & 64) ? rep : 0};
        pg8::gemm_phase<pg8::EpiProj, pg8::StaticOrder, true, true>(ldsb + RING_OFF, g, S, E); }
        if (DUP_MASK & 128) { const unsigned long long t0 = __builtin_amdgcn_s_memrealtime(); while (__builtin_amdgcn_s_memrealtime() - t0 < 15000ull) __builtin_amdgcn_s_sleep(8); }
        if (BOTH(1)) GRID_BAR();
    }

    TSTAMP(2);
    if (IN(2)) {
        for (int rep = 0; rep < NREP(2); ++rep) {
        const bool dummy = (rep + 1 < NREP(2));
        conv_phase(CBB, CCB, CUB, dummy ? XB : CBB, conv_w, conv_b, gw * 64 + lane, NGW * 64);
        for (int it = gw; it < BATCH * NH * (T / 32); it += NGW) {
            const int bh = it >> 7, qblk = it & 127;
            attn_item(QB, KB, VT, dummy ? MERGED : QB, bh >> 3, bh & 7, qblk, lane);
        }
        }
        if (BOTH(2)) GRID_BAR();
    }

    TSTAMP(3);
    if (IN(3)) { for (int rep = 0; rep < NREP(3); ++rep) { if (rep) GRID_BAR();
        pg8::Gemm g{QB, Wab, 2 * M, 2048, 512}; pg8::PairOrder S; S.init(G, (int)blockIdx.x);
        pg8::EpiGate E{out, MERGED, GATE, GATE + (size_t)M * 1024};
        pg8::gemm_phase<pg8::EpiGate, pg8::PairOrder, true, true>(ldsb + RING_OFF, g, S, E); }
        if (BOTH(3)) GRID_BAR();
    }

    TSTAMP(4);
    if (IN(4)) { for (int rep = 0; rep < NREP(4); ++rep) { if (rep) GRID_BAR();
        pg8::Gemm g{MERGED, Wo_t, M, D, D}; pg8::StaticOrder S; S.init(M, D, G, (int)blockIdx.x);
        pg8::EpiWo E{x, X1B};
        pg8::gemm_phase<pg8::EpiWo, pg8::StaticOrder, false, true>(ldsb + RING_OFF, g, S, E);
        }
        if (BOTH(4)) GRID_BAR();
    }

    TSTAMP(5);
    if (IN(5)) { for (int rep = 0; rep < NREP(5); ++rep) { if (rep) GRID_BAR();
        pg8::Gemm g{X1B, Weff, M, 2048, D}; pg8::StaticOrder S; S.init(M, 2048, G, (int)blockIdx.x);
        pg8::EpiScores E{(unsigned short*)SCORES};
        pg8::gemm_phase<pg8::EpiScores, pg8::StaticOrder, true, true>(ldsb + RING_OFF, g, S, E);
        asm volatile("s_waitcnt vmcnt(0)" ::: "memory"); __syncthreads();
        int nu = 0; { pg8::Unit u; while (S.next(nu, u)) ++nu; }
        LAS unsigned char* scr = ldsb + RING_OFF + wave * 8192;
        for (int t = wave; t < nu * 4; t += NWAVES) { pg8::Unit u; S.next(t >> 2, u); route_task((const unsigned short*)SCORES, ROUTE, u.pm * 256 + (t & 3) * 64, u.pn, scr, lane); } }
        if (BOTH(5)) GRID_BAR();
    }
    const bool sliced_ok = (G % 8 == 0) && (M % ((G / 8) * NWAVES) == 0);

    TSTAMP(7);
    if (IN(7)) {
        LAS unsigned char* scr = ldsb + RING_OFF + wave * 8192;
#ifdef DEBUG_U
        if (1) {} else
#endif
        if (sliced_ok) { const int nj = G >> 3; peer_u_phase_dot4(bx & 7, (bx >> 3) * NWAVES + wave, nj * NWAVES, M / (nj * NWAVES), ROUTE, (const float*)X1B, TU8, UPART, scr, lane); }
        else for (int s8 = 0; s8 < 8; ++s8) { const int nt = (M - 1 - gw) / NGW + 1; if (gw < M) peer_u_phase_dot4(s8, gw, NGW, nt, ROUTE, (const float*)X1B, TU8, UPART, scr, lane); }
        if (BOTH(7)) GRID_BAR();
    }

    TSTAMP(8);
    if (IN(8)) {
#ifdef DEBUG_U
        for (int tok = gw; tok < M; tok += NGW) peer_u_debug(tok, ROUTE, out, TU8, SU, SV, WBUF, lane);
#else
        for (int tok = gw; tok < M; tok += 2 * NGW) peer_w_token2(tok, (tok + NGW < M) ? tok + NGW : tok, ROUTE, X1B, (const bf16*)UPART, SU, SV, WBUF, lane);
#endif
        if (BOTH(8)) GRID_BAR();
    }

    TSTAMP(9);
    if (IN(9)) {
        LAS unsigned char* scr = ldsb + RING_OFF + wave * 8192;
#ifdef DEBUG_V
        for (int tok = gw; tok < M; tok += NGW) peer_v_debug(tok, ROUTE, WBUF, TV8, out, SSB, lane);
        if (0)
#endif
        if (sliced_ok) { const int nj = G >> 3; peer_v_phase(bx & 7, (bx >> 3) * NWAVES + wave, nj * NWAVES, M / (nj * NWAVES), ROUTE, WBUF, TV8, X1B, out, SSB, scr, lane); }
        else for (int s8 = 0; s8 < 8; ++s8) { const int nt = (M - 1 - gw) / NGW + 1; if (gw < M) peer_v_phase(s8, gw, NGW, nt, ROUTE, WBUF, TV8, X1B, out, SSB, scr, lane); }
        if (BOTH(9)) GRID_BAR();
    }

    TSTAMP(10);
    if (IN(10)) {
        for (int tok = gw; tok < M; tok += NGW) {
            GAS f32x4* op = (GAS f32x4*)(out + (size_t)tok * D) + lane; const GAS f32x4* gp = (const GAS f32x4*)final_norm + lane;
            f32x4 v[4]; float s2 = 0.f;
#pragma unroll
            for (int j = 0; j < 4; ++j) { v[j] = op[64 * j]; s2 += (v[j].x * v[j].x + v[j].y * v[j].y) + (v[j].z * v[j].z + v[j].w * v[j].w); }
            const float rstd3 = 1.0f / sqrtf(wave_sum(s2) * (1.0f / D) + RMS_EPS);
#pragma unroll
            for (int j = 0; j < 4; ++j) { const f32x4 g = gp[64 * j]; f32x4 o; o.x = v[j].x * rstd3 * g.x; o.y = v[j].y * rstd3 * g.y; o.z = v[j].z * rstd3 * g.z; o.w = v[j].w * rstd3 * g.w; op[64 * j] = o; }
        }
    }
    TSTAMP(11);
    TSTALL();
#undef IN
#undef BOTH
#undef GRID_BAR
#undef norm_mix
#undef w_in
#undef conv_w
#undef conv_b
#undef w_a
#undef w_b
#undef w_o
#undef norm_ffn
#undef w_q
#undef sub_keys
#undef exp_u
#undef exp_v
#undef final_norm
#undef Weff
#undef Wab
#undef Wo_t
#undef Win_t
#undef XB
#undef SIX
#undef VT
#undef GATE
#undef MERGED
#undef X1B
#undef TU8
#undef TV8
#undef SU
#undef SV
#undef SCORES
#undef ROUTE
#undef WBUF
#undef SSB
#undef UPART
#undef RSTD1
#undef QB
#undef CBB
#undef KB
#undef CCB
#undef CUB
}

extern "C" void kernel_launch(void* const* d_in, const int* in_sizes, int n_in, void* d_out, int out_size, void* d_ws, size_t ws_size, hipStream_t stream) {
    static int grid = 0;
    if (grid == 0) {
        if (n_in != 14 || in_sizes[0] != M * D || out_size != M * D || ws_size < WS_END) { fprintf(stderr, "kernel_launch: built for 14 inputs, x/out of %d floats, >= %zu bytes of workspace; got n_in %d, in0 %d, out %d, ws %zu; nothing launched\n", M * D, (size_t)WS_END, n_in, n_in > 0 ? in_sizes[0] : -1, out_size, ws_size); grid = -1; return; }
        int dev = 0, cus = 0, per_cu = 0;
        if (hipGetDevice(&dev) != hipSuccess || hipDeviceGetAttribute(&cus, hipDeviceAttributeMultiprocessorCount, dev) != hipSuccess) { fprintf(stderr, "kernel_launch: device query failed\n"); grid = -1; return; }
        if (hipFuncSetAttribute((const void*)hybrid_fwd, hipFuncAttributeMaxDynamicSharedMemorySize, LDS_BYTES) != hipSuccess) { fprintf(stderr, "kernel_launch: hipFuncSetAttribute failed\n"); grid = -1; return; }
        if (hipOccupancyMaxActiveBlocksPerMultiprocessor(&per_cu, (const void*)hybrid_fwd, NWAVES * 64, LDS_BYTES) != hipSuccess || per_cu < 1) { fprintf(stderr, "kernel_launch: occupancy query reports %d workgroups per CU\n", per_cu); per_cu = 1; }
        (void)hipGetLastError();
        grid = cus;
    }
    if (grid < 0) return;
    if (hipMemsetAsync((char*)d_ws + WS_CTL, 0, CTL_ZERO_BYTES, stream) != hipSuccess) { fprintf(stderr, "kernel_launch: hipMemsetAsync failed\n"); return; }
    Args a{};
    for (int i = 0; i < 14; ++i) a.in[i] = (const float*)d_in[i];
    a.out = (float*)d_out; a.ws = (unsigned char*)d_ws;
#ifdef PROBE_SEQ
    const int seq[] = PROBE_SEQ; const int nseq = (int)(sizeof(seq) / sizeof(int));
#else
    const int seq[] = {0, 1, 2, 3, 4, 5, 6, 7, 8, 9, 10}; const int nseq = (N_LAUNCHES == 1) ? 1 : 11;
#endif
    for (int li = 0; li < nseq; ++li) {
        a.ph_lo = (N_LAUNCHES == 1) ? 0 : seq[li]; a.ph_hi = (N_LAUNCHES == 1) ? N_PHASES : seq[li] + 1; a.li = li;
        hipLaunchKernelGGL(hybrid_fwd, dim3(grid), dim3(NWAVES * 64), LDS_BYTES, stream, a);
        const hipError_t le = hipPeekAtLastError();
        if (le != hipSuccess) { fprintf(stderr, "kernel_launch: launch %d failed: %s\n", li, hipGetErrorName(le)); break; }
    }
}
```

```cpp
#define DUP_MASK 0
#include <hip/hip_runtime.h>
#include <cstdio>
#include <cstdint>
#include <cmath>
namespace pg8 {
#define PG8_LAS __attribute__((address_space(3)))
typedef unsigned short bf16_t;
typedef short bf16x8 __attribute__((ext_vector_type(8)));
typedef float f32x4 __attribute__((ext_vector_type(4)));
typedef unsigned u32x4 __attribute__((ext_vector_type(4)));
constexpr int BM = 256, BK = 64, HALF = 128, HTB = HALF * BK * 2  , STAGE_BYTES = 8 * HTB, NXCD = 8, WGM = 8;

__host__ __device__ __forceinline__ int lds_byte(int r, int c) { const int st = (r >> 4) * 2 + (c >> 5), rr = r & 15, cc = c & 31, ob = rr * 64 + cc * 2; return st * 1024 + (ob ^ (((ob >> 9) & 1) << 5)); }
__host__ __device__ __forceinline__ void stage_rc(int b, int& R, int& C) { const int st = b / 1024, sb = b % 1024, swz = sb ^ (((sb >> 9) & 1) << 5); R = (st >> 1) * 16 + swz / 64; C = (st & 1) * 32 + (swz % 64) / 2; }
__host__ __device__ __forceinline__ int perm32(int rho) { const int n = rho >> 4, i = rho & 15; return 8 * (i >> 2) + 4 * n + (i & 3); }

struct Unit { int pm, pn; };
struct Gemm { const bf16_t* A; const bf16_t* Bt; int M, N, K; };

struct StaticOrder {
    int nM, nN, nwg, G, c;
    __host__ __device__ void init(int M, int N, int G_, int c_) { nM = M / BM; nN = N / BM; nwg = nM * nN; G = G_; c = c_; }
    __host__ __device__ bool next(int i, Unit& u) const {
        const long L = (long)i * G + c; if (L >= nwg) return false;
        int wgid = (int)L; { const int q = nwg / NXCD, r = nwg % NXCD, xcd = wgid % NXCD, off = wgid / NXCD; wgid = (xcd < r ? xcd * (q + 1) : r * (q + 1) + (xcd - r) * q) + off; }
        const int nig = WGM * nN, gid = wgid / nig, fm = gid * WGM, gsz = (nM - fm) < WGM ? (nM - fm) : WGM;
        u.pm = fm + ((wgid % nig) % gsz); u.pn = (wgid % nig) / gsz; return true;
    }
    __device__ __forceinline__ void a_ready(const Unit&) const {}
    __device__ __forceinline__ void done(const Unit&) const {}
};

__device__ __forceinline__ unsigned cvt_pk_bf16(float lo, float hi) { unsigned r; asm volatile("v_cvt_pk_bf16_f32 %0, %1, %2" : "=v"(r) : "v"(lo), "v"(hi)); return r; }
constexpr int MTOK = 16384;
__device__ __forceinline__ unsigned f2bf_rne(float f) { unsigned u = __builtin_bit_cast(unsigned, f); return (u + 0x7fffu + ((u >> 16) & 1u)) >> 16; }
__device__ __forceinline__ float bf_lo(unsigned w) { return __builtin_bit_cast(float, w << 16); }
__device__ __forceinline__ float bf_hi(unsigned w) { return __builtin_bit_cast(float, w & 0xffff0000u); }
__device__ __forceinline__ float sigmoid_fast(float x) { return __builtin_amdgcn_rcpf(1.0f + __builtin_amdgcn_exp2f(-1.4426950408889634f * x)); }

struct EpiProj {
    static constexpr bool PERM = true, AFTER_DRAIN = false;
    bf16_t* six;
    bf16_t* vt;
    bf16_t* gate;
    const float* rstd; int skip;
    __device__ __forceinline__ void operator()(const f32x4 (&acc)[2][2][4][2], const Unit& u, int wr, int wc, int fr, int fq) const {
        const int row0 = u.pm * BM + wr * 64 + fr; const int colt = u.pn * BM;
        if (skip) return;
        if (colt < 3072) {
            const int t = colt >> 9, cc = colt & 511;
            if (t == 2) {
#pragma unroll
                for (int ai = 0; ai < 2; ++ai)
#pragma unroll
                    for (int m = 0; m < 4; ++m) { const int r = row0 + ai * HALF + m * 16; const float rs = rstd[r]; const int b = r >> 12, tt = r & 4095;
#pragma unroll
                        for (int bj = 0; bj < 2; ++bj) { const int c0 = cc + bj * HALF + wc * 32 + 8 * fq; const int hh = c0 >> 6, d0 = c0 & 63;
                            bf16_t* p = vt + ((size_t)((b * 8 + hh) * 64 + d0)) * 4096 + tt;
#pragma unroll
                            for (int n = 0; n < 2; ++n)
#pragma unroll
                                for (int i = 0; i < 4; ++i) p[(size_t)(4 * n + i) * 4096] = (bf16_t)f2bf_rne(acc[ai][bj][m][n][i] * rs); } }
            } else {
                const int bufidx = (t == 0) ? 0 : (t == 1) ? 2 : (t == 3) ? 1 : t;
                bf16_t* base = six + (size_t)bufidx * MTOK * 512; const float sc = (t == 0) ? 0.125f : 1.0f;
                const int col0 = cc + wc * 32 + 8 * fq;
#pragma unroll
                for (int ai = 0; ai < 2; ++ai)
#pragma unroll
                    for (int m = 0; m < 4; ++m) { const int r = row0 + ai * HALF + m * 16; const float rs = rstd[r] * sc; bf16_t* rowp = base + (size_t)r * 512 + col0;
#pragma unroll
                        for (int bj = 0; bj < 2; ++bj) { const f32x4 v0 = acc[ai][bj][m][0] * rs, v1 = acc[ai][bj][m][1] * rs;
                            u32x4 w; w.x = cvt_pk_bf16(v0[0], v0[1]); w.y = cvt_pk_bf16(v0[2], v0[3]); w.z = cvt_pk_bf16(v1[0], v1[1]); w.w = cvt_pk_bf16(v1[2], v1[3]);
                            *(u32x4*)(rowp + bj * HALF) = w; } }
            }
        } else {
            const int gi = (colt - 3072) >> 10, cc = (colt - 3072) & 1023;
            bf16_t* base = gate + (size_t)gi * MTOK * 1024; const int col0 = cc + wc * 32 + 8 * fq;
#pragma unroll
            for (int ai = 0; ai < 2; ++ai)
#pragma unroll
                for (int m = 0; m < 4; ++m) { const int r = row0 + ai * HALF + m * 16; const float rs = rstd[r]; bf16_t* rowp = base + (size_t)r * 1024 + col0;
#pragma unroll
                    for (int bj = 0; bj < 2; ++bj) { f32x4 v0 = acc[ai][bj][m][0] * rs, v1 = acc[ai][bj][m][1] * rs;
#pragma unroll
                        for (int i = 0; i < 4; ++i) { v0[i] = sigmoid_fast(v0[i]); v1[i] = sigmoid_fast(v1[i]); }
                        u32x4 w; w.x = cvt_pk_bf16(v0[0], v0[1]); w.y = cvt_pk_bf16(v0[2], v0[3]); w.z = cvt_pk_bf16(v1[0], v1[1]); w.w = cvt_pk_bf16(v1[2], v1[3]);
                        *(u32x4*)(rowp + bj * HALF) = w; } }
        }
    }
};

struct EpiGate {
    static constexpr bool PERM = true, AFTER_DRAIN = false;
    float* P; bf16_t* merged; const bf16_t* g0; const bf16_t* g1;
    __device__ __forceinline__ void operator()(const f32x4 (&acc)[2][2][4][2], const Unit& u, int wr, int wc, int fr, int fq) const {
        const int which = (u.pm >= 64) ? 1 : 0; const int pm = u.pm - 64 * which, pn = u.pn - 4 * which;
        const int row0 = pm * BM + wr * 64 + fr, col0 = pn * BM + wc * 32 + 8 * fq; const bf16_t* g = which ? g1 : g0;
#pragma unroll
        for (int ai = 0; ai < 2; ++ai)
#pragma unroll
            for (int m = 0; m < 4; ++m) { const int r = row0 + ai * HALF + m * 16;
#pragma unroll
                for (int bj = 0; bj < 2; ++bj) { const size_t off = (size_t)r * 1024 + col0 + bj * HALF;
                    const u32x4 gv = *(const u32x4*)(g + off);
                    f32x4 a0 = acc[ai][bj][m][0], a1 = acc[ai][bj][m][1];
                    a0[0] *= bf_lo(gv.x); a0[1] *= bf_hi(gv.x); a0[2] *= bf_lo(gv.y); a0[3] *= bf_hi(gv.y);
                    a1[0] *= bf_lo(gv.z); a1[1] *= bf_hi(gv.z); a1[2] *= bf_lo(gv.w); a1[3] *= bf_hi(gv.w);
                    if (!which) { u32x4 w; w.x = cvt_pk_bf16(a0[0], a0[1]); w.y = cvt_pk_bf16(a0[2], a0[3]); w.z = cvt_pk_bf16(a1[0], a1[1]); w.w = cvt_pk_bf16(a1[2], a1[3]); *(u32x4*)((bf16_t*)P + off) = w; }
                    else { const u32x4 pw = *(const u32x4*)((const bf16_t*)P + off);
                        a0[0] += bf_lo(pw.x); a0[1] += bf_hi(pw.x); a0[2] += bf_lo(pw.y); a0[3] += bf_hi(pw.y); a1[0] += bf_lo(pw.z); a1[1] += bf_hi(pw.z); a1[2] += bf_lo(pw.w); a1[3] += bf_hi(pw.w);
                        u32x4 w; w.x = cvt_pk_bf16(a0[0], a0[1]); w.y = cvt_pk_bf16(a0[2], a0[3]); w.z = cvt_pk_bf16(a1[0], a1[1]); w.w = cvt_pk_bf16(a1[2], a1[3]);
                        *(u32x4*)(merged + off) = w; } } }
    }
};
struct PairOrder {
    StaticOrder so;
    __host__ __device__ void init(int G_, int c_) { so.init(MTOK, 1024, G_, c_); }
    __host__ __device__ bool next(int i, Unit& u) const { Unit t; if (!so.next(i >> 1, t)) return false; const int w = i & 1; u.pm = t.pm + 64 * w; u.pn = t.pn + 4 * w; return true; }
    __device__ __forceinline__ void a_ready(const Unit&) const {}
    __device__ __forceinline__ void done(const Unit&) const {}
};

struct EpiWo {
    static constexpr bool PERM = true, AFTER_DRAIN = false;
    const float* x; bf16_t* x1b;
    __device__ __forceinline__ void operator()(const f32x4 (&acc)[2][2][4][2], const Unit& u, int wr, int wc, int fr, int fq) const {
        const int row0 = u.pm * BM + wr * 64 + fr, col0 = u.pn * BM + wc * 32 + 8 * fq;
#pragma unroll
        for (int ai = 0; ai < 2; ++ai)
#pragma unroll
            for (int m = 0; m < 4; ++m) { const int r = row0 + ai * HALF + m * 16;
#pragma unroll
                for (int bj = 0; bj < 2; ++bj) { const size_t off = (size_t)r * 1024 + col0 + bj * HALF;
                    const f32x4 a0 = acc[ai][bj][m][0] + *(const f32x4*)(x + off), a1 = acc[ai][bj][m][1] + *(const f32x4*)(x + off + 4);
                    u32x4 w; w.x = cvt_pk_bf16(a0[0], a0[1]); w.y = cvt_pk_bf16(a0[2], a0[3]); w.z = cvt_pk_bf16(a1[0], a1[1]); w.w = cvt_pk_bf16(a1[2], a1[3]);
                    *(u32x4*)(x1b + off) = w; } }
    }
};
typedef _Float16 f16x2_t __attribute__((ext_vector_type(2)));
typedef float f32x2e __attribute__((ext_vector_type(2)));
__device__ __forceinline__ unsigned pk_f16(float lo, float hi) { f32x2e v = {lo, hi}; f16x2_t h = __builtin_convertvector(v, f16x2_t); return __builtin_bit_cast(unsigned, h); }
struct EpiScores {
    static constexpr bool PERM = true, AFTER_DRAIN = false;
    unsigned short* S;
    __device__ __forceinline__ void operator()(const f32x4 (&acc)[2][2][4][2], const Unit& u, int wr, int wc, int fr, int fq) const {
        const int row0 = u.pm * BM + wr * 64 + fr, col0 = u.pn * BM + wc * 32 + 8 * fq;
#pragma unroll
        for (int ai = 0; ai < 2; ++ai)
#pragma unroll
            for (int m = 0; m < 4; ++m) { const int r = row0 + ai * HALF + m * 16;
#pragma unroll
                for (int bj = 0; bj < 2; ++bj) { const size_t off = ((size_t)((col0 + bj * HALF) >> 3) * MTOK + r) * 8;
                    const f32x4 a0 = acc[ai][bj][m][0], a1 = acc[ai][bj][m][1];
                    u32x4 w; w.x = pk_f16(a0[0], a0[1]); w.y = pk_f16(a0[2], a0[3]); w.z = pk_f16(a1[0], a1[1]); w.w = pk_f16(a1[2], a1[3]);
                    *(u32x4*)(S + off) = w; } }
    }
};
template <class Epi, class Sched, bool ALIGN_EPI = false, bool SP2 = false>
__device__ __forceinline__ void gemm_phase(PG8_LAS unsigned char* lds, const Gemm g, const Sched& S, const Epi& E) {
    const int tid = threadIdx.x, wid = __builtin_amdgcn_readfirstlane(tid >> 6), lane = tid & 63, wr = wid >> 2, wc = wid & 3, fr = lane & 15, fq = lane >> 4;
    const int K = g.K, nt = K / BK;
    unsigned voffA[2], voffB[2];
#pragma unroll
    for (int i = 0; i < 2; ++i) { int R, C; stage_rc(tid * 16 + i * 8192, R, C); const int Rb = Epi::PERM ? ((R & ~31) + perm32(R & 31)) : R;
        voffA[i] = (unsigned)(R * K + C) * 2u; voffB[i] = (unsigned)(Rb * K + C) * 2u; }
    const size_t kstep = (size_t)(BK * 2);
    const size_t hstep = (size_t)HALF * K * 2;
    const size_t tstep = 2 * hstep;
    const unsigned ldsw = (unsigned)wid * 1024u;
    const int aoff = lds_byte(wr * 64 + fr, fq * 8), boff = lds_byte(wc * 32 + fr, fq * 8);
#define PG8_SA(b, h) (((b) * 2 + (h)) * HTB)
#define PG8_SB(b, h) ((4 + (b) * 2 + (h)) * HTB)
#define PG8_STAGE(bufoff, gbase, voff) do { _Pragma("unroll") for (int _i = 0; _i < 2; ++_i) \
        __builtin_amdgcn_global_load_lds((const unsigned*)((const char*)(gbase) + (voff)[_i]), (PG8_LAS unsigned*)(lds + (bufoff) + ldsw + _i * 8192), 16, 0, 0); } while (0)
#define PG8_LDA(dst, b, h) do { _Pragma("unroll") for (int m = 0; m < 4; ++m) _Pragma("unroll") for (int k = 0; k < 2; ++k) dst[m][k] = *(const PG8_LAS bf16x8*)(lds + PG8_SA(b, h) + aoff + m * 2048 + k * 1024); } while (0)
#define PG8_LDB(dst, b, h) do { _Pragma("unroll") for (int n = 0; n < 2; ++n) _Pragma("unroll") for (int k = 0; k < 2; ++k) dst[n][k] = *(const PG8_LAS bf16x8*)(lds + PG8_SB(b, h) + boff + n * 2048 + k * 1024); } while (0)
#define PG8_MMA(ai, bj, At, Bt) do { __builtin_amdgcn_s_setprio(1); _Pragma("unroll") for (int m = 0; m < 4; ++m) _Pragma("unroll") for (int n = 0; n < 2; ++n) _Pragma("unroll") for (int k = 0; k < 2; ++k) \
        acc[ai][bj][m][n] = __builtin_amdgcn_mfma_f32_16x16x32_bf16(Bt[n][k], At[m][k], acc[ai][bj][m][n], 0, 0, 0); __builtin_amdgcn_s_setprio(0); } while (0)
#define PG8_WAIT_V(n) asm volatile("s_waitcnt vmcnt(" #n ")" ::: "memory")
#define PG8_WAIT_L(n) asm volatile("s_waitcnt lgkmcnt(" #n ")" ::: "memory")
#define PG8_BAR __builtin_amdgcn_s_barrier()
#define PG8_SCHED __builtin_amdgcn_sched_barrier(0)
    Unit cur, nxt; int ui = 0;
    if (!S.next(0, cur)) return;
    f32x4 acc[2][2][4][2];
#pragma unroll
    for (int a = 0; a < 2; ++a)
#pragma unroll
        for (int b = 0; b < 2; ++b)
#pragma unroll
            for (int m = 0; m < 4; ++m)
#pragma unroll
                for (int n = 0; n < 2; ++n) acc[a][b][m][n] = (f32x4){0.f, 0.f, 0.f, 0.f};
    bf16x8 At[4][2], B0[2][2], B1[2][2];
    const char* cA = (const char*)g.A + (size_t)cur.pm * tstep; const char* cB = (const char*)g.Bt + (size_t)cur.pn * tstep;
    S.a_ready(cur);
    if constexpr (SP2) {
        PG8_STAGE(PG8_SB(0, 0), cB, voffB); PG8_STAGE(PG8_SB(0, 1), cB + hstep, voffB); PG8_STAGE(PG8_SA(0, 0), cA, voffA); PG8_STAGE(PG8_SA(0, 1), cA + hstep, voffA);
        if (wr == 1) PG8_BAR;
        PG8_WAIT_V(2); PG8_BAR;
        PG8_STAGE(PG8_SB(1, 0), cB + kstep, voffB); PG8_STAGE(PG8_SA(1, 0), cA + kstep, voffA); PG8_STAGE(PG8_SB(1, 1), cB + hstep + kstep, voffB);
        PG8_WAIT_V(6); PG8_BAR;
    } else {
        PG8_STAGE(PG8_SB(0, 0), cB, voffB); PG8_STAGE(PG8_SA(0, 0), cA, voffA); PG8_STAGE(PG8_SB(0, 1), cB + hstep, voffB); PG8_STAGE(PG8_SA(0, 1), cA + hstep, voffA);
        if (wr == 1) PG8_BAR;
        PG8_WAIT_V(4); PG8_BAR;
        PG8_STAGE(PG8_SB(1, 0), cB + kstep, voffB); PG8_STAGE(PG8_SA(1, 0), cA + kstep, voffA); PG8_STAGE(PG8_SB(1, 1), cB + hstep + kstep, voffB);
        PG8_WAIT_V(6); PG8_BAR;
    }
    for (;;) {
        const bool has_next = S.next(ui + 1, nxt);
        const char* nA = has_next ? (const char*)g.A + (size_t)nxt.pm * tstep : cA; const char* nB = has_next ? (const char*)g.Bt + (size_t)nxt.pn * tstep : cB;
        for (int t = 0; t < nt; t += 2) {
            const bool last = (t == nt - 2);
            const char* a1 = cA + (size_t)(t + 1) * kstep;
            const char* a2 = last ? nA : cA + (size_t)(t + 2) * kstep; const char* b2 = last ? nB : cB + (size_t)(t + 2) * kstep;
            const char* a3 = a2 + kstep; const char* b3 = b2 + kstep;
            if (last && has_next) S.a_ready(nxt);
            if constexpr (SP2) {
            PG8_LDB(B0, 0, 0); PG8_LDB(B1, 0, 1); PG8_SCHED; PG8_LDA(At, 0, 0); PG8_STAGE(PG8_SA(1, 1), a1 + hstep, voffA);
            PG8_WAIT_V(8); PG8_WAIT_L(0); PG8_BAR; PG8_MMA(0, 0, At, B0); PG8_MMA(0, 1, At, B1); PG8_BAR; PG8_SCHED;
            PG8_LDA(At, 0, 1); PG8_STAGE(PG8_SB(0, 0), b2, voffB); PG8_STAGE(PG8_SB(0, 1), b2 + hstep, voffB); PG8_STAGE(PG8_SA(0, 0), a2, voffA);
            PG8_WAIT_V(8); PG8_WAIT_L(0); PG8_BAR; PG8_MMA(1, 0, At, B0); PG8_MMA(1, 1, At, B1); PG8_BAR; PG8_SCHED;
            PG8_LDB(B0, 1, 0); PG8_LDB(B1, 1, 1); PG8_SCHED; PG8_LDA(At, 1, 0); PG8_STAGE(PG8_SA(0, 1), a2 + hstep, voffA);
            PG8_WAIT_V(8); PG8_WAIT_L(0); PG8_BAR; PG8_MMA(0, 0, At, B0); PG8_MMA(0, 1, At, B1); PG8_BAR; PG8_SCHED;
            PG8_LDA(At, 1, 1); PG8_STAGE(PG8_SB(1, 0), b3, voffB); PG8_STAGE(PG8_SB(1, 1), b3 + hstep, voffB); PG8_STAGE(PG8_SA(1, 0), a3, voffA);
            PG8_WAIT_V(8); PG8_WAIT_L(0); PG8_BAR; PG8_MMA(1, 0, At, B0); PG8_MMA(1, 1, At, B1); PG8_BAR; PG8_SCHED;
            } else {
            PG8_LDB(B0, 0, 0); PG8_SCHED; PG8_LDA(At, 0, 0); PG8_STAGE(PG8_SA(1, 1), a1 + hstep, voffA);
            PG8_WAIT_L(8); PG8_BAR; PG8_WAIT_L(0); PG8_MMA(0, 0, At, B0); PG8_BAR; PG8_SCHED;
            PG8_LDB(B1, 0, 1); PG8_STAGE(PG8_SB(0, 0), b2, voffB);
            PG8_BAR; PG8_WAIT_L(0); PG8_MMA(0, 1, At, B1); PG8_BAR;
            PG8_LDA(At, 0, 1); PG8_STAGE(PG8_SA(0, 0), a2, voffA);
            PG8_BAR; PG8_WAIT_L(0); PG8_MMA(1, 0, At, B0); PG8_BAR; PG8_SCHED;
            PG8_STAGE(PG8_SB(0, 1), b2 + hstep, voffB);
            PG8_WAIT_V(6); PG8_BAR; PG8_MMA(1, 1, At, B1); PG8_BAR;
            PG8_LDB(B0, 1, 0); PG8_SCHED; PG8_LDA(At, 1, 0); PG8_STAGE(PG8_SA(0, 1), a2 + hstep, voffA);
            PG8_WAIT_L(8); PG8_BAR; PG8_WAIT_L(0); PG8_MMA(0, 0, At, B0); PG8_BAR; PG8_SCHED;
            PG8_LDB(B1, 1, 1); PG8_STAGE(PG8_SB(1, 0), b3, voffB);
            PG8_BAR; PG8_WAIT_L(0); PG8_MMA(0, 1, At, B1); PG8_BAR;
            PG8_LDA(At, 1, 1); PG8_STAGE(PG8_SA(1, 0), a3, voffA);
            PG8_BAR; PG8_WAIT_L(0); PG8_MMA(1, 0, At, B0); PG8_BAR; PG8_SCHED;
            PG8_STAGE(PG8_SB(1, 1), b3 + hstep, voffB);
            PG8_WAIT_V(6); PG8_BAR; PG8_MMA(1, 1, At, B1); PG8_BAR;
            }
        }
        if constexpr (ALIGN_EPI) { if (wr == 0) PG8_BAR; }
        if constexpr (!Epi::AFTER_DRAIN) { E(acc, cur, wr, wc, fr, fq); S.done(cur); }
        if (!has_next) break;
#pragma unroll
        for (int a = 0; a < 2; ++a)
#pragma unroll
            for (int b = 0; b < 2; ++b)
#pragma unroll
                for (int m = 0; m < 4; ++m)
#pragma unroll
                    for (int n = 0; n < 2; ++n) acc[a][b][m][n] = (f32x4){0.f, 0.f, 0.f, 0.f};
        cur = nxt; cA = nA; cB = nB; ++ui;
        if constexpr (ALIGN_EPI) { if (wr == 1) PG8_BAR; }
    }
    PG8_WAIT_V(0);
    if constexpr (!ALIGN_EPI) { if (wr == 0) PG8_BAR; }
    PG8_BAR;
    if constexpr (Epi::AFTER_DRAIN) { E.fused(acc, cur, wr, wc, fr, fq, lds, wid, lane); S.done(cur); }
#undef PG8_SA
#undef PG8_SB
#undef PG8_STAGE
#undef PG8_LDA
#undef PG8_LDB
#undef PG8_MMA
#undef PG8_WAIT_V
#undef PG8_WAIT_L
#undef PG8_BAR
#undef PG8_SCHED
}
}

constexpr int NWAVES = 8;
constexpr int BATCH = 4, T = 4096, D = 1024, NH = 8, HD = 64, NIN = 5120;
constexpr int M = BATCH * T;
constexpr int NEXP = 16384;
constexpr float RMS_EPS = 1e-6f;
#ifndef MK_N_LAUNCHES
#define MK_N_LAUNCHES 1
#endif
constexpr int N_PHASES = 11;
constexpr int N_LAUNCHES = MK_N_LAUNCHES;

constexpr size_t MiB = 1u << 20;
constexpr size_t WS_CTL = 0, CTL_ZERO_BYTES = 64 * 1024;
constexpr size_t WS_RSTD1 = 512 * 1024;
constexpr size_t WS_WEFF = 1 * MiB;
constexpr size_t WS_WAB = 5 * MiB;
constexpr size_t WS_WO = 7 * MiB;
constexpr size_t WS_WIN = 9 * MiB;
constexpr size_t WS_XB = 19 * MiB;
constexpr size_t WS_SIX = 51 * MiB;
constexpr size_t WS_VT = WS_SIX + 3 * 16 * MiB;
constexpr size_t WS_GATE = 147 * MiB;
constexpr size_t WS_MERGED = 19 * MiB;
constexpr size_t WS_X1B = 51 * MiB;
constexpr size_t WS_TU = 211 * MiB, WS_TV = 227 * MiB;
constexpr size_t WS_SU = 576 * 1024, WS_SV = 640 * 1024;
constexpr size_t WS_SCORES = 83 * MiB;
constexpr size_t WS_ROUTE = 19 * MiB;
constexpr size_t WS_W = 35 * MiB;
constexpr size_t WS_SS = 43 * MiB;
constexpr size_t WS_UPART = 83 * MiB;
constexpr size_t WS_END = 256 * MiB;
constexpr int CW_BAR = 4096;

constexpr int RING_OFF = 0, RING_BYTES = 131072;
constexpr int LDSCTL_OFF = RING_BYTES;
constexpr int LDS_BYTES = 147456;
constexpr int MISC_OFF = LDS_BYTES - 128;

#define GAS __attribute__((address_space(1)))
#define LAS __attribute__((address_space(3)))
#define CAS __attribute__((address_space(4)))
typedef unsigned short bf16;
typedef unsigned v4u __attribute__((ext_vector_type(4)));
typedef unsigned v2u __attribute__((ext_vector_type(2)));
typedef float f32x4 __attribute__((ext_vector_type(4)));
typedef float f32x2 __attribute__((ext_vector_type(2)));
typedef float f32x16 __attribute__((ext_vector_type(16)));
typedef short bf16x8 __attribute__((ext_vector_type(8)));
typedef _Float16 f16x8 __attribute__((ext_vector_type(8)));
typedef _Float16 f16x2 __attribute__((ext_vector_type(2)));
typedef __bf16 bf16x2_t __attribute__((ext_vector_type(2)));
typedef GAS unsigned gu32;
#define RLX_AGENT __ATOMIC_RELAXED, __HIP_MEMORY_SCOPE_AGENT
#define LDS_WAIT() asm volatile("s_waitcnt lgkmcnt(0)" ::: "memory")
#define VM_WAIT() asm volatile("s_waitcnt vmcnt(0)" ::: "memory")
__device__ __forceinline__ unsigned f2bf(float f) { unsigned u = __builtin_bit_cast(unsigned, f); return (u + 0x7fffu + ((u >> 16) & 1u)) >> 16; }
__device__ __forceinline__ unsigned pk2(float lo, float hi) { return f2bf(lo) | (f2bf(hi) << 16); }
__device__ __forceinline__ unsigned cvtpk(float lo, float hi) { f32x2 v = {lo, hi}; bf16x2_t b = __builtin_convertvector(v, bf16x2_t); return __builtin_bit_cast(unsigned, b); }
__device__ __forceinline__ float bflo(unsigned w) { return __builtin_bit_cast(float, w << 16); }
__device__ __forceinline__ float bfhi(unsigned w) { return __builtin_bit_cast(float, w & 0xffff0000u); }
__device__ __forceinline__ float wave_sum(float v) {
#pragma unroll
    for (int o = 1; o < 64; o <<= 1) v += __shfl_xor(v, o);
    return v;
}
#define XB_TMO      128
#define XB_XCNT(j)  (256  + 64 * (j))
#define XB_XSUB(j)  (1280 + 64 * (j))
#define XB_XGEN(j)  (2304 + 64 * (j))
#define XB_TOP      3328
#define XB_TOPGEN   3392
#define XCD_BAR_WORDS 3456
#define XB_SPIN_CAP (1u << 18)

__device__ __forceinline__ unsigned xb_ld(unsigned* p)              { return __hip_atomic_load(p, __ATOMIC_RELAXED, __HIP_MEMORY_SCOPE_AGENT); }
__device__ __forceinline__ unsigned xb_add(unsigned* p, unsigned v) { return __hip_atomic_fetch_add(p, v, __ATOMIC_RELAXED, __HIP_MEMORY_SCOPE_AGENT); }
__device__ __forceinline__ unsigned xb_xcc_id() { return (unsigned)__builtin_amdgcn_s_getreg((3 << 11) | 20) & 0xFu; }
#define XB_SPIN(cond, bar) do { unsigned _sp = 0; while (cond) { __builtin_amdgcn_s_sleep(1); \
    if ((++_sp & 255u) == 0u) { if (xb_ld(&(bar)[XB_TMO])) break; if (_sp > XB_SPIN_CAP) { atomicAdd(&(bar)[XB_TMO], 1u); break; } } } } while (0)

struct XcdBarrier {
    unsigned* bar; unsigned x;
    volatile LAS unsigned* st;
};

__device__ __forceinline__ XcdBarrier xcd_barrier_post(unsigned* bar, volatile LAS unsigned* st) {
    XcdBarrier b; b.bar = bar; b.x = xb_xcc_id(); b.st = st;
    if (threadIdx.x == 0) (void)xb_add(&bar[XB_XCNT(b.x)], 1u);
    return b;
}
__device__ __forceinline__ void xcd_barrier_complete(unsigned* bar, unsigned x, unsigned& nloc, unsigned& nx) {
    const unsigned G = gridDim.x * gridDim.y * gridDim.z;
    unsigned sum, cnt, mine, sp = 0u;
    for (;;) {
        sum = 0u; cnt = 0u; mine = 0u;
#pragma unroll
        for (unsigned j = 0; j < 16; ++j) { const unsigned c = xb_ld(&bar[XB_XCNT(j)]); sum += c; cnt += (c > 0u) ? 1u : 0u; mine = (j == x) ? c : mine; }
        if (sum == G) break;
        __builtin_amdgcn_s_sleep(1);
        if ((++sp & 255u) == 0u) { if (xb_ld(&bar[XB_TMO])) break; if (sp > XB_SPIN_CAP) { atomicAdd(&bar[XB_TMO], 1u); break; } }
    }
    nloc = mine > 0u ? mine : 1u; nx = cnt > 0u ? cnt : 1u;
}

__device__ __forceinline__ void xcd_barrier(const XcdBarrier& b) {
    asm volatile("s_waitcnt vmcnt(0)" ::: "memory");
    __syncthreads();
    if (threadIdx.x == 0) {
        unsigned* bar = b.bar;
        __builtin_amdgcn_s_waitcnt(0);
        unsigned nloc = b.st[0], nx = b.st[1];
        if (nloc == 0u) { xcd_barrier_complete(bar, b.x, nloc, nx); b.st[0] = nloc; b.st[1] = nx; }
        const unsigned old = xb_add(&bar[XB_XSUB(b.x)], 1u);
        const unsigned gen = old / nloc;
        if (old + 1u == (gen + 1u) * nloc) {
            __builtin_amdgcn_fence(__ATOMIC_RELEASE, "agent");
            asm volatile("s_waitcnt vmcnt(0)" ::: "memory");
            const unsigned og = xb_add(&bar[XB_TOP], 1u);
            const unsigned tg = og / nx;
            if (og + 1u == (tg + 1u) * nx) xb_add(&bar[XB_TOPGEN], 1u);
            else XB_SPIN(xb_ld(&bar[XB_TOPGEN]) == tg, bar);
            __builtin_amdgcn_fence(__ATOMIC_ACQUIRE, "agent");
            xb_add(&bar[XB_XGEN(b.x)], 1u);
            asm volatile("s_waitcnt vmcnt(0)" ::: "memory");
        } else {
            XB_SPIN(xb_ld(&bar[XB_XGEN(b.x)]) == gen, bar);
            __builtin_amdgcn_fence(__ATOMIC_ACQUIRE, "agent");
            asm volatile("s_waitcnt vmcnt(0)" ::: "memory");
        }
    }
    __syncthreads();
}

__device__ __forceinline__ void p0_transpose_item(const float* W, int K, int N, bf16* WT, int row_off, const float* kscale, LAS float* scr, int item, int lane) {
    const int nblk = N / 32, kb = item / nblk, nb = item % nblk, k0 = 64 * kb, n0 = 32 * nb;
    f32x4 ld[8];
#pragma unroll
    for (int i = 0; i < 8; ++i) ld[i] = __builtin_nontemporal_load((const GAS f32x4*)(W + (size_t)(k0 + 8 * i + (lane >> 3)) * N + n0 + 4 * (lane & 7)));
#pragma unroll
    for (int i = 0; i < 8; ++i) { LAS float* d = scr + (8 * i + (lane >> 3)) * 33 + 4 * (lane & 7); d[0] = ld[i].x; d[1] = ld[i].y; d[2] = ld[i].z; d[3] = ld[i].w; }
    LDS_WAIT(); asm volatile("" ::: "memory");
    const int c = lane & 7;
    float ks[8];
#pragma unroll
    for (int i = 0; i < 8; ++i) ks[i] = kscale ? kscale[k0 + 8 * c + i] : 1.0f;
#pragma unroll
    for (int j = 0; j < 4; ++j) { const int n = (lane >> 3) + 8 * j; const LAS float* s = scr + (8 * c) * 33 + n;
        v4u o; o.x = pk2(s[0 * 33] * ks[0], s[1 * 33] * ks[1]); o.y = pk2(s[2 * 33] * ks[2], s[3 * 33] * ks[3]); o.z = pk2(s[4 * 33] * ks[4], s[5 * 33] * ks[5]); o.w = pk2(s[6 * 33] * ks[6], s[7 * 33] * ks[7]);
        *(GAS v4u*)(WT + (size_t)(row_off + n0 + n) * K + k0 + 8 * c) = o; }
    LDS_WAIT(); asm volatile("" ::: "memory");
}

__device__ __forceinline__ void conv_phase(const bf16* CB, const bf16* CC, const bf16* CU, bf16* CO, const float* cw, const float* cbias, int gtid, int nthreads) {
    for (int task = gtid; task < M * 64; task += nthreads) {
        const int tok = task >> 6, c8 = (task & 63) * 8, tt = tok & (T - 1);
        const size_t off = (size_t)tok * 512 + c8;
        float z[3][8];
#pragma unroll
        for (int k = 0; k < 3; ++k) {
            const int dt = 2 - k;
            if (tt >= dt) { const v4u a = *(const GAS v4u*)(CC + off - (size_t)dt * 512), b = *(const GAS v4u*)(CU + off - (size_t)dt * 512);
                z[k][0] = bflo(a.x) * bflo(b.x); z[k][1] = bfhi(a.x) * bfhi(b.x); z[k][2] = bflo(a.y) * bflo(b.y); z[k][3] = bfhi(a.y) * bfhi(b.y);
                z[k][4] = bflo(a.z) * bflo(b.z); z[k][5] = bfhi(a.z) * bfhi(b.z); z[k][6] = bflo(a.w) * bflo(b.w); z[k][7] = bfhi(a.w) * bfhi(b.w); }
            else {
#pragma unroll
                for (int i = 0; i < 8; ++i) z[k][i] = 0.f; }
        }
        float y[8];
#pragma unroll
        for (int i = 0; i < 8; ++i) y[i] = cbias[c8 + i];
#pragma unroll
        for (int k = 0; k < 3; ++k)
#pragma unroll
            for (int i = 0; i < 8; ++i) y[i] += cw[k * 512 + c8 + i] * z[k][i];
        const v4u g = *(const GAS v4u*)(CB + off);
        v4u o; o.x = pk2(bflo(g.x) * y[0], bfhi(g.x) * y[1]); o.y = pk2(bflo(g.y) * y[2], bfhi(g.y) * y[3]); o.z = pk2(bflo(g.z) * y[4], bfhi(g.z) * y[5]); o.w = pk2(bflo(g.w) * y[6], bfhi(g.w) * y[7]);
        *(GAS v4u*)(CO + off) = o;
    }
}

__device__ __forceinline__ int crow(int r, int hf) { return (r & 3) + 8 * (r >> 2) + 4 * hf; }
#define MFMA_BF16(a, b, c) __builtin_amdgcn_mfma_f32_32x32x16_bf16((a), (b), (c), 0, 0, 0)
#define MFMA_F16(a, b, c) __builtin_amdgcn_mfma_f32_32x32x16_f16((a), (b), (c), 0, 0, 0)
__device__ __forceinline__ void attn_item(const bf16* Qb, const bf16* Kb, const bf16* VT, bf16* Ob, int b, int h, int qblk, LAS unsigned char* scr, int lane) {
    const int t32 = lane & 31, hf = lane >> 5, q0 = qblk * 32, tq = q0 + t32;
    const size_t rowbase = (size_t)b * T;
    const float LOG2E = 1.4426950408889634f, LN2 = 0.6931471805599453f;
    bf16x8 qf[4];
    { const bf16* qp = Qb + (rowbase + q0 + t32) * 512 + h * 64 + 8 * hf;
#pragma unroll
      for (int st = 0; st < 4; ++st) qf[st] = *(const GAS bf16x8*)(qp + 16 * st); }
    f16x8 tri[2];
#pragma unroll
    for (int st = 0; st < 2; ++st)
#pragma unroll
        for (int e = 0; e < 8; ++e) { const int j = 16 * st + 8 * (e >> 2) + 4 * hf + (e & 3); tri[st][e] = (j >= t32) ? (_Float16)1.0f : (_Float16)0.0f; }
    f32x16 o0, o1;
#pragma unroll
    for (int r = 0; r < 16; ++r) { o0[r] = 0.f; o1[r] = 0.f; }
    float R = 0.f;
    const bf16* kld = Kb + (rowbase + (lane >> 3)) * 512 + h * 64 + 8 * (lane & 7);
    const bf16* vld = VT + ((size_t)(b * 8 + h) * 64 + (lane >> 3)) * T + 8 * (lane & 7);
    LAS unsigned char* stw = scr + (lane >> 3) * 144 + 16 * (lane & 7);
    const LAS unsigned char* kfr = scr + t32 * 144 + 16 * hf;
    const LAS unsigned char* vfr = scr + t32 * 144 + 8 * hf;
    for (int jt = q0 >> 6; jt >= 0; --jt) {
        const int k0 = jt * 64;
        f32x16 s0, s1;
#pragma unroll
        for (int r = 0; r < 16; ++r) { s0[r] = 0.f; s1[r] = 0.f; }
        { v4u kl[8], vl[8];
#pragma unroll
          for (int i = 0; i < 8; ++i) { kl[i] = *(const GAS v4u*)(kld + (size_t)(k0 + 8 * i) * 512); vl[i] = *(const GAS v4u*)(vld + (size_t)(8 * i) * T + k0); }
#pragma unroll
          for (int i = 0; i < 8; ++i) *(LAS v4u*)(stw + i * (8 * 144)) = kl[i];
          LDS_WAIT();
          bf16x8 ka0[4], ka1[4];
#pragma unroll
          for (int st = 0; st < 4; ++st) { ka0[st] = *(const LAS bf16x8*)(kfr + 32 * st); ka1[st] = *(const LAS bf16x8*)(kfr + 32 * 144 + 32 * st); }
          LDS_WAIT();
#pragma unroll
          for (int i = 0; i < 8; ++i) *(LAS v4u*)(stw + i * (8 * 144)) = vl[i];
#pragma unroll
          for (int st = 0; st < 4; ++st) { s0 = MFMA_BF16(ka0[st], qf[st], s0); s1 = MFMA_BF16(ka1[st], qf[st], s1); }
        }
        f32x16 L0, L1; float tot0 = 0.f, tot1 = 0.f;
#pragma unroll
        for (int r = 0; r < 16; ++r) {
            const int key = k0 + crow(r, hf);
            { const float z = s0[r]; const float e = __builtin_amdgcn_exp2f(-__builtin_fabsf(z) * LOG2E); const float lp = __builtin_amdgcn_logf(1.0f + e) * LN2;
              const float L = (key < tq) ? -(__builtin_fmaxf(z, 0.f) + lp) : 0.f; L0[r] = L; tot0 += L; }
            { const float z = s1[r]; const float e = __builtin_amdgcn_exp2f(-__builtin_fabsf(z) * LOG2E); const float lp = __builtin_amdgcn_logf(1.0f + e) * LN2;
              const float L = (key + 32 < tq) ? -(__builtin_fmaxf(z, 0.f) + lp) : 0.f; L1[r] = L; tot1 += L; }
        }
        tot0 += __shfl_xor(tot0, 32); tot1 += __shfl_xor(tot1, 32);
        f16x8 lf00, lf01, lf10, lf11;
#pragma unroll
        for (int e = 0; e < 8; ++e) { lf00[e] = (_Float16)L0[e]; lf01[e] = (_Float16)L0[8 + e]; lf10[e] = (_Float16)L1[e]; lf11[e] = (_Float16)L1[8 + e]; }
        f32x16 y0, y1;
#pragma unroll
        for (int r = 0; r < 16; ++r) { y0[r] = 0.f; y1[r] = 0.f; }
        y0 = MFMA_F16(tri[0], lf00, y0); y0 = MFMA_F16(tri[1], lf01, y0);
        y1 = MFMA_F16(tri[0], lf10, y1); y1 = MFMA_F16(tri[1], lf11, y1);
        const float base0 = R + tot1, base1 = R;
        float a0v[16], a1v[16];
#pragma unroll
        for (int r = 0; r < 16; ++r) {
            const int key = k0 + crow(r, hf);
            a0v[r] = (key < tq) ? __builtin_amdgcn_exp2f((s0[r] + y0[r] + base0) * LOG2E) : 0.f;
            a1v[r] = (key + 32 < tq) ? __builtin_amdgcn_exp2f((s1[r] + y1[r] + base1) * LOG2E) : 0.f;
        }
        bf16x8 pf[2][2];
#pragma unroll
        for (int st = 0; st < 2; ++st) {
            v4u w0, w1;
            w0.x = cvtpk(a0v[8 * st + 0], a0v[8 * st + 1]); w0.y = cvtpk(a0v[8 * st + 2], a0v[8 * st + 3]); w0.z = cvtpk(a0v[8 * st + 4], a0v[8 * st + 5]); w0.w = cvtpk(a0v[8 * st + 6], a0v[8 * st + 7]);
            w1.x = cvtpk(a1v[8 * st + 0], a1v[8 * st + 1]); w1.y = cvtpk(a1v[8 * st + 2], a1v[8 * st + 3]); w1.z = cvtpk(a1v[8 * st + 4], a1v[8 * st + 5]); w1.w = cvtpk(a1v[8 * st + 6], a1v[8 * st + 7]);
            pf[0][st] = __builtin_bit_cast(bf16x8, w0); pf[1][st] = __builtin_bit_cast(bf16x8, w1);
        }
#pragma unroll
        for (int kb = 0; kb < 2; ++kb)
#pragma unroll
            for (int st = 0; st < 2; ++st) {
                const int kk2 = 2 * (32 * kb + 16 * st);
                { const v2u lo = *(const LAS v2u*)(vfr + kk2), hi = *(const LAS v2u*)(vfr + kk2 + 16); v4u w; w.x = lo.x; w.y = lo.y; w.z = hi.x; w.w = hi.y;
                  o0 = MFMA_BF16(__builtin_bit_cast(bf16x8, w), pf[kb][st], o0); }
                { const v2u lo = *(const LAS v2u*)(vfr + 32 * 144 + kk2), hi = *(const LAS v2u*)(vfr + 32 * 144 + kk2 + 16); v4u w; w.x = lo.x; w.y = lo.y; w.z = hi.x; w.w = hi.y;
                  o1 = MFMA_BF16(__builtin_bit_cast(bf16x8, w), pf[kb][st], o1); }
            }
        R += tot0 + tot1;
        LDS_WAIT();
        if (__all(R < -104.0f)) break;
    }
    bf16* op = Ob + (rowbase + q0 + t32) * 512 + h * 64 + 4 * hf;
#pragma unroll
    for (int q4 = 0; q4 < 4; ++q4) {
        v2u w; w.x = cvtpk(o0[4 * q4], o0[4 * q4 + 1]); w.y = cvtpk(o0[4 * q4 + 2], o0[4 * q4 + 3]); *(GAS v2u*)(op + 8 * q4) = w;
        v2u w2; w2.x = cvtpk(o1[4 * q4], o1[4 * q4 + 1]); w2.y = cvtpk(o1[4 * q4 + 2], o1[4 * q4 + 3]); *(GAS v2u*)(op + 32 + 8 * q4) = w2;
    }
}

#define RT_C8(op_str, cnt, x0, x1, x2, x3, x4, x5, x6, x7, thr) asm volatile(op_str : "+v"(cnt) : "v"(x0), "v"(x1), "v"(x2), "v"(x3), "v"(x4), "v"(x5), "v"(x6), "v"(x7), "v"(thr) : "vcc")
#define RT_GE8 "v_cmp_ge_f32 vcc, %1, %9\n\tv_addc_co_u32_e32 %0, vcc, 0, %0, vcc\n\tv_cmp_ge_f32 vcc, %2, %9\n\tv_addc_co_u32_e32 %0, vcc, 0, %0, vcc\n\tv_cmp_ge_f32 vcc, %3, %9\n\tv_addc_co_u32_e32 %0, vcc, 0, %0, vcc\n\tv_cmp_ge_f32 vcc, %4, %9\n\tv_addc_co_u32_e32 %0, vcc, 0, %0, vcc\n\tv_cmp_ge_f32 vcc, %5, %9\n\tv_addc_co_u32_e32 %0, vcc, 0, %0, vcc\n\tv_cmp_ge_f32 vcc, %6, %9\n\tv_addc_co_u32_e32 %0, vcc, 0, %0, vcc\n\tv_cmp_ge_f32 vcc, %7, %9\n\tv_addc_co_u32_e32 %0, vcc, 0, %0, vcc\n\tv_cmp_ge_f32 vcc, %8, %9\n\tv_addc_co_u32_e32 %0, vcc, 0, %0, vcc"
#define RT_GT8 "v_cmp_gt_f32 vcc, %1, %9\n\tv_addc_co_u32_e32 %0, vcc, 0, %0, vcc\n\tv_cmp_gt_f32 vcc, %2, %9\n\tv_addc_co_u32_e32 %0, vcc, 0, %0, vcc\n\tv_cmp_gt_f32 vcc, %3, %9\n\tv_addc_co_u32_e32 %0, vcc, 0, %0, vcc\n\tv_cmp_gt_f32 vcc, %4, %9\n\tv_addc_co_u32_e32 %0, vcc, 0, %0, vcc\n\tv_cmp_gt_f32 vcc, %5, %9\n\tv_addc_co_u32_e32 %0, vcc, 0, %0, vcc\n\tv_cmp_gt_f32 vcc, %6, %9\n\tv_addc_co_u32_e32 %0, vcc, 0, %0, vcc\n\tv_cmp_gt_f32 vcc, %7, %9\n\tv_addc_co_u32_e32 %0, vcc, 0, %0, vcc\n\tv_cmp_gt_f32 vcc, %8, %9\n\tv_addc_co_u32_e32 %0, vcc, 0, %0, vcc"
#define RT_COUNT128(OPS, cnt, thr) do { cnt = 0; RT_C8(OPS, cnt, v[0], v[1], v[2], v[3], v[4], v[5], v[6], v[7], thr); RT_C8(OPS, cnt, v[8], v[9], v[10], v[11], v[12], v[13], v[14], v[15], thr); RT_C8(OPS, cnt, v[16], v[17], v[18], v[19], v[20], v[21], v[22], v[23], thr); RT_C8(OPS, cnt, v[24], v[25], v[26], v[27], v[28], v[29], v[30], v[31], thr); RT_C8(OPS, cnt, v[32], v[33], v[34], v[35], v[36], v[37], v[38], v[39], thr); RT_C8(OPS, cnt, v[40], v[41], v[42], v[43], v[44], v[45], v[46], v[47], thr); RT_C8(OPS, cnt, v[48], v[49], v[50], v[51], v[52], v[53], v[54], v[55], thr); RT_C8(OPS, cnt, v[56], v[57], v[58], v[59], v[60], v[61], v[62], v[63], thr); RT_C8(OPS, cnt, v[64], v[65], v[66], v[67], v[68], v[69], v[70], v[71], thr); RT_C8(OPS, cnt, v[72], v[73], v[74], v[75], v[76], v[77], v[78], v[79], thr); RT_C8(OPS, cnt, v[80], v[81], v[82], v[83], v[84], v[85], v[86], v[87], thr); RT_C8(OPS, cnt, v[88], v[89], v[90], v[91], v[92], v[93], v[94], v[95], thr); RT_C8(OPS, cnt, v[96], v[97], v[98], v[99], v[100], v[101], v[102], v[103], thr); RT_C8(OPS, cnt, v[104], v[105], v[106], v[107], v[108], v[109], v[110], v[111], thr); RT_C8(OPS, cnt, v[112], v[113], v[114], v[115], v[116], v[117], v[118], v[119], thr); RT_C8(OPS, cnt, v[120], v[121], v[122], v[123], v[124], v[125], v[126], v[127], thr); } while (0)
#define RT_S5(op_str, cnt, a0, a1, a2, a3, a4, b0, b1, b2, b3, b4, thr) do { float t_; asm volatile(op_str : "+v"(cnt), "=&v"(t_) : "v"(a0), "v"(a1), "v"(a2), "v"(a3), "v"(a4), "v"(b0), "v"(b1), "v"(b2), "v"(b3), "v"(b4), "v"(thr) : "vcc"); } while (0)
#define RT_SGE5 "v_add_f32_e32 %1, %2, %7\n\tv_cmp_ge_f32 vcc, %1, %12\n\tv_addc_co_u32_e32 %0, vcc, 0, %0, vcc\n\tv_add_f32_e32 %1, %3, %8\n\tv_cmp_ge_f32 vcc, %1, %12\n\tv_addc_co_u32_e32 %0, vcc, 0, %0, vcc\n\tv_add_f32_e32 %1, %4, %9\n\tv_cmp_ge_f32 vcc, %1, %12\n\tv_addc_co_u32_e32 %0, vcc, 0, %0, vcc\n\tv_add_f32_e32 %1, %5, %10\n\tv_cmp_ge_f32 vcc, %1, %12\n\tv_addc_co_u32_e32 %0, vcc, 0, %0, vcc\n\tv_add_f32_e32 %1, %6, %11\n\tv_cmp_ge_f32 vcc, %1, %12\n\tv_addc_co_u32_e32 %0, vcc, 0, %0, vcc"
#define RT_SGT5 "v_add_f32_e32 %1, %2, %7\n\tv_cmp_gt_f32 vcc, %1, %12\n\tv_addc_co_u32_e32 %0, vcc, 0, %0, vcc\n\tv_add_f32_e32 %1, %3, %8\n\tv_cmp_gt_f32 vcc, %1, %12\n\tv_addc_co_u32_e32 %0, vcc, 0, %0, vcc\n\tv_add_f32_e32 %1, %4, %9\n\tv_cmp_gt_f32 vcc, %1, %12\n\tv_addc_co_u32_e32 %0, vcc, 0, %0, vcc\n\tv_add_f32_e32 %1, %5, %10\n\tv_cmp_gt_f32 vcc, %1, %12\n\tv_addc_co_u32_e32 %0, vcc, 0, %0, vcc\n\tv_add_f32_e32 %1, %6, %11\n\tv_cmp_gt_f32 vcc, %1, %12\n\tv_addc_co_u32_e32 %0, vcc, 0, %0, vcc"
#define RT_COUNT50(OPS, cnt, thr) do { cnt = 0; RT_S5(OPS, cnt, a[0], a[0], a[0], a[0], a[0], b[0], b[1], b[2], b[3], b[4], thr); RT_S5(OPS, cnt, a[0], a[0], a[0], a[0], a[0], b[5], b[6], b[7], b[8], b[9], thr); RT_S5(OPS, cnt, a[0], a[0], a[0], a[0], a[0], b[10], b[11], b[12], b[13], b[14], thr); RT_S5(OPS, cnt, a[0], a[1], a[1], a[1], a[1], b[15], b[0], b[1], b[2], b[3], thr); RT_S5(OPS, cnt, a[1], a[1], a[1], a[1], a[2], b[4], b[5], b[6], b[7], b[0], thr); RT_S5(OPS, cnt, a[2], a[2], a[2], a[2], a[3], b[1], b[2], b[3], b[4], b[0], thr); RT_S5(OPS, cnt, a[3], a[3], a[3], a[4], a[4], b[1], b[2], b[3], b[0], b[1], thr); RT_S5(OPS, cnt, a[4], a[5], a[5], a[6], a[6], b[2], b[0], b[1], b[0], b[1], thr); RT_S5(OPS, cnt, a[7], a[7], a[8], a[9], a[10], b[0], b[1], b[0], b[0], b[0], thr); RT_S5(OPS, cnt, a[11], a[12], a[13], a[14], a[15], b[0], b[0], b[0], b[0], b[0], thr); } while (0)
#define RT_CSWAP(x, xi, p, q) do { float t_; asm volatile("v_cmp_gt_f32 vcc, %1, %0\n\tv_cndmask_b32_e32 %4, %0, %1, vcc\n\tv_cndmask_b32_e32 %1, %1, %0, vcc\n\tv_mov_b32_e32 %0, %4\n\tv_cndmask_b32_e32 %4, %2, %3, vcc\n\tv_cndmask_b32_e32 %3, %3, %2, vcc\n\tv_mov_b32_e32 %2, %4" : "+v"(x[p]), "+v"(x[q]), "+v"(xi[p]), "+v"(xi[q]), "=&v"(t_) : : "vcc"); } while (0)
#define RT_SORT16(x, xi) do { RT_CSWAP(x, xi, 0, 1); RT_CSWAP(x, xi, 2, 3); RT_CSWAP(x, xi, 0, 2); RT_CSWAP(x, xi, 1, 3); RT_CSWAP(x, xi, 1, 2); RT_CSWAP(x, xi, 4, 5); RT_CSWAP(x, xi, 6, 7); RT_CSWAP(x, xi, 4, 6); RT_CSWAP(x, xi, 5, 7); RT_CSWAP(x, xi, 5, 6); RT_CSWAP(x, xi, 0, 4); RT_CSWAP(x, xi, 2, 6); RT_CSWAP(x, xi, 2, 4); RT_CSWAP(x, xi, 1, 5); RT_CSWAP(x, xi, 3, 7); RT_CSWAP(x, xi, 3, 5); RT_CSWAP(x, xi, 1, 2); RT_CSWAP(x, xi, 3, 4); RT_CSWAP(x, xi, 5, 6); RT_CSWAP(x, xi, 8, 9); RT_CSWAP(x, xi, 10, 11); RT_CSWAP(x, xi, 8, 10); RT_CSWAP(x, xi, 9, 11); RT_CSWAP(x, xi, 9, 10); RT_CSWAP(x, xi, 12, 13); RT_CSWAP(x, xi, 14, 15); RT_CSWAP(x, xi, 12, 14); RT_CSWAP(x, xi, 13, 15); RT_CSWAP(x, xi, 13, 14); RT_CSWAP(x, xi, 8, 12); RT_CSWAP(x, xi, 10, 14); RT_CSWAP(x, xi, 10, 12); RT_CSWAP(x, xi, 9, 13); RT_CSWAP(x, xi, 11, 15); RT_CSWAP(x, xi, 11, 13); RT_CSWAP(x, xi, 9, 10); RT_CSWAP(x, xi, 11, 12); RT_CSWAP(x, xi, 13, 14); RT_CSWAP(x, xi, 0, 8); RT_CSWAP(x, xi, 4, 12); RT_CSWAP(x, xi, 4, 8); RT_CSWAP(x, xi, 2, 10); RT_CSWAP(x, xi, 6, 14); RT_CSWAP(x, xi, 6, 10); RT_CSWAP(x, xi, 2, 4); RT_CSWAP(x, xi, 6, 8); RT_CSWAP(x, xi, 10, 12); RT_CSWAP(x, xi, 1, 9); RT_CSWAP(x, xi, 5, 13); RT_CSWAP(x, xi, 5, 9); RT_CSWAP(x, xi, 3, 11); RT_CSWAP(x, xi, 7, 15); RT_CSWAP(x, xi, 7, 11); RT_CSWAP(x, xi, 3, 5); RT_CSWAP(x, xi, 7, 9); RT_CSWAP(x, xi, 11, 13); RT_CSWAP(x, xi, 1, 2); RT_CSWAP(x, xi, 3, 4); RT_CSWAP(x, xi, 5, 6); RT_CSWAP(x, xi, 7, 8); RT_CSWAP(x, xi, 9, 10); RT_CSWAP(x, xi, 11, 12); RT_CSWAP(x, xi, 13, 14); } while (0)
#define RT_FOR_CANDS(F) F(0, 0) F(0, 1) F(0, 2) F(0, 3) F(0, 4) F(0, 5) F(0, 6) F(0, 7) F(0, 8) F(0, 9) F(0, 10) F(0, 11) F(0, 12) F(0, 13) F(0, 14) F(0, 15) F(1, 0) F(1, 1) F(1, 2) F(1, 3) F(1, 4) F(1, 5) F(1, 6) F(1, 7) F(2, 0) F(2, 1) F(2, 2) F(2, 3) F(2, 4) F(3, 0) F(3, 1) F(3, 2) F(3, 3) F(4, 0) F(4, 1) F(4, 2) F(5, 0) F(5, 1) F(6, 0) F(6, 1) F(7, 0) F(7, 1) F(8, 0) F(9, 0) F(10, 0) F(11, 0) F(12, 0) F(13, 0) F(14, 0) F(15, 0)
#define RT_SEARCH(COUNT_MACRO, NTOT) \
    for (int it_ = 0; it_ < 400 && __any(!done); ++it_) { \
        const float w_ = hi - lo; float t_ = ((float)(clo - 16) + 0.5f) * __builtin_amdgcn_rcpf((float)(clo - chi)); t_ = __builtin_fminf(__builtin_fmaxf(t_, 0.125f), 0.875f); \
        float x_ = lo + w_ * t_; if (!(x_ > lo && x_ < hi)) x_ = 0.5f * lo + 0.5f * hi; const bool stuck_ = !(x_ > lo && x_ < hi); \
        int c_; COUNT_MACRO(c_, x_); \
        if (!done) { if (stuck_) { Tv = lo; done = true; } else if (c_ == 16) { Tv = x_; done = true; } else if (c_ > 16) { lo = x_; clo = c_; } else { hi = x_; chi = c_; } } } \
    if (!done) Tv = lo;
#define RT_CNT128_GE(c, x) RT_COUNT128(RT_GE8, c, x)
#define RT_CNT50_GE(c, x) RT_COUNT50(RT_SGE5, c, x)
__device__ __forceinline__ void lane_top16_of_128(const float (&v)[128], LAS unsigned char* sb) {
    float mx = v[0], mn = v[0];
#pragma unroll
    for (int i = 1; i < 128; ++i) { mx = __builtin_fmaxf(mx, v[i]); mn = __builtin_fminf(mn, v[i]); }
    float lo = mn, hi = mx, Tv = mn; int clo = 128, chi; bool done;
    RT_CNT128_GE(chi, mx); done = (chi >= 16); if (done) Tv = mx;
    RT_SEARCH(RT_CNT128_GE, 128)
    int cgt; RT_COUNT128(RT_GT8, cgt, Tv);
    const int need = 16 - cgt; int cnt = 0, idx = 0;
#pragma unroll
    for (int i = 0; i < 128; ++i) {
        asm volatile("" : "+v"(Tv), "+v"(cnt), "+v"(idx));
        LAS unsigned char* q = sb + cnt * 512; *(LAS float*)q = v[i]; *(LAS int*)(q + 4) = idx;
        cnt += (v[i] > Tv) ? 1 : 0; idx += 1;
    }
    if (__any(need > 0)) {
        idx = 0;
#pragma unroll
        for (int i = 0; i < 128; ++i) { asm volatile("" : "+v"(Tv), "+v"(cnt), "+v"(idx));
            if (v[i] == Tv && cnt < 16) { LAS unsigned char* q = sb + cnt * 512; *(LAS float*)q = v[i]; *(LAS int*)(q + 4) = idx; cnt += 1; } idx += 1; }
    }
}
__device__ __forceinline__ int opaque_zero() { int z = 0; asm volatile("" : "+v"(z)); return z; }
__device__ __forceinline__ void route_task_search(const float* SCT, v2u* ROUTE, int tok0, int h, LAS unsigned char* scr, int lane) {
    const int tok = tok0 + lane;
    LAS unsigned char* sb = scr + lane * 8;
#pragma unroll 1
    for (int p = 0; p < 2; ++p) {
        const int g = 2 * h + p; float v[128];
        const unsigned voff = (unsigned)tok * 16u;
#pragma unroll
        for (int k = 0; k < 32; ++k) { const char* bk = (const char*)SCT + ((size_t)(g * 32 + k) * M) * 16; const f32x4 q = *(const GAS f32x4*)(bk + voff); v[4 * k] = q.x; v[4 * k + 1] = q.y; v[4 * k + 2] = q.z; v[4 * k + 3] = q.w; }
        lane_top16_of_128(v, sb + p * 8704);
    }
    LDS_WAIT();
    float a[16], b[16]; int ai[16], bi[16];
#pragma unroll
    for (int i = 0; i < 16; ++i) { const v2u ea = *(LAS v2u*)(sb + i * 512), eb = *(LAS v2u*)(sb + 8704 + i * 512);
        a[i] = __builtin_bit_cast(float, ea.x); ai[i] = (int)ea.y; b[i] = __builtin_bit_cast(float, eb.x); bi[i] = (int)eb.y; }
    LDS_WAIT();
    RT_SORT16(a, ai); RT_SORT16(b, bi);
    float lo = a[15] + b[15], hi = a[0] + b[0], Tv = lo; int clo = 50, chi; bool done;
    RT_CNT50_GE(chi, hi); done = (chi >= 16); if (done) Tv = hi;
    RT_SEARCH(RT_CNT50_GE, 50)
    int cgt; RT_COUNT50(RT_SGT5, cgt, Tv);
    const int need = 16 - cgt; int cnt = 0;
#define RT_EXT(i, j) { asm volatile("" : "+v"(Tv), "+v"(cnt)); const float s_ = a[i] + b[j]; LAS unsigned char* q_ = sb + cnt * 512; *(LAS float*)q_ = s_; *(LAS int*)(q_ + 4) = ai[i] * 128 + bi[j]; cnt += (s_ > Tv) ? 1 : 0; }
    RT_FOR_CANDS(RT_EXT)
#undef RT_EXT
    if (__any(need > 0)) {
#define RT_EXT2(i, j) { asm volatile("" : "+v"(Tv), "+v"(cnt)); const float s_ = a[i] + b[j]; if (s_ == Tv && cnt < 16) { LAS unsigned char* q_ = sb + cnt * 512; *(LAS float*)q_ = s_; *(LAS int*)(q_ + 4) = ai[i] * 128 + bi[j]; cnt += 1; } }
        RT_FOR_CANDS(RT_EXT2)
#undef RT_EXT2
    }
    LDS_WAIT();
    GAS v4u* rp = (GAS v4u*)((GAS v2u*)ROUTE + (size_t)tok * 128 + h * 16);
#pragma unroll
    for (int i = 0; i < 8; ++i) { const v2u e0 = *(LAS v2u*)(sb + (2 * i) * 512), e1 = *(LAS v2u*)(sb + (2 * i + 1) * 512); v4u o; o.x = e0.y; o.y = e0.x; o.z = e1.y; o.w = e1.x; rp[i] = o; }
    LDS_WAIT();
}

#define RT2_CE(a, b) { const int t0_ = (a), t1_ = (b); (a) = t0_ > t1_ ? t0_ : t1_; (b) = t0_ > t1_ ? t1_ : t0_; }
#define RT2_MX(a, b) ((a) > (b) ? (a) : (b))
#define RT2_SORT16(k, B) do { RT2_CE(k[(B) + 0], k[(B) + 13]); RT2_CE(k[(B) + 1], k[(B) + 12]); RT2_CE(k[(B) + 2], k[(B) + 15]); RT2_CE(k[(B) + 3], k[(B) + 14]); RT2_CE(k[(B) + 4], k[(B) + 8]); RT2_CE(k[(B) + 5], k[(B) + 6]); RT2_CE(k[(B) + 7], k[(B) + 11]); RT2_CE(k[(B) + 9], k[(B) + 10]); RT2_CE(k[(B) + 0], k[(B) + 5]); RT2_CE(k[(B) + 1], k[(B) + 7]); RT2_CE(k[(B) + 2], k[(B) + 9]); RT2_CE(k[(B) + 3], k[(B) + 4]); RT2_CE(k[(B) + 6], k[(B) + 13]); RT2_CE(k[(B) + 8], k[(B) + 14]); RT2_CE(k[(B) + 10], k[(B) + 15]); RT2_CE(k[(B) + 11], k[(B) + 12]); RT2_CE(k[(B) + 0], k[(B) + 1]); RT2_CE(k[(B) + 2], k[(B) + 3]); RT2_CE(k[(B) + 4], k[(B) + 5]); RT2_CE(k[(B) + 6], k[(B) + 8]); RT2_CE(k[(B) + 7], k[(B) + 9]); RT2_CE(k[(B) + 10], k[(B) + 11]); RT2_CE(k[(B) + 12], k[(B) + 13]); RT2_CE(k[(B) + 14], k[(B) + 15]); RT2_CE(k[(B) + 0], k[(B) + 2]); RT2_CE(k[(B) + 1], k[(B) + 3]); RT2_CE(k[(B) + 4], k[(B) + 10]); RT2_CE(k[(B) + 5], k[(B) + 11]); RT2_CE(k[(B) + 6], k[(B) + 7]); RT2_CE(k[(B) + 8], k[(B) + 9]); RT2_CE(k[(B) + 12], k[(B) + 14]); RT2_CE(k[(B) + 13], k[(B) + 15]); RT2_CE(k[(B) + 1], k[(B) + 2]); RT2_CE(k[(B) + 3], k[(B) + 12]); RT2_CE(k[(B) + 4], k[(B) + 6]); RT2_CE(k[(B) + 5], k[(B) + 7]); RT2_CE(k[(B) + 8], k[(B) + 10]); RT2_CE(k[(B) + 9], k[(B) + 11]); RT2_CE(k[(B) + 13], k[(B) + 14]); RT2_CE(k[(B) + 1], k[(B) + 4]); RT2_CE(k[(B) + 2], k[(B) + 6]); RT2_CE(k[(B) + 5], k[(B) + 8]); RT2_CE(k[(B) + 7], k[(B) + 10]); RT2_CE(k[(B) + 9], k[(B) + 13]); RT2_CE(k[(B) + 11], k[(B) + 14]); RT2_CE(k[(B) + 2], k[(B) + 4]); RT2_CE(k[(B) + 3], k[(B) + 6]); RT2_CE(k[(B) + 9], k[(B) + 12]); RT2_CE(k[(B) + 11], k[(B) + 13]); RT2_CE(k[(B) + 3], k[(B) + 5]); RT2_CE(k[(B) + 6], k[(B) + 8]); RT2_CE(k[(B) + 7], k[(B) + 9]); RT2_CE(k[(B) + 10], k[(B) + 12]); RT2_CE(k[(B) + 3], k[(B) + 4]); RT2_CE(k[(B) + 5], k[(B) + 6]); RT2_CE(k[(B) + 7], k[(B) + 8]); RT2_CE(k[(B) + 9], k[(B) + 10]); RT2_CE(k[(B) + 11], k[(B) + 12]); RT2_CE(k[(B) + 6], k[(B) + 7]); RT2_CE(k[(B) + 8], k[(B) + 9]); } while (0)
#define RT2_BIT16(k, B) do { RT2_CE(k[(B) + 0], k[(B) + 8]); RT2_CE(k[(B) + 1], k[(B) + 9]); RT2_CE(k[(B) + 2], k[(B) + 10]); RT2_CE(k[(B) + 3], k[(B) + 11]); RT2_CE(k[(B) + 4], k[(B) + 12]); RT2_CE(k[(B) + 5], k[(B) + 13]); RT2_CE(k[(B) + 6], k[(B) + 14]); RT2_CE(k[(B) + 7], k[(B) + 15]); RT2_CE(k[(B) + 0], k[(B) + 4]); RT2_CE(k[(B) + 1], k[(B) + 5]); RT2_CE(k[(B) + 2], k[(B) + 6]); RT2_CE(k[(B) + 3], k[(B) + 7]); RT2_CE(k[(B) + 8], k[(B) + 12]); RT2_CE(k[(B) + 9], k[(B) + 13]); RT2_CE(k[(B) + 10], k[(B) + 14]); RT2_CE(k[(B) + 11], k[(B) + 15]); RT2_CE(k[(B) + 0], k[(B) + 2]); RT2_CE(k[(B) + 1], k[(B) + 3]); RT2_CE(k[(B) + 4], k[(B) + 6]); RT2_CE(k[(B) + 5], k[(B) + 7]); RT2_CE(k[(B) + 8], k[(B) + 10]); RT2_CE(k[(B) + 9], k[(B) + 11]); RT2_CE(k[(B) + 12], k[(B) + 14]); RT2_CE(k[(B) + 13], k[(B) + 15]); RT2_CE(k[(B) + 0], k[(B) + 1]); RT2_CE(k[(B) + 2], k[(B) + 3]); RT2_CE(k[(B) + 4], k[(B) + 5]); RT2_CE(k[(B) + 6], k[(B) + 7]); RT2_CE(k[(B) + 8], k[(B) + 9]); RT2_CE(k[(B) + 10], k[(B) + 11]); RT2_CE(k[(B) + 12], k[(B) + 13]); RT2_CE(k[(B) + 14], k[(B) + 15]); } while (0)
#define RT2_HCLEAN(k, A, B) do { k[(A) + 0] = RT2_MX(k[(A) + 0], k[(B) + 15]); k[(A) + 1] = RT2_MX(k[(A) + 1], k[(B) + 14]); k[(A) + 2] = RT2_MX(k[(A) + 2], k[(B) + 13]); k[(A) + 3] = RT2_MX(k[(A) + 3], k[(B) + 12]); k[(A) + 4] = RT2_MX(k[(A) + 4], k[(B) + 11]); k[(A) + 5] = RT2_MX(k[(A) + 5], k[(B) + 10]); k[(A) + 6] = RT2_MX(k[(A) + 6], k[(B) + 9]); k[(A) + 7] = RT2_MX(k[(A) + 7], k[(B) + 8]); k[(A) + 8] = RT2_MX(k[(A) + 8], k[(B) + 7]); k[(A) + 9] = RT2_MX(k[(A) + 9], k[(B) + 6]); k[(A) + 10] = RT2_MX(k[(A) + 10], k[(B) + 5]); k[(A) + 11] = RT2_MX(k[(A) + 11], k[(B) + 4]); k[(A) + 12] = RT2_MX(k[(A) + 12], k[(B) + 3]); k[(A) + 13] = RT2_MX(k[(A) + 13], k[(B) + 2]); k[(A) + 14] = RT2_MX(k[(A) + 14], k[(B) + 1]); k[(A) + 15] = RT2_MX(k[(A) + 15], k[(B) + 0]); } while (0)
#define RT2_TOP16_OF_128(k) do { RT2_SORT16(k, 0); RT2_SORT16(k, 16); RT2_SORT16(k, 32); RT2_SORT16(k, 48); RT2_SORT16(k, 64); RT2_SORT16(k, 80); RT2_SORT16(k, 96); RT2_SORT16(k, 112); RT2_HCLEAN(k, 0, 16); RT2_BIT16(k, 0); RT2_HCLEAN(k, 32, 48); RT2_BIT16(k, 32); RT2_HCLEAN(k, 64, 80); RT2_BIT16(k, 64); RT2_HCLEAN(k, 96, 112); RT2_BIT16(k, 96); RT2_HCLEAN(k, 0, 32); RT2_BIT16(k, 0); RT2_HCLEAN(k, 64, 96); RT2_BIT16(k, 64); RT2_HCLEAN(k, 0, 64); RT2_BIT16(k, 0); } while (0)
#define RT2_BUILD_CANDS(c) do { c[0] = RT2_CK(0, 0); c[1] = RT2_CK(0, 1); c[2] = RT2_CK(0, 2); c[3] = RT2_CK(0, 3); c[4] = RT2_CK(0, 4); c[5] = RT2_CK(0, 5); c[6] = RT2_CK(0, 6); c[7] = RT2_CK(0, 7); c[8] = RT2_CK(0, 8); c[9] = RT2_CK(0, 9); c[10] = RT2_CK(0, 10); c[11] = RT2_CK(0, 11); c[12] = RT2_CK(0, 12); c[13] = RT2_CK(0, 13); c[14] = RT2_CK(0, 14); c[15] = RT2_CK(0, 15); c[16] = RT2_CK(1, 0); c[17] = RT2_CK(1, 1); c[18] = RT2_CK(1, 2); c[19] = RT2_CK(1, 3); c[20] = RT2_CK(1, 4); c[21] = RT2_CK(1, 5); c[22] = RT2_CK(1, 6); c[23] = RT2_CK(1, 7); c[24] = RT2_CK(15, 0); c[25] = RT2_CK(14, 0); c[26] = RT2_CK(13, 0); c[27] = RT2_CK(12, 0); c[28] = RT2_CK(11, 0); c[29] = RT2_CK(10, 0); c[30] = RT2_CK(9, 0); c[31] = RT2_CK(8, 0); c[32] = RT2_CK(2, 0); c[33] = RT2_CK(2, 1); c[34] = RT2_CK(2, 2); c[35] = RT2_CK(2, 3); c[36] = RT2_CK(2, 4); c[37] = RT2_CK(3, 0); c[38] = RT2_CK(3, 1); c[39] = RT2_CK(3, 2); c[40] = RT2_CK(3, 3); c[41] = RT2_CK(4, 0); c[42] = RT2_CK(4, 1); c[43] = RT2_CK(4, 2); c[44] = RT2_CK(5, 0); c[45] = RT2_CK(5, 1); c[46] = RT2_CK(6, 0); c[47] = RT2_CK(6, 1); } while (0)
__device__ __forceinline__ int rt2_tr(int u) { return u ^ (int)((unsigned)(u >> 31) >> 1); }
__device__ __forceinline__ int rt2_key(float x, int code, int mask) { return (rt2_tr(__builtin_bit_cast(int, x)) & ~mask) | code; }
__device__ __forceinline__ int rt2_key16(unsigned hbits_hi, int code) { return (rt2_tr((int)hbits_hi) & (int)0xffff0000) | code; }
__device__ __forceinline__ float rt2_val16(int k) { const unsigned u = (unsigned)rt2_tr(k) >> 16; return (float)__builtin_bit_cast(_Float16, (unsigned short)u); }
__device__ __forceinline__ void route_task(const unsigned short* SCT, v2u* ROUTE, int tok0, int h, LAS unsigned char* scr, int lane) {
    const int tok = tok0 + lane;
    LAS unsigned char* sb = scr + lane * 4;
#pragma unroll 1
    for (int p = 0; p < 2; ++p) {
        const int g = 2 * h + p; int k[128];
        const unsigned voff = (unsigned)tok * 16u;
#pragma unroll
        for (int q8 = 0; q8 < 16; ++q8) { const char* bq = (const char*)SCT + ((size_t)(g * 16 + q8) * M) * 16; const v4u q = *(const GAS v4u*)(bq + voff);
            k[8 * q8 + 0] = rt2_key16(q.x << 16, 127 - 8 * q8); k[8 * q8 + 1] = rt2_key16(q.x, 126 - 8 * q8); k[8 * q8 + 2] = rt2_key16(q.y << 16, 125 - 8 * q8); k[8 * q8 + 3] = rt2_key16(q.y, 124 - 8 * q8);
            k[8 * q8 + 4] = rt2_key16(q.z << 16, 123 - 8 * q8); k[8 * q8 + 5] = rt2_key16(q.z, 122 - 8 * q8); k[8 * q8 + 6] = rt2_key16(q.w << 16, 121 - 8 * q8); k[8 * q8 + 7] = rt2_key16(q.w, 120 - 8 * q8); }
        RT2_TOP16_OF_128(k);
#pragma unroll
        for (int i = 0; i < 16; ++i) *(LAS int*)(sb + (p * 16 + i) * 256) = k[i];
    }
    LDS_WAIT();
    float af[16], bf[16];
#pragma unroll
    for (int i = 0; i < 16; ++i) { af[i] = rt2_val16(*(const LAS int*)(sb + i * 256)); bf[i] = rt2_val16(*(const LAS int*)(sb + (16 + i) * 256)); }
    int c[48];
#define RT2_CK(i, j) rt2_key(af[i] + bf[j], 255 - (16 * (i) + (j)), 255)
    RT2_BUILD_CANDS(c);
    const int r7a = RT2_CK(7, 0), r7b = RT2_CK(7, 1);
#undef RT2_CK
    RT2_BIT16(c, 16);
    RT2_SORT16(c, 32);
    RT2_HCLEAN(c, 0, 16); RT2_BIT16(c, 0);
    c[46] = RT2_MX(c[46], r7b); c[47] = RT2_MX(c[47], r7a); RT2_BIT16(c, 32);
    RT2_HCLEAN(c, 0, 32);
    GAS v4u* rp = (GAS v4u*)((GAS v2u*)ROUTE + (size_t)tok * 128 + h * 16);
#pragma unroll
    for (int i = 0; i < 8; ++i) { v4u o;
        { const int ij = (~c[2 * i]) & 255; const int ka = *(const LAS int*)(sb + ((ij >> 4) << 8)), kb = *(const LAS int*)(sb + 4096 + ((ij & 15) << 8));
          o.x = (unsigned)(((~ka) & 127) * 128 + ((~kb) & 127)); o.y = __builtin_bit_cast(unsigned, rt2_val16(ka) + rt2_val16(kb)); }
        { const int ij = (~c[2 * i + 1]) & 255; const int ka = *(const LAS int*)(sb + ((ij >> 4) << 8)), kb = *(const LAS int*)(sb + 4096 + ((ij & 15) << 8));
          o.z = (unsigned)(((~ka) & 127) * 128 + ((~kb) & 127)); o.w = __builtin_bit_cast(unsigned, rt2_val16(ka) + rt2_val16(kb)); }
        rp[i] = o; }
    LDS_WAIT();
}

#define DPPF(v, ctrl) __builtin_bit_cast(float, __builtin_amdgcn_update_dpp(0, __builtin_bit_cast(int, (v)), (ctrl), 0xf, 0xf, true))
__device__ __forceinline__ float wave_max_f(float m) {
#pragma unroll
    for (int o = 1; o < 64; o <<= 1) m = __builtin_fmaxf(m, __shfl_xor(m, o));
    return m;
}
template <int NV> __device__ __forceinline__ void select16(const float (&v)[NV], bool (&sel)[NV], int (&pos)[NV]) {
    float mx = v[0], mn = v[0];
#pragma unroll
    for (int i = 1; i < NV; ++i) { mx = __builtin_fmaxf(mx, v[i]); mn = __builtin_fminf(mn, v[i]); }
    mx = wave_max_f(mx); mn = -wave_max_f(-mn);
    float lo = mn, hi = mx, Tv;
    { int c = 0;
#pragma unroll
      for (int i = 0; i < NV; ++i) c += __popcll(__ballot(v[i] >= mx));
      if (c >= 16) { Tv = mx; }
      else {
        Tv = lo;
        for (int it = 0; it < 300; ++it) {
            const float mid = 0.5f * lo + 0.5f * hi;
            if (!(mid > lo && mid < hi)) { Tv = lo; break; }
            int cc = 0;
#pragma unroll
            for (int i = 0; i < NV; ++i) cc += __popcll(__ballot(v[i] >= mid));
            if (cc == 16) { Tv = mid; break; }
            if (cc > 16) lo = mid; else hi = mid;
            Tv = lo;
        }
      }
    }
    int cgt = 0;
#pragma unroll
    for (int i = 0; i < NV; ++i) cgt += __popcll(__ballot(v[i] > Tv));
    const int need = 16 - cgt;
    int eqbelow = 0;
#pragma unroll
    for (int i = 0; i < NV; ++i) { const unsigned long long m = __ballot(v[i] == Tv); eqbelow += __builtin_amdgcn_mbcnt_hi((unsigned)(m >> 32), __builtin_amdgcn_mbcnt_lo((unsigned)m, 0u)); }
    int eqown = 0;
#pragma unroll
    for (int i = 0; i < NV; ++i) { const bool eq = (v[i] == Tv); sel[i] = (v[i] > Tv) || (eq && (eqbelow + eqown) < need); eqown += eq ? 1 : 0; }
    int selbelow = 0;
#pragma unroll
    for (int i = 0; i < NV; ++i) { const unsigned long long m = __ballot(sel[i]); selbelow += __builtin_amdgcn_mbcnt_hi((unsigned)(m >> 32), __builtin_amdgcn_mbcnt_lo((unsigned)m, 0u)); }
    int own = 0;
#pragma unroll
    for (int i = 0; i < NV; ++i) { pos[i] = selbelow + own; own += sel[i] ? 1 : 0; }
}

__device__ __forceinline__ float gelu_exact(float a) { return 0.5f * a * (1.0f + erff(a * 0.7071067811865476f)); }

__device__ __forceinline__ void fp8_row_dot(const v4u q, const float (&xr)[16], float& s) {
    const f32x2 a0 = __builtin_amdgcn_cvt_pk_f32_fp8((int)q.x, false), a1 = __builtin_amdgcn_cvt_pk_f32_fp8((int)q.x, true), a2 = __builtin_amdgcn_cvt_pk_f32_fp8((int)q.y, false), a3 = __builtin_amdgcn_cvt_pk_f32_fp8((int)q.y, true);
    const f32x2 b0 = __builtin_amdgcn_cvt_pk_f32_fp8((int)q.z, false), b1 = __builtin_amdgcn_cvt_pk_f32_fp8((int)q.z, true), b2 = __builtin_amdgcn_cvt_pk_f32_fp8((int)q.w, false), b3 = __builtin_amdgcn_cvt_pk_f32_fp8((int)q.w, true);
    f32x2 t = a0 * (f32x2){xr[0], xr[1]};
    t = __builtin_elementwise_fma(a1, (f32x2){xr[2], xr[3]}, t); t = __builtin_elementwise_fma(a2, (f32x2){xr[4], xr[5]}, t); t = __builtin_elementwise_fma(a3, (f32x2){xr[6], xr[7]}, t);
    t = __builtin_elementwise_fma(b0, (f32x2){xr[8], xr[9]}, t); t = __builtin_elementwise_fma(b1, (f32x2){xr[10], xr[11]}, t); t = __builtin_elementwise_fma(b2, (f32x2){xr[12], xr[13]}, t); t = __builtin_elementwise_fma(b3, (f32x2){xr[14], xr[15]}, t);
    s = t.x + t.y;
}
__device__ __forceinline__ void fp8_row_axpy2(const v4u q, const float w, f32x2 (&acc)[8]) {
    const f32x2 a0 = __builtin_amdgcn_cvt_pk_f32_fp8((int)q.x, false), a1 = __builtin_amdgcn_cvt_pk_f32_fp8((int)q.x, true), a2 = __builtin_amdgcn_cvt_pk_f32_fp8((int)q.y, false), a3 = __builtin_amdgcn_cvt_pk_f32_fp8((int)q.y, true);
    const f32x2 b0 = __builtin_amdgcn_cvt_pk_f32_fp8((int)q.z, false), b1 = __builtin_amdgcn_cvt_pk_f32_fp8((int)q.z, true), b2 = __builtin_amdgcn_cvt_pk_f32_fp8((int)q.w, false), b3 = __builtin_amdgcn_cvt_pk_f32_fp8((int)q.w, true);
    const f32x2 ww = {w, w};
    acc[0] = __builtin_elementwise_fma(a0, ww, acc[0]); acc[1] = __builtin_elementwise_fma(a1, ww, acc[1]); acc[2] = __builtin_elementwise_fma(a2, ww, acc[2]); acc[3] = __builtin_elementwise_fma(a3, ww, acc[3]);
    acc[4] = __builtin_elementwise_fma(b0, ww, acc[4]); acc[5] = __builtin_elementwise_fma(b1, ww, acc[5]); acc[6] = __builtin_elementwise_fma(b2, ww, acc[6]); acc[7] = __builtin_elementwise_fma(b3, ww, acc[7]);
}
__device__ __forceinline__ void fp8_row_axpy(const v4u q, const float w, float (&acc)[16]) {
    const f32x2 a0 = __builtin_amdgcn_cvt_pk_f32_fp8((int)q.x, false), a1 = __builtin_amdgcn_cvt_pk_f32_fp8((int)q.x, true), a2 = __builtin_amdgcn_cvt_pk_f32_fp8((int)q.y, false), a3 = __builtin_amdgcn_cvt_pk_f32_fp8((int)q.y, true);
    const f32x2 b0 = __builtin_amdgcn_cvt_pk_f32_fp8((int)q.z, false), b1 = __builtin_amdgcn_cvt_pk_f32_fp8((int)q.z, true), b2 = __builtin_amdgcn_cvt_pk_f32_fp8((int)q.w, false), b3 = __builtin_amdgcn_cvt_pk_f32_fp8((int)q.w, true);
    acc[0] += w * a0.x; acc[1] += w * a0.y; acc[2] += w * a1.x; acc[3] += w * a1.y; acc[4] += w * a2.x; acc[5] += w * a2.y; acc[6] += w * a3.x; acc[7] += w * a3.y;
    acc[8] += w * b0.x; acc[9] += w * b0.y; acc[10] += w * b1.x; acc[11] += w * b1.y; acc[12] += w * b2.x; acc[13] += w * b2.y; acc[14] += w * b3.x; acc[15] += w * b3.y;
}
__device__ __forceinline__ void fp8_convert_row(const float* src, const float* gain, unsigned char* dst, float* inv_scale, int lane, int sliced, int e) {
    const GAS f32x4* sp = (const GAS f32x4*)src; float v[16];
#pragma unroll
    for (int j = 0; j < 2; ++j) { f32x4 a = sp[2 * lane + 128 * j], b = sp[2 * lane + 128 * j + 1];
        if (gain) { const GAS f32x4* gp = (const GAS f32x4*)gain; const f32x4 ga = gp[2 * lane + 128 * j], gb = gp[2 * lane + 128 * j + 1]; a = a * ga; b = b * gb; }
        v[8 * j + 0] = a.x; v[8 * j + 1] = a.y; v[8 * j + 2] = a.z; v[8 * j + 3] = a.w; v[8 * j + 4] = b.x; v[8 * j + 5] = b.y; v[8 * j + 6] = b.z; v[8 * j + 7] = b.w; }
    float am = 0.f;
#pragma unroll
    for (int i = 0; i < 16; ++i) am = __builtin_fmaxf(am, __builtin_fabsf(v[i]));
    am = wave_max_f(am);
    const float sc = (am > 0.f) ? 384.0f / am : 1.0f, inv = (am > 0.f) ? am * (1.0f / 384.0f) : 1.0f;
    v4u q;
    { int w = __builtin_amdgcn_cvt_pk_fp8_f32(v[0] * sc, v[1] * sc, 0, false); w = __builtin_amdgcn_cvt_pk_fp8_f32(v[2] * sc, v[3] * sc, w, true); q.x = (unsigned)w; }
    { int w = __builtin_amdgcn_cvt_pk_fp8_f32(v[4] * sc, v[5] * sc, 0, false); w = __builtin_amdgcn_cvt_pk_fp8_f32(v[6] * sc, v[7] * sc, w, true); q.y = (unsigned)w; }
    { int w = __builtin_amdgcn_cvt_pk_fp8_f32(v[8] * sc, v[9] * sc, 0, false); w = __builtin_amdgcn_cvt_pk_fp8_f32(v[10] * sc, v[11] * sc, w, true); q.z = (unsigned)w; }
    { int w = __builtin_amdgcn_cvt_pk_fp8_f32(v[12] * sc, v[13] * sc, 0, false); w = __builtin_amdgcn_cvt_pk_fp8_f32(v[14] * sc, v[15] * sc, w, true); q.w = (unsigned)w; }
    if (!sliced) ((GAS v4u*)dst)[lane] = q;
    else { v2u q0, q1; q0.x = q.x; q0.y = q.y; q1.x = q.z; q1.y = q.w; const int s0 = lane >> 4, o8 = 8 * (lane & 15);
        *(GAS v2u*)(dst + ((size_t)s0 * NEXP + e) * 128 + o8) = q0; *(GAS v2u*)(dst + ((size_t)(s0 + 4) * NEXP + e) * 128 + o8) = q1; }
    if (lane == 0) *inv_scale = inv;
}

#define PIN_ACC2(b) asm volatile("" : "+v"(b), "+v"(acc2[0]), "+v"(acc2[1]), "+v"(acc2[2]), "+v"(acc2[3]), "+v"(acc2[4]), "+v"(acc2[5]), "+v"(acc2[6]), "+v"(acc2[7]))
#define PIN_ACC(b) asm volatile("" : "+v"(b), "+v"(acc[0]), "+v"(acc[1]), "+v"(acc[2]), "+v"(acc[3]), "+v"(acc[4]), "+v"(acc[5]), "+v"(acc[6]), "+v"(acc[7]), "+v"(acc[8]), "+v"(acc[9]), "+v"(acc[10]), "+v"(acc[11]), "+v"(acc[12]), "+v"(acc[13]), "+v"(acc[14]), "+v"(acc[15]))
#define PC_META_U(tk) do { const char* rb_ = (const char*)route + (size_t)(tk) * 1024; m_e0 = *(const GAS int*)(rb_ + l8); m_e1 = *(const GAS int*)(rb_ + 512 + l8); } while (0)
#define PC_ISSUE_U(buf, xs, par, tk) do { LAS int* lid_ = (LAS int*)(scr + (par) * 512); lid_[lane] = m_e0; lid_[lane + 64] = m_e1; LDS_WAIT(); \
        { const GAS f32x4* xq_ = (const GAS f32x4*)(x1 + (size_t)(tk) * D + 128 * s + 16 * c); const f32x4 x0_ = xq_[0], x1_ = xq_[1], x2_ = xq_[2], x3_ = xq_[3]; \
          xs[0] = x0_.x; xs[1] = x0_.y; xs[2] = x0_.z; xs[3] = x0_.w; xs[4] = x1_.x; xs[5] = x1_.y; xs[6] = x1_.z; xs[7] = x1_.w; xs[8] = x2_.x; xs[9] = x2_.y; xs[10] = x2_.z; xs[11] = x2_.w; xs[12] = x3_.x; xs[13] = x3_.y; xs[14] = x3_.z; xs[15] = x3_.w; } \
        _Pragma("unroll") for (int k = 0; k < 16; ++k) { const int e_ = lid_[8 * k + r]; buf[k] = *(const GAS v4u*)(tbs + (unsigned)(e_ * 128)); } } while (0)
#define PC_COMPUTE_U(buf, xs, tk) do { float p_[16]; \
        _Pragma("unroll") for (int k = 0; k < 16; ++k) { if (k) asm volatile("" : "+v"(buf[k]), "+v"(p_[k ? k - 1 : 0])); else asm volatile("" : "+v"(buf[k])); fp8_row_dot(buf[k], xs, p_[k]); } \
        float q8_[8], q4_[4], q2_[2]; \
        _Pragma("unroll") for (int k = 0; k < 8; ++k) { const float send = c2 ? p_[k] : p_[k + 8], keep = c2 ? p_[k + 8] : p_[k]; q8_[k] = keep + __shfl_xor(send, 4); } \
        _Pragma("unroll") for (int k = 0; k < 4; ++k) { const float send = c1 ? q8_[k] : q8_[k + 4], keep = c1 ? q8_[k + 4] : q8_[k]; q4_[k] = keep + __shfl_xor(send, 2); } \
        _Pragma("unroll") for (int k = 0; k < 2; ++k) { const float send = c0 ? q4_[k] : q4_[k + 2], keep = c0 ? q4_[k + 2] : q4_[k]; q2_[k] = keep + __shfl_xor(send, 1); } \
        GAS float* up_ = (GAS float*)(Upart + ((size_t)s * M + (tk)) * 128 + 64 * c2 + 32 * c1 + 16 * c0 + r); up_[0] = q2_[0]; up_[8] = q2_[1]; } while (0)
__device__ __forceinline__ void peer_u_phase(int s, int tok0, int tstride, int nitems, const v2u* route, const float* x1, const unsigned char* TU8s, float* Upart, LAS unsigned char* scr, int lane) {
    const int r = lane >> 3, c = lane & 7, c2 = (lane >> 2) & 1, c1 = (lane >> 1) & 1, c0 = lane & 1; const unsigned l8 = (unsigned)lane * 8u;
    const char* tbs = (const char*)TU8s + (size_t)s * NEXP * 128 + 16 * c;
    int m_e0, m_e1;
    v4u bufA[16], bufB[16]; float xsA[16], xsB[16];
    PC_META_U(tok0); PC_ISSUE_U(bufA, xsA, 0, tok0); if (nitems > 1) PC_META_U(tok0 + tstride);
#pragma unroll 1
    for (int i = 0; i < nitems; i += 2) {
        const int tk = tok0 + i * tstride;
        if (i + 1 < nitems) PC_ISSUE_U(bufB, xsB, 1, tk + tstride);
        if (i + 2 < nitems) PC_META_U(tk + 2 * tstride);
        PC_COMPUTE_U(bufA, xsA, tk);
        if (i + 1 < nitems) {
            if (i + 2 < nitems) PC_ISSUE_U(bufA, xsA, 0, tk + 2 * tstride);
            if (i + 3 < nitems) PC_META_U(tk + 3 * tstride);
            PC_COMPUTE_U(bufB, xsB, tk + tstride);
        }
    }
    LDS_WAIT();
}
#define PD_META_U(tk) do { const char* rb_ = (const char*)route + (size_t)(tk) * 1024; m_e0 = *(const GAS int*)(rb_ + l8); m_e1 = *(const GAS int*)(rb_ + 512 + l8); \
        { const unsigned xw_ = *(const GAS unsigned*)((const bf16*)x1 + (size_t)(tk) * D + 128 * s + 2 * lane); m_x.x = bflo(xw_); m_x.y = bfhi(xw_); } } while (0)
#define PD_ISSUE_U(buf, xq, xinv, par) do { LAS int* lid_ = (LAS int*)(scr + (par) * 1024); LAS unsigned short* lx_ = (LAS unsigned short*)(scr + (par) * 1024 + 512); lid_[lane] = m_e0; lid_[lane + 64] = m_e1; LDS_WAIT(); \
        _Pragma("unroll") for (int k = 0; k < 16; ++k) { const int e_ = lid_[8 * k + r]; buf[k] = *(const GAS v4u*)(tbs + (unsigned)(e_ * 128)); } \
        { float am_ = __builtin_fmaxf(__builtin_fabsf(m_x.x), __builtin_fabsf(m_x.y)); \
          _Pragma("unroll") for (int o_ = 1; o_ < 64; o_ <<= 1) am_ = __builtin_fmaxf(am_, __shfl_xor(am_, o_)); \
          const float sc_ = (am_ > 0.f) ? 127.0f / am_ : 0.f; xinv = am_ * (1.0f / 127.0f); \
          const int q0_ = (int)__builtin_rintf(m_x.x * sc_), q1_ = (int)__builtin_rintf(m_x.y * sc_); lx_[lane] = (unsigned short)(((unsigned)q0_ & 255u) | (((unsigned)q1_ & 255u) << 8)); } \
        LDS_WAIT(); xq = *(const LAS v4u*)((LAS unsigned char*)lx_ + 16 * c); } while (0)
#define PD_COMPUTE_U(buf, xq, xinv, tk) do { int p_[16]; \
        _Pragma("unroll") for (int k = 0; k < 16; ++k) { int a_ = __builtin_amdgcn_sdot4((int)buf[k].x, (int)xq.x, 0, false); a_ = __builtin_amdgcn_sdot4((int)buf[k].y, (int)xq.y, a_, false); \
            a_ = __builtin_amdgcn_sdot4((int)buf[k].z, (int)xq.z, a_, false); a_ = __builtin_amdgcn_sdot4((int)buf[k].w, (int)xq.w, a_, false); p_[k] = a_; } \
          \
        LAS int* red_ = (LAS int*)(scr + 2048); \
        _Pragma("unroll") for (int k = 0; k < 16; ++k) red_[64 * k + lane] = p_[k]; \
        LDS_WAIT(); \
        const v4u ra_ = *(const LAS v4u*)(red_ + 8 * lane + rsw), rb_ = *(const LAS v4u*)(red_ + 8 * lane + (4 - rsw)), rc_ = *(const LAS v4u*)(red_ + 512 + 8 * lane + rsw), rd_ = *(const LAS v4u*)(red_ + 512 + 8 * lane + (4 - rsw)); \
        const int s0_ = (int)(ra_.x + ra_.y + ra_.z + ra_.w + rb_.x + rb_.y + rb_.z + rb_.w), s1_ = (int)(rc_.x + rc_.y + rc_.z + rc_.w + rd_.x + rd_.y + rd_.z + rd_.w); \
        GAS bf16* up_ = (GAS bf16*)Upart + ((size_t)s * M + (tk)) * 128 + lane; const unsigned pk_ = cvtpk((float)s0_ * xinv, (float)s1_ * xinv); up_[0] = (bf16)(pk_ & 0xffffu); up_[64] = (bf16)(pk_ >> 16); } while (0)
__device__ __forceinline__ void peer_u_phase_dot4(int s, int tok0, int tstride, int nitems, const v2u* route, const float* x1, const unsigned char* TU8s, float* Upart, LAS unsigned char* scr, int lane) {
    const int r = lane >> 3, c = lane & 7, rsw = 4 * ((lane >> 3) & 1); const unsigned l8 = (unsigned)lane * 8u;
    const char* tbs = (const char*)TU8s + (size_t)s * NEXP * 128 + 16 * c;
    int m_e0, m_e1; f32x2 m_x;
    v4u bufA[16], bufB[16], xqA, xqB; float xiA, xiB;
    PD_META_U(tok0); PD_ISSUE_U(bufA, xqA, xiA, 0); if (nitems > 1) PD_META_U(tok0 + tstride);
#pragma unroll 1
    for (int it = 0; it < nitems; it += 2) {
        const int tk = tok0 + it * tstride;
        if (it + 1 < nitems) PD_ISSUE_U(bufB, xqB, xiB, 1);
        if (it + 2 < nitems) PD_META_U(tk + 2 * tstride);
        PD_COMPUTE_U(bufA, xqA, xiA, tk);
        if (it + 1 < nitems) {
            if (it + 2 < nitems) PD_ISSUE_U(bufA, xqA, xiA, 0);
            if (it + 3 < nitems) PD_META_U(tk + 3 * tstride);
            PD_COMPUTE_U(bufB, xqB, xiB, tk + tstride);
        }
    }
    LDS_WAIT();
}
__device__ __forceinline__ void peer_w_token(int tok, const v2u* route, const float* x1, const float* Upart, const float* SU, const float* SV, float* W, int lane) {
    const GAS f32x4* xp = (const GAS f32x4*)(x1 + (size_t)tok * D) + lane; float ssq = 0.f;
#pragma unroll
    for (int j = 0; j < 4; ++j) { const f32x4 q = xp[64 * j]; ssq += (q.x * q.x + q.y * q.y) + (q.z * q.z + q.w * q.w); }
    const float rstd2 = 1.0f / sqrtf(wave_sum(ssq) * (1.0f / D) + RMS_EPS);
    const char* rb_ = (const char*)route + (size_t)tok * 1024; const unsigned l8_ = (unsigned)lane * 8u;
    const v2u r_lo = *(const GAS v2u*)(rb_ + l8_), r_hi = *(const GAS v2u*)(rb_ + 512 + l8_);
    float g_lo, g_hi;
#pragma unroll
    for (int half = 0; half < 2; ++half) {
        const float sc_ = __builtin_bit_cast(float, half ? r_hi.y : r_lo.y) * rstd2; float m_ = sc_;
#pragma unroll
        for (int o = 1; o < 16; o <<= 1) m_ = __builtin_fmaxf(m_, __shfl_xor(m_, o));
        const float p_ = __builtin_amdgcn_exp2f((sc_ - m_) * 1.4426950408889634f); float sum_ = p_;
#pragma unroll
        for (int o = 1; o < 16; o <<= 1) sum_ += __shfl_xor(sum_, o);
        if (half) g_hi = p_ / sum_; else g_lo = p_ / sum_;
    }
    asm volatile("" : "+v"(g_lo), "+v"(g_hi));
#pragma unroll
    for (int half = 0; half < 2; ++half) {
        const int e = (int)(half ? r_hi.x : r_lo.x); const int n = lane + 64 * half;
        float dot = 0.f;
#pragma unroll
        for (int s8 = 0; s8 < 8; ++s8) dot += Upart[((size_t)s8 * M + tok) * 128 + n];
        const float act = gelu_exact(dot * SU[e] * rstd2);
        W[(size_t)tok * 128 + n] = (half ? g_hi : g_lo) * act * SV[e];
    }
}
__device__ __forceinline__ void peer_w_token2(int tokA, int tokB, const v2u* route, const bf16* x1b, const bf16* Upart, const float* SU, const float* SV, float* W, int lane) {
    v4u xv[2][2]; v2u r_lo[2], r_hi[2]; unsigned short ub[2][2][8];
#pragma unroll
    for (int t = 0; t < 2; ++t) { const int tok = t ? tokB : tokA;
        const GAS v4u* xp = (const GAS v4u*)(x1b + (size_t)tok * D) + lane; xv[t][0] = xp[0]; xv[t][1] = xp[64];
        const char* rb_ = (const char*)route + (size_t)tok * 1024; const unsigned l8_ = (unsigned)lane * 8u;
        r_lo[t] = *(const GAS v2u*)(rb_ + l8_); r_hi[t] = *(const GAS v2u*)(rb_ + 512 + l8_);
#pragma unroll
        for (int half = 0; half < 2; ++half)
#pragma unroll
            for (int s8 = 0; s8 < 8; ++s8) ub[t][half][s8] = *(const GAS bf16*)(Upart + ((size_t)s8 * M + tok) * 128 + lane + 64 * half); }
#pragma unroll
    for (int t = 0; t < 2; ++t) { const int tok = t ? tokB : tokA;
        float ssq = 0.f;
#pragma unroll
        for (int j = 0; j < 2; ++j) { const v4u q = xv[t][j];
            ssq += (bflo(q.x) * bflo(q.x) + bfhi(q.x) * bfhi(q.x)) + (bflo(q.y) * bflo(q.y) + bfhi(q.y) * bfhi(q.y)) + (bflo(q.z) * bflo(q.z) + bfhi(q.z) * bfhi(q.z)) + (bflo(q.w) * bflo(q.w) + bfhi(q.w) * bfhi(q.w)); }
        const float rstd2 = 1.0f / sqrtf(wave_sum(ssq) * (1.0f / D) + RMS_EPS);
        float g_lo, g_hi;
#pragma unroll
        for (int half = 0; half < 2; ++half) {
            const float sc_ = __builtin_bit_cast(float, half ? r_hi[t].y : r_lo[t].y) * rstd2; float m_ = sc_;
#pragma unroll
            for (int o = 1; o < 16; o <<= 1) m_ = __builtin_fmaxf(m_, __shfl_xor(m_, o));
            const float p_ = __builtin_amdgcn_exp2f((sc_ - m_) * 1.4426950408889634f); float sum_ = p_;
#pragma unroll
            for (int o = 1; o < 16; o <<= 1) sum_ += __shfl_xor(sum_, o);
            if (half) g_hi = p_ / sum_; else g_lo = p_ / sum_;
        }
        asm volatile("" : "+v"(g_lo), "+v"(g_hi));
#pragma unroll
        for (int half = 0; half < 2; ++half) {
            const int e = (int)(half ? r_hi[t].x : r_lo[t].x); const int n = lane + 64 * half;
            float dot = 0.f;
#pragma unroll
            for (int s8 = 0; s8 < 8; ++s8) dot += __builtin_bit_cast(float, (unsigned)ub[t][half][s8] << 16);
            const float act = gelu_exact(dot * SU[e] * rstd2);
            W[(size_t)tok * 128 + n] = (half ? g_hi : g_lo) * act * SV[e];
        }
    }
}
#define PC_META_V(tk) do { const char* rb_ = (const char*)route + (size_t)(tk) * 1024; m_e0 = *(const GAS int*)(rb_ + l8); m_e1 = *(const GAS int*)(rb_ + 512 + l8); \
        const GAS float* wp_ = (const GAS float*)(W + (size_t)(tk) * 128); m_w0 = wp_[lane]; m_w1 = wp_[lane + 64]; m_xv = *(const GAS unsigned*)(xres + (size_t)(tk) * D + col0); } while (0)
#define PC_ISSUE_V(buf, wk, xv, par) do { LAS int* lid_ = (LAS int*)(scr + (par) * 1024); LAS float* lw_ = (LAS float*)(scr + (par) * 1024 + 512); lid_[lane] = m_e0; lid_[lane + 64] = m_e1; lw_[lane] = m_w0; lw_[lane + 64] = m_w1; LDS_WAIT(); xv = m_xv; \
        _Pragma("unroll") for (int k = 0; k < 16; ++k) { const int e_ = lid_[8 * k + r]; wk[k] = lw_[8 * k + r]; buf[k] = *(const GAS v4u*)(tbs + (unsigned)(e_ * 128)); } } while (0)
#define PC_COMPUTE_V(buf, wk, xv, tk) do { f32x2 acc2[8]; _Pragma("unroll") for (int i_ = 0; i_ < 8; ++i_) acc2[i_] = (f32x2){0.f, 0.f}; \
        _Pragma("unroll") for (int k = 0; k < 16; ++k) { PIN_ACC2(buf[k]); fp8_row_axpy2(buf[k], wk[k], acc2); } \
          \
        LAS float* red_ = (LAS float*)(scr + 2048); LAS f32x4* wp_ = (LAS f32x4*)(red_ + 128 * r + 16 * c); \
        _Pragma("unroll") for (int j_ = 0; j_ < 4; ++j_) { f32x4 t_; t_.x = acc2[2 * j_].x; t_.y = acc2[2 * j_].y; t_.z = acc2[2 * j_ + 1].x; t_.w = acc2[2 * j_ + 1].y; wp_[j_] = t_; } \
        LDS_WAIT(); \
        f32x2 o_; o_.x = bflo(xv); o_.y = bfhi(xv); \
        _Pragma("unroll") for (int rr_ = 0; rr_ < 8; ++rr_) { const f32x2 t_ = *(const LAS f32x2*)(red_ + 128 * rr_ + 2 * lane); o_.x += t_.x; o_.y += t_.y; } \
        *(GAS f32x2*)(xio + (size_t)(tk) * D + col0) = o_; } while (0)
__device__ __forceinline__ void peer_v_phase(int s, int tok0, int tstride, int nitems, const v2u* route, const float* W, const unsigned char* TV8s, const bf16* xres, float* xio, float* SS, LAS unsigned char* scr, int lane) {
    const int r = lane >> 3, c = lane & 7; const unsigned l8 = (unsigned)lane * 8u;
    const int col0 = 128 * s + 2 * lane;
    const char* tbs = (const char*)TV8s + (size_t)s * NEXP * 128 + 16 * c;
    int m_e0, m_e1; float m_w0, m_w1; unsigned m_xv;
    v4u bufA[16], bufB[16]; float wA[16], wB[16]; unsigned xvA, xvB;
    PC_META_V(tok0); PC_ISSUE_V(bufA, wA, xvA, 0); if (nitems > 1) PC_META_V(tok0 + tstride);
#pragma unroll 1
    for (int i = 0; i < nitems; i += 2) {
        const int tk = tok0 + i * tstride;
        if (i + 1 < nitems) PC_ISSUE_V(bufB, wB, xvB, 1);
        if (i + 2 < nitems) PC_META_V(tk + 2 * tstride);
        PC_COMPUTE_V(bufA, wA, xvA, tk);
        if (i + 1 < nitems) {
            if (i + 2 < nitems) PC_ISSUE_V(bufA, wA, xvA, 0);
            if (i + 3 < nitems) PC_META_V(tk + 3 * tstride);
            PC_COMPUTE_V(bufB, wB, xvB, tk + tstride);
        }
    }
    LDS_WAIT();
}


__device__ __forceinline__ void peer_u_debug(int tok, const v2u* route, const float* x1, const unsigned char* TU8s, const float* SU, const float* SV, float* W, int lane) {
    float xr[16], ssq = 0.f;
    { const GAS f32x4* xp = (const GAS f32x4*)(x1 + (size_t)tok * D + 16 * lane);
#pragma unroll
      for (int j = 0; j < 4; ++j) { const f32x4 a = xp[j]; xr[4 * j] = a.x; xr[4 * j + 1] = a.y; xr[4 * j + 2] = a.z; xr[4 * j + 3] = a.w; } }
#pragma unroll
    for (int i = 0; i < 16; ++i) ssq += xr[i] * xr[i];
    const float rstd2 = 1.0f / sqrtf(wave_sum(ssq) * (1.0f / D) + RMS_EPS);
    const char* rb_ = (const char*)route + (size_t)tok * 1024; const int s = lane >> 3, c = lane & 7;
#pragma unroll 1
    for (int h = 0; h < 8; ++h) {
        float sc[16]; int id[16]; float m = -3e38f;
#pragma unroll
        for (int i = 0; i < 16; ++i) { const v2u r = *(const GAS v2u*)(rb_ + (h * 16 + i) * 8 + opaque_zero()); id[i] = (int)r.x; sc[i] = __builtin_bit_cast(float, r.y) * rstd2; m = __builtin_fmaxf(m, sc[i]); }
        float sum = 0.f;
#pragma unroll
        for (int i = 0; i < 16; ++i) { sc[i] = __builtin_amdgcn_exp2f((sc[i] - m) * 1.4426950408889634f); sum += sc[i]; }
#pragma unroll
        for (int i = 0; i < 16; ++i) { const int e = id[i];
            const v4u q = *(const GAS v4u*)(TU8s + ((size_t)s * NEXP + e) * 128 + 16 * c);
            float d; fp8_row_dot(q, xr, d); d = wave_sum(d);
            const float act = gelu_exact(d * SU[e] * rstd2);
            if (lane == 0) W[(size_t)tok * 128 + h * 16 + i] = (sc[i] / sum) * act * SV[e]; }
    }
}
__device__ __forceinline__ void peer_v_debug(int tok, const v2u* route, const float* W, const unsigned char* TV8s, float* xio, float* SS, int lane) {
    const char* rb_ = (const char*)route + (size_t)tok * 1024;
    float acc[16];
#pragma unroll
    for (int i = 0; i < 16; ++i) acc[i] = 0.f;
    const int s = lane >> 3, c = lane & 7;
#pragma unroll 1
    for (int n = 0; n < 128; ++n) {
        const int e = *(const GAS int*)(rb_ + n * 8 + opaque_zero()); const float w = W[(size_t)tok * 128 + n + opaque_zero()];
        const v4u q = *(const GAS v4u*)(TV8s + ((size_t)s * NEXP + e) * 128 + 16 * c);
        fp8_row_axpy(q, w, acc);
    }
    float ssq = 0.f;
    GAS float* xp = (GAS float*)(xio + (size_t)tok * D + 16 * lane);
#pragma unroll
    for (int i = 0; i < 16; ++i) { const float o = xp[i] + acc[i]; xp[i] = o; ssq += o * o; }
    ssq = wave_sum(ssq);
    if (lane < 8) SS[(size_t)lane * M + tok] = (lane == 0) ? ssq : 0.f;
}
#ifndef DUP_MASK
#define DUP_MASK 0
#endif
#define NREP(k) (1 + ((DUP_MASK >> (k)) & 1))
struct Args { const float* in[14]; float* out; unsigned char* ws; int ph_lo, ph_hi, li, pad; };
__global__ void __launch_bounds__(NWAVES * 64, 2) hybrid_fwd(Args args) {
    extern __shared__ __attribute__((aligned(16))) unsigned char lds[];
    LAS unsigned char* ldsb = (LAS unsigned char*)lds;
    volatile LAS unsigned* MISC = (volatile LAS unsigned*)(ldsb + MISC_OFF);
    const int tid = threadIdx.x, lane = tid & 63, wave = __builtin_amdgcn_readfirstlane(tid >> 6);
    const int G = gridDim.x; const int bx = blockIdx.x; const int vcu = (G % 8 == 0) ? (bx % 8) * (G / 8) + bx / 8 : bx;
    const int gw = vcu * NWAVES + wave, NGW = G * NWAVES;
    unsigned char* ws = args.ws;
    gu32* ctl = (gu32*)(ws + WS_CTL);
    const float* x = args.in[0]; float* out = args.out;
#define norm_mix (args.in[1])
#define w_in (args.in[2])
#define conv_w (args.in[3])
#define conv_b (args.in[4])
#define w_a (args.in[5])
#define w_b (args.in[6])
#define w_o (args.in[7])
#define norm_ffn (args.in[8])
#define w_q (args.in[9])
#define sub_keys (args.in[10])
#define exp_u (args.in[11])
#define exp_v (args.in[12])
#define final_norm (args.in[13])
#define Weff ((bf16*)((bf16*)(ws + WS_WEFF)))
#define Wab ((bf16*)((bf16*)(ws + WS_WAB)))
#define Wo_t ((bf16*)((bf16*)(ws + WS_WO)))
#define Win_t ((bf16*)((bf16*)(ws + WS_WIN)))
#define XB ((bf16*)((bf16*)(ws + WS_XB)))
#define SIX ((bf16*)((bf16*)(ws + WS_SIX)))
#define VT ((bf16*)((bf16*)(ws + WS_VT)))
#define GATE ((bf16*)((bf16*)(ws + WS_GATE)))
#define MERGED ((bf16*)((bf16*)(ws + WS_MERGED)))
#define X1B ((bf16*)((bf16*)(ws + WS_X1B)))
#define TU8 ((unsigned char*)(ws + WS_TU))
#define TV8 ((unsigned char*)(ws + WS_TV))
#define SU ((float*)((float*)(ws + WS_SU)))
#define SV ((float*)((float*)(ws + WS_SV)))
#define SCORES ((float*)((float*)(ws + WS_SCORES)))
#define ROUTE ((v2u*)((v2u*)(ws + WS_ROUTE)))
#define WBUF ((float*)((float*)(ws + WS_W)))
#define SSB ((float*)((float*)(ws + WS_SS)))
#define UPART ((float*)((float*)(ws + WS_UPART)))
#define RSTD1 ((float*)((float*)(ws + WS_RSTD1)))
#define QB ((bf16*)(SIX))
#define CBB ((bf16*)(SIX + (size_t)1 * M * 512))
#define KB ((bf16*)(SIX + (size_t)2 * M * 512))
#define CCB ((bf16*)(SIX + (size_t)4 * M * 512))
#define CUB ((bf16*)(SIX + (size_t)5 * M * 512))
    for (int u = tid; u < (LDS_BYTES - LDSCTL_OFF) / 4; u += NWAVES * 64) ((LAS unsigned*)(ldsb + LDSCTL_OFF))[u] = 0u;
    __syncthreads();
    XcdBarrier bar; bar.bar = (unsigned*)(ctl + CW_BAR); bar.x = 0; bar.st = nullptr;
    if (N_LAUNCHES == 1) bar = xcd_barrier_post((unsigned*)(ctl + CW_BAR), MISC + 8);
#define GRID_BAR() do { if (N_LAUNCHES == 1) xcd_barrier(bar); } while (0)
#ifdef TPROBE
    unsigned long long t_s = 0, t_e = 0;
#define TSTAMP(k) do { if ((k) == TPROBE) t_s = __builtin_amdgcn_s_memrealtime(); if ((k) == TPROBE_END) t_e = __builtin_amdgcn_s_memrealtime(); } while (0)
#ifndef TPROBE_TID
#define TPROBE_TID 0
#endif
#define TSTALL() do { if (bx == 0 && tid == TPROBE_TID) { const unsigned long long t0_ = __builtin_amdgcn_s_memrealtime(), dt_ = (t_e - t_s) * 8ull; while (__builtin_amdgcn_s_memrealtime() - t0_ < dt_) __builtin_amdgcn_s_sleep(4); } } while (0)
#else
#define TSTAMP(k) do { } while (0)
#define TSTALL() do { } while (0)
#endif
    const int lo = args.ph_lo, hi = args.ph_hi;
#define IN(k) (lo <= (k) && (k) < hi)
#define BOTH(k) (IN(k) && IN((k) + 1))

    TSTAMP(0);
    if (IN(0)) { for (int rep = 0; rep < NREP(0); ++rep) {
        LAS float* scr = (LAS float*)(ldsb + RING_OFF + wave * 17408);
        constexpr int I_IN = (D / 64) * (NIN / 32), I_A = (512 / 64) * (D / 32), I_O = (D / 64) * (D / 32);
        constexpr int NITEMS = I_IN + 2 * I_A + I_O;
        constexpr int ABW = 3; const int aw = vcu * ABW + wave, NAW = G * ABW, cw = vcu * (NWAVES - ABW) + (wave - ABW), NCW = G * (NWAVES - ABW);
        if (wave < ABW) {
        for (int it = aw; it < NITEMS; it += NAW) {
            int r = it;
            if (r < I_IN) { p0_transpose_item(w_in, D, NIN, Win_t, 0, norm_mix, scr, r, lane); continue; } r -= I_IN;
            if (r < I_A) { p0_transpose_item(w_a, 512, D, Wab, 0, nullptr, scr, r, lane); continue; } r -= I_A;
            if (r < I_A) { p0_transpose_item(w_b, 512, D, Wab, 1024, nullptr, scr, r, lane); continue; } r -= I_A;
            p0_transpose_item(w_o, D, D, Wo_t, 0, nullptr, scr, r, lane);
        }
        TSTAMP(20);
        for (int wt = aw; wt < 64 * 32; wt += NAW) {
            const int nt = wt & 63, kt = wt >> 6, hp = nt >> 2, h = lane >> 5, l32 = lane & 31;
            f32x4 av[16], bv[16];
            { f32x4 t[16];
#pragma unroll
              for (int i = 0; i < 16; ++i) t[i] = *(const GAS f32x4*)(w_q + (size_t)(kt * 32 + 2 * i + (lane >> 5)) * 2048 + hp * 128 + 4 * (lane & 31));
#pragma unroll
              for (int i = 0; i < 16; ++i) *(LAS f32x4*)(scr + (2 * i + (lane >> 5)) * 132 + 4 * (lane & 31)) = t[i];
              LDS_WAIT();
#pragma unroll
              for (int i = 0; i < 16; ++i) av[i] = *(const LAS f32x4*)(scr + l32 * 132 + 64 * h + 4 * i);
              LDS_WAIT();
#pragma unroll
              for (int i = 0; i < 16; ++i) t[i] = *(const GAS f32x4*)(sub_keys + (size_t)(nt * 32) * 128 + 4 * (i * 64 + lane));
#pragma unroll
              for (int i = 0; i < 16; ++i) *(LAS f32x4*)(scr + (2 * i + (lane >> 5)) * 132 + 4 * (lane & 31)) = t[i];
              LDS_WAIT();
#pragma unroll
              for (int i = 0; i < 16; ++i) bv[i] = *(const LAS f32x4*)(scr + l32 * 132 + 64 * h + 4 * i);
              LDS_WAIT(); }
            f32x16 acc;
#pragma unroll
            for (int i = 0; i < 16; ++i) acc[i] = 0.f;
#pragma unroll
            for (int i = 0; i < 16; ++i) {
                acc = __builtin_amdgcn_mfma_f32_32x32x2f32(av[i].x, bv[i].x, acc, 0, 0, 0); acc = __builtin_amdgcn_mfma_f32_32x32x2f32(av[i].y, bv[i].y, acc, 0, 0, 0);
                acc = __builtin_amdgcn_mfma_f32_32x32x2f32(av[i].z, bv[i].z, acc, 0, 0, 0); acc = __builtin_amdgcn_mfma_f32_32x32x2f32(av[i].w, bv[i].w, acc, 0, 0, 0); }
            const int n = nt * 32 + l32;
#pragma unroll
            for (int rq = 0; rq < 4; ++rq) { const int kb = kt * 32 + 8 * rq + 4 * h; const f32x4 g = *(const GAS f32x4*)(norm_ffn + kb);
                v2u o; o.x = pk2(acc[4 * rq] * g.x, acc[4 * rq + 1] * g.y); o.y = pk2(acc[4 * rq + 2] * g.z, acc[4 * rq + 3] * g.w);
                *(GAS v2u*)(Weff + (size_t)n * D + kb) = o; }
        }
        TSTAMP(21);
        } else {
        for (int m0 = cw; m0 < M; m0 += 4 * NCW) {
            f32x4 v[4][4]; float s[4];
#pragma unroll
            for (int q = 0; q < 4; ++q) { const int m = m0 + q * NCW; const GAS f32x4* xr = (const GAS f32x4*)(x + (size_t)(m < M ? m : m0) * D) + lane;
#pragma unroll
                for (int j = 0; j < 4; ++j) v[q][j] = __builtin_nontemporal_load(xr + 64 * j); }
#pragma unroll
            for (int q = 0; q < 4; ++q) { s[q] = 0.f;
#pragma unroll
                for (int j = 0; j < 4; ++j) s[q] += (v[q][j].x * v[q][j].x + v[q][j].y * v[q][j].y) + (v[q][j].z * v[q][j].z + v[q][j].w * v[q][j].w); }
#pragma unroll
            for (int o = 1; o < 64; o <<= 1) {
#pragma unroll
                for (int q = 0; q < 4; ++q) s[q] += __shfl_xor(s[q], o); }
#pragma unroll
            for (int q = 0; q < 4; ++q) { const int m = m0 + q * NCW; if (m < M) {
                const float rstd = 1.0f / sqrtf(s[q] * (1.0f / D) + RMS_EPS);
                GAS v2u* o8 = (GAS v2u*)(XB + (size_t)m * D) + lane;
#pragma unroll
                for (int j = 0; j < 4; ++j) { v2u o; o.x = pk2(v[q][j].x, v[q][j].y); o.y = pk2(v[q][j].z, v[q][j].w); o8[64 * j] = o; }
                if (lane == 0) RSTD1[m] = rstd; } }
        }
        TSTAMP(22);
        for (int e0 = cw; e0 < NEXP; e0 += 2 * NCW) {
            float v[4][16]; float am[4]; int ee[4];
#pragma unroll
            for (int q = 0; q < 4; ++q) { const int e = e0 + (q >> 1) * NCW; ee[q] = e < NEXP ? e : e0; const float* src = ((q & 1) ? exp_v : exp_u) + (size_t)ee[q] * D; const GAS f32x4* sp = (const GAS f32x4*)src;
#pragma unroll
                for (int j = 0; j < 2; ++j) { const f32x4 a = __builtin_nontemporal_load(sp + 2 * lane + 128 * j), b = __builtin_nontemporal_load(sp + 2 * lane + 128 * j + 1);
                    v[q][8 * j + 0] = a.x; v[q][8 * j + 1] = a.y; v[q][8 * j + 2] = a.z; v[q][8 * j + 3] = a.w; v[q][8 * j + 4] = b.x; v[q][8 * j + 5] = b.y; v[q][8 * j + 6] = b.z; v[q][8 * j + 7] = b.w; } }
            { const GAS f32x4* gp = (const GAS f32x4*)norm_ffn;
#pragma unroll
              for (int j = 0; j < 2; ++j) { const f32x4 ga = gp[2 * lane + 128 * j], gb = gp[2 * lane + 128 * j + 1];
#pragma unroll
                for (int q = 0; q < 4; q += 2) { v[q][8 * j + 0] *= ga.x; v[q][8 * j + 1] *= ga.y; v[q][8 * j + 2] *= ga.z; v[q][8 * j + 3] *= ga.w; v[q][8 * j + 4] *= gb.x; v[q][8 * j + 5] *= gb.y; v[q][8 * j + 6] *= gb.z; v[q][8 * j + 7] *= gb.w; } } }
#pragma unroll
            for (int q = 0; q < 4; ++q) { am[q] = 0.f;
#pragma unroll
                for (int i = 0; i < 16; ++i) am[q] = __builtin_fmaxf(am[q], __builtin_fabsf(v[q][i])); }
#pragma unroll
            for (int o = 1; o < 64; o <<= 1) {
#pragma unroll
                for (int q = 0; q < 4; ++q) am[q] = __builtin_fmaxf(am[q], __shfl_xor(am[q], o)); }
#pragma unroll
            for (int q = 0; q < 4; ++q) { const int e = e0 + (q >> 1) * NCW; if (e < NEXP) {
                const float top = (q & 1) ? 384.0f : 127.0f;
                const float sc = (am[q] > 0.f) ? top / am[q] : 1.0f, inv = (am[q] > 0.f) ? am[q] * (1.0f / top) : 1.0f;
                v2u q0, q1;
                if (q & 1) {
                { int w = __builtin_amdgcn_cvt_pk_fp8_f32(v[q][0] * sc, v[q][1] * sc, 0, false); w = __builtin_amdgcn_cvt_pk_fp8_f32(v[q][2] * sc, v[q][3] * sc, w, true); q0.x = (unsigned)w; }
                { int w = __builtin_amdgcn_cvt_pk_fp8_f32(v[q][4] * sc, v[q][5] * sc, 0, false); w = __builtin_amdgcn_cvt_pk_fp8_f32(v[q][6] * sc, v[q][7] * sc, w, true); q0.y = (unsigned)w; }
                { int w = __builtin_amdgcn_cvt_pk_fp8_f32(v[q][8] * sc, v[q][9] * sc, 0, false); w = __builtin_amdgcn_cvt_pk_fp8_f32(v[q][10] * sc, v[q][11] * sc, w, true); q1.x = (unsigned)w; }
                { int w = __builtin_amdgcn_cvt_pk_fp8_f32(v[q][12] * sc, v[q][13] * sc, 0, false); w = __builtin_amdgcn_cvt_pk_fp8_f32(v[q][14] * sc, v[q][15] * sc, w, true); q1.y = (unsigned)w; }
                } else {
                    unsigned w4[4];
#pragma unroll
                    for (int j = 0; j < 4; ++j) { const int i0 = (int)__builtin_rintf(v[q][4 * j] * sc), i1 = (int)__builtin_rintf(v[q][4 * j + 1] * sc), i2 = (int)__builtin_rintf(v[q][4 * j + 2] * sc), i3 = (int)__builtin_rintf(v[q][4 * j + 3] * sc);
                        w4[j] = ((unsigned)i0 & 255u) | (((unsigned)i1 & 255u) << 8) | (((unsigned)i2 & 255u) << 16) | ((unsigned)i3 << 24); }
                    q0.x = w4[0]; q0.y = w4[1]; q1.x = w4[2]; q1.y = w4[3];
                }
                unsigned char* dst = (q & 1) ? TV8 : TU8; const int s0 = lane >> 4, o8 = 8 * (lane & 15);
                *(GAS v2u*)(dst + ((size_t)s0 * NEXP + e) * 128 + o8) = q0; *(GAS v2u*)(dst + ((size_t)(s0 + 4) * NEXP + e) * 128 + o8) = q1;
                if (lane == 0) ((q & 1) ? SV : SU)[e] = inv; } }
        }
                TSTAMP(23);
        }
}
        if (BOTH(0)) GRID_BAR();
    }

    TSTAMP(1);
    if (IN(1)) { for (int rep = 0; rep < NREP(1); ++rep) { if (rep) GRID_BAR();
        pg8::Gemm g{XB, Win_t, M, NIN, D}; pg8::StaticOrder S; S.init(M, NIN, G, (int)blockIdx.x);
        pg8::EpiProj E{SIX, VT, GATE, RSTD1, (DUP_MASK & 64) ? rep : 0};
        pg8::gemm_phase<pg8::EpiProj, pg8::StaticOrder, true, true>(ldsb + RING_OFF, g, S, E); }
        if (DUP_MASK & 128) { const unsigned long long t0 = __builtin_amdgcn_s_memrealtime(); while (__builtin_amdgcn_s_memrealtime() - t0 < 15000ull) __builtin_amdgcn_s_sleep(8); }
        if (BOTH(1)) GRID_BAR();
    }

    TSTAMP(2);
    if (IN(2)) {
        for (int rep = 0; rep < NREP(2); ++rep) {
        const bool dummy = (rep + 1 < NREP(2));
        conv_phase(CBB, CCB, CUB, dummy ? XB : CBB, conv_w, conv_b, gw * 64 + lane, NGW * 64);
        TSTAMP(24);
        for (int it = gw; it < BATCH * NH * (T / 32); it += NGW) {
            const int bh = it >> 7, qblk = it & 127;
            attn_item(QB, KB, VT, dummy ? MERGED : QB, bh >> 3, bh & 7, qblk, ldsb + RING_OFF + wave * 9216, lane);
        }
        }
        if (BOTH(2)) GRID_BAR();
    }

    TSTAMP(3);
    if (IN(3)) { for (int rep = 0; rep < NREP(3); ++rep) { if (rep) GRID_BAR();
        pg8::Gemm g{QB, Wab, 2 * M, 2048, 512}; pg8::PairOrder S; S.init(G, (int)blockIdx.x);
        pg8::EpiGate E{out, MERGED, GATE, GATE + (size_t)M * 1024};
        pg8::gemm_phase<pg8::EpiGate, pg8::PairOrder, true, true>(ldsb + RING_OFF, g, S, E); }
        if (BOTH(3)) GRID_BAR();
    }

    TSTAMP(4);
    if (IN(4)) { for (int rep = 0; rep < NREP(4); ++rep) { if (rep) GRID_BAR();
        pg8::Gemm g{MERGED, Wo_t, M, D, D}; pg8::StaticOrder S; S.init(M, D, G, (int)blockIdx.x);
        pg8::EpiWo E{x, X1B};
        pg8::gemm_phase<pg8::EpiWo, pg8::StaticOrder, false, true>(ldsb + RING_OFF, g, S, E);
        }
        if (BOTH(4)) GRID_BAR();
    }

    TSTAMP(5);
    if (IN(5)) { for (int rep = 0; rep < NREP(5); ++rep) { if (rep) GRID_BAR();
        pg8::Gemm g{X1B, Weff, M, 2048, D}; pg8::StaticOrder S; S.init(M, 2048, G, (int)blockIdx.x);
        pg8::EpiScores E{(unsigned short*)SCORES};
        pg8::gemm_phase<pg8::EpiScores, pg8::StaticOrder, true, true>(ldsb + RING_OFF, g, S, E);
        asm volatile("s_waitcnt vmcnt(0)" ::: "memory"); __syncthreads();
        int nu = 0; { pg8::Unit u; while (S.next(nu, u)) ++nu; }
        LAS unsigned char* scr = ldsb + RING_OFF + wave * 8192;
        for (int t = wave; t < nu * 4; t += NWAVES) { pg8::Unit u; S.next(t >> 2, u); route_task((const unsigned short*)SCORES, ROUTE, u.pm * 256 + (t & 3) * 64, u.pn, scr, lane); } }
        if (BOTH(5)) GRID_BAR();
    }
    const bool sliced_ok = (G % 8 == 0) && (M % ((G / 8) * NWAVES) == 0);

    TSTAMP(7);
    if (IN(7)) {
        LAS unsigned char* scr = ldsb + RING_OFF + wave * 8192;
#ifdef DEBUG_U
        if (1) {} else
#endif
        if (sliced_ok) { const int nj = G >> 3; peer_u_phase_dot4(bx & 7, (bx >> 3) * NWAVES + wave, nj * NWAVES, M / (nj * NWAVES), ROUTE, (const float*)X1B, TU8, UPART, scr, lane); }
        else for (int s8 = 0; s8 < 8; ++s8) { const int nt = (M - 1 - gw) / NGW + 1; if (gw < M) peer_u_phase_dot4(s8, gw, NGW, nt, ROUTE, (const float*)X1B, TU8, UPART, scr, lane); }
        if (BOTH(7)) GRID_BAR();
    }

    TSTAMP(8);
    if (IN(8)) {
#ifdef DEBUG_U
        for (int tok = gw; tok < M; tok += NGW) peer_u_debug(tok, ROUTE, out, TU8, SU, SV, WBUF, lane);
#else
        for (int tok = gw; tok < M; tok += 2 * NGW) peer_w_token2(tok, (tok + NGW < M) ? tok + NGW : tok, ROUTE, X1B, (const bf16*)UPART, SU, SV, WBUF, lane);
#endif
        if (BOTH(8)) GRID_BAR();
    }

    TSTAMP(9);
    if (IN(9)) {
        LAS unsigned char* scr = ldsb + RING_OFF + wave * 8192;
#ifdef DEBUG_V
        for (int tok = gw; tok < M; tok += NGW) peer_v_debug(tok, ROUTE, WBUF, TV8, out, SSB, lane);
        if (0)
#endif
        if (sliced_ok) { const int nj = G >> 3; peer_v_phase(bx & 7, (bx >> 3) * NWAVES + wave, nj * NWAVES, M / (nj * NWAVES), ROUTE, WBUF, TV8, X1B, out, SSB, scr, lane); }
        else for (int s8 = 0; s8 < 8; ++s8) { const int nt = (M - 1 - gw) / NGW + 1; if (gw < M) peer_v_phase(s8, gw, NGW, nt, ROUTE, WBUF, TV8, X1B, out, SSB, scr, lane); }
        if (BOTH(9)) GRID_BAR();
    }

    TSTAMP(10);
    if (IN(10)) {
        for (int tok = gw; tok < M; tok += NGW) {
            GAS f32x4* op = (GAS f32x4*)(out + (size_t)tok * D) + lane; const GAS f32x4* gp = (const GAS f32x4*)final_norm + lane;
            f32x4 v[4]; float s2 = 0.f;
#pragma unroll
            for (int j = 0; j < 4; ++j) { v[j] = op[64 * j]; s2 += (v[j].x * v[j].x + v[j].y * v[j].y) + (v[j].z * v[j].z + v[j].w * v[j].w); }
            const float rstd3 = 1.0f / sqrtf(wave_sum(s2) * (1.0f / D) + RMS_EPS);
#pragma unroll
            for (int j = 0; j < 4; ++j) { const f32x4 g = gp[64 * j]; f32x4 o; o.x = v[j].x * rstd3 * g.x; o.y = v[j].y * rstd3 * g.y; o.z = v[j].z * rstd3 * g.z; o.w = v[j].w * rstd3 * g.w; op[64 * j] = o; }
        }
    }
    TSTAMP(11);
    TSTALL();
#undef IN
#undef BOTH
#undef GRID_BAR
#undef norm_mix
#undef w_in
#undef conv_w
#undef conv_b
#undef w_a
#undef w_b
#undef w_o
#undef norm_ffn
#undef w_q
#undef sub_keys
#undef exp_u
#undef exp_v
#undef final_norm
#undef Weff
#undef Wab
#undef Wo_t
#undef Win_t
#undef XB
#undef SIX
#undef VT
#undef GATE
#undef MERGED
#undef X1B
#undef TU8
#undef TV8
#undef SU
#undef SV
#undef SCORES
#undef ROUTE
#undef WBUF
#undef SSB
#undef UPART
#undef RSTD1
#undef QB
#undef CBB
#undef KB
#undef CCB
#undef CUB
}

extern "C" void kernel_launch(void* const* d_in, const int* in_sizes, int n_in, void* d_out, int out_size, void* d_ws, size_t ws_size, hipStream_t stream) {
    static int grid = 0;
    if (grid == 0) {
        if (n_in != 14 || in_sizes[0] != M * D || out_size != M * D || ws_size < WS_END) { fprintf(stderr, "kernel_launch: built for 14 inputs, x/out of %d floats, >= %zu bytes of workspace; got n_in %d, in0 %d, out %d, ws %zu; nothing launched\n", M * D, (size_t)WS_END, n_in, n_in > 0 ? in_sizes[0] : -1, out_size, ws_size); grid = -1; return; }
        int dev = 0, cus = 0, per_cu = 0;
        if (hipGetDevice(&dev) != hipSuccess || hipDeviceGetAttribute(&cus, hipDeviceAttributeMultiprocessorCount, dev) != hipSuccess) { fprintf(stderr, "kernel_launch: device query failed\n"); grid = -1; return; }
        if (hipFuncSetAttribute((const void*)hybrid_fwd, hipFuncAttributeMaxDynamicSharedMemorySize, LDS_BYTES) != hipSuccess) { fprintf(stderr, "kernel_launch: hipFuncSetAttribute failed\n"); grid = -1; return; }
        if (hipOccupancyMaxActiveBlocksPerMultiprocessor(&per_cu, (const void*)hybrid_fwd, NWAVES * 64, LDS_BYTES) != hipSuccess || per_cu < 1) { fprintf(stderr, "kernel_launch: occupancy query reports %d workgroups per CU\n", per_cu); per_cu = 1; }
        (void)hipGetLastError();
        grid = cus;
    }
    if (grid < 0) return;
    if (hipMemsetAsync((char*)d_ws + WS_CTL, 0, CTL_ZERO_BYTES, stream) != hipSuccess) { fprintf(stderr, "kernel_launch: hipMemsetAsync failed\n"); return; }
    Args a{};
    for (int i = 0; i < 14; ++i) a.in[i] = (const float*)d_in[i];
    a.out = (float*)d_out; a.ws = (unsigned char*)d_ws;
#ifdef PROBE_SEQ
    const int seq[] = PROBE_SEQ; const int nseq = (int)(sizeof(seq) / sizeof(int));
#else
    const int seq[] = {0, 1, 2, 3, 4, 5, 6, 7, 8, 9, 10}; const int nseq = (N_LAUNCHES == 1) ? 1 : 11;
#endif
    for (int li = 0; li < nseq; ++li) {
        a.ph_lo = (N_LAUNCHES == 1) ? 0 : seq[li]; a.ph_hi = (N_LAUNCHES == 1) ? N_PHASES : seq[li] + 1; a.li = li;
        hipLaunchKernelGGL(hybrid_fwd, dim3(grid), dim3(NWAVES * 64), LDS_BYTES, stream, a);
        const hipError_t le = hipPeekAtLastError();
        if (le != hipSuccess) { fprintf(stderr, "kernel_launch: launch %d failed: %s\n", li, hipGetErrorName(le)); break; }
    }
}
```

```cpp
#define DUP_MASK 0
#include <hip/hip_runtime.h>
#include <cstdio>
#include <cstdint>
#include <cmath>
namespace pg8 {
#define PG8_LAS __attribute__((address_space(3)))
typedef unsigned short bf16_t;
typedef short bf16x8 __attribute__((ext_vector_type(8)));
typedef float f32x4 __attribute__((ext_vector_type(4)));
typedef unsigned u32x4 __attribute__((ext_vector_type(4)));
constexpr int BM = 256, BK = 64, HALF = 128, HTB = HALF * BK * 2  , STAGE_BYTES = 8 * HTB, NXCD = 8, WGM = 8;

__host__ __device__ __forceinline__ int lds_byte(int r, int c) { const int st = (r >> 4) * 2 + (c >> 5), rr = r & 15, cc = c & 31, ob = rr * 64 + cc * 2; return st * 1024 + (ob ^ (((ob >> 9) & 1) << 5)); }
__host__ __device__ __forceinline__ void stage_rc(int b, int& R, int& C) { const int st = b / 1024, sb = b % 1024, swz = sb ^ (((sb >> 9) & 1) << 5); R = (st >> 1) * 16 + swz / 64; C = (st & 1) * 32 + (swz % 64) / 2; }
__host__ __device__ __forceinline__ int perm32(int rho) { const int n = rho >> 4, i = rho & 15; return 8 * (i >> 2) + 4 * n + (i & 3); }

struct Unit { int pm, pn; };
struct Gemm { const bf16_t* A; const bf16_t* Bt; int M, N, K; };

struct StaticOrder {
    int nM, nN, nwg, G, c;
    __host__ __device__ void init(int M, int N, int G_, int c_) { nM = M / BM; nN = N / BM; nwg = nM * nN; G = G_; c = c_; }
    __host__ __device__ bool next(int i, Unit& u) const {
        const long L = (long)i * G + c; if (L >= nwg) return false;
        int wgid = (int)L; { const int q = nwg / NXCD, r = nwg % NXCD, xcd = wgid % NXCD, off = wgid / NXCD; wgid = (xcd < r ? xcd * (q + 1) : r * (q + 1) + (xcd - r) * q) + off; }
        const int nig = WGM * nN, gid = wgid / nig, fm = gid * WGM, gsz = (nM - fm) < WGM ? (nM - fm) : WGM;
        u.pm = fm + ((wgid % nig) % gsz); u.pn = (wgid % nig) / gsz; return true;
    }
    __device__ __forceinline__ void a_ready(const Unit&) const {}
    __device__ __forceinline__ void done(const Unit&) const {}
};

__device__ __forceinline__ unsigned cvt_pk_bf16(float lo, float hi) { unsigned r; asm volatile("v_cvt_pk_bf16_f32 %0, %1, %2" : "=v"(r) : "v"(lo), "v"(hi)); return r; }
constexpr int MTOK = 16384;
__device__ __forceinline__ unsigned f2bf_rne(float f) { unsigned u = __builtin_bit_cast(unsigned, f); return (u + 0x7fffu + ((u >> 16) & 1u)) >> 16; }
__device__ __forceinline__ float bf_lo(unsigned w) { return __builtin_bit_cast(float, w << 16); }
__device__ __forceinline__ float bf_hi(unsigned w) { return __builtin_bit_cast(float, w & 0xffff0000u); }
__device__ __forceinline__ float sigmoid_fast(float x) { return __builtin_amdgcn_rcpf(1.0f + __builtin_amdgcn_exp2f(-1.4426950408889634f * x)); }

struct EpiProj {
    static constexpr bool PERM = true, AFTER_DRAIN = false;
    bf16_t* six;
    bf16_t* vt;
    bf16_t* gate;
    const float* rstd; int skip;
    __device__ __forceinline__ void operator()(const f32x4 (&acc)[2][2][4][2], const Unit& u, int wr, int wc, int fr, int fq) const {
        const int row0 = u.pm * BM + wr * 64 + fr; const int colt = u.pn * BM;
        if (skip) return;
        if (colt < 3072) {
            const int t = colt >> 9, cc = colt & 511;
            if (t == 2) {
#pragma unroll
                for (int ai = 0; ai < 2; ++ai)
#pragma unroll
                    for (int m = 0; m < 4; ++m) { const int r = row0 + ai * HALF + m * 16; const float rs = rstd[r]; const int b = r >> 12, tt = r & 4095;
#pragma unroll
                        for (int bj = 0; bj < 2; ++bj) { const int c0 = cc + bj * HALF + wc * 32 + 8 * fq; const int hh = c0 >> 6, d0 = c0 & 63;
                            bf16_t* p = vt + ((size_t)((b * 8 + hh) * 64 + d0)) * 4096 + tt;
#pragma unroll
                            for (int n = 0; n < 2; ++n)
#pragma unroll
                                for (int i = 0; i < 4; ++i) p[(size_t)(4 * n + i) * 4096] = (bf16_t)f2bf_rne(acc[ai][bj][m][n][i] * rs); } }
            } else {
                const int bufidx = (t == 0) ? 0 : (t == 1) ? 2 : (t == 3) ? 1 : t;
                bf16_t* base = six + (size_t)bufidx * MTOK * 512; const float sc = (t == 0) ? 0.125f : 1.0f;
                const int col0 = cc + wc * 32 + 8 * fq;
#pragma unroll
                for (int ai = 0; ai < 2; ++ai)
#pragma unroll
                    for (int m = 0; m < 4; ++m) { const int r = row0 + ai * HALF + m * 16; const float rs = rstd[r] * sc; bf16_t* rowp = base + (size_t)r * 512 + col0;
#pragma unroll
                        for (int bj = 0; bj < 2; ++bj) { const f32x4 v0 = acc[ai][bj][m][0] * rs, v1 = acc[ai][bj][m][1] * rs;
                            u32x4 w; w.x = cvt_pk_bf16(v0[0], v0[1]); w.y = cvt_pk_bf16(v0[2], v0[3]); w.z = cvt_pk_bf16(v1[0], v1[1]); w.w = cvt_pk_bf16(v1[2], v1[3]);
                            *(u32x4*)(rowp + bj * HALF) = w; } }
            }
        } else {
            const int gi = (colt - 3072) >> 10, cc = (colt - 3072) & 1023;
            bf16_t* base = gate + (size_t)gi * MTOK * 1024; const int col0 = cc + wc * 32 + 8 * fq;
#pragma unroll
            for (int ai = 0; ai < 2; ++ai)
#pragma unroll
                for (int m = 0; m < 4; ++m) { const int r = row0 + ai * HALF + m * 16; const float rs = rstd[r]; bf16_t* rowp = base + (size_t)r * 1024 + col0;
#pragma unroll
                    for (int bj = 0; bj < 2; ++bj) { f32x4 v0 = acc[ai][bj][m][0] * rs, v1 = acc[ai][bj][m][1] * rs;
#pragma unroll
                        for (int i = 0; i < 4; ++i) { v0[i] = sigmoid_fast(v0[i]); v1[i] = sigmoid_fast(v1[i]); }
                        u32x4 w; w.x = cvt_pk_bf16(v0[0], v0[1]); w.y = cvt_pk_bf16(v0[2], v0[3]); w.z = cvt_pk_bf16(v1[0], v1[1]); w.w = cvt_pk_bf16(v1[2], v1[3]);
                        *(u32x4*)(rowp + bj * HALF) = w; } }
        }
    }
};

struct EpiGate {
    static constexpr bool PERM = true, AFTER_DRAIN = false;
    float* P; bf16_t* merged; const bf16_t* g0; const bf16_t* g1;
    __device__ __forceinline__ void operator()(const f32x4 (&acc)[2][2][4][2], const Unit& u, int wr, int wc, int fr, int fq) const {
        const int which = (u.pm >= 64) ? 1 : 0; const int pm = u.pm - 64 * which, pn = u.pn - 4 * which;
        const int row0 = pm * BM + wr * 64 + fr, col0 = pn * BM + wc * 32 + 8 * fq; const bf16_t* g = which ? g1 : g0;
#pragma unroll
        for (int ai = 0; ai < 2; ++ai)
#pragma unroll
            for (int m = 0; m < 4; ++m) { const int r = row0 + ai * HALF + m * 16;
#pragma unroll
                for (int bj = 0; bj < 2; ++bj) { const size_t off = (size_t)r * 1024 + col0 + bj * HALF;
                    const u32x4 gv = *(const u32x4*)(g + off);
                    f32x4 a0 = acc[ai][bj][m][0], a1 = acc[ai][bj][m][1];
                    a0[0] *= bf_lo(gv.x); a0[1] *= bf_hi(gv.x); a0[2] *= bf_lo(gv.y); a0[3] *= bf_hi(gv.y);
                    a1[0] *= bf_lo(gv.z); a1[1] *= bf_hi(gv.z); a1[2] *= bf_lo(gv.w); a1[3] *= bf_hi(gv.w);
                    if (!which) { u32x4 w; w.x = cvt_pk_bf16(a0[0], a0[1]); w.y = cvt_pk_bf16(a0[2], a0[3]); w.z = cvt_pk_bf16(a1[0], a1[1]); w.w = cvt_pk_bf16(a1[2], a1[3]); *(u32x4*)((bf16_t*)P + off) = w; }
                    else { const u32x4 pw = *(const u32x4*)((const bf16_t*)P + off);
                        a0[0] += bf_lo(pw.x); a0[1] += bf_hi(pw.x); a0[2] += bf_lo(pw.y); a0[3] += bf_hi(pw.y); a1[0] += bf_lo(pw.z); a1[1] += bf_hi(pw.z); a1[2] += bf_lo(pw.w); a1[3] += bf_hi(pw.w);
                        u32x4 w; w.x = cvt_pk_bf16(a0[0], a0[1]); w.y = cvt_pk_bf16(a0[2], a0[3]); w.z = cvt_pk_bf16(a1[0], a1[1]); w.w = cvt_pk_bf16(a1[2], a1[3]);
                        *(u32x4*)(merged + off) = w; } } }
    }
};
struct PairOrder {
    StaticOrder so;
    __host__ __device__ void init(int G_, int c_) { so.init(MTOK, 1024, G_, c_); }
    __host__ __device__ bool next(int i, Unit& u) const { Unit t; if (!so.next(i >> 1, t)) return false; const int w = i & 1; u.pm = t.pm + 64 * w; u.pn = t.pn + 4 * w; return true; }
    __device__ __forceinline__ void a_ready(const Unit&) const {}
    __device__ __forceinline__ void done(const Unit&) const {}
};

struct EpiWo {
    static constexpr bool PERM = true, AFTER_DRAIN = false;
    const float* x; bf16_t* x1b;
    __device__ __forceinline__ void operator()(const f32x4 (&acc)[2][2][4][2], const Unit& u, int wr, int wc, int fr, int fq) const {
        const int row0 = u.pm * BM + wr * 64 + fr, col0 = u.pn * BM + wc * 32 + 8 * fq;
#pragma unroll
        for (int ai = 0; ai < 2; ++ai)
#pragma unroll
            for (int m = 0; m < 4; ++m) { const int r = row0 + ai * HALF + m * 16;
#pragma unroll
                for (int bj = 0; bj < 2; ++bj) { const size_t off = (size_t)r * 1024 + col0 + bj * HALF;
                    const f32x4 a0 = acc[ai][bj][m][0] + *(const f32x4*)(x + off), a1 = acc[ai][bj][m][1] + *(const f32x4*)(x + off + 4);
                    u32x4 w; w.x = cvt_pk_bf16(a0[0], a0[1]); w.y = cvt_pk_bf16(a0[2], a0[3]); w.z = cvt_pk_bf16(a1[0], a1[1]); w.w = cvt_pk_bf16(a1[2], a1[3]);
                    *(u32x4*)(x1b + off) = w; } }
    }
};
typedef _Float16 f16x2_t __attribute__((ext_vector_type(2)));
typedef float f32x2e __attribute__((ext_vector_type(2)));
__device__ __forceinline__ unsigned pk_f16(float lo, float hi) { f32x2e v = {lo, hi}; f16x2_t h = __builtin_convertvector(v, f16x2_t); return __builtin_bit_cast(unsigned, h); }
struct EpiScores {
    static constexpr bool PERM = true, AFTER_DRAIN = false;
    unsigned short* S;
    __device__ __forceinline__ void operator()(const f32x4 (&acc)[2][2][4][2], const Unit& u, int wr, int wc, int fr, int fq) const {
        const int row0 = u.pm * BM + wr * 64 + fr, col0 = u.pn * BM + wc * 32 + 8 * fq;
#pragma unroll
        for (int ai = 0; ai < 2; ++ai)
#pragma unroll
            for (int m = 0; m < 4; ++m) { const int r = row0 + ai * HALF + m * 16;
#pragma unroll
                for (int bj = 0; bj < 2; ++bj) { const size_t off = ((size_t)((col0 + bj * HALF) >> 3) * MTOK + r) * 8;
                    const f32x4 a0 = acc[ai][bj][m][0], a1 = acc[ai][bj][m][1];
                    u32x4 w; w.x = pk_f16(a0[0], a0[1]); w.y = pk_f16(a0[2], a0[3]); w.z = pk_f16(a1[0], a1[1]); w.w = pk_f16(a1[2], a1[3]);
                    *(u32x4*)(S + off) = w; } }
    }
};
template <class Epi, class Sched, bool ALIGN_EPI = false, bool SP2 = false>
__device__ __forceinline__ void gemm_phase(PG8_LAS unsigned char* lds, const Gemm g, const Sched& S, const Epi& E) {
    const int tid = threadIdx.x, wid = __builtin_amdgcn_readfirstlane(tid >> 6), lane = tid & 63, wr = wid >> 2, wc = wid & 3, fr = lane & 15, fq = lane >> 4;
    const int K = g.K, nt = K / BK;
    unsigned voffA[2], voffB[2];
#pragma unroll
    for (int i = 0; i < 2; ++i) { int R, C; stage_rc(tid * 16 + i * 8192, R, C); const int Rb = Epi::PERM ? ((R & ~31) + perm32(R & 31)) : R;
        voffA[i] = (unsigned)(R * K + C) * 2u; voffB[i] = (unsigned)(Rb * K + C) * 2u; }
    const size_t kstep = (size_t)(BK * 2);
    const size_t hstep = (size_t)HALF * K * 2;
    const size_t tstep = 2 * hstep;
    const unsigned ldsw = (unsigned)wid * 1024u;
    const int aoff = lds_byte(wr * 64 + fr, fq * 8), boff = lds_byte(wc * 32 + fr, fq * 8);
#define PG8_SA(b, h) (((b) * 2 + (h)) * HTB)
#define PG8_SB(b, h) ((4 + (b) * 2 + (h)) * HTB)
#define PG8_STAGE(bufoff, gbase, voff) do { _Pragma("unroll") for (int _i = 0; _i < 2; ++_i) \
        __builtin_amdgcn_global_load_lds((const unsigned*)((const char*)(gbase) + (voff)[_i]), (PG8_LAS unsigned*)(lds + (bufoff) + ldsw + _i * 8192), 16, 0, 0); } while (0)
#define PG8_LDA(dst, b, h) do { _Pragma("unroll") for (int m = 0; m < 4; ++m) _Pragma("unroll") for (int k = 0; k < 2; ++k) dst[m][k] = *(const PG8_LAS bf16x8*)(lds + PG8_SA(b, h) + aoff + m * 2048 + k * 1024); } while (0)
#define PG8_LDB(dst, b, h) do { _Pragma("unroll") for (int n = 0; n < 2; ++n) _Pragma("unroll") for (int k = 0; k < 2; ++k) dst[n][k] = *(const PG8_LAS bf16x8*)(lds + PG8_SB(b, h) + boff + n * 2048 + k * 1024); } while (0)
#define PG8_MMA(ai, bj, At, Bt) do { __builtin_amdgcn_s_setprio(1); _Pragma("unroll") for (int m = 0; m < 4; ++m) _Pragma("unroll") for (int n = 0; n < 2; ++n) _Pragma("unroll") for (int k = 0; k < 2; ++k) \
        acc[ai][bj][m][n] = __builtin_amdgcn_mfma_f32_16x16x32_bf16(Bt[n][k], At[m][k], acc[ai][bj][m][n], 0, 0, 0); __builtin_amdgcn_s_setprio(0); } while (0)
#define PG8_WAIT_V(n) asm volatile("s_waitcnt vmcnt(" #n ")" ::: "memory")
#define PG8_WAIT_L(n) asm volatile("s_waitcnt lgkmcnt(" #n ")" ::: "memory")
#define PG8_BAR __builtin_amdgcn_s_barrier()
#define PG8_SCHED __builtin_amdgcn_sched_barrier(0)
    Unit cur, nxt; int ui = 0;
    if (!S.next(0, cur)) return;
    f32x4 acc[2][2][4][2];
#pragma unroll
    for (int a = 0; a < 2; ++a)
#pragma unroll
        for (int b = 0; b < 2; ++b)
#pragma unroll
            for (int m = 0; m < 4; ++m)
#pragma unroll
                for (int n = 0; n < 2; ++n) acc[a][b][m][n] = (f32x4){0.f, 0.f, 0.f, 0.f};
    bf16x8 At[4][2], B0[2][2], B1[2][2];
    const char* cA = (const char*)g.A + (size_t)cur.pm * tstep; const char* cB = (const char*)g.Bt + (size_t)cur.pn * tstep;
    S.a_ready(cur);
    if constexpr (SP2) {
        PG8_STAGE(PG8_SB(0, 0), cB, voffB); PG8_STAGE(PG8_SB(0, 1), cB + hstep, voffB); PG8_STAGE(PG8_SA(0, 0), cA, voffA); PG8_STAGE(PG8_SA(0, 1), cA + hstep, voffA);
        if (wr == 1) PG8_BAR;
        PG8_WAIT_V(2); PG8_BAR;
        PG8_STAGE(PG8_SB(1, 0), cB + kstep, voffB); PG8_STAGE(PG8_SA(1, 0), cA + kstep, voffA); PG8_STAGE(PG8_SB(1, 1), cB + hstep + kstep, voffB);
        PG8_WAIT_V(6); PG8_BAR;
    } else {
        PG8_STAGE(PG8_SB(0, 0), cB, voffB); PG8_STAGE(PG8_SA(0, 0), cA, voffA); PG8_STAGE(PG8_SB(0, 1), cB + hstep, voffB); PG8_STAGE(PG8_SA(0, 1), cA + hstep, voffA);
        if (wr == 1) PG8_BAR;
        PG8_WAIT_V(4); PG8_BAR;
        PG8_STAGE(PG8_SB(1, 0), cB + kstep, voffB); PG8_STAGE(PG8_SA(1, 0), cA + kstep, voffA); PG8_STAGE(PG8_SB(1, 1), cB + hstep + kstep, voffB);
        PG8_WAIT_V(6); PG8_BAR;
    }
    for (;;) {
        const bool has_next = S.next(ui + 1, nxt);
        const char* nA = has_next ? (const char*)g.A + (size_t)nxt.pm * tstep : cA; const char* nB = has_next ? (const char*)g.Bt + (size_t)nxt.pn * tstep : cB;
        for (int t = 0; t < nt; t += 2) {
            const bool last = (t == nt - 2);
            const char* a1 = cA + (size_t)(t + 1) * kstep;
            const char* a2 = last ? nA : cA + (size_t)(t + 2) * kstep; const char* b2 = last ? nB : cB + (size_t)(t + 2) * kstep;
            const char* a3 = a2 + kstep; const char* b3 = b2 + kstep;
            if (last && has_next) S.a_ready(nxt);
            if constexpr (SP2) {
            PG8_LDB(B0, 0, 0); PG8_LDB(B1, 0, 1); PG8_SCHED; PG8_LDA(At, 0, 0); PG8_STAGE(PG8_SA(1, 1), a1 + hstep, voffA);
            PG8_WAIT_V(8); PG8_WAIT_L(0); PG8_BAR; PG8_MMA(0, 0, At, B0); PG8_MMA(0, 1, At, B1); PG8_BAR; PG8_SCHED;
            PG8_LDA(At, 0, 1); PG8_STAGE(PG8_SB(0, 0), b2, voffB); PG8_STAGE(PG8_SB(0, 1), b2 + hstep, voffB); PG8_STAGE(PG8_SA(0, 0), a2, voffA);
            PG8_WAIT_V(8); PG8_WAIT_L(0); PG8_BAR; PG8_MMA(1, 0, At, B0); PG8_MMA(1, 1, At, B1); PG8_BAR; PG8_SCHED;
            PG8_LDB(B0, 1, 0); PG8_LDB(B1, 1, 1); PG8_SCHED; PG8_LDA(At, 1, 0); PG8_STAGE(PG8_SA(0, 1), a2 + hstep, voffA);
            PG8_WAIT_V(8); PG8_WAIT_L(0); PG8_BAR; PG8_MMA(0, 0, At, B0); PG8_MMA(0, 1, At, B1); PG8_BAR; PG8_SCHED;
            PG8_LDA(At, 1, 1); PG8_STAGE(PG8_SB(1, 0), b3, voffB); PG8_STAGE(PG8_SB(1, 1), b3 + hstep, voffB); PG8_STAGE(PG8_SA(1, 0), a3, voffA);
            PG8_WAIT_V(8); PG8_WAIT_L(0); PG8_BAR; PG8_MMA(1, 0, At, B0); PG8_MMA(1, 1, At, B1); PG8_BAR; PG8_SCHED;
            } else {
            PG8_LDB(B0, 0, 0); PG8_SCHED; PG8_LDA(At, 0, 0); PG8_STAGE(PG8_SA(1, 1), a1 + hstep, voffA);
            PG8_WAIT_L(8); PG8_BAR; PG8_WAIT_L(0); PG8_MMA(0, 0, At, B0); PG8_BAR; PG8_SCHED;
            PG8_LDB(B1, 0, 1); PG8_STAGE(PG8_SB(0, 0), b2, voffB);
            PG8_BAR; PG8_WAIT_L(0); PG8_MMA(0, 1, At, B1); PG8_BAR;
            PG8_LDA(At, 0, 1); PG8_STAGE(PG8_SA(0, 0), a2, voffA);
            PG8_BAR; PG8_WAIT_L(0); PG8_MMA(1, 0, At, B0); PG8_BAR; PG8_SCHED;
            PG8_STAGE(PG8_SB(0, 1), b2 + hstep, voffB);
            PG8_WAIT_V(6); PG8_BAR; PG8_MMA(1, 1, At, B1); PG8_BAR;
            PG8_LDB(B0, 1, 0); PG8_SCHED; PG8_LDA(At, 1, 0); PG8_STAGE(PG8_SA(0, 1), a2 + hstep, voffA);
            PG8_WAIT_L(8); PG8_BAR; PG8_WAIT_L(0); PG8_MMA(0, 0, At, B0); PG8_BAR; PG8_SCHED;
            PG8_LDB(B1, 1, 1); PG8_STAGE(PG8_SB(1, 0), b3, voffB);
            PG8_BAR; PG8_WAIT_L(0); PG8_MMA(0, 1, At, B1); PG8_BAR;
            PG8_LDA(At, 1, 1); PG8_STAGE(PG8_SA(1, 0), a3, voffA);
            PG8_BAR; PG8_WAIT_L(0); PG8_MMA(1, 0, At, B0); PG8_BAR; PG8_SCHED;
            PG8_STAGE(PG8_SB(1, 1), b3 + hstep, voffB);
            PG8_WAIT_V(6); PG8_BAR; PG8_MMA(1, 1, At, B1); PG8_BAR;
            }
        }
        if constexpr (ALIGN_EPI) { if (wr == 0) PG8_BAR; }
        if constexpr (!Epi::AFTER_DRAIN) { E(acc, cur, wr, wc, fr, fq); S.done(cur); }
        if (!has_next) break;
#pragma unroll
        for (int a = 0; a < 2; ++a)
#pragma unroll
            for (int b = 0; b < 2; ++b)
#pragma unroll
                for (int m = 0; m < 4; ++m)
#pragma unroll
                    for (int n = 0; n < 2; ++n) acc[a][b][m][n] = (f32x4){0.f, 0.f, 0.f, 0.f};
        cur = nxt; cA = nA; cB = nB; ++ui;
        if constexpr (ALIGN_EPI) { if (wr == 1) PG8_BAR; }
    }
    PG8_WAIT_V(0);
    if constexpr (!ALIGN_EPI) { if (wr == 0) PG8_BAR; }
    PG8_BAR;
    if constexpr (Epi::AFTER_DRAIN) { E.fused(acc, cur, wr, wc, fr, fq, lds, wid, lane); S.done(cur); }
#undef PG8_SA
#undef PG8_SB
#undef PG8_STAGE
#undef PG8_LDA
#undef PG8_LDB
#undef PG8_MMA
#undef PG8_WAIT_V
#undef PG8_WAIT_L
#undef PG8_BAR
#undef PG8_SCHED
}
}

constexpr int NWAVES = 8;
constexpr int BATCH = 4, T = 4096, D = 1024, NH = 8, HD = 64, NIN = 5120;
constexpr int M = BATCH * T;
constexpr int NEXP = 16384;
constexpr float RMS_EPS = 1e-6f;
#ifndef MK_N_LAUNCHES
#define MK_N_LAUNCHES 1
#endif
constexpr int N_PHASES = 11;
constexpr int N_LAUNCHES = MK_N_LAUNCHES;

constexpr size_t MiB = 1u << 20;
constexpr size_t WS_CTL = 0, CTL_ZERO_BYTES = 64 * 1024;
constexpr size_t WS_RSTD1 = 512 * 1024;
constexpr size_t WS_WEFF = 1 * MiB;
constexpr size_t WS_WAB = 5 * MiB;
constexpr size_t WS_WO = 7 * MiB;
constexpr size_t WS_WIN = 9 * MiB;
constexpr size_t WS_XB = 19 * MiB;
constexpr size_t WS_SIX = 51 * MiB;
constexpr size_t WS_VT = WS_SIX + 3 * 16 * MiB;
constexpr size_t WS_GATE = 147 * MiB;
constexpr size_t WS_MERGED = 19 * MiB;
constexpr size_t WS_X1B = 51 * MiB;
constexpr size_t WS_TU = 211 * MiB, WS_TV = 227 * MiB;
constexpr size_t WS_SU = 576 * 1024, WS_SV = 640 * 1024;
constexpr size_t WS_SCORES = 83 * MiB;
constexpr size_t WS_ROUTE = 19 * MiB;
constexpr size_t WS_W = 35 * MiB;
constexpr size_t WS_SS = 43 * MiB;
constexpr size_t WS_UPART = 83 * MiB;
constexpr size_t WS_END = 256 * MiB;
constexpr int CW_BAR = 4096;

constexpr int RING_OFF = 0, RING_BYTES = 131072;
constexpr int LDSCTL_OFF = RING_BYTES;
constexpr int LDS_BYTES = 147456;
constexpr int MISC_OFF = LDS_BYTES - 128;

#define GAS __attribute__((address_space(1)))
#define LAS __attribute__((address_space(3)))
#define CAS __attribute__((address_space(4)))
typedef unsigned short bf16;
typedef unsigned v4u __attribute__((ext_vector_type(4)));
typedef unsigned v2u __attribute__((ext_vector_type(2)));
typedef float f32x4 __attribute__((ext_vector_type(4)));
typedef float f32x2 __attribute__((ext_vector_type(2)));
typedef float f32x16 __attribute__((ext_vector_type(16)));
typedef short bf16x8 __attribute__((ext_vector_type(8)));
typedef _Float16 f16x8 __attribute__((ext_vector_type(8)));
typedef _Float16 f16x2 __attribute__((ext_vector_type(2)));
typedef __bf16 bf16x2_t __attribute__((ext_vector_type(2)));
typedef GAS unsigned gu32;
#define RLX_AGENT __ATOMIC_RELAXED, __HIP_MEMORY_SCOPE_AGENT
#define LDS_WAIT() asm volatile("s_waitcnt lgkmcnt(0)" ::: "memory")
#define VM_WAIT() asm volatile("s_waitcnt vmcnt(0)" ::: "memory")
__device__ __forceinline__ unsigned f2bf(float f) { unsigned u = __builtin_bit_cast(unsigned, f); return (u + 0x7fffu + ((u >> 16) & 1u)) >> 16; }
__device__ __forceinline__ unsigned pk2(float lo, float hi) { return f2bf(lo) | (f2bf(hi) << 16); }
__device__ __forceinline__ unsigned cvtpk(float lo, float hi) { f32x2 v = {lo, hi}; bf16x2_t b = __builtin_convertvector(v, bf16x2_t); return __builtin_bit_cast(unsigned, b); }
__device__ __forceinline__ float bflo(unsigned w) { return __builtin_bit_cast(float, w << 16); }
__device__ __forceinline__ float bfhi(unsigned w) { return __builtin_bit_cast(float, w & 0xffff0000u); }
__device__ __forceinline__ float wave_sum(float v) {
#pragma unroll
    for (int o = 1; o < 64; o <<= 1) v += __shfl_xor(v, o);
    return v;
}
#define XB_TMO      128
#define XB_XCNT(j)  (256  + 64 * (j))
#define XB_XSUB(j)  (1280 + 64 * (j))
#define XB_XGEN(j)  (2304 + 64 * (j))
#define XB_TOP      3328
#define XB_TOPGEN   3392
#define XCD_BAR_WORDS 3456
#define XB_SPIN_CAP (1u << 18)

__device__ __forceinline__ unsigned xb_ld(unsigned* p)              { return __hip_atomic_load(p, __ATOMIC_RELAXED, __HIP_MEMORY_SCOPE_AGENT); }
__device__ __forceinline__ unsigned xb_add(unsigned* p, unsigned v) { return __hip_atomic_fetch_add(p, v, __ATOMIC_RELAXED, __HIP_MEMORY_SCOPE_AGENT); }
__device__ __forceinline__ unsigned xb_xcc_id() { return (unsigned)__builtin_amdgcn_s_getreg((3 << 11) | 20) & 0xFu; }
#define XB_SPIN(cond, bar) do { unsigned _sp = 0; while (cond) { __builtin_amdgcn_s_sleep(1); \
    if ((++_sp & 255u) == 0u) { if (xb_ld(&(bar)[XB_TMO])) break; if (_sp > XB_SPIN_CAP) { atomicAdd(&(bar)[XB_TMO], 1u); break; } } } } while (0)

struct XcdBarrier {
    unsigned* bar; unsigned x;
    volatile LAS unsigned* st;
};

__device__ __forceinline__ XcdBarrier xcd_barrier_post(unsigned* bar, volatile LAS unsigned* st) {
    XcdBarrier b; b.bar = bar; b.x = xb_xcc_id(); b.st = st;
    if (threadIdx.x == 0) (void)xb_add(&bar[XB_XCNT(b.x)], 1u);
    return b;
}
__device__ __forceinline__ void xcd_barrier_complete(unsigned* bar, unsigned x, unsigned& nloc, unsigned& nx) {
    const unsigned G = gridDim.x * gridDim.y * gridDim.z;
    unsigned sum, cnt, mine, sp = 0u;
    for (;;) {
        sum = 0u; cnt = 0u; mine = 0u;
#pragma unroll
        for (unsigned j = 0; j < 16; ++j) { const unsigned c = xb_ld(&bar[XB_XCNT(j)]); sum += c; cnt += (c > 0u) ? 1u : 0u; mine = (j == x) ? c : mine; }
        if (sum == G) break;
        __builtin_amdgcn_s_sleep(1);
        if ((++sp & 255u) == 0u) { if (xb_ld(&bar[XB_TMO])) break; if (sp > XB_SPIN_CAP) { atomicAdd(&bar[XB_TMO], 1u); break; } }
    }
    nloc = mine > 0u ? mine : 1u; nx = cnt > 0u ? cnt : 1u;
}

__device__ __forceinline__ void xcd_barrier(const XcdBarrier& b) {
    asm volatile("s_waitcnt vmcnt(0)" ::: "memory");
    __syncthreads();
    if (threadIdx.x == 0) {
        unsigned* bar = b.bar;
        __builtin_amdgcn_s_waitcnt(0);
        unsigned nloc = b.st[0], nx = b.st[1];
        if (nloc == 0u) { xcd_barrier_complete(bar, b.x, nloc, nx); b.st[0] = nloc; b.st[1] = nx; }
        const unsigned old = xb_add(&bar[XB_XSUB(b.x)], 1u);
        const unsigned gen = old / nloc;
        if (old + 1u == (gen + 1u) * nloc) {
            __builtin_amdgcn_fence(__ATOMIC_RELEASE, "agent");
            asm volatile("s_waitcnt vmcnt(0)" ::: "memory");
            const unsigned og = xb_add(&bar[XB_TOP], 1u);
            const unsigned tg = og / nx;
            if (og + 1u == (tg + 1u) * nx) xb_add(&bar[XB_TOPGEN], 1u);
            else XB_SPIN(xb_ld(&bar[XB_TOPGEN]) == tg, bar);
            __builtin_amdgcn_fence(__ATOMIC_ACQUIRE, "agent");
            xb_add(&bar[XB_XGEN(b.x)], 1u);
            asm volatile("s_waitcnt vmcnt(0)" ::: "memory");
        } else {
            XB_SPIN(xb_ld(&bar[XB_XGEN(b.x)]) == gen, bar);
            __builtin_amdgcn_fence(__ATOMIC_ACQUIRE, "agent");
            asm volatile("s_waitcnt vmcnt(0)" ::: "memory");
        }
    }
    __syncthreads();
}

__device__ __forceinline__ void p0_transpose_item(const float* W, int K, int N, bf16* WT, int row_off, const float* kscale, LAS float* scr, int item, int lane) {
    const int nblk = N / 32, kb = item / nblk, nb = item % nblk, k0 = 64 * kb, n0 = 32 * nb;
    f32x4 ld[8];
#pragma unroll
    for (int i = 0; i < 8; ++i) ld[i] = __builtin_nontemporal_load((const GAS f32x4*)(W + (size_t)(k0 + 8 * i + (lane >> 3)) * N + n0 + 4 * (lane & 7)));
#pragma unroll
    for (int i = 0; i < 8; ++i) { LAS float* d = scr + (8 * i + (lane >> 3)) * 33 + 4 * (lane & 7); d[0] = ld[i].x; d[1] = ld[i].y; d[2] = ld[i].z; d[3] = ld[i].w; }
    LDS_WAIT(); asm volatile("" ::: "memory");
    const int c = lane & 7;
    float ks[8];
#pragma unroll
    for (int i = 0; i < 8; ++i) ks[i] = kscale ? kscale[k0 + 8 * c + i] : 1.0f;
#pragma unroll
    for (int j = 0; j < 4; ++j) { const int n = (lane >> 3) + 8 * j; const LAS float* s = scr + (8 * c) * 33 + n;
        v4u o; o.x = pk2(s[0 * 33] * ks[0], s[1 * 33] * ks[1]); o.y = pk2(s[2 * 33] * ks[2], s[3 * 33] * ks[3]); o.z = pk2(s[4 * 33] * ks[4], s[5 * 33] * ks[5]); o.w = pk2(s[6 * 33] * ks[6], s[7 * 33] * ks[7]);
        *(GAS v4u*)(WT + (size_t)(row_off + n0 + n) * K + k0 + 8 * c) = o; }
    LDS_WAIT(); asm volatile("" ::: "memory");
}

__device__ __forceinline__ void conv_phase(const bf16* CB, const bf16* CC, const bf16* CU, bf16* CO, const float* cw, const float* cbias, int gtid, int nthreads) {
    for (int task = gtid; task < M * 64; task += nthreads) {
        const int tok = task >> 6, c8 = (task & 63) * 8, tt = tok & (T - 1);
        const size_t off = (size_t)tok * 512 + c8;
        float z[3][8];
#pragma unroll
        for (int k = 0; k < 3; ++k) {
            const int dt = 2 - k;
            if (tt >= dt) { const v4u a = *(const GAS v4u*)(CC + off - (size_t)dt * 512), b = *(const GAS v4u*)(CU + off - (size_t)dt * 512);
                z[k][0] = bflo(a.x) * bflo(b.x); z[k][1] = bfhi(a.x) * bfhi(b.x); z[k][2] = bflo(a.y) * bflo(b.y); z[k][3] = bfhi(a.y) * bfhi(b.y);
                z[k][4] = bflo(a.z) * bflo(b.z); z[k][5] = bfhi(a.z) * bfhi(b.z); z[k][6] = bflo(a.w) * bflo(b.w); z[k][7] = bfhi(a.w) * bfhi(b.w); }
            else {
#pragma unroll
                for (int i = 0; i < 8; ++i) z[k][i] = 0.f; }
        }
        float y[8];
#pragma unroll
        for (int i = 0; i < 8; ++i) y[i] = cbias[c8 + i];
#pragma unroll
        for (int k = 0; k < 3; ++k)
#pragma unroll
            for (int i = 0; i < 8; ++i) y[i] += cw[k * 512 + c8 + i] * z[k][i];
        const v4u g = *(const GAS v4u*)(CB + off);
        v4u o; o.x = pk2(bflo(g.x) * y[0], bfhi(g.x) * y[1]); o.y = pk2(bflo(g.y) * y[2], bfhi(g.y) * y[3]); o.z = pk2(bflo(g.z) * y[4], bfhi(g.z) * y[5]); o.w = pk2(bflo(g.w) * y[6], bfhi(g.w) * y[7]);
        *(GAS v4u*)(CO + off) = o;
    }
}

__device__ __forceinline__ int crow(int r, int hf) { return (r & 3) + 8 * (r >> 2) + 4 * hf; }
#define MFMA_BF16(a, b, c) __builtin_amdgcn_mfma_f32_32x32x16_bf16((a), (b), (c), 0, 0, 0)
#define MFMA_F16(a, b, c) __builtin_amdgcn_mfma_f32_32x32x16_f16((a), (b), (c), 0, 0, 0)
__device__ __forceinline__ void attn_item(const bf16* Qb, const bf16* Kb, const bf16* VT, bf16* Ob, int b, int h, int qblk, LAS unsigned char* scr, int lane) {
    const int t32 = lane & 31, hf = lane >> 5, q0 = qblk * 32, tq = q0 + t32;
    const size_t rowbase = (size_t)b * T;
    const float LOG2E = 1.4426950408889634f, LN2 = 0.6931471805599453f;
    bf16x8 qf[4];
    { const bf16* qp = Qb + (rowbase + q0 + t32) * 512 + h * 64 + 8 * hf;
#pragma unroll
      for (int st = 0; st < 4; ++st) qf[st] = *(const GAS bf16x8*)(qp + 16 * st); }
    f16x8 tri[2];
#pragma unroll
    for (int st = 0; st < 2; ++st)
#pragma unroll
        for (int e = 0; e < 8; ++e) { const int j = 16 * st + 8 * (e >> 2) + 4 * hf + (e & 3); tri[st][e] = (j >= t32) ? (_Float16)1.0f : (_Float16)0.0f; }
    f32x16 o0, o1;
#pragma unroll
    for (int r = 0; r < 16; ++r) { o0[r] = 0.f; o1[r] = 0.f; }
    float R = 0.f;
    const bf16* kld = Kb + (rowbase + (lane >> 3)) * 512 + h * 64 + 8 * (lane & 7);
    const bf16* vld = VT + ((size_t)(b * 8 + h) * 64 + (lane >> 3)) * T + 8 * (lane & 7);
    LAS unsigned char* stw = scr + (lane >> 3) * 144 + 16 * (lane & 7);
    const LAS unsigned char* kfr = scr + t32 * 144 + 16 * hf;
    const LAS unsigned char* vfr = scr + t32 * 144 + 8 * hf;
    for (int jt = q0 >> 6; jt >= 0; --jt) {
        const int k0 = jt * 64;
        f32x16 s0, s1;
#pragma unroll
        for (int r = 0; r < 16; ++r) { s0[r] = 0.f; s1[r] = 0.f; }
        { v4u kl[8], vl[8];
#pragma unroll
          for (int i = 0; i < 8; ++i) { kl[i] = *(const GAS v4u*)(kld + (size_t)(k0 + 8 * i) * 512); vl[i] = *(const GAS v4u*)(vld + (size_t)(8 * i) * T + k0); }
#pragma unroll
          for (int i = 0; i < 8; ++i) *(LAS v4u*)(stw + i * (8 * 144)) = kl[i];
          LDS_WAIT();
          bf16x8 ka0[4], ka1[4];
#pragma unroll
          for (int st = 0; st < 4; ++st) { ka0[st] = *(const LAS bf16x8*)(kfr + 32 * st); ka1[st] = *(const LAS bf16x8*)(kfr + 32 * 144 + 32 * st); }
          LDS_WAIT();
#pragma unroll
          for (int i = 0; i < 8; ++i) *(LAS v4u*)(stw + i * (8 * 144)) = vl[i];
#pragma unroll
          for (int st = 0; st < 4; ++st) { s0 = MFMA_BF16(ka0[st], qf[st], s0); s1 = MFMA_BF16(ka1[st], qf[st], s1); }
        }
        f32x16 L0, L1; float tot0 = 0.f, tot1 = 0.f;
#pragma unroll
        for (int r = 0; r < 16; ++r) {
            const int key = k0 + crow(r, hf);
            { const float z = s0[r]; const float e = __builtin_amdgcn_exp2f(-__builtin_fabsf(z) * LOG2E); const float lp = __builtin_amdgcn_logf(1.0f + e) * LN2;
              const float L = (key < tq) ? -(__builtin_fmaxf(z, 0.f) + lp) : 0.f; L0[r] = L; tot0 += L; }
            { const float z = s1[r]; const float e = __builtin_amdgcn_exp2f(-__builtin_fabsf(z) * LOG2E); const float lp = __builtin_amdgcn_logf(1.0f + e) * LN2;
              const float L = (key + 32 < tq) ? -(__builtin_fmaxf(z, 0.f) + lp) : 0.f; L1[r] = L; tot1 += L; }
        }
        tot0 += __shfl_xor(tot0, 32); tot1 += __shfl_xor(tot1, 32);
        f16x8 lf00, lf01, lf10, lf11;
#pragma unroll
        for (int e = 0; e < 8; ++e) { lf00[e] = (_Float16)L0[e]; lf01[e] = (_Float16)L0[8 + e]; lf10[e] = (_Float16)L1[e]; lf11[e] = (_Float16)L1[8 + e]; }
        f32x16 y0, y1;
#pragma unroll
        for (int r = 0; r < 16; ++r) { y0[r] = 0.f; y1[r] = 0.f; }
        y0 = MFMA_F16(tri[0], lf00, y0); y0 = MFMA_F16(tri[1], lf01, y0);
        y1 = MFMA_F16(tri[0], lf10, y1); y1 = MFMA_F16(tri[1], lf11, y1);
        const float base0 = R + tot1, base1 = R;
        float a0v[16], a1v[16];
#pragma unroll
        for (int r = 0; r < 16; ++r) {
            const int key = k0 + crow(r, hf);
            a0v[r] = (key < tq) ? __builtin_amdgcn_exp2f((s0[r] + y0[r] + base0) * LOG2E) : 0.f;
            a1v[r] = (key + 32 < tq) ? __builtin_amdgcn_exp2f((s1[r] + y1[r] + base1) * LOG2E) : 0.f;
        }
        bf16x8 pf[2][2];
#pragma unroll
        for (int st = 0; st < 2; ++st) {
            v4u w0, w1;
            w0.x = cvtpk(a0v[8 * st + 0], a0v[8 * st + 1]); w0.y = cvtpk(a0v[8 * st + 2], a0v[8 * st + 3]); w0.z = cvtpk(a0v[8 * st + 4], a0v[8 * st + 5]); w0.w = cvtpk(a0v[8 * st + 6], a0v[8 * st + 7]);
            w1.x = cvtpk(a1v[8 * st + 0], a1v[8 * st + 1]); w1.y = cvtpk(a1v[8 * st + 2], a1v[8 * st + 3]); w1.z = cvtpk(a1v[8 * st + 4], a1v[8 * st + 5]); w1.w = cvtpk(a1v[8 * st + 6], a1v[8 * st + 7]);
            pf[0][st] = __builtin_bit_cast(bf16x8, w0); pf[1][st] = __builtin_bit_cast(bf16x8, w1);
        }
#pragma unroll
        for (int kb = 0; kb < 2; ++kb)
#pragma unroll
            for (int st = 0; st < 2; ++st) {
                const int kk2 = 2 * (32 * kb + 16 * st);
                { const v2u lo = *(const LAS v2u*)(vfr + kk2), hi = *(const LAS v2u*)(vfr + kk2 + 16); v4u w; w.x = lo.x; w.y = lo.y; w.z = hi.x; w.w = hi.y;
                  o0 = MFMA_BF16(__builtin_bit_cast(bf16x8, w), pf[kb][st], o0); }
                { const v2u lo = *(const LAS v2u*)(vfr + 32 * 144 + kk2), hi = *(const LAS v2u*)(vfr + 32 * 144 + kk2 + 16); v4u w; w.x = lo.x; w.y = lo.y; w.z = hi.x; w.w = hi.y;
                  o1 = MFMA_BF16(__builtin_bit_cast(bf16x8, w), pf[kb][st], o1); }
            }
        R += tot0 + tot1;
        LDS_WAIT();
        if (__all(R < -104.0f)) break;
    }
    bf16* op = Ob + (rowbase + q0 + t32) * 512 + h * 64 + 4 * hf;
#pragma unroll
    for (int q4 = 0; q4 < 4; ++q4) {
        v2u w; w.x = cvtpk(o0[4 * q4], o0[4 * q4 + 1]); w.y = cvtpk(o0[4 * q4 + 2], o0[4 * q4 + 3]); *(GAS v2u*)(op + 8 * q4) = w;
        v2u w2; w2.x = cvtpk(o1[4 * q4], o1[4 * q4 + 1]); w2.y = cvtpk(o1[4 * q4 + 2], o1[4 * q4 + 3]); *(GAS v2u*)(op + 32 + 8 * q4) = w2;
    }
}

#define RT_C8(op_str, cnt, x0, x1, x2, x3, x4, x5, x6, x7, thr) asm volatile(op_str : "+v"(cnt) : "v"(x0), "v"(x1), "v"(x2), "v"(x3), "v"(x4), "v"(x5), "v"(x6), "v"(x7), "v"(thr) : "vcc")
#define RT_GE8 "v_cmp_ge_f32 vcc, %1, %9\n\tv_addc_co_u32_e32 %0, vcc, 0, %0, vcc\n\tv_cmp_ge_f32 vcc, %2, %9\n\tv_addc_co_u32_e32 %0, vcc, 0, %0, vcc\n\tv_cmp_ge_f32 vcc, %3, %9\n\tv_addc_co_u32_e32 %0, vcc, 0, %0, vcc\n\tv_cmp_ge_f32 vcc, %4, %9\n\tv_addc_co_u32_e32 %0, vcc, 0, %0, vcc\n\tv_cmp_ge_f32 vcc, %5, %9\n\tv_addc_co_u32_e32 %0, vcc, 0, %0, vcc\n\tv_cmp_ge_f32 vcc, %6, %9\n\tv_addc_co_u32_e32 %0, vcc, 0, %0, vcc\n\tv_cmp_ge_f32 vcc, %7, %9\n\tv_addc_co_u32_e32 %0, vcc, 0, %0, vcc\n\tv_cmp_ge_f32 vcc, %8, %9\n\tv_addc_co_u32_e32 %0, vcc, 0, %0, vcc"
#define RT_GT8 "v_cmp_gt_f32 vcc, %1, %9\n\tv_addc_co_u32_e32 %0, vcc, 0, %0, vcc\n\tv_cmp_gt_f32 vcc, %2, %9\n\tv_addc_co_u32_e32 %0, vcc, 0, %0, vcc\n\tv_cmp_gt_f32 vcc, %3, %9\n\tv_addc_co_u32_e32 %0, vcc, 0, %0, vcc\n\tv_cmp_gt_f32 vcc, %4, %9\n\tv_addc_co_u32_e32 %0, vcc, 0, %0, vcc\n\tv_cmp_gt_f32 vcc, %5, %9\n\tv_addc_co_u32_e32 %0, vcc, 0, %0, vcc\n\tv_cmp_gt_f32 vcc, %6, %9\n\tv_addc_co_u32_e32 %0, vcc, 0, %0, vcc\n\tv_cmp_gt_f32 vcc, %7, %9\n\tv_addc_co_u32_e32 %0, vcc, 0, %0, vcc\n\tv_cmp_gt_f32 vcc, %8, %9\n\tv_addc_co_u32_e32 %0, vcc, 0, %0, vcc"
#define RT_COUNT128(OPS, cnt, thr) do { cnt = 0; RT_C8(OPS, cnt, v[0], v[1], v[2], v[3], v[4], v[5], v[6], v[7], thr); RT_C8(OPS, cnt, v[8], v[9], v[10], v[11], v[12], v[13], v[14], v[15], thr); RT_C8(OPS, cnt, v[16], v[17], v[18], v[19], v[20], v[21], v[22], v[23], thr); RT_C8(OPS, cnt, v[24], v[25], v[26], v[27], v[28], v[29], v[30], v[31], thr); RT_C8(OPS, cnt, v[32], v[33], v[34], v[35], v[36], v[37], v[38], v[39], thr); RT_C8(OPS, cnt, v[40], v[41], v[42], v[43], v[44], v[45], v[46], v[47], thr); RT_C8(OPS, cnt, v[48], v[49], v[50], v[51], v[52], v[53], v[54], v[55], thr); RT_C8(OPS, cnt, v[56], v[57], v[58], v[59], v[60], v[61], v[62], v[63], thr); RT_C8(OPS, cnt, v[64], v[65], v[66], v[67], v[68], v[69], v[70], v[71], thr); RT_C8(OPS, cnt, v[72], v[73], v[74], v[75], v[76], v[77], v[78], v[79], thr); RT_C8(OPS, cnt, v[80], v[81], v[82], v[83], v[84], v[85], v[86], v[87], thr); RT_C8(OPS, cnt, v[88], v[89], v[90], v[91], v[92], v[93], v[94], v[95], thr); RT_C8(OPS, cnt, v[96], v[97], v[98], v[99], v[100], v[101], v[102], v[103], thr); RT_C8(OPS, cnt, v[104], v[105], v[106], v[107], v[108], v[109], v[110], v[111], thr); RT_C8(OPS, cnt, v[112], v[113], v[114], v[115], v[116], v[117], v[118], v[119], thr); RT_C8(OPS, cnt, v[120], v[121], v[122], v[123], v[124], v[125], v[126], v[127], thr); } while (0)
#define RT_S5(op_str, cnt, a0, a1, a2, a3, a4, b0, b1, b2, b3, b4, thr) do { float t_; asm volatile(op_str : "+v"(cnt), "=&v"(t_) : "v"(a0), "v"(a1), "v"(a2), "v"(a3), "v"(a4), "v"(b0), "v"(b1), "v"(b2), "v"(b3), "v"(b4), "v"(thr) : "vcc"); } while (0)
#define RT_SGE5 "v_add_f32_e32 %1, %2, %7\n\tv_cmp_ge_f32 vcc, %1, %12\n\tv_addc_co_u32_e32 %0, vcc, 0, %0, vcc\n\tv_add_f32_e32 %1, %3, %8\n\tv_cmp_ge_f32 vcc, %1, %12\n\tv_addc_co_u32_e32 %0, vcc, 0, %0, vcc\n\tv_add_f32_e32 %1, %4, %9\n\tv_cmp_ge_f32 vcc, %1, %12\n\tv_addc_co_u32_e32 %0, vcc, 0, %0, vcc\n\tv_add_f32_e32 %1, %5, %10\n\tv_cmp_ge_f32 vcc, %1, %12\n\tv_addc_co_u32_e32 %0, vcc, 0, %0, vcc\n\tv_add_f32_e32 %1, %6, %11\n\tv_cmp_ge_f32 vcc, %1, %12\n\tv_addc_co_u32_e32 %0, vcc, 0, %0, vcc"
#define RT_SGT5 "v_add_f32_e32 %1, %2, %7\n\tv_cmp_gt_f32 vcc, %1, %12\n\tv_addc_co_u32_e32 %0, vcc, 0, %0, vcc\n\tv_add_f32_e32 %1, %3, %8\n\tv_cmp_gt_f32 vcc, %1, %12\n\tv_addc_co_u32_e32 %0, vcc, 0, %0, vcc\n\tv_add_f32_e32 %1, %4, %9\n\tv_cmp_gt_f32 vcc, %1, %12\n\tv_addc_co_u32_e32 %0, vcc, 0, %0, vcc\n\tv_add_f32_e32 %1, %5, %10\n\tv_cmp_gt_f32 vcc, %1, %12\n\tv_addc_co_u32_e32 %0, vcc, 0, %0, vcc\n\tv_add_f32_e32 %1, %6, %11\n\tv_cmp_gt_f32 vcc, %1, %12\n\tv_addc_co_u32_e32 %0, vcc, 0, %0, vcc"
#define RT_COUNT50(OPS, cnt, thr) do { cnt = 0; RT_S5(OPS, cnt, a[0], a[0], a[0], a[0], a[0], b[0], b[1], b[2], b[3], b[4], thr); RT_S5(OPS, cnt, a[0], a[0], a[0], a[0], a[0], b[5], b[6], b[7], b[8], b[9], thr); RT_S5(OPS, cnt, a[0], a[0], a[0], a[0], a[0], b[10], b[11], b[12], b[13], b[14], thr); RT_S5(OPS, cnt, a[0], a[1], a[1], a[1], a[1], b[15], b[0], b[1], b[2], b[3], thr); RT_S5(OPS, cnt, a[1], a[1], a[1], a[1], a[2], b[4], b[5], b[6], b[7], b[0], thr); RT_S5(OPS, cnt, a[2], a[2], a[2], a[2], a[3], b[1], b[2], b[3], b[4], b[0], thr); RT_S5(OPS, cnt, a[3], a[3], a[3], a[4], a[4], b[1], b[2], b[3], b[0], b[1], thr); RT_S5(OPS, cnt, a[4], a[5], a[5], a[6], a[6], b[2], b[0], b[1], b[0], b[1], thr); RT_S5(OPS, cnt, a[7], a[7], a[8], a[9], a[10], b[0], b[1], b[0], b[0], b[0], thr); RT_S5(OPS, cnt, a[11], a[12], a[13], a[14], a[15], b[0], b[0], b[0], b[0], b[0], thr); } while (0)
#define RT_CSWAP(x, xi, p, q) do { float t_; asm volatile("v_cmp_gt_f32 vcc, %1, %0\n\tv_cndmask_b32_e32 %4, %0, %1, vcc\n\tv_cndmask_b32_e32 %1, %1, %0, vcc\n\tv_mov_b32_e32 %0, %4\n\tv_cndmask_b32_e32 %4, %2, %3, vcc\n\tv_cndmask_b32_e32 %3, %3, %2, vcc\n\tv_mov_b32_e32 %2, %4" : "+v"(x[p]), "+v"(x[q]), "+v"(xi[p]), "+v"(xi[q]), "=&v"(t_) : : "vcc"); } while (0)
#define RT_SORT16(x, xi) do { RT_CSWAP(x, xi, 0, 1); RT_CSWAP(x, xi, 2, 3); RT_CSWAP(x, xi, 0, 2); RT_CSWAP(x, xi, 1, 3); RT_CSWAP(x, xi, 1, 2); RT_CSWAP(x, xi, 4, 5); RT_CSWAP(x, xi, 6, 7); RT_CSWAP(x, xi, 4, 6); RT_CSWAP(x, xi, 5, 7); RT_CSWAP(x, xi, 5, 6); RT_CSWAP(x, xi, 0, 4); RT_CSWAP(x, xi, 2, 6); RT_CSWAP(x, xi, 2, 4); RT_CSWAP(x, xi, 1, 5); RT_CSWAP(x, xi, 3, 7); RT_CSWAP(x, xi, 3, 5); RT_CSWAP(x, xi, 1, 2); RT_CSWAP(x, xi, 3, 4); RT_CSWAP(x, xi, 5, 6); RT_CSWAP(x, xi, 8, 9); RT_CSWAP(x, xi, 10, 11); RT_CSWAP(x, xi, 8, 10); RT_CSWAP(x, xi, 9, 11); RT_CSWAP(x, xi, 9, 10); RT_CSWAP(x, xi, 12, 13); RT_CSWAP(x, xi, 14, 15); RT_CSWAP(x, xi, 12, 14); RT_CSWAP(x, xi, 13, 15); RT_CSWAP(x, xi, 13, 14); RT_CSWAP(x, xi, 8, 12); RT_CSWAP(x, xi, 10, 14); RT_CSWAP(x, xi, 10, 12); RT_CSWAP(x, xi, 9, 13); RT_CSWAP(x, xi, 11, 15); RT_CSWAP(x, xi, 11, 13); RT_CSWAP(x, xi, 9, 10); RT_CSWAP(x, xi, 11, 12); RT_CSWAP(x, xi, 13, 14); RT_CSWAP(x, xi, 0, 8); RT_CSWAP(x, xi, 4, 12); RT_CSWAP(x, xi, 4, 8); RT_CSWAP(x, xi, 2, 10); RT_CSWAP(x, xi, 6, 14); RT_CSWAP(x, xi, 6, 10); RT_CSWAP(x, xi, 2, 4); RT_CSWAP(x, xi, 6, 8); RT_CSWAP(x, xi, 10, 12); RT_CSWAP(x, xi, 1, 9); RT_CSWAP(x, xi, 5, 13); RT_CSWAP(x, xi, 5, 9); RT_CSWAP(x, xi, 3, 11); RT_CSWAP(x, xi, 7, 15); RT_CSWAP(x, xi, 7, 11); RT_CSWAP(x, xi, 3, 5); RT_CSWAP(x, xi, 7, 9); RT_CSWAP(x, xi, 11, 13); RT_CSWAP(x, xi, 1, 2); RT_CSWAP(x, xi, 3, 4); RT_CSWAP(x, xi, 5, 6); RT_CSWAP(x, xi, 7, 8); RT_CSWAP(x, xi, 9, 10); RT_CSWAP(x, xi, 11, 12); RT_CSWAP(x, xi, 13, 14); } while (0)
#define RT_FOR_CANDS(F) F(0, 0) F(0, 1) F(0, 2) F(0, 3) F(0, 4) F(0, 5) F(0, 6) F(0, 7) F(0, 8) F(0, 9) F(0, 10) F(0, 11) F(0, 12) F(0, 13) F(0, 14) F(0, 15) F(1, 0) F(1, 1) F(1, 2) F(1, 3) F(1, 4) F(1, 5) F(1, 6) F(1, 7) F(2, 0) F(2, 1) F(2, 2) F(2, 3) F(2, 4) F(3, 0) F(3, 1) F(3, 2) F(3, 3) F(4, 0) F(4, 1) F(4, 2) F(5, 0) F(5, 1) F(6, 0) F(6, 1) F(7, 0) F(7, 1) F(8, 0) F(9, 0) F(10, 0) F(11, 0) F(12, 0) F(13, 0) F(14, 0) F(15, 0)
#define RT_SEARCH(COUNT_MACRO, NTOT) \
    for (int it_ = 0; it_ < 400 && __any(!done); ++it_) { \
        const float w_ = hi - lo; float t_ = ((float)(clo - 16) + 0.5f) * __builtin_amdgcn_rcpf((float)(clo - chi)); t_ = __builtin_fminf(__builtin_fmaxf(t_, 0.125f), 0.875f); \
        float x_ = lo + w_ * t_; if (!(x_ > lo && x_ < hi)) x_ = 0.5f * lo + 0.5f * hi; const bool stuck_ = !(x_ > lo && x_ < hi); \
        int c_; COUNT_MACRO(c_, x_); \
        if (!done) { if (stuck_) { Tv = lo; done = true; } else if (c_ == 16) { Tv = x_; done = true; } else if (c_ > 16) { lo = x_; clo = c_; } else { hi = x_; chi = c_; } } } \
    if (!done) Tv = lo;
#define RT_CNT128_GE(c, x) RT_COUNT128(RT_GE8, c, x)
#define RT_CNT50_GE(c, x) RT_COUNT50(RT_SGE5, c, x)
__device__ __forceinline__ void lane_top16_of_128(const float (&v)[128], LAS unsigned char* sb) {
    float mx = v[0], mn = v[0];
#pragma unroll
    for (int i = 1; i < 128; ++i) { mx = __builtin_fmaxf(mx, v[i]); mn = __builtin_fminf(mn, v[i]); }
    float lo = mn, hi = mx, Tv = mn; int clo = 128, chi; bool done;
    RT_CNT128_GE(chi, mx); done = (chi >= 16); if (done) Tv = mx;
    RT_SEARCH(RT_CNT128_GE, 128)
    int cgt; RT_COUNT128(RT_GT8, cgt, Tv);
    const int need = 16 - cgt; int cnt = 0, idx = 0;
#pragma unroll
    for (int i = 0; i < 128; ++i) {
        asm volatile("" : "+v"(Tv), "+v"(cnt), "+v"(idx));
        LAS unsigned char* q = sb + cnt * 512; *(LAS float*)q = v[i]; *(LAS int*)(q + 4) = idx;
        cnt += (v[i] > Tv) ? 1 : 0; idx += 1;
    }
    if (__any(need > 0)) {
        idx = 0;
#pragma unroll
        for (int i = 0; i < 128; ++i) { asm volatile("" : "+v"(Tv), "+v"(cnt), "+v"(idx));
            if (v[i] == Tv && cnt < 16) { LAS unsigned char* q = sb + cnt * 512; *(LAS float*)q = v[i]; *(LAS int*)(q + 4) = idx; cnt += 1; } idx += 1; }
    }
}
__device__ __forceinline__ int opaque_zero() { int z = 0; asm volatile("" : "+v"(z)); return z; }
__device__ __forceinline__ void route_task_search(const float* SCT, v2u* ROUTE, int tok0, int h, LAS unsigned char* scr, int lane) {
    const int tok = tok0 + lane;
    LAS unsigned char* sb = scr + lane * 8;
#pragma unroll 1
    for (int p = 0; p < 2; ++p) {
        const int g = 2 * h + p; float v[128];
        const unsigned voff = (unsigned)tok * 16u;
#pragma unroll
        for (int k = 0; k < 32; ++k) { const char* bk = (const char*)SCT + ((size_t)(g * 32 + k) * M) * 16; const f32x4 q = *(const GAS f32x4*)(bk + voff); v[4 * k] = q.x; v[4 * k + 1] = q.y; v[4 * k + 2] = q.z; v[4 * k + 3] = q.w; }
        lane_top16_of_128(v, sb + p * 8704);
    }
    LDS_WAIT();
    float a[16], b[16]; int ai[16], bi[16];
#pragma unroll
    for (int i = 0; i < 16; ++i) { const v2u ea = *(LAS v2u*)(sb + i * 512), eb = *(LAS v2u*)(sb + 8704 + i * 512);
        a[i] = __builtin_bit_cast(float, ea.x); ai[i] = (int)ea.y; b[i] = __builtin_bit_cast(float, eb.x); bi[i] = (int)eb.y; }
    LDS_WAIT();
    RT_SORT16(a, ai); RT_SORT16(b, bi);
    float lo = a[15] + b[15], hi = a[0] + b[0], Tv = lo; int clo = 50, chi; bool done;
    RT_CNT50_GE(chi, hi); done = (chi >= 16); if (done) Tv = hi;
    RT_SEARCH(RT_CNT50_GE, 50)
    int cgt; RT_COUNT50(RT_SGT5, cgt, Tv);
    const int need = 16 - cgt; int cnt = 0;
#define RT_EXT(i, j) { asm volatile("" : "+v"(Tv), "+v"(cnt)); const float s_ = a[i] + b[j]; LAS unsigned char* q_ = sb + cnt * 512; *(LAS float*)q_ = s_; *(LAS int*)(q_ + 4) = ai[i] * 128 + bi[j]; cnt += (s_ > Tv) ? 1 : 0; }
    RT_FOR_CANDS(RT_EXT)
#undef RT_EXT
    if (__any(need > 0)) {
#define RT_EXT2(i, j) { asm volatile("" : "+v"(Tv), "+v"(cnt)); const float s_ = a[i] + b[j]; if (s_ == Tv && cnt < 16) { LAS unsigned char* q_ = sb + cnt * 512; *(LAS float*)q_ = s_; *(LAS int*)(q_ + 4) = ai[i] * 128 + bi[j]; cnt += 1; } }
        RT_FOR_CANDS(RT_EXT2)
#undef RT_EXT2
    }
    LDS_WAIT();
    GAS v4u* rp = (GAS v4u*)((GAS v2u*)ROUTE + (size_t)tok * 128 + h * 16);
#pragma unroll
    for (int i = 0; i < 8; ++i) { const v2u e0 = *(LAS v2u*)(sb + (2 * i) * 512), e1 = *(LAS v2u*)(sb + (2 * i + 1) * 512); v4u o; o.x = e0.y; o.y = e0.x; o.z = e1.y; o.w = e1.x; rp[i] = o; }
    LDS_WAIT();
}

#define RT2_CE(a, b) { const int t0_ = (a), t1_ = (b); (a) = t0_ > t1_ ? t0_ : t1_; (b) = t0_ > t1_ ? t1_ : t0_; }
#define RT2_MX(a, b) ((a) > (b) ? (a) : (b))
#define RT2_SORT16(k, B) do { RT2_CE(k[(B) + 0], k[(B) + 13]); RT2_CE(k[(B) + 1], k[(B) + 12]); RT2_CE(k[(B) + 2], k[(B) + 15]); RT2_CE(k[(B) + 3], k[(B) + 14]); RT2_CE(k[(B) + 4], k[(B) + 8]); RT2_CE(k[(B) + 5], k[(B) + 6]); RT2_CE(k[(B) + 7], k[(B) + 11]); RT2_CE(k[(B) + 9], k[(B) + 10]); RT2_CE(k[(B) + 0], k[(B) + 5]); RT2_CE(k[(B) + 1], k[(B) + 7]); RT2_CE(k[(B) + 2], k[(B) + 9]); RT2_CE(k[(B) + 3], k[(B) + 4]); RT2_CE(k[(B) + 6], k[(B) + 13]); RT2_CE(k[(B) + 8], k[(B) + 14]); RT2_CE(k[(B) + 10], k[(B) + 15]); RT2_CE(k[(B) + 11], k[(B) + 12]); RT2_CE(k[(B) + 0], k[(B) + 1]); RT2_CE(k[(B) + 2], k[(B) + 3]); RT2_CE(k[(B) + 4], k[(B) + 5]); RT2_CE(k[(B) + 6], k[(B) + 8]); RT2_CE(k[(B) + 7], k[(B) + 9]); RT2_CE(k[(B) + 10], k[(B) + 11]); RT2_CE(k[(B) + 12], k[(B) + 13]); RT2_CE(k[(B) + 14], k[(B) + 15]); RT2_CE(k[(B) + 0], k[(B) + 2]); RT2_CE(k[(B) + 1], k[(B) + 3]); RT2_CE(k[(B) + 4], k[(B) + 10]); RT2_CE(k[(B) + 5], k[(B) + 11]); RT2_CE(k[(B) + 6], k[(B) + 7]); RT2_CE(k[(B) + 8], k[(B) + 9]); RT2_CE(k[(B) + 12], k[(B) + 14]); RT2_CE(k[(B) + 13], k[(B) + 15]); RT2_CE(k[(B) + 1], k[(B) + 2]); RT2_CE(k[(B) + 3], k[(B) + 12]); RT2_CE(k[(B) + 4], k[(B) + 6]); RT2_CE(k[(B) + 5], k[(B) + 7]); RT2_CE(k[(B) + 8], k[(B) + 10]); RT2_CE(k[(B) + 9], k[(B) + 11]); RT2_CE(k[(B) + 13], k[(B) + 14]); RT2_CE(k[(B) + 1], k[(B) + 4]); RT2_CE(k[(B) + 2], k[(B) + 6]); RT2_CE(k[(B) + 5], k[(B) + 8]); RT2_CE(k[(B) + 7], k[(B) + 10]); RT2_CE(k[(B) + 9], k[(B) + 13]); RT2_CE(k[(B) + 11], k[(B) + 14]); RT2_CE(k[(B) + 2], k[(B) + 4]); RT2_CE(k[(B) + 3], k[(B) + 6]); RT2_CE(k[(B) + 9], k[(B) + 12]); RT2_CE(k[(B) + 11], k[(B) + 13]); RT2_CE(k[(B) + 3], k[(B) + 5]); RT2_CE(k[(B) + 6], k[(B) + 8]); RT2_CE(k[(B) + 7], k[(B) + 9]); RT2_CE(k[(B) + 10], k[(B) + 12]); RT2_CE(k[(B) + 3], k[(B) + 4]); RT2_CE(k[(B) + 5], k[(B) + 6]); RT2_CE(k[(B) + 7], k[(B) + 8]); RT2_CE(k[(B) + 9], k[(B) + 10]); RT2_CE(k[(B) + 11], k[(B) + 12]); RT2_CE(k[(B) + 6], k[(B) + 7]); RT2_CE(k[(B) + 8], k[(B) + 9]); } while (0)
#define RT2_BIT16(k, B) do { RT2_CE(k[(B) + 0], k[(B) + 8]); RT2_CE(k[(B) + 1], k[(B) + 9]); RT2_CE(k[(B) + 2], k[(B) + 10]); RT2_CE(k[(B) + 3], k[(B) + 11]); RT2_CE(k[(B) + 4], k[(B) + 12]); RT2_CE(k[(B) + 5], k[(B) + 13]); RT2_CE(k[(B) + 6], k[(B) + 14]); RT2_CE(k[(B) + 7], k[(B) + 15]); RT2_CE(k[(B) + 0], k[(B) + 4]); RT2_CE(k[(B) + 1], k[(B) + 5]); RT2_CE(k[(B) + 2], k[(B) + 6]); RT2_CE(k[(B) + 3], k[(B) + 7]); RT2_CE(k[(B) + 8], k[(B) + 12]); RT2_CE(k[(B) + 9], k[(B) + 13]); RT2_CE(k[(B) + 10], k[(B) + 14]); RT2_CE(k[(B) + 11], k[(B) + 15]); RT2_CE(k[(B) + 0], k[(B) + 2]); RT2_CE(k[(B) + 1], k[(B) + 3]); RT2_CE(k[(B) + 4], k[(B) + 6]); RT2_CE(k[(B) + 5], k[(B) + 7]); RT2_CE(k[(B) + 8], k[(B) + 10]); RT2_CE(k[(B) + 9], k[(B) + 11]); RT2_CE(k[(B) + 12], k[(B) + 14]); RT2_CE(k[(B) + 13], k[(B) + 15]); RT2_CE(k[(B) + 0], k[(B) + 1]); RT2_CE(k[(B) + 2], k[(B) + 3]); RT2_CE(k[(B) + 4], k[(B) + 5]); RT2_CE(k[(B) + 6], k[(B) + 7]); RT2_CE(k[(B) + 8], k[(B) + 9]); RT2_CE(k[(B) + 10], k[(B) + 11]); RT2_CE(k[(B) + 12], k[(B) + 13]); RT2_CE(k[(B) + 14], k[(B) + 15]); } while (0)
#define RT2_HCLEAN(k, A, B) do { k[(A) + 0] = RT2_MX(k[(A) + 0], k[(B) + 15]); k[(A) + 1] = RT2_MX(k[(A) + 1], k[(B) + 14]); k[(A) + 2] = RT2_MX(k[(A) + 2], k[(B) + 13]); k[(A) + 3] = RT2_MX(k[(A) + 3], k[(B) + 12]); k[(A) + 4] = RT2_MX(k[(A) + 4], k[(B) + 11]); k[(A) + 5] = RT2_MX(k[(A) + 5], k[(B) + 10]); k[(A) + 6] = RT2_MX(k[(A) + 6], k[(B) + 9]); k[(A) + 7] = RT2_MX(k[(A) + 7], k[(B) + 8]); k[(A) + 8] = RT2_MX(k[(A) + 8], k[(B) + 7]); k[(A) + 9] = RT2_MX(k[(A) + 9], k[(B) + 6]); k[(A) + 10] = RT2_MX(k[(A) + 10], k[(B) + 5]); k[(A) + 11] = RT2_MX(k[(A) + 11], k[(B) + 4]); k[(A) + 12] = RT2_MX(k[(A) + 12], k[(B) + 3]); k[(A) + 13] = RT2_MX(k[(A) + 13], k[(B) + 2]); k[(A) + 14] = RT2_MX(k[(A) + 14], k[(B) + 1]); k[(A) + 15] = RT2_MX(k[(A) + 15], k[(B) + 0]); } while (0)
#define RT2_TOP16_OF_128(k) do { RT2_SORT16(k, 0); RT2_SORT16(k, 16); RT2_SORT16(k, 32); RT2_SORT16(k, 48); RT2_SORT16(k, 64); RT2_SORT16(k, 80); RT2_SORT16(k, 96); RT2_SORT16(k, 112); RT2_HCLEAN(k, 0, 16); RT2_BIT16(k, 0); RT2_HCLEAN(k, 32, 48); RT2_BIT16(k, 32); RT2_HCLEAN(k, 64, 80); RT2_BIT16(k, 64); RT2_HCLEAN(k, 96, 112); RT2_BIT16(k, 96); RT2_HCLEAN(k, 0, 32); RT2_BIT16(k, 0); RT2_HCLEAN(k, 64, 96); RT2_BIT16(k, 64); RT2_HCLEAN(k, 0, 64); RT2_BIT16(k, 0); } while (0)
#define RT2_BUILD_CANDS(c) do { c[0] = RT2_CK(0, 0); c[1] = RT2_CK(0, 1); c[2] = RT2_CK(0, 2); c[3] = RT2_CK(0, 3); c[4] = RT2_CK(0, 4); c[5] = RT2_CK(0, 5); c[6] = RT2_CK(0, 6); c[7] = RT2_CK(0, 7); c[8] = RT2_CK(0, 8); c[9] = RT2_CK(0, 9); c[10] = RT2_CK(0, 10); c[11] = RT2_CK(0, 11); c[12] = RT2_CK(0, 12); c[13] = RT2_CK(0, 13); c[14] = RT2_CK(0, 14); c[15] = RT2_CK(0, 15); c[16] = RT2_CK(1, 0); c[17] = RT2_CK(1, 1); c[18] = RT2_CK(1, 2); c[19] = RT2_CK(1, 3); c[20] = RT2_CK(1, 4); c[21] = RT2_CK(1, 5); c[22] = RT2_CK(1, 6); c[23] = RT2_CK(1, 7); c[24] = RT2_CK(15, 0); c[25] = RT2_CK(14, 0); c[26] = RT2_CK(13, 0); c[27] = RT2_CK(12, 0); c[28] = RT2_CK(11, 0); c[29] = RT2_CK(10, 0); c[30] = RT2_CK(9, 0); c[31] = RT2_CK(8, 0); c[32] = RT2_CK(2, 0); c[33] = RT2_CK(2, 1); c[34] = RT2_CK(2, 2); c[35] = RT2_CK(2, 3); c[36] = RT2_CK(2, 4); c[37] = RT2_CK(3, 0); c[38] = RT2_CK(3, 1); c[39] = RT2_CK(3, 2); c[40] = RT2_CK(3, 3); c[41] = RT2_CK(4, 0); c[42] = RT2_CK(4, 1); c[43] = RT2_CK(4, 2); c[44] = RT2_CK(5, 0); c[45] = RT2_CK(5, 1); c[46] = RT2_CK(6, 0); c[47] = RT2_CK(6, 1); } while (0)
__device__ __forceinline__ int rt2_tr(int u) { return u ^ (int)((unsigned)(u >> 31) >> 1); }
__device__ __forceinline__ int rt2_key(float x, int code, int mask) { return (rt2_tr(__builtin_bit_cast(int, x)) & ~mask) | code; }
__device__ __forceinline__ int rt2_key16(unsigned hbits_hi, int code) { return (rt2_tr((int)hbits_hi) & (int)0xffff0000) | code; }
__device__ __forceinline__ float rt2_val16(int k) { const unsigned u = (unsigned)rt2_tr(k) >> 16; return (float)__builtin_bit_cast(_Float16, (unsigned short)u); }
__device__ __forceinline__ void route_task(const unsigned short* SCT, v2u* ROUTE, int tok0, int h, LAS unsigned char* scr, int lane) {
    const int tok = tok0 + lane;
    LAS unsigned char* sb = scr + lane * 4;
#pragma unroll 1
    for (int p = 0; p < 2; ++p) {
        const int g = 2 * h + p; int k[128];
        const unsigned voff = (unsigned)tok * 16u;
#pragma unroll
        for (int q8 = 0; q8 < 16; ++q8) { const char* bq = (const char*)SCT + ((size_t)(g * 16 + q8) * M) * 16; const v4u q = *(const GAS v4u*)(bq + voff);
            k[8 * q8 + 0] = rt2_key16(q.x << 16, 127 - 8 * q8); k[8 * q8 + 1] = rt2_key16(q.x, 126 - 8 * q8); k[8 * q8 + 2] = rt2_key16(q.y << 16, 125 - 8 * q8); k[8 * q8 + 3] = rt2_key16(q.y, 124 - 8 * q8);
            k[8 * q8 + 4] = rt2_key16(q.z << 16, 123 - 8 * q8); k[8 * q8 + 5] = rt2_key16(q.z, 122 - 8 * q8); k[8 * q8 + 6] = rt2_key16(q.w << 16, 121 - 8 * q8); k[8 * q8 + 7] = rt2_key16(q.w, 120 - 8 * q8); }
        RT2_TOP16_OF_128(k);
#pragma unroll
        for (int i = 0; i < 16; ++i) *(LAS int*)(sb + (p * 16 + i) * 256) = k[i];
    }
    LDS_WAIT();
    float af[16], bf[16];
#pragma unroll
    for (int i = 0; i < 16; ++i) { af[i] = rt2_val16(*(const LAS int*)(sb + i * 256)); bf[i] = rt2_val16(*(const LAS int*)(sb + (16 + i) * 256)); }
    int c[48];
#define RT2_CK(i, j) rt2_key(af[i] + bf[j], 255 - (16 * (i) + (j)), 255)
    RT2_BUILD_CANDS(c);
    const int r7a = RT2_CK(7, 0), r7b = RT2_CK(7, 1);
#undef RT2_CK
    RT2_BIT16(c, 16);
    RT2_SORT16(c, 32);
    RT2_HCLEAN(c, 0, 16); RT2_BIT16(c, 0);
    c[46] = RT2_MX(c[46], r7b); c[47] = RT2_MX(c[47], r7a); RT2_BIT16(c, 32);
    RT2_HCLEAN(c, 0, 32);
    GAS v4u* rp = (GAS v4u*)((GAS v2u*)ROUTE + (size_t)tok * 128 + h * 16);
#pragma unroll
    for (int i = 0; i < 8; ++i) { v4u o;
        { const int ij = (~c[2 * i]) & 255; const int ka = *(const LAS int*)(sb + ((ij >> 4) << 8)), kb = *(const LAS int*)(sb + 4096 + ((ij & 15) << 8));
          o.x = (unsigned)(((~ka) & 127) * 128 + ((~kb) & 127)); o.y = __builtin_bit_cast(unsigned, rt2_val16(ka) + rt2_val16(kb)); }
        { const int ij = (~c[2 * i + 1]) & 255; const int ka = *(const LAS int*)(sb + ((ij >> 4) << 8)), kb = *(const LAS int*)(sb + 4096 + ((ij & 15) << 8));
          o.z = (unsigned)(((~ka) & 127) * 128 + ((~kb) & 127)); o.w = __builtin_bit_cast(unsigned, rt2_val16(ka) + rt2_val16(kb)); }
        rp[i] = o; }
    LDS_WAIT();
}

#define DPPF(v, ctrl) __builtin_bit_cast(float, __builtin_amdgcn_update_dpp(0, __builtin_bit_cast(int, (v)), (ctrl), 0xf, 0xf, true))
__device__ __forceinline__ float wave_max_f(float m) {
#pragma unroll
    for (int o = 1; o < 64; o <<= 1) m = __builtin_fmaxf(m, __shfl_xor(m, o));
    return m;
}
template <int NV> __device__ __forceinline__ void select16(const float (&v)[NV], bool (&sel)[NV], int (&pos)[NV]) {
    float mx = v[0], mn = v[0];
#pragma unroll
    for (int i = 1; i < NV; ++i) { mx = __builtin_fmaxf(mx, v[i]); mn = __builtin_fminf(mn, v[i]); }
    mx = wave_max_f(mx); mn = -wave_max_f(-mn);
    float lo = mn, hi = mx, Tv;
    { int c = 0;
#pragma unroll
      for (int i = 0; i < NV; ++i) c += __popcll(__ballot(v[i] >= mx));
      if (c >= 16) { Tv = mx; }
      else {
        Tv = lo;
        for (int it = 0; it < 300; ++it) {
            const float mid = 0.5f * lo + 0.5f * hi;
            if (!(mid > lo && mid < hi)) { Tv = lo; break; }
            int cc = 0;
#pragma unroll
            for (int i = 0; i < NV; ++i) cc += __popcll(__ballot(v[i] >= mid));
            if (cc == 16) { Tv = mid; break; }
            if (cc > 16) lo = mid; else hi = mid;
            Tv = lo;
        }
      }
    }
    int cgt = 0;
#pragma unroll
    for (int i = 0; i < NV; ++i) cgt += __popcll(__ballot(v[i] > Tv));
    const int need = 16 - cgt;
    int eqbelow = 0;
#pragma unroll
    for (int i = 0; i < NV; ++i) { const unsigned long long m = __ballot(v[i] == Tv); eqbelow += __builtin_amdgcn_mbcnt_hi((unsigned)(m >> 32), __builtin_amdgcn_mbcnt_lo((unsigned)m, 0u)); }
    int eqown = 0;
#pragma unroll
    for (int i = 0; i < NV; ++i) { const bool eq = (v[i] == Tv); sel[i] = (v[i] > Tv) || (eq && (eqbelow + eqown) < need); eqown += eq ? 1 : 0; }
    int selbelow = 0;
#pragma unroll
    for (int i = 0; i < NV; ++i) { const unsigned long long m = __ballot(sel[i]); selbelow += __builtin_amdgcn_mbcnt_hi((unsigned)(m >> 32), __builtin_amdgcn_mbcnt_lo((unsigned)m, 0u)); }
    int own = 0;
#pragma unroll
    for (int i = 0; i < NV; ++i) { pos[i] = selbelow + own; own += sel[i] ? 1 : 0; }
}

__device__ __forceinline__ float gelu_exact(float a) { return 0.5f * a * (1.0f + erff(a * 0.7071067811865476f)); }

__device__ __forceinline__ void fp8_row_dot(const v4u q, const float (&xr)[16], float& s) {
    const f32x2 a0 = __builtin_amdgcn_cvt_pk_f32_fp8((int)q.x, false), a1 = __builtin_amdgcn_cvt_pk_f32_fp8((int)q.x, true), a2 = __builtin_amdgcn_cvt_pk_f32_fp8((int)q.y, false), a3 = __builtin_amdgcn_cvt_pk_f32_fp8((int)q.y, true);
    const f32x2 b0 = __builtin_amdgcn_cvt_pk_f32_fp8((int)q.z, false), b1 = __builtin_amdgcn_cvt_pk_f32_fp8((int)q.z, true), b2 = __builtin_amdgcn_cvt_pk_f32_fp8((int)q.w, false), b3 = __builtin_amdgcn_cvt_pk_f32_fp8((int)q.w, true);
    f32x2 t = a0 * (f32x2){xr[0], xr[1]};
    t = __builtin_elementwise_fma(a1, (f32x2){xr[2], xr[3]}, t); t = __builtin_elementwise_fma(a2, (f32x2){xr[4], xr[5]}, t); t = __builtin_elementwise_fma(a3, (f32x2){xr[6], xr[7]}, t);
    t = __builtin_elementwise_fma(b0, (f32x2){xr[8], xr[9]}, t); t = __builtin_elementwise_fma(b1, (f32x2){xr[10], xr[11]}, t); t = __builtin_elementwise_fma(b2, (f32x2){xr[12], xr[13]}, t); t = __builtin_elementwise_fma(b3, (f32x2){xr[14], xr[15]}, t);
    s = t.x + t.y;
}
__device__ __forceinline__ void fp8_row_axpy2(const v4u q, const float w, f32x2 (&acc)[8]) {
    const f32x2 a0 = __builtin_amdgcn_cvt_pk_f32_fp8((int)q.x, false), a1 = __builtin_amdgcn_cvt_pk_f32_fp8((int)q.x, true), a2 = __builtin_amdgcn_cvt_pk_f32_fp8((int)q.y, false), a3 = __builtin_amdgcn_cvt_pk_f32_fp8((int)q.y, true);
    const f32x2 b0 = __builtin_amdgcn_cvt_pk_f32_fp8((int)q.z, false), b1 = __builtin_amdgcn_cvt_pk_f32_fp8((int)q.z, true), b2 = __builtin_amdgcn_cvt_pk_f32_fp8((int)q.w, false), b3 = __builtin_amdgcn_cvt_pk_f32_fp8((int)q.w, true);
    const f32x2 ww = {w, w};
    acc[0] = __builtin_elementwise_fma(a0, ww, acc[0]); acc[1] = __builtin_elementwise_fma(a1, ww, acc[1]); acc[2] = __builtin_elementwise_fma(a2, ww, acc[2]); acc[3] = __builtin_elementwise_fma(a3, ww, acc[3]);
    acc[4] = __builtin_elementwise_fma(b0, ww, acc[4]); acc[5] = __builtin_elementwise_fma(b1, ww, acc[5]); acc[6] = __builtin_elementwise_fma(b2, ww, acc[6]); acc[7] = __builtin_elementwise_fma(b3, ww, acc[7]);
}
__device__ __forceinline__ void fp8_row_axpy(const v4u q, const float w, float (&acc)[16]) {
    const f32x2 a0 = __builtin_amdgcn_cvt_pk_f32_fp8((int)q.x, false), a1 = __builtin_amdgcn_cvt_pk_f32_fp8((int)q.x, true), a2 = __builtin_amdgcn_cvt_pk_f32_fp8((int)q.y, false), a3 = __builtin_amdgcn_cvt_pk_f32_fp8((int)q.y, true);
    const f32x2 b0 = __builtin_amdgcn_cvt_pk_f32_fp8((int)q.z, false), b1 = __builtin_amdgcn_cvt_pk_f32_fp8((int)q.z, true), b2 = __builtin_amdgcn_cvt_pk_f32_fp8((int)q.w, false), b3 = __builtin_amdgcn_cvt_pk_f32_fp8((int)q.w, true);
    acc[0] += w * a0.x; acc[1] += w * a0.y; acc[2] += w * a1.x; acc[3] += w * a1.y; acc[4] += w * a2.x; acc[5] += w * a2.y; acc[6] += w * a3.x; acc[7] += w * a3.y;
    acc[8] += w * b0.x; acc[9] += w * b0.y; acc[10] += w * b1.x; acc[11] += w * b1.y; acc[12] += w * b2.x; acc[13] += w * b2.y; acc[14] += w * b3.x; acc[15] += w * b3.y;
}
__device__ __forceinline__ void fp8_convert_row(const float* src, const float* gain, unsigned char* dst, float* inv_scale, int lane, int sliced, int e) {
    const GAS f32x4* sp = (const GAS f32x4*)src; float v[16];
#pragma unroll
    for (int j = 0; j < 2; ++j) { f32x4 a = sp[2 * lane + 128 * j], b = sp[2 * lane + 128 * j + 1];
        if (gain) { const GAS f32x4* gp = (const GAS f32x4*)gain; const f32x4 ga = gp[2 * lane + 128 * j], gb = gp[2 * lane + 128 * j + 1]; a = a * ga; b = b * gb; }
        v[8 * j + 0] = a.x; v[8 * j + 1] = a.y; v[8 * j + 2] = a.z; v[8 * j + 3] = a.w; v[8 * j + 4] = b.x; v[8 * j + 5] = b.y; v[8 * j + 6] = b.z; v[8 * j + 7] = b.w; }
    float am = 0.f;
#pragma unroll
    for (int i = 0; i < 16; ++i) am = __builtin_fmaxf(am, __builtin_fabsf(v[i]));
    am = wave_max_f(am);
    const float sc = (am > 0.f) ? 384.0f / am : 1.0f, inv = (am > 0.f) ? am * (1.0f / 384.0f) : 1.0f;
    v4u q;
    { int w = __builtin_amdgcn_cvt_pk_fp8_f32(v[0] * sc, v[1] * sc, 0, false); w = __builtin_amdgcn_cvt_pk_fp8_f32(v[2] * sc, v[3] * sc, w, true); q.x = (unsigned)w; }
    { int w = __builtin_amdgcn_cvt_pk_fp8_f32(v[4] * sc, v[5] * sc, 0, false); w = __builtin_amdgcn_cvt_pk_fp8_f32(v[6] * sc, v[7] * sc, w, true); q.y = (unsigned)w; }
    { int w = __builtin_amdgcn_cvt_pk_fp8_f32(v[8] * sc, v[9] * sc, 0, false); w = __builtin_amdgcn_cvt_pk_fp8_f32(v[10] * sc, v[11] * sc, w, true); q.z = (unsigned)w; }
    { int w = __builtin_amdgcn_cvt_pk_fp8_f32(v[12] * sc, v[13] * sc, 0, false); w = __builtin_amdgcn_cvt_pk_fp8_f32(v[14] * sc, v[15] * sc, w, true); q.w = (unsigned)w; }
    if (!sliced) ((GAS v4u*)dst)[lane] = q;
    else { v2u q0, q1; q0.x = q.x; q0.y = q.y; q1.x = q.z; q1.y = q.w; const int s0 = lane >> 4, o8 = 8 * (lane & 15);
        *(GAS v2u*)(dst + ((size_t)s0 * NEXP + e) * 128 + o8) = q0; *(GAS v2u*)(dst + ((size_t)(s0 + 4) * NEXP + e) * 128 + o8) = q1; }
    if (lane == 0) *inv_scale = inv;
}

#define PIN_ACC2(b) asm volatile("" : "+v"(b), "+v"(acc2[0]), "+v"(acc2[1]), "+v"(acc2[2]), "+v"(acc2[3]), "+v"(acc2[4]), "+v"(acc2[5]), "+v"(acc2[6]), "+v"(acc2[7]))
#define PIN_ACC(b) asm volatile("" : "+v"(b), "+v"(acc[0]), "+v"(acc[1]), "+v"(acc[2]), "+v"(acc[3]), "+v"(acc[4]), "+v"(acc[5]), "+v"(acc[6]), "+v"(acc[7]), "+v"(acc[8]), "+v"(acc[9]), "+v"(acc[10]), "+v"(acc[11]), "+v"(acc[12]), "+v"(acc[13]), "+v"(acc[14]), "+v"(acc[15]))
#define PC_META_U(tk) do { const char* rb_ = (const char*)route + (size_t)(tk) * 1024; m_e0 = *(const GAS int*)(rb_ + l8); m_e1 = *(const GAS int*)(rb_ + 512 + l8); } while (0)
#define PC_ISSUE_U(buf, xs, par, tk) do { LAS int* lid_ = (LAS int*)(scr + (par) * 512); lid_[lane] = m_e0; lid_[lane + 64] = m_e1; LDS_WAIT(); \
        { const GAS f32x4* xq_ = (const GAS f32x4*)(x1 + (size_t)(tk) * D + 128 * s + 16 * c); const f32x4 x0_ = xq_[0], x1_ = xq_[1], x2_ = xq_[2], x3_ = xq_[3]; \
          xs[0] = x0_.x; xs[1] = x0_.y; xs[2] = x0_.z; xs[3] = x0_.w; xs[4] = x1_.x; xs[5] = x1_.y; xs[6] = x1_.z; xs[7] = x1_.w; xs[8] = x2_.x; xs[9] = x2_.y; xs[10] = x2_.z; xs[11] = x2_.w; xs[12] = x3_.x; xs[13] = x3_.y; xs[14] = x3_.z; xs[15] = x3_.w; } \
        _Pragma("unroll") for (int k = 0; k < 16; ++k) { const int e_ = lid_[8 * k + r]; buf[k] = *(const GAS v4u*)(tbs + (unsigned)(e_ * 128)); } } while (0)
#define PC_COMPUTE_U(buf, xs, tk) do { float p_[16]; \
        _Pragma("unroll") for (int k = 0; k < 16; ++k) { if (k) asm volatile("" : "+v"(buf[k]), "+v"(p_[k ? k - 1 : 0])); else asm volatile("" : "+v"(buf[k])); fp8_row_dot(buf[k], xs, p_[k]); } \
        float q8_[8], q4_[4], q2_[2]; \
        _Pragma("unroll") for (int k = 0; k < 8; ++k) { const float send = c2 ? p_[k] : p_[k + 8], keep = c2 ? p_[k + 8] : p_[k]; q8_[k] = keep + __shfl_xor(send, 4); } \
        _Pragma("unroll") for (int k = 0; k < 4; ++k) { const float send = c1 ? q8_[k] : q8_[k + 4], keep = c1 ? q8_[k + 4] : q8_[k]; q4_[k] = keep + __shfl_xor(send, 2); } \
        _Pragma("unroll") for (int k = 0; k < 2; ++k) { const float send = c0 ? q4_[k] : q4_[k + 2], keep = c0 ? q4_[k + 2] : q4_[k]; q2_[k] = keep + __shfl_xor(send, 1); } \
        GAS float* up_ = (GAS float*)(Upart + ((size_t)s * M + (tk)) * 128 + 64 * c2 + 32 * c1 + 16 * c0 + r); up_[0] = q2_[0]; up_[8] = q2_[1]; } while (0)
__device__ __forceinline__ void peer_u_phase(int s, int tok0, int tstride, int nitems, const v2u* route, const float* x1, const unsigned char* TU8s, float* Upart, LAS unsigned char* scr, int lane) {
    const int r = lane >> 3, c = lane & 7, c2 = (lane >> 2) & 1, c1 = (lane >> 1) & 1, c0 = lane & 1; const unsigned l8 = (unsigned)lane * 8u;
    const char* tbs = (const char*)TU8s + (size_t)s * NEXP * 128 + 16 * c;
    int m_e0, m_e1;
    v4u bufA[16], bufB[16]; float xsA[16], xsB[16];
    PC_META_U(tok0); PC_ISSUE_U(bufA, xsA, 0, tok0); if (nitems > 1) PC_META_U(tok0 + tstride);
#pragma unroll 1
    for (int i = 0; i < nitems; i += 2) {
        const int tk = tok0 + i * tstride;
        if (i + 1 < nitems) PC_ISSUE_U(bufB, xsB, 1, tk + tstride);
        if (i + 2 < nitems) PC_META_U(tk + 2 * tstride);
        PC_COMPUTE_U(bufA, xsA, tk);
        if (i + 1 < nitems) {
            if (i + 2 < nitems) PC_ISSUE_U(bufA, xsA, 0, tk + 2 * tstride);
            if (i + 3 < nitems) PC_META_U(tk + 3 * tstride);
            PC_COMPUTE_U(bufB, xsB, tk + tstride);
        }
    }
    LDS_WAIT();
}
#define PD_META_U(tk) do { const char* rb_ = (const char*)route + (size_t)(tk) * 1024; m_e0 = *(const GAS int*)(rb_ + l8); m_e1 = *(const GAS int*)(rb_ + 512 + l8); \
        { const unsigned xw_ = *(const GAS unsigned*)((const bf16*)x1 + (size_t)(tk) * D + 128 * s + 2 * lane); m_x.x = bflo(xw_); m_x.y = bfhi(xw_); } } while (0)
#define PD_ISSUE_U(buf, xq, xinv, par) do { LAS int* lid_ = (LAS int*)(scr + (par) * 1024); LAS unsigned short* lx_ = (LAS unsigned short*)(scr + (par) * 1024 + 512); lid_[lane] = m_e0; lid_[lane + 64] = m_e1; LDS_WAIT(); \
        _Pragma("unroll") for (int k = 0; k < 16; ++k) { const int e_ = lid_[8 * k + r]; buf[k] = *(const GAS v4u*)(tbs + (unsigned)(e_ * 128)); } \
        { float am_ = __builtin_fmaxf(__builtin_fabsf(m_x.x), __builtin_fabsf(m_x.y)); \
          _Pragma("unroll") for (int o_ = 1; o_ < 64; o_ <<= 1) am_ = __builtin_fmaxf(am_, __shfl_xor(am_, o_)); \
          const float sc_ = (am_ > 0.f) ? 127.0f / am_ : 0.f; xinv = am_ * (1.0f / 127.0f); \
          const int q0_ = (int)__builtin_rintf(m_x.x * sc_), q1_ = (int)__builtin_rintf(m_x.y * sc_); lx_[lane] = (unsigned short)(((unsigned)q0_ & 255u) | (((unsigned)q1_ & 255u) << 8)); } \
        LDS_WAIT(); xq = *(const LAS v4u*)((LAS unsigned char*)lx_ + 16 * c); } while (0)
#define PD_COMPUTE_U(buf, xq, xinv, tk) do { int p_[16]; \
        _Pragma("unroll") for (int k = 0; k < 16; ++k) { int a_ = __builtin_amdgcn_sdot4((int)buf[k].x, (int)xq.x, 0, false); a_ = __builtin_amdgcn_sdot4((int)buf[k].y, (int)xq.y, a_, false); \
            a_ = __builtin_amdgcn_sdot4((int)buf[k].z, (int)xq.z, a_, false); a_ = __builtin_amdgcn_sdot4((int)buf[k].w, (int)xq.w, a_, false); p_[k] = a_; } \
          \
        LAS int* red_ = (LAS int*)(scr + 2048); \
        _Pragma("unroll") for (int k = 0; k < 16; ++k) red_[64 * k + lane] = p_[k]; \
        LDS_WAIT(); \
        const v4u ra_ = *(const LAS v4u*)(red_ + 8 * lane + rsw), rb_ = *(const LAS v4u*)(red_ + 8 * lane + (4 - rsw)), rc_ = *(const LAS v4u*)(red_ + 512 + 8 * lane + rsw), rd_ = *(const LAS v4u*)(red_ + 512 + 8 * lane + (4 - rsw)); \
        const int s0_ = (int)(ra_.x + ra_.y + ra_.z + ra_.w + rb_.x + rb_.y + rb_.z + rb_.w), s1_ = (int)(rc_.x + rc_.y + rc_.z + rc_.w + rd_.x + rd_.y + rd_.z + rd_.w); \
        GAS bf16* up_ = (GAS bf16*)Upart + ((size_t)s * M + (tk)) * 128 + lane; const unsigned pk_ = cvtpk((float)s0_ * xinv, (float)s1_ * xinv); up_[0] = (bf16)(pk_ & 0xffffu); up_[64] = (bf16)(pk_ >> 16); } while (0)
__device__ __forceinline__ void peer_u_phase_dot4(int s, int tok0, int tstride, int nitems, const v2u* route, const float* x1, const unsigned char* TU8s, float* Upart, LAS unsigned char* scr, int lane) {
    const int r = lane >> 3, c = lane & 7, rsw = 4 * ((lane >> 3) & 1); const unsigned l8 = (unsigned)lane * 8u;
    const char* tbs = (const char*)TU8s + (size_t)s * NEXP * 128 + 16 * c;
    int m_e0, m_e1; f32x2 m_x;
    v4u bufA[16], bufB[16], xqA, xqB; float xiA, xiB;
    PD_META_U(tok0); PD_ISSUE_U(bufA, xqA, xiA, 0); if (nitems > 1) PD_META_U(tok0 + tstride);
#pragma unroll 1
    for (int it = 0; it < nitems; it += 2) {
        const int tk = tok0 + it * tstride;
        if (it + 1 < nitems) PD_ISSUE_U(bufB, xqB, xiB, 1);
        if (it + 2 < nitems) PD_META_U(tk + 2 * tstride);
        PD_COMPUTE_U(bufA, xqA, xiA, tk);
        if (it + 1 < nitems) {
            if (it + 2 < nitems) PD_ISSUE_U(bufA, xqA, xiA, 0);
            if (it + 3 < nitems) PD_META_U(tk + 3 * tstride);
            PD_COMPUTE_U(bufB, xqB, xiB, tk + tstride);
        }
    }
    LDS_WAIT();
}
__device__ __forceinline__ void peer_w_token(int tok, const v2u* route, const float* x1, const float* Upart, const float* SU, const float* SV, float* W, int lane) {
    const GAS f32x4* xp = (const GAS f32x4*)(x1 + (size_t)tok * D) + lane; float ssq = 0.f;
#pragma unroll
    for (int j = 0; j < 4; ++j) { const f32x4 q = xp[64 * j]; ssq += (q.x * q.x + q.y * q.y) + (q.z * q.z + q.w * q.w); }
    const float rstd2 = 1.0f / sqrtf(wave_sum(ssq) * (1.0f / D) + RMS_EPS);
    const char* rb_ = (const char*)route + (size_t)tok * 1024; const unsigned l8_ = (unsigned)lane * 8u;
    const v2u r_lo = *(const GAS v2u*)(rb_ + l8_), r_hi = *(const GAS v2u*)(rb_ + 512 + l8_);
    float g_lo, g_hi;
#pragma unroll
    for (int half = 0; half < 2; ++half) {
        const float sc_ = __builtin_bit_cast(float, half ? r_hi.y : r_lo.y) * rstd2; float m_ = sc_;
#pragma unroll
        for (int o = 1; o < 16; o <<= 1) m_ = __builtin_fmaxf(m_, __shfl_xor(m_, o));
        const float p_ = __builtin_amdgcn_exp2f((sc_ - m_) * 1.4426950408889634f); float sum_ = p_;
#pragma unroll
        for (int o = 1; o < 16; o <<= 1) sum_ += __shfl_xor(sum_, o);
        if (half) g_hi = p_ / sum_; else g_lo = p_ / sum_;
    }
    asm volatile("" : "+v"(g_lo), "+v"(g_hi));
#pragma unroll
    for (int half = 0; half < 2; ++half) {
        const int e = (int)(half ? r_hi.x : r_lo.x); const int n = lane + 64 * half;
        float dot = 0.f;
#pragma unroll
        for (int s8 = 0; s8 < 8; ++s8) dot += Upart[((size_t)s8 * M + tok) * 128 + n];
        const float act = gelu_exact(dot * SU[e] * rstd2);
        W[(size_t)tok * 128 + n] = (half ? g_hi : g_lo) * act * SV[e];
    }
}
__device__ __forceinline__ void peer_w_token2(int tokA, int tokB, const v2u* route, const bf16* x1b, const bf16* Upart, const float* SU, const float* SV, float* W, int lane) {
    v4u xv[2][2]; v2u r_lo[2], r_hi[2]; unsigned short ub[2][2][8];
#pragma unroll
    for (int t = 0; t < 2; ++t) { const int tok = t ? tokB : tokA;
        const GAS v4u* xp = (const GAS v4u*)(x1b + (size_t)tok * D) + lane; xv[t][0] = xp[0]; xv[t][1] = xp[64];
        const char* rb_ = (const char*)route + (size_t)tok * 1024; const unsigned l8_ = (unsigned)lane * 8u;
        r_lo[t] = *(const GAS v2u*)(rb_ + l8_); r_hi[t] = *(const GAS v2u*)(rb_ + 512 + l8_);
#pragma unroll
        for (int half = 0; half < 2; ++half)
#pragma unroll
            for (int s8 = 0; s8 < 8; ++s8) ub[t][half][s8] = *(const GAS bf16*)(Upart + ((size_t)s8 * M + tok) * 128 + lane + 64 * half); }
#pragma unroll
    for (int t = 0; t < 2; ++t) { const int tok = t ? tokB : tokA;
        float ssq = 0.f;
#pragma unroll
        for (int j = 0; j < 2; ++j) { const v4u q = xv[t][j];
            ssq += (bflo(q.x) * bflo(q.x) + bfhi(q.x) * bfhi(q.x)) + (bflo(q.y) * bflo(q.y) + bfhi(q.y) * bfhi(q.y)) + (bflo(q.z) * bflo(q.z) + bfhi(q.z) * bfhi(q.z)) + (bflo(q.w) * bflo(q.w) + bfhi(q.w) * bfhi(q.w)); }
        const float rstd2 = 1.0f / sqrtf(wave_sum(ssq) * (1.0f / D) + RMS_EPS);
        float g_lo, g_hi;
#pragma unroll
        for (int half = 0; half < 2; ++half) {
            const float sc_ = __builtin_bit_cast(float, half ? r_hi[t].y : r_lo[t].y) * rstd2; float m_ = sc_;
#pragma unroll
            for (int o = 1; o < 16; o <<= 1) m_ = __builtin_fmaxf(m_, __shfl_xor(m_, o));
            const float p_ = __builtin_amdgcn_exp2f((sc_ - m_) * 1.4426950408889634f); float sum_ = p_;
#pragma unroll
            for (int o = 1; o < 16; o <<= 1) sum_ += __shfl_xor(sum_, o);
            if (half) g_hi = p_ / sum_; else g_lo = p_ / sum_;
        }
        asm volatile("" : "+v"(g_lo), "+v"(g_hi));
#pragma unroll
        for (int half = 0; half < 2; ++half) {
            const int e = (int)(half ? r_hi[t].x : r_lo[t].x); const int n = lane + 64 * half;
            float dot = 0.f;
#pragma unroll
            for (int s8 = 0; s8 < 8; ++s8) dot += __builtin_bit_cast(float, (unsigned)ub[t][half][s8] << 16);
            const float act = gelu_exact(dot * SU[e] * rstd2);
            W[(size_t)tok * 128 + n] = (half ? g_hi : g_lo) * act * SV[e];
        }
    }
}
#define PC_META_V(tk) do { const char* rb_ = (const char*)route + (size_t)(tk) * 1024; m_e0 = *(const GAS int*)(rb_ + l8); m_e1 = *(const GAS int*)(rb_ + 512 + l8); \
        const GAS float* wp_ = (const GAS float*)(W + (size_t)(tk) * 128); m_w0 = wp_[lane]; m_w1 = wp_[lane + 64]; m_xv = *(const GAS unsigned*)(xres + (size_t)(tk) * D + col0); } while (0)
#define PC_ISSUE_V(buf, wk, xv, par) do { LAS int* lid_ = (LAS int*)(scr + (par) * 1024); LAS float* lw_ = (LAS float*)(scr + (par) * 1024 + 512); lid_[lane] = m_e0; lid_[lane + 64] = m_e1; lw_[lane] = m_w0; lw_[lane + 64] = m_w1; LDS_WAIT(); xv = m_xv; \
        _Pragma("unroll") for (int k = 0; k < 16; ++k) { const int e_ = lid_[8 * k + r]; wk[k] = lw_[8 * k + r]; buf[k] = *(const GAS v4u*)(tbs + (unsigned)(e_ * 128)); } } while (0)
#define PC_COMPUTE_V(buf, wk, xv, tk) do { f32x2 acc2[8]; _Pragma("unroll") for (int i_ = 0; i_ < 8; ++i_) acc2[i_] = (f32x2){0.f, 0.f}; \
        _Pragma("unroll") for (int k = 0; k < 16; ++k) { PIN_ACC2(buf[k]); fp8_row_axpy2(buf[k], wk[k], acc2); } \
          \
        LAS float* red_ = (LAS float*)(scr + 2048); LAS f32x4* wp_ = (LAS f32x4*)(red_ + 128 * r + 16 * c); \
        _Pragma("unroll") for (int j_ = 0; j_ < 4; ++j_) { f32x4 t_; t_.x = acc2[2 * j_].x; t_.y = acc2[2 * j_].y; t_.z = acc2[2 * j_ + 1].x; t_.w = acc2[2 * j_ + 1].y; wp_[j_] = t_; } \
        LDS_WAIT(); \
        f32x2 o_; o_.x = bflo(xv); o_.y = bfhi(xv); \
        _Pragma("unroll") for (int rr_ = 0; rr_ < 8; ++rr_) { const f32x2 t_ = *(const LAS f32x2*)(red_ + 128 * rr_ + 2 * lane); o_.x += t_.x; o_.y += t_.y; } \
        *(GAS f32x2*)(xio + (size_t)(tk) * D + col0) = o_; } while (0)
__device__ __forceinline__ void peer_v_phase(int s, int tok0, int tstride, int nitems, const v2u* route, const float* W, const unsigned char* TV8s, const bf16* xres, float* xio, float* SS, LAS unsigned char* scr, int lane) {
    const int r = lane >> 3, c = lane & 7; const unsigned l8 = (unsigned)lane * 8u;
    const int col0 = 128 * s + 2 * lane;
    const char* tbs = (const char*)TV8s + (size_t)s * NEXP * 128 + 16 * c;
    int m_e0, m_e1; float m_w0, m_w1; unsigned m_xv;
    v4u bufA[16], bufB[16]; float wA[16], wB[16]; unsigned xvA, xvB;
    PC_META_V(tok0); PC_ISSUE_V(bufA, wA, xvA, 0); if (nitems > 1) PC_META_V(tok0 + tstride);
#pragma unroll 1
    for (int i = 0; i < nitems; i += 2) {
        const int tk = tok0 + i * tstride;
        if (i + 1 < nitems) PC_ISSUE_V(bufB, wB, xvB, 1);
        if (i + 2 < nitems) PC_META_V(tk + 2 * tstride);
        PC_COMPUTE_V(bufA, wA, xvA, tk);
        if (i + 1 < nitems) {
            if (i + 2 < nitems) PC_ISSUE_V(bufA, wA, xvA, 0);
            if (i + 3 < nitems) PC_META_V(tk + 3 * tstride);
            PC_COMPUTE_V(bufB, wB, xvB, tk + tstride);
        }
    }
    LDS_WAIT();
}


#define FZ_S(i_) ((xs + ((i_) >> 3)) & 7)
#define FZ_TK(i_) (tokb + tjs * ((i_) & 7))
#define FU_META(i_) do { const unsigned xw_ = *(const GAS unsigned*)(x1b + (size_t)FZ_TK(i_) * D + 128 * FZ_S(i_) + 2 * lane); m_x.x = bflo(xw_); m_x.y = bfhi(xw_); } while (0)
#define FU_ISSUE(buf, xq, xinv, par, i_) do { const LAS int* lid_ = ids + ((i_) & 7) * 128; LAS unsigned short* lx_ = (LAS unsigned short*)(scr + 12288 + (par) * 128); \
        const char* tb_ = (const char*)TU8s + (size_t)FZ_S(i_) * NEXP * 128 + 16 * c; \
        _Pragma("unroll") for (int k = 0; k < 16; ++k) { const int e_ = lid_[8 * k + r]; buf[k] = *(const GAS v4u*)(tb_ + (unsigned)(e_ * 128)); } \
        { float am_ = __builtin_fmaxf(__builtin_fabsf(m_x.x), __builtin_fabsf(m_x.y)); \
          _Pragma("unroll") for (int o_ = 1; o_ < 64; o_ <<= 1) am_ = __builtin_fmaxf(am_, __shfl_xor(am_, o_)); \
          const float sc_ = (am_ > 0.f) ? 127.0f / am_ : 0.f; xinv = am_ * (1.0f / 127.0f); \
          const int q0_ = (int)__builtin_rintf(m_x.x * sc_), q1_ = (int)__builtin_rintf(m_x.y * sc_); lx_[lane] = (unsigned short)(((unsigned)q0_ & 255u) | (((unsigned)q1_ & 255u) << 8)); } \
        LDS_WAIT(); xq = *(const LAS v4u*)((LAS unsigned char*)lx_ + 16 * c); } while (0)
#define FU_COMPUTE(buf, xq, xinv, i_) do { int p_[16]; \
        _Pragma("unroll") for (int k = 0; k < 16; ++k) { int a_ = __builtin_amdgcn_sdot4((int)buf[k].x, (int)xq.x, 0, false); a_ = __builtin_amdgcn_sdot4((int)buf[k].y, (int)xq.y, a_, false); \
            a_ = __builtin_amdgcn_sdot4((int)buf[k].z, (int)xq.z, a_, false); a_ = __builtin_amdgcn_sdot4((int)buf[k].w, (int)xq.w, a_, false); p_[k] = a_; } \
        LAS int* red_ = (LAS int*)(scr + 8192); \
        _Pragma("unroll") for (int k = 0; k < 16; ++k) red_[64 * k + lane] = p_[k]; \
        LDS_WAIT(); \
        const v4u ra_ = *(const LAS v4u*)(red_ + 8 * lane + rsw), rb_ = *(const LAS v4u*)(red_ + 8 * lane + (4 - rsw)), rc_ = *(const LAS v4u*)(red_ + 512 + 8 * lane + rsw), rd_ = *(const LAS v4u*)(red_ + 512 + 8 * lane + (4 - rsw)); \
        const int s0_ = (int)(ra_.x + ra_.y + ra_.z + ra_.w + rb_.x + rb_.y + rb_.z + rb_.w), s1_ = (int)(rc_.x + rc_.y + rc_.z + rc_.w + rd_.x + rd_.y + rd_.z + rd_.w); \
        LAS float* ua_ = uw + ((i_) & 7) * 128 + lane; ua_[0] += (float)s0_ * xinv; ua_[64] += (float)s1_ * xinv; } while (0)
#define FV_META(i_) do { m_xv = *(const GAS unsigned*)(x1b + (size_t)FZ_TK(i_) * D + 128 * FZ_S(i_) + 2 * lane); } while (0)
#define FV_ISSUE(buf, wk, xv, i_) do { const LAS int* lid_ = ids + ((i_) & 7) * 128; const LAS float* lw_ = uw + ((i_) & 7) * 128; xv = m_xv; \
        const char* tb_ = (const char*)TV8s + (size_t)FZ_S(i_) * NEXP * 128 + 16 * c; \
        _Pragma("unroll") for (int k = 0; k < 16; ++k) { const int e_ = lid_[8 * k + r]; wk[k] = lw_[8 * k + r]; buf[k] = *(const GAS v4u*)(tb_ + (unsigned)(e_ * 128)); } } while (0)
#define FV_COMPUTE(buf, wk, xv, i_) do { f32x2 acc2[8]; _Pragma("unroll") for (int i2_ = 0; i2_ < 8; ++i2_) acc2[i2_] = (f32x2){0.f, 0.f}; \
        _Pragma("unroll") for (int k = 0; k < 16; ++k) { PIN_ACC2(buf[k]); fp8_row_axpy2(buf[k], wk[k], acc2); } \
        LAS float* red_ = (LAS float*)(scr + 8192); LAS f32x4* wp_ = (LAS f32x4*)(red_ + 128 * r + 16 * c); \
        _Pragma("unroll") for (int j_ = 0; j_ < 4; ++j_) { f32x4 t_; t_.x = acc2[2 * j_].x; t_.y = acc2[2 * j_].y; t_.z = acc2[2 * j_ + 1].x; t_.w = acc2[2 * j_ + 1].y; wp_[j_] = t_; } \
        LDS_WAIT(); \
        f32x2 o_; o_.x = bflo(xv); o_.y = bfhi(xv); \
        _Pragma("unroll") for (int rr_ = 0; rr_ < 8; ++rr_) { const f32x2 t_ = *(const LAS f32x2*)(red_ + 128 * rr_ + 2 * lane); o_.x += t_.x; o_.y += t_.y; } \
        *(GAS f32x2*)(xio + (size_t)FZ_TK(i_) * D + 128 * FZ_S(i_) + 2 * lane) = o_; } while (0)
__device__ __forceinline__ void peer_fused(int xs, int tokb, int tjs, const v2u* route, const bf16* x1b, const unsigned char* TU8s, const unsigned char* TV8s, const float* SU, const float* SV,
                                           const float* gain, float* xio, LAS unsigned char* scr, int lane) {
    const int r = lane >> 3, c = lane & 7, rsw = 4 * ((lane >> 3) & 1); const unsigned l8 = (unsigned)lane * 8u;
    LAS int* ids = (LAS int*)scr; LAS float* uw = (LAS float*)(scr + 4096);
#pragma unroll
    for (int j = 0; j < 8; ++j) { const char* rb_ = (const char*)route + (size_t)(tokb + tjs * j) * 1024;
        ids[j * 128 + lane] = *(const GAS int*)(rb_ + l8); ids[j * 128 + 64 + lane] = *(const GAS int*)(rb_ + 512 + l8); uw[j * 128 + lane] = 0.f; uw[j * 128 + 64 + lane] = 0.f; }
    LDS_WAIT();
    {
        f32x2 m_x; v4u bufA[16], bufB[16], xqA, xqB; float xiA, xiB;
        FU_META(0); FU_ISSUE(bufA, xqA, xiA, 0, 0); FU_META(1);
#pragma unroll 1
        for (int it = 0; it < 64; it += 2) {
            FU_ISSUE(bufB, xqB, xiB, 1, it + 1);
            if (it + 2 < 64) FU_META(it + 2);
            FU_COMPUTE(bufA, xqA, xiA, it);
            if (it + 2 < 64) FU_ISSUE(bufA, xqA, xiA, 0, it + 2);
            if (it + 3 < 64) FU_META(it + 3);
            FU_COMPUTE(bufB, xqB, xiB, it + 1);
        }
        LDS_WAIT();
    }
    {
        v4u xv[8][2]; v2u r_lo[8], r_hi[8];
#pragma unroll
        for (int t = 0; t < 8; ++t) { const int tok = tokb + tjs * t;
            const GAS v4u* xp = (const GAS v4u*)(x1b + (size_t)tok * D) + lane; xv[t][0] = xp[0]; xv[t][1] = xp[64];
            const char* rb_ = (const char*)route + (size_t)tok * 1024; r_lo[t] = *(const GAS v2u*)(rb_ + l8); r_hi[t] = *(const GAS v2u*)(rb_ + 512 + l8); }
        float su[8][2], sv[8][2];
#pragma unroll
        for (int t = 0; t < 8; ++t) { su[t][0] = SU[(int)r_lo[t].x]; su[t][1] = SU[(int)r_hi[t].x]; sv[t][0] = SV[(int)r_lo[t].x]; sv[t][1] = SV[(int)r_hi[t].x]; }
#pragma unroll
        for (int t = 0; t < 8; ++t) {
            float ssq = 0.f;
#pragma unroll
            for (int j = 0; j < 2; ++j) { const v4u q = xv[t][j];
                ssq += (bflo(q.x) * bflo(q.x) + bfhi(q.x) * bfhi(q.x)) + (bflo(q.y) * bflo(q.y) + bfhi(q.y) * bfhi(q.y)) + (bflo(q.z) * bflo(q.z) + bfhi(q.z) * bfhi(q.z)) + (bflo(q.w) * bflo(q.w) + bfhi(q.w) * bfhi(q.w)); }
            const float rstd2 = 1.0f / sqrtf(wave_sum(ssq) * (1.0f / D) + RMS_EPS);
            float g_lo, g_hi;
#pragma unroll
            for (int half = 0; half < 2; ++half) {
                const float sc_ = __builtin_bit_cast(float, half ? r_hi[t].y : r_lo[t].y) * rstd2; float m_ = sc_;
#pragma unroll
                for (int o = 1; o < 16; o <<= 1) m_ = __builtin_fmaxf(m_, __shfl_xor(m_, o));
                const float p_ = __builtin_amdgcn_exp2f((sc_ - m_) * 1.4426950408889634f); float sum_ = p_;
#pragma unroll
                for (int o = 1; o < 16; o <<= 1) sum_ += __shfl_xor(sum_, o);
                if (half) g_hi = p_ / sum_; else g_lo = p_ / sum_;
            }
            asm volatile("" : "+v"(g_lo), "+v"(g_hi));
            LAS float* up_ = uw + t * 128 + lane;
            const float d0 = up_[0], d1 = up_[64];
            up_[0] = g_lo * gelu_exact(d0 * su[t][0] * rstd2) * sv[t][0]; up_[64] = g_hi * gelu_exact(d1 * su[t][1] * rstd2) * sv[t][1];
        }
        LDS_WAIT();
    }
    {
        unsigned m_xv; v4u bufA[16], bufB[16]; float wA[16], wB[16]; unsigned xvA, xvB;
        FV_META(0); FV_ISSUE(bufA, wA, xvA, 0); FV_META(1);
#pragma unroll 1
        for (int it = 0; it < 64; it += 2) {
            FV_ISSUE(bufB, wB, xvB, it + 1);
            if (it + 2 < 64) FV_META(it + 2);
            FV_COMPUTE(bufA, wA, xvA, it);
            if (it + 2 < 64) FV_ISSUE(bufA, wA, xvA, it + 2);
            if (it + 3 < 64) FV_META(it + 3);
            FV_COMPUTE(bufB, wB, xvB, it + 1);
        }
        LDS_WAIT();
    }
    asm volatile("s_waitcnt vmcnt(0)" ::: "memory");
#pragma unroll 1
    for (int jb = 0; jb < 8; jb += 4) {
        f32x4 v[4][4];
#pragma unroll
        for (int t = 0; t < 4; ++t) { const GAS f32x4* op = (const GAS f32x4*)(xio + (size_t)(tokb + tjs * (jb + t)) * D) + lane;
#pragma unroll
            for (int j = 0; j < 4; ++j) v[t][j] = op[64 * j]; }
#pragma unroll
        for (int t = 0; t < 4; ++t) { float s2 = 0.f;
#pragma unroll
            for (int j = 0; j < 4; ++j) s2 += (v[t][j].x * v[t][j].x + v[t][j].y * v[t][j].y) + (v[t][j].z * v[t][j].z + v[t][j].w * v[t][j].w);
            const float rstd3 = 1.0f / sqrtf(wave_sum(s2) * (1.0f / D) + RMS_EPS);
            GAS f32x4* op = (GAS f32x4*)(xio + (size_t)(tokb + tjs * (jb + t)) * D) + lane; const GAS f32x4* gp = (const GAS f32x4*)gain + lane;
#pragma unroll
            for (int j = 0; j < 4; ++j) { const f32x4 g = gp[64 * j]; f32x4 o; o.x = v[t][j].x * rstd3 * g.x; o.y = v[t][j].y * rstd3 * g.y; o.z = v[t][j].z * rstd3 * g.z; o.w = v[t][j].w * rstd3 * g.w; op[64 * j] = o; } }
    }
}

__device__ __forceinline__ void peer_u_debug(int tok, const v2u* route, const float* x1, const unsigned char* TU8s, const float* SU, const float* SV, float* W, int lane) {
    float xr[16], ssq = 0.f;
    { const GAS f32x4* xp = (const GAS f32x4*)(x1 + (size_t)tok * D + 16 * lane);
#pragma unroll
      for (int j = 0; j < 4; ++j) { const f32x4 a = xp[j]; xr[4 * j] = a.x; xr[4 * j + 1] = a.y; xr[4 * j + 2] = a.z; xr[4 * j + 3] = a.w; } }
#pragma unroll
    for (int i = 0; i < 16; ++i) ssq += xr[i] * xr[i];
    const float rstd2 = 1.0f / sqrtf(wave_sum(ssq) * (1.0f / D) + RMS_EPS);
    const char* rb_ = (const char*)route + (size_t)tok * 1024; const int s = lane >> 3, c = lane & 7;
#pragma unroll 1
    for (int h = 0; h < 8; ++h) {
        float sc[16]; int id[16]; float m = -3e38f;
#pragma unroll
        for (int i = 0; i < 16; ++i) { const v2u r = *(const GAS v2u*)(rb_ + (h * 16 + i) * 8 + opaque_zero()); id[i] = (int)r.x; sc[i] = __builtin_bit_cast(float, r.y) * rstd2; m = __builtin_fmaxf(m, sc[i]); }
        float sum = 0.f;
#pragma unroll
        for (int i = 0; i < 16; ++i) { sc[i] = __builtin_amdgcn_exp2f((sc[i] - m) * 1.4426950408889634f); sum += sc[i]; }
#pragma unroll
        for (int i = 0; i < 16; ++i) { const int e = id[i];
            const v4u q = *(const GAS v4u*)(TU8s + ((size_t)s * NEXP + e) * 128 + 16 * c);
            float d; fp8_row_dot(q, xr, d); d = wave_sum(d);
            const float act = gelu_exact(d * SU[e] * rstd2);
            if (lane == 0) W[(size_t)tok * 128 + h * 16 + i] = (sc[i] / sum) * act * SV[e]; }
    }
}
__device__ __forceinline__ void peer_v_debug(int tok, const v2u* route, const float* W, const unsigned char* TV8s, float* xio, float* SS, int lane) {
    const char* rb_ = (const char*)route + (size_t)tok * 1024;
    float acc[16];
#pragma unroll
    for (int i = 0; i < 16; ++i) acc[i] = 0.f;
    const int s = lane >> 3, c = lane & 7;
#pragma unroll 1
    for (int n = 0; n < 128; ++n) {
        const int e = *(const GAS int*)(rb_ + n * 8 + opaque_zero()); const float w = W[(size_t)tok * 128 + n + opaque_zero()];
        const v4u q = *(const GAS v4u*)(TV8s + ((size_t)s * NEXP + e) * 128 + 16 * c);
        fp8_row_axpy(q, w, acc);
    }
    float ssq = 0.f;
    GAS float* xp = (GAS float*)(xio + (size_t)tok * D + 16 * lane);
#pragma unroll
    for (int i = 0; i < 16; ++i) { const float o = xp[i] + acc[i]; xp[i] = o; ssq += o * o; }
    ssq = wave_sum(ssq);
    if (lane < 8) SS[(size_t)lane * M + tok] = (lane == 0) ? ssq : 0.f;
}
#ifndef DUP_MASK
#define DUP_MASK 0
#endif
#define NREP(k) (1 + ((DUP_MASK >> (k)) & 1))
struct Args { const float* in[14]; float* out; unsigned char* ws; int ph_lo, ph_hi, li, pad; };
__global__ void __launch_bounds__(NWAVES * 64, 2) hybrid_fwd(Args args) {
    extern __shared__ __attribute__((aligned(16))) unsigned char lds[];
    LAS unsigned char* ldsb = (LAS unsigned char*)lds;
    volatile LAS unsigned* MISC = (volatile LAS unsigned*)(ldsb + MISC_OFF);
    const int tid = threadIdx.x, lane = tid & 63, wave = __builtin_amdgcn_readfirstlane(tid >> 6);
    const int G = gridDim.x; const int bx = blockIdx.x; const int vcu = (G % 8 == 0) ? (bx % 8) * (G / 8) + bx / 8 : bx;
    const int gw = vcu * NWAVES + wave, NGW = G * NWAVES;
    unsigned char* ws = args.ws;
    gu32* ctl = (gu32*)(ws + WS_CTL);
    const float* x = args.in[0]; float* out = args.out;
#define norm_mix (args.in[1])
#define w_in (args.in[2])
#define conv_w (args.in[3])
#define conv_b (args.in[4])
#define w_a (args.in[5])
#define w_b (args.in[6])
#define w_o (args.in[7])
#define norm_ffn (args.in[8])
#define w_q (args.in[9])
#define sub_keys (args.in[10])
#define exp_u (args.in[11])
#define exp_v (args.in[12])
#define final_norm (args.in[13])
#define Weff ((bf16*)((bf16*)(ws + WS_WEFF)))
#define Wab ((bf16*)((bf16*)(ws + WS_WAB)))
#define Wo_t ((bf16*)((bf16*)(ws + WS_WO)))
#define Win_t ((bf16*)((bf16*)(ws + WS_WIN)))
#define XB ((bf16*)((bf16*)(ws + WS_XB)))
#define SIX ((bf16*)((bf16*)(ws + WS_SIX)))
#define VT ((bf16*)((bf16*)(ws + WS_VT)))
#define GATE ((bf16*)((bf16*)(ws + WS_GATE)))
#define MERGED ((bf16*)((bf16*)(ws + WS_MERGED)))
#define X1B ((bf16*)((bf16*)(ws + WS_X1B)))
#define TU8 ((unsigned char*)(ws + WS_TU))
#define TV8 ((unsigned char*)(ws + WS_TV))
#define SU ((float*)((float*)(ws + WS_SU)))
#define SV ((float*)((float*)(ws + WS_SV)))
#define SCORES ((float*)((float*)(ws + WS_SCORES)))
#define ROUTE ((v2u*)((v2u*)(ws + WS_ROUTE)))
#define WBUF ((float*)((float*)(ws + WS_W)))
#define SSB ((float*)((float*)(ws + WS_SS)))
#define UPART ((float*)((float*)(ws + WS_UPART)))
#define RSTD1 ((float*)((float*)(ws + WS_RSTD1)))
#define QB ((bf16*)(SIX))
#define CBB ((bf16*)(SIX + (size_t)1 * M * 512))
#define KB ((bf16*)(SIX + (size_t)2 * M * 512))
#define CCB ((bf16*)(SIX + (size_t)4 * M * 512))
#define CUB ((bf16*)(SIX + (size_t)5 * M * 512))
    for (int u = tid; u < (LDS_BYTES - LDSCTL_OFF) / 4; u += NWAVES * 64) ((LAS unsigned*)(ldsb + LDSCTL_OFF))[u] = 0u;
    __syncthreads();
    XcdBarrier bar; bar.bar = (unsigned*)(ctl + CW_BAR); bar.x = 0; bar.st = nullptr;
    if (N_LAUNCHES == 1) bar = xcd_barrier_post((unsigned*)(ctl + CW_BAR), MISC + 8);
#define GRID_BAR() do { if (N_LAUNCHES == 1) xcd_barrier(bar); } while (0)
#ifdef TPROBE
    unsigned long long t_s = 0, t_e = 0;
#define TSTAMP(k) do { if ((k) == TPROBE) t_s = __builtin_amdgcn_s_memrealtime(); if ((k) == TPROBE_END) t_e = __builtin_amdgcn_s_memrealtime(); } while (0)
#ifndef TPROBE_TID
#define TPROBE_TID 0
#endif
#define TSTALL() do { if (bx == 0 && tid == TPROBE_TID) { const unsigned long long t0_ = __builtin_amdgcn_s_memrealtime(), dt_ = (t_e - t_s) * 8ull; while (__builtin_amdgcn_s_memrealtime() - t0_ < dt_) __builtin_amdgcn_s_sleep(4); } } while (0)
#else
#define TSTAMP(k) do { } while (0)
#define TSTALL() do { } while (0)
#endif
    const int lo = args.ph_lo, hi = args.ph_hi;
#define IN(k) (lo <= (k) && (k) < hi)
#define BOTH(k) (IN(k) && IN((k) + 1))

    TSTAMP(0);
    if (IN(0)) { for (int rep = 0; rep < NREP(0); ++rep) {
        LAS float* scr = (LAS float*)(ldsb + RING_OFF + wave * 17408);
        constexpr int I_IN = (D / 64) * (NIN / 32), I_A = (512 / 64) * (D / 32), I_O = (D / 64) * (D / 32);
        constexpr int NITEMS = I_IN + 2 * I_A + I_O;
        constexpr int ABW = 3; const int aw = vcu * ABW + wave, NAW = G * ABW, cw = vcu * (NWAVES - ABW) + (wave - ABW), NCW = G * (NWAVES - ABW);
        if (wave < ABW) {
        for (int it = aw; it < NITEMS; it += NAW) {
            int r = it;
            if (r < I_IN) { p0_transpose_item(w_in, D, NIN, Win_t, 0, norm_mix, scr, r, lane); continue; } r -= I_IN;
            if (r < I_A) { p0_transpose_item(w_a, 512, D, Wab, 0, nullptr, scr, r, lane); continue; } r -= I_A;
            if (r < I_A) { p0_transpose_item(w_b, 512, D, Wab, 1024, nullptr, scr, r, lane); continue; } r -= I_A;
            p0_transpose_item(w_o, D, D, Wo_t, 0, nullptr, scr, r, lane);
        }
        TSTAMP(20);
        for (int wt = aw; wt < 64 * 32; wt += NAW) {
            const int nt = wt & 63, kt = wt >> 6, hp = nt >> 2, h = lane >> 5, l32 = lane & 31;
            f32x4 av[16], bv[16];
            { f32x4 t[16];
#pragma unroll
              for (int i = 0; i < 16; ++i) t[i] = *(const GAS f32x4*)(w_q + (size_t)(kt * 32 + 2 * i + (lane >> 5)) * 2048 + hp * 128 + 4 * (lane & 31));
#pragma unroll
              for (int i = 0; i < 16; ++i) *(LAS f32x4*)(scr + (2 * i + (lane >> 5)) * 132 + 4 * (lane & 31)) = t[i];
              LDS_WAIT();
#pragma unroll
              for (int i = 0; i < 16; ++i) av[i] = *(const LAS f32x4*)(scr + l32 * 132 + 64 * h + 4 * i);
              LDS_WAIT();
#pragma unroll
              for (int i = 0; i < 16; ++i) t[i] = *(const GAS f32x4*)(sub_keys + (size_t)(nt * 32) * 128 + 4 * (i * 64 + lane));
#pragma unroll
              for (int i = 0; i < 16; ++i) *(LAS f32x4*)(scr + (2 * i + (lane >> 5)) * 132 + 4 * (lane & 31)) = t[i];
              LDS_WAIT();
#pragma unroll
              for (int i = 0; i < 16; ++i) bv[i] = *(const LAS f32x4*)(scr + l32 * 132 + 64 * h + 4 * i);
              LDS_WAIT(); }
            f32x16 acc;
#pragma unroll
            for (int i = 0; i < 16; ++i) acc[i] = 0.f;
#pragma unroll
            for (int i = 0; i < 16; ++i) {
                acc = __builtin_amdgcn_mfma_f32_32x32x2f32(av[i].x, bv[i].x, acc, 0, 0, 0); acc = __builtin_amdgcn_mfma_f32_32x32x2f32(av[i].y, bv[i].y, acc, 0, 0, 0);
                acc = __builtin_amdgcn_mfma_f32_32x32x2f32(av[i].z, bv[i].z, acc, 0, 0, 0); acc = __builtin_amdgcn_mfma_f32_32x32x2f32(av[i].w, bv[i].w, acc, 0, 0, 0); }
            const int n = nt * 32 + l32;
#pragma unroll
            for (int rq = 0; rq < 4; ++rq) { const int kb = kt * 32 + 8 * rq + 4 * h; const f32x4 g = *(const GAS f32x4*)(norm_ffn + kb);
                v2u o; o.x = pk2(acc[4 * rq] * g.x, acc[4 * rq + 1] * g.y); o.y = pk2(acc[4 * rq + 2] * g.z, acc[4 * rq + 3] * g.w);
                *(GAS v2u*)(Weff + (size_t)n * D + kb) = o; }
        }
        TSTAMP(21);
        } else {
        for (int m0 = cw; m0 < M; m0 += 4 * NCW) {
            f32x4 v[4][4]; float s[4];
#pragma unroll
            for (int q = 0; q < 4; ++q) { const int m = m0 + q * NCW; const GAS f32x4* xr = (const GAS f32x4*)(x + (size_t)(m < M ? m : m0) * D) + lane;
#pragma unroll
                for (int j = 0; j < 4; ++j) v[q][j] = __builtin_nontemporal_load(xr + 64 * j); }
#pragma unroll
            for (int q = 0; q < 4; ++q) { s[q] = 0.f;
#pragma unroll
                for (int j = 0; j < 4; ++j) s[q] += (v[q][j].x * v[q][j].x + v[q][j].y * v[q][j].y) + (v[q][j].z * v[q][j].z + v[q][j].w * v[q][j].w); }
#pragma unroll
            for (int o = 1; o < 64; o <<= 1) {
#pragma unroll
                for (int q = 0; q < 4; ++q) s[q] += __shfl_xor(s[q], o); }
#pragma unroll
            for (int q = 0; q < 4; ++q) { const int m = m0 + q * NCW; if (m < M) {
                const float rstd = 1.0f / sqrtf(s[q] * (1.0f / D) + RMS_EPS);
                GAS v2u* o8 = (GAS v2u*)(XB + (size_t)m * D) + lane;
#pragma unroll
                for (int j = 0; j < 4; ++j) { v2u o; o.x = pk2(v[q][j].x, v[q][j].y); o.y = pk2(v[q][j].z, v[q][j].w); o8[64 * j] = o; }
                if (lane == 0) RSTD1[m] = rstd; } }
        }
        TSTAMP(22);
        for (int e0 = cw; e0 < NEXP; e0 += 2 * NCW) {
            float v[4][16]; float am[4]; int ee[4];
#pragma unroll
            for (int q = 0; q < 4; ++q) { const int e = e0 + (q >> 1) * NCW; ee[q] = e < NEXP ? e : e0; const float* src = ((q & 1) ? exp_v : exp_u) + (size_t)ee[q] * D; const GAS f32x4* sp = (const GAS f32x4*)src;
#pragma unroll
                for (int j = 0; j < 2; ++j) { const f32x4 a = __builtin_nontemporal_load(sp + 2 * lane + 128 * j), b = __builtin_nontemporal_load(sp + 2 * lane + 128 * j + 1);
                    v[q][8 * j + 0] = a.x; v[q][8 * j + 1] = a.y; v[q][8 * j + 2] = a.z; v[q][8 * j + 3] = a.w; v[q][8 * j + 4] = b.x; v[q][8 * j + 5] = b.y; v[q][8 * j + 6] = b.z; v[q][8 * j + 7] = b.w; } }
            { const GAS f32x4* gp = (const GAS f32x4*)norm_ffn;
#pragma unroll
              for (int j = 0; j < 2; ++j) { const f32x4 ga = gp[2 * lane + 128 * j], gb = gp[2 * lane + 128 * j + 1];
#pragma unroll
                for (int q = 0; q < 4; q += 2) { v[q][8 * j + 0] *= ga.x; v[q][8 * j + 1] *= ga.y; v[q][8 * j + 2] *= ga.z; v[q][8 * j + 3] *= ga.w; v[q][8 * j + 4] *= gb.x; v[q][8 * j + 5] *= gb.y; v[q][8 * j + 6] *= gb.z; v[q][8 * j + 7] *= gb.w; } } }
#pragma unroll
            for (int q = 0; q < 4; ++q) { am[q] = 0.f;
#pragma unroll
                for (int i = 0; i < 16; ++i) am[q] = __builtin_fmaxf(am[q], __builtin_fabsf(v[q][i])); }
#pragma unroll
            for (int o = 1; o < 64; o <<= 1) {
#pragma unroll
                for (int q = 0; q < 4; ++q) am[q] = __builtin_fmaxf(am[q], __shfl_xor(am[q], o)); }
#pragma unroll
            for (int q = 0; q < 4; ++q) { const int e = e0 + (q >> 1) * NCW; if (e < NEXP) {
                const float top = (q & 1) ? 384.0f : 127.0f;
                const float sc = (am[q] > 0.f) ? top / am[q] : 1.0f, inv = (am[q] > 0.f) ? am[q] * (1.0f / top) : 1.0f;
                v2u q0, q1;
                if (q & 1) {
                { int w = __builtin_amdgcn_cvt_pk_fp8_f32(v[q][0] * sc, v[q][1] * sc, 0, false); w = __builtin_amdgcn_cvt_pk_fp8_f32(v[q][2] * sc, v[q][3] * sc, w, true); q0.x = (unsigned)w; }
                { int w = __builtin_amdgcn_cvt_pk_fp8_f32(v[q][4] * sc, v[q][5] * sc, 0, false); w = __builtin_amdgcn_cvt_pk_fp8_f32(v[q][6] * sc, v[q][7] * sc, w, true); q0.y = (unsigned)w; }
                { int w = __builtin_amdgcn_cvt_pk_fp8_f32(v[q][8] * sc, v[q][9] * sc, 0, false); w = __builtin_amdgcn_cvt_pk_fp8_f32(v[q][10] * sc, v[q][11] * sc, w, true); q1.x = (unsigned)w; }
                { int w = __builtin_amdgcn_cvt_pk_fp8_f32(v[q][12] * sc, v[q][13] * sc, 0, false); w = __builtin_amdgcn_cvt_pk_fp8_f32(v[q][14] * sc, v[q][15] * sc, w, true); q1.y = (unsigned)w; }
                } else {
                    unsigned w4[4];
#pragma unroll
                    for (int j = 0; j < 4; ++j) { const int i0 = (int)__builtin_rintf(v[q][4 * j] * sc), i1 = (int)__builtin_rintf(v[q][4 * j + 1] * sc), i2 = (int)__builtin_rintf(v[q][4 * j + 2] * sc), i3 = (int)__builtin_rintf(v[q][4 * j + 3] * sc);
                        w4[j] = ((unsigned)i0 & 255u) | (((unsigned)i1 & 255u) << 8) | (((unsigned)i2 & 255u) << 16) | ((unsigned)i3 << 24); }
                    q0.x = w4[0]; q0.y = w4[1]; q1.x = w4[2]; q1.y = w4[3];
                }
                unsigned char* dst = (q & 1) ? TV8 : TU8; const int s0 = lane >> 4, o8 = 8 * (lane & 15);
                *(GAS v2u*)(dst + ((size_t)s0 * NEXP + e) * 128 + o8) = q0; *(GAS v2u*)(dst + ((size_t)(s0 + 4) * NEXP + e) * 128 + o8) = q1;
                if (lane == 0) ((q & 1) ? SV : SU)[e] = inv; } }
        }
                TSTAMP(23);
        }
}
        if (BOTH(0)) GRID_BAR();
    }

    TSTAMP(1);
    if (IN(1)) { for (int rep = 0; rep < NREP(1); ++rep) { if (rep) GRID_BAR();
        pg8::Gemm g{XB, Win_t, M, NIN, D}; pg8::StaticOrder S; S.init(M, NIN, G, (int)blockIdx.x);
        pg8::EpiProj E{SIX, VT, GATE, RSTD1, (DUP_MASK & 64) ? rep : 0};
        pg8::gemm_phase<pg8::EpiProj, pg8::StaticOrder, true, true>(ldsb + RING_OFF, g, S, E); }
        if (DUP_MASK & 128) { const unsigned long long t0 = __builtin_amdgcn_s_memrealtime(); while (__builtin_amdgcn_s_memrealtime() - t0 < 15000ull) __builtin_amdgcn_s_sleep(8); }
        if (BOTH(1)) GRID_BAR();
    }

    TSTAMP(2);
    if (IN(2)) {
        for (int rep = 0; rep < NREP(2); ++rep) {
        const bool dummy = (rep + 1 < NREP(2));
        conv_phase(CBB, CCB, CUB, dummy ? XB : CBB, conv_w, conv_b, gw * 64 + lane, NGW * 64);
        TSTAMP(24);
        for (int it = gw; it < BATCH * NH * (T / 32); it += NGW) {
            const int bh = it >> 7, qblk = it & 127;
            attn_item(QB, KB, VT, dummy ? MERGED : QB, bh >> 3, bh & 7, qblk, ldsb + RING_OFF + wave * 9216, lane);
        }
        }
        if (BOTH(2)) GRID_BAR();
    }

    TSTAMP(3);
    if (IN(3)) { for (int rep = 0; rep < NREP(3); ++rep) { if (rep) GRID_BAR();
        pg8::Gemm g{QB, Wab, 2 * M, 2048, 512}; pg8::PairOrder S; S.init(G, (int)blockIdx.x);
        pg8::EpiGate E{out, MERGED, GATE, GATE + (size_t)M * 1024};
        pg8::gemm_phase<pg8::EpiGate, pg8::PairOrder, true, true>(ldsb + RING_OFF, g, S, E); }
        if (BOTH(3)) GRID_BAR();
    }

    TSTAMP(4);
    if (IN(4)) { for (int rep = 0; rep < NREP(4); ++rep) { if (rep) GRID_BAR();
        pg8::Gemm g{MERGED, Wo_t, M, D, D}; pg8::StaticOrder S; S.init(M, D, G, (int)blockIdx.x);
        pg8::EpiWo E{x, X1B};
        pg8::gemm_phase<pg8::EpiWo, pg8::StaticOrder, false, true>(ldsb + RING_OFF, g, S, E);
        }
        if (BOTH(4)) GRID_BAR();
    }

    TSTAMP(5);
    if (IN(5)) { for (int rep = 0; rep < NREP(5); ++rep) { if (rep) GRID_BAR();
        pg8::Gemm g{X1B, Weff, M, 2048, D}; pg8::StaticOrder S; S.init(M, 2048, G, (int)blockIdx.x);
        pg8::EpiScores E{(unsigned short*)SCORES};
        pg8::gemm_phase<pg8::EpiScores, pg8::StaticOrder, true, true>(ldsb + RING_OFF, g, S, E);
        asm volatile("s_waitcnt vmcnt(0)" ::: "memory"); __syncthreads();
        int nu = 0; { pg8::Unit u; while (S.next(nu, u)) ++nu; }
        LAS unsigned char* scr = ldsb + RING_OFF + wave * 8192;
        for (int t = wave; t < nu * 4; t += NWAVES) { pg8::Unit u; S.next(t >> 2, u); route_task((const unsigned short*)SCORES, ROUTE, u.pm * 256 + (t & 3) * 64, u.pn, scr, lane); } }
        if (BOTH(5)) GRID_BAR();
    }
    const bool sliced_ok = (G % 8 == 0) && (M % ((G / 8) * NWAVES) == 0);
    const bool fused_ok = (G % 8 == 0) && (M == G * NWAVES * 8);

    TSTAMP(7);
    if (IN(7)) {
        LAS unsigned char* scr = ldsb + RING_OFF + wave * 8192;
#ifdef DEBUG_U
        if (1) {} else
#endif
        if (fused_ok) peer_fused(bx & 7, (bx & 7) + 8 * ((bx >> 3) * NWAVES + wave), M / 8, ROUTE, X1B, TU8, TV8, SU, SV, final_norm, out, ldsb + RING_OFF + wave * 16384, lane);
        else if (sliced_ok) { const int nj = G >> 3; peer_u_phase_dot4(bx & 7, (bx >> 3) * NWAVES + wave, nj * NWAVES, M / (nj * NWAVES), ROUTE, (const float*)X1B, TU8, UPART, scr, lane); }
        else for (int s8 = 0; s8 < 8; ++s8) { const int nt = (M - 1 - gw) / NGW + 1; if (gw < M) peer_u_phase_dot4(s8, gw, NGW, nt, ROUTE, (const float*)X1B, TU8, UPART, scr, lane); }
        if (BOTH(7) && !fused_ok) GRID_BAR();
    }

    TSTAMP(8);
    if (IN(8) && !fused_ok) {
#ifdef DEBUG_U
        for (int tok = gw; tok < M; tok += NGW) peer_u_debug(tok, ROUTE, out, TU8, SU, SV, WBUF, lane);
#else
        for (int tok = gw; tok < M; tok += 2 * NGW) peer_w_token2(tok, (tok + NGW < M) ? tok + NGW : tok, ROUTE, X1B, (const bf16*)UPART, SU, SV, WBUF, lane);
#endif
        if (BOTH(8)) GRID_BAR();
    }

    TSTAMP(9);
    if (IN(9) && !fused_ok) {
        LAS unsigned char* scr = ldsb + RING_OFF + wave * 8192;
#ifdef DEBUG_V
        for (int tok = gw; tok < M; tok += NGW) peer_v_debug(tok, ROUTE, WBUF, TV8, out, SSB, lane);
        if (0)
#endif
        if (sliced_ok) { const int nj = G >> 3; peer_v_phase(bx & 7, (bx >> 3) * NWAVES + wave, nj * NWAVES, M / (nj * NWAVES), ROUTE, WBUF, TV8, X1B, out, SSB, scr, lane); }
        else for (int s8 = 0; s8 < 8; ++s8) { const int nt = (M - 1 - gw) / NGW + 1; if (gw < M) peer_v_phase(s8, gw, NGW, nt, ROUTE, WBUF, TV8, X1B, out, SSB, scr, lane); }
        if (BOTH(9)) GRID_BAR();
    }

    TSTAMP(10);
    if (IN(10) && !fused_ok) {
        for (int tok = gw; tok < M; tok += NGW) {
            GAS f32x4* op = (GAS f32x4*)(out + (size_t)tok * D) + lane; const GAS f32x4* gp = (const GAS f32x4*)final_norm + lane;
            f32x4 v[4]; float s2 = 0.f;
#pragma unroll
            for (int j = 0; j < 4; ++j) { v[j] = op[64 * j]; s2 += (v[j].x * v[j].x + v[j].y * v[j].y) + (v[j].z * v[j].z + v[j].w * v[j].w); }
            const float rstd3 = 1.0f / sqrtf(wave_sum(s2) * (1.0f / D) + RMS_EPS);
#pragma unroll
            for (int j = 0; j < 4; ++j) { const f32x4 g = gp[64 * j]; f32x4 o; o.x = v[j].x * rstd3 * g.x; o.y = v[j].y * rstd3 * g.y; o.z = v[j].z * rstd3 * g.z; o.w = v[j].w * rstd3 * g.w; op[64 * j] = o; }
        }
    }
    TSTAMP(11);
    TSTALL();
#undef IN
#undef BOTH
#undef GRID_BAR
#undef norm_mix
#undef w_in
#undef conv_w
#undef conv_b
#undef w_a
#undef w_b
#undef w_o
#undef norm_ffn
#undef w_q
#undef sub_keys
#undef exp_u
#undef exp_v
#undef final_norm
#undef Weff
#undef Wab
#undef Wo_t
#undef Win_t
#undef XB
#undef SIX
#undef VT
#undef GATE
#undef MERGED
#undef X1B
#undef TU8
#undef TV8
#undef SU
#undef SV
#undef SCORES
#undef ROUTE
#undef WBUF
#undef SSB
#undef UPART
#undef RSTD1
#undef QB
#undef CBB
#undef KB
#undef CCB
#undef CUB
}

extern "C" void kernel_launch(void* const* d_in, const int* in_sizes, int n_in, void* d_out, int out_size, void* d_ws, size_t ws_size, hipStream_t stream) {
    static int grid = 0;
    if (grid == 0) {
        if (n_in != 14 || in_sizes[0] != M * D || out_size != M * D || ws_size < WS_END) { fprintf(stderr, "kernel_launch: built for 14 inputs, x/out of %d floats, >= %zu bytes of workspace; got n_in %d, in0 %d, out %d, ws %zu; nothing launched\n", M * D, (size_t)WS_END, n_in, n_in > 0 ? in_sizes[0] : -1, out_size, ws_size); grid = -1; return; }
        int dev = 0, cus = 0, per_cu = 0;
        if (hipGetDevice(&dev) != hipSuccess || hipDeviceGetAttribute(&cus, hipDeviceAttributeMultiprocessorCount, dev) != hipSuccess) { fprintf(stderr, "kernel_launch: device query failed\n"); grid = -1; return; }
        if (hipFuncSetAttribute((const void*)hybrid_fwd, hipFuncAttributeMaxDynamicSharedMemorySize, LDS_BYTES) != hipSuccess) { fprintf(stderr, "kernel_launch: hipFuncSetAttribute failed\n"); grid = -1; return; }
        if (hipOccupancyMaxActiveBlocksPerMultiprocessor(&per_cu, (const void*)hybrid_fwd, NWAVES * 64, LDS_BYTES) != hipSuccess || per_cu < 1) { fprintf(stderr, "kernel_launch: occupancy query reports %d workgroups per CU\n", per_cu); per_cu = 1; }
        (void)hipGetLastError();
        grid = cus;
    }
    if (grid < 0) return;
    if (hipMemsetAsync((char*)d_ws + WS_CTL, 0, CTL_ZERO_BYTES, stream) != hipSuccess) { fprintf(stderr, "kernel_launch: hipMemsetAsync failed\n"); return; }
    Args a{};
    for (int i = 0; i < 14; ++i) a.in[i] = (const float*)d_in[i];
    a.out = (float*)d_out; a.ws = (unsigned char*)d_ws;
#ifdef PROBE_SEQ
    const int seq[] = PROBE_SEQ; const int nseq = (int)(sizeof(seq) / sizeof(int));
#else
    const int seq[] = {0, 1, 2, 3, 4, 5, 6, 7, 8, 9, 10}; const int nseq = (N_LAUNCHES == 1) ? 1 : 11;
#endif
    for (int li = 0; li < nseq; ++li) {
        a.ph_lo = (N_LAUNCHES == 1) ? 0 : seq[li]; a.ph_hi = (N_LAUNCHES == 1) ? N_PHASES : seq[li] + 1; a.li = li;
        hipLaunchKernelGGL(hybrid_fwd, dim3(grid), dim3(NWAVES * 64), LDS_BYTES, stream, a);
        const hipError_t le = hipPeekAtLastError();
        if (le != hipSuccess) { fprintf(stderr, "kernel_launch: launch %d failed: %s\n", li, hipGetErrorName(le)); break; }
    }
}
```

```cpp
#define DUP_MASK 0
#include <hip/hip_runtime.h>
#include <cstdio>
#include <cstdint>
#include <cmath>
namespace pg8 {
#define PG8_LAS __attribute__((address_space(3)))
typedef unsigned short bf16_t;
typedef short bf16x8 __attribute__((ext_vector_type(8)));
typedef float f32x4 __attribute__((ext_vector_type(4)));
typedef unsigned u32x4 __attribute__((ext_vector_type(4)));
constexpr int BM = 256, BK = 64, HALF = 128, HTB = HALF * BK * 2  , STAGE_BYTES = 8 * HTB, NXCD = 8, WGM = 8;

__host__ __device__ __forceinline__ int lds_byte(int r, int c) { const int st = (r >> 4) * 2 + (c >> 5), rr = r & 15, cc = c & 31, ob = rr * 64 + cc * 2; return st * 1024 + (ob ^ (((ob >> 9) & 1) << 5)); }
__host__ __device__ __forceinline__ void stage_rc(int b, int& R, int& C) { const int st = b / 1024, sb = b % 1024, swz = sb ^ (((sb >> 9) & 1) << 5); R = (st >> 1) * 16 + swz / 64; C = (st & 1) * 32 + (swz % 64) / 2; }
__host__ __device__ __forceinline__ int perm32(int rho) { const int n = rho >> 4, i = rho & 15; return 8 * (i >> 2) + 4 * n + (i & 3); }

struct Unit { int pm, pn; };
struct Gemm { const bf16_t* A; const bf16_t* Bt; int M, N, K; };

struct StaticOrder {
    int nM, nN, nwg, G, c;
    __host__ __device__ void init(int M, int N, int G_, int c_) { nM = M / BM; nN = N / BM; nwg = nM * nN; G = G_; c = c_; }
    __host__ __device__ bool next(int i, Unit& u) const {
        const long L = (long)i * G + c; if (L >= nwg) return false;
        int wgid = (int)L; { const int q = nwg / NXCD, r = nwg % NXCD, xcd = wgid % NXCD, off = wgid / NXCD; wgid = (xcd < r ? xcd * (q + 1) : r * (q + 1) + (xcd - r) * q) + off; }
        const int nig = WGM * nN, gid = wgid / nig, fm = gid * WGM, gsz = (nM - fm) < WGM ? (nM - fm) : WGM;
        u.pm = fm + ((wgid % nig) % gsz); u.pn = (wgid % nig) / gsz; return true;
    }
    __device__ __forceinline__ void a_ready(const Unit&) const {}
    __device__ __forceinline__ void done(const Unit&) const {}
};

__device__ __forceinline__ unsigned cvt_pk_bf16(float lo, float hi) { unsigned r; asm volatile("v_cvt_pk_bf16_f32 %0, %1, %2" : "=v"(r) : "v"(lo), "v"(hi)); return r; }
constexpr int MTOK = 16384;
__device__ __forceinline__ unsigned f2bf_rne(float f) { unsigned u = __builtin_bit_cast(unsigned, f); return (u + 0x7fffu + ((u >> 16) & 1u)) >> 16; }
__device__ __forceinline__ float bf_lo(unsigned w) { return __builtin_bit_cast(float, w << 16); }
__device__ __forceinline__ float bf_hi(unsigned w) { return __builtin_bit_cast(float, w & 0xffff0000u); }
__device__ __forceinline__ float sigmoid_fast(float x) { return __builtin_amdgcn_rcpf(1.0f + __builtin_amdgcn_exp2f(-1.4426950408889634f * x)); }

struct EpiProj {
    static constexpr bool PERM = true, AFTER_DRAIN = false;
    bf16_t* six;
    bf16_t* vt;
    bf16_t* gate;
    const float* rstd; int skip;
    __device__ __forceinline__ void operator()(const f32x4 (&acc)[2][2][4][2], const Unit& u, int wr, int wc, int fr, int fq) const {
        const int row0 = u.pm * BM + wr * 64 + fr; const int colt = u.pn * BM;
        if (skip) return;
        if (colt < 3072) {
            const int t = colt >> 9, cc = colt & 511;
            if (t == 2) {
#pragma unroll
                for (int ai = 0; ai < 2; ++ai)
#pragma unroll
                    for (int m = 0; m < 4; ++m) { const int r = row0 + ai * HALF + m * 16; const float rs = rstd[r]; const int b = r >> 12, tt = r & 4095;
#pragma unroll
                        for (int bj = 0; bj < 2; ++bj) { const int c0 = cc + bj * HALF + wc * 32 + 8 * fq; const int hh = c0 >> 6, d0 = c0 & 63;
                            bf16_t* p = vt + ((size_t)((b * 8 + hh) * 64 + d0)) * 4096 + tt;
#pragma unroll
                            for (int n = 0; n < 2; ++n)
#pragma unroll
                                for (int i = 0; i < 4; ++i) p[(size_t)(4 * n + i) * 4096] = (bf16_t)f2bf_rne(acc[ai][bj][m][n][i] * rs); } }
            } else {
                const int bufidx = (t == 0) ? 0 : (t == 1) ? 2 : (t == 3) ? 1 : t;
                bf16_t* base = six + (size_t)bufidx * MTOK * 512; const float sc = (t == 0) ? 0.125f : 1.0f;
                const int col0 = cc + wc * 32 + 8 * fq;
#pragma unroll
                for (int ai = 0; ai < 2; ++ai)
#pragma unroll
                    for (int m = 0; m < 4; ++m) { const int r = row0 + ai * HALF + m * 16; const float rs = rstd[r] * sc; bf16_t* rowp = base + (size_t)r * 512 + col0;
#pragma unroll
                        for (int bj = 0; bj < 2; ++bj) { const f32x4 v0 = acc[ai][bj][m][0] * rs, v1 = acc[ai][bj][m][1] * rs;
                            u32x4 w; w.x = cvt_pk_bf16(v0[0], v0[1]); w.y = cvt_pk_bf16(v0[2], v0[3]); w.z = cvt_pk_bf16(v1[0], v1[1]); w.w = cvt_pk_bf16(v1[2], v1[3]);
                            *(u32x4*)(rowp + bj * HALF) = w; } }
            }
        } else {
            const int gi = (colt - 3072) >> 10, cc = (colt - 3072) & 1023;
            bf16_t* base = gate + (size_t)gi * MTOK * 1024; const int col0 = cc + wc * 32 + 8 * fq;
#pragma unroll
            for (int ai = 0; ai < 2; ++ai)
#pragma unroll
                for (int m = 0; m < 4; ++m) { const int r = row0 + ai * HALF + m * 16; const float rs = rstd[r]; bf16_t* rowp = base + (size_t)r * 1024 + col0;
#pragma unroll
                    for (int bj = 0; bj < 2; ++bj) { f32x4 v0 = acc[ai][bj][m][0] * rs, v1 = acc[ai][bj][m][1] * rs;
#pragma unroll
                        for (int i = 0; i < 4; ++i) { v0[i] = sigmoid_fast(v0[i]); v1[i] = sigmoid_fast(v1[i]); }
                        u32x4 w; w.x = cvt_pk_bf16(v0[0], v0[1]); w.y = cvt_pk_bf16(v0[2], v0[3]); w.z = cvt_pk_bf16(v1[0], v1[1]); w.w = cvt_pk_bf16(v1[2], v1[3]);
                        *(u32x4*)(rowp + bj * HALF) = w; } }
        }
    }
};

struct EpiGate {
    static constexpr bool PERM = true, AFTER_DRAIN = false;
    float* P; bf16_t* merged; const bf16_t* g0; const bf16_t* g1;
    __device__ __forceinline__ void operator()(const f32x4 (&acc)[2][2][4][2], const Unit& u, int wr, int wc, int fr, int fq) const {
        const int which = (u.pm >= 64) ? 1 : 0; const int pm = u.pm - 64 * which, pn = u.pn - 4 * which;
        const int row0 = pm * BM + wr * 64 + fr, col0 = pn * BM + wc * 32 + 8 * fq; const bf16_t* g = which ? g1 : g0;
#pragma unroll
        for (int ai = 0; ai < 2; ++ai)
#pragma unroll
            for (int m = 0; m < 4; ++m) { const int r = row0 + ai * HALF + m * 16;
#pragma unroll
                for (int bj = 0; bj < 2; ++bj) { const size_t off = (size_t)r * 1024 + col0 + bj * HALF;
                    const u32x4 gv = *(const u32x4*)(g + off);
                    f32x4 a0 = acc[ai][bj][m][0], a1 = acc[ai][bj][m][1];
                    a0[0] *= bf_lo(gv.x); a0[1] *= bf_hi(gv.x); a0[2] *= bf_lo(gv.y); a0[3] *= bf_hi(gv.y);
                    a1[0] *= bf_lo(gv.z); a1[1] *= bf_hi(gv.z); a1[2] *= bf_lo(gv.w); a1[3] *= bf_hi(gv.w);
                    if (!which) { u32x4 w; w.x = cvt_pk_bf16(a0[0], a0[1]); w.y = cvt_pk_bf16(a0[2], a0[3]); w.z = cvt_pk_bf16(a1[0], a1[1]); w.w = cvt_pk_bf16(a1[2], a1[3]); *(u32x4*)((bf16_t*)P + off) = w; }
                    else { const u32x4 pw = *(const u32x4*)((const bf16_t*)P + off);
                        a0[0] += bf_lo(pw.x); a0[1] += bf_hi(pw.x); a0[2] += bf_lo(pw.y); a0[3] += bf_hi(pw.y); a1[0] += bf_lo(pw.z); a1[1] += bf_hi(pw.z); a1[2] += bf_lo(pw.w); a1[3] += bf_hi(pw.w);
                        u32x4 w; w.x = cvt_pk_bf16(a0[0], a0[1]); w.y = cvt_pk_bf16(a0[2], a0[3]); w.z = cvt_pk_bf16(a1[0], a1[1]); w.w = cvt_pk_bf16(a1[2], a1[3]);
                        *(u32x4*)(merged + off) = w; } } }
    }
};
struct PairOrder {
    StaticOrder so;
    __host__ __device__ void init(int G_, int c_) { so.init(MTOK, 1024, G_, c_); }
    __host__ __device__ bool next(int i, Unit& u) const { Unit t; if (!so.next(i >> 1, t)) return false; const int w = i & 1; u.pm = t.pm + 64 * w; u.pn = t.pn + 4 * w; return true; }
    __device__ __forceinline__ void a_ready(const Unit&) const {}
    __device__ __forceinline__ void done(const Unit&) const {}
};

struct EpiWo {
    static constexpr bool PERM = true, AFTER_DRAIN = false;
    const float* x; bf16_t* x1b;
    __device__ __forceinline__ void operator()(const f32x4 (&acc)[2][2][4][2], const Unit& u, int wr, int wc, int fr, int fq) const {
        const int row0 = u.pm * BM + wr * 64 + fr, col0 = u.pn * BM + wc * 32 + 8 * fq;
#pragma unroll
        for (int ai = 0; ai < 2; ++ai)
#pragma unroll
            for (int m = 0; m < 4; ++m) { const int r = row0 + ai * HALF + m * 16;
#pragma unroll
                for (int bj = 0; bj < 2; ++bj) { const size_t off = (size_t)r * 1024 + col0 + bj * HALF;
                    const f32x4 a0 = acc[ai][bj][m][0] + *(const f32x4*)(x + off), a1 = acc[ai][bj][m][1] + *(const f32x4*)(x + off + 4);
                    u32x4 w; w.x = cvt_pk_bf16(a0[0], a0[1]); w.y = cvt_pk_bf16(a0[2], a0[3]); w.z = cvt_pk_bf16(a1[0], a1[1]); w.w = cvt_pk_bf16(a1[2], a1[3]);
                    *(u32x4*)(x1b + off) = w; } }
    }
};
typedef _Float16 f16x2_t __attribute__((ext_vector_type(2)));
typedef float f32x2e __attribute__((ext_vector_type(2)));
__device__ __forceinline__ unsigned pk_f16(float lo, float hi) { f32x2e v = {lo, hi}; f16x2_t h = __builtin_convertvector(v, f16x2_t); return __builtin_bit_cast(unsigned, h); }
struct EpiScores {
    static constexpr bool PERM = true, AFTER_DRAIN = false;
    unsigned short* S;
    __device__ __forceinline__ void operator()(const f32x4 (&acc)[2][2][4][2], const Unit& u, int wr, int wc, int fr, int fq) const {
        const int row0 = u.pm * BM + wr * 64 + fr, col0 = u.pn * BM + wc * 32 + 8 * fq;
#pragma unroll
        for (int ai = 0; ai < 2; ++ai)
#pragma unroll
            for (int m = 0; m < 4; ++m) { const int r = row0 + ai * HALF + m * 16;
#pragma unroll
                for (int bj = 0; bj < 2; ++bj) { const size_t off = ((size_t)((col0 + bj * HALF) >> 3) * MTOK + r) * 8;
                    const f32x4 a0 = acc[ai][bj][m][0], a1 = acc[ai][bj][m][1];
                    u32x4 w; w.x = pk_f16(a0[0], a0[1]); w.y = pk_f16(a0[2], a0[3]); w.z = pk_f16(a1[0], a1[1]); w.w = pk_f16(a1[2], a1[3]);
                    *(u32x4*)(S + off) = w; } }
    }
};
template <class Epi, class Sched, bool ALIGN_EPI = false, bool SP2 = false>
__device__ __forceinline__ void gemm_phase(PG8_LAS unsigned char* lds, const Gemm g, const Sched& S, const Epi& E) {
    const int tid = threadIdx.x, wid = __builtin_amdgcn_readfirstlane(tid >> 6), lane = tid & 63, wr = wid >> 2, wc = wid & 3, fr = lane & 15, fq = lane >> 4;
    const int K = g.K, nt = K / BK;
    unsigned voffA[2], voffB[2];
#pragma unroll
    for (int i = 0; i < 2; ++i) { int R, C; stage_rc(tid * 16 + i * 8192, R, C); const int Rb = Epi::PERM ? ((R & ~31) + perm32(R & 31)) : R;
        voffA[i] = (unsigned)(R * K + C) * 2u; voffB[i] = (unsigned)(Rb * K + C) * 2u; }
    const size_t kstep = (size_t)(BK * 2);
    const size_t hstep = (size_t)HALF * K * 2;
    const size_t tstep = 2 * hstep;
    const unsigned ldsw = (unsigned)wid * 1024u;
    const int aoff = lds_byte(wr * 64 + fr, fq * 8), boff = lds_byte(wc * 32 + fr, fq * 8);
#define PG8_SA(b, h) (((b) * 2 + (h)) * HTB)
#define PG8_SB(b, h) ((4 + (b) * 2 + (h)) * HTB)
#define PG8_STAGE(bufoff, gbase, voff) do { _Pragma("unroll") for (int _i = 0; _i < 2; ++_i) \
        __builtin_amdgcn_global_load_lds((const unsigned*)((const char*)(gbase) + (voff)[_i]), (PG8_LAS unsigned*)(lds + (bufoff) + ldsw + _i * 8192), 16, 0, 0); } while (0)
#define PG8_LDA(dst, b, h) do { _Pragma("unroll") for (int m = 0; m < 4; ++m) _Pragma("unroll") for (int k = 0; k < 2; ++k) dst[m][k] = *(const PG8_LAS bf16x8*)(lds + PG8_SA(b, h) + aoff + m * 2048 + k * 1024); } while (0)
#define PG8_LDB(dst, b, h) do { _Pragma("unroll") for (int n = 0; n < 2; ++n) _Pragma("unroll") for (int k = 0; k < 2; ++k) dst[n][k] = *(const PG8_LAS bf16x8*)(lds + PG8_SB(b, h) + boff + n * 2048 + k * 1024); } while (0)
#define PG8_MMA(ai, bj, At, Bt) do { __builtin_amdgcn_s_setprio(1); _Pragma("unroll") for (int m = 0; m < 4; ++m) _Pragma("unroll") for (int n = 0; n < 2; ++n) _Pragma("unroll") for (int k = 0; k < 2; ++k) \
        acc[ai][bj][m][n] = __builtin_amdgcn_mfma_f32_16x16x32_bf16(Bt[n][k], At[m][k], acc[ai][bj][m][n], 0, 0, 0); __builtin_amdgcn_s_setprio(0); } while (0)
#define PG8_WAIT_V(n) asm volatile("s_waitcnt vmcnt(" #n ")" ::: "memory")
#define PG8_WAIT_L(n) asm volatile("s_waitcnt lgkmcnt(" #n ")" ::: "memory")
#define PG8_BAR __builtin_amdgcn_s_barrier()
#define PG8_SCHED __builtin_amdgcn_sched_barrier(0)
    Unit cur, nxt; int ui = 0;
    if (!S.next(0, cur)) return;
    f32x4 acc[2][2][4][2];
#pragma unroll
    for (int a = 0; a < 2; ++a)
#pragma unroll
        for (int b = 0; b < 2; ++b)
#pragma unroll
            for (int m = 0; m < 4; ++m)
#pragma unroll
                for (int n = 0; n < 2; ++n) acc[a][b][m][n] = (f32x4){0.f, 0.f, 0.f, 0.f};
    bf16x8 At[4][2], B0[2][2], B1[2][2];
    const char* cA = (const char*)g.A + (size_t)cur.pm * tstep; const char* cB = (const char*)g.Bt + (size_t)cur.pn * tstep;
    S.a_ready(cur);
    if constexpr (SP2) {
        PG8_STAGE(PG8_SB(0, 0), cB, voffB); PG8_STAGE(PG8_SB(0, 1), cB + hstep, voffB); PG8_STAGE(PG8_SA(0, 0), cA, voffA); PG8_STAGE(PG8_SA(0, 1), cA + hstep, voffA);
        if (wr == 1) PG8_BAR;
        PG8_WAIT_V(2); PG8_BAR;
        PG8_STAGE(PG8_SB(1, 0), cB + kstep, voffB); PG8_STAGE(PG8_SA(1, 0), cA + kstep, voffA); PG8_STAGE(PG8_SB(1, 1), cB + hstep + kstep, voffB);
        PG8_WAIT_V(6); PG8_BAR;
    } else {
        PG8_STAGE(PG8_SB(0, 0), cB, voffB); PG8_STAGE(PG8_SA(0, 0), cA, voffA); PG8_STAGE(PG8_SB(0, 1), cB + hstep, voffB); PG8_STAGE(PG8_SA(0, 1), cA + hstep, voffA);
        if (wr == 1) PG8_BAR;
        PG8_WAIT_V(4); PG8_BAR;
        PG8_STAGE(PG8_SB(1, 0), cB + kstep, voffB); PG8_STAGE(PG8_SA(1, 0), cA + kstep, voffA); PG8_STAGE(PG8_SB(1, 1), cB + hstep + kstep, voffB);
        PG8_WAIT_V(6); PG8_BAR;
    }
    for (;;) {
        const bool has_next = S.next(ui + 1, nxt);
        const char* nA = has_next ? (const char*)g.A + (size_t)nxt.pm * tstep : cA; const char* nB = has_next ? (const char*)g.Bt + (size_t)nxt.pn * tstep : cB;
        for (int t = 0; t < nt; t += 2) {
            const bool last = (t == nt - 2);
            const char* a1 = cA + (size_t)(t + 1) * kstep;
            const char* a2 = last ? nA : cA + (size_t)(t + 2) * kstep; const char* b2 = last ? nB : cB + (size_t)(t + 2) * kstep;
            const char* a3 = a2 + kstep; const char* b3 = b2 + kstep;
            if (last && has_next) S.a_ready(nxt);
            if constexpr (SP2) {
            PG8_LDB(B0, 0, 0); PG8_LDB(B1, 0, 1); PG8_SCHED; PG8_LDA(At, 0, 0); PG8_STAGE(PG8_SA(1, 1), a1 + hstep, voffA);
            PG8_WAIT_V(8); PG8_WAIT_L(0); PG8_BAR; PG8_MMA(0, 0, At, B0); PG8_MMA(0, 1, At, B1); PG8_BAR; PG8_SCHED;
            PG8_LDA(At, 0, 1); PG8_STAGE(PG8_SB(0, 0), b2, voffB); PG8_STAGE(PG8_SB(0, 1), b2 + hstep, voffB); PG8_STAGE(PG8_SA(0, 0), a2, voffA);
            PG8_WAIT_V(8); PG8_WAIT_L(0); PG8_BAR; PG8_MMA(1, 0, At, B0); PG8_MMA(1, 1, At, B1); PG8_BAR; PG8_SCHED;
            PG8_LDB(B0, 1, 0); PG8_LDB(B1, 1, 1); PG8_SCHED; PG8_LDA(At, 1, 0); PG8_STAGE(PG8_SA(0, 1), a2 + hstep, voffA);
            PG8_WAIT_V(8); PG8_WAIT_L(0); PG8_BAR; PG8_MMA(0, 0, At, B0); PG8_MMA(0, 1, At, B1); PG8_BAR; PG8_SCHED;
            PG8_LDA(At, 1, 1); PG8_STAGE(PG8_SB(1, 0), b3, voffB); PG8_STAGE(PG8_SB(1, 1), b3 + hstep, voffB); PG8_STAGE(PG8_SA(1, 0), a3, voffA);
            PG8_WAIT_V(8); PG8_WAIT_L(0); PG8_BAR; PG8_MMA(1, 0, At, B0); PG8_MMA(1, 1, At, B1); PG8_BAR; PG8_SCHED;
            } else {
            PG8_LDB(B0, 0, 0); PG8_SCHED; PG8_LDA(At, 0, 0); PG8_STAGE(PG8_SA(1, 1), a1 + hstep, voffA);
            PG8_WAIT_L(8); PG8_BAR; PG8_WAIT_L(0); PG8_MMA(0, 0, At, B0); PG8_BAR; PG8_SCHED;
            PG8_LDB(B1, 0, 1); PG8_STAGE(PG8_SB(0, 0), b2, voffB);
            PG8_BAR; PG8_WAIT_L(0); PG8_MMA(0, 1, At, B1); PG8_BAR;
            PG8_LDA(At, 0, 1); PG8_STAGE(PG8_SA(0, 0), a2, voffA);
            PG8_BAR; PG8_WAIT_L(0); PG8_MMA(1, 0, At, B0); PG8_BAR; PG8_SCHED;
            PG8_STAGE(PG8_SB(0, 1), b2 + hstep, voffB);
            PG8_WAIT_V(6); PG8_BAR; PG8_MMA(1, 1, At, B1); PG8_BAR;
            PG8_LDB(B0, 1, 0); PG8_SCHED; PG8_LDA(At, 1, 0); PG8_STAGE(PG8_SA(0, 1), a2 + hstep, voffA);
            PG8_WAIT_L(8); PG8_BAR; PG8_WAIT_L(0); PG8_MMA(0, 0, At, B0); PG8_BAR; PG8_SCHED;
            PG8_LDB(B1, 1, 1); PG8_STAGE(PG8_SB(1, 0), b3, voffB);
            PG8_BAR; PG8_WAIT_L(0); PG8_MMA(0, 1, At, B1); PG8_BAR;
            PG8_LDA(At, 1, 1); PG8_STAGE(PG8_SA(1, 0), a3, voffA);
            PG8_BAR; PG8_WAIT_L(0); PG8_MMA(1, 0, At, B0); PG8_BAR; PG8_SCHED;
            PG8_STAGE(PG8_SB(1, 1), b3 + hstep, voffB);
            PG8_WAIT_V(6); PG8_BAR; PG8_MMA(1, 1, At, B1); PG8_BAR;
            }
        }
        if constexpr (ALIGN_EPI) { if (wr == 0) PG8_BAR; }
        if constexpr (!Epi::AFTER_DRAIN) { E(acc, cur, wr, wc, fr, fq); S.done(cur); }
        if (!has_next) break;
#pragma unroll
        for (int a = 0; a < 2; ++a)
#pragma unroll
            for (int b = 0; b < 2; ++b)
#pragma unroll
                for (int m = 0; m < 4; ++m)
#pragma unroll
                    for (int n = 0; n < 2; ++n) acc[a][b][m][n] = (f32x4){0.f, 0.f, 0.f, 0.f};
        cur = nxt; cA = nA; cB = nB; ++ui;
        if constexpr (ALIGN_EPI) { if (wr == 1) PG8_BAR; }
    }
    PG8_WAIT_V(0);
    if constexpr (!ALIGN_EPI) { if (wr == 0) PG8_BAR; }
    PG8_BAR;
    if constexpr (Epi::AFTER_DRAIN) { E.fused(acc, cur, wr, wc, fr, fq, lds, wid, lane); S.done(cur); }
#undef PG8_SA
#undef PG8_SB
#undef PG8_STAGE
#undef PG8_LDA
#undef PG8_LDB
#undef PG8_MMA
#undef PG8_WAIT_V
#undef PG8_WAIT_L
#undef PG8_BAR
#undef PG8_SCHED
}
}

constexpr int NWAVES = 8;
constexpr int BATCH = 4, T = 4096, D = 1024, NH = 8, HD = 64, NIN = 5120;
constexpr int M = BATCH * T;
constexpr int NEXP = 16384;
constexpr float RMS_EPS = 1e-6f;
#ifndef MK_N_LAUNCHES
#define MK_N_LAUNCHES 1
#endif
constexpr int N_PHASES = 11;
constexpr int N_LAUNCHES = MK_N_LAUNCHES;

constexpr size_t MiB = 1u << 20;
constexpr size_t WS_CTL = 0, CTL_ZERO_BYTES = 64 * 1024;
constexpr size_t WS_RSTD1 = 512 * 1024;
constexpr size_t WS_WEFF = 1 * MiB;
constexpr size_t WS_WAB = 5 * MiB;
constexpr size_t WS_WO = 7 * MiB;
constexpr size_t WS_WIN = 9 * MiB;
constexpr size_t WS_XB = 19 * MiB;
constexpr size_t WS_SIX = 51 * MiB;
constexpr size_t WS_VT = WS_SIX + 3 * 16 * MiB;
constexpr size_t WS_GATE = 147 * MiB;
constexpr size_t WS_MERGED = 19 * MiB;
constexpr size_t WS_X1B = 51 * MiB;
constexpr size_t WS_TU = 211 * MiB, WS_TV = 227 * MiB;
constexpr size_t WS_SU = 576 * 1024, WS_SV = 640 * 1024;
constexpr size_t WS_SCORES = 83 * MiB;
constexpr size_t WS_ROUTE = 19 * MiB;
constexpr size_t WS_W = 35 * MiB;
constexpr size_t WS_SS = 43 * MiB;
constexpr size_t WS_UPART = 83 * MiB;
constexpr size_t WS_END = 256 * MiB;
constexpr int CW_BAR = 4096;

constexpr int RING_OFF = 0, RING_BYTES = 131072;
constexpr int LDSCTL_OFF = RING_BYTES;
constexpr int LDS_BYTES = 147456;
constexpr int MISC_OFF = LDS_BYTES - 128;

#define GAS __attribute__((address_space(1)))
#define LAS __attribute__((address_space(3)))
#define CAS __attribute__((address_space(4)))
typedef unsigned short bf16;
typedef unsigned v4u __attribute__((ext_vector_type(4)));
typedef unsigned v2u __attribute__((ext_vector_type(2)));
typedef float f32x4 __attribute__((ext_vector_type(4)));
typedef float f32x2 __attribute__((ext_vector_type(2)));
typedef float f32x16 __attribute__((ext_vector_type(16)));
typedef short bf16x8 __attribute__((ext_vector_type(8)));
typedef _Float16 f16x8 __attribute__((ext_vector_type(8)));
typedef _Float16 f16x2 __attribute__((ext_vector_type(2)));
typedef __bf16 bf16x2_t __attribute__((ext_vector_type(2)));
typedef GAS unsigned gu32;
#define RLX_AGENT __ATOMIC_RELAXED, __HIP_MEMORY_SCOPE_AGENT
#define LDS_WAIT() asm volatile("s_waitcnt lgkmcnt(0)" ::: "memory")
#define VM_WAIT() asm volatile("s_waitcnt vmcnt(0)" ::: "memory")
__device__ __forceinline__ unsigned f2bf(float f) { unsigned u = __builtin_bit_cast(unsigned, f); return (u + 0x7fffu + ((u >> 16) & 1u)) >> 16; }
__device__ __forceinline__ unsigned pk2(float lo, float hi) { return f2bf(lo) | (f2bf(hi) << 16); }
__device__ __forceinline__ unsigned cvtpk(float lo, float hi) { f32x2 v = {lo, hi}; bf16x2_t b = __builtin_convertvector(v, bf16x2_t); return __builtin_bit_cast(unsigned, b); }
__device__ __forceinline__ float bflo(unsigned w) { return __builtin_bit_cast(float, w << 16); }
__device__ __forceinline__ float bfhi(unsigned w) { return __builtin_bit_cast(float, w & 0xffff0000u); }
__device__ __forceinline__ float wave_sum(float v) {
#pragma unroll
    for (int o = 1; o < 64; o <<= 1) v += __shfl_xor(v, o);
    return v;
}
#define XB_TMO      128
#define XB_XCNT(j)  (256  + 64 * (j))
#define XB_XSUB(j)  (1280 + 64 * (j))
#define XB_XGEN(j)  (2304 + 64 * (j))
#define XB_TOP      3328
#define XB_TOPGEN   3392
#define XCD_BAR_WORDS 3456
#define XB_SPIN_CAP (1u << 18)

__device__ __forceinline__ unsigned xb_ld(unsigned* p)              { return __hip_atomic_load(p, __ATOMIC_RELAXED, __HIP_MEMORY_SCOPE_AGENT); }
__device__ __forceinline__ unsigned xb_add(unsigned* p, unsigned v) { return __hip_atomic_fetch_add(p, v, __ATOMIC_RELAXED, __HIP_MEMORY_SCOPE_AGENT); }
__device__ __forceinline__ unsigned xb_xcc_id() { return (unsigned)__builtin_amdgcn_s_getreg((3 << 11) | 20) & 0xFu; }
#define XB_SPIN(cond, bar) do { unsigned _sp = 0; while (cond) { __builtin_amdgcn_s_sleep(1); \
    if ((++_sp & 255u) == 0u) { if (xb_ld(&(bar)[XB_TMO])) break; if (_sp > XB_SPIN_CAP) { atomicAdd(&(bar)[XB_TMO], 1u); break; } } } } while (0)

struct XcdBarrier {
    unsigned* bar; unsigned x;
    volatile LAS unsigned* st;
};

__device__ __forceinline__ XcdBarrier xcd_barrier_post(unsigned* bar, volatile LAS unsigned* st) {
    XcdBarrier b; b.bar = bar; b.x = xb_xcc_id(); b.st = st;
    if (threadIdx.x == 0) (void)xb_add(&bar[XB_XCNT(b.x)], 1u);
    return b;
}
__device__ __forceinline__ void xcd_barrier_complete(unsigned* bar, unsigned x, unsigned& nloc, unsigned& nx) {
    const unsigned G = gridDim.x * gridDim.y * gridDim.z;
    unsigned sum, cnt, mine, sp = 0u;
    for (;;) {
        sum = 0u; cnt = 0u; mine = 0u;
#pragma unroll
        for (unsigned j = 0; j < 16; ++j) { const unsigned c = xb_ld(&bar[XB_XCNT(j)]); sum += c; cnt += (c > 0u) ? 1u : 0u; mine = (j == x) ? c : mine; }
        if (sum == G) break;
        __builtin_amdgcn_s_sleep(1);
        if ((++sp & 255u) == 0u) { if (xb_ld(&bar[XB_TMO])) break; if (sp > XB_SPIN_CAP) { atomicAdd(&bar[XB_TMO], 1u); break; } }
    }
    nloc = mine > 0u ? mine : 1u; nx = cnt > 0u ? cnt : 1u;
}

__device__ __forceinline__ void xcd_barrier(const XcdBarrier& b) {
    asm volatile("s_waitcnt vmcnt(0)" ::: "memory");
    __syncthreads();
    if (threadIdx.x == 0) {
        unsigned* bar = b.bar;
        __builtin_amdgcn_s_waitcnt(0);
        unsigned nloc = b.st[0], nx = b.st[1];
        if (nloc == 0u) { xcd_barrier_complete(bar, b.x, nloc, nx); b.st[0] = nloc; b.st[1] = nx; }
        const unsigned old = xb_add(&bar[XB_XSUB(b.x)], 1u);
        const unsigned gen = old / nloc;
        if (old + 1u == (gen + 1u) * nloc) {
            __builtin_amdgcn_fence(__ATOMIC_RELEASE, "agent");
            asm volatile("s_waitcnt vmcnt(0)" ::: "memory");
            const unsigned og = xb_add(&bar[XB_TOP], 1u);
            const unsigned tg = og / nx;
            if (og + 1u == (tg + 1u) * nx) xb_add(&bar[XB_TOPGEN], 1u);
            else XB_SPIN(xb_ld(&bar[XB_TOPGEN]) == tg, bar);
            __builtin_amdgcn_fence(__ATOMIC_ACQUIRE, "agent");
            xb_add(&bar[XB_XGEN(b.x)], 1u);
            asm volatile("s_waitcnt vmcnt(0)" ::: "memory");
        } else {
            XB_SPIN(xb_ld(&bar[XB_XGEN(b.x)]) == gen, bar);
            __builtin_amdgcn_fence(__ATOMIC_ACQUIRE, "agent");
            asm volatile("s_waitcnt vmcnt(0)" ::: "memory");
        }
    }
    __syncthreads();
}

__device__ __forceinline__ void p0_transpose_item(const float* W, int K, int N, bf16* WT, int row_off, const float* kscale, LAS float* scr, int item, int lane) {
    const int nblk = N / 32, kb = item / nblk, nb = item % nblk, k0 = 64 * kb, n0 = 32 * nb;
    f32x4 ld[8];
#pragma unroll
    for (int i = 0; i < 8; ++i) ld[i] = __builtin_nontemporal_load((const GAS f32x4*)(W + (size_t)(k0 + 8 * i + (lane >> 3)) * N + n0 + 4 * (lane & 7)));
#pragma unroll
    for (int i = 0; i < 8; ++i) { LAS float* d = scr + (8 * i + (lane >> 3)) * 33 + 4 * (lane & 7); d[0] = ld[i].x; d[1] = ld[i].y; d[2] = ld[i].z; d[3] = ld[i].w; }
    LDS_WAIT(); asm volatile("" ::: "memory");
    const int c = lane & 7;
    float ks[8];
#pragma unroll
    for (int i = 0; i < 8; ++i) ks[i] = kscale ? kscale[k0 + 8 * c + i] : 1.0f;
#pragma unroll
    for (int j = 0; j < 4; ++j) { const int n = (lane >> 3) + 8 * j; const LAS float* s = scr + (8 * c) * 33 + n;
        v4u o; o.x = pk2(s[0 * 33] * ks[0], s[1 * 33] * ks[1]); o.y = pk2(s[2 * 33] * ks[2], s[3 * 33] * ks[3]); o.z = pk2(s[4 * 33] * ks[4], s[5 * 33] * ks[5]); o.w = pk2(s[6 * 33] * ks[6], s[7 * 33] * ks[7]);
        *(GAS v4u*)(WT + (size_t)(row_off + n0 + n) * K + k0 + 8 * c) = o; }
    LDS_WAIT(); asm volatile("" ::: "memory");
}

__device__ __forceinline__ void conv_phase(const bf16* CB, const bf16* CC, const bf16* CU, bf16* CO, const float* cw, const float* cbias, int gtid, int nthreads) {
    for (int task = gtid; task < M * 64; task += nthreads) {
        const int tok = task >> 6, c8 = (task & 63) * 8, tt = tok & (T - 1);
        const size_t off = (size_t)tok * 512 + c8;
        float z[3][8];
#pragma unroll
        for (int k = 0; k < 3; ++k) {
            const int dt = 2 - k;
            if (tt >= dt) { const v4u a = *(const GAS v4u*)(CC + off - (size_t)dt * 512), b = *(const GAS v4u*)(CU + off - (size_t)dt * 512);
                z[k][0] = bflo(a.x) * bflo(b.x); z[k][1] = bfhi(a.x) * bfhi(b.x); z[k][2] = bflo(a.y) * bflo(b.y); z[k][3] = bfhi(a.y) * bfhi(b.y);
                z[k][4] = bflo(a.z) * bflo(b.z); z[k][5] = bfhi(a.z) * bfhi(b.z); z[k][6] = bflo(a.w) * bflo(b.w); z[k][7] = bfhi(a.w) * bfhi(b.w); }
            else {
#pragma unroll
                for (int i = 0; i < 8; ++i) z[k][i] = 0.f; }
        }
        float y[8];
#pragma unroll
        for (int i = 0; i < 8; ++i) y[i] = cbias[c8 + i];
#pragma unroll
        for (int k = 0; k < 3; ++k)
#pragma unroll
            for (int i = 0; i < 8; ++i) y[i] += cw[k * 512 + c8 + i] * z[k][i];
        const v4u g = *(const GAS v4u*)(CB + off);
        v4u o; o.x = pk2(bflo(g.x) * y[0], bfhi(g.x) * y[1]); o.y = pk2(bflo(g.y) * y[2], bfhi(g.y) * y[3]); o.z = pk2(bflo(g.z) * y[4], bfhi(g.z) * y[5]); o.w = pk2(bflo(g.w) * y[6], bfhi(g.w) * y[7]);
        *(GAS v4u*)(CO + off) = o;
    }
}

__device__ __forceinline__ int crow(int r, int hf) { return (r & 3) + 8 * (r >> 2) + 4 * hf; }
#define MFMA_BF16(a, b, c) __builtin_amdgcn_mfma_f32_32x32x16_bf16((a), (b), (c), 0, 0, 0)
#define MFMA_F16(a, b, c) __builtin_amdgcn_mfma_f32_32x32x16_f16((a), (b), (c), 0, 0, 0)
__device__ __forceinline__ void attn_item(const bf16* Qb, const bf16* Kb, const bf16* VT, bf16* Ob, int b, int h, int qblk, LAS unsigned char* scr, int lane) {
    const int t32 = lane & 31, hf = lane >> 5, q0 = qblk * 32, tq = q0 + t32;
    const size_t rowbase = (size_t)b * T;
    const float LOG2E = 1.4426950408889634f, LN2 = 0.6931471805599453f;
    bf16x8 qf[4];
    { const bf16* qp = Qb + (rowbase + q0 + t32) * 512 + h * 64 + 8 * hf;
#pragma unroll
      for (int st = 0; st < 4; ++st) qf[st] = *(const GAS bf16x8*)(qp + 16 * st); }
    f16x8 tri[2];
#pragma unroll
    for (int st = 0; st < 2; ++st)
#pragma unroll
        for (int e = 0; e < 8; ++e) { const int j = 16 * st + 8 * (e >> 2) + 4 * hf + (e & 3); tri[st][e] = (j >= t32) ? (_Float16)1.0f : (_Float16)0.0f; }
    f32x16 o0, o1;
#pragma unroll
    for (int r = 0; r < 16; ++r) { o0[r] = 0.f; o1[r] = 0.f; }
    float R = 0.f;
    const bf16* kld = Kb + (rowbase + (lane >> 3)) * 512 + h * 64 + 8 * (lane & 7);
    const bf16* vld = VT + ((size_t)(b * 8 + h) * 64 + (lane >> 3)) * T + 8 * (lane & 7);
    LAS unsigned char* stw = scr + (lane >> 3) * 144 + 16 * (lane & 7);
    const LAS unsigned char* kfr = scr + t32 * 144 + 16 * hf;
    const LAS unsigned char* vfr = scr + t32 * 144 + 8 * hf;
    for (int jt = q0 >> 6; jt >= 0; --jt) {
        const int k0 = jt * 64;
        f32x16 s0, s1;
#pragma unroll
        for (int r = 0; r < 16; ++r) { s0[r] = 0.f; s1[r] = 0.f; }
        { v4u kl[8], vl[8];
#pragma unroll
          for (int i = 0; i < 8; ++i) { kl[i] = *(const GAS v4u*)(kld + (size_t)(k0 + 8 * i) * 512); vl[i] = *(const GAS v4u*)(vld + (size_t)(8 * i) * T + k0); }
#pragma unroll
          for (int i = 0; i < 8; ++i) *(LAS v4u*)(stw + i * (8 * 144)) = kl[i];
          LDS_WAIT();
          bf16x8 ka0[4], ka1[4];
#pragma unroll
          for (int st = 0; st < 4; ++st) { ka0[st] = *(const LAS bf16x8*)(kfr + 32 * st); ka1[st] = *(const LAS bf16x8*)(kfr + 32 * 144 + 32 * st); }
          LDS_WAIT();
#pragma unroll
          for (int i = 0; i < 8; ++i) *(LAS v4u*)(stw + i * (8 * 144)) = vl[i];
#pragma unroll
          for (int st = 0; st < 4; ++st) { s0 = MFMA_BF16(ka0[st], qf[st], s0); s1 = MFMA_BF16(ka1[st], qf[st], s1); }
        }
        f32x16 L0, L1; float tot0 = 0.f, tot1 = 0.f;
#pragma unroll
        for (int r = 0; r < 16; ++r) {
            const int key = k0 + crow(r, hf);
            { const float z = s0[r]; const float e = __builtin_amdgcn_exp2f(-__builtin_fabsf(z) * LOG2E); const float lp = __builtin_amdgcn_logf(1.0f + e) * LN2;
              const float L = (key < tq) ? -(__builtin_fmaxf(z, 0.f) + lp) : 0.f; L0[r] = L; tot0 += L; }
            { const float z = s1[r]; const float e = __builtin_amdgcn_exp2f(-__builtin_fabsf(z) * LOG2E); const float lp = __builtin_amdgcn_logf(1.0f + e) * LN2;
              const float L = (key + 32 < tq) ? -(__builtin_fmaxf(z, 0.f) + lp) : 0.f; L1[r] = L; tot1 += L; }
        }
        tot0 += __shfl_xor(tot0, 32); tot1 += __shfl_xor(tot1, 32);
        f16x8 lf00, lf01, lf10, lf11;
#pragma unroll
        for (int e = 0; e < 8; ++e) { lf00[e] = (_Float16)L0[e]; lf01[e] = (_Float16)L0[8 + e]; lf10[e] = (_Float16)L1[e]; lf11[e] = (_Float16)L1[8 + e]; }
        f32x16 y0, y1;
#pragma unroll
        for (int r = 0; r < 16; ++r) { y0[r] = 0.f; y1[r] = 0.f; }
        y0 = MFMA_F16(tri[0], lf00, y0); y0 = MFMA_F16(tri[1], lf01, y0);
        y1 = MFMA_F16(tri[0], lf10, y1); y1 = MFMA_F16(tri[1], lf11, y1);
        const float base0 = R + tot1, base1 = R;
        float a0v[16], a1v[16];
#pragma unroll
        for (int r = 0; r < 16; ++r) {
            const int key = k0 + crow(r, hf);
            a0v[r] = (key < tq) ? __builtin_amdgcn_exp2f((s0[r] + y0[r] + base0) * LOG2E) : 0.f;
            a1v[r] = (key + 32 < tq) ? __builtin_amdgcn_exp2f((s1[r] + y1[r] + base1) * LOG2E) : 0.f;
        }
        bf16x8 pf[2][2];
#pragma unroll
        for (int st = 0; st < 2; ++st) {
            v4u w0, w1;
            w0.x = cvtpk(a0v[8 * st + 0], a0v[8 * st + 1]); w0.y = cvtpk(a0v[8 * st + 2], a0v[8 * st + 3]); w0.z = cvtpk(a0v[8 * st + 4], a0v[8 * st + 5]); w0.w = cvtpk(a0v[8 * st + 6], a0v[8 * st + 7]);
            w1.x = cvtpk(a1v[8 * st + 0], a1v[8 * st + 1]); w1.y = cvtpk(a1v[8 * st + 2], a1v[8 * st + 3]); w1.z = cvtpk(a1v[8 * st + 4], a1v[8 * st + 5]); w1.w = cvtpk(a1v[8 * st + 6], a1v[8 * st + 7]);
            pf[0][st] = __builtin_bit_cast(bf16x8, w0); pf[1][st] = __builtin_bit_cast(bf16x8, w1);
        }
#pragma unroll
        for (int kb = 0; kb < 2; ++kb)
#pragma unroll
            for (int st = 0; st < 2; ++st) {
                const int kk2 = 2 * (32 * kb + 16 * st);
                { const v2u lo = *(const LAS v2u*)(vfr + kk2), hi = *(const LAS v2u*)(vfr + kk2 + 16); v4u w; w.x = lo.x; w.y = lo.y; w.z = hi.x; w.w = hi.y;
                  o0 = MFMA_BF16(__builtin_bit_cast(bf16x8, w), pf[kb][st], o0); }
                { const v2u lo = *(const LAS v2u*)(vfr + 32 * 144 + kk2), hi = *(const LAS v2u*)(vfr + 32 * 144 + kk2 + 16); v4u w; w.x = lo.x; w.y = lo.y; w.z = hi.x; w.w = hi.y;
                  o1 = MFMA_BF16(__builtin_bit_cast(bf16x8, w), pf[kb][st], o1); }
            }
        R += tot0 + tot1;
        LDS_WAIT();
        if (__all(R < -104.0f)) break;
    }
    bf16* op = Ob + (rowbase + q0 + t32) * 512 + h * 64 + 4 * hf;
#pragma unroll
    for (int q4 = 0; q4 < 4; ++q4) {
        v2u w; w.x = cvtpk(o0[4 * q4], o0[4 * q4 + 1]); w.y = cvtpk(o0[4 * q4 + 2], o0[4 * q4 + 3]); *(GAS v2u*)(op + 8 * q4) = w;
        v2u w2; w2.x = cvtpk(o1[4 * q4], o1[4 * q4 + 1]); w2.y = cvtpk(o1[4 * q4 + 2], o1[4 * q4 + 3]); *(GAS v2u*)(op + 32 + 8 * q4) = w2;
    }
}

#define RT_C8(op_str, cnt, x0, x1, x2, x3, x4, x5, x6, x7, thr) asm volatile(op_str : "+v"(cnt) : "v"(x0), "v"(x1), "v"(x2), "v"(x3), "v"(x4), "v"(x5), "v"(x6), "v"(x7), "v"(thr) : "vcc")
#define RT_GE8 "v_cmp_ge_f32 vcc, %1, %9\n\tv_addc_co_u32_e32 %0, vcc, 0, %0, vcc\n\tv_cmp_ge_f32 vcc, %2, %9\n\tv_addc_co_u32_e32 %0, vcc, 0, %0, vcc\n\tv_cmp_ge_f32 vcc, %3, %9\n\tv_addc_co_u32_e32 %0, vcc, 0, %0, vcc\n\tv_cmp_ge_f32 vcc, %4, %9\n\tv_addc_co_u32_e32 %0, vcc, 0, %0, vcc\n\tv_cmp_ge_f32 vcc, %5, %9\n\tv_addc_co_u32_e32 %0, vcc, 0, %0, vcc\n\tv_cmp_ge_f32 vcc, %6, %9\n\tv_addc_co_u32_e32 %0, vcc, 0, %0, vcc\n\tv_cmp_ge_f32 vcc, %7, %9\n\tv_addc_co_u32_e32 %0, vcc, 0, %0, vcc\n\tv_cmp_ge_f32 vcc, %8, %9\n\tv_addc_co_u32_e32 %0, vcc, 0, %0, vcc"
#define RT_GT8 "v_cmp_gt_f32 vcc, %1, %9\n\tv_addc_co_u32_e32 %0, vcc, 0, %0, vcc\n\tv_cmp_gt_f32 vcc, %2, %9\n\tv_addc_co_u32_e32 %0, vcc, 0, %0, vcc\n\tv_cmp_gt_f32 vcc, %3, %9\n\tv_addc_co_u32_e32 %0, vcc, 0, %0, vcc\n\tv_cmp_gt_f32 vcc, %4, %9\n\tv_addc_co_u32_e32 %0, vcc, 0, %0, vcc\n\tv_cmp_gt_f32 vcc, %5, %9\n\tv_addc_co_u32_e32 %0, vcc, 0, %0, vcc\n\tv_cmp_gt_f32 vcc, %6, %9\n\tv_addc_co_u32_e32 %0, vcc, 0, %0, vcc\n\tv_cmp_gt_f32 vcc, %7, %9\n\tv_addc_co_u32_e32 %0, vcc, 0, %0, vcc\n\tv_cmp_gt_f32 vcc, %8, %9\n\tv_addc_co_u32_e32 %0, vcc, 0, %0, vcc"
#define RT_COUNT128(OPS, cnt, thr) do { cnt = 0; RT_C8(OPS, cnt, v[0], v[1], v[2], v[3], v[4], v[5], v[6], v[7], thr); RT_C8(OPS, cnt, v[8], v[9], v[10], v[11], v[12], v[13], v[14], v[15], thr); RT_C8(OPS, cnt, v[16], v[17], v[18], v[19], v[20], v[21], v[22], v[23], thr); RT_C8(OPS, cnt, v[24], v[25], v[26], v[27], v[28], v[29], v[30], v[31], thr); RT_C8(OPS, cnt, v[32], v[33], v[34], v[35], v[36], v[37], v[38], v[39], thr); RT_C8(OPS, cnt, v[40], v[41], v[42], v[43], v[44], v[45], v[46], v[47], thr); RT_C8(OPS, cnt, v[48], v[49], v[50], v[51], v[52], v[53], v[54], v[55], thr); RT_C8(OPS, cnt, v[56], v[57], v[58], v[59], v[60], v[61], v[62], v[63], thr); RT_C8(OPS, cnt, v[64], v[65], v[66], v[67], v[68], v[69], v[70], v[71], thr); RT_C8(OPS, cnt, v[72], v[73], v[74], v[75], v[76], v[77], v[78], v[79], thr); RT_C8(OPS, cnt, v[80], v[81], v[82], v[83], v[84], v[85], v[86], v[87], thr); RT_C8(OPS, cnt, v[88], v[89], v[90], v[91], v[92], v[93], v[94], v[95], thr); RT_C8(OPS, cnt, v[96], v[97], v[98], v[99], v[100], v[101], v[102], v[103], thr); RT_C8(OPS, cnt, v[104], v[105], v[106], v[107], v[108], v[109], v[110], v[111], thr); RT_C8(OPS, cnt, v[112], v[113], v[114], v[115], v[116], v[117], v[118], v[119], thr); RT_C8(OPS, cnt, v[120], v[121], v[122], v[123], v[124], v[125], v[126], v[127], thr); } while (0)
#define RT_S5(op_str, cnt, a0, a1, a2, a3, a4, b0, b1, b2, b3, b4, thr) do { float t_; asm volatile(op_str : "+v"(cnt), "=&v"(t_) : "v"(a0), "v"(a1), "v"(a2), "v"(a3), "v"(a4), "v"(b0), "v"(b1), "v"(b2), "v"(b3), "v"(b4), "v"(thr) : "vcc"); } while (0)
#define RT_SGE5 "v_add_f32_e32 %1, %2, %7\n\tv_cmp_ge_f32 vcc, %1, %12\n\tv_addc_co_u32_e32 %0, vcc, 0, %0, vcc\n\tv_add_f32_e32 %1, %3, %8\n\tv_cmp_ge_f32 vcc, %1, %12\n\tv_addc_co_u32_e32 %0, vcc, 0, %0, vcc\n\tv_add_f32_e32 %1, %4, %9\n\tv_cmp_ge_f32 vcc, %1, %12\n\tv_addc_co_u32_e32 %0, vcc, 0, %0, vcc\n\tv_add_f32_e32 %1, %5, %10\n\tv_cmp_ge_f32 vcc, %1, %12\n\tv_addc_co_u32_e32 %0, vcc, 0, %0, vcc\n\tv_add_f32_e32 %1, %6, %11\n\tv_cmp_ge_f32 vcc, %1, %12\n\tv_addc_co_u32_e32 %0, vcc, 0, %0, vcc"
#define RT_SGT5 "v_add_f32_e32 %1, %2, %7\n\tv_cmp_gt_f32 vcc, %1, %12\n\tv_addc_co_u32_e32 %0, vcc, 0, %0, vcc\n\tv_add_f32_e32 %1, %3, %8\n\tv_cmp_gt_f32 vcc, %1, %12\n\tv_addc_co_u32_e32 %0, vcc, 0, %0, vcc\n\tv_add_f32_e32 %1, %4, %9\n\tv_cmp_gt_f32 vcc, %1, %12\n\tv_addc_co_u32_e32 %0, vcc, 0, %0, vcc\n\tv_add_f32_e32 %1, %5, %10\n\tv_cmp_gt_f32 vcc, %1, %12\n\tv_addc_co_u32_e32 %0, vcc, 0, %0, vcc\n\tv_add_f32_e32 %1, %6, %11\n\tv_cmp_gt_f32 vcc, %1, %12\n\tv_addc_co_u32_e32 %0, vcc, 0, %0, vcc"
#define RT_COUNT50(OPS, cnt, thr) do { cnt = 0; RT_S5(OPS, cnt, a[0], a[0], a[0], a[0], a[0], b[0], b[1], b[2], b[3], b[4], thr); RT_S5(OPS, cnt, a[0], a[0], a[0], a[0], a[0], b[5], b[6], b[7], b[8], b[9], thr); RT_S5(OPS, cnt, a[0], a[0], a[0], a[0], a[0], b[10], b[11], b[12], b[13], b[14], thr); RT_S5(OPS, cnt, a[0], a[1], a[1], a[1], a[1], b[15], b[0], b[1], b[2], b[3], thr); RT_S5(OPS, cnt, a[1], a[1], a[1], a[1], a[2], b[4], b[5], b[6], b[7], b[0], thr); RT_S5(OPS, cnt, a[2], a[2], a[2], a[2], a[3], b[1], b[2], b[3], b[4], b[0], thr); RT_S5(OPS, cnt, a[3], a[3], a[3], a[4], a[4], b[1], b[2], b[3], b[0], b[1], thr); RT_S5(OPS, cnt, a[4], a[5], a[5], a[6], a[6], b[2], b[0], b[1], b[0], b[1], thr); RT_S5(OPS, cnt, a[7], a[7], a[8], a[9], a[10], b[0], b[1], b[0], b[0], b[0], thr); RT_S5(OPS, cnt, a[11], a[12], a[13], a[14], a[15], b[0], b[0], b[0], b[0], b[0], thr); } while (0)
#define RT_CSWAP(x, xi, p, q) do { float t_; asm volatile("v_cmp_gt_f32 vcc, %1, %0\n\tv_cndmask_b32_e32 %4, %0, %1, vcc\n\tv_cndmask_b32_e32 %1, %1, %0, vcc\n\tv_mov_b32_e32 %0, %4\n\tv_cndmask_b32_e32 %4, %2, %3, vcc\n\tv_cndmask_b32_e32 %3, %3, %2, vcc\n\tv_mov_b32_e32 %2, %4" : "+v"(x[p]), "+v"(x[q]), "+v"(xi[p]), "+v"(xi[q]), "=&v"(t_) : : "vcc"); } while (0)
#define RT_SORT16(x, xi) do { RT_CSWAP(x, xi, 0, 1); RT_CSWAP(x, xi, 2, 3); RT_CSWAP(x, xi, 0, 2); RT_CSWAP(x, xi, 1, 3); RT_CSWAP(x, xi, 1, 2); RT_CSWAP(x, xi, 4, 5); RT_CSWAP(x, xi, 6, 7); RT_CSWAP(x, xi, 4, 6); RT_CSWAP(x, xi, 5, 7); RT_CSWAP(x, xi, 5, 6); RT_CSWAP(x, xi, 0, 4); RT_CSWAP(x, xi, 2, 6); RT_CSWAP(x, xi, 2, 4); RT_CSWAP(x, xi, 1, 5); RT_CSWAP(x, xi, 3, 7); RT_CSWAP(x, xi, 3, 5); RT_CSWAP(x, xi, 1, 2); RT_CSWAP(x, xi, 3, 4); RT_CSWAP(x, xi, 5, 6); RT_CSWAP(x, xi, 8, 9); RT_CSWAP(x, xi, 10, 11); RT_CSWAP(x, xi, 8, 10); RT_CSWAP(x, xi, 9, 11); RT_CSWAP(x, xi, 9, 10); RT_CSWAP(x, xi, 12, 13); RT_CSWAP(x, xi, 14, 15); RT_CSWAP(x, xi, 12, 14); RT_CSWAP(x, xi, 13, 15); RT_CSWAP(x, xi, 13, 14); RT_CSWAP(x, xi, 8, 12); RT_CSWAP(x, xi, 10, 14); RT_CSWAP(x, xi, 10, 12); RT_CSWAP(x, xi, 9, 13); RT_CSWAP(x, xi, 11, 15); RT_CSWAP(x, xi, 11, 13); RT_CSWAP(x, xi, 9, 10); RT_CSWAP(x, xi, 11, 12); RT_CSWAP(x, xi, 13, 14); RT_CSWAP(x, xi, 0, 8); RT_CSWAP(x, xi, 4, 12); RT_CSWAP(x, xi, 4, 8); RT_CSWAP(x, xi, 2, 10); RT_CSWAP(x, xi, 6, 14); RT_CSWAP(x, xi, 6, 10); RT_CSWAP(x, xi, 2, 4); RT_CSWAP(x, xi, 6, 8); RT_CSWAP(x, xi, 10, 12); RT_CSWAP(x, xi, 1, 9); RT_CSWAP(x, xi, 5, 13); RT_CSWAP(x, xi, 5, 9); RT_CSWAP(x, xi, 3, 11); RT_CSWAP(x, xi, 7, 15); RT_CSWAP(x, xi, 7, 11); RT_CSWAP(x, xi, 3, 5); RT_CSWAP(x, xi, 7, 9); RT_CSWAP(x, xi, 11, 13); RT_CSWAP(x, xi, 1, 2); RT_CSWAP(x, xi, 3, 4); RT_CSWAP(x, xi, 5, 6); RT_CSWAP(x, xi, 7, 8); RT_CSWAP(x, xi, 9, 10); RT_CSWAP(x, xi, 11, 12); RT_CSWAP(x, xi, 13, 14); } while (0)
#define RT_FOR_CANDS(F) F(0, 0) F(0, 1) F(0, 2) F(0, 3) F(0, 4) F(0, 5) F(0, 6) F(0, 7) F(0, 8) F(0, 9) F(0, 10) F(0, 11) F(0, 12) F(0, 13) F(0, 14) F(0, 15) F(1, 0) F(1, 1) F(1, 2) F(1, 3) F(1, 4) F(1, 5) F(1, 6) F(1, 7) F(2, 0) F(2, 1) F(2, 2) F(2, 3) F(2, 4) F(3, 0) F(3, 1) F(3, 2) F(3, 3) F(4, 0) F(4, 1) F(4, 2) F(5, 0) F(5, 1) F(6, 0) F(6, 1) F(7, 0) F(7, 1) F(8, 0) F(9, 0) F(10, 0) F(11, 0) F(12, 0) F(13, 0) F(14, 0) F(15, 0)
#define RT_SEARCH(COUNT_MACRO, NTOT) \
    for (int it_ = 0; it_ < 400 && __any(!done); ++it_) { \
        const float w_ = hi - lo; float t_ = ((float)(clo - 16) + 0.5f) * __builtin_amdgcn_rcpf((float)(clo - chi)); t_ = __builtin_fminf(__builtin_fmaxf(t_, 0.125f), 0.875f); \
        float x_ = lo + w_ * t_; if (!(x_ > lo && x_ < hi)) x_ = 0.5f * lo + 0.5f * hi; const bool stuck_ = !(x_ > lo && x_ < hi); \
        int c_; COUNT_MACRO(c_, x_); \
        if (!done) { if (stuck_) { Tv = lo; done = true; } else if (c_ == 16) { Tv = x_; done = true; } else if (c_ > 16) { lo = x_; clo = c_; } else { hi = x_; chi = c_; } } } \
    if (!done) Tv = lo;
#define RT_CNT128_GE(c, x) RT_COUNT128(RT_GE8, c, x)
#define RT_CNT50_GE(c, x) RT_COUNT50(RT_SGE5, c, x)
__device__ __forceinline__ void lane_top16_of_128(const float (&v)[128], LAS unsigned char* sb) {
    float mx = v[0], mn = v[0];
#pragma unroll
    for (int i = 1; i < 128; ++i) { mx = __builtin_fmaxf(mx, v[i]); mn = __builtin_fminf(mn, v[i]); }
    float lo = mn, hi = mx, Tv = mn; int clo = 128, chi; bool done;
    RT_CNT128_GE(chi, mx); done = (chi >= 16); if (done) Tv = mx;
    RT_SEARCH(RT_CNT128_GE, 128)
    int cgt; RT_COUNT128(RT_GT8, cgt, Tv);
    const int need = 16 - cgt; int cnt = 0, idx = 0;
#pragma unroll
    for (int i = 0; i < 128; ++i) {
        asm volatile("" : "+v"(Tv), "+v"(cnt), "+v"(idx));
        LAS unsigned char* q = sb + cnt * 512; *(LAS float*)q = v[i]; *(LAS int*)(q + 4) = idx;
        cnt += (v[i] > Tv) ? 1 : 0; idx += 1;
    }
    if (__any(need > 0)) {
        idx = 0;
#pragma unroll
        for (int i = 0; i < 128; ++i) { asm volatile("" : "+v"(Tv), "+v"(cnt), "+v"(idx));
            if (v[i] == Tv && cnt < 16) { LAS unsigned char* q = sb + cnt * 512; *(LAS float*)q = v[i]; *(LAS int*)(q + 4) = idx; cnt += 1; } idx += 1; }
    }
}
__device__ __forceinline__ int opaque_zero() { int z = 0; asm volatile("" : "+v"(z)); return z; }
__device__ __forceinline__ void route_task_search(const float* SCT, v2u* ROUTE, int tok0, int h, LAS unsigned char* scr, int lane) {
    const int tok = tok0 + lane;
    LAS unsigned char* sb = scr + lane * 8;
#pragma unroll 1
    for (int p = 0; p < 2; ++p) {
        const int g = 2 * h + p; float v[128];
        const unsigned voff = (unsigned)tok * 16u;
#pragma unroll
        for (int k = 0; k < 32; ++k) { const char* bk = (const char*)SCT + ((size_t)(g * 32 + k) * M) * 16; const f32x4 q = *(const GAS f32x4*)(bk + voff); v[4 * k] = q.x; v[4 * k + 1] = q.y; v[4 * k + 2] = q.z; v[4 * k + 3] = q.w; }
        lane_top16_of_128(v, sb + p * 8704);
    }
    LDS_WAIT();
    float a[16], b[16]; int ai[16], bi[16];
#pragma unroll
    for (int i = 0; i < 16; ++i) { const v2u ea = *(LAS v2u*)(sb + i * 512), eb = *(LAS v2u*)(sb + 8704 + i * 512);
        a[i] = __builtin_bit_cast(float, ea.x); ai[i] = (int)ea.y; b[i] = __builtin_bit_cast(float, eb.x); bi[i] = (int)eb.y; }
    LDS_WAIT();
    RT_SORT16(a, ai); RT_SORT16(b, bi);
    float lo = a[15] + b[15], hi = a[0] + b[0], Tv = lo; int clo = 50, chi; bool done;
    RT_CNT50_GE(chi, hi); done = (chi >= 16); if (done) Tv = hi;
    RT_SEARCH(RT_CNT50_GE, 50)
    int cgt; RT_COUNT50(RT_SGT5, cgt, Tv);
    const int need = 16 - cgt; int cnt = 0;
#define RT_EXT(i, j) { asm volatile("" : "+v"(Tv), "+v"(cnt)); const float s_ = a[i] + b[j]; LAS unsigned char* q_ = sb + cnt * 512; *(LAS float*)q_ = s_; *(LAS int*)(q_ + 4) = ai[i] * 128 + bi[j]; cnt += (s_ > Tv) ? 1 : 0; }
    RT_FOR_CANDS(RT_EXT)
#undef RT_EXT
    if (__any(need > 0)) {
#define RT_EXT2(i, j) { asm volatile("" : "+v"(Tv), "+v"(cnt)); const float s_ = a[i] + b[j]; if (s_ == Tv && cnt < 16) { LAS unsigned char* q_ = sb + cnt * 512; *(LAS float*)q_ = s_; *(LAS int*)(q_ + 4) = ai[i] * 128 + bi[j]; cnt += 1; } }
        RT_FOR_CANDS(RT_EXT2)
#undef RT_EXT2
    }
    LDS_WAIT();
    GAS v4u* rp = (GAS v4u*)((GAS v2u*)ROUTE + (size_t)tok * 128 + h * 16);
#pragma unroll
    for (int i = 0; i < 8; ++i) { const v2u e0 = *(LAS v2u*)(sb + (2 * i) * 512), e1 = *(LAS v2u*)(sb + (2 * i + 1) * 512); v4u o; o.x = e0.y; o.y = e0.x; o.z = e1.y; o.w = e1.x; rp[i] = o; }
    LDS_WAIT();
}

#define RT2_CE(a, b) { const int t0_ = (a), t1_ = (b); (a) = t0_ > t1_ ? t0_ : t1_; (b) = t0_ > t1_ ? t1_ : t0_; }
#define RT2_MX(a, b) ((a) > (b) ? (a) : (b))
#define RT2_SORT16(k, B) do { RT2_CE(k[(B) + 0], k[(B) + 13]); RT2_CE(k[(B) + 1], k[(B) + 12]); RT2_CE(k[(B) + 2], k[(B) + 15]); RT2_CE(k[(B) + 3], k[(B) + 14]); RT2_CE(k[(B) + 4], k[(B) + 8]); RT2_CE(k[(B) + 5], k[(B) + 6]); RT2_CE(k[(B) + 7], k[(B) + 11]); RT2_CE(k[(B) + 9], k[(B) + 10]); RT2_CE(k[(B) + 0], k[(B) + 5]); RT2_CE(k[(B) + 1], k[(B) + 7]); RT2_CE(k[(B) + 2], k[(B) + 9]); RT2_CE(k[(B) + 3], k[(B) + 4]); RT2_CE(k[(B) + 6], k[(B) + 13]); RT2_CE(k[(B) + 8], k[(B) + 14]); RT2_CE(k[(B) + 10], k[(B) + 15]); RT2_CE(k[(B) + 11], k[(B) + 12]); RT2_CE(k[(B) + 0], k[(B) + 1]); RT2_CE(k[(B) + 2], k[(B) + 3]); RT2_CE(k[(B) + 4], k[(B) + 5]); RT2_CE(k[(B) + 6], k[(B) + 8]); RT2_CE(k[(B) + 7], k[(B) + 9]); RT2_CE(k[(B) + 10], k[(B) + 11]); RT2_CE(k[(B) + 12], k[(B) + 13]); RT2_CE(k[(B) + 14], k[(B) + 15]); RT2_CE(k[(B) + 0], k[(B) + 2]); RT2_CE(k[(B) + 1], k[(B) + 3]); RT2_CE(k[(B) + 4], k[(B) + 10]); RT2_CE(k[(B) + 5], k[(B) + 11]); RT2_CE(k[(B) + 6], k[(B) + 7]); RT2_CE(k[(B) + 8], k[(B) + 9]); RT2_CE(k[(B) + 12], k[(B) + 14]); RT2_CE(k[(B) + 13], k[(B) + 15]); RT2_CE(k[(B) + 1], k[(B) + 2]); RT2_CE(k[(B) + 3], k[(B) + 12]); RT2_CE(k[(B) + 4], k[(B) + 6]); RT2_CE(k[(B) + 5], k[(B) + 7]); RT2_CE(k[(B) + 8], k[(B) + 10]); RT2_CE(k[(B) + 9], k[(B) + 11]); RT2_CE(k[(B) + 13], k[(B) + 14]); RT2_CE(k[(B) + 1], k[(B) + 4]); RT2_CE(k[(B) + 2], k[(B) + 6]); RT2_CE(k[(B) + 5], k[(B) + 8]); RT2_CE(k[(B) + 7], k[(B) + 10]); RT2_CE(k[(B) + 9], k[(B) + 13]); RT2_CE(k[(B) + 11], k[(B) + 14]); RT2_CE(k[(B) + 2], k[(B) + 4]); RT2_CE(k[(B) + 3], k[(B) + 6]); RT2_CE(k[(B) + 9], k[(B) + 12]); RT2_CE(k[(B) + 11], k[(B) + 13]); RT2_CE(k[(B) + 3], k[(B) + 5]); RT2_CE(k[(B) + 6], k[(B) + 8]); RT2_CE(k[(B) + 7], k[(B) + 9]); RT2_CE(k[(B) + 10], k[(B) + 12]); RT2_CE(k[(B) + 3], k[(B) + 4]); RT2_CE(k[(B) + 5], k[(B) + 6]); RT2_CE(k[(B) + 7], k[(B) + 8]); RT2_CE(k[(B) + 9], k[(B) + 10]); RT2_CE(k[(B) + 11], k[(B) + 12]); RT2_CE(k[(B) + 6], k[(B) + 7]); RT2_CE(k[(B) + 8], k[(B) + 9]); } while (0)
#define RT2_BIT16(k, B) do { RT2_CE(k[(B) + 0], k[(B) + 8]); RT2_CE(k[(B) + 1], k[(B) + 9]); RT2_CE(k[(B) + 2], k[(B) + 10]); RT2_CE(k[(B) + 3], k[(B) + 11]); RT2_CE(k[(B) + 4], k[(B) + 12]); RT2_CE(k[(B) + 5], k[(B) + 13]); RT2_CE(k[(B) + 6], k[(B) + 14]); RT2_CE(k[(B) + 7], k[(B) + 15]); RT2_CE(k[(B) + 0], k[(B) + 4]); RT2_CE(k[(B) + 1], k[(B) + 5]); RT2_CE(k[(B) + 2], k[(B) + 6]); RT2_CE(k[(B) + 3], k[(B) + 7]); RT2_CE(k[(B) + 8], k[(B) + 12]); RT2_CE(k[(B) + 9], k[(B) + 13]); RT2_CE(k[(B) + 10], k[(B) + 14]); RT2_CE(k[(B) + 11], k[(B) + 15]); RT2_CE(k[(B) + 0], k[(B) + 2]); RT2_CE(k[(B) + 1], k[(B) + 3]); RT2_CE(k[(B) + 4], k[(B) + 6]); RT2_CE(k[(B) + 5], k[(B) + 7]); RT2_CE(k[(B) + 8], k[(B) + 10]); RT2_CE(k[(B) + 9], k[(B) + 11]); RT2_CE(k[(B) + 12], k[(B) + 14]); RT2_CE(k[(B) + 13], k[(B) + 15]); RT2_CE(k[(B) + 0], k[(B) + 1]); RT2_CE(k[(B) + 2], k[(B) + 3]); RT2_CE(k[(B) + 4], k[(B) + 5]); RT2_CE(k[(B) + 6], k[(B) + 7]); RT2_CE(k[(B) + 8], k[(B) + 9]); RT2_CE(k[(B) + 10], k[(B) + 11]); RT2_CE(k[(B) + 12], k[(B) + 13]); RT2_CE(k[(B) + 14], k[(B) + 15]); } while (0)
#define RT2_HCLEAN(k, A, B) do { k[(A) + 0] = RT2_MX(k[(A) + 0], k[(B) + 15]); k[(A) + 1] = RT2_MX(k[(A) + 1], k[(B) + 14]); k[(A) + 2] = RT2_MX(k[(A) + 2], k[(B) + 13]); k[(A) + 3] = RT2_MX(k[(A) + 3], k[(B) + 12]); k[(A) + 4] = RT2_MX(k[(A) + 4], k[(B) + 11]); k[(A) + 5] = RT2_MX(k[(A) + 5], k[(B) + 10]); k[(A) + 6] = RT2_MX(k[(A) + 6], k[(B) + 9]); k[(A) + 7] = RT2_MX(k[(A) + 7], k[(B) + 8]); k[(A) + 8] = RT2_MX(k[(A) + 8], k[(B) + 7]); k[(A) + 9] = RT2_MX(k[(A) + 9], k[(B) + 6]); k[(A) + 10] = RT2_MX(k[(A) + 10], k[(B) + 5]); k[(A) + 11] = RT2_MX(k[(A) + 11], k[(B) + 4]); k[(A) + 12] = RT2_MX(k[(A) + 12], k[(B) + 3]); k[(A) + 13] = RT2_MX(k[(A) + 13], k[(B) + 2]); k[(A) + 14] = RT2_MX(k[(A) + 14], k[(B) + 1]); k[(A) + 15] = RT2_MX(k[(A) + 15], k[(B) + 0]); } while (0)
#define RT2_TOP16_OF_128(k) do { RT2_SORT16(k, 0); RT2_SORT16(k, 16); RT2_SORT16(k, 32); RT2_SORT16(k, 48); RT2_SORT16(k, 64); RT2_SORT16(k, 80); RT2_SORT16(k, 96); RT2_SORT16(k, 112); RT2_HCLEAN(k, 0, 16); RT2_BIT16(k, 0); RT2_HCLEAN(k, 32, 48); RT2_BIT16(k, 32); RT2_HCLEAN(k, 64, 80); RT2_BIT16(k, 64); RT2_HCLEAN(k, 96, 112); RT2_BIT16(k, 96); RT2_HCLEAN(k, 0, 32); RT2_BIT16(k, 0); RT2_HCLEAN(k, 64, 96); RT2_BIT16(k, 64); RT2_HCLEAN(k, 0, 64); RT2_BIT16(k, 0); } while (0)
#define RT2_BUILD_CANDS(c) do { c[0] = RT2_CK(0, 0); c[1] = RT2_CK(0, 1); c[2] = RT2_CK(0, 2); c[3] = RT2_CK(0, 3); c[4] = RT2_CK(0, 4); c[5] = RT2_CK(0, 5); c[6] = RT2_CK(0, 6); c[7] = RT2_CK(0, 7); c[8] = RT2_CK(0, 8); c[9] = RT2_CK(0, 9); c[10] = RT2_CK(0, 10); c[11] = RT2_CK(0, 11); c[12] = RT2_CK(0, 12); c[13] = RT2_CK(0, 13); c[14] = RT2_CK(0, 14); c[15] = RT2_CK(0, 15); c[16] = RT2_CK(1, 0); c[17] = RT2_CK(1, 1); c[18] = RT2_CK(1, 2); c[19] = RT2_CK(1, 3); c[20] = RT2_CK(1, 4); c[21] = RT2_CK(1, 5); c[22] = RT2_CK(1, 6); c[23] = RT2_CK(1, 7); c[24] = RT2_CK(15, 0); c[25] = RT2_CK(14, 0); c[26] = RT2_CK(13, 0); c[27] = RT2_CK(12, 0); c[28] = RT2_CK(11, 0); c[29] = RT2_CK(10, 0); c[30] = RT2_CK(9, 0); c[31] = RT2_CK(8, 0); c[32] = RT2_CK(2, 0); c[33] = RT2_CK(2, 1); c[34] = RT2_CK(2, 2); c[35] = RT2_CK(2, 3); c[36] = RT2_CK(2, 4); c[37] = RT2_CK(3, 0); c[38] = RT2_CK(3, 1); c[39] = RT2_CK(3, 2); c[40] = RT2_CK(3, 3); c[41] = RT2_CK(4, 0); c[42] = RT2_CK(4, 1); c[43] = RT2_CK(4, 2); c[44] = RT2_CK(5, 0); c[45] = RT2_CK(5, 1); c[46] = RT2_CK(6, 0); c[47] = RT2_CK(6, 1); } while (0)
__device__ __forceinline__ int rt2_tr(int u) { return u ^ (int)((unsigned)(u >> 31) >> 1); }
__device__ __forceinline__ int rt2_key(float x, int code, int mask) { return (rt2_tr(__builtin_bit_cast(int, x)) & ~mask) | code; }
__device__ __forceinline__ int rt2_key16(unsigned hbits_hi, int code) { return (rt2_tr((int)hbits_hi) & (int)0xffff0000) | code; }
__device__ __forceinline__ float rt2_val16(int k) { const unsigned u = (unsigned)rt2_tr(k) >> 16; return (float)__builtin_bit_cast(_Float16, (unsigned short)u); }
__device__ __forceinline__ void route_task(const unsigned short* SCT, v2u* ROUTE, int tok0, int h, LAS unsigned char* scr, int lane) {
    const int tok = tok0 + lane;
    LAS unsigned char* sb = scr + lane * 4;
#pragma unroll 1
    for (int p = 0; p < 2; ++p) {
        const int g = 2 * h + p; int k[128];
        const unsigned voff = (unsigned)tok * 16u;
#pragma unroll
        for (int q8 = 0; q8 < 16; ++q8) { const char* bq = (const char*)SCT + ((size_t)(g * 16 + q8) * M) * 16; const v4u q = *(const GAS v4u*)(bq + voff);
            k[8 * q8 + 0] = rt2_key16(q.x << 16, 127 - 8 * q8); k[8 * q8 + 1] = rt2_key16(q.x, 126 - 8 * q8); k[8 * q8 + 2] = rt2_key16(q.y << 16, 125 - 8 * q8); k[8 * q8 + 3] = rt2_key16(q.y, 124 - 8 * q8);
            k[8 * q8 + 4] = rt2_key16(q.z << 16, 123 - 8 * q8); k[8 * q8 + 5] = rt2_key16(q.z, 122 - 8 * q8); k[8 * q8 + 6] = rt2_key16(q.w << 16, 121 - 8 * q8); k[8 * q8 + 7] = rt2_key16(q.w, 120 - 8 * q8); }
        RT2_TOP16_OF_128(k);
#pragma unroll
        for (int i = 0; i < 16; ++i) *(LAS int*)(sb + (p * 16 + i) * 256) = k[i];
    }
    LDS_WAIT();
    float af[16], bf[16];
#pragma unroll
    for (int i = 0; i < 16; ++i) { af[i] = rt2_val16(*(const LAS int*)(sb + i * 256)); bf[i] = rt2_val16(*(const LAS int*)(sb + (16 + i) * 256)); }
    int c[48];
#define RT2_CK(i, j) rt2_key(af[i] + bf[j], 255 - (16 * (i) + (j)), 255)
    RT2_BUILD_CANDS(c);
    const int r7a = RT2_CK(7, 0), r7b = RT2_CK(7, 1);
#undef RT2_CK
    RT2_BIT16(c, 16);
    RT2_SORT16(c, 32);
    RT2_HCLEAN(c, 0, 16); RT2_BIT16(c, 0);
    c[46] = RT2_MX(c[46], r7b); c[47] = RT2_MX(c[47], r7a); RT2_BIT16(c, 32);
    RT2_HCLEAN(c, 0, 32);
    GAS v4u* rp = (GAS v4u*)((GAS v2u*)ROUTE + (size_t)tok * 128 + h * 16);
#pragma unroll
    for (int i = 0; i < 8; ++i) { v4u o;
        { const int ij = (~c[2 * i]) & 255; const int ka = *(const LAS int*)(sb + ((ij >> 4) << 8)), kb = *(const LAS int*)(sb + 4096 + ((ij & 15) << 8));
          o.x = (unsigned)(((~ka) & 127) * 128 + ((~kb) & 127)); o.y = __builtin_bit_cast(unsigned, rt2_val16(ka) + rt2_val16(kb)); }
        { const int ij = (~c[2 * i + 1]) & 255; const int ka = *(const LAS int*)(sb + ((ij >> 4) << 8)), kb = *(const LAS int*)(sb + 4096 + ((ij & 15) << 8));
          o.z = (unsigned)(((~ka) & 127) * 128 + ((~kb) & 127)); o.w = __builtin_bit_cast(unsigned, rt2_val16(ka) + rt2_val16(kb)); }
        rp[i] = o; }
    LDS_WAIT();
}

#define DPPF(v, ctrl) __builtin_bit_cast(float, __builtin_amdgcn_update_dpp(0, __builtin_bit_cast(int, (v)), (ctrl), 0xf, 0xf, true))
__device__ __forceinline__ float wave_max_f(float m) {
#pragma unroll
    for (int o = 1; o < 64; o <<= 1) m = __builtin_fmaxf(m, __shfl_xor(m, o));
    return m;
}
template <int NV> __device__ __forceinline__ void select16(const float (&v)[NV], bool (&sel)[NV], int (&pos)[NV]) {
    float mx = v[0], mn = v[0];
#pragma unroll
    for (int i = 1; i < NV; ++i) { mx = __builtin_fmaxf(mx, v[i]); mn = __builtin_fminf(mn, v[i]); }
    mx = wave_max_f(mx); mn = -wave_max_f(-mn);
    float lo = mn, hi = mx, Tv;
    { int c = 0;
#pragma unroll
      for (int i = 0; i < NV; ++i) c += __popcll(__ballot(v[i] >= mx));
      if (c >= 16) { Tv = mx; }
      else {
        Tv = lo;
        for (int it = 0; it < 300; ++it) {
            const float mid = 0.5f * lo + 0.5f * hi;
            if (!(mid > lo && mid < hi)) { Tv = lo; break; }
            int cc = 0;
#pragma unroll
            for (int i = 0; i < NV; ++i) cc += __popcll(__ballot(v[i] >= mid));
            if (cc == 16) { Tv = mid; break; }
            if (cc > 16) lo = mid; else hi = mid;
            Tv = lo;
        }
      }
    }
    int cgt = 0;
#pragma unroll
    for (int i = 0; i < NV; ++i) cgt += __popcll(__ballot(v[i] > Tv));
    const int need = 16 - cgt;
    int eqbelow = 0;
#pragma unroll
    for (int i = 0; i < NV; ++i) { const unsigned long long m = __ballot(v[i] == Tv); eqbelow += __builtin_amdgcn_mbcnt_hi((unsigned)(m >> 32), __builtin_amdgcn_mbcnt_lo((unsigned)m, 0u)); }
    int eqown = 0;
#pragma unroll
    for (int i = 0; i < NV; ++i) { const bool eq = (v[i] == Tv); sel[i] = (v[i] > Tv) || (eq && (eqbelow + eqown) < need); eqown += eq ? 1 : 0; }
    int selbelow = 0;
#pragma unroll
    for (int i = 0; i < NV; ++i) { const unsigned long long m = __ballot(sel[i]); selbelow += __builtin_amdgcn_mbcnt_hi((unsigned)(m >> 32), __builtin_amdgcn_mbcnt_lo((unsigned)m, 0u)); }
    int own = 0;
#pragma unroll
    for (int i = 0; i < NV; ++i) { pos[i] = selbelow + own; own += sel[i] ? 1 : 0; }
}

__device__ __forceinline__ float gelu_exact(float a) { return 0.5f * a * (1.0f + erff(a * 0.7071067811865476f)); }

__device__ __forceinline__ void fp8_row_dot(const v4u q, const float (&xr)[16], float& s) {
    const f32x2 a0 = __builtin_amdgcn_cvt_pk_f32_fp8((int)q.x, false), a1 = __builtin_amdgcn_cvt_pk_f32_fp8((int)q.x, true), a2 = __builtin_amdgcn_cvt_pk_f32_fp8((int)q.y, false), a3 = __builtin_amdgcn_cvt_pk_f32_fp8((int)q.y, true);
    const f32x2 b0 = __builtin_amdgcn_cvt_pk_f32_fp8((int)q.z, false), b1 = __builtin_amdgcn_cvt_pk_f32_fp8((int)q.z, true), b2 = __builtin_amdgcn_cvt_pk_f32_fp8((int)q.w, false), b3 = __builtin_amdgcn_cvt_pk_f32_fp8((int)q.w, true);
    f32x2 t = a0 * (f32x2){xr[0], xr[1]};
    t = __builtin_elementwise_fma(a1, (f32x2){xr[2], xr[3]}, t); t = __builtin_elementwise_fma(a2, (f32x2){xr[4], xr[5]}, t); t = __builtin_elementwise_fma(a3, (f32x2){xr[6], xr[7]}, t);
    t = __builtin_elementwise_fma(b0, (f32x2){xr[8], xr[9]}, t); t = __builtin_elementwise_fma(b1, (f32x2){xr[10], xr[11]}, t); t = __builtin_elementwise_fma(b2, (f32x2){xr[12], xr[13]}, t); t = __builtin_elementwise_fma(b3, (f32x2){xr[14], xr[15]}, t);
    s = t.x + t.y;
}
__device__ __forceinline__ void fp8_row_axpy2(const v4u q, const float w, f32x2 (&acc)[8]) {
    const f32x2 a0 = __builtin_amdgcn_cvt_pk_f32_fp8((int)q.x, false), a1 = __builtin_amdgcn_cvt_pk_f32_fp8((int)q.x, true), a2 = __builtin_amdgcn_cvt_pk_f32_fp8((int)q.y, false), a3 = __builtin_amdgcn_cvt_pk_f32_fp8((int)q.y, true);
    const f32x2 b0 = __builtin_amdgcn_cvt_pk_f32_fp8((int)q.z, false), b1 = __builtin_amdgcn_cvt_pk_f32_fp8((int)q.z, true), b2 = __builtin_amdgcn_cvt_pk_f32_fp8((int)q.w, false), b3 = __builtin_amdgcn_cvt_pk_f32_fp8((int)q.w, true);
    const f32x2 ww = {w, w};
    acc[0] = __builtin_elementwise_fma(a0, ww, acc[0]); acc[1] = __builtin_elementwise_fma(a1, ww, acc[1]); acc[2] = __builtin_elementwise_fma(a2, ww, acc[2]); acc[3] = __builtin_elementwise_fma(a3, ww, acc[3]);
    acc[4] = __builtin_elementwise_fma(b0, ww, acc[4]); acc[5] = __builtin_elementwise_fma(b1, ww, acc[5]); acc[6] = __builtin_elementwise_fma(b2, ww, acc[6]); acc[7] = __builtin_elementwise_fma(b3, ww, acc[7]);
}
__device__ __forceinline__ void fp8_row_axpy(const v4u q, const float w, float (&acc)[16]) {
    const f32x2 a0 = __builtin_amdgcn_cvt_pk_f32_fp8((int)q.x, false), a1 = __builtin_amdgcn_cvt_pk_f32_fp8((int)q.x, true), a2 = __builtin_amdgcn_cvt_pk_f32_fp8((int)q.y, false), a3 = __builtin_amdgcn_cvt_pk_f32_fp8((int)q.y, true);
    const f32x2 b0 = __builtin_amdgcn_cvt_pk_f32_fp8((int)q.z, false), b1 = __builtin_amdgcn_cvt_pk_f32_fp8((int)q.z, true), b2 = __builtin_amdgcn_cvt_pk_f32_fp8((int)q.w, false), b3 = __builtin_amdgcn_cvt_pk_f32_fp8((int)q.w, true);
    acc[0] += w * a0.x; acc[1] += w * a0.y; acc[2] += w * a1.x; acc[3] += w * a1.y; acc[4] += w * a2.x; acc[5] += w * a2.y; acc[6] += w * a3.x; acc[7] += w * a3.y;
    acc[8] += w * b0.x; acc[9] += w * b0.y; acc[10] += w * b1.x; acc[11] += w * b1.y; acc[12] += w * b2.x; acc[13] += w * b2.y; acc[14] += w * b3.x; acc[15] += w * b3.y;
}
__device__ __forceinline__ void fp8_convert_row(const float* src, const float* gain, unsigned char* dst, float* inv_scale, int lane, int sliced, int e) {
    const GAS f32x4* sp = (const GAS f32x4*)src; float v[16];
#pragma unroll
    for (int j = 0; j < 2; ++j) { f32x4 a = sp[2 * lane + 128 * j], b = sp[2 * lane + 128 * j + 1];
        if (gain) { const GAS f32x4* gp = (const GAS f32x4*)gain; const f32x4 ga = gp[2 * lane + 128 * j], gb = gp[2 * lane + 128 * j + 1]; a = a * ga; b = b * gb; }
        v[8 * j + 0] = a.x; v[8 * j + 1] = a.y; v[8 * j + 2] = a.z; v[8 * j + 3] = a.w; v[8 * j + 4] = b.x; v[8 * j + 5] = b.y; v[8 * j + 6] = b.z; v[8 * j + 7] = b.w; }
    float am = 0.f;
#pragma unroll
    for (int i = 0; i < 16; ++i) am = __builtin_fmaxf(am, __builtin_fabsf(v[i]));
    am = wave_max_f(am);
    const float sc = (am > 0.f) ? 384.0f / am : 1.0f, inv = (am > 0.f) ? am * (1.0f / 384.0f) : 1.0f;
    v4u q;
    { int w = __builtin_amdgcn_cvt_pk_fp8_f32(v[0] * sc, v[1] * sc, 0, false); w = __builtin_amdgcn_cvt_pk_fp8_f32(v[2] * sc, v[3] * sc, w, true); q.x = (unsigned)w; }
    { int w = __builtin_amdgcn_cvt_pk_fp8_f32(v[4] * sc, v[5] * sc, 0, false); w = __builtin_amdgcn_cvt_pk_fp8_f32(v[6] * sc, v[7] * sc, w, true); q.y = (unsigned)w; }
    { int w = __builtin_amdgcn_cvt_pk_fp8_f32(v[8] * sc, v[9] * sc, 0, false); w = __builtin_amdgcn_cvt_pk_fp8_f32(v[10] * sc, v[11] * sc, w, true); q.z = (unsigned)w; }
    { int w = __builtin_amdgcn_cvt_pk_fp8_f32(v[12] * sc, v[13] * sc, 0, false); w = __builtin_amdgcn_cvt_pk_fp8_f32(v[14] * sc, v[15] * sc, w, true); q.w = (unsigned)w; }
    if (!sliced) ((GAS v4u*)dst)[lane] = q;
    else { v2u q0, q1; q0.x = q.x; q0.y = q.y; q1.x = q.z; q1.y = q.w; const int s0 = lane >> 4, o8 = 8 * (lane & 15);
        *(GAS v2u*)(dst + ((size_t)s0 * NEXP + e) * 128 + o8) = q0; *(GAS v2u*)(dst + ((size_t)(s0 + 4) * NEXP + e) * 128 + o8) = q1; }
    if (lane == 0) *inv_scale = inv;
}

#define PIN_ACC2(b) asm volatile("" : "+v"(b), "+v"(acc2[0]), "+v"(acc2[1]), "+v"(acc2[2]), "+v"(acc2[3]), "+v"(acc2[4]), "+v"(acc2[5]), "+v"(acc2[6]), "+v"(acc2[7]))
#define PIN_ACC(b) asm volatile("" : "+v"(b), "+v"(acc[0]), "+v"(acc[1]), "+v"(acc[2]), "+v"(acc[3]), "+v"(acc[4]), "+v"(acc[5]), "+v"(acc[6]), "+v"(acc[7]), "+v"(acc[8]), "+v"(acc[9]), "+v"(acc[10]), "+v"(acc[11]), "+v"(acc[12]), "+v"(acc[13]), "+v"(acc[14]), "+v"(acc[15]))
#define PC_META_U(tk) do { const char* rb_ = (const char*)route + (size_t)(tk) * 1024; m_e0 = *(const GAS int*)(rb_ + l8); m_e1 = *(const GAS int*)(rb_ + 512 + l8); } while (0)
#define PC_ISSUE_U(buf, xs, par, tk) do { LAS int* lid_ = (LAS int*)(scr + (par) * 512); lid_[lane] = m_e0; lid_[lane + 64] = m_e1; LDS_WAIT(); \
        { const GAS f32x4* xq_ = (const GAS f32x4*)(x1 + (size_t)(tk) * D + 128 * s + 16 * c); const f32x4 x0_ = xq_[0], x1_ = xq_[1], x2_ = xq_[2], x3_ = xq_[3]; \
          xs[0] = x0_.x; xs[1] = x0_.y; xs[2] = x0_.z; xs[3] = x0_.w; xs[4] = x1_.x; xs[5] = x1_.y; xs[6] = x1_.z; xs[7] = x1_.w; xs[8] = x2_.x; xs[9] = x2_.y; xs[10] = x2_.z; xs[11] = x2_.w; xs[12] = x3_.x; xs[13] = x3_.y; xs[14] = x3_.z; xs[15] = x3_.w; } \
        _Pragma("unroll") for (int k = 0; k < 16; ++k) { const int e_ = lid_[8 * k + r]; buf[k] = *(const GAS v4u*)(tbs + (unsigned)(e_ * 128)); } } while (0)
#define PC_COMPUTE_U(buf, xs, tk) do { float p_[16]; \
        _Pragma("unroll") for (int k = 0; k < 16; ++k) { if (k) asm volatile("" : "+v"(buf[k]), "+v"(p_[k ? k - 1 : 0])); else asm volatile("" : "+v"(buf[k])); fp8_row_dot(buf[k], xs, p_[k]); } \
        float q8_[8], q4_[4], q2_[2]; \
        _Pragma("unroll") for (int k = 0; k < 8; ++k) { const float send = c2 ? p_[k] : p_[k + 8], keep = c2 ? p_[k + 8] : p_[k]; q8_[k] = keep + __shfl_xor(send, 4); } \
        _Pragma("unroll") for (int k = 0; k < 4; ++k) { const float send = c1 ? q8_[k] : q8_[k + 4], keep = c1 ? q8_[k + 4] : q8_[k]; q4_[k] = keep + __shfl_xor(send, 2); } \
        _Pragma("unroll") for (int k = 0; k < 2; ++k) { const float send = c0 ? q4_[k] : q4_[k + 2], keep = c0 ? q4_[k + 2] : q4_[k]; q2_[k] = keep + __shfl_xor(send, 1); } \
        GAS float* up_ = (GAS float*)(Upart + ((size_t)s * M + (tk)) * 128 + 64 * c2 + 32 * c1 + 16 * c0 + r); up_[0] = q2_[0]; up_[8] = q2_[1]; } while (0)
__device__ __forceinline__ void peer_u_phase(int s, int tok0, int tstride, int nitems, const v2u* route, const float* x1, const unsigned char* TU8s, float* Upart, LAS unsigned char* scr, int lane) {
    const int r = lane >> 3, c = lane & 7, c2 = (lane >> 2) & 1, c1 = (lane >> 1) & 1, c0 = lane & 1; const unsigned l8 = (unsigned)lane * 8u;
    const char* tbs = (const char*)TU8s + (size_t)s * NEXP * 128 + 16 * c;
    int m_e0, m_e1;
    v4u bufA[16], bufB[16]; float xsA[16], xsB[16];
    PC_META_U(tok0); PC_ISSUE_U(bufA, xsA, 0, tok0); if (nitems > 1) PC_META_U(tok0 + tstride);
#pragma unroll 1
    for (int i = 0; i < nitems; i += 2) {
        const int tk = tok0 + i * tstride;
        if (i + 1 < nitems) PC_ISSUE_U(bufB, xsB, 1, tk + tstride);
        if (i + 2 < nitems) PC_META_U(tk + 2 * tstride);
        PC_COMPUTE_U(bufA, xsA, tk);
        if (i + 1 < nitems) {
            if (i + 2 < nitems) PC_ISSUE_U(bufA, xsA, 0, tk + 2 * tstride);
            if (i + 3 < nitems) PC_META_U(tk + 3 * tstride);
            PC_COMPUTE_U(bufB, xsB, tk + tstride);
        }
    }
    LDS_WAIT();
}
#define PD_META_U(tk) do { const char* rb_ = (const char*)route + (size_t)(tk) * 1024; m_e0 = *(const GAS int*)(rb_ + l8); m_e1 = *(const GAS int*)(rb_ + 512 + l8); \
        { const unsigned xw_ = *(const GAS unsigned*)((const bf16*)x1 + (size_t)(tk) * D + 128 * s + 2 * lane); m_x.x = bflo(xw_); m_x.y = bfhi(xw_); } } while (0)
#define PD_ISSUE_U(buf, xq, xinv, par) do { LAS int* lid_ = (LAS int*)(scr + (par) * 1024); LAS unsigned short* lx_ = (LAS unsigned short*)(scr + (par) * 1024 + 512); lid_[lane] = m_e0; lid_[lane + 64] = m_e1; LDS_WAIT(); \
        _Pragma("unroll") for (int k = 0; k < 16; ++k) { const int e_ = lid_[8 * k + r]; buf[k] = *(const GAS v4u*)(tbs + (unsigned)(e_ * 128)); } \
        { float am_ = __builtin_fmaxf(__builtin_fabsf(m_x.x), __builtin_fabsf(m_x.y)); \
          _Pragma("unroll") for (int o_ = 1; o_ < 64; o_ <<= 1) am_ = __builtin_fmaxf(am_, __shfl_xor(am_, o_)); \
          const float sc_ = (am_ > 0.f) ? 127.0f / am_ : 0.f; xinv = am_ * (1.0f / 127.0f); \
          const int q0_ = (int)__builtin_rintf(m_x.x * sc_), q1_ = (int)__builtin_rintf(m_x.y * sc_); lx_[lane] = (unsigned short)(((unsigned)q0_ & 255u) | (((unsigned)q1_ & 255u) << 8)); } \
        LDS_WAIT(); xq = *(const LAS v4u*)((LAS unsigned char*)lx_ + 16 * c); } while (0)
#define PD_COMPUTE_U(buf, xq, xinv, tk) do { int p_[16]; \
        _Pragma("unroll") for (int k = 0; k < 16; ++k) { int a_ = __builtin_amdgcn_sdot4((int)buf[k].x, (int)xq.x, 0, false); a_ = __builtin_amdgcn_sdot4((int)buf[k].y, (int)xq.y, a_, false); \
            a_ = __builtin_amdgcn_sdot4((int)buf[k].z, (int)xq.z, a_, false); a_ = __builtin_amdgcn_sdot4((int)buf[k].w, (int)xq.w, a_, false); p_[k] = a_; } \
          \
        LAS int* red_ = (LAS int*)(scr + 2048); \
        _Pragma("unroll") for (int k = 0; k < 16; ++k) red_[64 * k + lane] = p_[k]; \
        LDS_WAIT(); \
        const v4u ra_ = *(const LAS v4u*)(red_ + 8 * lane + rsw), rb_ = *(const LAS v4u*)(red_ + 8 * lane + (4 - rsw)), rc_ = *(const LAS v4u*)(red_ + 512 + 8 * lane + rsw), rd_ = *(const LAS v4u*)(red_ + 512 + 8 * lane + (4 - rsw)); \
        const int s0_ = (int)(ra_.x + ra_.y + ra_.z + ra_.w + rb_.x + rb_.y + rb_.z + rb_.w), s1_ = (int)(rc_.x + rc_.y + rc_.z + rc_.w + rd_.x + rd_.y + rd_.z + rd_.w); \
        GAS bf16* up_ = (GAS bf16*)Upart + ((size_t)s * M + (tk)) * 128 + lane; const unsigned pk_ = cvtpk((float)s0_ * xinv, (float)s1_ * xinv); up_[0] = (bf16)(pk_ & 0xffffu); up_[64] = (bf16)(pk_ >> 16); } while (0)
__device__ __forceinline__ void peer_u_phase_dot4(int s, int tok0, int tstride, int nitems, const v2u* route, const float* x1, const unsigned char* TU8s, float* Upart, LAS unsigned char* scr, int lane) {
    const int r = lane >> 3, c = lane & 7, rsw = 4 * ((lane >> 3) & 1); const unsigned l8 = (unsigned)lane * 8u;
    const char* tbs = (const char*)TU8s + (size_t)s * NEXP * 128 + 16 * c;
    int m_e0, m_e1; f32x2 m_x;
    v4u bufA[16], bufB[16], xqA, xqB; float xiA, xiB;
    PD_META_U(tok0); PD_ISSUE_U(bufA, xqA, xiA, 0); if (nitems > 1) PD_META_U(tok0 + tstride);
#pragma unroll 1
    for (int it = 0; it < nitems; it += 2) {
        const int tk = tok0 + it * tstride;
        if (it + 1 < nitems) PD_ISSUE_U(bufB, xqB, xiB, 1);
        if (it + 2 < nitems) PD_META_U(tk + 2 * tstride);
        PD_COMPUTE_U(bufA, xqA, xiA, tk);
        if (it + 1 < nitems) {
            if (it + 2 < nitems) PD_ISSUE_U(bufA, xqA, xiA, 0);
            if (it + 3 < nitems) PD_META_U(tk + 3 * tstride);
            PD_COMPUTE_U(bufB, xqB, xiB, tk + tstride);
        }
    }
    LDS_WAIT();
}
__device__ __forceinline__ void peer_w_token(int tok, const v2u* route, const float* x1, const float* Upart, const float* SU, const float* SV, float* W, int lane) {
    const GAS f32x4* xp = (const GAS f32x4*)(x1 + (size_t)tok * D) + lane; float ssq = 0.f;
#pragma unroll
    for (int j = 0; j < 4; ++j) { const f32x4 q = xp[64 * j]; ssq += (q.x * q.x + q.y * q.y) + (q.z * q.z + q.w * q.w); }
    const float rstd2 = 1.0f / sqrtf(wave_sum(ssq) * (1.0f / D) + RMS_EPS);
    const char* rb_ = (const char*)route + (size_t)tok * 1024; const unsigned l8_ = (unsigned)lane * 8u;
    const v2u r_lo = *(const GAS v2u*)(rb_ + l8_), r_hi = *(const GAS v2u*)(rb_ + 512 + l8_);
    float g_lo, g_hi;
#pragma unroll
    for (int half = 0; half < 2; ++half) {
        const float sc_ = __builtin_bit_cast(float, half ? r_hi.y : r_lo.y) * rstd2; float m_ = sc_;
#pragma unroll
        for (int o = 1; o < 16; o <<= 1) m_ = __builtin_fmaxf(m_, __shfl_xor(m_, o));
        const float p_ = __builtin_amdgcn_exp2f((sc_ - m_) * 1.4426950408889634f); float sum_ = p_;
#pragma unroll
        for (int o = 1; o < 16; o <<= 1) sum_ += __shfl_xor(sum_, o);
        if (half) g_hi = p_ / sum_; else g_lo = p_ / sum_;
    }
    asm volatile("" : "+v"(g_lo), "+v"(g_hi));
#pragma unroll
    for (int half = 0; half < 2; ++half) {
        const int e = (int)(half ? r_hi.x : r_lo.x); const int n = lane + 64 * half;
        float dot = 0.f;
#pragma unroll
        for (int s8 = 0; s8 < 8; ++s8) dot += Upart[((size_t)s8 * M + tok) * 128 + n];
        const float act = gelu_exact(dot * SU[e] * rstd2);
        W[(size_t)tok * 128 + n] = (half ? g_hi : g_lo) * act * SV[e];
    }
}
__device__ __forceinline__ void peer_w_token2(int tokA, int tokB, const v2u* route, const bf16* x1b, const bf16* Upart, const float* SU, const float* SV, float* W, int lane) {
    v4u xv[2][2]; v2u r_lo[2], r_hi[2]; unsigned short ub[2][2][8];
#pragma unroll
    for (int t = 0; t < 2; ++t) { const int tok = t ? tokB : tokA;
        const GAS v4u* xp = (const GAS v4u*)(x1b + (size_t)tok * D) + lane; xv[t][0] = xp[0]; xv[t][1] = xp[64];
        const char* rb_ = (const char*)route + (size_t)tok * 1024; const unsigned l8_ = (unsigned)lane * 8u;
        r_lo[t] = *(const GAS v2u*)(rb_ + l8_); r_hi[t] = *(const GAS v2u*)(rb_ + 512 + l8_);
#pragma unroll
        for (int half = 0; half < 2; ++half)
#pragma unroll
            for (int s8 = 0; s8 < 8; ++s8) ub[t][half][s8] = *(const GAS bf16*)(Upart + ((size_t)s8 * M + tok) * 128 + lane + 64 * half); }
#pragma unroll
    for (int t = 0; t < 2; ++t) { const int tok = t ? tokB : tokA;
        float ssq = 0.f;
#pragma unroll
        for (int j = 0; j < 2; ++j) { const v4u q = xv[t][j];
            ssq += (bflo(q.x) * bflo(q.x) + bfhi(q.x) * bfhi(q.x)) + (bflo(q.y) * bflo(q.y) + bfhi(q.y) * bfhi(q.y)) + (bflo(q.z) * bflo(q.z) + bfhi(q.z) * bfhi(q.z)) + (bflo(q.w) * bflo(q.w) + bfhi(q.w) * bfhi(q.w)); }
        const float rstd2 = 1.0f / sqrtf(wave_sum(ssq) * (1.0f / D) + RMS_EPS);
        float g_lo, g_hi;
#pragma unroll
        for (int half = 0; half < 2; ++half) {
            const float sc_ = __builtin_bit_cast(float, half ? r_hi[t].y : r_lo[t].y) * rstd2; float m_ = sc_;
#pragma unroll
            for (int o = 1; o < 16; o <<= 1) m_ = __builtin_fmaxf(m_, __shfl_xor(m_, o));
            const float p_ = __builtin_amdgcn_exp2f((sc_ - m_) * 1.4426950408889634f); float sum_ = p_;
#pragma unroll
            for (int o = 1; o < 16; o <<= 1) sum_ += __shfl_xor(sum_, o);
            if (half) g_hi = p_ / sum_; else g_lo = p_ / sum_;
        }
        asm volatile("" : "+v"(g_lo), "+v"(g_hi));
#pragma unroll
        for (int half = 0; half < 2; ++half) {
            const int e = (int)(half ? r_hi[t].x : r_lo[t].x); const int n = lane + 64 * half;
            float dot = 0.f;
#pragma unroll
            for (int s8 = 0; s8 < 8; ++s8) dot += __builtin_bit_cast(float, (unsigned)ub[t][half][s8] << 16);
            const float act = gelu_exact(dot * SU[e] * rstd2);
            W[(size_t)tok * 128 + n] = (half ? g_hi : g_lo) * act * SV[e];
        }
    }
}
#define PC_META_V(tk) do { const char* rb_ = (const char*)route + (size_t)(tk) * 1024; m_e0 = *(const GAS int*)(rb_ + l8); m_e1 = *(const GAS int*)(rb_ + 512 + l8); \
        const GAS float* wp_ = (const GAS float*)(W + (size_t)(tk) * 128); m_w0 = wp_[lane]; m_w1 = wp_[lane + 64]; m_xv = *(const GAS unsigned*)(xres + (size_t)(tk) * D + col0); } while (0)
#define PC_ISSUE_V(buf, wk, xv, par) do { LAS int* lid_ = (LAS int*)(scr + (par) * 1024); LAS float* lw_ = (LAS float*)(scr + (par) * 1024 + 512); lid_[lane] = m_e0; lid_[lane + 64] = m_e1; lw_[lane] = m_w0; lw_[lane + 64] = m_w1; LDS_WAIT(); xv = m_xv; \
        _Pragma("unroll") for (int k = 0; k < 16; ++k) { const int e_ = lid_[8 * k + r]; wk[k] = lw_[8 * k + r]; buf[k] = *(const GAS v4u*)(tbs + (unsigned)(e_ * 128)); } } while (0)
#define PC_COMPUTE_V(buf, wk, xv, tk) do { f32x2 acc2[8]; _Pragma("unroll") for (int i_ = 0; i_ < 8; ++i_) acc2[i_] = (f32x2){0.f, 0.f}; \
        _Pragma("unroll") for (int k = 0; k < 16; ++k) { PIN_ACC2(buf[k]); fp8_row_axpy2(buf[k], wk[k], acc2); } \
          \
        LAS float* red_ = (LAS float*)(scr + 2048); LAS f32x4* wp_ = (LAS f32x4*)(red_ + 128 * r + 16 * c); \
        _Pragma("unroll") for (int j_ = 0; j_ < 4; ++j_) { f32x4 t_; t_.x = acc2[2 * j_].x; t_.y = acc2[2 * j_].y; t_.z = acc2[2 * j_ + 1].x; t_.w = acc2[2 * j_ + 1].y; wp_[j_] = t_; } \
        LDS_WAIT(); \
        f32x2 o_; o_.x = bflo(xv); o_.y = bfhi(xv); \
        _Pragma("unroll") for (int rr_ = 0; rr_ < 8; ++rr_) { const f32x2 t_ = *(const LAS f32x2*)(red_ + 128 * rr_ + 2 * lane); o_.x += t_.x; o_.y += t_.y; } \
        *(GAS f32x2*)(xio + (size_t)(tk) * D + col0) = o_; } while (0)
__device__ __forceinline__ void peer_v_phase(int s, int tok0, int tstride, int nitems, const v2u* route, const float* W, const unsigned char* TV8s, const bf16* xres, float* xio, float* SS, LAS unsigned char* scr, int lane) {
    const int r = lane >> 3, c = lane & 7; const unsigned l8 = (unsigned)lane * 8u;
    const int col0 = 128 * s + 2 * lane;
    const char* tbs = (const char*)TV8s + (size_t)s * NEXP * 128 + 16 * c;
    int m_e0, m_e1; float m_w0, m_w1; unsigned m_xv;
    v4u bufA[16], bufB[16]; float wA[16], wB[16]; unsigned xvA, xvB;
    PC_META_V(tok0); PC_ISSUE_V(bufA, wA, xvA, 0); if (nitems > 1) PC_META_V(tok0 + tstride);
#pragma unroll 1
    for (int i = 0; i < nitems; i += 2) {
        const int tk = tok0 + i * tstride;
        if (i + 1 < nitems) PC_ISSUE_V(bufB, wB, xvB, 1);
        if (i + 2 < nitems) PC_META_V(tk + 2 * tstride);
        PC_COMPUTE_V(bufA, wA, xvA, tk);
        if (i + 1 < nitems) {
            if (i + 2 < nitems) PC_ISSUE_V(bufA, wA, xvA, 0);
            if (i + 3 < nitems) PC_META_V(tk + 3 * tstride);
            PC_COMPUTE_V(bufB, wB, xvB, tk + tstride);
        }
    }
    LDS_WAIT();
}


#define FZ_S(i_) ((xs + ((i_) >> 3)) & 7)
#define FZ_TK(i_) (tokb + tjs * ((i_) & 7))
#define FU_META(i_) do { const unsigned xw_ = *(const GAS unsigned*)(x1b + (size_t)FZ_TK(i_) * D + 128 * FZ_S(i_) + 2 * lane); m_x.x = bflo(xw_); m_x.y = bfhi(xw_); } while (0)
#define FU_ISSUE(buf, xq, xinv, par, i_) do { const LAS int* lid_ = ids + ((i_) & 7) * 128; LAS unsigned short* lx_ = (LAS unsigned short*)(scr + 12288 + (par) * 128); \
        const char* tb_ = (const char*)TU8s + (size_t)FZ_S(i_) * NEXP * 128 + 16 * c; \
        _Pragma("unroll") for (int k = 0; k < 16; ++k) { const int e_ = lid_[8 * k + r]; buf[k] = *(const GAS v4u*)(tb_ + (unsigned)(e_ * 128)); } \
        { const float sc_ = tks[((i_) & 7)]; xinv = tks[8 + ((i_) & 7)];        \
          const int q0_ = (int)__builtin_rintf(m_x.x * sc_), q1_ = (int)__builtin_rintf(m_x.y * sc_); lx_[lane] = (unsigned short)(((unsigned)q0_ & 255u) | (((unsigned)q1_ & 255u) << 8)); } \
        LDS_WAIT(); xq = *(const LAS v4u*)((LAS unsigned char*)lx_ + 16 * c); } while (0)
#define FU_COMPUTE(buf, xq, xinv, i_) do { int p_[16]; \
        _Pragma("unroll") for (int k = 0; k < 16; ++k) { int a_ = __builtin_amdgcn_sdot4((int)buf[k].x, (int)xq.x, 0, false); a_ = __builtin_amdgcn_sdot4((int)buf[k].y, (int)xq.y, a_, false); \
            a_ = __builtin_amdgcn_sdot4((int)buf[k].z, (int)xq.z, a_, false); a_ = __builtin_amdgcn_sdot4((int)buf[k].w, (int)xq.w, a_, false); p_[k] = a_; } \
        LAS int* red_ = (LAS int*)(scr + 8192); \
        _Pragma("unroll") for (int k = 0; k < 16; ++k) red_[64 * k + lane] = p_[k]; \
        LDS_WAIT(); \
        const v4u ra_ = *(const LAS v4u*)(red_ + 8 * lane + rsw), rb_ = *(const LAS v4u*)(red_ + 8 * lane + (4 - rsw)), rc_ = *(const LAS v4u*)(red_ + 512 + 8 * lane + rsw), rd_ = *(const LAS v4u*)(red_ + 512 + 8 * lane + (4 - rsw)); \
        const int s0_ = (int)(ra_.x + ra_.y + ra_.z + ra_.w + rb_.x + rb_.y + rb_.z + rb_.w), s1_ = (int)(rc_.x + rc_.y + rc_.z + rc_.w + rd_.x + rd_.y + rd_.z + rd_.w); \
        LAS float* ua_ = uw + ((i_) & 7) * 128 + lane; ua_[0] += (float)s0_ * xinv; ua_[64] += (float)s1_ * xinv; } while (0)
#define FV_META(i_) do { m_xv = *(const GAS unsigned*)(x1b + (size_t)FZ_TK(i_) * D + 128 * FZ_S(i_) + 2 * lane); } while (0)
#define FV_ISSUE(buf, wk, xv, i_) do { const LAS int* lid_ = ids + ((i_) & 7) * 128; const LAS float* lw_ = uw + ((i_) & 7) * 128; xv = m_xv; \
        const char* tb_ = (const char*)TV8s + (size_t)FZ_S(i_) * NEXP * 128 + 16 * c; \
        _Pragma("unroll") for (int k = 0; k < 16; ++k) { const int e_ = lid_[8 * k + r]; wk[k] = lw_[8 * k + r]; buf[k] = *(const GAS v4u*)(tb_ + (unsigned)(e_ * 128)); } } while (0)
#define FV_COMPUTE(buf, wk, xv, i_) do { f32x2 acc2[8]; _Pragma("unroll") for (int i2_ = 0; i2_ < 8; ++i2_) acc2[i2_] = (f32x2){0.f, 0.f}; \
        _Pragma("unroll") for (int k = 0; k < 16; ++k) { PIN_ACC2(buf[k]); fp8_row_axpy2(buf[k], wk[k], acc2); } \
        LAS float* red_ = (LAS float*)(scr + 8192); LAS f32x4* wp_ = (LAS f32x4*)(red_ + 128 * r + 16 * c); \
        _Pragma("unroll") for (int j_ = 0; j_ < 4; ++j_) { f32x4 t_; t_.x = acc2[2 * j_].x; t_.y = acc2[2 * j_].y; t_.z = acc2[2 * j_ + 1].x; t_.w = acc2[2 * j_ + 1].y; wp_[j_] = t_; } \
        LDS_WAIT(); \
        f32x2 o_; o_.x = bflo(xv); o_.y = bfhi(xv); \
        _Pragma("unroll") for (int rr_ = 0; rr_ < 8; ++rr_) { const f32x2 t_ = *(const LAS f32x2*)(red_ + 128 * rr_ + 2 * lane); o_.x += t_.x; o_.y += t_.y; } \
        *(GAS f32x2*)(xio + (size_t)FZ_TK(i_) * D + 128 * FZ_S(i_) + 2 * lane) = o_; } while (0)
__device__ __forceinline__ void peer_fused(int xs, int tokb, int tjs, const v2u* route, const bf16* x1b, const unsigned char* TU8s, const unsigned char* TV8s, const float* SU, const float* SV,
                                           const float* gain, float* xio, LAS unsigned char* scr, int lane) {
    const int r = lane >> 3, c = lane & 7, rsw = 4 * ((lane >> 3) & 1); const unsigned l8 = (unsigned)lane * 8u;
    LAS int* ids = (LAS int*)scr; LAS float* uw = (LAS float*)(scr + 4096); LAS float* tks = (LAS float*)(scr + 12288 + 256);
    { v4u xr[8][2];
#pragma unroll
      for (int t = 0; t < 8; ++t) { const GAS v4u* xp = (const GAS v4u*)(x1b + (size_t)(tokb + tjs * t) * D) + lane; xr[t][0] = xp[0]; xr[t][1] = xp[64]; }
      float am[8], sq[8];
#pragma unroll
      for (int t = 0; t < 8; ++t) { am[t] = 0.f; sq[t] = 0.f;
#pragma unroll
          for (int j = 0; j < 2; ++j) { const v4u q = xr[t][j]; const unsigned w4[4] = {q.x, q.y, q.z, q.w};
#pragma unroll
              for (int e = 0; e < 4; ++e) { const float a = bflo(w4[e]), b = bfhi(w4[e]); am[t] = __builtin_fmaxf(am[t], __builtin_fmaxf(__builtin_fabsf(a), __builtin_fabsf(b))); sq[t] += a * a + b * b; } } }
#pragma unroll
      for (int o = 1; o < 64; o <<= 1) {
#pragma unroll
          for (int t = 0; t < 8; ++t) { am[t] = __builtin_fmaxf(am[t], __shfl_xor(am[t], o)); sq[t] += __shfl_xor(sq[t], o); } }
#pragma unroll
      for (int t = 0; t < 8; ++t) if (lane == 0) { tks[t] = (am[t] > 0.f) ? 127.0f / am[t] : 0.f; tks[8 + t] = am[t] * (1.0f / 127.0f); tks[16 + t] = 1.0f / sqrtf(sq[t] * (1.0f / D) + RMS_EPS); } }
#pragma unroll
    for (int j = 0; j < 8; ++j) { const char* rb_ = (const char*)route + (size_t)(tokb + tjs * j) * 1024;
        ids[j * 128 + lane] = *(const GAS int*)(rb_ + l8); ids[j * 128 + 64 + lane] = *(const GAS int*)(rb_ + 512 + l8); uw[j * 128 + lane] = 0.f; uw[j * 128 + 64 + lane] = 0.f; }
    LDS_WAIT();
    {
        f32x2 m_x; v4u bufA[16], bufB[16], xqA, xqB; float xiA, xiB;
        FU_META(0); FU_ISSUE(bufA, xqA, xiA, 0, 0); FU_META(1);
#pragma unroll 1
        for (int it = 0; it < 64; it += 2) {
            FU_ISSUE(bufB, xqB, xiB, 1, it + 1);
            if (it + 2 < 64) FU_META(it + 2);
            FU_COMPUTE(bufA, xqA, xiA, it);
            if (it + 2 < 64) FU_ISSUE(bufA, xqA, xiA, 0, it + 2);
            if (it + 3 < 64) FU_META(it + 3);
            FU_COMPUTE(bufB, xqB, xiB, it + 1);
        }
        LDS_WAIT();
    }
    {
        v2u r_lo[8], r_hi[8];
#pragma unroll
        for (int t = 0; t < 8; ++t) { const int tok = tokb + tjs * t;
            const char* rb_ = (const char*)route + (size_t)tok * 1024; r_lo[t] = *(const GAS v2u*)(rb_ + l8); r_hi[t] = *(const GAS v2u*)(rb_ + 512 + l8); }
        float su[8][2], sv[8][2];
#pragma unroll
        for (int t = 0; t < 8; ++t) { su[t][0] = SU[(int)r_lo[t].x]; su[t][1] = SU[(int)r_hi[t].x]; sv[t][0] = SV[(int)r_lo[t].x]; sv[t][1] = SV[(int)r_hi[t].x]; }
#pragma unroll
        for (int t = 0; t < 8; ++t) {
            const float rstd2 = tks[16 + t];
            float g_lo, g_hi;
#pragma unroll
            for (int half = 0; half < 2; ++half) {
                const float sc_ = __builtin_bit_cast(float, half ? r_hi[t].y : r_lo[t].y) * rstd2; float m_ = sc_;
#pragma unroll
                for (int o = 1; o < 16; o <<= 1) m_ = __builtin_fmaxf(m_, __shfl_xor(m_, o));
                const float p_ = __builtin_amdgcn_exp2f((sc_ - m_) * 1.4426950408889634f); float sum_ = p_;
#pragma unroll
                for (int o = 1; o < 16; o <<= 1) sum_ += __shfl_xor(sum_, o);
                if (half) g_hi = p_ / sum_; else g_lo = p_ / sum_;
            }
            asm volatile("" : "+v"(g_lo), "+v"(g_hi));
            LAS float* up_ = uw + t * 128 + lane;
            const float d0 = up_[0], d1 = up_[64];
            up_[0] = g_lo * gelu_exact(d0 * su[t][0] * rstd2) * sv[t][0]; up_[64] = g_hi * gelu_exact(d1 * su[t][1] * rstd2) * sv[t][1];
        }
        LDS_WAIT();
    }
    {
        unsigned m_xv; v4u bufA[16], bufB[16]; float wA[16], wB[16]; unsigned xvA, xvB;
        FV_META(0); FV_ISSUE(bufA, wA, xvA, 0); FV_META(1);
#pragma unroll 1
        for (int it = 0; it < 64; it += 2) {
            FV_ISSUE(bufB, wB, xvB, it + 1);
            if (it + 2 < 64) FV_META(it + 2);
            FV_COMPUTE(bufA, wA, xvA, it);
            if (it + 2 < 64) FV_ISSUE(bufA, wA, xvA, it + 2);
            if (it + 3 < 64) FV_META(it + 3);
            FV_COMPUTE(bufB, wB, xvB, it + 1);
        }
        LDS_WAIT();
    }
    asm volatile("s_waitcnt vmcnt(0)" ::: "memory");
#pragma unroll 1
    for (int jb = 0; jb < 8; jb += 4) {
        f32x4 v[4][4];
#pragma unroll
        for (int t = 0; t < 4; ++t) { const GAS f32x4* op = (const GAS f32x4*)(xio + (size_t)(tokb + tjs * (jb + t)) * D) + lane;
#pragma unroll
            for (int j = 0; j < 4; ++j) v[t][j] = op[64 * j]; }
#pragma unroll
        for (int t = 0; t < 4; ++t) { float s2 = 0.f;
#pragma unroll
            for (int j = 0; j < 4; ++j) s2 += (v[t][j].x * v[t][j].x + v[t][j].y * v[t][j].y) + (v[t][j].z * v[t][j].z + v[t][j].w * v[t][j].w);
            const float rstd3 = 1.0f / sqrtf(wave_sum(s2) * (1.0f / D) + RMS_EPS);
            GAS f32x4* op = (GAS f32x4*)(xio + (size_t)(tokb + tjs * (jb + t)) * D) + lane; const GAS f32x4* gp = (const GAS f32x4*)gain + lane;
#pragma unroll
            for (int j = 0; j < 4; ++j) { const f32x4 g = gp[64 * j]; f32x4 o; o.x = v[t][j].x * rstd3 * g.x; o.y = v[t][j].y * rstd3 * g.y; o.z = v[t][j].z * rstd3 * g.z; o.w = v[t][j].w * rstd3 * g.w; op[64 * j] = o; } }
    }
}

__device__ __forceinline__ void peer_u_debug(int tok, const v2u* route, const float* x1, const unsigned char* TU8s, const float* SU, const float* SV, float* W, int lane) {
    float xr[16], ssq = 0.f;
    { const GAS f32x4* xp = (const GAS f32x4*)(x1 + (size_t)tok * D + 16 * lane);
#pragma unroll
      for (int j = 0; j < 4; ++j) { const f32x4 a = xp[j]; xr[4 * j] = a.x; xr[4 * j + 1] = a.y; xr[4 * j + 2] = a.z; xr[4 * j + 3] = a.w; } }
#pragma unroll
    for (int i = 0; i < 16; ++i) ssq += xr[i] * xr[i];
    const float rstd2 = 1.0f / sqrtf(wave_sum(ssq) * (1.0f / D) + RMS_EPS);
    const char* rb_ = (const char*)route + (size_t)tok * 1024; const int s = lane >> 3, c = lane & 7;
#pragma unroll 1
    for (int h = 0; h < 8; ++h) {
        float sc[16]; int id[16]; float m = -3e38f;
#pragma unroll
        for (int i = 0; i < 16; ++i) { const v2u r = *(const GAS v2u*)(rb_ + (h * 16 + i) * 8 + opaque_zero()); id[i] = (int)r.x; sc[i] = __builtin_bit_cast(float, r.y) * rstd2; m = __builtin_fmaxf(m, sc[i]); }
        float sum = 0.f;
#pragma unroll
        for (int i = 0; i < 16; ++i) { sc[i] = __builtin_amdgcn_exp2f((sc[i] - m) * 1.4426950408889634f); sum += sc[i]; }
#pragma unroll
        for (int i = 0; i < 16; ++i) { const int e = id[i];
            const v4u q = *(const GAS v4u*)(TU8s + ((size_t)s * NEXP + e) * 128 + 16 * c);
            float d; fp8_row_dot(q, xr, d); d = wave_sum(d);
            const float act = gelu_exact(d * SU[e] * rstd2);
            if (lane == 0) W[(size_t)tok * 128 + h * 16 + i] = (sc[i] / sum) * act * SV[e]; }
    }
}
__device__ __forceinline__ void peer_v_debug(int tok, const v2u* route, const float* W, const unsigned char* TV8s, float* xio, float* SS, int lane) {
    const char* rb_ = (const char*)route + (size_t)tok * 1024;
    float acc[16];
#pragma unroll
    for (int i = 0; i < 16; ++i) acc[i] = 0.f;
    const int s = lane >> 3, c = lane & 7;
#pragma unroll 1
    for (int n = 0; n < 128; ++n) {
        const int e = *(const GAS int*)(rb_ + n * 8 + opaque_zero()); const float w = W[(size_t)tok * 128 + n + opaque_zero()];
        const v4u q = *(const GAS v4u*)(TV8s + ((size_t)s * NEXP + e) * 128 + 16 * c);
        fp8_row_axpy(q, w, acc);
    }
    float ssq = 0.f;
    GAS float* xp = (GAS float*)(xio + (size_t)tok * D + 16 * lane);
#pragma unroll
    for (int i = 0; i < 16; ++i) { const float o = xp[i] + acc[i]; xp[i] = o; ssq += o * o; }
    ssq = wave_sum(ssq);
    if (lane < 8) SS[(size_t)lane * M + tok] = (lane == 0) ? ssq : 0.f;
}
#ifndef DUP_MASK
#define DUP_MASK 0
#endif
#define NREP(k) (1 + ((DUP_MASK >> (k)) & 1))
struct Args { const float* in[14]; float* out; unsigned char* ws; int ph_lo, ph_hi, li, pad; };
__global__ void __launch_bounds__(NWAVES * 64, 2) hybrid_fwd(Args args) {
    extern __shared__ __attribute__((aligned(16))) unsigned char lds[];
    LAS unsigned char* ldsb = (LAS unsigned char*)lds;
    volatile LAS unsigned* MISC = (volatile LAS unsigned*)(ldsb + MISC_OFF);
    const int tid = threadIdx.x, lane = tid & 63, wave = __builtin_amdgcn_readfirstlane(tid >> 6);
    const int G = gridDim.x; const int bx = blockIdx.x; const int vcu = (G % 8 == 0) ? (bx % 8) * (G / 8) + bx / 8 : bx;
    const int gw = vcu * NWAVES + wave, NGW = G * NWAVES;
    unsigned char* ws = args.ws;
    gu32* ctl = (gu32*)(ws + WS_CTL);
    const float* x = args.in[0]; float* out = args.out;
#define norm_mix (args.in[1])
#define w_in (args.in[2])
#define conv_w (args.in[3])
#define conv_b (args.in[4])
#define w_a (args.in[5])
#define w_b (args.in[6])
#define w_o (args.in[7])
#define norm_ffn (args.in[8])
#define w_q (args.in[9])
#define sub_keys (args.in[10])
#define exp_u (args.in[11])
#define exp_v (args.in[12])
#define final_norm (args.in[13])
#define Weff ((bf16*)((bf16*)(ws + WS_WEFF)))
#define Wab ((bf16*)((bf16*)(ws + WS_WAB)))
#define Wo_t ((bf16*)((bf16*)(ws + WS_WO)))
#define Win_t ((bf16*)((bf16*)(ws + WS_WIN)))
#define XB ((bf16*)((bf16*)(ws + WS_XB)))
#define SIX ((bf16*)((bf16*)(ws + WS_SIX)))
#define VT ((bf16*)((bf16*)(ws + WS_VT)))
#define GATE ((bf16*)((bf16*)(ws + WS_GATE)))
#define MERGED ((bf16*)((bf16*)(ws + WS_MERGED)))
#define X1B ((bf16*)((bf16*)(ws + WS_X1B)))
#define TU8 ((unsigned char*)(ws + WS_TU))
#define TV8 ((unsigned char*)(ws + WS_TV))
#define SU ((float*)((float*)(ws + WS_SU)))
#define SV ((float*)((float*)(ws + WS_SV)))
#define SCORES ((float*)((float*)(ws + WS_SCORES)))
#define ROUTE ((v2u*)((v2u*)(ws + WS_ROUTE)))
#define WBUF ((float*)((float*)(ws + WS_W)))
#define SSB ((float*)((float*)(ws + WS_SS)))
#define UPART ((float*)((float*)(ws + WS_UPART)))
#define RSTD1 ((float*)((float*)(ws + WS_RSTD1)))
#define QB ((bf16*)(SIX))
#define CBB ((bf16*)(SIX + (size_t)1 * M * 512))
#define KB ((bf16*)(SIX + (size_t)2 * M * 512))
#define CCB ((bf16*)(SIX + (size_t)4 * M * 512))
#define CUB ((bf16*)(SIX + (size_t)5 * M * 512))
    for (int u = tid; u < (LDS_BYTES - LDSCTL_OFF) / 4; u += NWAVES * 64) ((LAS unsigned*)(ldsb + LDSCTL_OFF))[u] = 0u;
    __syncthreads();
    XcdBarrier bar; bar.bar = (unsigned*)(ctl + CW_BAR); bar.x = 0; bar.st = nullptr;
    if (N_LAUNCHES == 1) bar = xcd_barrier_post((unsigned*)(ctl + CW_BAR), MISC + 8);
#define GRID_BAR() do { if (N_LAUNCHES == 1) xcd_barrier(bar); } while (0)
#ifdef TPROBE
    unsigned long long t_s = 0, t_e = 0;
#define TSTAMP(k) do { if ((k) == TPROBE) t_s = __builtin_amdgcn_s_memrealtime(); if ((k) == TPROBE_END) t_e = __builtin_amdgcn_s_memrealtime(); } while (0)
#ifndef TPROBE_TID
#define TPROBE_TID 0
#endif
#define TSTALL() do { if (bx == 0 && tid == TPROBE_TID) { const unsigned long long t0_ = __builtin_amdgcn_s_memrealtime(), dt_ = (t_e - t_s) * 8ull; while (__builtin_amdgcn_s_memrealtime() - t0_ < dt_) __builtin_amdgcn_s_sleep(4); } } while (0)
#else
#define TSTAMP(k) do { } while (0)
#define TSTALL() do { } while (0)
#endif
    const int lo = args.ph_lo, hi = args.ph_hi;
#define IN(k) (lo <= (k) && (k) < hi)
#define BOTH(k) (IN(k) && IN((k) + 1))

    TSTAMP(0);
    if (IN(0)) { for (int rep = 0; rep < NREP(0); ++rep) {
        LAS float* scr = (LAS float*)(ldsb + RING_OFF + wave * 17408);
        constexpr int I_IN = (D / 64) * (NIN / 32), I_A = (512 / 64) * (D / 32), I_O = (D / 64) * (D / 32);
        constexpr int NITEMS = I_IN + 2 * I_A + I_O;
        constexpr int ABW = 3; const int aw = vcu * ABW + wave, NAW = G * ABW, cw = vcu * (NWAVES - ABW) + (wave - ABW), NCW = G * (NWAVES - ABW);
        if (wave < ABW) {
        for (int it = aw; it < NITEMS; it += NAW) {
            int r = it;
            if (r < I_IN) { p0_transpose_item(w_in, D, NIN, Win_t, 0, norm_mix, scr, r, lane); continue; } r -= I_IN;
            if (r < I_A) { p0_transpose_item(w_a, 512, D, Wab, 0, nullptr, scr, r, lane); continue; } r -= I_A;
            if (r < I_A) { p0_transpose_item(w_b, 512, D, Wab, 1024, nullptr, scr, r, lane); continue; } r -= I_A;
            p0_transpose_item(w_o, D, D, Wo_t, 0, nullptr, scr, r, lane);
        }
        TSTAMP(20);
        for (int wt = aw; wt < 64 * 32; wt += NAW) {
            const int nt = wt & 63, kt = wt >> 6, hp = nt >> 2, h = lane >> 5, l32 = lane & 31;
            f32x4 av[16], bv[16];
            { f32x4 t[16];
#pragma unroll
              for (int i = 0; i < 16; ++i) t[i] = *(const GAS f32x4*)(w_q + (size_t)(kt * 32 + 2 * i + (lane >> 5)) * 2048 + hp * 128 + 4 * (lane & 31));
#pragma unroll
              for (int i = 0; i < 16; ++i) *(LAS f32x4*)(scr + (2 * i + (lane >> 5)) * 132 + 4 * (lane & 31)) = t[i];
              LDS_WAIT();
#pragma unroll
              for (int i = 0; i < 16; ++i) av[i] = *(const LAS f32x4*)(scr + l32 * 132 + 64 * h + 4 * i);
              LDS_WAIT();
#pragma unroll
              for (int i = 0; i < 16; ++i) t[i] = *(const GAS f32x4*)(sub_keys + (size_t)(nt * 32) * 128 + 4 * (i * 64 + lane));
#pragma unroll
              for (int i = 0; i < 16; ++i) *(LAS f32x4*)(scr + (2 * i + (lane >> 5)) * 132 + 4 * (lane & 31)) = t[i];
              LDS_WAIT();
#pragma unroll
              for (int i = 0; i < 16; ++i) bv[i] = *(const LAS f32x4*)(scr + l32 * 132 + 64 * h + 4 * i);
              LDS_WAIT(); }
            f32x16 acc;
#pragma unroll
            for (int i = 0; i < 16; ++i) acc[i] = 0.f;
#pragma unroll
            for (int i = 0; i < 16; ++i) {
                acc = __builtin_amdgcn_mfma_f32_32x32x2f32(av[i].x, bv[i].x, acc, 0, 0, 0); acc = __builtin_amdgcn_mfma_f32_32x32x2f32(av[i].y, bv[i].y, acc, 0, 0, 0);
                acc = __builtin_amdgcn_mfma_f32_32x32x2f32(av[i].z, bv[i].z, acc, 0, 0, 0); acc = __builtin_amdgcn_mfma_f32_32x32x2f32(av[i].w, bv[i].w, acc, 0, 0, 0); }
            const int n = nt * 32 + l32;
#pragma unroll
            for (int rq = 0; rq < 4; ++rq) { const int kb = kt * 32 + 8 * rq + 4 * h; const f32x4 g = *(const GAS f32x4*)(norm_ffn + kb);
                v2u o; o.x = pk2(acc[4 * rq] * g.x, acc[4 * rq + 1] * g.y); o.y = pk2(acc[4 * rq + 2] * g.z, acc[4 * rq + 3] * g.w);
                *(GAS v2u*)(Weff + (size_t)n * D + kb) = o; }
        }
        TSTAMP(21);
        } else {
        for (int m0 = cw; m0 < M; m0 += 4 * NCW) {
            f32x4 v[4][4]; float s[4];
#pragma unroll
            for (int q = 0; q < 4; ++q) { const int m = m0 + q * NCW; const GAS f32x4* xr = (const GAS f32x4*)(x + (size_t)(m < M ? m : m0) * D) + lane;
#pragma unroll
                for (int j = 0; j < 4; ++j) v[q][j] = __builtin_nontemporal_load(xr + 64 * j); }
#pragma unroll
            for (int q = 0; q < 4; ++q) { s[q] = 0.f;
#pragma unroll
                for (int j = 0; j < 4; ++j) s[q] += (v[q][j].x * v[q][j].x + v[q][j].y * v[q][j].y) + (v[q][j].z * v[q][j].z + v[q][j].w * v[q][j].w); }
#pragma unroll
            for (int o = 1; o < 64; o <<= 1) {
#pragma unroll
                for (int q = 0; q < 4; ++q) s[q] += __shfl_xor(s[q], o); }
#pragma unroll
            for (int q = 0; q < 4; ++q) { const int m = m0 + q * NCW; if (m < M) {
                const float rstd = 1.0f / sqrtf(s[q] * (1.0f / D) + RMS_EPS);
                GAS v2u* o8 = (GAS v2u*)(XB + (size_t)m * D) + lane;
#pragma unroll
                for (int j = 0; j < 4; ++j) { v2u o; o.x = pk2(v[q][j].x, v[q][j].y); o.y = pk2(v[q][j].z, v[q][j].w); o8[64 * j] = o; }
                if (lane == 0) RSTD1[m] = rstd; } }
        }
        TSTAMP(22);
        for (int e0 = cw; e0 < NEXP; e0 += 2 * NCW) {
            float v[4][16]; float am[4]; int ee[4];
#pragma unroll
            for (int q = 0; q < 4; ++q) { const int e = e0 + (q >> 1) * NCW; ee[q] = e < NEXP ? e : e0; const float* src = ((q & 1) ? exp_v : exp_u) + (size_t)ee[q] * D; const GAS f32x4* sp = (const GAS f32x4*)src;
#pragma unroll
                for (int j = 0; j < 2; ++j) { const f32x4 a = __builtin_nontemporal_load(sp + 2 * lane + 128 * j), b = __builtin_nontemporal_load(sp + 2 * lane + 128 * j + 1);
                    v[q][8 * j + 0] = a.x; v[q][8 * j + 1] = a.y; v[q][8 * j + 2] = a.z; v[q][8 * j + 3] = a.w; v[q][8 * j + 4] = b.x; v[q][8 * j + 5] = b.y; v[q][8 * j + 6] = b.z; v[q][8 * j + 7] = b.w; } }
            { const GAS f32x4* gp = (const GAS f32x4*)norm_ffn;
#pragma unroll
              for (int j = 0; j < 2; ++j) { const f32x4 ga = gp[2 * lane + 128 * j], gb = gp[2 * lane + 128 * j + 1];
#pragma unroll
                for (int q = 0; q < 4; q += 2) { v[q][8 * j + 0] *= ga.x; v[q][8 * j + 1] *= ga.y; v[q][8 * j + 2] *= ga.z; v[q][8 * j + 3] *= ga.w; v[q][8 * j + 4] *= gb.x; v[q][8 * j + 5] *= gb.y; v[q][8 * j + 6] *= gb.z; v[q][8 * j + 7] *= gb.w; } } }
#pragma unroll
            for (int q = 0; q < 4; ++q) { am[q] = 0.f;
#pragma unroll
                for (int i = 0; i < 16; ++i) am[q] = __builtin_fmaxf(am[q], __builtin_fabsf(v[q][i])); }
#pragma unroll
            for (int o = 1; o < 64; o <<= 1) {
#pragma unroll
                for (int q = 0; q < 4; ++q) am[q] = __builtin_fmaxf(am[q], __shfl_xor(am[q], o)); }
#pragma unroll
            for (int q = 0; q < 4; ++q) { const int e = e0 + (q >> 1) * NCW; if (e < NEXP) {
                const float top = (q & 1) ? 384.0f : 127.0f;
                const float sc = (am[q] > 0.f) ? top / am[q] : 1.0f, inv = (am[q] > 0.f) ? am[q] * (1.0f / top) : 1.0f;
                v2u q0, q1;
                if (q & 1) {
                { int w = __builtin_amdgcn_cvt_pk_fp8_f32(v[q][0] * sc, v[q][1] * sc, 0, false); w = __builtin_amdgcn_cvt_pk_fp8_f32(v[q][2] * sc, v[q][3] * sc, w, true); q0.x = (unsigned)w; }
                { int w = __builtin_amdgcn_cvt_pk_fp8_f32(v[q][4] * sc, v[q][5] * sc, 0, false); w = __builtin_amdgcn_cvt_pk_fp8_f32(v[q][6] * sc, v[q][7] * sc, w, true); q0.y = (unsigned)w; }
                { int w = __builtin_amdgcn_cvt_pk_fp8_f32(v[q][8] * sc, v[q][9] * sc, 0, false); w = __builtin_amdgcn_cvt_pk_fp8_f32(v[q][10] * sc, v[q][11] * sc, w, true); q1.x = (unsigned)w; }
                { int w = __builtin_amdgcn_cvt_pk_fp8_f32(v[q][12] * sc, v[q][13] * sc, 0, false); w = __builtin_amdgcn_cvt_pk_fp8_f32(v[q][14] * sc, v[q][15] * sc, w, true); q1.y = (unsigned)w; }
                } else {
                    unsigned w4[4];
#pragma unroll
                    for (int j = 0; j < 4; ++j) { const int i0 = (int)__builtin_rintf(v[q][4 * j] * sc), i1 = (int)__builtin_rintf(v[q][4 * j + 1] * sc), i2 = (int)__builtin_rintf(v[q][4 * j + 2] * sc), i3 = (int)__builtin_rintf(v[q][4 * j + 3] * sc);
                        w4[j] = ((unsigned)i0 & 255u) | (((unsigned)i1 & 255u) << 8) | (((unsigned)i2 & 255u) << 16) | ((unsigned)i3 << 24); }
                    q0.x = w4[0]; q0.y = w4[1]; q1.x = w4[2]; q1.y = w4[3];
                }
                unsigned char* dst = (q & 1) ? TV8 : TU8; const int s0 = lane >> 4, o8 = 8 * (lane & 15);
                *(GAS v2u*)(dst + ((size_t)s0 * NEXP + e) * 128 + o8) = q0; *(GAS v2u*)(dst + ((size_t)(s0 + 4) * NEXP + e) * 128 + o8) = q1;
                if (lane == 0) ((q & 1) ? SV : SU)[e] = inv; } }
        }
                TSTAMP(23);
        }
}
        if (BOTH(0)) GRID_BAR();
    }

    TSTAMP(1);
    if (IN(1)) { for (int rep = 0; rep < NREP(1); ++rep) { if (rep) GRID_BAR();
        pg8::Gemm g{XB, Win_t, M, NIN, D}; pg8::StaticOrder S; S.init(M, NIN, G, (int)blockIdx.x);
        pg8::EpiProj E{SIX, VT, GATE, RSTD1, (DUP_MASK & 64) ? rep : 0};
        pg8::gemm_phase<pg8::EpiProj, pg8::StaticOrder, true, true>(ldsb + RING_OFF, g, S, E); }
        if (DUP_MASK & 128) { const unsigned long long t0 = __builtin_amdgcn_s_memrealtime(); while (__builtin_amdgcn_s_memrealtime() - t0 < 15000ull) __builtin_amdgcn_s_sleep(8); }
        if (BOTH(1)) GRID_BAR();
    }

    TSTAMP(2);
    if (IN(2)) {
        for (int rep = 0; rep < NREP(2); ++rep) {
        const bool dummy = (rep + 1 < NREP(2));
        conv_phase(CBB, CCB, CUB, dummy ? XB : CBB, conv_w, conv_b, gw * 64 + lane, NGW * 64);
        TSTAMP(24);
        for (int it = gw; it < BATCH * NH * (T / 32); it += NGW) {
            const int bh = it >> 7, qblk = it & 127;
            attn_item(QB, KB, VT, dummy ? MERGED : QB, bh >> 3, bh & 7, qblk, ldsb + RING_OFF + wave * 9216, lane);
        }
        }
        if (BOTH(2)) GRID_BAR();
    }

    TSTAMP(3);
    if (IN(3)) { for (int rep = 0; rep < NREP(3); ++rep) { if (rep) GRID_BAR();
        pg8::Gemm g{QB, Wab, 2 * M, 2048, 512}; pg8::PairOrder S; S.init(G, (int)blockIdx.x);
        pg8::EpiGate E{out, MERGED, GATE, GATE + (size_t)M * 1024};
        pg8::gemm_phase<pg8::EpiGate, pg8::PairOrder, true, true>(ldsb + RING_OFF, g, S, E); }
        if (BOTH(3)) GRID_BAR();
    }

    TSTAMP(4);
    if (IN(4)) { for (int rep = 0; rep < NREP(4); ++rep) { if (rep) GRID_BAR();
        pg8::Gemm g{MERGED, Wo_t, M, D, D}; pg8::StaticOrder S; S.init(M, D, G, (int)blockIdx.x);
        pg8::EpiWo E{x, X1B};
        pg8::gemm_phase<pg8::EpiWo, pg8::StaticOrder, false, true>(ldsb + RING_OFF, g, S, E);
        }
        if (BOTH(4)) GRID_BAR();
    }

    TSTAMP(5);
    if (IN(5)) { for (int rep = 0; rep < NREP(5); ++rep) { if (rep) GRID_BAR();
        pg8::Gemm g{X1B, Weff, M, 2048, D}; pg8::StaticOrder S; S.init(M, 2048, G, (int)blockIdx.x);
        pg8::EpiScores E{(unsigned short*)SCORES};
        pg8::gemm_phase<pg8::EpiScores, pg8::StaticOrder, true, true>(ldsb + RING_OFF, g, S, E);
        asm volatile("s_waitcnt vmcnt(0)" ::: "memory"); __syncthreads();
        int nu = 0; { pg8::Unit u; while (S.next(nu, u)) ++nu; }
        LAS unsigned char* scr = ldsb + RING_OFF + wave * 8192;
        for (int t = wave; t < nu * 4; t += NWAVES) { pg8::Unit u; S.next(t >> 2, u); route_task((const unsigned short*)SCORES, ROUTE, u.pm * 256 + (t & 3) * 64, u.pn, scr, lane); } }
        if (BOTH(5)) GRID_BAR();
    }
    const bool sliced_ok = (G % 8 == 0) && (M % ((G / 8) * NWAVES) == 0);
    const bool fused_ok = (G % 8 == 0) && (M == G * NWAVES * 8);

    TSTAMP(7);
    if (IN(7)) {
        LAS unsigned char* scr = ldsb + RING_OFF + wave * 8192;
#ifdef DEBUG_U
        if (1) {} else
#endif
        if (fused_ok) peer_fused(bx & 7, (bx & 7) + 8 * ((bx >> 3) * NWAVES + wave), M / 8, ROUTE, X1B, TU8, TV8, SU, SV, final_norm, out, ldsb + RING_OFF + wave * 16384, lane);
        else if (sliced_ok) { const int nj = G >> 3; peer_u_phase_dot4(bx & 7, (bx >> 3) * NWAVES + wave, nj * NWAVES, M / (nj * NWAVES), ROUTE, (const float*)X1B, TU8, UPART, scr, lane); }
        else for (int s8 = 0; s8 < 8; ++s8) { const int nt = (M - 1 - gw) / NGW + 1; if (gw < M) peer_u_phase_dot4(s8, gw, NGW, nt, ROUTE, (const float*)X1B, TU8, UPART, scr, lane); }
        if (BOTH(7) && !fused_ok) GRID_BAR();
    }

    TSTAMP(8);
    if (IN(8) && !fused_ok) {
#ifdef DEBUG_U
        for (int tok = gw; tok < M; tok += NGW) peer_u_debug(tok, ROUTE, out, TU8, SU, SV, WBUF, lane);
#else
        for (int tok = gw; tok < M; tok += 2 * NGW) peer_w_token2(tok, (tok + NGW < M) ? tok + NGW : tok, ROUTE, X1B, (const bf16*)UPART, SU, SV, WBUF, lane);
#endif
        if (BOTH(8)) GRID_BAR();
    }

    TSTAMP(9);
    if (IN(9) && !fused_ok) {
        LAS unsigned char* scr = ldsb + RING_OFF + wave * 8192;
#ifdef DEBUG_V
        for (int tok = gw; tok < M; tok += NGW) peer_v_debug(tok, ROUTE, WBUF, TV8, out, SSB, lane);
        if (0)
#endif
        if (sliced_ok) { const int nj = G >> 3; peer_v_phase(bx & 7, (bx >> 3) * NWAVES + wave, nj * NWAVES, M / (nj * NWAVES), ROUTE, WBUF, TV8, X1B, out, SSB, scr, lane); }
        else for (int s8 = 0; s8 < 8; ++s8) { const int nt = (M - 1 - gw) / NGW + 1; if (gw < M) peer_v_phase(s8, gw, NGW, nt, ROUTE, WBUF, TV8, X1B, out, SSB, scr, lane); }
        if (BOTH(9)) GRID_BAR();
    }

    TSTAMP(10);
    if (IN(10) && !fused_ok) {
        for (int tok = gw; tok < M; tok += NGW) {
            GAS f32x4* op = (GAS f32x4*)(out + (size_t)tok * D) + lane; const GAS f32x4* gp = (const GAS f32x4*)final_norm + lane;
            f32x4 v[4]; float s2 = 0.f;
#pragma unroll
            for (int j = 0; j < 4; ++j) { v[j] = op[64 * j]; s2 += (v[j].x * v[j].x + v[j].y * v[j].y) + (v[j].z * v[j].z + v[j].w * v[j].w); }
            const float rstd3 = 1.0f / sqrtf(wave_sum(s2) * (1.0f / D) + RMS_EPS);
#pragma unroll
            for (int j = 0; j < 4; ++j) { const f32x4 g = gp[64 * j]; f32x4 o; o.x = v[j].x * rstd3 * g.x; o.y = v[j].y * rstd3 * g.y; o.z = v[j].z * rstd3 * g.z; o.w = v[j].w * rstd3 * g.w; op[64 * j] = o; }
        }
    }
    TSTAMP(11);
    TSTALL();
#undef IN
#undef BOTH
#undef GRID_BAR
#undef norm_mix
#undef w_in
#undef conv_w
#undef conv_b
#undef w_a
#undef w_b
#undef w_o
#undef norm_ffn
#undef w_q
#undef sub_keys
#undef exp_u
#undef exp_v
#undef final_norm
#undef Weff
#undef Wab
#undef Wo_t
#undef Win_t
#undef XB
#undef SIX
#undef VT
#undef GATE
#undef MERGED
#undef X1B
#undef TU8
#undef TV8
#undef SU
#undef SV
#undef SCORES
#undef ROUTE
#undef WBUF
#undef SSB
#undef UPART
#undef RSTD1
#undef QB
#undef CBB
#undef KB
#undef CCB
#undef CUB
}

extern "C" void kernel_launch(void* const* d_in, const int* in_sizes, int n_in, void* d_out, int out_size, void* d_ws, size_t ws_size, hipStream_t stream) {
    static int grid = 0;
    if (grid == 0) {
        if (n_in != 14 || in_sizes[0] != M * D || out_size != M * D || ws_size < WS_END) { fprintf(stderr, "kernel_launch: built for 14 inputs, x/out of %d floats, >= %zu bytes of workspace; got n_in %d, in0 %d, out %d, ws %zu; nothing launched\n", M * D, (size_t)WS_END, n_in, n_in > 0 ? in_sizes[0] : -1, out_size, ws_size); grid = -1; return; }
        int dev = 0, cus = 0, per_cu = 0;
        if (hipGetDevice(&dev) != hipSuccess || hipDeviceGetAttribute(&cus, hipDeviceAttributeMultiprocessorCount, dev) != hipSuccess) { fprintf(stderr, "kernel_launch: device query failed\n"); grid = -1; return; }
        if (hipFuncSetAttribute((const void*)hybrid_fwd, hipFuncAttributeMaxDynamicSharedMemorySize, LDS_BYTES) != hipSuccess) { fprintf(stderr, "kernel_launch: hipFuncSetAttribute failed\n"); grid = -1; return; }
        if (hipOccupancyMaxActiveBlocksPerMultiprocessor(&per_cu, (const void*)hybrid_fwd, NWAVES * 64, LDS_BYTES) != hipSuccess || per_cu < 1) { fprintf(stderr, "kernel_launch: occupancy query reports %d workgroups per CU\n", per_cu); per_cu = 1; }
        (void)hipGetLastError();
        grid = cus;
    }
    if (grid < 0) return;
    if (hipMemsetAsync((char*)d_ws + WS_CTL, 0, CTL_ZERO_BYTES, stream) != hipSuccess) { fprintf(stderr, "kernel_launch: hipMemsetAsync failed\n"); return; }
    Args a{};
    for (int i = 0; i < 14; ++i) a.in[i] = (const float*)d_in[i];
    a.out = (float*)d_out; a.ws = (unsigned char*)d_ws;
#ifdef PROBE_SEQ
    const int seq[] = PROBE_SEQ; const int nseq = (int)(sizeof(seq) / sizeof(int));
#else
    const int seq[] = {0, 1, 2, 3, 4, 5, 6, 7, 8, 9, 10}; const int nseq = (N_LAUNCHES == 1) ? 1 : 11;
#endif
    for (int li = 0; li < nseq; ++li) {
        a.ph_lo = (N_LAUNCHES == 1) ? 0 : seq[li]; a.ph_hi = (N_LAUNCHES == 1) ? N_PHASES : seq[li] + 1; a.li = li;
        hipLaunchKernelGGL(hybrid_fwd, dim3(grid), dim3(NWAVES * 64), LDS_BYTES, stream, a);
        const hipError_t le = hipPeekAtLastError();
        if (le != hipSuccess) { fprintf(stderr, "kernel_launch: launch %d failed: %s\n", li, hipGetErrorName(le)); break; }
    }
}
```

```cpp
#define DUP_MASK 0
#include <hip/hip_runtime.h>
#include <cstdio>
#include <cstdint>
#include <cmath>
namespace pg8 {
#define PG8_LAS __attribute__((address_space(3)))
typedef unsigned short bf16_t;
typedef short bf16x8 __attribute__((ext_vector_type(8)));
typedef float f32x4 __attribute__((ext_vector_type(4)));
typedef unsigned u32x4 __attribute__((ext_vector_type(4)));
constexpr int BM = 256, BK = 64, HALF = 128, HTB = HALF * BK * 2  , STAGE_BYTES = 8 * HTB, NXCD = 8, WGM = 8;

__host__ __device__ __forceinline__ int lds_byte(int r, int c) { const int st = (r >> 4) * 2 + (c >> 5), rr = r & 15, cc = c & 31, ob = rr * 64 + cc * 2; return st * 1024 + (ob ^ (((ob >> 9) & 1) << 5)); }
__host__ __device__ __forceinline__ void stage_rc(int b, int& R, int& C) { const int st = b / 1024, sb = b % 1024, swz = sb ^ (((sb >> 9) & 1) << 5); R = (st >> 1) * 16 + swz / 64; C = (st & 1) * 32 + (swz % 64) / 2; }
__host__ __device__ __forceinline__ int perm32(int rho) { const int n = rho >> 4, i = rho & 15; return 8 * (i >> 2) + 4 * n + (i & 3); }

struct Unit { int pm, pn; };
struct Gemm { const bf16_t* A; const bf16_t* Bt; int M, N, K; };

struct StaticOrder {
    int nM, nN, nwg, G, c;
    __host__ __device__ void init(int M, int N, int G_, int c_) { nM = M / BM; nN = N / BM; nwg = nM * nN; G = G_; c = c_; }
    __host__ __device__ bool next(int i, Unit& u) const {
        const long L = (long)i * G + c; if (L >= nwg) return false;
        int wgid = (int)L; { const int q = nwg / NXCD, r = nwg % NXCD, xcd = wgid % NXCD, off = wgid / NXCD; wgid = (xcd < r ? xcd * (q + 1) : r * (q + 1) + (xcd - r) * q) + off; }
        const int nig = WGM * nN, gid = wgid / nig, fm = gid * WGM, gsz = (nM - fm) < WGM ? (nM - fm) : WGM;
        u.pm = fm + ((wgid % nig) % gsz); u.pn = (wgid % nig) / gsz; return true;
    }
    __device__ __forceinline__ void a_ready(const Unit&) const {}
    __device__ __forceinline__ void done(const Unit&) const {}
};

__device__ __forceinline__ unsigned cvt_pk_bf16(float lo, float hi) { unsigned r; asm volatile("v_cvt_pk_bf16_f32 %0, %1, %2" : "=v"(r) : "v"(lo), "v"(hi)); return r; }
constexpr int MTOK = 16384;
__device__ __forceinline__ unsigned f2bf_rne(float f) { unsigned u = __builtin_bit_cast(unsigned, f); return (u + 0x7fffu + ((u >> 16) & 1u)) >> 16; }
__device__ __forceinline__ float bf_lo(unsigned w) { return __builtin_bit_cast(float, w << 16); }
__device__ __forceinline__ float bf_hi(unsigned w) { return __builtin_bit_cast(float, w & 0xffff0000u); }
__device__ __forceinline__ float sigmoid_fast(float x) { return __builtin_amdgcn_rcpf(1.0f + __builtin_amdgcn_exp2f(-1.4426950408889634f * x)); }

struct EpiProj {
    static constexpr bool PERM = true, AFTER_DRAIN = false;
    bf16_t* six;
    bf16_t* vt;
    bf16_t* gate;
    const float* rstd; int skip;
    __device__ __forceinline__ void operator()(const f32x4 (&acc)[2][2][4][2], const Unit& u, int wr, int wc, int fr, int fq) const {
        const int row0 = u.pm * BM + wr * 64 + fr; const int colt = u.pn * BM;
        if (skip) return;
        if (colt < 3072) {
            const int t = colt >> 9, cc = colt & 511;
            if (t == 2) {
#pragma unroll
                for (int ai = 0; ai < 2; ++ai)
#pragma unroll
                    for (int m = 0; m < 4; ++m) { const int r = row0 + ai * HALF + m * 16; const float rs = rstd[r]; const int b = r >> 12, tt = r & 4095;
#pragma unroll
                        for (int bj = 0; bj < 2; ++bj) { const int c0 = cc + bj * HALF + wc * 32 + 8 * fq; const int hh = c0 >> 6, d0 = c0 & 63;
                            bf16_t* p = vt + ((size_t)((b * 8 + hh) * 64 + d0)) * 4096 + tt;
#pragma unroll
                            for (int n = 0; n < 2; ++n)
#pragma unroll
                                for (int i = 0; i < 4; ++i) p[(size_t)(4 * n + i) * 4096] = (bf16_t)f2bf_rne(acc[ai][bj][m][n][i] * rs); } }
            } else {
                const int bufidx = (t == 0) ? 0 : (t == 1) ? 2 : (t == 3) ? 1 : t;
                bf16_t* base = six + (size_t)bufidx * MTOK * 512; const float sc = (t == 0) ? 0.125f : 1.0f;
                const int col0 = cc + wc * 32 + 8 * fq;
#pragma unroll
                for (int ai = 0; ai < 2; ++ai)
#pragma unroll
                    for (int m = 0; m < 4; ++m) { const int r = row0 + ai * HALF + m * 16; const float rs = rstd[r] * sc; bf16_t* rowp = base + (size_t)r * 512 + col0;
#pragma unroll
                        for (int bj = 0; bj < 2; ++bj) { const f32x4 v0 = acc[ai][bj][m][0] * rs, v1 = acc[ai][bj][m][1] * rs;
                            u32x4 w; w.x = cvt_pk_bf16(v0[0], v0[1]); w.y = cvt_pk_bf16(v0[2], v0[3]); w.z = cvt_pk_bf16(v1[0], v1[1]); w.w = cvt_pk_bf16(v1[2], v1[3]);
                            *(u32x4*)(rowp + bj * HALF) = w; } }
            }
        } else {
            const int gi = (colt - 3072) >> 10, cc = (colt - 3072) & 1023;
            bf16_t* base = gate + (size_t)gi * MTOK * 1024; const int col0 = cc + wc * 32 + 8 * fq;
#pragma unroll
            for (int ai = 0; ai < 2; ++ai)
#pragma unroll
                for (int m = 0; m < 4; ++m) { const int r = row0 + ai * HALF + m * 16; const float rs = rstd[r]; bf16_t* rowp = base + (size_t)r * 1024 + col0;
#pragma unroll
                    for (int bj = 0; bj < 2; ++bj) { f32x4 v0 = acc[ai][bj][m][0] * rs, v1 = acc[ai][bj][m][1] * rs;
#pragma unroll
                        for (int i = 0; i < 4; ++i) { v0[i] = sigmoid_fast(v0[i]); v1[i] = sigmoid_fast(v1[i]); }
                        u32x4 w; w.x = cvt_pk_bf16(v0[0], v0[1]); w.y = cvt_pk_bf16(v0[2], v0[3]); w.z = cvt_pk_bf16(v1[0], v1[1]); w.w = cvt_pk_bf16(v1[2], v1[3]);
                        *(u32x4*)(rowp + bj * HALF) = w; } }
        }
    }
};

struct EpiGate {
    static constexpr bool PERM = true, AFTER_DRAIN = false;
    float* P; bf16_t* merged; const bf16_t* g0; const bf16_t* g1;
    __device__ __forceinline__ void operator()(const f32x4 (&acc)[2][2][4][2], const Unit& u, int wr, int wc, int fr, int fq) const {
        const int which = (u.pm >= 64) ? 1 : 0; const int pm = u.pm - 64 * which, pn = u.pn - 4 * which;
        const int row0 = pm * BM + wr * 64 + fr, col0 = pn * BM + wc * 32 + 8 * fq; const bf16_t* g = which ? g1 : g0;
#pragma unroll
        for (int ai = 0; ai < 2; ++ai)
#pragma unroll
            for (int m = 0; m < 4; ++m) { const int r = row0 + ai * HALF + m * 16;
#pragma unroll
                for (int bj = 0; bj < 2; ++bj) { const size_t off = (size_t)r * 1024 + col0 + bj * HALF;
                    const u32x4 gv = *(const u32x4*)(g + off);
                    f32x4 a0 = acc[ai][bj][m][0], a1 = acc[ai][bj][m][1];
                    a0[0] *= bf_lo(gv.x); a0[1] *= bf_hi(gv.x); a0[2] *= bf_lo(gv.y); a0[3] *= bf_hi(gv.y);
                    a1[0] *= bf_lo(gv.z); a1[1] *= bf_hi(gv.z); a1[2] *= bf_lo(gv.w); a1[3] *= bf_hi(gv.w);
                    if (!which) { u32x4 w; w.x = cvt_pk_bf16(a0[0], a0[1]); w.y = cvt_pk_bf16(a0[2], a0[3]); w.z = cvt_pk_bf16(a1[0], a1[1]); w.w = cvt_pk_bf16(a1[2], a1[3]); *(u32x4*)((bf16_t*)P + off) = w; }
                    else { const u32x4 pw = *(const u32x4*)((const bf16_t*)P + off);
                        a0[0] += bf_lo(pw.x); a0[1] += bf_hi(pw.x); a0[2] += bf_lo(pw.y); a0[3] += bf_hi(pw.y); a1[0] += bf_lo(pw.z); a1[1] += bf_hi(pw.z); a1[2] += bf_lo(pw.w); a1[3] += bf_hi(pw.w);
                        u32x4 w; w.x = cvt_pk_bf16(a0[0], a0[1]); w.y = cvt_pk_bf16(a0[2], a0[3]); w.z = cvt_pk_bf16(a1[0], a1[1]); w.w = cvt_pk_bf16(a1[2], a1[3]);
                        *(u32x4*)(merged + off) = w; } } }
    }
};
struct PairOrder {
    StaticOrder so;
    __host__ __device__ void init(int G_, int c_) { so.init(MTOK, 1024, G_, c_); }
    __host__ __device__ bool next(int i, Unit& u) const { Unit t; if (!so.next(i >> 1, t)) return false; const int w = i & 1; u.pm = t.pm + 64 * w; u.pn = t.pn + 4 * w; return true; }
    __device__ __forceinline__ void a_ready(const Unit&) const {}
    __device__ __forceinline__ void done(const Unit&) const {}
};

struct EpiWo {
    static constexpr bool PERM = true, AFTER_DRAIN = false;
    const float* x; bf16_t* x1b;
    __device__ __forceinline__ void operator()(const f32x4 (&acc)[2][2][4][2], const Unit& u, int wr, int wc, int fr, int fq) const {
        const int row0 = u.pm * BM + wr * 64 + fr, col0 = u.pn * BM + wc * 32 + 8 * fq;
#pragma unroll
        for (int ai = 0; ai < 2; ++ai)
#pragma unroll
            for (int m = 0; m < 4; ++m) { const int r = row0 + ai * HALF + m * 16;
#pragma unroll
                for (int bj = 0; bj < 2; ++bj) { const size_t off = (size_t)r * 1024 + col0 + bj * HALF;
                    const f32x4 a0 = acc[ai][bj][m][0] + *(const f32x4*)(x + off), a1 = acc[ai][bj][m][1] + *(const f32x4*)(x + off + 4);
                    u32x4 w; w.x = cvt_pk_bf16(a0[0], a0[1]); w.y = cvt_pk_bf16(a0[2], a0[3]); w.z = cvt_pk_bf16(a1[0], a1[1]); w.w = cvt_pk_bf16(a1[2], a1[3]);
                    *(u32x4*)(x1b + off) = w; } }
    }
};
typedef _Float16 f16x2_t __attribute__((ext_vector_type(2)));
typedef float f32x2e __attribute__((ext_vector_type(2)));
__device__ __forceinline__ unsigned pk_f16(float lo, float hi) { f32x2e v = {lo, hi}; f16x2_t h = __builtin_convertvector(v, f16x2_t); return __builtin_bit_cast(unsigned, h); }
struct EpiScores {
    static constexpr bool PERM = true, AFTER_DRAIN = false;
    unsigned short* S;
    __device__ __forceinline__ void operator()(const f32x4 (&acc)[2][2][4][2], const Unit& u, int wr, int wc, int fr, int fq) const {
        const int row0 = u.pm * BM + wr * 64 + fr, col0 = u.pn * BM + wc * 32 + 8 * fq;
#pragma unroll
        for (int ai = 0; ai < 2; ++ai)
#pragma unroll
            for (int m = 0; m < 4; ++m) { const int r = row0 + ai * HALF + m * 16;
#pragma unroll
                for (int bj = 0; bj < 2; ++bj) { const size_t off = ((size_t)((col0 + bj * HALF) >> 3) * MTOK + r) * 8;
                    const f32x4 a0 = acc[ai][bj][m][0], a1 = acc[ai][bj][m][1];
                    u32x4 w; w.x = pk_f16(a0[0], a0[1]); w.y = pk_f16(a0[2], a0[3]); w.z = pk_f16(a1[0], a1[1]); w.w = pk_f16(a1[2], a1[3]);
                    *(u32x4*)(S + off) = w; } }
    }
};
template <class Epi, class Sched, bool ALIGN_EPI = false, bool SP2 = false>
__device__ __forceinline__ void gemm_phase(PG8_LAS unsigned char* lds, const Gemm g, const Sched& S, const Epi& E) {
    const int tid = threadIdx.x, wid = __builtin_amdgcn_readfirstlane(tid >> 6), lane = tid & 63, wr = wid >> 2, wc = wid & 3, fr = lane & 15, fq = lane >> 4;
    const int K = g.K, nt = K / BK;
    unsigned voffA[2], voffB[2];
#pragma unroll
    for (int i = 0; i < 2; ++i) { int R, C; stage_rc(tid * 16 + i * 8192, R, C); const int Rb = Epi::PERM ? ((R & ~31) + perm32(R & 31)) : R;
        voffA[i] = (unsigned)(R * K + C) * 2u; voffB[i] = (unsigned)(Rb * K + C) * 2u; }
    const size_t kstep = (size_t)(BK * 2);
    const size_t hstep = (size_t)HALF * K * 2;
    const size_t tstep = 2 * hstep;
    const unsigned ldsw = (unsigned)wid * 1024u;
    const int aoff = lds_byte(wr * 64 + fr, fq * 8), boff = lds_byte(wc * 32 + fr, fq * 8);
#define PG8_SA(b, h) (((b) * 2 + (h)) * HTB)
#define PG8_SB(b, h) ((4 + (b) * 2 + (h)) * HTB)
#define PG8_STAGE(bufoff, gbase, voff) do { _Pragma("unroll") for (int _i = 0; _i < 2; ++_i) \
        __builtin_amdgcn_global_load_lds((const unsigned*)((const char*)(gbase) + (voff)[_i]), (PG8_LAS unsigned*)(lds + (bufoff) + ldsw + _i * 8192), 16, 0, 0); } while (0)
#define PG8_LDA(dst, b, h) do { _Pragma("unroll") for (int m = 0; m < 4; ++m) _Pragma("unroll") for (int k = 0; k < 2; ++k) dst[m][k] = *(const PG8_LAS bf16x8*)(lds + PG8_SA(b, h) + aoff + m * 2048 + k * 1024); } while (0)
#define PG8_LDB(dst, b, h) do { _Pragma("unroll") for (int n = 0; n < 2; ++n) _Pragma("unroll") for (int k = 0; k < 2; ++k) dst[n][k] = *(const PG8_LAS bf16x8*)(lds + PG8_SB(b, h) + boff + n * 2048 + k * 1024); } while (0)
#define PG8_MMA(ai, bj, At, Bt) do { __builtin_amdgcn_s_setprio(1); _Pragma("unroll") for (int m = 0; m < 4; ++m) _Pragma("unroll") for (int n = 0; n < 2; ++n) _Pragma("unroll") for (int k = 0; k < 2; ++k) \
        acc[ai][bj][m][n] = __builtin_amdgcn_mfma_f32_16x16x32_bf16(Bt[n][k], At[m][k], acc[ai][bj][m][n], 0, 0, 0); __builtin_amdgcn_s_setprio(0); } while (0)
#define PG8_WAIT_V(n) asm volatile("s_waitcnt vmcnt(" #n ")" ::: "memory")
#define PG8_WAIT_L(n) asm volatile("s_waitcnt lgkmcnt(" #n ")" ::: "memory")
#define PG8_BAR __builtin_amdgcn_s_barrier()
#define PG8_SCHED __builtin_amdgcn_sched_barrier(0)
    Unit cur, nxt; int ui = 0;
    if (!S.next(0, cur)) return;
    f32x4 acc[2][2][4][2];
#pragma unroll
    for (int a = 0; a < 2; ++a)
#pragma unroll
        for (int b = 0; b < 2; ++b)
#pragma unroll
            for (int m = 0; m < 4; ++m)
#pragma unroll
                for (int n = 0; n < 2; ++n) acc[a][b][m][n] = (f32x4){0.f, 0.f, 0.f, 0.f};
    bf16x8 At[4][2], B0[2][2], B1[2][2];
    const char* cA = (const char*)g.A + (size_t)cur.pm * tstep; const char* cB = (const char*)g.Bt + (size_t)cur.pn * tstep;
    S.a_ready(cur);
    if constexpr (SP2) {
        PG8_STAGE(PG8_SB(0, 0), cB, voffB); PG8_STAGE(PG8_SB(0, 1), cB + hstep, voffB); PG8_STAGE(PG8_SA(0, 0), cA, voffA); PG8_STAGE(PG8_SA(0, 1), cA + hstep, voffA);
        if (wr == 1) PG8_BAR;
        PG8_WAIT_V(2); PG8_BAR;
        PG8_STAGE(PG8_SB(1, 0), cB + kstep, voffB); PG8_STAGE(PG8_SA(1, 0), cA + kstep, voffA); PG8_STAGE(PG8_SB(1, 1), cB + hstep + kstep, voffB);
        PG8_WAIT_V(6); PG8_BAR;
    } else {
        PG8_STAGE(PG8_SB(0, 0), cB, voffB); PG8_STAGE(PG8_SA(0, 0), cA, voffA); PG8_STAGE(PG8_SB(0, 1), cB + hstep, voffB); PG8_STAGE(PG8_SA(0, 1), cA + hstep, voffA);
        if (wr == 1) PG8_BAR;
        PG8_WAIT_V(4); PG8_BAR;
        PG8_STAGE(PG8_SB(1, 0), cB + kstep, voffB); PG8_STAGE(PG8_SA(1, 0), cA + kstep, voffA); PG8_STAGE(PG8_SB(1, 1), cB + hstep + kstep, voffB);
        PG8_WAIT_V(6); PG8_BAR;
    }
    for (;;) {
        const bool has_next = S.next(ui + 1, nxt);
        const char* nA = has_next ? (const char*)g.A + (size_t)nxt.pm * tstep : cA; const char* nB = has_next ? (const char*)g.Bt + (size_t)nxt.pn * tstep : cB;
        for (int t = 0; t < nt; t += 2) {
            const bool last = (t == nt - 2);
            const char* a1 = cA + (size_t)(t + 1) * kstep;
            const char* a2 = last ? nA : cA + (size_t)(t + 2) * kstep; const char* b2 = last ? nB : cB + (size_t)(t + 2) * kstep;
            const char* a3 = a2 + kstep; const char* b3 = b2 + kstep;
            if (last && has_next) S.a_ready(nxt);
            if constexpr (SP2) {
            PG8_LDB(B0, 0, 0); PG8_LDB(B1, 0, 1); PG8_SCHED; PG8_LDA(At, 0, 0); PG8_STAGE(PG8_SA(1, 1), a1 + hstep, voffA);
            PG8_WAIT_V(8); PG8_WAIT_L(0); PG8_BAR; PG8_MMA(0, 0, At, B0); PG8_MMA(0, 1, At, B1); PG8_BAR; PG8_SCHED;
            PG8_LDA(At, 0, 1); PG8_STAGE(PG8_SB(0, 0), b2, voffB); PG8_STAGE(PG8_SB(0, 1), b2 + hstep, voffB); PG8_STAGE(PG8_SA(0, 0), a2, voffA);
            PG8_WAIT_V(8); PG8_WAIT_L(0); PG8_BAR; PG8_MMA(1, 0, At, B0); PG8_MMA(1, 1, At, B1); PG8_BAR; PG8_SCHED;
            PG8_LDB(B0, 1, 0); PG8_LDB(B1, 1, 1); PG8_SCHED; PG8_LDA(At, 1, 0); PG8_STAGE(PG8_SA(0, 1), a2 + hstep, voffA);
            PG8_WAIT_V(8); PG8_WAIT_L(0); PG8_BAR; PG8_MMA(0, 0, At, B0); PG8_MMA(0, 1, At, B1); PG8_BAR; PG8_SCHED;
            PG8_LDA(At, 1, 1); PG8_STAGE(PG8_SB(1, 0), b3, voffB); PG8_STAGE(PG8_SB(1, 1), b3 + hstep, voffB); PG8_STAGE(PG8_SA(1, 0), a3, voffA);
            PG8_WAIT_V(8); PG8_WAIT_L(0); PG8_BAR; PG8_MMA(1, 0, At, B0); PG8_MMA(1, 1, At, B1); PG8_BAR; PG8_SCHED;
            } else {
            PG8_LDB(B0, 0, 0); PG8_SCHED; PG8_LDA(At, 0, 0); PG8_STAGE(PG8_SA(1, 1), a1 + hstep, voffA);
            PG8_WAIT_L(8); PG8_BAR; PG8_WAIT_L(0); PG8_MMA(0, 0, At, B0); PG8_BAR; PG8_SCHED;
            PG8_LDB(B1, 0, 1); PG8_STAGE(PG8_SB(0, 0), b2, voffB);
            PG8_BAR; PG8_WAIT_L(0); PG8_MMA(0, 1, At, B1); PG8_BAR;
            PG8_LDA(At, 0, 1); PG8_STAGE(PG8_SA(0, 0), a2, voffA);
            PG8_BAR; PG8_WAIT_L(0); PG8_MMA(1, 0, At, B0); PG8_BAR; PG8_SCHED;
            PG8_STAGE(PG8_SB(0, 1), b2 + hstep, voffB);
            PG8_WAIT_V(6); PG8_BAR; PG8_MMA(1, 1, At, B1); PG8_BAR;
            PG8_LDB(B0, 1, 0); PG8_SCHED; PG8_LDA(At, 1, 0); PG8_STAGE(PG8_SA(0, 1), a2 + hstep, voffA);
            PG8_WAIT_L(8); PG8_BAR; PG8_WAIT_L(0); PG8_MMA(0, 0, At, B0); PG8_BAR; PG8_SCHED;
            PG8_LDB(B1, 1, 1); PG8_STAGE(PG8_SB(1, 0), b3, voffB);
            PG8_BAR; PG8_WAIT_L(0); PG8_MMA(0, 1, At, B1); PG8_BAR;
            PG8_LDA(At, 1, 1); PG8_STAGE(PG8_SA(1, 0), a3, voffA);
            PG8_BAR; PG8_WAIT_L(0); PG8_MMA(1, 0, At, B0); PG8_BAR; PG8_SCHED;
            PG8_STAGE(PG8_SB(1, 1), b3 + hstep, voffB);
            PG8_WAIT_V(6); PG8_BAR; PG8_MMA(1, 1, At, B1); PG8_BAR;
            }
        }
        if constexpr (ALIGN_EPI) { if (wr == 0) PG8_BAR; }
        if constexpr (!Epi::AFTER_DRAIN) { E(acc, cur, wr, wc, fr, fq); S.done(cur); }
        if (!has_next) break;
#pragma unroll
        for (int a = 0; a < 2; ++a)
#pragma unroll
            for (int b = 0; b < 2; ++b)
#pragma unroll
                for (int m = 0; m < 4; ++m)
#pragma unroll
                    for (int n = 0; n < 2; ++n) acc[a][b][m][n] = (f32x4){0.f, 0.f, 0.f, 0.f};
        cur = nxt; cA = nA; cB = nB; ++ui;
        if constexpr (ALIGN_EPI) { if (wr == 1) PG8_BAR; }
    }
    PG8_WAIT_V(0);
    if constexpr (!ALIGN_EPI) { if (wr == 0) PG8_BAR; }
    PG8_BAR;
    if constexpr (Epi::AFTER_DRAIN) { E.fused(acc, cur, wr, wc, fr, fq, lds, wid, lane); S.done(cur); }
#undef PG8_SA
#undef PG8_SB
#undef PG8_STAGE
#undef PG8_LDA
#undef PG8_LDB
#undef PG8_MMA
#undef PG8_WAIT_V
#undef PG8_WAIT_L
#undef PG8_BAR
#undef PG8_SCHED
}
}

constexpr int NWAVES = 8;
constexpr int BATCH = 4, T = 4096, D = 1024, NH = 8, HD = 64, NIN = 5120;
constexpr int M = BATCH * T;
constexpr int NEXP = 16384;
constexpr float RMS_EPS = 1e-6f;
#ifndef MK_N_LAUNCHES
#define MK_N_LAUNCHES 1
#endif
constexpr int N_PHASES = 11;
constexpr int N_LAUNCHES = MK_N_LAUNCHES;

constexpr size_t MiB = 1u << 20;
constexpr size_t WS_CTL = 0, CTL_ZERO_BYTES = 64 * 1024;
constexpr size_t WS_RSTD1 = 512 * 1024;
constexpr size_t WS_WEFF = 1 * MiB;
constexpr size_t WS_WAB = 5 * MiB;
constexpr size_t WS_WO = 7 * MiB;
constexpr size_t WS_WIN = 9 * MiB;
constexpr size_t WS_XB = 19 * MiB;
constexpr size_t WS_SIX = 51 * MiB;
constexpr size_t WS_VT = WS_SIX + 3 * 16 * MiB;
constexpr size_t WS_GATE = 147 * MiB;
constexpr size_t WS_MERGED = 19 * MiB;
constexpr size_t WS_X1B = 51 * MiB;
constexpr size_t WS_TU = 211 * MiB, WS_TV = 227 * MiB;
constexpr size_t WS_SU = 576 * 1024, WS_SV = 640 * 1024;
constexpr size_t WS_SCORES = 83 * MiB;
constexpr size_t WS_ROUTE = 19 * MiB;
constexpr size_t WS_W = 35 * MiB;
constexpr size_t WS_SS = 43 * MiB;
constexpr size_t WS_UPART = 83 * MiB;
constexpr size_t WS_END = 256 * MiB;
constexpr int CW_BAR = 4096;

constexpr int RING_OFF = 0, RING_BYTES = 131072;
constexpr int LDSCTL_OFF = RING_BYTES;
constexpr int LDS_BYTES = 147456;
constexpr int MISC_OFF = LDS_BYTES - 128;

#define GAS __attribute__((address_space(1)))
#define LAS __attribute__((address_space(3)))
#define CAS __attribute__((address_space(4)))
typedef unsigned short bf16;
typedef unsigned v4u __attribute__((ext_vector_type(4)));
typedef unsigned v2u __attribute__((ext_vector_type(2)));
typedef float f32x4 __attribute__((ext_vector_type(4)));
typedef float f32x2 __attribute__((ext_vector_type(2)));
typedef float f32x16 __attribute__((ext_vector_type(16)));
typedef short bf16x8 __attribute__((ext_vector_type(8)));
typedef _Float16 f16x8 __attribute__((ext_vector_type(8)));
typedef _Float16 f16x2 __attribute__((ext_vector_type(2)));
typedef __bf16 bf16x2_t __attribute__((ext_vector_type(2)));
typedef GAS unsigned gu32;
#define RLX_AGENT __ATOMIC_RELAXED, __HIP_MEMORY_SCOPE_AGENT
#define LDS_WAIT() asm volatile("s_waitcnt lgkmcnt(0)" ::: "memory")
#define VM_WAIT() asm volatile("s_waitcnt vmcnt(0)" ::: "memory")
__device__ __forceinline__ unsigned f2bf(float f) { unsigned u = __builtin_bit_cast(unsigned, f); return (u + 0x7fffu + ((u >> 16) & 1u)) >> 16; }
__device__ __forceinline__ unsigned pk2(float lo, float hi) { return f2bf(lo) | (f2bf(hi) << 16); }
__device__ __forceinline__ unsigned cvtpk(float lo, float hi) { f32x2 v = {lo, hi}; bf16x2_t b = __builtin_convertvector(v, bf16x2_t); return __builtin_bit_cast(unsigned, b); }
__device__ __forceinline__ float bflo(unsigned w) { return __builtin_bit_cast(float, w << 16); }
__device__ __forceinline__ float bfhi(unsigned w) { return __builtin_bit_cast(float, w & 0xffff0000u); }
__device__ __forceinline__ float wave_sum(float v) {
#pragma unroll
    for (int o = 1; o < 64; o <<= 1) v += __shfl_xor(v, o);
    return v;
}
#define XB_TMO      128
#define XB_XCNT(j)  (256  + 64 * (j))
#define XB_XSUB(j)  (1280 + 64 * (j))
#define XB_XGEN(j)  (2304 + 64 * (j))
#define XB_TOP      3328
#define XB_TOPGEN   3392
#define XCD_BAR_WORDS 3456
#define XB_SPIN_CAP (1u << 18)

__device__ __forceinline__ unsigned xb_ld(unsigned* p)              { return __hip_atomic_load(p, __ATOMIC_RELAXED, __HIP_MEMORY_SCOPE_AGENT); }
__device__ __forceinline__ unsigned xb_add(unsigned* p, unsigned v) { return __hip_atomic_fetch_add(p, v, __ATOMIC_RELAXED, __HIP_MEMORY_SCOPE_AGENT); }
__device__ __forceinline__ unsigned xb_xcc_id() { return (unsigned)__builtin_amdgcn_s_getreg((3 << 11) | 20) & 0xFu; }
#define XB_SPIN(cond, bar) do { unsigned _sp = 0; while (cond) { __builtin_amdgcn_s_sleep(1); \
    if ((++_sp & 255u) == 0u) { if (xb_ld(&(bar)[XB_TMO])) break; if (_sp > XB_SPIN_CAP) { atomicAdd(&(bar)[XB_TMO], 1u); break; } } } } while (0)

struct XcdBarrier {
    unsigned* bar; unsigned x;
    volatile LAS unsigned* st;
};

__device__ __forceinline__ XcdBarrier xcd_barrier_post(unsigned* bar, volatile LAS unsigned* st) {
    XcdBarrier b; b.bar = bar; b.x = xb_xcc_id(); b.st = st;
    if (threadIdx.x == 0) (void)xb_add(&bar[XB_XCNT(b.x)], 1u);
    return b;
}
__device__ __forceinline__ void xcd_barrier_complete(unsigned* bar, unsigned x, unsigned& nloc, unsigned& nx) {
    const unsigned G = gridDim.x * gridDim.y * gridDim.z;
    unsigned sum, cnt, mine, sp = 0u;
    for (;;) {
        sum = 0u; cnt = 0u; mine = 0u;
#pragma unroll
        for (unsigned j = 0; j < 16; ++j) { const unsigned c = xb_ld(&bar[XB_XCNT(j)]); sum += c; cnt += (c > 0u) ? 1u : 0u; mine = (j == x) ? c : mine; }
        if (sum == G) break;
        __builtin_amdgcn_s_sleep(1);
        if ((++sp & 255u) == 0u) { if (xb_ld(&bar[XB_TMO])) break; if (sp > XB_SPIN_CAP) { atomicAdd(&bar[XB_TMO], 1u); break; } }
    }
    nloc = mine > 0u ? mine : 1u; nx = cnt > 0u ? cnt : 1u;
}

__device__ __forceinline__ void xcd_barrier(const XcdBarrier& b) {
    asm volatile("s_waitcnt vmcnt(0)" ::: "memory");
    __syncthreads();
    if (threadIdx.x == 0) {
        unsigned* bar = b.bar;
        __builtin_amdgcn_s_waitcnt(0);
        unsigned nloc = b.st[0], nx = b.st[1];
        if (nloc == 0u) { xcd_barrier_complete(bar, b.x, nloc, nx); b.st[0] = nloc; b.st[1] = nx; }
        const unsigned old = xb_add(&bar[XB_XSUB(b.x)], 1u);
        const unsigned gen = old / nloc;
        if (old + 1u == (gen + 1u) * nloc) {
            __builtin_amdgcn_fence(__ATOMIC_RELEASE, "agent");
            asm volatile("s_waitcnt vmcnt(0)" ::: "memory");
            const unsigned og = xb_add(&bar[XB_TOP], 1u);
            const unsigned tg = og / nx;
            if (og + 1u == (tg + 1u) * nx) xb_add(&bar[XB_TOPGEN], 1u);
            else XB_SPIN(xb_ld(&bar[XB_TOPGEN]) == tg, bar);
            __builtin_amdgcn_fence(__ATOMIC_ACQUIRE, "agent");
            xb_add(&bar[XB_XGEN(b.x)], 1u);
            asm volatile("s_waitcnt vmcnt(0)" ::: "memory");
        } else {
            XB_SPIN(xb_ld(&bar[XB_XGEN(b.x)]) == gen, bar);
            __builtin_amdgcn_fence(__ATOMIC_ACQUIRE, "agent");
            asm volatile("s_waitcnt vmcnt(0)" ::: "memory");
        }
    }
    __syncthreads();
}

__device__ __forceinline__ void p0_transpose_item(const float* W, int K, int N, bf16* WT, int row_off, const float* kscale, LAS float* scr, int item, int lane) {
    const int nblk = N / 32, kb = item / nblk, nb = item % nblk, k0 = 64 * kb, n0 = 32 * nb;
    f32x4 ld[8];
#pragma unroll
    for (int i = 0; i < 8; ++i) ld[i] = __builtin_nontemporal_load((const GAS f32x4*)(W + (size_t)(k0 + 8 * i + (lane >> 3)) * N + n0 + 4 * (lane & 7)));
#pragma unroll
    for (int i = 0; i < 8; ++i) { LAS float* d = scr + (8 * i + (lane >> 3)) * 33 + 4 * (lane & 7); d[0] = ld[i].x; d[1] = ld[i].y; d[2] = ld[i].z; d[3] = ld[i].w; }
    LDS_WAIT(); asm volatile("" ::: "memory");
    const int c = lane & 7;
    float ks[8];
#pragma unroll
    for (int i = 0; i < 8; ++i) ks[i] = kscale ? kscale[k0 + 8 * c + i] : 1.0f;
#pragma unroll
    for (int j = 0; j < 4; ++j) { const int n = (lane >> 3) + 8 * j; const LAS float* s = scr + (8 * c) * 33 + n;
        v4u o; o.x = pk2(s[0 * 33] * ks[0], s[1 * 33] * ks[1]); o.y = pk2(s[2 * 33] * ks[2], s[3 * 33] * ks[3]); o.z = pk2(s[4 * 33] * ks[4], s[5 * 33] * ks[5]); o.w = pk2(s[6 * 33] * ks[6], s[7 * 33] * ks[7]);
        *(GAS v4u*)(WT + (size_t)(row_off + n0 + n) * K + k0 + 8 * c) = o; }
    LDS_WAIT(); asm volatile("" ::: "memory");
}

__device__ __forceinline__ void conv_phase(const bf16* CB, const bf16* CC, const bf16* CU, bf16* CO, const float* cw, const float* cbias, int gtid, int nthreads) {
    for (int task = gtid; task < M * 64; task += nthreads) {
        const int tok = task >> 6, c8 = (task & 63) * 8, tt = tok & (T - 1);
        const size_t off = (size_t)tok * 512 + c8;
        float z[3][8];
#pragma unroll
        for (int k = 0; k < 3; ++k) {
            const int dt = 2 - k;
            if (tt >= dt) { const v4u a = *(const GAS v4u*)(CC + off - (size_t)dt * 512), b = *(const GAS v4u*)(CU + off - (size_t)dt * 512);
                z[k][0] = bflo(a.x) * bflo(b.x); z[k][1] = bfhi(a.x) * bfhi(b.x); z[k][2] = bflo(a.y) * bflo(b.y); z[k][3] = bfhi(a.y) * bfhi(b.y);
                z[k][4] = bflo(a.z) * bflo(b.z); z[k][5] = bfhi(a.z) * bfhi(b.z); z[k][6] = bflo(a.w) * bflo(b.w); z[k][7] = bfhi(a.w) * bfhi(b.w); }
            else {
#pragma unroll
                for (int i = 0; i < 8; ++i) z[k][i] = 0.f; }
        }
        float y[8];
#pragma unroll
        for (int i = 0; i < 8; ++i) y[i] = cbias[c8 + i];
#pragma unroll
        for (int k = 0; k < 3; ++k)
#pragma unroll
            for (int i = 0; i < 8; ++i) y[i] += cw[k * 512 + c8 + i] * z[k][i];
        const v4u g = *(const GAS v4u*)(CB + off);
        v4u o; o.x = pk2(bflo(g.x) * y[0], bfhi(g.x) * y[1]); o.y = pk2(bflo(g.y) * y[2], bfhi(g.y) * y[3]); o.z = pk2(bflo(g.z) * y[4], bfhi(g.z) * y[5]); o.w = pk2(bflo(g.w) * y[6], bfhi(g.w) * y[7]);
        *(GAS v4u*)(CO + off) = o;
    }
}

__device__ __forceinline__ int crow(int r, int hf) { return (r & 3) + 8 * (r >> 2) + 4 * hf; }
#define MFMA_BF16(a, b, c) __builtin_amdgcn_mfma_f32_32x32x16_bf16((a), (b), (c), 0, 0, 0)
#define MFMA_F16(a, b, c) __builtin_amdgcn_mfma_f32_32x32x16_f16((a), (b), (c), 0, 0, 0)
__device__ __forceinline__ void attn_item(const bf16* Qb, const bf16* Kb, const bf16* VT, bf16* Ob, int b, int h, int qblk, LAS unsigned char* scr, int lane) {
    const int t32 = lane & 31, hf = lane >> 5, q0 = qblk * 32, tq = q0 + t32;
    const size_t rowbase = (size_t)b * T;
    const float LOG2E = 1.4426950408889634f, LN2 = 0.6931471805599453f;
    bf16x8 qf[4];
    { const bf16* qp = Qb + (rowbase + q0 + t32) * 512 + h * 64 + 8 * hf;
#pragma unroll
      for (int st = 0; st < 4; ++st) qf[st] = *(const GAS bf16x8*)(qp + 16 * st); }
    f16x8 tri[2];
#pragma unroll
    for (int st = 0; st < 2; ++st)
#pragma unroll
        for (int e = 0; e < 8; ++e) { const int j = 16 * st + 8 * (e >> 2) + 4 * hf + (e & 3); tri[st][e] = (j >= t32) ? (_Float16)1.0f : (_Float16)0.0f; }
    f32x16 o0, o1;
#pragma unroll
    for (int r = 0; r < 16; ++r) { o0[r] = 0.f; o1[r] = 0.f; }
    float R = 0.f;
    const bf16* kld = Kb + (rowbase + (lane >> 3)) * 512 + h * 64 + 8 * (lane & 7);
    const bf16* vld = VT + ((size_t)(b * 8 + h) * 64 + (lane >> 3)) * T + 8 * (lane & 7);
    LAS unsigned char* stw = scr + (lane >> 3) * 144 + 16 * (lane & 7);
    const LAS unsigned char* kfr = scr + t32 * 144 + 16 * hf;
    const LAS unsigned char* vfr = scr + t32 * 144 + 8 * hf;
    for (int jt = q0 >> 6; jt >= 0; --jt) {
        const int k0 = jt * 64;
        f32x16 s0, s1;
#pragma unroll
        for (int r = 0; r < 16; ++r) { s0[r] = 0.f; s1[r] = 0.f; }
        { v4u kl[8], vl[8];
#pragma unroll
          for (int i = 0; i < 8; ++i) { kl[i] = *(const GAS v4u*)(kld + (size_t)(k0 + 8 * i) * 512); vl[i] = *(const GAS v4u*)(vld + (size_t)(8 * i) * T + k0); }
#pragma unroll
          for (int i = 0; i < 8; ++i) *(LAS v4u*)(stw + i * (8 * 144)) = kl[i];
          LDS_WAIT();
          bf16x8 ka0[4], ka1[4];
#pragma unroll
          for (int st = 0; st < 4; ++st) { ka0[st] = *(const LAS bf16x8*)(kfr + 32 * st); ka1[st] = *(const LAS bf16x8*)(kfr + 32 * 144 + 32 * st); }
          LDS_WAIT();
#pragma unroll
          for (int i = 0; i < 8; ++i) *(LAS v4u*)(stw + i * (8 * 144)) = vl[i];
#pragma unroll
          for (int st = 0; st < 4; ++st) { s0 = MFMA_BF16(ka0[st], qf[st], s0); s1 = MFMA_BF16(ka1[st], qf[st], s1); }
        }
        f32x16 L0, L1; float tot0 = 0.f, tot1 = 0.f;
#pragma unroll
        for (int r = 0; r < 16; ++r) {
            const int key = k0 + crow(r, hf);
            { const float z = s0[r]; const float e = __builtin_amdgcn_exp2f(-__builtin_fabsf(z) * LOG2E); const float lp = __builtin_amdgcn_logf(1.0f + e) * LN2;
              const float L = (key < tq) ? -(__builtin_fmaxf(z, 0.f) + lp) : 0.f; L0[r] = L; tot0 += L; }
            { const float z = s1[r]; const float e = __builtin_amdgcn_exp2f(-__builtin_fabsf(z) * LOG2E); const float lp = __builtin_amdgcn_logf(1.0f + e) * LN2;
              const float L = (key + 32 < tq) ? -(__builtin_fmaxf(z, 0.f) + lp) : 0.f; L1[r] = L; tot1 += L; }
        }
        tot0 += __shfl_xor(tot0, 32); tot1 += __shfl_xor(tot1, 32);
        f16x8 lf00, lf01, lf10, lf11;
#pragma unroll
        for (int e = 0; e < 8; ++e) { lf00[e] = (_Float16)L0[e]; lf01[e] = (_Float16)L0[8 + e]; lf10[e] = (_Float16)L1[e]; lf11[e] = (_Float16)L1[8 + e]; }
        f32x16 y0, y1;
#pragma unroll
        for (int r = 0; r < 16; ++r) { y0[r] = 0.f; y1[r] = 0.f; }
        y0 = MFMA_F16(tri[0], lf00, y0); y0 = MFMA_F16(tri[1], lf01, y0);
        y1 = MFMA_F16(tri[0], lf10, y1); y1 = MFMA_F16(tri[1], lf11, y1);
        const float base0 = R + tot1, base1 = R;
        float a0v[16], a1v[16];
#pragma unroll
        for (int r = 0; r < 16; ++r) {
            const int key = k0 + crow(r, hf);
            a0v[r] = (key < tq) ? __builtin_amdgcn_exp2f((s0[r] + y0[r] + base0) * LOG2E) : 0.f;
            a1v[r] = (key + 32 < tq) ? __builtin_amdgcn_exp2f((s1[r] + y1[r] + base1) * LOG2E) : 0.f;
        }
        bf16x8 pf[2][2];
#pragma unroll
        for (int st = 0; st < 2; ++st) {
            v4u w0, w1;
            w0.x = cvtpk(a0v[8 * st + 0], a0v[8 * st + 1]); w0.y = cvtpk(a0v[8 * st + 2], a0v[8 * st + 3]); w0.z = cvtpk(a0v[8 * st + 4], a0v[8 * st + 5]); w0.w = cvtpk(a0v[8 * st + 6], a0v[8 * st + 7]);
            w1.x = cvtpk(a1v[8 * st + 0], a1v[8 * st + 1]); w1.y = cvtpk(a1v[8 * st + 2], a1v[8 * st + 3]); w1.z = cvtpk(a1v[8 * st + 4], a1v[8 * st + 5]); w1.w = cvtpk(a1v[8 * st + 6], a1v[8 * st + 7]);
            pf[0][st] = __builtin_bit_cast(bf16x8, w0); pf[1][st] = __builtin_bit_cast(bf16x8, w1);
        }
#pragma unroll
        for (int kb = 0; kb < 2; ++kb)
#pragma unroll
            for (int st = 0; st < 2; ++st) {
                const int kk2 = 2 * (32 * kb + 16 * st);
                { const v2u lo = *(const LAS v2u*)(vfr + kk2), hi = *(const LAS v2u*)(vfr + kk2 + 16); v4u w; w.x = lo.x; w.y = lo.y; w.z = hi.x; w.w = hi.y;
                  o0 = MFMA_BF16(__builtin_bit_cast(bf16x8, w), pf[kb][st], o0); }
                { const v2u lo = *(const LAS v2u*)(vfr + 32 * 144 + kk2), hi = *(const LAS v2u*)(vfr + 32 * 144 + kk2 + 16); v4u w; w.x = lo.x; w.y = lo.y; w.z = hi.x; w.w = hi.y;
                  o1 = MFMA_BF16(__builtin_bit_cast(bf16x8, w), pf[kb][st], o1); }
            }
        R += tot0 + tot1;
        LDS_WAIT();
        if (__all(R < -104.0f)) break;
    }
    bf16* op = Ob + (rowbase + q0 + t32) * 512 + h * 64 + 4 * hf;
#pragma unroll
    for (int q4 = 0; q4 < 4; ++q4) {
        v2u w; w.x = cvtpk(o0[4 * q4], o0[4 * q4 + 1]); w.y = cvtpk(o0[4 * q4 + 2], o0[4 * q4 + 3]); *(GAS v2u*)(op + 8 * q4) = w;
        v2u w2; w2.x = cvtpk(o1[4 * q4], o1[4 * q4 + 1]); w2.y = cvtpk(o1[4 * q4 + 2], o1[4 * q4 + 3]); *(GAS v2u*)(op + 32 + 8 * q4) = w2;
    }
}

#define RT_C8(op_str, cnt, x0, x1, x2, x3, x4, x5, x6, x7, thr) asm volatile(op_str : "+v"(cnt) : "v"(x0), "v"(x1), "v"(x2), "v"(x3), "v"(x4), "v"(x5), "v"(x6), "v"(x7), "v"(thr) : "vcc")
#define RT_GE8 "v_cmp_ge_f32 vcc, %1, %9\n\tv_addc_co_u32_e32 %0, vcc, 0, %0, vcc\n\tv_cmp_ge_f32 vcc, %2, %9\n\tv_addc_co_u32_e32 %0, vcc, 0, %0, vcc\n\tv_cmp_ge_f32 vcc, %3, %9\n\tv_addc_co_u32_e32 %0, vcc, 0, %0, vcc\n\tv_cmp_ge_f32 vcc, %4, %9\n\tv_addc_co_u32_e32 %0, vcc, 0, %0, vcc\n\tv_cmp_ge_f32 vcc, %5, %9\n\tv_addc_co_u32_e32 %0, vcc, 0, %0, vcc\n\tv_cmp_ge_f32 vcc, %6, %9\n\tv_addc_co_u32_e32 %0, vcc, 0, %0, vcc\n\tv_cmp_ge_f32 vcc, %7, %9\n\tv_addc_co_u32_e32 %0, vcc, 0, %0, vcc\n\tv_cmp_ge_f32 vcc, %8, %9\n\tv_addc_co_u32_e32 %0, vcc, 0, %0, vcc"
#define RT_GT8 "v_cmp_gt_f32 vcc, %1, %9\n\tv_addc_co_u32_e32 %0, vcc, 0, %0, vcc\n\tv_cmp_gt_f32 vcc, %2, %9\n\tv_addc_co_u32_e32 %0, vcc, 0, %0, vcc\n\tv_cmp_gt_f32 vcc, %3, %9\n\tv_addc_co_u32_e32 %0, vcc, 0, %0, vcc\n\tv_cmp_gt_f32 vcc, %4, %9\n\tv_addc_co_u32_e32 %0, vcc, 0, %0, vcc\n\tv_cmp_gt_f32 vcc, %5, %9\n\tv_addc_co_u32_e32 %0, vcc, 0, %0, vcc\n\tv_cmp_gt_f32 vcc, %6, %9\n\tv_addc_co_u32_e32 %0, vcc, 0, %0, vcc\n\tv_cmp_gt_f32 vcc, %7, %9\n\tv_addc_co_u32_e32 %0, vcc, 0, %0, vcc\n\tv_cmp_gt_f32 vcc, %8, %9\n\tv_addc_co_u32_e32 %0, vcc, 0, %0, vcc"
#define RT_COUNT128(OPS, cnt, thr) do { cnt = 0; RT_C8(OPS, cnt, v[0], v[1], v[2], v[3], v[4], v[5], v[6], v[7], thr); RT_C8(OPS, cnt, v[8], v[9], v[10], v[11], v[12], v[13], v[14], v[15], thr); RT_C8(OPS, cnt, v[16], v[17], v[18], v[19], v[20], v[21], v[22], v[23], thr); RT_C8(OPS, cnt, v[24], v[25], v[26], v[27], v[28], v[29], v[30], v[31], thr); RT_C8(OPS, cnt, v[32], v[33], v[34], v[35], v[36], v[37], v[38], v[39], thr); RT_C8(OPS, cnt, v[40], v[41], v[42], v[43], v[44], v[45], v[46], v[47], thr); RT_C8(OPS, cnt, v[48], v[49], v[50], v[51], v[52], v[53], v[54], v[55], thr); RT_C8(OPS, cnt, v[56], v[57], v[58], v[59], v[60], v[61], v[62], v[63], thr); RT_C8(OPS, cnt, v[64], v[65], v[66], v[67], v[68], v[69], v[70], v[71], thr); RT_C8(OPS, cnt, v[72], v[73], v[74], v[75], v[76], v[77], v[78], v[79], thr); RT_C8(OPS, cnt, v[80], v[81], v[82], v[83], v[84], v[85], v[86], v[87], thr); RT_C8(OPS, cnt, v[88], v[89], v[90], v[91], v[92], v[93], v[94], v[95], thr); RT_C8(OPS, cnt, v[96], v[97], v[98], v[99], v[100], v[101], v[102], v[103], thr); RT_C8(OPS, cnt, v[104], v[105], v[106], v[107], v[108], v[109], v[110], v[111], thr); RT_C8(OPS, cnt, v[112], v[113], v[114], v[115], v[116], v[117], v[118], v[119], thr); RT_C8(OPS, cnt, v[120], v[121], v[122], v[123], v[124], v[125], v[126], v[127], thr); } while (0)
#define RT_S5(op_str, cnt, a0, a1, a2, a3, a4, b0, b1, b2, b3, b4, thr) do { float t_; asm volatile(op_str : "+v"(cnt), "=&v"(t_) : "v"(a0), "v"(a1), "v"(a2), "v"(a3), "v"(a4), "v"(b0), "v"(b1), "v"(b2), "v"(b3), "v"(b4), "v"(thr) : "vcc"); } while (0)
#define RT_SGE5 "v_add_f32_e32 %1, %2, %7\n\tv_cmp_ge_f32 vcc, %1, %12\n\tv_addc_co_u32_e32 %0, vcc, 0, %0, vcc\n\tv_add_f32_e32 %1, %3, %8\n\tv_cmp_ge_f32 vcc, %1, %12\n\tv_addc_co_u32_e32 %0, vcc, 0, %0, vcc\n\tv_add_f32_e32 %1, %4, %9\n\tv_cmp_ge_f32 vcc, %1, %12\n\tv_addc_co_u32_e32 %0, vcc, 0, %0, vcc\n\tv_add_f32_e32 %1, %5, %10\n\tv_cmp_ge_f32 vcc, %1, %12\n\tv_addc_co_u32_e32 %0, vcc, 0, %0, vcc\n\tv_add_f32_e32 %1, %6, %11\n\tv_cmp_ge_f32 vcc, %1, %12\n\tv_addc_co_u32_e32 %0, vcc, 0, %0, vcc"
#define RT_SGT5 "v_add_f32_e32 %1, %2, %7\n\tv_cmp_gt_f32 vcc, %1, %12\n\tv_addc_co_u32_e32 %0, vcc, 0, %0, vcc\n\tv_add_f32_e32 %1, %3, %8\n\tv_cmp_gt_f32 vcc, %1, %12\n\tv_addc_co_u32_e32 %0, vcc, 0, %0, vcc\n\tv_add_f32_e32 %1, %4, %9\n\tv_cmp_gt_f32 vcc, %1, %12\n\tv_addc_co_u32_e32 %0, vcc, 0, %0, vcc\n\tv_add_f32_e32 %1, %5, %10\n\tv_cmp_gt_f32 vcc, %1, %12\n\tv_addc_co_u32_e32 %0, vcc, 0, %0, vcc\n\tv_add_f32_e32 %1, %6, %11\n\tv_cmp_gt_f32 vcc, %1, %12\n\tv_addc_co_u32_e32 %0, vcc, 0, %0, vcc"
#define RT_COUNT50(OPS, cnt, thr) do { cnt = 0; RT_S5(OPS, cnt, a[0], a[0], a[0], a[0], a[0], b[0], b[1], b[2], b[3], b[4], thr); RT_S5(OPS, cnt, a[0], a[0], a[0], a[0], a[0], b[5], b[6], b[7], b[8], b[9], thr); RT_S5(OPS, cnt, a[0], a[0], a[0], a[0], a[0], b[10], b[11], b[12], b[13], b[14], thr); RT_S5(OPS, cnt, a[0], a[1], a[1], a[1], a[1], b[15], b[0], b[1], b[2], b[3], thr); RT_S5(OPS, cnt, a[1], a[1], a[1], a[1], a[2], b[4], b[5], b[6], b[7], b[0], thr); RT_S5(OPS, cnt, a[2], a[2], a[2], a[2], a[3], b[1], b[2], b[3], b[4], b[0], thr); RT_S5(OPS, cnt, a[3], a[3], a[3], a[4], a[4], b[1], b[2], b[3], b[0], b[1], thr); RT_S5(OPS, cnt, a[4], a[5], a[5], a[6], a[6], b[2], b[0], b[1], b[0], b[1], thr); RT_S5(OPS, cnt, a[7], a[7], a[8], a[9], a[10], b[0], b[1], b[0], b[0], b[0], thr); RT_S5(OPS, cnt, a[11], a[12], a[13], a[14], a[15], b[0], b[0], b[0], b[0], b[0], thr); } while (0)
#define RT_CSWAP(x, xi, p, q) do { float t_; asm volatile("v_cmp_gt_f32 vcc, %1, %0\n\tv_cndmask_b32_e32 %4, %0, %1, vcc\n\tv_cndmask_b32_e32 %1, %1, %0, vcc\n\tv_mov_b32_e32 %0, %4\n\tv_cndmask_b32_e32 %4, %2, %3, vcc\n\tv_cndmask_b32_e32 %3, %3, %2, vcc\n\tv_mov_b32_e32 %2, %4" : "+v"(x[p]), "+v"(x[q]), "+v"(xi[p]), "+v"(xi[q]), "=&v"(t_) : : "vcc"); } while (0)
#define RT_SORT16(x, xi) do { RT_CSWAP(x, xi, 0, 1); RT_CSWAP(x, xi, 2, 3); RT_CSWAP(x, xi, 0, 2); RT_CSWAP(x, xi, 1, 3); RT_CSWAP(x, xi, 1, 2); RT_CSWAP(x, xi, 4, 5); RT_CSWAP(x, xi, 6, 7); RT_CSWAP(x, xi, 4, 6); RT_CSWAP(x, xi, 5, 7); RT_CSWAP(x, xi, 5, 6); RT_CSWAP(x, xi, 0, 4); RT_CSWAP(x, xi, 2, 6); RT_CSWAP(x, xi, 2, 4); RT_CSWAP(x, xi, 1, 5); RT_CSWAP(x, xi, 3, 7); RT_CSWAP(x, xi, 3, 5); RT_CSWAP(x, xi, 1, 2); RT_CSWAP(x, xi, 3, 4); RT_CSWAP(x, xi, 5, 6); RT_CSWAP(x, xi, 8, 9); RT_CSWAP(x, xi, 10, 11); RT_CSWAP(x, xi, 8, 10); RT_CSWAP(x, xi, 9, 11); RT_CSWAP(x, xi, 9, 10); RT_CSWAP(x, xi, 12, 13); RT_CSWAP(x, xi, 14, 15); RT_CSWAP(x, xi, 12, 14); RT_CSWAP(x, xi, 13, 15); RT_CSWAP(x, xi, 13, 14); RT_CSWAP(x, xi, 8, 12); RT_CSWAP(x, xi, 10, 14); RT_CSWAP(x, xi, 10, 12); RT_CSWAP(x, xi, 9, 13); RT_CSWAP(x, xi, 11, 15); RT_CSWAP(x, xi, 11, 13); RT_CSWAP(x, xi, 9, 10); RT_CSWAP(x, xi, 11, 12); RT_CSWAP(x, xi, 13, 14); RT_CSWAP(x, xi, 0, 8); RT_CSWAP(x, xi, 4, 12); RT_CSWAP(x, xi, 4, 8); RT_CSWAP(x, xi, 2, 10); RT_CSWAP(x, xi, 6, 14); RT_CSWAP(x, xi, 6, 10); RT_CSWAP(x, xi, 2, 4); RT_CSWAP(x, xi, 6, 8); RT_CSWAP(x, xi, 10, 12); RT_CSWAP(x, xi, 1, 9); RT_CSWAP(x, xi, 5, 13); RT_CSWAP(x, xi, 5, 9); RT_CSWAP(x, xi, 3, 11); RT_CSWAP(x, xi, 7, 15); RT_CSWAP(x, xi, 7, 11); RT_CSWAP(x, xi, 3, 5); RT_CSWAP(x, xi, 7, 9); RT_CSWAP(x, xi, 11, 13); RT_CSWAP(x, xi, 1, 2); RT_CSWAP(x, xi, 3, 4); RT_CSWAP(x, xi, 5, 6); RT_CSWAP(x, xi, 7, 8); RT_CSWAP(x, xi, 9, 10); RT_CSWAP(x, xi, 11, 12); RT_CSWAP(x, xi, 13, 14); } while (0)
#define RT_FOR_CANDS(F) F(0, 0) F(0, 1) F(0, 2) F(0, 3) F(0, 4) F(0, 5) F(0, 6) F(0, 7) F(0, 8) F(0, 9) F(0, 10) F(0, 11) F(0, 12) F(0, 13) F(0, 14) F(0, 15) F(1, 0) F(1, 1) F(1, 2) F(1, 3) F(1, 4) F(1, 5) F(1, 6) F(1, 7) F(2, 0) F(2, 1) F(2, 2) F(2, 3) F(2, 4) F(3, 0) F(3, 1) F(3, 2) F(3, 3) F(4, 0) F(4, 1) F(4, 2) F(5, 0) F(5, 1) F(6, 0) F(6, 1) F(7, 0) F(7, 1) F(8, 0) F(9, 0) F(10, 0) F(11, 0) F(12, 0) F(13, 0) F(14, 0) F(15, 0)
#define RT_SEARCH(COUNT_MACRO, NTOT) \
    for (int it_ = 0; it_ < 400 && __any(!done); ++it_) { \
        const float w_ = hi - lo; float t_ = ((float)(clo - 16) + 0.5f) * __builtin_amdgcn_rcpf((float)(clo - chi)); t_ = __builtin_fminf(__builtin_fmaxf(t_, 0.125f), 0.875f); \
        float x_ = lo + w_ * t_; if (!(x_ > lo && x_ < hi)) x_ = 0.5f * lo + 0.5f * hi; const bool stuck_ = !(x_ > lo && x_ < hi); \
        int c_; COUNT_MACRO(c_, x_); \
        if (!done) { if (stuck_) { Tv = lo; done = true; } else if (c_ == 16) { Tv = x_; done = true; } else if (c_ > 16) { lo = x_; clo = c_; } else { hi = x_; chi = c_; } } } \
    if (!done) Tv = lo;
#define RT_CNT128_GE(c, x) RT_COUNT128(RT_GE8, c, x)
#define RT_CNT50_GE(c, x) RT_COUNT50(RT_SGE5, c, x)
__device__ __forceinline__ void lane_top16_of_128(const float (&v)[128], LAS unsigned char* sb) {
    float mx = v[0], mn = v[0];
#pragma unroll
    for (int i = 1; i < 128; ++i) { mx = __builtin_fmaxf(mx, v[i]); mn = __builtin_fminf(mn, v[i]); }
    float lo = mn, hi = mx, Tv = mn; int clo = 128, chi; bool done;
    RT_CNT128_GE(chi, mx); done = (chi >= 16); if (done) Tv = mx;
    RT_SEARCH(RT_CNT128_GE, 128)
    int cgt; RT_COUNT128(RT_GT8, cgt, Tv);
    const int need = 16 - cgt; int cnt = 0, idx = 0;
#pragma unroll
    for (int i = 0; i < 128; ++i) {
        asm volatile("" : "+v"(Tv), "+v"(cnt), "+v"(idx));
        LAS unsigned char* q = sb + cnt * 512; *(LAS float*)q = v[i]; *(LAS int*)(q + 4) = idx;
        cnt += (v[i] > Tv) ? 1 : 0; idx += 1;
    }
    if (__any(need > 0)) {
        idx = 0;
#pragma unroll
        for (int i = 0; i < 128; ++i) { asm volatile("" : "+v"(Tv), "+v"(cnt), "+v"(idx));
            if (v[i] == Tv && cnt < 16) { LAS unsigned char* q = sb + cnt * 512; *(LAS float*)q = v[i]; *(LAS int*)(q + 4) = idx; cnt += 1; } idx += 1; }
    }
}
__device__ __forceinline__ int opaque_zero() { int z = 0; asm volatile("" : "+v"(z)); return z; }
__device__ __forceinline__ void route_task_search(const float* SCT, v2u* ROUTE, int tok0, int h, LAS unsigned char* scr, int lane) {
    const int tok = tok0 + lane;
    LAS unsigned char* sb = scr + lane * 8;
#pragma unroll 1
    for (int p = 0; p < 2; ++p) {
        const int g = 2 * h + p; float v[128];
        const unsigned voff = (unsigned)tok * 16u;
#pragma unroll
        for (int k = 0; k < 32; ++k) { const char* bk = (const char*)SCT + ((size_t)(g * 32 + k) * M) * 16; const f32x4 q = *(const GAS f32x4*)(bk + voff); v[4 * k] = q.x; v[4 * k + 1] = q.y; v[4 * k + 2] = q.z; v[4 * k + 3] = q.w; }
        lane_top16_of_128(v, sb + p * 8704);
    }
    LDS_WAIT();
    float a[16], b[16]; int ai[16], bi[16];
#pragma unroll
    for (int i = 0; i < 16; ++i) { const v2u ea = *(LAS v2u*)(sb + i * 512), eb = *(LAS v2u*)(sb + 8704 + i * 512);
        a[i] = __builtin_bit_cast(float, ea.x); ai[i] = (int)ea.y; b[i] = __builtin_bit_cast(float, eb.x); bi[i] = (int)eb.y; }
    LDS_WAIT();
    RT_SORT16(a, ai); RT_SORT16(b, bi);
    float lo = a[15] + b[15], hi = a[0] + b[0], Tv = lo; int clo = 50, chi; bool done;
    RT_CNT50_GE(chi, hi); done = (chi >= 16); if (done) Tv = hi;
    RT_SEARCH(RT_CNT50_GE, 50)
    int cgt; RT_COUNT50(RT_SGT5, cgt, Tv);
    const int need = 16 - cgt; int cnt = 0;
#define RT_EXT(i, j) { asm volatile("" : "+v"(Tv), "+v"(cnt)); const float s_ = a[i] + b[j]; LAS unsigned char* q_ = sb + cnt * 512; *(LAS float*)q_ = s_; *(LAS int*)(q_ + 4) = ai[i] * 128 + bi[j]; cnt += (s_ > Tv) ? 1 : 0; }
    RT_FOR_CANDS(RT_EXT)
#undef RT_EXT
    if (__any(need > 0)) {
#define RT_EXT2(i, j) { asm volatile("" : "+v"(Tv), "+v"(cnt)); const float s_ = a[i] + b[j]; if (s_ == Tv && cnt < 16) { LAS unsigned char* q_ = sb + cnt * 512; *(LAS float*)q_ = s_; *(LAS int*)(q_ + 4) = ai[i] * 128 + bi[j]; cnt += 1; } }
        RT_FOR_CANDS(RT_EXT2)
#undef RT_EXT2
    }
    LDS_WAIT();
    GAS v4u* rp = (GAS v4u*)((GAS v2u*)ROUTE + (size_t)tok * 128 + h * 16);
#pragma unroll
    for (int i = 0; i < 8; ++i) { const v2u e0 = *(LAS v2u*)(sb + (2 * i) * 512), e1 = *(LAS v2u*)(sb + (2 * i + 1) * 512); v4u o; o.x = e0.y; o.y = e0.x; o.z = e1.y; o.w = e1.x; rp[i] = o; }
    LDS_WAIT();
}

#define RT2_CE(a, b) { const int t0_ = (a), t1_ = (b); (a) = t0_ > t1_ ? t0_ : t1_; (b) = t0_ > t1_ ? t1_ : t0_; }
#define RT2_MX(a, b) ((a) > (b) ? (a) : (b))
#define RT2_SORT16(k, B) do { RT2_CE(k[(B) + 0], k[(B) + 13]); RT2_CE(k[(B) + 1], k[(B) + 12]); RT2_CE(k[(B) + 2], k[(B) + 15]); RT2_CE(k[(B) + 3], k[(B) + 14]); RT2_CE(k[(B) + 4], k[(B) + 8]); RT2_CE(k[(B) + 5], k[(B) + 6]); RT2_CE(k[(B) + 7], k[(B) + 11]); RT2_CE(k[(B) + 9], k[(B) + 10]); RT2_CE(k[(B) + 0], k[(B) + 5]); RT2_CE(k[(B) + 1], k[(B) + 7]); RT2_CE(k[(B) + 2], k[(B) + 9]); RT2_CE(k[(B) + 3], k[(B) + 4]); RT2_CE(k[(B) + 6], k[(B) + 13]); RT2_CE(k[(B) + 8], k[(B) + 14]); RT2_CE(k[(B) + 10], k[(B) + 15]); RT2_CE(k[(B) + 11], k[(B) + 12]); RT2_CE(k[(B) + 0], k[(B) + 1]); RT2_CE(k[(B) + 2], k[(B) + 3]); RT2_CE(k[(B) + 4], k[(B) + 5]); RT2_CE(k[(B) + 6], k[(B) + 8]); RT2_CE(k[(B) + 7], k[(B) + 9]); RT2_CE(k[(B) + 10], k[(B) + 11]); RT2_CE(k[(B) + 12], k[(B) + 13]); RT2_CE(k[(B) + 14], k[(B) + 15]); RT2_CE(k[(B) + 0], k[(B) + 2]); RT2_CE(k[(B) + 1], k[(B) + 3]); RT2_CE(k[(B) + 4], k[(B) + 10]); RT2_CE(k[(B) + 5], k[(B) + 11]); RT2_CE(k[(B) + 6], k[(B) + 7]); RT2_CE(k[(B) + 8], k[(B) + 9]); RT2_CE(k[(B) + 12], k[(B) + 14]); RT2_CE(k[(B) + 13], k[(B) + 15]); RT2_CE(k[(B) + 1], k[(B) + 2]); RT2_CE(k[(B) + 3], k[(B) + 12]); RT2_CE(k[(B) + 4], k[(B) + 6]); RT2_CE(k[(B) + 5], k[(B) + 7]); RT2_CE(k[(B) + 8], k[(B) + 10]); RT2_CE(k[(B) + 9], k[(B) + 11]); RT2_CE(k[(B) + 13], k[(B) + 14]); RT2_CE(k[(B) + 1], k[(B) + 4]); RT2_CE(k[(B) + 2], k[(B) + 6]); RT2_CE(k[(B) + 5], k[(B) + 8]); RT2_CE(k[(B) + 7], k[(B) + 10]); RT2_CE(k[(B) + 9], k[(B) + 13]); RT2_CE(k[(B) + 11], k[(B) + 14]); RT2_CE(k[(B) + 2], k[(B) + 4]); RT2_CE(k[(B) + 3], k[(B) + 6]); RT2_CE(k[(B) + 9], k[(B) + 12]); RT2_CE(k[(B) + 11], k[(B) + 13]); RT2_CE(k[(B) + 3], k[(B) + 5]); RT2_CE(k[(B) + 6], k[(B) + 8]); RT2_CE(k[(B) + 7], k[(B) + 9]); RT2_CE(k[(B) + 10], k[(B) + 12]); RT2_CE(k[(B) + 3], k[(B) + 4]); RT2_CE(k[(B) + 5], k[(B) + 6]); RT2_CE(k[(B) + 7], k[(B) + 8]); RT2_CE(k[(B) + 9], k[(B) + 10]); RT2_CE(k[(B) + 11], k[(B) + 12]); RT2_CE(k[(B) + 6], k[(B) + 7]); RT2_CE(k[(B) + 8], k[(B) + 9]); } while (0)
#define RT2_BIT16(k, B) do { RT2_CE(k[(B) + 0], k[(B) + 8]); RT2_CE(k[(B) + 1], k[(B) + 9]); RT2_CE(k[(B) + 2], k[(B) + 10]); RT2_CE(k[(B) + 3], k[(B) + 11]); RT2_CE(k[(B) + 4], k[(B) + 12]); RT2_CE(k[(B) + 5], k[(B) + 13]); RT2_CE(k[(B) + 6], k[(B) + 14]); RT2_CE(k[(B) + 7], k[(B) + 15]); RT2_CE(k[(B) + 0], k[(B) + 4]); RT2_CE(k[(B) + 1], k[(B) + 5]); RT2_CE(k[(B) + 2], k[(B) + 6]); RT2_CE(k[(B) + 3], k[(B) + 7]); RT2_CE(k[(B) + 8], k[(B) + 12]); RT2_CE(k[(B) + 9], k[(B) + 13]); RT2_CE(k[(B) + 10], k[(B) + 14]); RT2_CE(k[(B) + 11], k[(B) + 15]); RT2_CE(k[(B) + 0], k[(B) + 2]); RT2_CE(k[(B) + 1], k[(B) + 3]); RT2_CE(k[(B) + 4], k[(B) + 6]); RT2_CE(k[(B) + 5], k[(B) + 7]); RT2_CE(k[(B) + 8], k[(B) + 10]); RT2_CE(k[(B) + 9], k[(B) + 11]); RT2_CE(k[(B) + 12], k[(B) + 14]); RT2_CE(k[(B) + 13], k[(B) + 15]); RT2_CE(k[(B) + 0], k[(B) + 1]); RT2_CE(k[(B) + 2], k[(B) + 3]); RT2_CE(k[(B) + 4], k[(B) + 5]); RT2_CE(k[(B) + 6], k[(B) + 7]); RT2_CE(k[(B) + 8], k[(B) + 9]); RT2_CE(k[(B) + 10], k[(B) + 11]); RT2_CE(k[(B) + 12], k[(B) + 13]); RT2_CE(k[(B) + 14], k[(B) + 15]); } while (0)
#define RT2_HCLEAN(k, A, B) do { k[(A) + 0] = RT2_MX(k[(A) + 0], k[(B) + 15]); k[(A) + 1] = RT2_MX(k[(A) + 1], k[(B) + 14]); k[(A) + 2] = RT2_MX(k[(A) + 2], k[(B) + 13]); k[(A) + 3] = RT2_MX(k[(A) + 3], k[(B) + 12]); k[(A) + 4] = RT2_MX(k[(A) + 4], k[(B) + 11]); k[(A) + 5] = RT2_MX(k[(A) + 5], k[(B) + 10]); k[(A) + 6] = RT2_MX(k[(A) + 6], k[(B) + 9]); k[(A) + 7] = RT2_MX(k[(A) + 7], k[(B) + 8]); k[(A) + 8] = RT2_MX(k[(A) + 8], k[(B) + 7]); k[(A) + 9] = RT2_MX(k[(A) + 9], k[(B) + 6]); k[(A) + 10] = RT2_MX(k[(A) + 10], k[(B) + 5]); k[(A) + 11] = RT2_MX(k[(A) + 11], k[(B) + 4]); k[(A) + 12] = RT2_MX(k[(A) + 12], k[(B) + 3]); k[(A) + 13] = RT2_MX(k[(A) + 13], k[(B) + 2]); k[(A) + 14] = RT2_MX(k[(A) + 14], k[(B) + 1]); k[(A) + 15] = RT2_MX(k[(A) + 15], k[(B) + 0]); } while (0)
#define RT2_TOP16_OF_128(k) do { RT2_SORT16(k, 0); RT2_SORT16(k, 16); RT2_SORT16(k, 32); RT2_SORT16(k, 48); RT2_SORT16(k, 64); RT2_SORT16(k, 80); RT2_SORT16(k, 96); RT2_SORT16(k, 112); RT2_HCLEAN(k, 0, 16); RT2_BIT16(k, 0); RT2_HCLEAN(k, 32, 48); RT2_BIT16(k, 32); RT2_HCLEAN(k, 64, 80); RT2_BIT16(k, 64); RT2_HCLEAN(k, 96, 112); RT2_BIT16(k, 96); RT2_HCLEAN(k, 0, 32); RT2_BIT16(k, 0); RT2_HCLEAN(k, 64, 96); RT2_BIT16(k, 64); RT2_HCLEAN(k, 0, 64); RT2_BIT16(k, 0); } while (0)
#define RT2_BUILD_CANDS(c) do { c[0] = RT2_CK(0, 0); c[1] = RT2_CK(0, 1); c[2] = RT2_CK(0, 2); c[3] = RT2_CK(0, 3); c[4] = RT2_CK(0, 4); c[5] = RT2_CK(0, 5); c[6] = RT2_CK(0, 6); c[7] = RT2_CK(0, 7); c[8] = RT2_CK(0, 8); c[9] = RT2_CK(0, 9); c[10] = RT2_CK(0, 10); c[11] = RT2_CK(0, 11); c[12] = RT2_CK(0, 12); c[13] = RT2_CK(0, 13); c[14] = RT2_CK(0, 14); c[15] = RT2_CK(0, 15); c[16] = RT2_CK(1, 0); c[17] = RT2_CK(1, 1); c[18] = RT2_CK(1, 2); c[19] = RT2_CK(1, 3); c[20] = RT2_CK(1, 4); c[21] = RT2_CK(1, 5); c[22] = RT2_CK(1, 6); c[23] = RT2_CK(1, 7); c[24] = RT2_CK(15, 0); c[25] = RT2_CK(14, 0); c[26] = RT2_CK(13, 0); c[27] = RT2_CK(12, 0); c[28] = RT2_CK(11, 0); c[29] = RT2_CK(10, 0); c[30] = RT2_CK(9, 0); c[31] = RT2_CK(8, 0); c[32] = RT2_CK(2, 0); c[33] = RT2_CK(2, 1); c[34] = RT2_CK(2, 2); c[35] = RT2_CK(2, 3); c[36] = RT2_CK(2, 4); c[37] = RT2_CK(3, 0); c[38] = RT2_CK(3, 1); c[39] = RT2_CK(3, 2); c[40] = RT2_CK(3, 3); c[41] = RT2_CK(4, 0); c[42] = RT2_CK(4, 1); c[43] = RT2_CK(4, 2); c[44] = RT2_CK(5, 0); c[45] = RT2_CK(5, 1); c[46] = RT2_CK(6, 0); c[47] = RT2_CK(6, 1); } while (0)
__device__ __forceinline__ int rt2_tr(int u) { return u ^ (int)((unsigned)(u >> 31) >> 1); }
__device__ __forceinline__ int rt2_key(float x, int code, int mask) { return (rt2_tr(__builtin_bit_cast(int, x)) & ~mask) | code; }
__device__ __forceinline__ int rt2_key16(unsigned hbits_hi, int code) { return (rt2_tr((int)hbits_hi) & (int)0xffff0000) | code; }
__device__ __forceinline__ float rt2_val16(int k) { const unsigned u = (unsigned)rt2_tr(k) >> 16; return (float)__builtin_bit_cast(_Float16, (unsigned short)u); }
__device__ __forceinline__ void route_task(const unsigned short* SCT, v2u* ROUTE, int tok0, int h, LAS unsigned char* scr, int lane) {
    const int tok = tok0 + lane;
    LAS unsigned char* sb = scr + lane * 4;
#pragma unroll 1
    for (int p = 0; p < 2; ++p) {
        const int g = 2 * h + p; int k[128];
        const unsigned voff = (unsigned)tok * 16u;
#pragma unroll
        for (int q8 = 0; q8 < 16; ++q8) { const char* bq = (const char*)SCT + ((size_t)(g * 16 + q8) * M) * 16; const v4u q = *(const GAS v4u*)(bq + voff);
            k[8 * q8 + 0] = rt2_key16(q.x << 16, 127 - 8 * q8); k[8 * q8 + 1] = rt2_key16(q.x, 126 - 8 * q8); k[8 * q8 + 2] = rt2_key16(q.y << 16, 125 - 8 * q8); k[8 * q8 + 3] = rt2_key16(q.y, 124 - 8 * q8);
            k[8 * q8 + 4] = rt2_key16(q.z << 16, 123 - 8 * q8); k[8 * q8 + 5] = rt2_key16(q.z, 122 - 8 * q8); k[8 * q8 + 6] = rt2_key16(q.w << 16, 121 - 8 * q8); k[8 * q8 + 7] = rt2_key16(q.w, 120 - 8 * q8); }
        RT2_TOP16_OF_128(k);
#pragma unroll
        for (int i = 0; i < 16; ++i) *(LAS int*)(sb + (p * 16 + i) * 256) = k[i];
    }
    LDS_WAIT();
    float af[16], bf[16];
#pragma unroll
    for (int i = 0; i < 16; ++i) { af[i] = rt2_val16(*(const LAS int*)(sb + i * 256)); bf[i] = rt2_val16(*(const LAS int*)(sb + (16 + i) * 256)); }
    int c[48];
#define RT2_CK(i, j) rt2_key(af[i] + bf[j], 255 - (16 * (i) + (j)), 255)
    RT2_BUILD_CANDS(c);
    const int r7a = RT2_CK(7, 0), r7b = RT2_CK(7, 1);
#undef RT2_CK
    RT2_BIT16(c, 16);
    RT2_SORT16(c, 32);
    RT2_HCLEAN(c, 0, 16); RT2_BIT16(c, 0);
    c[46] = RT2_MX(c[46], r7b); c[47] = RT2_MX(c[47], r7a); RT2_BIT16(c, 32);
    RT2_HCLEAN(c, 0, 32);
    GAS v4u* rp = (GAS v4u*)((GAS v2u*)ROUTE + (size_t)tok * 128 + h * 16);
#pragma unroll
    for (int i = 0; i < 8; ++i) { v4u o;
        { const int ij = (~c[2 * i]) & 255; const int ka = *(const LAS int*)(sb + ((ij >> 4) << 8)), kb = *(const LAS int*)(sb + 4096 + ((ij & 15) << 8));
          o.x = (unsigned)(((~ka) & 127) * 128 + ((~kb) & 127)); o.y = __builtin_bit_cast(unsigned, rt2_val16(ka) + rt2_val16(kb)); }
        { const int ij = (~c[2 * i + 1]) & 255; const int ka = *(const LAS int*)(sb + ((ij >> 4) << 8)), kb = *(const LAS int*)(sb + 4096 + ((ij & 15) << 8));
          o.z = (unsigned)(((~ka) & 127) * 128 + ((~kb) & 127)); o.w = __builtin_bit_cast(unsigned, rt2_val16(ka) + rt2_val16(kb)); }
        rp[i] = o; }
    LDS_WAIT();
}

#define DPPF(v, ctrl) __builtin_bit_cast(float, __builtin_amdgcn_update_dpp(0, __builtin_bit_cast(int, (v)), (ctrl), 0xf, 0xf, true))
__device__ __forceinline__ float wave_max_f(float m) {
#pragma unroll
    for (int o = 1; o < 64; o <<= 1) m = __builtin_fmaxf(m, __shfl_xor(m, o));
    return m;
}
template <int NV> __device__ __forceinline__ void select16(const float (&v)[NV], bool (&sel)[NV], int (&pos)[NV]) {
    float mx = v[0], mn = v[0];
#pragma unroll
    for (int i = 1; i < NV; ++i) { mx = __builtin_fmaxf(mx, v[i]); mn = __builtin_fminf(mn, v[i]); }
    mx = wave_max_f(mx); mn = -wave_max_f(-mn);
    float lo = mn, hi = mx, Tv;
    { int c = 0;
#pragma unroll
      for (int i = 0; i < NV; ++i) c += __popcll(__ballot(v[i] >= mx));
      if (c >= 16) { Tv = mx; }
      else {
        Tv = lo;
        for (int it = 0; it < 300; ++it) {
            const float mid = 0.5f * lo + 0.5f * hi;
            if (!(mid > lo && mid < hi)) { Tv = lo; break; }
            int cc = 0;
#pragma unroll
            for (int i = 0; i < NV; ++i) cc += __popcll(__ballot(v[i] >= mid));
            if (cc == 16) { Tv = mid; break; }
            if (cc > 16) lo = mid; else hi = mid;
            Tv = lo;
        }
      }
    }
    int cgt = 0;
#pragma unroll
    for (int i = 0; i < NV; ++i) cgt += __popcll(__ballot(v[i] > Tv));
    const int need = 16 - cgt;
    int eqbelow = 0;
#pragma unroll
    for (int i = 0; i < NV; ++i) { const unsigned long long m = __ballot(v[i] == Tv); eqbelow += __builtin_amdgcn_mbcnt_hi((unsigned)(m >> 32), __builtin_amdgcn_mbcnt_lo((unsigned)m, 0u)); }
    int eqown = 0;
#pragma unroll
    for (int i = 0; i < NV; ++i) { const bool eq = (v[i] == Tv); sel[i] = (v[i] > Tv) || (eq && (eqbelow + eqown) < need); eqown += eq ? 1 : 0; }
    int selbelow = 0;
#pragma unroll
    for (int i = 0; i < NV; ++i) { const unsigned long long m = __ballot(sel[i]); selbelow += __builtin_amdgcn_mbcnt_hi((unsigned)(m >> 32), __builtin_amdgcn_mbcnt_lo((unsigned)m, 0u)); }
    int own = 0;
#pragma unroll
    for (int i = 0; i < NV; ++i) { pos[i] = selbelow + own; own += sel[i] ? 1 : 0; }
}

__device__ __forceinline__ float gelu_exact(float a) { return 0.5f * a * (1.0f + erff(a * 0.7071067811865476f)); }

__device__ __forceinline__ void fp8_row_dot(const v4u q, const float (&xr)[16], float& s) {
    const f32x2 a0 = __builtin_amdgcn_cvt_pk_f32_fp8((int)q.x, false), a1 = __builtin_amdgcn_cvt_pk_f32_fp8((int)q.x, true), a2 = __builtin_amdgcn_cvt_pk_f32_fp8((int)q.y, false), a3 = __builtin_amdgcn_cvt_pk_f32_fp8((int)q.y, true);
    const f32x2 b0 = __builtin_amdgcn_cvt_pk_f32_fp8((int)q.z, false), b1 = __builtin_amdgcn_cvt_pk_f32_fp8((int)q.z, true), b2 = __builtin_amdgcn_cvt_pk_f32_fp8((int)q.w, false), b3 = __builtin_amdgcn_cvt_pk_f32_fp8((int)q.w, true);
    f32x2 t = a0 * (f32x2){xr[0], xr[1]};
    t = __builtin_elementwise_fma(a1, (f32x2){xr[2], xr[3]}, t); t = __builtin_elementwise_fma(a2, (f32x2){xr[4], xr[5]}, t); t = __builtin_elementwise_fma(a3, (f32x2){xr[6], xr[7]}, t);
    t = __builtin_elementwise_fma(b0, (f32x2){xr[8], xr[9]}, t); t = __builtin_elementwise_fma(b1, (f32x2){xr[10], xr[11]}, t); t = __builtin_elementwise_fma(b2, (f32x2){xr[12], xr[13]}, t); t = __builtin_elementwise_fma(b3, (f32x2){xr[14], xr[15]}, t);
    s = t.x + t.y;
}
__device__ __forceinline__ void fp8_row_axpy2(const v4u q, const float w, f32x2 (&acc)[8]) {
    const f32x2 a0 = __builtin_amdgcn_cvt_pk_f32_fp8((int)q.x, false), a1 = __builtin_amdgcn_cvt_pk_f32_fp8((int)q.x, true), a2 = __builtin_amdgcn_cvt_pk_f32_fp8((int)q.y, false), a3 = __builtin_amdgcn_cvt_pk_f32_fp8((int)q.y, true);
    const f32x2 b0 = __builtin_amdgcn_cvt_pk_f32_fp8((int)q.z, false), b1 = __builtin_amdgcn_cvt_pk_f32_fp8((int)q.z, true), b2 = __builtin_amdgcn_cvt_pk_f32_fp8((int)q.w, false), b3 = __builtin_amdgcn_cvt_pk_f32_fp8((int)q.w, true);
    const f32x2 ww = {w, w};
    acc[0] = __builtin_elementwise_fma(a0, ww, acc[0]); acc[1] = __builtin_elementwise_fma(a1, ww, acc[1]); acc[2] = __builtin_elementwise_fma(a2, ww, acc[2]); acc[3] = __builtin_elementwise_fma(a3, ww, acc[3]);
    acc[4] = __builtin_elementwise_fma(b0, ww, acc[4]); acc[5] = __builtin_elementwise_fma(b1, ww, acc[5]); acc[6] = __builtin_elementwise_fma(b2, ww, acc[6]); acc[7] = __builtin_elementwise_fma(b3, ww, acc[7]);
}
__device__ __forceinline__ void fp8_row_axpy(const v4u q, const float w, float (&acc)[16]) {
    const f32x2 a0 = __builtin_amdgcn_cvt_pk_f32_fp8((int)q.x, false), a1 = __builtin_amdgcn_cvt_pk_f32_fp8((int)q.x, true), a2 = __builtin_amdgcn_cvt_pk_f32_fp8((int)q.y, false), a3 = __builtin_amdgcn_cvt_pk_f32_fp8((int)q.y, true);
    const f32x2 b0 = __builtin_amdgcn_cvt_pk_f32_fp8((int)q.z, false), b1 = __builtin_amdgcn_cvt_pk_f32_fp8((int)q.z, true), b2 = __builtin_amdgcn_cvt_pk_f32_fp8((int)q.w, false), b3 = __builtin_amdgcn_cvt_pk_f32_fp8((int)q.w, true);
    acc[0] += w * a0.x; acc[1] += w * a0.y; acc[2] += w * a1.x; acc[3] += w * a1.y; acc[4] += w * a2.x; acc[5] += w * a2.y; acc[6] += w * a3.x; acc[7] += w * a3.y;
    acc[8] += w * b0.x; acc[9] += w * b0.y; acc[10] += w * b1.x; acc[11] += w * b1.y; acc[12] += w * b2.x; acc[13] += w * b2.y; acc[14] += w * b3.x; acc[15] += w * b3.y;
}
__device__ __forceinline__ void fp8_convert_row(const float* src, const float* gain, unsigned char* dst, float* inv_scale, int lane, int sliced, int e) {
    const GAS f32x4* sp = (const GAS f32x4*)src; float v[16];
#pragma unroll
    for (int j = 0; j < 2; ++j) { f32x4 a = sp[2 * lane + 128 * j], b = sp[2 * lane + 128 * j + 1];
        if (gain) { const GAS f32x4* gp = (const GAS f32x4*)gain; const f32x4 ga = gp[2 * lane + 128 * j], gb = gp[2 * lane + 128 * j + 1]; a = a * ga; b = b * gb; }
        v[8 * j + 0] = a.x; v[8 * j + 1] = a.y; v[8 * j + 2] = a.z; v[8 * j + 3] = a.w; v[8 * j + 4] = b.x; v[8 * j + 5] = b.y; v[8 * j + 6] = b.z; v[8 * j + 7] = b.w; }
    float am = 0.f;
#pragma unroll
    for (int i = 0; i < 16; ++i) am = __builtin_fmaxf(am, __builtin_fabsf(v[i]));
    am = wave_max_f(am);
    const float sc = (am > 0.f) ? 384.0f / am : 1.0f, inv = (am > 0.f) ? am * (1.0f / 384.0f) : 1.0f;
    v4u q;
    { int w = __builtin_amdgcn_cvt_pk_fp8_f32(v[0] * sc, v[1] * sc, 0, false); w = __builtin_amdgcn_cvt_pk_fp8_f32(v[2] * sc, v[3] * sc, w, true); q.x = (unsigned)w; }
    { int w = __builtin_amdgcn_cvt_pk_fp8_f32(v[4] * sc, v[5] * sc, 0, false); w = __builtin_amdgcn_cvt_pk_fp8_f32(v[6] * sc, v[7] * sc, w, true); q.y = (unsigned)w; }
    { int w = __builtin_amdgcn_cvt_pk_fp8_f32(v[8] * sc, v[9] * sc, 0, false); w = __builtin_amdgcn_cvt_pk_fp8_f32(v[10] * sc, v[11] * sc, w, true); q.z = (unsigned)w; }
    { int w = __builtin_amdgcn_cvt_pk_fp8_f32(v[12] * sc, v[13] * sc, 0, false); w = __builtin_amdgcn_cvt_pk_fp8_f32(v[14] * sc, v[15] * sc, w, true); q.w = (unsigned)w; }
    if (!sliced) ((GAS v4u*)dst)[lane] = q;
    else { v2u q0, q1; q0.x = q.x; q0.y = q.y; q1.x = q.z; q1.y = q.w; const int s0 = lane >> 4, o8 = 8 * (lane & 15);
        *(GAS v2u*)(dst + ((size_t)s0 * NEXP + e) * 128 + o8) = q0; *(GAS v2u*)(dst + ((size_t)(s0 + 4) * NEXP + e) * 128 + o8) = q1; }
    if (lane == 0) *inv_scale = inv;
}

#define PIN_ACC2(b) asm volatile("" : "+v"(b), "+v"(acc2[0]), "+v"(acc2[1]), "+v"(acc2[2]), "+v"(acc2[3]), "+v"(acc2[4]), "+v"(acc2[5]), "+v"(acc2[6]), "+v"(acc2[7]))
#define PIN_ACC(b) asm volatile("" : "+v"(b), "+v"(acc[0]), "+v"(acc[1]), "+v"(acc[2]), "+v"(acc[3]), "+v"(acc[4]), "+v"(acc[5]), "+v"(acc[6]), "+v"(acc[7]), "+v"(acc[8]), "+v"(acc[9]), "+v"(acc[10]), "+v"(acc[11]), "+v"(acc[12]), "+v"(acc[13]), "+v"(acc[14]), "+v"(acc[15]))
#define PC_META_U(tk) do { const char* rb_ = (const char*)route + (size_t)(tk) * 1024; m_e0 = *(const GAS int*)(rb_ + l8); m_e1 = *(const GAS int*)(rb_ + 512 + l8); } while (0)
#define PC_ISSUE_U(buf, xs, par, tk) do { LAS int* lid_ = (LAS int*)(scr + (par) * 512); lid_[lane] = m_e0; lid_[lane + 64] = m_e1; LDS_WAIT(); \
        { const GAS f32x4* xq_ = (const GAS f32x4*)(x1 + (size_t)(tk) * D + 128 * s + 16 * c); const f32x4 x0_ = xq_[0], x1_ = xq_[1], x2_ = xq_[2], x3_ = xq_[3]; \
          xs[0] = x0_.x; xs[1] = x0_.y; xs[2] = x0_.z; xs[3] = x0_.w; xs[4] = x1_.x; xs[5] = x1_.y; xs[6] = x1_.z; xs[7] = x1_.w; xs[8] = x2_.x; xs[9] = x2_.y; xs[10] = x2_.z; xs[11] = x2_.w; xs[12] = x3_.x; xs[13] = x3_.y; xs[14] = x3_.z; xs[15] = x3_.w; } \
        _Pragma("unroll") for (int k = 0; k < 16; ++k) { const int e_ = lid_[8 * k + r]; buf[k] = *(const GAS v4u*)(tbs + (unsigned)(e_ * 128)); } } while (0)
#define PC_COMPUTE_U(buf, xs, tk) do { float p_[16]; \
        _Pragma("unroll") for (int k = 0; k < 16; ++k) { if (k) asm volatile("" : "+v"(buf[k]), "+v"(p_[k ? k - 1 : 0])); else asm volatile("" : "+v"(buf[k])); fp8_row_dot(buf[k], xs, p_[k]); } \
        float q8_[8], q4_[4], q2_[2]; \
        _Pragma("unroll") for (int k = 0; k < 8; ++k) { const float send = c2 ? p_[k] : p_[k + 8], keep = c2 ? p_[k + 8] : p_[k]; q8_[k] = keep + __shfl_xor(send, 4); } \
        _Pragma("unroll") for (int k = 0; k < 4; ++k) { const float send = c1 ? q8_[k] : q8_[k + 4], keep = c1 ? q8_[k + 4] : q8_[k]; q4_[k] = keep + __shfl_xor(send, 2); } \
        _Pragma("unroll") for (int k = 0; k < 2; ++k) { const float send = c0 ? q4_[k] : q4_[k + 2], keep = c0 ? q4_[k + 2] : q4_[k]; q2_[k] = keep + __shfl_xor(send, 1); } \
        GAS float* up_ = (GAS float*)(Upart + ((size_t)s * M + (tk)) * 128 + 64 * c2 + 32 * c1 + 16 * c0 + r); up_[0] = q2_[0]; up_[8] = q2_[1]; } while (0)
__device__ __forceinline__ void peer_u_phase(int s, int tok0, int tstride, int nitems, const v2u* route, const float* x1, const unsigned char* TU8s, float* Upart, LAS unsigned char* scr, int lane) {
    const int r = lane >> 3, c = lane & 7, c2 = (lane >> 2) & 1, c1 = (lane >> 1) & 1, c0 = lane & 1; const unsigned l8 = (unsigned)lane * 8u;
    const char* tbs = (const char*)TU8s + (size_t)s * NEXP * 128 + 16 * c;
    int m_e0, m_e1;
    v4u bufA[16], bufB[16]; float xsA[16], xsB[16];
    PC_META_U(tok0); PC_ISSUE_U(bufA, xsA, 0, tok0); if (nitems > 1) PC_META_U(tok0 + tstride);
#pragma unroll 1
    for (int i = 0; i < nitems; i += 2) {
        const int tk = tok0 + i * tstride;
        if (i + 1 < nitems) PC_ISSUE_U(bufB, xsB, 1, tk + tstride);
        if (i + 2 < nitems) PC_META_U(tk + 2 * tstride);
        PC_COMPUTE_U(bufA, xsA, tk);
        if (i + 1 < nitems) {
            if (i + 2 < nitems) PC_ISSUE_U(bufA, xsA, 0, tk + 2 * tstride);
            if (i + 3 < nitems) PC_META_U(tk + 3 * tstride);
            PC_COMPUTE_U(bufB, xsB, tk + tstride);
        }
    }
    LDS_WAIT();
}
#define PD_META_U(tk) do { const char* rb_ = (const char*)route + (size_t)(tk) * 1024; m_e0 = *(const GAS int*)(rb_ + l8); m_e1 = *(const GAS int*)(rb_ + 512 + l8); \
        { const unsigned xw_ = *(const GAS unsigned*)((const bf16*)x1 + (size_t)(tk) * D + 128 * s + 2 * lane); m_x.x = bflo(xw_); m_x.y = bfhi(xw_); } } while (0)
#define PD_ISSUE_U(buf, xq, xinv, par) do { LAS int* lid_ = (LAS int*)(scr + (par) * 1024); LAS unsigned short* lx_ = (LAS unsigned short*)(scr + (par) * 1024 + 512); lid_[lane] = m_e0; lid_[lane + 64] = m_e1; LDS_WAIT(); \
        _Pragma("unroll") for (int k = 0; k < 16; ++k) { const int e_ = lid_[8 * k + r]; buf[k] = *(const GAS v4u*)(tbs + (unsigned)(e_ * 128)); } \
        { float am_ = __builtin_fmaxf(__builtin_fabsf(m_x.x), __builtin_fabsf(m_x.y)); \
          _Pragma("unroll") for (int o_ = 1; o_ < 64; o_ <<= 1) am_ = __builtin_fmaxf(am_, __shfl_xor(am_, o_)); \
          const float sc_ = (am_ > 0.f) ? 127.0f / am_ : 0.f; xinv = am_ * (1.0f / 127.0f); \
          const int q0_ = (int)__builtin_rintf(m_x.x * sc_), q1_ = (int)__builtin_rintf(m_x.y * sc_); lx_[lane] = (unsigned short)(((unsigned)q0_ & 255u) | (((unsigned)q1_ & 255u) << 8)); } \
        LDS_WAIT(); xq = *(const LAS v4u*)((LAS unsigned char*)lx_ + 16 * c); } while (0)
#define PD_COMPUTE_U(buf, xq, xinv, tk) do { int p_[16]; \
        _Pragma("unroll") for (int k = 0; k < 16; ++k) { int a_ = __builtin_amdgcn_sdot4((int)buf[k].x, (int)xq.x, 0, false); a_ = __builtin_amdgcn_sdot4((int)buf[k].y, (int)xq.y, a_, false); \
            a_ = __builtin_amdgcn_sdot4((int)buf[k].z, (int)xq.z, a_, false); a_ = __builtin_amdgcn_sdot4((int)buf[k].w, (int)xq.w, a_, false); p_[k] = a_; } \
          \
        LAS int* red_ = (LAS int*)(scr + 2048); \
        _Pragma("unroll") for (int k = 0; k < 16; ++k) red_[64 * k + lane] = p_[k]; \
        LDS_WAIT(); \
        const v4u ra_ = *(const LAS v4u*)(red_ + 8 * lane + rsw), rb_ = *(const LAS v4u*)(red_ + 8 * lane + (4 - rsw)), rc_ = *(const LAS v4u*)(red_ + 512 + 8 * lane + rsw), rd_ = *(const LAS v4u*)(red_ + 512 + 8 * lane + (4 - rsw)); \
        const int s0_ = (int)(ra_.x + ra_.y + ra_.z + ra_.w + rb_.x + rb_.y + rb_.z + rb_.w), s1_ = (int)(rc_.x + rc_.y + rc_.z + rc_.w + rd_.x + rd_.y + rd_.z + rd_.w); \
        GAS bf16* up_ = (GAS bf16*)Upart + ((size_t)s * M + (tk)) * 128 + lane; const unsigned pk_ = cvtpk((float)s0_ * xinv, (float)s1_ * xinv); up_[0] = (bf16)(pk_ & 0xffffu); up_[64] = (bf16)(pk_ >> 16); } while (0)
__device__ __forceinline__ void peer_u_phase_dot4(int s, int tok0, int tstride, int nitems, const v2u* route, const float* x1, const unsigned char* TU8s, float* Upart, LAS unsigned char* scr, int lane) {
    const int r = lane >> 3, c = lane & 7, rsw = 4 * ((lane >> 3) & 1); const unsigned l8 = (unsigned)lane * 8u;
    const char* tbs = (const char*)TU8s + (size_t)s * NEXP * 128 + 16 * c;
    int m_e0, m_e1; f32x2 m_x;
    v4u bufA[16], bufB[16], xqA, xqB; float xiA, xiB;
    PD_META_U(tok0); PD_ISSUE_U(bufA, xqA, xiA, 0); if (nitems > 1) PD_META_U(tok0 + tstride);
#pragma unroll 1
    for (int it = 0; it < nitems; it += 2) {
        const int tk = tok0 + it * tstride;
        if (it + 1 < nitems) PD_ISSUE_U(bufB, xqB, xiB, 1);
        if (it + 2 < nitems) PD_META_U(tk + 2 * tstride);
        PD_COMPUTE_U(bufA, xqA, xiA, tk);
        if (it + 1 < nitems) {
            if (it + 2 < nitems) PD_ISSUE_U(bufA, xqA, xiA, 0);
            if (it + 3 < nitems) PD_META_U(tk + 3 * tstride);
            PD_COMPUTE_U(bufB, xqB, xiB, tk + tstride);
        }
    }
    LDS_WAIT();
}
__device__ __forceinline__ void peer_w_token(int tok, const v2u* route, const float* x1, const float* Upart, const float* SU, const float* SV, float* W, int lane) {
    const GAS f32x4* xp = (const GAS f32x4*)(x1 + (size_t)tok * D) + lane; float ssq = 0.f;
#pragma unroll
    for (int j = 0; j < 4; ++j) { const f32x4 q = xp[64 * j]; ssq += (q.x * q.x + q.y * q.y) + (q.z * q.z + q.w * q.w); }
    const float rstd2 = 1.0f / sqrtf(wave_sum(ssq) * (1.0f / D) + RMS_EPS);
    const char* rb_ = (const char*)route + (size_t)tok * 1024; const unsigned l8_ = (unsigned)lane * 8u;
    const v2u r_lo = *(const GAS v2u*)(rb_ + l8_), r_hi = *(const GAS v2u*)(rb_ + 512 + l8_);
    float g_lo, g_hi;
#pragma unroll
    for (int half = 0; half < 2; ++half) {
        const float sc_ = __builtin_bit_cast(float, half ? r_hi.y : r_lo.y) * rstd2; float m_ = sc_;
#pragma unroll
        for (int o = 1; o < 16; o <<= 1) m_ = __builtin_fmaxf(m_, __shfl_xor(m_, o));
        const float p_ = __builtin_amdgcn_exp2f((sc_ - m_) * 1.4426950408889634f); float sum_ = p_;
#pragma unroll
        for (int o = 1; o < 16; o <<= 1) sum_ += __shfl_xor(sum_, o);
        if (half) g_hi = p_ / sum_; else g_lo = p_ / sum_;
    }
    asm volatile("" : "+v"(g_lo), "+v"(g_hi));
#pragma unroll
    for (int half = 0; half < 2; ++half) {
        const int e = (int)(half ? r_hi.x : r_lo.x); const int n = lane + 64 * half;
        float dot = 0.f;
#pragma unroll
        for (int s8 = 0; s8 < 8; ++s8) dot += Upart[((size_t)s8 * M + tok) * 128 + n];
        const float act = gelu_exact(dot * SU[e] * rstd2);
        W[(size_t)tok * 128 + n] = (half ? g_hi : g_lo) * act * SV[e];
    }
}
__device__ __forceinline__ void peer_w_token2(int tokA, int tokB, const v2u* route, const bf16* x1b, const bf16* Upart, const float* SU, const float* SV, float* W, int lane) {
    v4u xv[2][2]; v2u r_lo[2], r_hi[2]; unsigned short ub[2][2][8];
#pragma unroll
    for (int t = 0; t < 2; ++t) { const int tok = t ? tokB : tokA;
        const GAS v4u* xp = (const GAS v4u*)(x1b + (size_t)tok * D) + lane; xv[t][0] = xp[0]; xv[t][1] = xp[64];
        const char* rb_ = (const char*)route + (size_t)tok * 1024; const unsigned l8_ = (unsigned)lane * 8u;
        r_lo[t] = *(const GAS v2u*)(rb_ + l8_); r_hi[t] = *(const GAS v2u*)(rb_ + 512 + l8_);
#pragma unroll
        for (int half = 0; half < 2; ++half)
#pragma unroll
            for (int s8 = 0; s8 < 8; ++s8) ub[t][half][s8] = *(const GAS bf16*)(Upart + ((size_t)s8 * M + tok) * 128 + lane + 64 * half); }
#pragma unroll
    for (int t = 0; t < 2; ++t) { const int tok = t ? tokB : tokA;
        float ssq = 0.f;
#pragma unroll
        for (int j = 0; j < 2; ++j) { const v4u q = xv[t][j];
            ssq += (bflo(q.x) * bflo(q.x) + bfhi(q.x) * bfhi(q.x)) + (bflo(q.y) * bflo(q.y) + bfhi(q.y) * bfhi(q.y)) + (bflo(q.z) * bflo(q.z) + bfhi(q.z) * bfhi(q.z)) + (bflo(q.w) * bflo(q.w) + bfhi(q.w) * bfhi(q.w)); }
        const float rstd2 = 1.0f / sqrtf(wave_sum(ssq) * (1.0f / D) + RMS_EPS);
        float g_lo, g_hi;
#pragma unroll
        for (int half = 0; half < 2; ++half) {
            const float sc_ = __builtin_bit_cast(float, half ? r_hi[t].y : r_lo[t].y) * rstd2; float m_ = sc_;
#pragma unroll
            for (int o = 1; o < 16; o <<= 1) m_ = __builtin_fmaxf(m_, __shfl_xor(m_, o));
            const float p_ = __builtin_amdgcn_exp2f((sc_ - m_) * 1.4426950408889634f); float sum_ = p_;
#pragma unroll
            for (int o = 1; o < 16; o <<= 1) sum_ += __shfl_xor(sum_, o);
            if (half) g_hi = p_ / sum_; else g_lo = p_ / sum_;
        }
        asm volatile("" : "+v"(g_lo), "+v"(g_hi));
#pragma unroll
        for (int half = 0; half < 2; ++half) {
            const int e = (int)(half ? r_hi[t].x : r_lo[t].x); const int n = lane + 64 * half;
            float dot = 0.f;
#pragma unroll
            for (int s8 = 0; s8 < 8; ++s8) dot += __builtin_bit_cast(float, (unsigned)ub[t][half][s8] << 16);
            const float act = gelu_exact(dot * SU[e] * rstd2);
            W[(size_t)tok * 128 + n] = (half ? g_hi : g_lo) * act * SV[e];
        }
    }
}
#define PC_META_V(tk) do { const char* rb_ = (const char*)route + (size_t)(tk) * 1024; m_e0 = *(const GAS int*)(rb_ + l8); m_e1 = *(const GAS int*)(rb_ + 512 + l8); \
        const GAS float* wp_ = (const GAS float*)(W + (size_t)(tk) * 128); m_w0 = wp_[lane]; m_w1 = wp_[lane + 64]; m_xv = *(const GAS unsigned*)(xres + (size_t)(tk) * D + col0); } while (0)
#define PC_ISSUE_V(buf, wk, xv, par) do { LAS int* lid_ = (LAS int*)(scr + (par) * 1024); LAS float* lw_ = (LAS float*)(scr + (par) * 1024 + 512); lid_[lane] = m_e0; lid_[lane + 64] = m_e1; lw_[lane] = m_w0; lw_[lane + 64] = m_w1; LDS_WAIT(); xv = m_xv; \
        _Pragma("unroll") for (int k = 0; k < 16; ++k) { const int e_ = lid_[8 * k + r]; wk[k] = lw_[8 * k + r]; buf[k] = *(const GAS v4u*)(tbs + (unsigned)(e_ * 128)); } } while (0)
#define PC_COMPUTE_V(buf, wk, xv, tk) do { f32x2 acc2[8]; _Pragma("unroll") for (int i_ = 0; i_ < 8; ++i_) acc2[i_] = (f32x2){0.f, 0.f}; \
        _Pragma("unroll") for (int k = 0; k < 16; ++k) { PIN_ACC2(buf[k]); fp8_row_axpy2(buf[k], wk[k], acc2); } \
          \
        LAS float* red_ = (LAS float*)(scr + 2048); LAS f32x4* wp_ = (LAS f32x4*)(red_ + 128 * r + 16 * c); \
        _Pragma("unroll") for (int j_ = 0; j_ < 4; ++j_) { f32x4 t_; t_.x = acc2[2 * j_].x; t_.y = acc2[2 * j_].y; t_.z = acc2[2 * j_ + 1].x; t_.w = acc2[2 * j_ + 1].y; wp_[j_] = t_; } \
        LDS_WAIT(); \
        f32x2 o_; o_.x = bflo(xv); o_.y = bfhi(xv); \
        _Pragma("unroll") for (int rr_ = 0; rr_ < 8; ++rr_) { const f32x2 t_ = *(const LAS f32x2*)(red_ + 128 * rr_ + 2 * lane); o_.x += t_.x; o_.y += t_.y; } \
        *(GAS f32x2*)(xio + (size_t)(tk) * D + col0) = o_; } while (0)
__device__ __forceinline__ void peer_v_phase(int s, int tok0, int tstride, int nitems, const v2u* route, const float* W, const unsigned char* TV8s, const bf16* xres, float* xio, float* SS, LAS unsigned char* scr, int lane) {
    const int r = lane >> 3, c = lane & 7; const unsigned l8 = (unsigned)lane * 8u;
    const int col0 = 128 * s + 2 * lane;
    const char* tbs = (const char*)TV8s + (size_t)s * NEXP * 128 + 16 * c;
    int m_e0, m_e1; float m_w0, m_w1; unsigned m_xv;
    v4u bufA[16], bufB[16]; float wA[16], wB[16]; unsigned xvA, xvB;
    PC_META_V(tok0); PC_ISSUE_V(bufA, wA, xvA, 0); if (nitems > 1) PC_META_V(tok0 + tstride);
#pragma unroll 1
    for (int i = 0; i < nitems; i += 2) {
        const int tk = tok0 + i * tstride;
        if (i + 1 < nitems) PC_ISSUE_V(bufB, wB, xvB, 1);
        if (i + 2 < nitems) PC_META_V(tk + 2 * tstride);
        PC_COMPUTE_V(bufA, wA, xvA, tk);
        if (i + 1 < nitems) {
            if (i + 2 < nitems) PC_ISSUE_V(bufA, wA, xvA, 0);
            if (i + 3 < nitems) PC_META_V(tk + 3 * tstride);
            PC_COMPUTE_V(bufB, wB, xvB, tk + tstride);
        }
    }
    LDS_WAIT();
}


#define FZ_S(i_) ((xs + ((i_) >> 3)) & 7)
#define FZ_TK(i_) (tokb + tjs * ((i_) & 7))
#define FU_META(i_) do { const unsigned xw_ = *(const GAS unsigned*)(x1b + (size_t)FZ_TK(i_) * D + 128 * FZ_S(i_) + 2 * lane); m_x.x = bflo(xw_); m_x.y = bfhi(xw_); } while (0)
#define FU_ISSUE(buf, xq, xinv, par, i_) do { const LAS int* lid_ = ids + ((i_) & 7) * 128; LAS unsigned short* lx_ = (LAS unsigned short*)(scr + 12288 + (par) * 128); \
        const char* tb_ = (const char*)TU8s + (size_t)FZ_S(i_) * NEXP * 128 + 16 * c; \
        _Pragma("unroll") for (int k = 0; k < 16; ++k) { const int e_ = lid_[8 * k + r]; buf[k] = *(const GAS v4u*)(tb_ + (unsigned)(e_ * 128)); } \
        { const float sc_ = tks[((i_) & 7)]; xinv = tks[8 + ((i_) & 7)];        \
          const int q0_ = (int)__builtin_rintf(m_x.x * sc_), q1_ = (int)__builtin_rintf(m_x.y * sc_); lx_[lane] = (unsigned short)(((unsigned)q0_ & 255u) | (((unsigned)q1_ & 255u) << 8)); } \
        LDS_WAIT(); xq = *(const LAS v4u*)((LAS unsigned char*)lx_ + 16 * c); } while (0)
#define FU_COMPUTE(buf, xq, xinv, i_) do { int p_[16]; \
        _Pragma("unroll") for (int k = 0; k < 16; ++k) { int a_ = __builtin_amdgcn_sdot4((int)buf[k].x, (int)xq.x, 0, false); a_ = __builtin_amdgcn_sdot4((int)buf[k].y, (int)xq.y, a_, false); \
            a_ = __builtin_amdgcn_sdot4((int)buf[k].z, (int)xq.z, a_, false); a_ = __builtin_amdgcn_sdot4((int)buf[k].w, (int)xq.w, a_, false); p_[k] = a_; } \
        LAS int* red_ = (LAS int*)(scr + 8192); \
        _Pragma("unroll") for (int k = 0; k < 16; ++k) red_[64 * k + lane] = p_[k]; \
        LDS_WAIT(); \
        const v4u ra_ = *(const LAS v4u*)(red_ + 8 * lane + rsw), rb_ = *(const LAS v4u*)(red_ + 8 * lane + (4 - rsw)), rc_ = *(const LAS v4u*)(red_ + 512 + 8 * lane + rsw), rd_ = *(const LAS v4u*)(red_ + 512 + 8 * lane + (4 - rsw)); \
        const int s0_ = (int)(ra_.x + ra_.y + ra_.z + ra_.w + rb_.x + rb_.y + rb_.z + rb_.w), s1_ = (int)(rc_.x + rc_.y + rc_.z + rc_.w + rd_.x + rd_.y + rd_.z + rd_.w); \
        LAS float* ua_ = uw + ((i_) & 7) * 128 + lane; ua_[0] += (float)s0_ * xinv; ua_[64] += (float)s1_ * xinv; } while (0)
#define FV_META(i_) do { m_xv = *(const GAS unsigned*)(x1b + (size_t)FZ_TK(i_) * D + 128 * FZ_S(i_) + 2 * lane); } while (0)
#define FV_ISSUE(buf, wk, xv, i_) do { const LAS int* lid_ = ids + ((i_) & 7) * 128; const LAS float* lw_ = uw + ((i_) & 7) * 128; xv = m_xv; \
        const char* tb_ = (const char*)TV8s + (size_t)FZ_S(i_) * NEXP * 128 + 16 * c; \
        _Pragma("unroll") for (int k = 0; k < 16; ++k) { const int e_ = lid_[8 * k + r]; wk[k] = lw_[8 * k + r]; buf[k] = *(const GAS v4u*)(tb_ + (unsigned)(e_ * 128)); } } while (0)
#define FV_COMPUTE(buf, wk, xv, i_) do { f32x2 acc2[8]; _Pragma("unroll") for (int i2_ = 0; i2_ < 8; ++i2_) acc2[i2_] = (f32x2){0.f, 0.f}; \
        _Pragma("unroll") for (int k = 0; k < 16; ++k) { PIN_ACC2(buf[k]); fp8_row_axpy2(buf[k], wk[k], acc2); } \
        LAS float* red_ = (LAS float*)(scr + 8192); LAS f32x4* wp_ = (LAS f32x4*)(red_ + 128 * r + 16 * c); \
        _Pragma("unroll") for (int j_ = 0; j_ < 4; ++j_) { f32x4 t_; t_.x = acc2[2 * j_].x; t_.y = acc2[2 * j_].y; t_.z = acc2[2 * j_ + 1].x; t_.w = acc2[2 * j_ + 1].y; wp_[j_] = t_; } \
        LDS_WAIT(); \
        f32x2 o_; o_.x = bflo(xv); o_.y = bfhi(xv); \
        _Pragma("unroll") for (int rr_ = 0; rr_ < 8; ++rr_) { const f32x2 t_ = *(const LAS f32x2*)(red_ + 128 * rr_ + 2 * lane); o_.x += t_.x; o_.y += t_.y; } \
        *(GAS unsigned*)((bf16*)x1b + (size_t)FZ_TK(i_) * D + 128 * FZ_S(i_) + 2 * lane) = cvtpk(o_.x, o_.y); } while (0)
__device__ __forceinline__ void peer_fused(int xs, int tokb, int tjs, const v2u* route, const bf16* x1b, const unsigned char* TU8s, const unsigned char* TV8s, const float* SU, const float* SV,
                                           const float* gain, float* xio, LAS unsigned char* scr, int lane) {
    const int r = lane >> 3, c = lane & 7, rsw = 4 * ((lane >> 3) & 1); const unsigned l8 = (unsigned)lane * 8u;
    LAS int* ids = (LAS int*)scr; LAS float* uw = (LAS float*)(scr + 4096); LAS float* tks = (LAS float*)(scr + 12288 + 256);
    { v4u xr[8][2];
#pragma unroll
      for (int t = 0; t < 8; ++t) { const GAS v4u* xp = (const GAS v4u*)(x1b + (size_t)(tokb + tjs * t) * D) + lane; xr[t][0] = xp[0]; xr[t][1] = xp[64]; }
      float am[8], sq[8];
#pragma unroll
      for (int t = 0; t < 8; ++t) { am[t] = 0.f; sq[t] = 0.f;
#pragma unroll
          for (int j = 0; j < 2; ++j) { const v4u q = xr[t][j]; const unsigned w4[4] = {q.x, q.y, q.z, q.w};
#pragma unroll
              for (int e = 0; e < 4; ++e) { const float a = bflo(w4[e]), b = bfhi(w4[e]); am[t] = __builtin_fmaxf(am[t], __builtin_fmaxf(__builtin_fabsf(a), __builtin_fabsf(b))); sq[t] += a * a + b * b; } } }
#pragma unroll
      for (int o = 1; o < 64; o <<= 1) {
#pragma unroll
          for (int t = 0; t < 8; ++t) { am[t] = __builtin_fmaxf(am[t], __shfl_xor(am[t], o)); sq[t] += __shfl_xor(sq[t], o); } }
#pragma unroll
      for (int t = 0; t < 8; ++t) if (lane == 0) { tks[t] = (am[t] > 0.f) ? 127.0f / am[t] : 0.f; tks[8 + t] = am[t] * (1.0f / 127.0f); tks[16 + t] = 1.0f / sqrtf(sq[t] * (1.0f / D) + RMS_EPS); } }
#pragma unroll
    for (int j = 0; j < 8; ++j) { const char* rb_ = (const char*)route + (size_t)(tokb + tjs * j) * 1024;
        ids[j * 128 + lane] = *(const GAS int*)(rb_ + l8); ids[j * 128 + 64 + lane] = *(const GAS int*)(rb_ + 512 + l8); uw[j * 128 + lane] = 0.f; uw[j * 128 + 64 + lane] = 0.f; }
    LDS_WAIT();
    {
        f32x2 m_x; v4u bufA[16], bufB[16], xqA, xqB; float xiA, xiB;
        FU_META(0); FU_ISSUE(bufA, xqA, xiA, 0, 0); FU_META(1);
#pragma unroll 1
        for (int it = 0; it < 64; it += 2) {
            FU_ISSUE(bufB, xqB, xiB, 1, it + 1);
            if (it + 2 < 64) FU_META(it + 2);
            FU_COMPUTE(bufA, xqA, xiA, it);
            if (it + 2 < 64) FU_ISSUE(bufA, xqA, xiA, 0, it + 2);
            if (it + 3 < 64) FU_META(it + 3);
            FU_COMPUTE(bufB, xqB, xiB, it + 1);
        }
        LDS_WAIT();
    }
    {
        v2u r_lo[8], r_hi[8];
#pragma unroll
        for (int t = 0; t < 8; ++t) { const int tok = tokb + tjs * t;
            const char* rb_ = (const char*)route + (size_t)tok * 1024; r_lo[t] = *(const GAS v2u*)(rb_ + l8); r_hi[t] = *(const GAS v2u*)(rb_ + 512 + l8); }
        float su[8][2], sv[8][2];
#pragma unroll
        for (int t = 0; t < 8; ++t) { su[t][0] = SU[(int)r_lo[t].x]; su[t][1] = SU[(int)r_hi[t].x]; sv[t][0] = SV[(int)r_lo[t].x]; sv[t][1] = SV[(int)r_hi[t].x]; }
#pragma unroll
        for (int t = 0; t < 8; ++t) {
            const float rstd2 = tks[16 + t];
            float g_lo, g_hi;
#pragma unroll
            for (int half = 0; half < 2; ++half) {
                const float sc_ = __builtin_bit_cast(float, half ? r_hi[t].y : r_lo[t].y) * rstd2; float m_ = sc_;
#pragma unroll
                for (int o = 1; o < 16; o <<= 1) m_ = __builtin_fmaxf(m_, __shfl_xor(m_, o));
                const float p_ = __builtin_amdgcn_exp2f((sc_ - m_) * 1.4426950408889634f); float sum_ = p_;
#pragma unroll
                for (int o = 1; o < 16; o <<= 1) sum_ += __shfl_xor(sum_, o);
                if (half) g_hi = p_ / sum_; else g_lo = p_ / sum_;
            }
            asm volatile("" : "+v"(g_lo), "+v"(g_hi));
            LAS float* up_ = uw + t * 128 + lane;
            const float d0 = up_[0], d1 = up_[64];
            up_[0] = g_lo * gelu_exact(d0 * su[t][0] * rstd2) * sv[t][0]; up_[64] = g_hi * gelu_exact(d1 * su[t][1] * rstd2) * sv[t][1];
        }
        LDS_WAIT();
    }
    {
        unsigned m_xv; v4u bufA[16], bufB[16]; float wA[16], wB[16]; unsigned xvA, xvB;
        FV_META(0); FV_ISSUE(bufA, wA, xvA, 0); FV_META(1);
#pragma unroll 1
        for (int it = 0; it < 64; it += 2) {
            FV_ISSUE(bufB, wB, xvB, it + 1);
            if (it + 2 < 64) FV_META(it + 2);
            FV_COMPUTE(bufA, wA, xvA, it);
            if (it + 2 < 64) FV_ISSUE(bufA, wA, xvA, it + 2);
            if (it + 3 < 64) FV_META(it + 3);
            FV_COMPUTE(bufB, wB, xvB, it + 1);
        }
        LDS_WAIT();
    }
    asm volatile("s_waitcnt vmcnt(0)" ::: "memory");
    { v4u xr[8][2];
#pragma unroll
      for (int t = 0; t < 8; ++t) { const GAS v4u* xp = (const GAS v4u*)(x1b + (size_t)(tokb + tjs * t) * D) + lane; xr[t][0] = xp[0]; xr[t][1] = xp[64]; }
      float sq[8];
#pragma unroll
      for (int t = 0; t < 8; ++t) { sq[t] = 0.f;
#pragma unroll
          for (int j = 0; j < 2; ++j) { const v4u q = xr[t][j]; const unsigned w4[4] = {q.x, q.y, q.z, q.w};
#pragma unroll
              for (int e = 0; e < 4; ++e) { const float a = bflo(w4[e]), b = bfhi(w4[e]); sq[t] += a * a + b * b; } } }
#pragma unroll
      for (int o = 1; o < 64; o <<= 1) {
#pragma unroll
          for (int t = 0; t < 8; ++t) sq[t] += __shfl_xor(sq[t], o); }
      f32x4 g[4];
#pragma unroll
      for (int j = 0; j < 2; ++j) { const GAS f32x4* gp = (const GAS f32x4*)(gain + 512 * j + 8 * lane); g[2 * j] = gp[0]; g[2 * j + 1] = gp[1]; }
#pragma unroll
      for (int t = 0; t < 8; ++t) { const float rstd3 = 1.0f / sqrtf(sq[t] * (1.0f / D) + RMS_EPS);
#pragma unroll
          for (int j = 0; j < 2; ++j) { const v4u q = xr[t][j]; GAS f32x4* op = (GAS f32x4*)(xio + (size_t)(tokb + tjs * t) * D + 512 * j + 8 * lane);
              f32x4 o0, o1; o0.x = bflo(q.x) * rstd3 * g[2 * j].x; o0.y = bfhi(q.x) * rstd3 * g[2 * j].y; o0.z = bflo(q.y) * rstd3 * g[2 * j].z; o0.w = bfhi(q.y) * rstd3 * g[2 * j].w;
              o1.x = bflo(q.z) * rstd3 * g[2 * j + 1].x; o1.y = bfhi(q.z) * rstd3 * g[2 * j + 1].y; o1.z = bflo(q.w) * rstd3 * g[2 * j + 1].z; o1.w = bfhi(q.w) * rstd3 * g[2 * j + 1].w;
              op[0] = o0; op[1] = o1; } } }
}

__device__ __forceinline__ void peer_u_debug(int tok, const v2u* route, const float* x1, const unsigned char* TU8s, const float* SU, const float* SV, float* W, int lane) {
    float xr[16], ssq = 0.f;
    { const GAS f32x4* xp = (const GAS f32x4*)(x1 + (size_t)tok * D + 16 * lane);
#pragma unroll
      for (int j = 0; j < 4; ++j) { const f32x4 a = xp[j]; xr[4 * j] = a.x; xr[4 * j + 1] = a.y; xr[4 * j + 2] = a.z; xr[4 * j + 3] = a.w; } }
#pragma unroll
    for (int i = 0; i < 16; ++i) ssq += xr[i] * xr[i];
    const float rstd2 = 1.0f / sqrtf(wave_sum(ssq) * (1.0f / D) + RMS_EPS);
    const char* rb_ = (const char*)route + (size_t)tok * 1024; const int s = lane >> 3, c = lane & 7;
#pragma unroll 1
    for (int h = 0; h < 8; ++h) {
        float sc[16]; int id[16]; float m = -3e38f;
#pragma unroll
        for (int i = 0; i < 16; ++i) { const v2u r = *(const GAS v2u*)(rb_ + (h * 16 + i) * 8 + opaque_zero()); id[i] = (int)r.x; sc[i] = __builtin_bit_cast(float, r.y) * rstd2; m = __builtin_fmaxf(m, sc[i]); }
        float sum = 0.f;
#pragma unroll
        for (int i = 0; i < 16; ++i) { sc[i] = __builtin_amdgcn_exp2f((sc[i] - m) * 1.4426950408889634f); sum += sc[i]; }
#pragma unroll
        for (int i = 0; i < 16; ++i) { const int e = id[i];
            const v4u q = *(const GAS v4u*)(TU8s + ((size_t)s * NEXP + e) * 128 + 16 * c);
            float d; fp8_row_dot(q, xr, d); d = wave_sum(d);
            const float act = gelu_exact(d * SU[e] * rstd2);
            if (lane == 0) W[(size_t)tok * 128 + h * 16 + i] = (sc[i] / sum) * act * SV[e]; }
    }
}
__device__ __forceinline__ void peer_v_debug(int tok, const v2u* route, const float* W, const unsigned char* TV8s, float* xio, float* SS, int lane) {
    const char* rb_ = (const char*)route + (size_t)tok * 1024;
    float acc[16];
#pragma unroll
    for (int i = 0; i < 16; ++i) acc[i] = 0.f;
    const int s = lane >> 3, c = lane & 7;
#pragma unroll 1
    for (int n = 0; n < 128; ++n) {
        const int e = *(const GAS int*)(rb_ + n * 8 + opaque_zero()); const float w = W[(size_t)tok * 128 + n + opaque_zero()];
        const v4u q = *(const GAS v4u*)(TV8s + ((size_t)s * NEXP + e) * 128 + 16 * c);
        fp8_row_axpy(q, w, acc);
    }
    float ssq = 0.f;
    GAS float* xp = (GAS float*)(xio + (size_t)tok * D + 16 * lane);
#pragma unroll
    for (int i = 0; i < 16; ++i) { const float o = xp[i] + acc[i]; xp[i] = o; ssq += o * o; }
    ssq = wave_sum(ssq);
    if (lane < 8) SS[(size_t)lane * M + tok] = (lane == 0) ? ssq : 0.f;
}
#ifndef DUP_MASK
#define DUP_MASK 0
#endif
#define NREP(k) (1 + ((DUP_MASK >> (k)) & 1))
struct Args { const float* in[14]; float* out; unsigned char* ws; int ph_lo, ph_hi, li, pad; };
__global__ void __launch_bounds__(NWAVES * 64, 2) hybrid_fwd(Args args) {
    extern __shared__ __attribute__((aligned(16))) unsigned char lds[];
    LAS unsigned char* ldsb = (LAS unsigned char*)lds;
    volatile LAS unsigned* MISC = (volatile LAS unsigned*)(ldsb + MISC_OFF);
    const int tid = threadIdx.x, lane = tid & 63, wave = __builtin_amdgcn_readfirstlane(tid >> 6);
    const int G = gridDim.x; const int bx = blockIdx.x; const int vcu = (G % 8 == 0) ? (bx % 8) * (G / 8) + bx / 8 : bx;
    const int gw = vcu * NWAVES + wave, NGW = G * NWAVES;
    unsigned char* ws = args.ws;
    gu32* ctl = (gu32*)(ws + WS_CTL);
    const float* x = args.in[0]; float* out = args.out;
#define norm_mix (args.in[1])
#define w_in (args.in[2])
#define conv_w (args.in[3])
#define conv_b (args.in[4])
#define w_a (args.in[5])
#define w_b (args.in[6])
#define w_o (args.in[7])
#define norm_ffn (args.in[8])
#define w_q (args.in[9])
#define sub_keys (args.in[10])
#define exp_u (args.in[11])
#define exp_v (args.in[12])
#define final_norm (args.in[13])
#define Weff ((bf16*)((bf16*)(ws + WS_WEFF)))
#define Wab ((bf16*)((bf16*)(ws + WS_WAB)))
#define Wo_t ((bf16*)((bf16*)(ws + WS_WO)))
#define Win_t ((bf16*)((bf16*)(ws + WS_WIN)))
#define XB ((bf16*)((bf16*)(ws + WS_XB)))
#define SIX ((bf16*)((bf16*)(ws + WS_SIX)))
#define VT ((bf16*)((bf16*)(ws + WS_VT)))
#define GATE ((bf16*)((bf16*)(ws + WS_GATE)))
#define MERGED ((bf16*)((bf16*)(ws + WS_MERGED)))
#define X1B ((bf16*)((bf16*)(ws + WS_X1B)))
#define TU8 ((unsigned char*)(ws + WS_TU))
#define TV8 ((unsigned char*)(ws + WS_TV))
#define SU ((float*)((float*)(ws + WS_SU)))
#define SV ((float*)((float*)(ws + WS_SV)))
#define SCORES ((float*)((float*)(ws + WS_SCORES)))
#define ROUTE ((v2u*)((v2u*)(ws + WS_ROUTE)))
#define WBUF ((float*)((float*)(ws + WS_W)))
#define SSB ((float*)((float*)(ws + WS_SS)))
#define UPART ((float*)((float*)(ws + WS_UPART)))
#define RSTD1 ((float*)((float*)(ws + WS_RSTD1)))
#define QB ((bf16*)(SIX))
#define CBB ((bf16*)(SIX + (size_t)1 * M * 512))
#define KB ((bf16*)(SIX + (size_t)2 * M * 512))
#define CCB ((bf16*)(SIX + (size_t)4 * M * 512))
#define CUB ((bf16*)(SIX + (size_t)5 * M * 512))
    for (int u = tid; u < (LDS_BYTES - LDSCTL_OFF) / 4; u += NWAVES * 64) ((LAS unsigned*)(ldsb + LDSCTL_OFF))[u] = 0u;
    __syncthreads();
    XcdBarrier bar; bar.bar = (unsigned*)(ctl + CW_BAR); bar.x = 0; bar.st = nullptr;
    if (N_LAUNCHES == 1) bar = xcd_barrier_post((unsigned*)(ctl + CW_BAR), MISC + 8);
#define GRID_BAR() do { if (N_LAUNCHES == 1) xcd_barrier(bar); } while (0)
#ifdef TPROBE
    unsigned long long t_s = 0, t_e = 0;
#define TSTAMP(k) do { if ((k) == TPROBE) t_s = __builtin_amdgcn_s_memrealtime(); if ((k) == TPROBE_END) t_e = __builtin_amdgcn_s_memrealtime(); } while (0)
#ifndef TPROBE_TID
#define TPROBE_TID 0
#endif
#define TSTALL() do { if (bx == 0 && tid == TPROBE_TID) { const unsigned long long t0_ = __builtin_amdgcn_s_memrealtime(), dt_ = (t_e - t_s) * 8ull; while (__builtin_amdgcn_s_memrealtime() - t0_ < dt_) __builtin_amdgcn_s_sleep(4); } } while (0)
#else
#define TSTAMP(k) do { } while (0)
#define TSTALL() do { } while (0)
#endif
    const int lo = args.ph_lo, hi = args.ph_hi;
#define IN(k) (lo <= (k) && (k) < hi)
#define BOTH(k) (IN(k) && IN((k) + 1))

    TSTAMP(0);
    if (IN(0)) { for (int rep = 0; rep < NREP(0); ++rep) {
        LAS float* scr = (LAS float*)(ldsb + RING_OFF + wave * 17408);
        constexpr int I_IN = (D / 64) * (NIN / 32), I_A = (512 / 64) * (D / 32), I_O = (D / 64) * (D / 32);
        constexpr int NITEMS = I_IN + 2 * I_A + I_O;
        constexpr int ABW = 3; const int aw = vcu * ABW + wave, NAW = G * ABW, cw = vcu * (NWAVES - ABW) + (wave - ABW), NCW = G * (NWAVES - ABW);
        if (wave < ABW) {
        for (int it = aw; it < NITEMS; it += NAW) {
            int r = it;
            if (r < I_IN) { p0_transpose_item(w_in, D, NIN, Win_t, 0, norm_mix, scr, r, lane); continue; } r -= I_IN;
            if (r < I_A) { p0_transpose_item(w_a, 512, D, Wab, 0, nullptr, scr, r, lane); continue; } r -= I_A;
            if (r < I_A) { p0_transpose_item(w_b, 512, D, Wab, 1024, nullptr, scr, r, lane); continue; } r -= I_A;
            p0_transpose_item(w_o, D, D, Wo_t, 0, nullptr, scr, r, lane);
        }
        TSTAMP(20);
        for (int wt = aw; wt < 64 * 32; wt += NAW) {
            const int nt = wt & 63, kt = wt >> 6, hp = nt >> 2, h = lane >> 5, l32 = lane & 31;
            f32x4 av[16], bv[16];
            { f32x4 t[16];
#pragma unroll
              for (int i = 0; i < 16; ++i) t[i] = *(const GAS f32x4*)(w_q + (size_t)(kt * 32 + 2 * i + (lane >> 5)) * 2048 + hp * 128 + 4 * (lane & 31));
#pragma unroll
              for (int i = 0; i < 16; ++i) *(LAS f32x4*)(scr + (2 * i + (lane >> 5)) * 132 + 4 * (lane & 31)) = t[i];
              LDS_WAIT();
#pragma unroll
              for (int i = 0; i < 16; ++i) av[i] = *(const LAS f32x4*)(scr + l32 * 132 + 64 * h + 4 * i);
              LDS_WAIT();
#pragma unroll
              for (int i = 0; i < 16; ++i) t[i] = *(const GAS f32x4*)(sub_keys + (size_t)(nt * 32) * 128 + 4 * (i * 64 + lane));
#pragma unroll
              for (int i = 0; i < 16; ++i) *(LAS f32x4*)(scr + (2 * i + (lane >> 5)) * 132 + 4 * (lane & 31)) = t[i];
              LDS_WAIT();
#pragma unroll
              for (int i = 0; i < 16; ++i) bv[i] = *(const LAS f32x4*)(scr + l32 * 132 + 64 * h + 4 * i);
              LDS_WAIT(); }
            f32x16 acc;
#pragma unroll
            for (int i = 0; i < 16; ++i) acc[i] = 0.f;
#pragma unroll
            for (int i = 0; i < 16; ++i) {
                acc = __builtin_amdgcn_mfma_f32_32x32x2f32(av[i].x, bv[i].x, acc, 0, 0, 0); acc = __builtin_amdgcn_mfma_f32_32x32x2f32(av[i].y, bv[i].y, acc, 0, 0, 0);
                acc = __builtin_amdgcn_mfma_f32_32x32x2f32(av[i].z, bv[i].z, acc, 0, 0, 0); acc = __builtin_amdgcn_mfma_f32_32x32x2f32(av[i].w, bv[i].w, acc, 0, 0, 0); }
            const int n = nt * 32 + l32;
#pragma unroll
            for (int rq = 0; rq < 4; ++rq) { const int kb = kt * 32 + 8 * rq + 4 * h; const f32x4 g = *(const GAS f32x4*)(norm_ffn + kb);
                v2u o; o.x = pk2(acc[4 * rq] * g.x, acc[4 * rq + 1] * g.y); o.y = pk2(acc[4 * rq + 2] * g.z, acc[4 * rq + 3] * g.w);
                *(GAS v2u*)(Weff + (size_t)n * D + kb) = o; }
        }
        TSTAMP(21);
        } else {
        for (int m0 = cw; m0 < M; m0 += 4 * NCW) {
            f32x4 v[4][4]; float s[4];
#pragma unroll
            for (int q = 0; q < 4; ++q) { const int m = m0 + q * NCW; const GAS f32x4* xr = (const GAS f32x4*)(x + (size_t)(m < M ? m : m0) * D) + lane;
#pragma unroll
                for (int j = 0; j < 4; ++j) v[q][j] = __builtin_nontemporal_load(xr + 64 * j); }
#pragma unroll
            for (int q = 0; q < 4; ++q) { s[q] = 0.f;
#pragma unroll
                for (int j = 0; j < 4; ++j) s[q] += (v[q][j].x * v[q][j].x + v[q][j].y * v[q][j].y) + (v[q][j].z * v[q][j].z + v[q][j].w * v[q][j].w); }
#pragma unroll
            for (int o = 1; o < 64; o <<= 1) {
#pragma unroll
                for (int q = 0; q < 4; ++q) s[q] += __shfl_xor(s[q], o); }
#pragma unroll
            for (int q = 0; q < 4; ++q) { const int m = m0 + q * NCW; if (m < M) {
                const float rstd = 1.0f / sqrtf(s[q] * (1.0f / D) + RMS_EPS);
                GAS v2u* o8 = (GAS v2u*)(XB + (size_t)m * D) + lane;
#pragma unroll
                for (int j = 0; j < 4; ++j) { v2u o; o.x = pk2(v[q][j].x, v[q][j].y); o.y = pk2(v[q][j].z, v[q][j].w); o8[64 * j] = o; }
                if (lane == 0) RSTD1[m] = rstd; } }
        }
        TSTAMP(22);
        for (int e0 = cw; e0 < NEXP; e0 += 2 * NCW) {
            float v[4][16]; float am[4]; int ee[4];
#pragma unroll
            for (int q = 0; q < 4; ++q) { const int e = e0 + (q >> 1) * NCW; ee[q] = e < NEXP ? e : e0; const float* src = ((q & 1) ? exp_v : exp_u) + (size_t)ee[q] * D; const GAS f32x4* sp = (const GAS f32x4*)src;
#pragma unroll
                for (int j = 0; j < 2; ++j) { const f32x4 a = __builtin_nontemporal_load(sp + 2 * lane + 128 * j), b = __builtin_nontemporal_load(sp + 2 * lane + 128 * j + 1);
                    v[q][8 * j + 0] = a.x; v[q][8 * j + 1] = a.y; v[q][8 * j + 2] = a.z; v[q][8 * j + 3] = a.w; v[q][8 * j + 4] = b.x; v[q][8 * j + 5] = b.y; v[q][8 * j + 6] = b.z; v[q][8 * j + 7] = b.w; } }
            { const GAS f32x4* gp = (const GAS f32x4*)norm_ffn;
#pragma unroll
              for (int j = 0; j < 2; ++j) { const f32x4 ga = gp[2 * lane + 128 * j], gb = gp[2 * lane + 128 * j + 1];
#pragma unroll
                for (int q = 0; q < 4; q += 2) { v[q][8 * j + 0] *= ga.x; v[q][8 * j + 1] *= ga.y; v[q][8 * j + 2] *= ga.z; v[q][8 * j + 3] *= ga.w; v[q][8 * j + 4] *= gb.x; v[q][8 * j + 5] *= gb.y; v[q][8 * j + 6] *= gb.z; v[q][8 * j + 7] *= gb.w; } } }
#pragma unroll
            for (int q = 0; q < 4; ++q) { am[q] = 0.f;
#pragma unroll
                for (int i = 0; i < 16; ++i) am[q] = __builtin_fmaxf(am[q], __builtin_fabsf(v[q][i])); }
#pragma unroll
            for (int o = 1; o < 64; o <<= 1) {
#pragma unroll
                for (int q = 0; q < 4; ++q) am[q] = __builtin_fmaxf(am[q], __shfl_xor(am[q], o)); }
#pragma unroll
            for (int q = 0; q < 4; ++q) { const int e = e0 + (q >> 1) * NCW; if (e < NEXP) {
                const float top = (q & 1) ? 384.0f : 127.0f;
                const float sc = (am[q] > 0.f) ? top / am[q] : 1.0f, inv = (am[q] > 0.f) ? am[q] * (1.0f / top) : 1.0f;
                v2u q0, q1;
                if (q & 1) {
                { int w = __builtin_amdgcn_cvt_pk_fp8_f32(v[q][0] * sc, v[q][1] * sc, 0, false); w = __builtin_amdgcn_cvt_pk_fp8_f32(v[q][2] * sc, v[q][3] * sc, w, true); q0.x = (unsigned)w; }
                { int w = __builtin_amdgcn_cvt_pk_fp8_f32(v[q][4] * sc, v[q][5] * sc, 0, false); w = __builtin_amdgcn_cvt_pk_fp8_f32(v[q][6] * sc, v[q][7] * sc, w, true); q0.y = (unsigned)w; }
                { int w = __builtin_amdgcn_cvt_pk_fp8_f32(v[q][8] * sc, v[q][9] * sc, 0, false); w = __builtin_amdgcn_cvt_pk_fp8_f32(v[q][10] * sc, v[q][11] * sc, w, true); q1.x = (unsigned)w; }
                { int w = __builtin_amdgcn_cvt_pk_fp8_f32(v[q][12] * sc, v[q][13] * sc, 0, false); w = __builtin_amdgcn_cvt_pk_fp8_f32(v[q][14] * sc, v[q][15] * sc, w, true); q1.y = (unsigned)w; }
                } else {
                    unsigned w4[4];
#pragma unroll
                    for (int j = 0; j < 4; ++j) { const int i0 = (int)__builtin_rintf(v[q][4 * j] * sc), i1 = (int)__builtin_rintf(v[q][4 * j + 1] * sc), i2 = (int)__builtin_rintf(v[q][4 * j + 2] * sc), i3 = (int)__builtin_rintf(v[q][4 * j + 3] * sc);
                        w4[j] = ((unsigned)i0 & 255u) | (((unsigned)i1 & 255u) << 8) | (((unsigned)i2 & 255u) << 16) | ((unsigned)i3 << 24); }
                    q0.x = w4[0]; q0.y = w4[1]; q1.x = w4[2]; q1.y = w4[3];
                }
                unsigned char* dst = (q & 1) ? TV8 : TU8; const int s0 = lane >> 4, o8 = 8 * (lane & 15);
                *(GAS v2u*)(dst + ((size_t)s0 * NEXP + e) * 128 + o8) = q0; *(GAS v2u*)(dst + ((size_t)(s0 + 4) * NEXP + e) * 128 + o8) = q1;
                if (lane == 0) ((q & 1) ? SV : SU)[e] = inv; } }
        }
                TSTAMP(23);
        }
}
        if (BOTH(0)) GRID_BAR();
    }

    TSTAMP(1);
    if (IN(1)) { for (int rep = 0; rep < NREP(1); ++rep) { if (rep) GRID_BAR();
        pg8::Gemm g{XB, Win_t, M, NIN, D}; pg8::StaticOrder S; S.init(M, NIN, G, (int)blockIdx.x);
        pg8::EpiProj E{SIX, VT, GATE, RSTD1, (DUP_MASK & 64) ? rep : 0};
        pg8::gemm_phase<pg8::EpiProj, pg8::StaticOrder, true, true>(ldsb + RING_OFF, g, S, E); }
        if (DUP_MASK & 128) { const unsigned long long t0 = __builtin_amdgcn_s_memrealtime(); while (__builtin_amdgcn_s_memrealtime() - t0 < 15000ull) __builtin_amdgcn_s_sleep(8); }
        if (BOTH(1)) GRID_BAR();
    }

    TSTAMP(2);
    if (IN(2)) {
        for (int rep = 0; rep < NREP(2); ++rep) {
        const bool dummy = (rep + 1 < NREP(2));
        conv_phase(CBB, CCB, CUB, dummy ? XB : CBB, conv_w, conv_b, gw * 64 + lane, NGW * 64);
        TSTAMP(24);
        for (int it = gw; it < BATCH * NH * (T / 32); it += NGW) {
            const int bh = it >> 7, qblk = it & 127;
            attn_item(QB, KB, VT, dummy ? MERGED : QB, bh >> 3, bh & 7, qblk, ldsb + RING_OFF + wave * 9216, lane);
        }
        }
        if (BOTH(2)) GRID_BAR();
    }

    TSTAMP(3);
    if (IN(3)) { for (int rep = 0; rep < NREP(3); ++rep) { if (rep) GRID_BAR();
        pg8::Gemm g{QB, Wab, 2 * M, 2048, 512}; pg8::PairOrder S; S.init(G, (int)blockIdx.x);
        pg8::EpiGate E{out, MERGED, GATE, GATE + (size_t)M * 1024};
        pg8::gemm_phase<pg8::EpiGate, pg8::PairOrder, true, true>(ldsb + RING_OFF, g, S, E); }
        if (BOTH(3)) GRID_BAR();
    }

    TSTAMP(4);
    if (IN(4)) { for (int rep = 0; rep < NREP(4); ++rep) { if (rep) GRID_BAR();
        pg8::Gemm g{MERGED, Wo_t, M, D, D}; pg8::StaticOrder S; S.init(M, D, G, (int)blockIdx.x);
        pg8::EpiWo E{x, X1B};
        pg8::gemm_phase<pg8::EpiWo, pg8::StaticOrder, false, true>(ldsb + RING_OFF, g, S, E);
        }
        if (BOTH(4)) GRID_BAR();
    }

    TSTAMP(5);
    if (IN(5)) { for (int rep = 0; rep < NREP(5); ++rep) { if (rep) GRID_BAR();
        pg8::Gemm g{X1B, Weff, M, 2048, D}; pg8::StaticOrder S; S.init(M, 2048, G, (int)blockIdx.x);
        pg8::EpiScores E{(unsigned short*)SCORES};
        pg8::gemm_phase<pg8::EpiScores, pg8::StaticOrder, true, true>(ldsb + RING_OFF, g, S, E);
        asm volatile("s_waitcnt vmcnt(0)" ::: "memory"); __syncthreads();
        int nu = 0; { pg8::Unit u; while (S.next(nu, u)) ++nu; }
        LAS unsigned char* scr = ldsb + RING_OFF + wave * 8192;
        for (int t = wave; t < nu * 4; t += NWAVES) { pg8::Unit u; S.next(t >> 2, u); route_task((const unsigned short*)SCORES, ROUTE, u.pm * 256 + (t & 3) * 64, u.pn, scr, lane); } }
        if (BOTH(5)) GRID_BAR();
    }
    const bool sliced_ok = (G % 8 == 0) && (M % ((G / 8) * NWAVES) == 0);
    const bool fused_ok = (G % 8 == 0) && (M == G * NWAVES * 8);

    TSTAMP(7);
    if (IN(7)) {
        LAS unsigned char* scr = ldsb + RING_OFF + wave * 8192;
#ifdef DEBUG_U
        if (1) {} else
#endif
        if (fused_ok) peer_fused(bx & 7, (bx & 7) + 8 * ((bx >> 3) * NWAVES + wave), M / 8, ROUTE, X1B, TU8, TV8, SU, SV, final_norm, out, ldsb + RING_OFF + wave * 16384, lane);
        else if (sliced_ok) { const int nj = G >> 3; peer_u_phase_dot4(bx & 7, (bx >> 3) * NWAVES + wave, nj * NWAVES, M / (nj * NWAVES), ROUTE, (const float*)X1B, TU8, UPART, scr, lane); }
        else for (int s8 = 0; s8 < 8; ++s8) { const int nt = (M - 1 - gw) / NGW + 1; if (gw < M) peer_u_phase_dot4(s8, gw, NGW, nt, ROUTE, (const float*)X1B, TU8, UPART, scr, lane); }
        if (BOTH(7) && !fused_ok) GRID_BAR();
    }

    TSTAMP(8);
    if (IN(8) && !fused_ok) {
#ifdef DEBUG_U
        for (int tok = gw; tok < M; tok += NGW) peer_u_debug(tok, ROUTE, out, TU8, SU, SV, WBUF, lane);
#else
        for (int tok = gw; tok < M; tok += 2 * NGW) peer_w_token2(tok, (tok + NGW < M) ? tok + NGW : tok, ROUTE, X1B, (const bf16*)UPART, SU, SV, WBUF, lane);
#endif
        if (BOTH(8)) GRID_BAR();
    }

    TSTAMP(9);
    if (IN(9) && !fused_ok) {
        LAS unsigned char* scr = ldsb + RING_OFF + wave * 8192;
#ifdef DEBUG_V
        for (int tok = gw; tok < M; tok += NGW) peer_v_debug(tok, ROUTE, WBUF, TV8, out, SSB, lane);
        if (0)
#endif
        if (sliced_ok) { const int nj = G >> 3; peer_v_phase(bx & 7, (bx >> 3) * NWAVES + wave, nj * NWAVES, M / (nj * NWAVES), ROUTE, WBUF, TV8, X1B, out, SSB, scr, lane); }
        else for (int s8 = 0; s8 < 8; ++s8) { const int nt = (M - 1 - gw) / NGW + 1; if (gw < M) peer_v_phase(s8, gw, NGW, nt, ROUTE, WBUF, TV8, X1B, out, SSB, scr, lane); }
        if (BOTH(9)) GRID_BAR();
    }

    TSTAMP(10);
    if (IN(10) && !fused_ok) {
        for (int tok = gw; tok < M; tok += NGW) {
            GAS f32x4* op = (GAS f32x4*)(out + (size_t)tok * D) + lane; const GAS f32x4* gp = (const GAS f32x4*)final_norm + lane;
            f32x4 v[4]; float s2 = 0.f;
#pragma unroll
            for (int j = 0; j < 4; ++j) { v[j] = op[64 * j]; s2 += (v[j].x * v[j].x + v[j].y * v[j].y) + (v[j].z * v[j].z + v[j].w * v[j].w); }
            const float rstd3 = 1.0f / sqrtf(wave_sum(s2) * (1.0f / D) + RMS_EPS);
#pragma unroll
            for (int j = 0; j < 4; ++j) { const f32x4 g = gp[64 * j]; f32x4 o; o.x = v[j].x * rstd3 * g.x; o.y = v[j].y * rstd3 * g.y; o.z = v[j].z * rstd3 * g.z; o.w = v[j].w * rstd3 * g.w; op[64 * j] = o; }
        }
    }
    TSTAMP(11);
    TSTALL();
#undef IN
#undef BOTH
#undef GRID_BAR
#undef norm_mix
#undef w_in
#undef conv_w
#undef conv_b
#undef w_a
#undef w_b
#undef w_o
#undef norm_ffn
#undef w_q
#undef sub_keys
#undef exp_u
#undef exp_v
#undef final_norm
#undef Weff
#undef Wab
#undef Wo_t
#undef Win_t
#undef XB
#undef SIX
#undef VT
#undef GATE
#undef MERGED
#undef X1B
#undef TU8
#undef TV8
#undef SU
#undef SV
#undef SCORES
#undef ROUTE
#undef WBUF
#undef SSB
#undef UPART
#undef RSTD1
#undef QB
#undef CBB
#undef KB
#undef CCB
#undef CUB
}

extern "C" void kernel_launch(void* const* d_in, const int* in_sizes, int n_in, void* d_out, int out_size, void* d_ws, size_t ws_size, hipStream_t stream) {
    static int grid = 0;
    if (grid == 0) {
        if (n_in != 14 || in_sizes[0] != M * D || out_size != M * D || ws_size < WS_END) { fprintf(stderr, "kernel_launch: built for 14 inputs, x/out of %d floats, >= %zu bytes of workspace; got n_in %d, in0 %d, out %d, ws %zu; nothing launched\n", M * D, (size_t)WS_END, n_in, n_in > 0 ? in_sizes[0] : -1, out_size, ws_size); grid = -1; return; }
        int dev = 0, cus = 0, per_cu = 0;
        if (hipGetDevice(&dev) != hipSuccess || hipDeviceGetAttribute(&cus, hipDeviceAttributeMultiprocessorCount, dev) != hipSuccess) { fprintf(stderr, "kernel_launch: device query failed\n"); grid = -1; return; }
        if (hipFuncSetAttribute((const void*)hybrid_fwd, hipFuncAttributeMaxDynamicSharedMemorySize, LDS_BYTES) != hipSuccess) { fprintf(stderr, "kernel_launch: hipFuncSetAttribute failed\n"); grid = -1; return; }
        if (hipOccupancyMaxActiveBlocksPerMultiprocessor(&per_cu, (const void*)hybrid_fwd, NWAVES * 64, LDS_BYTES) != hipSuccess || per_cu < 1) { fprintf(stderr, "kernel_launch: occupancy query reports %d workgroups per CU\n", per_cu); per_cu = 1; }
        (void)hipGetLastError();
        grid = cus;
    }
    if (grid < 0) return;
    if (hipMemsetAsync((char*)d_ws + WS_CTL, 0, CTL_ZERO_BYTES, stream) != hipSuccess) { fprintf(stderr, "kernel_launch: hipMemsetAsync failed\n"); return; }
    Args a{};
    for (int i = 0; i < 14; ++i) a.in[i] = (const float*)d_in[i];
    a.out = (float*)d_out; a.ws = (unsigned char*)d_ws;
#ifdef PROBE_SEQ
    const int seq[] = PROBE_SEQ; const int nseq = (int)(sizeof(seq) / sizeof(int));
#else
    const int seq[] = {0, 1, 2, 3, 4, 5, 6, 7, 8, 9, 10}; const int nseq = (N_LAUNCHES == 1) ? 1 : 11;
#endif
    for (int li = 0; li < nseq; ++li) {
        a.ph_lo = (N_LAUNCHES == 1) ? 0 : seq[li]; a.ph_hi = (N_LAUNCHES == 1) ? N_PHASES : seq[li] + 1; a.li = li;
        hipLaunchKernelGGL(hybrid_fwd, dim3(grid), dim3(NWAVES * 64), LDS_BYTES, stream, a);
        const hipError_t le = hipPeekAtLastError();
        if (le != hipSuccess) { fprintf(stderr, "kernel_launch: launch %d failed: %s\n", li, hipGetErrorName(le)); break; }
    }
}
```
